# Optimizing an MI355X kernel written in HIP

```python
import math
import jax, jax.numpy as jnp
from jax import lax
import numpy as np

D_MODEL = 1024
BATCH = 16
SEQ = 4096
DEPTH = 1

S5_WIDTH = 512
S5_GROUP = 16
S5_GROUPS = S5_WIDTH // S5_GROUP
S5_STATE = 64
S5_DT_MIN = 0.001
S5_DT_MAX = 0.1

RW_WIDTH = 512
RW_HEAD = 64
RW_HEADS = RW_WIDTH // RW_HEAD
DECAY_LORA = 64
AAA_LORA = 64
GATE_LORA = 128
RW_COLS = 3 * RW_WIDTH + DECAY_LORA + AAA_LORA + GATE_LORA

N_BRANCH = 2
IN_COLS = S5_WIDTH + RW_COLS + N_BRANCH * D_MODEL

N_EXPERTS = 32
TOP_K = 4
D_EXPERT = D_MODEL
SWIGLU_ALPHA = 1.702
SWIGLU_LIMIT = 7.0
MOE_BLOCK = 128

RMS_EPS = 1e-5
GN_EPS = 64e-5
L2_EPS = 1e-12

kernel_name = "hybrid_s5_rwkv7_moe_block"


def rmsnorm(x, g):
    xf = x.astype(jnp.float32)
    y = xf * lax.rsqrt(jnp.mean(xf * xf, axis=-1, keepdims=True) + RMS_EPS)
    return (y * g.astype(jnp.float32)).astype(x.dtype)


def s5_scan(u, lam_re, lam_im, log_dt, b_re, b_im, c_re, c_im, d_skip):
    f32 = jnp.float32
    bsz, seq, _ = u.shape
    uf = u.astype(f32)
    lr, li = lam_re.astype(f32), lam_im.astype(f32)
    dt = jnp.exp(log_dt.astype(f32))[:, None]
    mag = jnp.exp(lr * dt)
    ab_re, ab_im = mag * jnp.cos(li * dt), mag * jnp.sin(li * dt)
    den = lr * lr + li * li
    nr, ni = ab_re - 1.0, ab_im
    f_re = (nr * lr + ni * li) / den
    f_im = (ni * lr - nr * li) / den
    br, bi = b_re.astype(f32), b_im.astype(f32)
    bb_re = f_re[..., None] * br - f_im[..., None] * bi
    bb_im = f_re[..., None] * bi + f_im[..., None] * br
    ug = uf.reshape(bsz, seq, S5_GROUPS, S5_GROUP)
    bu_re = jnp.einsum('bsgc,gpc->bsgp', ug, bb_re)
    bu_im = jnp.einsum('bsgc,gpc->bsgp', ug, bb_im)
    a_re = jnp.broadcast_to(ab_re, (1, seq, S5_GROUPS, S5_STATE))
    a_im = jnp.broadcast_to(ab_im, (1, seq, S5_GROUPS, S5_STATE))

    def combine(e1, e2):
        a1r, a1i, b1r, b1i = e1
        a2r, a2i, b2r, b2i = e2
        return (a1r * a2r - a1i * a2i,
                a1r * a2i + a1i * a2r,
                a2r * b1r - a2i * b1i + b2r,
                a2r * b1i + a2i * b1r + b2i)

    _, _, xr, xi = lax.associative_scan(combine, (a_re, a_im, bu_re, bu_im), axis=1)
    y = (jnp.einsum('bsgp,gcp->bsgc', xr, c_re.astype(f32))
         - jnp.einsum('bsgp,gcp->bsgc', xi, c_im.astype(f32)))
    return y.reshape(bsz, seq, S5_WIDTH) + d_skip.astype(f32) * uf


def rwkv7_recurrence(r, decay, k, v, a_vec, b_vec):
    bsz, _, nh, n = r.shape

    def step(state, inp):
        rt, wt, kt, vt, at, bt = inp
        sa = jnp.einsum('bhvk,bhk->bhv', state, at)
        state = (state * wt[:, :, None, :] + sa[..., None] * bt[:, :, None, :]
                 + vt[..., None] * kt[:, :, None, :])
        return state, jnp.einsum('bhvk,bhk->bhv', state, rt)

    s0 = jnp.zeros((bsz, nh, n, n), jnp.float32)
    xs = (jnp.moveaxis(r, 1, 0), jnp.moveaxis(decay, 1, 0), jnp.moveaxis(k, 1, 0),
          jnp.moveaxis(v, 1, 0), jnp.moveaxis(a_vec, 1, 0), jnp.moveaxis(b_vec, 1, 0))
    _, ys = lax.scan(step, s0, xs)
    return jnp.moveaxis(ys, 0, 1)


def rwkv7_branch(p, mu, w0, w2, a0, a2, g2, k_k, k_a, r_k, ln_g, ln_b, w_o):
    f32 = jnp.float32
    bsz, seq, _ = p.shape
    pf = p.astype(f32)
    prev = jnp.pad(pf[:, :-1], ((0, 0), (1, 0), (0, 0)))
    xs = pf + mu.astype(f32) * (prev - pf)
    c1, c2, c3 = RW_WIDTH, 2 * RW_WIDTH, 3 * RW_WIDTH
    c4, c5 = c3 + DECAY_LORA, c3 + DECAY_LORA + AAA_LORA
    r, k, v = xs[..., :c1], xs[..., c1:c2], xs[..., c2:c3]
    wd, ad, gd = xs[..., c3:c4], xs[..., c4:c5], xs[..., c5:]
    w_log = -jax.nn.softplus(-(w0.astype(f32) + jnp.tanh(wd) @ w2.astype(f32))) - 0.5
    decay = jnp.exp(-jnp.exp(w_log))
    a = jax.nn.sigmoid(a0.astype(f32) + ad @ a2.astype(f32))
    g = jax.nn.sigmoid(gd) @ g2.astype(f32)
    heads = lambda t: t.reshape(bsz, seq, RW_HEADS, RW_HEAD)
    kk = heads(k * k_k.astype(f32))
    kk = kk / jnp.maximum(jnp.sqrt(jnp.sum(kk * kk, axis=-1, keepdims=True)), L2_EPS)
    k = k * (1.0 + (a - 1.0) * k_a.astype(f32))
    rh, kh, vh, ah = heads(r), heads(k), heads(v), heads(a)
    y = rwkv7_recurrence(rh, heads(decay), kh, vh, -kk, kk * ah)
    mean = jnp.mean(y, axis=-1, keepdims=True)
    var = jnp.mean(jnp.square(y - mean), axis=-1, keepdims=True)
    y = ((y - mean) * lax.rsqrt(var + GN_EPS)).reshape(bsz, seq, RW_WIDTH)
    y = y * ln_g.astype(f32) + ln_b.astype(f32)
    bonus = jnp.sum(rh * kh * r_k.astype(f32), axis=-1, keepdims=True) * vh
    y = (y + bonus.reshape(bsz, seq, RW_WIDTH)) * g
    return y @ w_o.astype(f32)


def mixer_sublayer(h, norm_g, w_in, lam_re, lam_im, log_dt, b_re, b_im, c_re, c_im, d_skip,
                   w_glu, b_glu, mu, w0, w2, a0, a2, g2, k_k, k_a, r_k, ln_g, ln_b, w_rw_out, w_out):
    f32 = jnp.float32
    xn = rmsnorm(h, norm_g)
    p = xn @ w_in
    u_s5 = p[..., :S5_WIDTH]
    p_rw = p[..., S5_WIDTH:S5_WIDTH + RW_COLS]
    gl = p[..., S5_WIDTH + RW_COLS:].astype(f32)
    ys = jax.nn.gelu(s5_scan(u_s5, lam_re, lam_im, log_dt, b_re, b_im, c_re, c_im, d_skip))
    z = ys @ w_glu.astype(f32) + b_glu.astype(f32)
    s5_out = z[..., :D_MODEL] * jax.nn.sigmoid(z[..., D_MODEL:])
    rw_out = rwkv7_branch(p_rw, mu, w0, w2, a0, a2, g2, k_k, k_a, r_k, ln_g, ln_b, w_rw_out)
    mixed = jax.nn.sigmoid(gl[..., :D_MODEL]) * s5_out + jax.nn.sigmoid(gl[..., D_MODEL:]) * rw_out
    return h + (mixed @ w_out.astype(f32)).astype(h.dtype)


def clamped_swiglu(hid):
    x_glu = jnp.minimum(hid[..., ::2], SWIGLU_LIMIT)
    x_lin = jnp.clip(hid[..., 1::2], -SWIGLU_LIMIT, SWIGLU_LIMIT)
    return x_glu * jax.nn.sigmoid(SWIGLU_ALPHA * x_glu) * (x_lin + 1.0)


def moe_sublayer(h, norm_g, router_w, router_b, w1, b1, w2, b2):
    bsz, seq, d = h.shape
    xn = rmsnorm(h, norm_g).reshape(-1, d)
    t = xn.shape[0]
    logits = xn.astype(jnp.float32) @ router_w.astype(jnp.float32) + router_b.astype(jnp.float32)
    top_vals, top_idx = lax.top_k(logits, TOP_K)
    gates = jax.nn.softmax(top_vals, axis=-1)
    n_assign = t * TOP_K
    n_blk = (n_assign + MOE_BLOCK - 1) // MOE_BLOCK + N_EXPERTS
    e_flat = top_idx.reshape(-1)
    tok_flat = jnp.arange(n_assign, dtype=jnp.int32) // TOP_K
    g_flat = gates.reshape(-1)
    order = jnp.argsort(e_flat, stable=True)
    e_s, tok_s, g_s = e_flat[order], tok_flat[order], g_flat[order]
    counts = jnp.bincount(e_flat, length=N_EXPERTS)
    offs = jnp.cumsum(counts) - counts
    pcounts = ((counts + MOE_BLOCK - 1) // MOE_BLOCK) * MOE_BLOCK
    pend = jnp.cumsum(pcounts)
    poffs = pend - pcounts
    dest = poffs[e_s] + (jnp.arange(n_assign, dtype=jnp.int32) - offs[e_s])
    row_tok = jnp.full((n_blk * MOE_BLOCK,), t, jnp.int32).at[dest].set(tok_s)
    row_g = jnp.zeros((n_blk * MOE_BLOCK,), jnp.float32).at[dest].set(g_s)
    blk_exp = jnp.minimum(jnp.searchsorted(pend, jnp.arange(n_blk) * MOE_BLOCK, side='right'),
                          N_EXPERTS - 1).astype(jnp.int32)
    x_pad = jnp.concatenate([xn, jnp.zeros((1, d), xn.dtype)], axis=0)

    def body(acc, inp):
        toks, gs, e = inp
        xb = x_pad[toks].astype(jnp.float32)
        hid = xb @ w1[e].astype(jnp.float32) + b1[e].astype(jnp.float32)
        out = (clamped_swiglu(hid) @ w2[e].astype(jnp.float32) + b2[e].astype(jnp.float32)) * gs[:, None]
        return acc.at[toks].add(out), None

    acc0 = jnp.zeros((t + 1, d), jnp.float32)
    acc, _ = lax.scan(body, acc0, (row_tok.reshape(n_blk, MOE_BLOCK),
                                   row_g.reshape(n_blk, MOE_BLOCK), blk_exp))
    return h + acc[:t].reshape(bsz, seq, d).astype(h.dtype)


def setup_inputs(seed: int = 0) -> dict:
    key = jax.random.key(seed)
    ks = jax.random.split(key, 40)
    f32 = jnp.float32
    nrm = lambda i, shape, s: jax.random.normal(ks[i], shape, f32) * s
    L, G, P = DEPTH, S5_GROUPS, S5_STATE
    return {
        "x": nrm(0, (BATCH, SEQ, D_MODEL), 1.0),
        "norm1_g": 1.0 + nrm(1, (L, D_MODEL), 0.02),
        "w_in": nrm(2, (L, D_MODEL, IN_COLS), D_MODEL ** -0.5),
        "s5_lambda_re": -0.5 + nrm(3, (L, G, P), 0.01),
        "s5_lambda_im": math.pi * jnp.arange(P, dtype=f32) + nrm(4, (L, G, P), 0.01),
        "s5_log_dt": jax.random.uniform(ks[5], (L, G), f32, math.log(S5_DT_MIN), math.log(S5_DT_MAX)),
        "s5_b_re": nrm(6, (L, G, P, S5_GROUP), (2 * S5_GROUP) ** -0.5),
        "s5_b_im": nrm(7, (L, G, P, S5_GROUP), (2 * S5_GROUP) ** -0.5),
        "s5_c_re": nrm(8, (L, G, S5_GROUP, P), P ** -0.5),
        "s5_c_im": nrm(9, (L, G, S5_GROUP, P), P ** -0.5),
        "s5_d": nrm(10, (L, S5_WIDTH), 1.0),
        "s5_w_glu": nrm(11, (L, S5_WIDTH, 2 * D_MODEL), S5_WIDTH ** -0.5),
        "s5_b_glu": nrm(12, (L, 2 * D_MODEL), 0.01),
        "rw_mu": jax.random.uniform(ks[13], (L, RW_COLS), f32, 0.0, 1.0),
        "rw_w0": jax.random.uniform(ks[14], (L, RW_WIDTH), f32, -5.0, 1.0),
        "rw_w2": nrm(15, (L, DECAY_LORA, RW_WIDTH), 0.5 * DECAY_LORA ** -0.5),
        "rw_a0": nrm(16, (L, RW_WIDTH), 0.5),
        "rw_a2": nrm(17, (L, AAA_LORA, RW_WIDTH), 0.5 * AAA_LORA ** -0.5),
        "rw_g2": nrm(18, (L, GATE_LORA, RW_WIDTH), GATE_LORA ** -0.5),
        "rw_k_k": 0.85 + nrm(19, (L, RW_WIDTH), 0.05),
        "rw_k_a": 1.0 + nrm(20, (L, RW_WIDTH), 0.05),
        "rw_r_k": nrm(21, (L, RW_HEADS, RW_HEAD), 0.1),
        "rw_ln_g": 1.0 + nrm(22, (L, RW_WIDTH), 0.02),
        "rw_ln_b": nrm(23, (L, RW_WIDTH), 0.02),
        "rw_w_out": nrm(24, (L, RW_WIDTH, D_MODEL), RW_WIDTH ** -0.5),
        "w_out": nrm(25, (L, D_MODEL, D_MODEL), D_MODEL ** -0.5),
        "norm2_g": 1.0 + nrm(26, (L, D_MODEL), 0.02),
        "router_w": nrm(27, (L, D_MODEL, N_EXPERTS), D_MODEL ** -0.5),
        "router_b": nrm(28, (L, N_EXPERTS), 0.01),
        "moe_w1": nrm(29, (L, N_EXPERTS, D_MODEL, 2 * D_EXPERT), D_MODEL ** -0.5),
        "moe_b1": nrm(30, (L, N_EXPERTS, 2 * D_EXPERT), 0.01),
        "moe_w2": nrm(31, (L, N_EXPERTS, D_EXPERT, D_MODEL), D_EXPERT ** -0.5),
        "moe_b2": nrm(32, (L, N_EXPERTS, D_MODEL), 0.01),
        "norm_f_g": 1.0 + nrm(33, (D_MODEL,), 0.02),
    }


def reference(x, norm1_g, w_in, s5_lambda_re, s5_lambda_im, s5_log_dt, s5_b_re, s5_b_im,
              s5_c_re, s5_c_im, s5_d, s5_w_glu, s5_b_glu, rw_mu, rw_w0, rw_w2, rw_a0, rw_a2,
              rw_g2, rw_k_k, rw_k_a, rw_r_k, rw_ln_g, rw_ln_b, rw_w_out, w_out, norm2_g,
              router_w, router_b, moe_w1, moe_b1, moe_w2, moe_b2, norm_f_g):
    h = x
    for l in range(DEPTH):
        h = mixer_sublayer(h, norm1_g[l], w_in[l], s5_lambda_re[l], s5_lambda_im[l], s5_log_dt[l],
                           s5_b_re[l], s5_b_im[l], s5_c_re[l], s5_c_im[l], s5_d[l], s5_w_glu[l],
                           s5_b_glu[l], rw_mu[l], rw_w0[l], rw_w2[l], rw_a0[l], rw_a2[l], rw_g2[l],
                           rw_k_k[l], rw_k_a[l], rw_r_k[l], rw_ln_g[l], rw_ln_b[l], rw_w_out[l],
                           w_out[l])
        h = moe_sublayer(h, norm2_g[l], router_w[l], router_b[l], moe_w1[l], moe_b1[l],
                         moe_w2[l], moe_b2[l])
    return rmsnorm(h, norm_f_g)
```

```cpp
#include <hip/hip_runtime.h>
#include <stdint.h>
#include <stdio.h>

#ifndef N_LAUNCH_MODE
#define N_LAUNCH_MODE 1
#endif

#ifndef GEMM_SP2
#define GEMM_SP2 1
#endif
#ifndef GEMM_ALIGN
#define GEMM_ALIGN 1
#endif
#ifndef PROBE_MASK
#define PROBE_MASK 0u
#endif
#define LAS __attribute__((address_space(3)))
#define DI __device__ __forceinline__
typedef unsigned short bf16_t;
typedef short bf16x8 __attribute__((ext_vector_type(8)));
typedef float f32x4 __attribute__((ext_vector_type(4)));
typedef float f32x2 __attribute__((ext_vector_type(2)));
typedef unsigned u32x4 __attribute__((ext_vector_type(4)));
typedef unsigned u32x2 __attribute__((ext_vector_type(2)));
typedef int i32x8 __attribute__((ext_vector_type(8)));
typedef int i32x4 __attribute__((ext_vector_type(4)));

constexpr int T = 65536, D = 1024, SEQ = 4096, NB = 16;
constexpr int INC = 4352, RWC = 1792;
constexpr int S5L = 32;
constexpr int S5NC = SEQ / S5L;
constexpr int S5ROWS = T / S5L;
constexpr int LDU = 16 * S5L + 128;
constexpr int NE = 32, TOPK = 4;
constexpr int NPASS = 2, TPP = T / NPASS;
constexpr int MAXTILES = (TPP * TOPK) / 256 + NE;
constexpr int NWAVES = 8, NTHR = 512;

constexpr size_t al(size_t x) { return (x + 4095) & ~(size_t)4095; }
constexpr size_t WS_CTL = 0, CTL_BYTES = 1 << 20;
constexpr size_t WS_WIN = WS_CTL + CTL_BYTES;
constexpr size_t WS_WGLU = WS_WIN + al((size_t)INC * D * 2);
constexpr size_t WS_WO = WS_WGLU + al((size_t)2048 * 512 * 2);
constexpr size_t WS_WOUT = WS_WO + al((size_t)1024 * 512 * 2);
constexpr size_t WS_WLORA = WS_WOUT + al((size_t)1024 * 1024 * 2);
constexpr size_t WS_WR = WS_WLORA + al((size_t)1536 * 256 * 2);
constexpr size_t WS_TOEP = WS_WR + al((size_t)256 * 1024 * 2);
constexpr size_t WS_WST = WS_TOEP + al((size_t)32 * 512 * LDU * 2);
constexpr size_t WS_BGLU = WS_WST + al((size_t)32 * 256 * 512 * 2);
constexpr size_t WS_B1P = WS_BGLU + al(2048 * 4);
constexpr size_t WS_SHARED = WS_B1P + al((size_t)32 * 2048 * 4);
constexpr size_t WS_PRW = WS_SHARED;
constexpr size_t WS_LWAG = WS_PRW + al((size_t)T * RWC * 2);
constexpr size_t WS_YS = WS_LWAG + al((size_t)T * 1536 * 2);
constexpr size_t WS_YRW = WS_YS + al((size_t)T * 512 * 2);
constexpr size_t WS_BONUS = WS_YRW + al((size_t)T * 512 * 2);
constexpr size_t WS_XN = WS_BONUS + al((size_t)T * 8 * 4);
constexpr size_t WS_US5 = WS_XN + al((size_t)T * D * 2);
constexpr size_t WS_ALORA = WS_US5 + al((size_t)32 * S5ROWS * LDU * 2);
constexpr size_t WS_SLOC = WS_ALORA + al((size_t)T * 256 * 2);
constexpr int RW_NCH = 128 * 64;
constexpr size_t CHK_BYTES = (size_t)RW_NCH * 4096 * 2;
constexpr size_t WS_CHK_M = WS_XN, WS_CHK_N0T = WS_CHK_M + CHK_BYTES, WS_CHK_Q = WS_CHK_N0T + CHK_BYTES, WS_CHK_Y0T = WS_CHK_Q + CHK_BYTES, WS_CHK_HT = WS_CHK_Y0T + CHK_BYTES;
constexpr size_t WS_MIX_END0 = WS_SLOC + al((size_t)32 * S5ROWS * 128 * 4);
constexpr size_t WS_MIX_END = (WS_CHK_HT + CHK_BYTES) > WS_MIX_END0 ? (WS_CHK_HT + CHK_BYTES) : WS_MIX_END0;
constexpr size_t WS_HB = WS_SHARED;
constexpr size_t WS_W1 = WS_HB + al((size_t)T * D * 2);
constexpr size_t WS_W2 = WS_W1 + al((size_t)32 * 2048 * 1024);
constexpr size_t WS_RS = WS_W2 + al((size_t)32 * 1024 * 1024);
constexpr size_t WS_LOG = WS_RS + al((size_t)T * 4);
constexpr size_t WS_EPOS = WS_LOG + al((size_t)T * 32 * 4);
constexpr size_t WS_GATEV = WS_EPOS + al((size_t)T * 4 * 4);
constexpr size_t WS_SLOT = WS_GATEV + al((size_t)T * 4 * 4);
constexpr size_t WS_ROWG = WS_SLOT + al((size_t)T * 4 * 4);
constexpr size_t WS_ROWTOK = WS_ROWG + al((size_t)NPASS * MAXTILES * 256 * 4);
constexpr size_t WS_TILEE = WS_ROWTOK + al((size_t)NPASS * MAXTILES * 256 * 4);
constexpr int TE_STRIDE = MAXTILES + 64;
constexpr size_t WS_XS = WS_TILEE + al((size_t)NPASS * (MAXTILES + 64) * 4);
constexpr size_t PASS_BUF = al((size_t)MAXTILES * 256 * 1024);
constexpr size_t WS_ACT = WS_XS + NPASS * PASS_BUF;
constexpr size_t WS_XN2F8 = WS_ACT + NPASS * PASS_BUF;
constexpr size_t WS_MOE_END = WS_XN2F8 + al((size_t)T * D);
static_assert(WS_W2 + (size_t)32 * 1024 * 1024 <= WS_SHARED + (size_t)T * RWC * 2, "converted expert weights must stay inside the (dead) PRW buffer while the GLU/Wo/out GEMM phases run");
constexpr size_t WS_END = WS_MIX_END > WS_MOE_END ? WS_MIX_END : WS_MOE_END;
static_assert(WS_END <= ((size_t)1 << 30), "workspace over 1 GiB");

constexpr int CW_BAR = 0;
constexpr int CW_GCNT = 4096;

constexpr float F8_SX = 16.f, F8_SW = 32.f, F8_SA = 4.f, F8_SY = 32.f;
constexpr int LDS_BYTES = 144 * 1024;
constexpr int MISC_OFF = 140 * 1024;

typedef __bf16 bf16x2_t __attribute__((ext_vector_type(2)));
DI unsigned cvt_pk_bf16(float lo, float hi) { f32x2 v = {lo, hi}; bf16x2_t b = __builtin_convertvector(v, bf16x2_t); return __builtin_bit_cast(unsigned, b); }
DI unsigned pk4_fp8(float a, float b, float c, float d) {
    a = fminf(fmaxf(a, -448.f), 448.f); b = fminf(fmaxf(b, -448.f), 448.f); c = fminf(fmaxf(c, -448.f), 448.f); d = fminf(fmaxf(d, -448.f), 448.f);
    int w = __builtin_amdgcn_cvt_pk_fp8_f32(a, b, 0, false); w = __builtin_amdgcn_cvt_pk_fp8_f32(c, d, w, true); return (unsigned)w; }
DI float bf_lo(unsigned u) { return __uint_as_float(u << 16); }
DI float bf_hi(unsigned u) { return __uint_as_float(u & 0xffff0000u); }
DI float bf2f(bf16_t b) { return __uint_as_float(((unsigned)b) << 16); }
DI bf16_t f2bf(float f) { return (bf16_t)(cvt_pk_bf16(f, 0.f) & 0xffffu); }
DI float fsigmoid(float x) { return __builtin_amdgcn_rcpf(1.0f + __expf(-x)); }
DI float ftanh(float x) { float e = __expf(2.0f * x); return 1.0f - 2.0f * __builtin_amdgcn_rcpf(e + 1.0f); }
DI float fgelu_tanh(float x) { float u = 0.7978845608f * (x + 0.044715f * x * x * x); return x * fsigmoid(2.0f * u); }
DI f32x2 lo2(const f32x4& v) { return __builtin_shufflevector(v, v, 0, 1); }
DI f32x2 hi2(const f32x4& v) { return __builtin_shufflevector(v, v, 2, 3); }
DI f32x2 pk_sigmoid_scaled(f32x2 x, float negk) {
    const f32x2 t = x * negk; f32x2 e; e.x = __builtin_amdgcn_exp2f(t.x); e.y = __builtin_amdgcn_exp2f(t.y);
    const f32x2 d = e + 1.0f; f32x2 r; r.x = __builtin_amdgcn_rcpf(d.x); r.y = __builtin_amdgcn_rcpf(d.y); return r; }
DI f32x2 pk_sigmoid(f32x2 x) { return pk_sigmoid_scaled(x, -1.44269504f); }
DI f32x2 pk_gelu_tanh(f32x2 x) { const f32x2 x2 = x * x; const f32x2 u = x * (x2 * (0.044715f * 0.7978845608f) + 0.7978845608f); return x * pk_sigmoid_scaled(u, -2.0f * 1.44269504f); }
DI unsigned pk4_fp8_nc(f32x2 a, f32x2 b) { int w = __builtin_amdgcn_cvt_pk_fp8_f32(a.x, a.y, 0, false); w = __builtin_amdgcn_cvt_pk_fp8_f32(b.x, b.y, w, true); return (unsigned)w; }
#define DPP_ROR_ADD(v, n) ((v) + __builtin_bit_cast(float, __builtin_amdgcn_update_dpp(0, __builtin_bit_cast(int, (v)), 0x120 + (n), 0xf, 0xf, false)))
DI float row_sum16(float v) { v = DPP_ROR_ADD(v, 8); v = DPP_ROR_ADD(v, 4); v = DPP_ROR_ADD(v, 2); v = DPP_ROR_ADD(v, 1); return v; }
DI float xrow_sum(float x) {
    float y = x;
    asm("s_nop 1\n\tv_permlane16_swap_b32 %0, %1\n\ts_nop 1" : "+v"(x), "+v"(y));
    x = x + y; y = x;
    asm("s_nop 1\n\tv_permlane32_swap_b32 %0, %1\n\ts_nop 1" : "+v"(x), "+v"(y));
    return x + y;
}
DI float wave_sum(float v) { return xrow_sum(row_sum16(v)); }
DI float sum16(float v) {
    v += __shfl_xor(v, 1); v += __shfl_xor(v, 2); v += __shfl_xor(v, 4); v += __shfl_xor(v, 8); return v;
}

#define XB_TMO      128
#define XB_XCNT(j)  (256  + 64 * (j))
#define XB_XSUB(j)  (1280 + 64 * (j))
#define XB_XGEN(j)  (2304 + 64 * (j))
#define XB_TOP      3328
#define XB_TOPGEN   3392
#define XCD_BAR_WORDS 3456
#define XB_SPIN_CAP (1u << 22)
DI unsigned xb_ld(unsigned* p)              { return __hip_atomic_load(p, __ATOMIC_RELAXED, __HIP_MEMORY_SCOPE_AGENT); }
DI unsigned xb_add(unsigned* p, unsigned v) { return __hip_atomic_fetch_add(p, v, __ATOMIC_RELAXED, __HIP_MEMORY_SCOPE_AGENT); }
DI unsigned xb_xcc_id() { return (unsigned)__builtin_amdgcn_s_getreg((3 << 11) | 20) & 0xFu; }
#define XB_SPIN(cond, bar) do { unsigned _sp = 0; while (cond) { __builtin_amdgcn_s_sleep(1); \
    if ((++_sp & 255u) == 0u) { if (xb_ld(&(bar)[XB_TMO])) break; if (_sp > XB_SPIN_CAP) { atomicAdd(&(bar)[XB_TMO], 1u); break; } } } } while (0)
struct XcdBarrier { unsigned* bar; unsigned x; volatile LAS unsigned* st; };
DI XcdBarrier xcd_barrier_post(unsigned* bar, volatile LAS unsigned* st) {
    XcdBarrier b; b.bar = bar; b.x = xb_xcc_id(); b.st = st;
    if (threadIdx.x == 0) (void)xb_add(&bar[XB_XCNT(b.x)], 1u);
    return b;
}
DI void xcd_barrier_complete(unsigned* bar, unsigned x, unsigned& nloc, unsigned& nx) {
    const unsigned G = gridDim.x * gridDim.y * gridDim.z;
    unsigned sum, cnt, mine, sp = 0u;
    for (;;) {
        sum = 0u; cnt = 0u; mine = 0u;
#pragma unroll
        for (unsigned j = 0; j < 16; ++j) { const unsigned c = xb_ld(&bar[XB_XCNT(j)]); sum += c; cnt += (c > 0u) ? 1u : 0u; mine = (j == x) ? c : mine; }
        if (sum == G) break;
        __builtin_amdgcn_s_sleep(1);
        if ((++sp & 255u) == 0u) { if (xb_ld(&bar[XB_TMO])) break; if (sp > XB_SPIN_CAP) { atomicAdd(&bar[XB_TMO], 1u); break; } }
    }
    nloc = mine > 0u ? mine : 1u; nx = cnt > 0u ? cnt : 1u;
}
DI void xcd_barrier(const XcdBarrier& b) {
    asm volatile("s_waitcnt vmcnt(0)" ::: "memory");
    __syncthreads();
    if (threadIdx.x == 0) {
        unsigned* bar = b.bar;
        __builtin_amdgcn_s_waitcnt(0);
        unsigned nloc = b.st[0], nx = b.st[1];
        if (nloc == 0u) { xcd_barrier_complete(bar, b.x, nloc, nx); b.st[0] = nloc; b.st[1] = nx; }
        const unsigned old = xb_add(&bar[XB_XSUB(b.x)], 1u);
        const unsigned gen = old / nloc;
        if (old + 1u == (gen + 1u) * nloc) {
            __builtin_amdgcn_fence(__ATOMIC_RELEASE, "agent");
            asm volatile("s_waitcnt vmcnt(0)" ::: "memory");
            const unsigned og = xb_add(&bar[XB_TOP], 1u);
            const unsigned tg = og / nx;
            if (og + 1u == (tg + 1u) * nx) xb_add(&bar[XB_TOPGEN], 1u);
            else XB_SPIN(xb_ld(&bar[XB_TOPGEN]) == tg, bar);
            __builtin_amdgcn_fence(__ATOMIC_ACQUIRE, "agent");
            xb_add(&bar[XB_XGEN(b.x)], 1u);
            asm volatile("s_waitcnt vmcnt(0)" ::: "memory");
        } else {
            XB_SPIN(xb_ld(&bar[XB_XGEN(b.x)]) == gen, bar);
            __builtin_amdgcn_fence(__ATOMIC_ACQUIRE, "agent");
            asm volatile("s_waitcnt vmcnt(0)" ::: "memory");
        }
    }
    __syncthreads();
}

constexpr int BM = 256, BK = 64, HALF = 128, HTB = HALF * BK * 2;
DI int lds_byte(int r, int c) { const int st = (r >> 4) * 2 + (c >> 5), rr = r & 15, cc = c & 31, ob = rr * 64 + cc * 2; return st * 1024 + (ob ^ (((ob >> 9) & 1) << 5)); }
DI void stage_rc(int b, int& R, int& C) { const int st = b / 1024, sb = b % 1024, swz = sb ^ (((sb >> 9) & 1) << 5); R = (st >> 1) * 16 + swz / 64; C = (st & 1) * 32 + (swz % 64) / 2; }
DI int perm32(int rho) { const int n = rho >> 4, i = rho & 15; return 8 * (i >> 2) + 4 * n + (i & 3); }
struct Unit { int pm, pn, aux; };

template <class Sched, class Epi>
DI void gemm_phase(LAS unsigned char* lds, const Sched& S, const Epi& E) {
    const int tid = threadIdx.x, wid = __builtin_amdgcn_readfirstlane(tid >> 6), lane = tid & 63, wr = wid >> 2, wc = wid & 3, fr = lane & 15, fq = lane >> 4;
    const int K = S.K, nt = K / BK;
    unsigned voffA[2], voffB[2];
#pragma unroll
    for (int i = 0; i < 2; ++i) { int R, C; stage_rc(tid * 16 + i * 8192, R, C); const int Rb = Epi::PERM ? ((R & ~31) + perm32(R & 31)) : R;
        voffA[i] = (unsigned)(R * S.lda + C) * 2u; voffB[i] = (unsigned)(Rb * S.ldb + C) * 2u; }
    const size_t kstep = (size_t)(BK * 2);
    const size_t hstepA = (size_t)HALF * S.lda * 2, hstepB = (size_t)HALF * S.ldb * 2;
    const unsigned ldsw = (unsigned)wid * 1024u;
    const int aoff = lds_byte(wr * 64 + fr, fq * 8), boff = lds_byte(wc * 32 + fr, fq * 8);
#define PG8_SA(b, h) (((b) * 2 + (h)) * HTB)
#define PG8_SB(b, h) ((4 + (b) * 2 + (h)) * HTB)
    const unsigned ldsbase = (unsigned)(size_t)lds;
#define PG8_STAGE(bufoff, gbase, voff) do { _Pragma("unroll") for (int _i = 0; _i < 2; ++_i) \
        asm volatile("s_mov_b32 m0, %0\n\ts_nop 0\n\tglobal_load_lds_dwordx4 %1, %2" :: "s"(ldsbase + (unsigned)(bufoff) + ldsw + (unsigned)(_i * 8192)), "v"((voff)[_i]), "s"((const char*)(gbase)) : "memory"); } while (0)
#define PG8_LDA(dst, b, h) do { _Pragma("unroll") for (int m = 0; m < 4; ++m) _Pragma("unroll") for (int k = 0; k < 2; ++k) dst[m][k] = *(const LAS bf16x8*)(lds + PG8_SA(b, h) + aoff + m * 2048 + k * 1024); } while (0)
#define PG8_LDB(dst, b, h) do { _Pragma("unroll") for (int n = 0; n < 2; ++n) _Pragma("unroll") for (int k = 0; k < 2; ++k) dst[n][k] = *(const LAS bf16x8*)(lds + PG8_SB(b, h) + boff + n * 2048 + k * 1024); } while (0)
#define PG8_MMA(ai, bj, At, Bt) do { __builtin_amdgcn_s_setprio(1); _Pragma("unroll") for (int m = 0; m < 4; ++m) _Pragma("unroll") for (int n = 0; n < 2; ++n) _Pragma("unroll") for (int k = 0; k < 2; ++k) \
        acc[ai][bj][m][n] = __builtin_amdgcn_mfma_f32_16x16x32_bf16(Bt[n][k], At[m][k], acc[ai][bj][m][n], 0, 0, 0); __builtin_amdgcn_s_setprio(0); } while (0)
#define PG8_WAIT_V(n) asm volatile("s_waitcnt vmcnt(" #n ")" ::: "memory")
#define PG8_WAIT_L(n) asm volatile("s_waitcnt lgkmcnt(" #n ")" ::: "memory")
#define PG8_BAR __builtin_amdgcn_s_barrier()
#define PG8_SCHED __builtin_amdgcn_sched_barrier(0)
    Unit cur, nxt; int ui = 0;
    if (!S.next(0, cur)) return;
    f32x4 acc[2][2][4][2];
#pragma unroll
    for (int a = 0; a < 2; ++a)
#pragma unroll
        for (int b = 0; b < 2; ++b)
#pragma unroll
            for (int m = 0; m < 4; ++m)
#pragma unroll
                for (int n = 0; n < 2; ++n) { if constexpr (Sched::FP8) { f32x2 z0_, z1_; asm volatile("v_pk_mov_b32 %0, 0, 0" : "=v"(z0_)); asm volatile("v_pk_mov_b32 %0, 0, 0" : "=v"(z1_)); acc[a][b][m][n] = (f32x4){z0_.x, z0_.y, z1_.x, z1_.y}; } else acc[a][b][m][n] = (f32x4){0.f, 0.f, 0.f, 0.f}; }
    bf16x8 At[4][2], B0[2][2], B1[2][2];
    i32x8 At8[4], B08[2], B18[2];
    const int aoff8a = lds_byte(wr * 64 + fr, 16 * fq) & ~16, boff8a = lds_byte(wc * 32 + fr, 16 * fq) & ~16;
#define PG8_LDA8(dst, b, h) do { _Pragma("unroll") for (int m = 0; m < 4; ++m) dst[m] = *(const LAS i32x8*)(lds + PG8_SA(b, h) + aoff8a + m * 2048); } while (0)
#define PG8_LDB8(dst, b, h) do { _Pragma("unroll") for (int n = 0; n < 2; ++n) dst[n] = *(const LAS i32x8*)(lds + PG8_SB(b, h) + boff8a + n * 2048); } while (0)
#define PG8_MMA8(ai, bj, At_, Bt_) do { __builtin_amdgcn_s_setprio(1); _Pragma("unroll") for (int m = 0; m < 4; ++m) _Pragma("unroll") for (int n = 0; n < 2; ++n) \
        acc[ai][bj][m][n] = __builtin_amdgcn_mfma_scale_f32_16x16x128_f8f6f4(Bt_[n], At_[m], acc[ai][bj][m][n], 0, 0, 0, 0x7f7f7f7f, 0, 0x7f7f7f7f); __builtin_amdgcn_s_setprio(0); } while (0)
#define XLDA(b, h) do { if constexpr (Sched::FP8) PG8_LDA8(At8, b, h); else PG8_LDA(At, b, h); } while (0)
#define XLDB0(b, h) do { if constexpr (Sched::FP8) PG8_LDB8(B08, b, h); else PG8_LDB(B0, b, h); } while (0)
#define XLDB1(b, h) do { if constexpr (Sched::FP8) PG8_LDB8(B18, b, h); else PG8_LDB(B1, b, h); } while (0)
#define XMMA0(ai, bj) do { if constexpr (Sched::FP8) PG8_MMA8(ai, bj, At8, B08); else PG8_MMA(ai, bj, At, B0); } while (0)
#define XMMA1(ai, bj) do { if constexpr (Sched::FP8) PG8_MMA8(ai, bj, At8, B18); else PG8_MMA(ai, bj, At, B1); } while (0)
    const char* cA = S.a_ptr(cur); const char* cB = S.b_ptr(cur);
    unsigned offA[2][2], offN[2][2];
    if constexpr (Sched::GATHER) {
#pragma unroll
        for (int h = 0; h < 2; ++h)
#pragma unroll
            for (int i = 0; i < 2; ++i) { int R, C; stage_rc(tid * 16 + i * 8192, R, C); offA[h][i] = S.a_rowoff(cur, h * HALF + R) + (unsigned)C * 2u; offN[h][i] = offA[h][i]; }
    }
#define A_STG(bufoff, plainptr, kt, h, nx) do { if constexpr (Sched::GATHER) { PG8_STAGE(bufoff, cA + (size_t)(kt) * kstep, offA[h]); } \
        else PG8_STAGE(bufoff, plainptr, voffA); } while (0)
    if constexpr (GEMM_SP2) {
        PG8_STAGE(PG8_SB(0, 0), cB, voffB); PG8_STAGE(PG8_SB(0, 1), cB + hstepB, voffB); A_STG(PG8_SA(0, 0), cA, 0, 0, false); A_STG(PG8_SA(0, 1), cA + hstepA, 0, 1, false);
        if (wr == 1) PG8_BAR;
        PG8_WAIT_V(2); PG8_BAR;
        PG8_STAGE(PG8_SB(1, 0), cB + kstep, voffB); A_STG(PG8_SA(1, 0), cA + kstep, 1, 0, false); PG8_STAGE(PG8_SB(1, 1), cB + hstepB + kstep, voffB);
        PG8_WAIT_V(6); PG8_BAR;
    } else {
    PG8_STAGE(PG8_SB(0, 0), cB, voffB); A_STG(PG8_SA(0, 0), cA, 0, 0, false); PG8_STAGE(PG8_SB(0, 1), cB + hstepB, voffB); A_STG(PG8_SA(0, 1), cA + hstepA, 0, 1, false);
    if (wr == 1) PG8_BAR;
    PG8_WAIT_V(4); PG8_BAR;
    PG8_STAGE(PG8_SB(1, 0), cB + kstep, voffB); A_STG(PG8_SA(1, 0), cA + kstep, 1, 0, false); PG8_STAGE(PG8_SB(1, 1), cB + hstepB + kstep, voffB);
    PG8_WAIT_V(6); PG8_BAR;
    }
    for (;;) {
        const bool has_next = S.next(ui + 1, nxt);
        const char* nA = has_next ? S.a_ptr(nxt) : cA; const char* nB = has_next ? S.b_ptr(nxt) : cB;
        for (int t = 0; t < nt; t += 2) {
            const bool last = (t == nt - 2);
            const char* a1 = cA + (size_t)(t + 1) * kstep;
            const char* a2 = last ? nA : cA + (size_t)(t + 2) * kstep; const char* b2 = last ? nB : cB + (size_t)(t + 2) * kstep;
            const char* a3 = a2 + kstep; const char* b3 = b2 + kstep;
            const int k2 = last ? 0 : t + 2, k3 = k2 + 1;
            if constexpr (GEMM_SP2) {
            XLDB0(0, 0); XLDB1(0, 1); PG8_SCHED; XLDA(0, 0); A_STG(PG8_SA(1, 1), a1 + hstepA, t + 1, 1, false);
            if constexpr (Sched::GATHER) {
                if (has_next && (t == nt - 4 || nt < 4)) {
#pragma unroll
                    for (int h = 0; h < 2; ++h)
#pragma unroll
                        for (int i = 0; i < 2; ++i) { int R, C; stage_rc(tid * 16 + i * 8192, R, C); offN[h][i] = S.a_rowoff(nxt, h * HALF + R) + (unsigned)C * 2u; } }
                if (last && has_next) { offA[0][0] = offN[0][0]; offA[0][1] = offN[0][1]; offA[1][0] = offN[1][0]; offA[1][1] = offN[1][1]; }
            }
            PG8_WAIT_V(8); PG8_WAIT_L(0); PG8_BAR; XMMA0(0, 0); XMMA1(0, 1); PG8_BAR; PG8_SCHED;
            XLDA(0, 1); PG8_STAGE(PG8_SB(0, 0), b2, voffB); PG8_STAGE(PG8_SB(0, 1), b2 + hstepB, voffB); A_STG(PG8_SA(0, 0), a2, k2, 0, last);
            PG8_WAIT_V(8); PG8_WAIT_L(0); PG8_BAR; XMMA0(1, 0); XMMA1(1, 1); PG8_BAR; PG8_SCHED;
            XLDB0(1, 0); XLDB1(1, 1); PG8_SCHED; XLDA(1, 0); A_STG(PG8_SA(0, 1), a2 + hstepA, k2, 1, last);
            PG8_WAIT_V(8); PG8_WAIT_L(0); PG8_BAR; XMMA0(0, 0); XMMA1(0, 1); PG8_BAR; PG8_SCHED;
            XLDA(1, 1); PG8_STAGE(PG8_SB(1, 0), b3, voffB); PG8_STAGE(PG8_SB(1, 1), b3 + hstepB, voffB); A_STG(PG8_SA(1, 0), a3, k3, 0, last);
            PG8_WAIT_V(8); PG8_WAIT_L(0); PG8_BAR; XMMA0(1, 0); XMMA1(1, 1); PG8_BAR; PG8_SCHED;
            } else {
            XLDB0(0, 0); PG8_SCHED; XLDA(0, 0); A_STG(PG8_SA(1, 1), a1 + hstepA, t + 1, 1, false);
            if constexpr (Sched::GATHER) {
                if (has_next && (t == nt - 4 || nt < 4)) {
#pragma unroll
                    for (int h = 0; h < 2; ++h)
#pragma unroll
                        for (int i = 0; i < 2; ++i) { int R, C; stage_rc(tid * 16 + i * 8192, R, C); offN[h][i] = S.a_rowoff(nxt, h * HALF + R) + (unsigned)C * 2u; } }
                if (last && has_next) { offA[0][0] = offN[0][0]; offA[0][1] = offN[0][1]; offA[1][0] = offN[1][0]; offA[1][1] = offN[1][1]; }
            }
            PG8_WAIT_L(8); PG8_BAR; PG8_WAIT_L(0); XMMA0(0, 0); PG8_BAR; PG8_SCHED;
            XLDB1(0, 1); PG8_STAGE(PG8_SB(0, 0), b2, voffB);
            PG8_BAR; PG8_WAIT_L(0); XMMA1(0, 1); PG8_BAR;
            XLDA(0, 1); A_STG(PG8_SA(0, 0), a2, k2, 0, last);
            PG8_BAR; PG8_WAIT_L(0); XMMA0(1, 0); PG8_BAR; PG8_SCHED;
            PG8_STAGE(PG8_SB(0, 1), b2 + hstepB, voffB);
            PG8_WAIT_V(6); PG8_BAR; XMMA1(1, 1); PG8_BAR;
            XLDB0(1, 0); PG8_SCHED; XLDA(1, 0); A_STG(PG8_SA(0, 1), a2 + hstepA, k2, 1, last);
            PG8_WAIT_L(8); PG8_BAR; PG8_WAIT_L(0); XMMA0(0, 0); PG8_BAR; PG8_SCHED;
            XLDB1(1, 1); PG8_STAGE(PG8_SB(1, 0), b3, voffB);
            PG8_BAR; PG8_WAIT_L(0); XMMA1(0, 1); PG8_BAR;
            XLDA(1, 1); A_STG(PG8_SA(1, 0), a3, k3, 0, last);
            PG8_BAR; PG8_WAIT_L(0); XMMA0(1, 0); PG8_BAR; PG8_SCHED;
            PG8_STAGE(PG8_SB(1, 1), b3 + hstepB, voffB);
            PG8_WAIT_V(6); PG8_BAR; XMMA1(1, 1); PG8_BAR;
            }
        }
        if constexpr (GEMM_ALIGN) { if (wr == 0) PG8_BAR; }
        {
            int tz = threadIdx.x; asm volatile("" : "+v"(tz));
            const int wid2 = tz >> 6, lane2 = tz & 63;
            E(acc, cur, wid2 >> 2, wid2 & 3, lane2 & 15, lane2 >> 4); }
        if (!has_next) break;
#pragma unroll
        for (int a = 0; a < 2; ++a)
#pragma unroll
            for (int b = 0; b < 2; ++b)
#pragma unroll
                for (int m = 0; m < 4; ++m)
#pragma unroll
                    for (int n = 0; n < 2; ++n) { if constexpr (Sched::FP8) { f32x2 z0_, z1_; asm volatile("v_pk_mov_b32 %0, 0, 0" : "=v"(z0_)); asm volatile("v_pk_mov_b32 %0, 0, 0" : "=v"(z1_)); acc[a][b][m][n] = (f32x4){z0_.x, z0_.y, z1_.x, z1_.y}; } else acc[a][b][m][n] = (f32x4){0.f, 0.f, 0.f, 0.f}; }
        cur = nxt; cA = nA; cB = nB; ++ui;
        if constexpr (GEMM_ALIGN) { if (wr == 1) PG8_BAR; }
    }
    PG8_WAIT_V(0);
    if constexpr (!GEMM_ALIGN) { if (wr == 0) PG8_BAR; }
    PG8_BAR;
#undef XLDA
#undef XLDB0
#undef XLDB1
#undef XMMA0
#undef XMMA1
#undef PG8_LDA8
#undef PG8_LDB8
#undef PG8_MMA8
#undef A_STG
#undef PG8_SA
#undef PG8_SB
#undef PG8_STAGE
#undef PG8_LDA
#undef PG8_LDB
#undef PG8_MMA
#undef PG8_WAIT_V
#undef PG8_WAIT_L
#undef PG8_BAR
#undef PG8_SCHED
}

struct PlainSched {
    static constexpr bool GATHER = false, FP8 = false;
    const char* A; const char* B; int K, lda, ldb, nM, nN, nwg, G, c; int akoff_pn = 1 << 30, akoff_bytes = 0;
    DI void init(const void* A_, const void* B_, int M, int N, int K_, int lda_, int ldb_, int G_, int c_) { A = (const char*)A_; B = (const char*)B_; K = K_; lda = lda_; ldb = ldb_; nM = M / BM; nN = N / BM; nwg = nM * nN; G = G_; c = c_; }
    DI bool next(int i, Unit& u) const {
        const long L = (long)i * G + c; if (L >= nwg) return false;
        int wgid = (int)L; { const int q = nwg / 8, r = nwg % 8, xcd = wgid % 8, off = wgid / 8; wgid = (xcd < r ? xcd * (q + 1) : r * (q + 1) + (xcd - r) * q) + off; }
        const int nig = 8 * nN, gid = wgid / nig, fm = gid * 8, gsz = (nM - fm) < 8 ? (nM - fm) : 8;
        u.pm = fm + ((wgid % nig) % gsz); u.pn = (wgid % nig) / gsz; u.aux = 0; return true;
    }
    DI const char* a_ptr(const Unit& u) const { return A + (size_t)u.pm * BM * lda * 2 + (u.pn >= akoff_pn ? akoff_bytes : 0); }
    DI const char* b_ptr(const Unit& u) const { return B + (size_t)u.pn * BM * ldb * 2; }
};
struct GroupSched {
    static constexpr bool GATHER = false, FP8 = false;
    const char* A; const char* B; int K, lda, ldb, nMg, nN, nwg, G, c;
    DI void init(const void* A_, const void* B_, int K_, int lda_, int ldb_, int nMg_, int nN_, int G_, int c_) { A = (const char*)A_; B = (const char*)B_; K = K_; lda = lda_; ldb = ldb_; nMg = nMg_; nN = nN_; nwg = 32 * nMg * nN; G = G_; c = c_; }
    DI bool next(int i, Unit& u) const {
        const int L = i * G + c; if (L >= nwg) return false;
        const int per = nMg * nN, g = L / per, rem = L % per; u.pm = g * nMg + rem / nN; u.pn = rem % nN; u.aux = g; return true;
    }
    DI const char* a_ptr(const Unit& u) const { return A + (size_t)u.pm * BM * lda * 2; }
    DI const char* b_ptr(const Unit& u) const { return B + ((size_t)u.aux * nN + u.pn) * BM * ldb * 2; }
};
template <bool GATH>
struct MoeSched {
    static constexpr bool GATHER = GATH, FP8 = true;
    const char* A; const char* B; const int* tile_e; const int* rowtok; int K, lda, ldb, nN, NperE, nwg, G, c;
    DI void init(const void* A_, const void* B_, const int* te, const int* rt, int ntiles, int K_, int nN_, int G_, int c_) { A = (const char*)A_; B = (const char*)B_; tile_e = te; rowtok = rt; K = K_; lda = K_; ldb = K_; nN = nN_; NperE = nN_ * BM; nwg = ntiles * nN_; G = G_; c = c_; }
    DI bool next(int i, Unit& u) const {
        int L = i * G + c; if (L >= nwg) return false;
        if (G == 256 && (i + 1) * G <= nwg) { const int x = c & 7, sl = c >> 3, mt = G / nN / 8;
            L = i * G + (x * mt + sl / nN) * nN + (sl % nN); }
        u.pm = L / nN; u.pn = L % nN; u.aux = __builtin_amdgcn_readfirstlane(__hip_atomic_load(tile_e + u.pm, __ATOMIC_RELAXED, __HIP_MEMORY_SCOPE_AGENT)); return true;
    }
    DI const char* a_ptr(const Unit& u) const { return GATH ? A : A + (size_t)u.pm * BM * lda * 2; }
    DI unsigned a_rowoff(const Unit& u, int row) const { return (unsigned)__hip_atomic_load(rowtok + u.pm * BM + row, __ATOMIC_RELAXED, __HIP_MEMORY_SCOPE_AGENT) * (unsigned)(lda * 2); }
    DI const char* b_ptr(const Unit& u) const { return B + ((size_t)u.aux * NperE + (size_t)u.pn * BM) * ldb * 2; }
};

typedef f32x4 AccT[2][2][4][2];
struct EpiWin {
    static constexpr bool PERM = true;
    bf16_t* us5; bf16_t* prw; bf16_t* gates;
    DI static u32x4 pack8(const f32x4& v0, const f32x4& v1) { u32x4 w; w.x = cvt_pk_bf16(v0[0], v0[1]); w.y = cvt_pk_bf16(v0[2], v0[3]); w.z = cvt_pk_bf16(v1[0], v1[1]); w.w = cvt_pk_bf16(v1[2], v1[3]); return w; }
    DI void operator()(const AccT& acc, const Unit& u, int wr, int wc, int fr, int fq) const {
        if (u.pn < 2) {
#pragma unroll
            for (int ai = 0; ai < 2; ++ai)
#pragma unroll
                for (int m = 0; m < 4; ++m) { const int r = u.pm * BM + ai * HALF + wr * 64 + m * 16 + fr, b = r >> 12, sq = r & 4095, ch = sq / S5L, j = sq % S5L;
#pragma unroll
                    for (int bj = 0; bj < 2; ++bj) { const int c0 = u.pn * BM + bj * HALF + wc * 32 + 8 * fq, g = c0 >> 4, ci = c0 & 15;
                        *(u32x4*)(us5 + ((size_t)(g * S5ROWS + b * S5NC + ch) * LDU + j * 16 + ci)) = pack8(acc[ai][bj][m][0], acc[ai][bj][m][1]); } }
        } else if (u.pn < 9) {
#pragma unroll
            for (int ai = 0; ai < 2; ++ai)
#pragma unroll
                for (int m = 0; m < 4; ++m) { const int r = u.pm * BM + ai * HALF + wr * 64 + m * 16 + fr;
#pragma unroll
                    for (int bj = 0; bj < 2; ++bj) { const int c0 = u.pn * BM + bj * HALF + wc * 32 + 8 * fq;
                        *(u32x4*)(prw + (size_t)r * RWC + (c0 - 512)) = pack8(acc[ai][bj][m][0], acc[ai][bj][m][1]); } }
        } else {
#pragma unroll
            for (int ai = 0; ai < 2; ++ai)
#pragma unroll
                for (int m = 0; m < 4; ++m) { const int r = u.pm * BM + ai * HALF + wr * 64 + m * 16 + fr;
#pragma unroll
                    for (int bj = 0; bj < 2; ++bj) { const int c0 = u.pn * BM + bj * HALF + wc * 32 + 8 * fq;
                        const f32x4& v0 = acc[ai][bj][m][0]; const f32x4& v1 = acc[ai][bj][m][1];
                        const f32x2 a_ = pk_sigmoid(lo2(v0)), b_ = pk_sigmoid(hi2(v0)), c_ = pk_sigmoid(lo2(v1)), d_ = pk_sigmoid(hi2(v1));
                        u32x4 w; w.x = cvt_pk_bf16(a_.x, a_.y); w.y = cvt_pk_bf16(b_.x, b_.y); w.z = cvt_pk_bf16(c_.x, c_.y); w.w = cvt_pk_bf16(d_.x, d_.y);
                        *(u32x4*)(gates + (size_t)r * 2048 + (c0 - 2304)) = w; } }
        }
    }
};
struct EpiS5State {
    static constexpr bool PERM = false;
    float* sloc;
    DI void operator()(const AccT& acc, const Unit& u, int wr, int wc, int fr, int fq) const {
#pragma unroll
        for (int ai = 0; ai < 2; ++ai)
#pragma unroll
            for (int m = 0; m < 4; ++m) {
                const int r = u.pm * BM + ai * HALF + wr * 64 + m * 16 + fr;
#pragma unroll
                for (int n = 0; n < 2; ++n) *(f32x4*)(sloc + (size_t)r * 128 + wc * 32 + 16 * n + 4 * fq) = acc[ai][0][m][n];
            }
    }
};
struct EpiS5Out {
    static constexpr bool PERM = true;
    bf16_t* ys;
    DI void operator()(const AccT& acc, const Unit& u, int wr, int wc, int fr, int fq) const {
        const int g = u.aux;
#pragma unroll
        for (int ai = 0; ai < 2; ++ai)
#pragma unroll
            for (int m = 0; m < 4; ++m) {
                const int r = u.pm * BM + ai * HALF + wr * 64 + m * 16 + fr;
                const int rc = r - g * S5ROWS;
#pragma unroll
                for (int bj = 0; bj < 2; ++bj) {
                    const int c0 = u.pn * BM + bj * HALF + wc * 32 + 8 * fq;
                    const int t = c0 >> 4, co = c0 & 15;
                    const size_t tok = (size_t)rc * S5L + t;
                    f32x4 v0 = acc[ai][bj][m][0], v1 = acc[ai][bj][m][1];
                    { const f32x2 a_ = pk_gelu_tanh(lo2(v0)), b_ = pk_gelu_tanh(hi2(v0)), c_ = pk_gelu_tanh(lo2(v1)), d_ = pk_gelu_tanh(hi2(v1));
                      v0 = (f32x4){a_.x, a_.y, b_.x, b_.y}; v1 = (f32x4){c_.x, c_.y, d_.x, d_.y}; }
                    u32x4 w; w.x = cvt_pk_bf16(v0[0], v0[1]); w.y = cvt_pk_bf16(v0[2], v0[3]); w.z = cvt_pk_bf16(v1[0], v1[1]); w.w = cvt_pk_bf16(v1[2], v1[3]);
                    *(u32x4*)(ys + tok * 512 + g * 16 + co) = w;
                }
            }
    }
};
struct EpiLora {
    static constexpr bool PERM = true;
    bf16_t* lwag; const float* w0; const float* a0;
    DI void operator()(const AccT& acc, const Unit& u, int wr, int wc, int fr, int fq) const {
#pragma unroll
        for (int bj = 0; bj < 2; ++bj) {
            const int c0 = u.pn * BM + bj * HALF + wc * 32 + 8 * fq;
            f32x4 b0 = (f32x4){0.f, 0.f, 0.f, 0.f}, b1 = b0;
            if (c0 < 512) { b0 = *(const f32x4*)(w0 + c0); b1 = *(const f32x4*)(w0 + c0 + 4); } else if (c0 < 1024) { b0 = *(const f32x4*)(a0 + c0 - 512); b1 = *(const f32x4*)(a0 + c0 - 508); }
            const f32x2 bias[4] = {lo2(b0), hi2(b0), lo2(b1), hi2(b1)};
            const float osc = (c0 < 512) ? -0.6065306597f : 1.0f;
            if (c0 < 1024) {
#pragma unroll
                for (int ai = 0; ai < 2; ++ai)
#pragma unroll
                    for (int m = 0; m < 4; ++m) { const int r = u.pm * BM + ai * HALF + wr * 64 + m * 16 + fr; u32x4 w;
#pragma unroll
                        for (int jp = 0; jp < 4; ++jp) { const f32x4& a = acc[ai][bj][m][jp >> 1]; const f32x2 v = pk_sigmoid(((jp & 1) ? hi2(a) : lo2(a)) + bias[jp]) * osc; w[jp] = cvt_pk_bf16(v.x, v.y); }
                        *(u32x4*)(lwag + (size_t)r * 1536 + c0) = w; }
            } else {
#pragma unroll
                for (int ai = 0; ai < 2; ++ai)
#pragma unroll
                    for (int m = 0; m < 4; ++m) { const int r = u.pm * BM + ai * HALF + wr * 64 + m * 16 + fr; u32x4 w;
#pragma unroll
                        for (int jp = 0; jp < 4; ++jp) { const f32x4& a = acc[ai][bj][m][jp >> 1]; const f32x2 v = (jp & 1) ? hi2(a) : lo2(a); w[jp] = cvt_pk_bf16(v.x, v.y); }
                        *(u32x4*)(lwag + (size_t)r * 1536 + c0) = w; }
            }
        }
    }
};
struct EpiGlu {
    static constexpr bool PERM = true;
    bf16_t* mixed; const bf16_t* gates; const float* bglu;
    DI void operator()(const AccT& acc, const Unit& u, int wr, int wc, int fr, int fq) const {
        const int cw = wc * 32 + 8 * fq, j0 = u.pn * 128 + cw;
        const float* bp = bglu + u.pn * 256 + cw;
        const f32x4 ba0 = *(const f32x4*)bp, ba1 = *(const f32x4*)(bp + 4), bb0 = *(const f32x4*)(bp + 128), bb1 = *(const f32x4*)(bp + 132);
        const f32x2 ba[4] = {lo2(ba0), hi2(ba0), lo2(ba1), hi2(ba1)}, bb[4] = {lo2(bb0), hi2(bb0), lo2(bb1), hi2(bb1)};
        u32x4 gw[2][4];
#pragma unroll
        for (int ai = 0; ai < 2; ++ai)
#pragma unroll
            for (int m = 0; m < 4; ++m) gw[ai][m] = *(const u32x4*)(gates + (size_t)(u.pm * BM + ai * HALF + wr * 64 + m * 16 + fr) * 2048 + j0);
#pragma unroll
        for (int ai = 0; ai < 2; ++ai)
#pragma unroll
            for (int m = 0; m < 4; ++m) {
                const int r = u.pm * BM + ai * HALF + wr * 64 + m * 16 + fr;
                u32x4 w;
#pragma unroll
                for (int jp = 0; jp < 4; ++jp) {
                    const f32x4& aa = acc[ai][0][m][jp >> 1]; const f32x4& ab = acc[ai][1][m][jp >> 1];
                    const f32x2 za = ((jp & 1) ? hi2(aa) : lo2(aa)) + ba[jp], zb = ((jp & 1) ? hi2(ab) : lo2(ab)) + bb[jp];
                    const unsigned gwd = gw[ai][m][jp]; const f32x2 gt = {bf_lo(gwd), bf_hi(gwd)};
                    const f32x2 o = (gt * za) * pk_sigmoid(zb);
                    w[jp] = cvt_pk_bf16(o.x, o.y);
                }
                *(u32x4*)(mixed + (size_t)r * 1024 + j0) = w;
            }
    }
};
struct EpiWo {
    static constexpr bool PERM = true;
    bf16_t* mixed; const bf16_t* gates;
    DI void operator()(const AccT& acc, const Unit& u, int wr, int wc, int fr, int fq) const {
#pragma unroll
        for (int ai = 0; ai < 2; ++ai) {
            u32x4 gw[4][2], mw[4][2];
#pragma unroll
            for (int m = 0; m < 4; ++m)
#pragma unroll
                for (int bj = 0; bj < 2; ++bj) { const size_t r = (size_t)(u.pm * BM + ai * HALF + wr * 64 + m * 16 + fr); const int c0 = u.pn * BM + bj * HALF + wc * 32 + 8 * fq;
                    gw[m][bj] = *(const u32x4*)(gates + r * 2048 + 1024 + c0); mw[m][bj] = *(const u32x4*)(mixed + r * 1024 + c0); }
#pragma unroll
            for (int m = 0; m < 4; ++m)
#pragma unroll
                for (int bj = 0; bj < 2; ++bj) { const size_t r = (size_t)(u.pm * BM + ai * HALF + wr * 64 + m * 16 + fr); const int c0 = u.pn * BM + bj * HALF + wc * 32 + 8 * fq;
                    u32x4 w;
#pragma unroll
                    for (int jp = 0; jp < 4; ++jp) { const unsigned gwd = gw[m][bj][jp], mwd = mw[m][bj][jp]; const f32x4& a = acc[ai][bj][m][jp >> 1];
                        const f32x2 o = (f32x2){bf_lo(mwd), bf_hi(mwd)} + (f32x2){bf_lo(gwd), bf_hi(gwd)} * ((jp & 1) ? hi2(a) : lo2(a));
                        w[jp] = cvt_pk_bf16(o.x, o.y); }
                    *(u32x4*)(mixed + r * 1024 + c0) = w; }
        }
    }
};
struct EpiOut {
    static constexpr bool PERM = true;
    bf16_t* hb; const float* x;
    DI void operator()(const AccT& acc, const Unit& u, int wr, int wc, int fr, int fq) const {
#pragma unroll
        for (int ai = 0; ai < 2; ++ai) {
            f32x4 xv[4][2][2];
#pragma unroll
            for (int m = 0; m < 4; ++m) { const size_t r = (size_t)(u.pm * BM + ai * HALF + wr * 64 + m * 16 + fr);
#pragma unroll
                for (int bj = 0; bj < 2; ++bj) { const float* xp = x + r * 1024 + u.pn * BM + bj * HALF + wc * 32 + 8 * fq; xv[m][bj][0] = *(const f32x4*)xp; xv[m][bj][1] = *(const f32x4*)(xp + 4); } }
#pragma unroll
            for (int m = 0; m < 4; ++m) { const size_t r = (size_t)(u.pm * BM + ai * HALF + wr * 64 + m * 16 + fr);
#pragma unroll
                for (int bj = 0; bj < 2; ++bj) { const f32x4 v0 = xv[m][bj][0] + acc[ai][bj][m][0], v1 = xv[m][bj][1] + acc[ai][bj][m][1];
                    u32x4 w; w.x = cvt_pk_bf16(v0[0], v0[1]); w.y = cvt_pk_bf16(v0[2], v0[3]); w.z = cvt_pk_bf16(v1[0], v1[1]); w.w = cvt_pk_bf16(v1[2], v1[3]);
                    *(u32x4*)(hb + r * 1024 + u.pn * BM + bj * HALF + wc * 32 + 8 * fq) = w; } }
        }
    }
};
struct EpiRouter {
    static constexpr bool PERM = false;
    float* logits;
    DI void operator()(const AccT& acc, const Unit& u, int wr, int wc, int fr, int fq) const {
        if (wc != 0) return;
#pragma unroll
        for (int n = 0; n < 2; ++n) {
            const int c = 16 * n + 4 * fq;
#pragma unroll
            for (int ai = 0; ai < 2; ++ai)
#pragma unroll
                for (int m = 0; m < 4; ++m) {
                    const size_t r = (size_t)(u.pm * BM + ai * HALF + wr * 64 + m * 16 + fr);
                    *(f32x4*)(logits + r * 32 + c) = acc[ai][0][m][n];
                }
        }
    }
};
struct EpiMoe1 {
    static constexpr bool PERM = true;
    unsigned char* act; const float* b1p;
    DI void operator()(const AccT& acc, const Unit& u, int wr, int wc, int fr, int fq) const {
        const int cw = wc * 32 + 8 * fq, j0 = u.pn * 128 + cw;
        const float* bp = b1p + (size_t)u.aux * 2048 + u.pn * 256 + cw;
        const f32x4 ba0 = *(const f32x4*)bp, ba1 = *(const f32x4*)(bp + 4), bb0 = *(const f32x4*)(bp + 128), bb1 = *(const f32x4*)(bp + 132);
        const f32x2 ba[4] = {lo2(ba0), hi2(ba0), lo2(ba1), hi2(ba1)}, bb[4] = {lo2(bb0), hi2(bb0), lo2(bb1), hi2(bb1)};
        constexpr float sc = 1.0f / (F8_SX * F8_SW);
#pragma unroll
        for (int ai = 0; ai < 2; ++ai)
#pragma unroll
            for (int m = 0; m < 4; ++m) {
                const size_t r = (size_t)(u.pm * BM + ai * HALF + wr * 64 + m * 16 + fr);
                f32x2 o[4];
#pragma unroll
                for (int jp = 0; jp < 4; ++jp) {
                    const f32x4& ag = acc[ai][0][m][jp >> 1]; const f32x4& al_ = acc[ai][1][m][jp >> 1];
                    const f32x2 g = ((jp & 1) ? hi2(ag) : lo2(ag)) * sc + ba[jp], l = ((jp & 1) ? hi2(al_) : lo2(al_)) * sc + bb[jp];
                    const f32x2 xg = __builtin_elementwise_min(g, (f32x2){7.0f, 7.0f});
                    const f32x2 xl = __builtin_elementwise_min(__builtin_elementwise_max(l, (f32x2){-7.0f, -7.0f}), (f32x2){7.0f, 7.0f});
                    o[jp] = (xg * pk_sigmoid_scaled(xg, -1.702f * 1.44269504f)) * (xl * F8_SA + F8_SA);
                }
                u32x2 w; w.x = pk4_fp8_nc(o[0], o[1]); w.y = pk4_fp8_nc(o[2], o[3]);
                *(u32x2*)(act + r * 1024 + j0) = w;
            }
    }
};
struct EpiMoe2 {
    static constexpr bool PERM = true;
    unsigned char* y2; const float* b2; const float* rowg;
    DI void operator()(const AccT& acc, const Unit& u, int wr, int wc, int fr, int fq) const {
        float gt[2][4];
#pragma unroll
        for (int ai = 0; ai < 2; ++ai)
#pragma unroll
            for (int m = 0; m < 4; ++m) gt[ai][m] = rowg[(size_t)(u.pm * BM + ai * HALF + wr * 64 + m * 16 + fr)] * F8_SY;
#pragma unroll
        for (int bj = 0; bj < 2; ++bj) {
            const int c0 = u.pn * BM + bj * HALF + wc * 32 + 8 * fq;
            const f32x4 bva = *(const f32x4*)(b2 + (size_t)u.aux * 1024 + c0), bvb = *(const f32x4*)(b2 + (size_t)u.aux * 1024 + c0 + 4);
            const f32x2 bv[4] = {lo2(bva), hi2(bva), lo2(bvb), hi2(bvb)};
#pragma unroll
            for (int ai = 0; ai < 2; ++ai)
#pragma unroll
                for (int m = 0; m < 4; ++m) {
                    const size_t r = (size_t)(u.pm * BM + ai * HALF + wr * 64 + m * 16 + fr);
                    const float g = gt[ai][m];
                    f32x2 o[4];
#pragma unroll
                    for (int jp = 0; jp < 4; ++jp) { const f32x4& a = acc[ai][bj][m][jp >> 1];
                        o[jp] = (((jp & 1) ? hi2(a) : lo2(a)) * (1.0f / (F8_SA * F8_SW)) + bv[jp]) * g;
                        o[jp] = __builtin_elementwise_min(__builtin_elementwise_max(o[jp], (f32x2){-448.f, -448.f}), (f32x2){448.f, 448.f}); }
                    u32x2 w; w.x = pk4_fp8_nc(o[0], o[1]); w.y = pk4_fp8_nc(o[2], o[3]);
                    *(u32x2*)(y2 + r * 1024 + c0) = w;
                }
        }
    }
};
struct KArgs { const float* in[34]; float* out; unsigned char* ws; int ph_lo, ph_hi; };
struct Frame {
    LAS unsigned char* lds; int tid, lane, wave, G, bid;
    const float* const* in; float* out; unsigned char* ws;
};

template <class MP>
DI void conv_T(const Frame& F, const float* src, size_t src_bstride, int ld, bf16_t* dst, int N, int K, int nbatch, MP mp, int t0 = 0, int t1 = 0x7fffffff) {
    LAS unsigned* tile = (LAS unsigned*)F.lds;
    const int ntk = K / 64, ntn = N / 256, per = ntk * ntn;
    const int tend = (per * nbatch) < t1 ? (per * nbatch) : t1;
    for (int t = t0 + F.bid; t < tend; t += F.G) {
        const int bt = t / per, tt = t % per, tk = tt % ntk, pn = tt / ntk;
        const float* s = src + (size_t)bt * src_bstride + (size_t)(tk * 64) * ld + mp.src(pn, F.lane);
        f32x4 va[4], vb[4];
#pragma unroll
        for (int i = 0; i < 4; ++i) { const int kp = F.wave + 8 * i; va[i] = *(const f32x4*)(s + (size_t)(2 * kp) * ld); vb[i] = *(const f32x4*)(s + (size_t)(2 * kp + 1) * ld); }
#pragma unroll
        for (int i = 0; i < 4; ++i) { const int kp = F.wave + 8 * i;
#pragma unroll
            for (int j = 0; j < 4; ++j) tile[mp.dst(F.lane, j) * 33 + kp] = cvt_pk_bf16(va[i][j], vb[i][j]); }
        __syncthreads();
        unsigned* d = (unsigned*)(dst + (size_t)bt * N * K + (size_t)(pn * 256) * K + tk * 64);
#pragma unroll
        for (int i = 0; i < 4; ++i) { const int pc = F.tid + NTHR * i, nn = pc >> 3, seg = pc & 7;
            u32x4 w; w.x = tile[nn * 33 + seg * 4]; w.y = tile[nn * 33 + seg * 4 + 1]; w.z = tile[nn * 33 + seg * 4 + 2]; w.w = tile[nn * 33 + seg * 4 + 3];
            *(u32x4*)(d + ((size_t)nn * K) / 2 + seg * 4) = w; }
        __syncthreads();
    }
}
template <class MP>
DI void conv_T8(const Frame& F, const float* src, size_t src_bstride, int ld, unsigned char* dst, int N, int K, int nbatch, MP mp, float scale, int t0 = 0, int t1 = 0x7fffffff) {
    LAS unsigned* tile = (LAS unsigned*)F.lds;
    const int ntk = K / 64, ntn = N / 256, per = ntk * ntn;
    const int tend = (per * nbatch) < t1 ? (per * nbatch) : t1;
    for (int t = t0 + F.bid; t < tend; t += F.G) {
        const int bt = t / per, tt = t % per, tk = tt % ntk, pn = tt / ntk;
        const float* s = src + (size_t)bt * src_bstride + (size_t)(tk * 64) * ld + mp.src(pn, F.lane);
        f32x4 v[2][4];
#pragma unroll
        for (int i = 0; i < 2; ++i) { const int kq = F.wave + 8 * i;
#pragma unroll
            for (int e = 0; e < 4; ++e) v[i][e] = *(const f32x4*)(s + (size_t)(4 * kq + e) * ld); }
#pragma unroll
        for (int i = 0; i < 2; ++i) { const int kq = F.wave + 8 * i;
#pragma unroll
            for (int j = 0; j < 4; ++j) tile[mp.dst(F.lane, j) * 17 + kq] = pk4_fp8(v[i][0][j] * scale, v[i][1][j] * scale, v[i][2][j] * scale, v[i][3][j] * scale); }
        __syncthreads();
        unsigned char* d = dst + ((size_t)bt * N + (size_t)pn * 256) * K + tk * 64;
#pragma unroll
        for (int i = 0; i < 2; ++i) { const int pc = F.tid + NTHR * i, nn = pc >> 2, seg = pc & 3;
            u32x4 w; w.x = tile[nn * 17 + seg * 4]; w.y = tile[nn * 17 + seg * 4 + 1]; w.z = tile[nn * 17 + seg * 4 + 2]; w.w = tile[nn * 17 + seg * 4 + 3];
            *(u32x4*)(d + (size_t)nn * K + seg * 16) = w; }
        __syncthreads();
    }
}
struct MpId  { DI int src(int pn, int f) const { return pn * 256 + 4 * f; } DI int dst(int f, int j) const { return 4 * f + j; } };
struct MpSwi { DI int src(int pn, int f) const { return pn * 256 + 4 * f; } DI int dst(int f, int j) const { const int n = 4 * f + j; return (n >> 1) + 128 * (n & 1); } };
struct MpGlu { DI int src(int pn, int f) const { const int w = 4 * f; return pn * 128 + (w & 127) + 1024 * (w >> 7); } DI int dst(int f, int j) const { return 4 * f + j; } };
struct CmGlu { DI int operator()(int n) const { const int pn = n >> 8, w = n & 255; return pn * 128 + (w & 127) + 1024 * (w >> 7); } };
struct CmSwi { DI int operator()(int n) const { const int pn = n >> 8, w = n & 255; return 2 * (pn * 128 + (w & 127)) + (w >> 7); } };

DI void rmsnorm_rows(const Frame& F, const float* x, const float* g, bf16_t* out, int row0, int nrows, unsigned char* out8 = nullptr) {
    const int stride = F.G * NWAVES;
    for (int row = row0 + F.bid * NWAVES + F.wave; row < row0 + nrows; row += 2 * stride) {
        const int row2 = (row + stride < row0 + nrows) ? row + stride : row;
        const f32x4* xr = (const f32x4*)(x + (size_t)row * D); const f32x4* xr2 = (const f32x4*)(x + (size_t)row2 * D);
        f32x4 v[4], u[4]; float ss = 0.f, su = 0.f;
#pragma unroll
        for (int i = 0; i < 4; ++i) { v[i] = xr[i * 64 + F.lane]; u[i] = xr2[i * 64 + F.lane]; }
#pragma unroll
        for (int i = 0; i < 4; ++i) { ss += v[i][0] * v[i][0] + v[i][1] * v[i][1] + v[i][2] * v[i][2] + v[i][3] * v[i][3]; su += u[i][0] * u[i][0] + u[i][1] * u[i][1] + u[i][2] * u[i][2] + u[i][3] * u[i][3]; }
        ss = wave_sum(ss); su = wave_sum(su);
        const float rs = rsqrtf(ss * (1.0f / D) + 1e-5f), ru = rsqrtf(su * (1.0f / D) + 1e-5f);
#pragma unroll
        for (int i = 0; i < 4; ++i) { const f32x4 gv = ((const f32x4*)g)[i * 64 + F.lane];
            u32x2 w; w.x = cvt_pk_bf16(v[i][0] * rs * gv[0], v[i][1] * rs * gv[1]); w.y = cvt_pk_bf16(v[i][2] * rs * gv[2], v[i][3] * rs * gv[3]);
            *(u32x2*)(out + (size_t)row * D + (i * 64 + F.lane) * 4) = w;
            u32x2 w2; w2.x = cvt_pk_bf16(u[i][0] * ru * gv[0], u[i][1] * ru * gv[1]); w2.y = cvt_pk_bf16(u[i][2] * ru * gv[2], u[i][3] * ru * gv[3]);
            *(u32x2*)(out + (size_t)row2 * D + (i * 64 + F.lane) * 4) = w2;
            if (out8) { *(unsigned*)(out8 + (size_t)row * D + (i * 64 + F.lane) * 4) = pk4_fp8(v[i][0] * rs * gv[0] * F8_SX, v[i][1] * rs * gv[1] * F8_SX, v[i][2] * rs * gv[2] * F8_SX, v[i][3] * rs * gv[3] * F8_SX);
                *(unsigned*)(out8 + (size_t)row2 * D + (i * 64 + F.lane) * 4) = pk4_fp8(u[i][0] * ru * gv[0] * F8_SX, u[i][1] * ru * gv[1] * F8_SX, u[i][2] * ru * gv[2] * F8_SX, u[i][3] * ru * gv[3] * F8_SX); } }
    }
}

DI void p0_prologue(const Frame& F) {
    unsigned char* ws = F.ws;
    conv_T(F, F.in[2], 0, INC, (bf16_t*)(ws + WS_WIN), INC, D, 1, MpId());
    conv_T(F, F.in[11], 0, 2048, (bf16_t*)(ws + WS_WGLU), 2048, 512, 1, MpGlu());
    conv_T(F, F.in[24], 0, 1024, (bf16_t*)(ws + WS_WO), 1024, 512, 1, MpId());
    conv_T(F, F.in[25], 0, 1024, (bf16_t*)(ws + WS_WOUT), 1024, 1024, 1, MpId());
    {
        bf16_t* wl = (bf16_t*)(ws + WS_WLORA); const float* w2 = F.in[15]; const float* a2 = F.in[17]; const float* g2 = F.in[18];
        for (int idx = F.bid * NTHR + F.tid; idx < 1536 * 128; idx += F.G * NTHR) { const int n = idx >> 7, k = idx & 127; float v = 0.f;
            if (n < 512) { if (k < 64) v = w2[k * 512 + n]; } else if (n < 1024) { if (k >= 64) v = a2[(k - 64) * 512 + (n - 512)]; } else { v = g2[k * 512 + (n - 1024)]; }
            wl[idx] = f2bf(v); }
        bf16_t* wrt = (bf16_t*)(ws + WS_WR); const float* rw = F.in[27];
        for (int idx = F.bid * NTHR + F.tid; idx < 256 * 1024; idx += F.G * NTHR) { const int n = idx >> 10, k = idx & 1023; wrt[idx] = f2bf(n < 32 ? rw[k * 32 + n] * F.in[26][k] : 0.f); }
        float* bg = (float*)(ws + WS_BGLU); const float* bsrc = F.in[12]; CmGlu cm;
        for (int idx = F.bid * NTHR + F.tid; idx < 2048; idx += F.G * NTHR) bg[idx] = bsrc[cm(idx)];
    }
    if (F.bid & 1) rmsnorm_rows(F, F.in[0], F.in[1], (bf16_t*)(ws + WS_XN), 0, T);
    {
        LAS float* L = (LAS float*)F.lds;
        LAS float* pwr = L, *pwi = L + 64, *p1r = L + 128, *p1i = L + 192, *ffr = L + 256, *ffi = L + 320;
        LAS float* bbr = L + 384, *bbi = bbr + 1024, *ccr = bbi + 1024, *cci = ccr + 1024, *kj = cci + 1024;
        const float* lam_re = F.in[3]; const float* lam_im = F.in[4]; const float* log_dt = F.in[5];
        const float* b_re = F.in[6]; const float* b_im = F.in[7]; const float* c_re = F.in[8]; const float* c_im = F.in[9]; const float* dsk = F.in[10];
        unsigned* toep = (unsigned*)(ws + WS_TOEP); unsigned* wst = (unsigned*)(ws + WS_WST);
        for (int it = F.bid; it < 32 * S5L; it += F.G) {
            const int g = it / S5L, j = it % S5L;
            if (F.tid < 64) { const int p = F.tid; const float lr = lam_re[g * 64 + p], li = lam_im[g * 64 + p], dt = __expf(log_dt[g]);
                float sn, cs; { const float mg = expf((float)j * lr * dt); sincosf((float)j * (li * dt), &sn, &cs); pwr[p] = mg * cs; pwi[p] = mg * sn; }
                { const float mg = expf((float)(j + 1) * lr * dt); sincosf((float)(j + 1) * (li * dt), &sn, &cs); p1r[p] = mg * cs; p1i[p] = mg * sn; }
                { const float mg = expf(lr * dt); sincosf(li * dt, &sn, &cs); const float nr = mg * cs - 1.0f, ni = mg * sn, den = lr * lr + li * li;
                  ffr[p] = (nr * lr + ni * li) / den; ffi[p] = (ni * lr - nr * li) / den; } }
            __syncthreads();
            for (int idx = F.tid; idx < 1024; idx += NTHR) { const int p = idx >> 4; const float br = b_re[g * 1024 + idx], bi = b_im[g * 1024 + idx];
                bbr[idx] = ffr[p] * br - ffi[p] * bi; bbi[idx] = ffr[p] * bi + ffi[p] * br;
                ccr[idx] = c_re[g * 1024 + idx]; cci[idx] = c_im[g * 1024 + idx]; }
            __syncthreads();
            if (F.tid < 256) { const int co = F.tid >> 4, ci = F.tid & 15; float s = 0.f;
                for (int p = 0; p < 64; ++p) { const float zr = pwr[p] * bbr[p * 16 + ci] - pwi[p] * bbi[p * 16 + ci], zi = pwr[p] * bbi[p * 16 + ci] + pwi[p] * bbr[p * 16 + ci];
                    s += ccr[co * 64 + p] * zr - cci[co * 64 + p] * zi; }
                if (j == 0 && co == ci) s += dsk[g * 16 + co];
                kj[F.tid] = s; }
            __syncthreads();
            for (int idx = F.tid; idx < (S5L - j) * 128; idx += NTHR) { const int t = j + idx / 128, rem = idx % 128, co = rem >> 3, ci = (rem & 7) * 2;
                toep[((size_t)(g * 512 + t * 16 + co) * LDU + (t - j) * 16 + ci) / 2] = cvt_pk_bf16(kj[co * 16 + ci], kj[co * 16 + ci + 1]);
                if (j > 0) toep[((size_t)(g * 512 + (t - j) * 16 + co) * LDU + t * 16 + ci) / 2] = 0u; }
            for (int idx = F.tid; idx < 16 * 64; idx += NTHR) { const int co = idx >> 6, q = (idx & 63) * 2; float o[2];
#pragma unroll
                for (int e = 0; e < 2; ++e) { const int qq = q + e, p = qq & 63; const float cr = ccr[co * 64 + p], cim = cci[co * 64 + p];
                    o[e] = (qq < 64) ? (cr * p1r[p] - cim * p1i[p]) : -(cr * p1i[p] + cim * p1r[p]); }
                toep[((size_t)(g * 512 + j * 16 + co) * LDU + 512 + q) / 2] = cvt_pk_bf16(o[0], o[1]); }
            { const int s = S5L - 1 - j;
              for (int idx = F.tid; idx < 256 * 8; idx += NTHR) { const int q = idx >> 3, ci = (idx & 7) * 2; float o[2] = {0.f, 0.f};
                if (q < 128) { const int p = q & 63;
#pragma unroll
                    for (int e = 0; e < 2; ++e) { const float br = bbr[p * 16 + ci + e], bi = bbi[p * 16 + ci + e];
                        o[e] = (q < 64) ? (pwr[p] * br - pwi[p] * bi) : (pwr[p] * bi + pwi[p] * br); } }
                wst[((size_t)(g * 256 + q) * 512 + s * 16 + ci) / 2] = cvt_pk_bf16(o[0], o[1]); } }
            __syncthreads();
        }
    }
    if (!(F.bid & 1)) rmsnorm_rows(F, F.in[0], F.in[1], (bf16_t*)(ws + WS_XN), 0, T);
}

DI void p_rw_prep(const Frame& F) {
    const bf16_t* prw = (const bf16_t*)(F.ws + WS_PRW); bf16_t* al_ = (bf16_t*)(F.ws + WS_ALORA); const float* mu = F.in[13];
    for (int idx = F.bid * NTHR + F.tid; idx < T * 32; idx += F.G * NTHR) {
        const int t = idx >> 5, c8 = (idx & 31) * 8;
        const u32x4 cur = *(const u32x4*)(prw + (size_t)t * RWC + 1536 + c8);
        u32x4 prv = (u32x4){0u, 0u, 0u, 0u};
        if ((t & (SEQ - 1)) != 0) prv = *(const u32x4*)(prw + (size_t)(t - 1) * RWC + 1536 + c8);
        float o[8];
#pragma unroll
        for (int j = 0; j < 8; ++j) { const float c = (j & 1) ? bf_hi(cur[j >> 1]) : bf_lo(cur[j >> 1]), p = (j & 1) ? bf_hi(prv[j >> 1]) : bf_lo(prv[j >> 1]);
            const float xs = c + mu[1536 + c8 + j] * (p - c);
            o[j] = (c8 < 64) ? ftanh(xs) : ((c8 < 128) ? xs : fsigmoid(xs)); }
        u32x4 w; w.x = cvt_pk_bf16(o[0], o[1]); w.y = cvt_pk_bf16(o[2], o[3]); w.z = cvt_pk_bf16(o[4], o[5]); w.w = cvt_pk_bf16(o[6], o[7]);
        *(u32x4*)(al_ + (size_t)t * 256 + c8) = w;
    }
}

DI void p_s5_carry(const Frame& F) {
    const float* lam_re = F.in[3]; const float* lam_im = F.in[4]; const float* log_dt = F.in[5];
    const float* sloc = (const float*)(F.ws + WS_SLOC); bf16_t* us5 = (bf16_t*)(F.ws + WS_US5);
    for (int gt = F.bid * NTHR + F.tid; gt < NB * 32 * 64; gt += F.G * NTHR) {
        const int p = gt & 63, g = (gt >> 6) & 31, b = gt >> 11;
        const float lr = lam_re[g * 64 + p], li = lam_im[g * 64 + p], dt = __expf(log_dt[g]);
        float sn, cs; const float mg = expf((float)S5L * lr * dt); sincosf((float)S5L * (li * dt), &sn, &cs);
        const float ar = mg * cs, ai = mg * sn;
        float xr = 0.f, xi = 0.f;
        const size_t row0 = (size_t)g * S5ROWS + (size_t)b * S5NC;
        for (int cb = 0; cb < S5NC; cb += 16) {
            float sr[16], si[16];
#pragma unroll
            for (int j = 0; j < 16; ++j) { sr[j] = sloc[(row0 + cb + j) * 128 + p]; si[j] = sloc[(row0 + cb + j) * 128 + 64 + p]; }
#pragma unroll
            for (int j = 0; j < 16; ++j) { const size_t row = row0 + cb + j;
                us5[row * LDU + 512 + p] = f2bf(xr); us5[row * LDU + 576 + p] = f2bf(xi);
                const float nr = ar * xr - ai * xi + sr[j], ni = ar * xi + ai * xr + si[j];
                xr = nr; xi = ni; }
        }
    }
}

constexpr int PT = 72, SLOTB = 64 * PT * 2;
DI LAS bf16_t* rslot(LAS unsigned char* lds, int i) { return (LAS bf16_t*)(lds + i * SLOTB); }
DI void mm_acc(f32x4 (&acc)[2], const LAS bf16_t* A, const LAS bf16_t* Bt, int ti, int tj0, int r, int q) {
#pragma unroll
    for (int s2 = 0; s2 < 2; ++s2) {
        const bf16x8 a = *(const LAS bf16x8*)(A + (16 * ti + r) * PT + 32 * s2 + 8 * q);
#pragma unroll
        for (int e = 0; e < 2; ++e) { const bf16x8 b = *(const LAS bf16x8*)(Bt + (16 * (tj0 + e) + r) * PT + 32 * s2 + 8 * q);
            acc[e] = __builtin_amdgcn_mfma_f32_16x16x32_bf16(a, b, acc[e], 0, 0, 0); }
    }
}
DI void mm_acc_bnat(f32x4 (&acc)[2], const LAS bf16_t* A, const LAS bf16_t* Bn, int ti, int tj0, int r, int q) {
#pragma unroll
    for (int s2 = 0; s2 < 2; ++s2) {
        const bf16x8 a = *(const LAS bf16x8*)(A + (16 * ti + r) * PT + 32 * s2 + 8 * q);
#pragma unroll
        for (int e = 0; e < 2; ++e) { bf16x8 b;
#pragma unroll
            for (int jj = 0; jj < 8; ++jj) b[jj] = (short)Bn[(32 * s2 + 8 * q + jj) * PT + 16 * (tj0 + e) + r];
            acc[e] = __builtin_amdgcn_mfma_f32_16x16x32_bf16(a, b, acc[e], 0, 0, 0); }
    }
}
DI void st_rm(LAS bf16_t* Dm, const f32x4& v, int i0, int j) {
#pragma unroll
    for (int g = 0; g < 4; ++g) Dm[(i0 + g) * PT + j] = f2bf(v[g]);
}
DI void st_tr(LAS bf16_t* Dm, const f32x4& v, int i0, int j) { u32x2 w; w.x = cvt_pk_bf16(v[0], v[1]); w.y = cvt_pk_bf16(v[2], v[3]); *(LAS u32x2*)(Dm + j * PT + i0) = w; }
DI f32x4 ld_rm(const LAS bf16_t* Sm, int i0, int j) { f32x4 v;
#pragma unroll
    for (int g = 0; g < 4; ++g) v[g] = bf2f(Sm[(i0 + g) * PT + j]);
    return v; }
#define ZACC(a) do { a[0] = (f32x4){0.f, 0.f, 0.f, 0.f}; a[1] = (f32x4){0.f, 0.f, 0.f, 0.f}; } while (0)

DI float wave_sum2(float v) { return xrow_sum(row_sum16(v)); }
#define LSYNC() do { asm volatile("s_waitcnt lgkmcnt(0)" ::: "memory"); __builtin_amdgcn_s_barrier(); asm volatile("" ::: "memory"); } while (0)

struct RaRaw { bf16_t r[9], k[9], v[9], lw[8], a[8]; };
DI void ra_load(RaRaw& x, const bf16_t* prw, const bf16_t* lwag, int ci, int w, int lane) {
    const int bh = ci >> 6, c = ci & 63, b = bh >> 3, h = bh & 7, ch = h * 64 + lane;
    const size_t tok0 = (size_t)b * SEQ + c * 64 + 8 * w;
    const bool has_prev = !(c == 0 && w == 0);
    const size_t tp = has_prev ? tok0 - 1 : tok0;
    x.r[0] = prw[tp * RWC + ch]; x.k[0] = prw[tp * RWC + 512 + ch]; x.v[0] = prw[tp * RWC + 1024 + ch];
#pragma unroll
    for (int i = 0; i < 8; ++i) { const size_t tok = tok0 + i;
        x.r[i + 1] = prw[tok * RWC + ch]; x.k[i + 1] = prw[tok * RWC + 512 + ch]; x.v[i + 1] = prw[tok * RWC + 1024 + ch];
        x.lw[i] = lwag[tok * 1536 + ch]; x.a[i] = lwag[tok * 1536 + 512 + ch]; }
}
DI void p_rw_chunk(const Frame& F) {
    const bf16_t* prw = (const bf16_t*)(F.ws + WS_PRW); const bf16_t* lwag = (const bf16_t*)(F.ws + WS_LWAG);
    const float* mu = F.in[13]; const float* k_k = F.in[19]; const float* k_a = F.in[20]; const float* r_k = F.in[21];
    float* bonus = (float*)(F.ws + WS_BONUS);
    bf16_t* gM = (bf16_t*)(F.ws + WS_CHK_M); bf16_t* gN0T = (bf16_t*)(F.ws + WS_CHK_N0T); bf16_t* gQ = (bf16_t*)(F.ws + WS_CHK_Q); bf16_t* gY0 = (bf16_t*)(F.ws + WS_CHK_Y0T);
    LAS unsigned char* lds = F.lds;
    LAS float* segtot = (LAS float*)(lds + 14 * SLOTB);
    LAS float* PLs = segtot + 512;
    LAS float* DB = PLs + 64;
    constexpr int PD = 20;
    const int w = F.wave, lane = F.lane, r = lane & 15, q = lane >> 4, ti = w >> 1, tj0 = 2 * (w & 1), i0 = 16 * ti + 4 * q;
    LAS bf16_t* S0 = rslot(lds, 0); LAS bf16_t* S1 = rslot(lds, 1); LAS bf16_t* S2 = rslot(lds, 2); LAS bf16_t* S3 = rslot(lds, 3);
    LAS bf16_t* S4 = rslot(lds, 4); LAS bf16_t* S5 = rslot(lds, 5); LAS bf16_t* S6 = rslot(lds, 6); LAS bf16_t* S7 = rslot(lds, 7);
    LAS bf16_t* S8 = rslot(lds, 8); LAS bf16_t* S9 = rslot(lds, 9); LAS bf16_t* S10 = rslot(lds, 10); LAS bf16_t* S11 = rslot(lds, 11);
    LAS bf16_t* S12 = rslot(lds, 12); LAS bf16_t* S13 = rslot(lds, 13);
    RaRaw raw;
    if (F.bid < RW_NCH) ra_load(raw, prw, lwag, F.bid, w, lane);
    for (int ci = F.bid; ci < RW_NCH; ci += F.G) {
        const int bh = ci >> 6, c = ci & 63, b = bh >> 3, h = bh & 7, ch = h * 64 + lane;
        {
            const size_t tok0 = (size_t)b * SEQ + c * 64 + 8 * w;
            const float mur = mu[ch], muk = mu[512 + ch], muv = mu[1024 + ch], kkw = k_k[ch], ka = k_a[ch], rk = r_k[ch];
            const bool has_prev = !(c == 0 && w == 0);
            float xr[9], xk[9], xv[9];
            xr[0] = has_prev ? bf2f(raw.r[0]) : 0.f; xk[0] = has_prev ? bf2f(raw.k[0]) : 0.f; xv[0] = has_prev ? bf2f(raw.v[0]) : 0.f;
#pragma unroll
            for (int i = 1; i < 9; ++i) { xr[i] = bf2f(raw.r[i]); xk[i] = bf2f(raw.k[i]); xv[i] = bf2f(raw.v[i]); }
            f32x2 rr2[4], vv2[4], aa2[4], km2[4], kn2[4]; float cl[8];
            float run = 0.f;
#pragma unroll
            for (int p2 = 0; p2 < 4; ++p2) {
                const f32x2 cr = {xr[2 * p2 + 1], xr[2 * p2 + 2]}, pr = {xr[2 * p2], xr[2 * p2 + 1]};
                const f32x2 ck = {xk[2 * p2 + 1], xk[2 * p2 + 2]}, pk = {xk[2 * p2], xk[2 * p2 + 1]};
                const f32x2 cv = {xv[2 * p2 + 1], xv[2 * p2 + 2]}, pv = {xv[2 * p2], xv[2 * p2 + 1]};
                const f32x2 r_ = cr + (pr - cr) * mur, k_ = ck + (pk - ck) * muk, v_ = cv + (pv - cv) * muv;
                const f32x2 a_ = {bf2f(raw.a[2 * p2]), bf2f(raw.a[2 * p2 + 1])};
                f32x2 kx = k_ * kkw; const f32x2 sq = kx * kx;
                const float ss0 = wave_sum2(sq.x), ss1 = wave_sum2(sq.y);
                kx = kx * (f32x2){fminf(__builtin_amdgcn_rsqf(ss0), 1e12f), fminf(__builtin_amdgcn_rsqf(ss1), 1e12f)};
                const f32x2 kmod = k_ * (a_ * ka + (1.0f - ka));
                const f32x2 bq = (r_ * kmod) * rk;
                const float bn0 = wave_sum2(bq.x), bn1 = wave_sum2(bq.y);
                if (lane == 0) { bonus[(tok0 + 2 * p2) * 8 + h] = bn0; bonus[(tok0 + 2 * p2 + 1) * 8 + h] = bn1; }
                rr2[p2] = r_; vv2[p2] = v_; aa2[p2] = a_; km2[p2] = kmod; kn2[p2] = kx;
                run += bf2f(raw.lw[2 * p2]); cl[2 * p2] = run; run += bf2f(raw.lw[2 * p2 + 1]); cl[2 * p2 + 1] = run;
            }
            segtot[w * 64 + lane] = run;
            LSYNC();
            float pre = 0.f;
            for (int w2 = 0; w2 < w; ++w2) pre += segtot[w2 * 64 + lane];
            if (w == 7) PLs[lane] = __expf(pre + run);
            float ep = __expf(pre);
            unsigned xa[4], xb[4], xkk[4], xrr[4], xvv[4];
#pragma unroll
            for (int p2 = 0; p2 < 4; ++p2) {
                const f32x2 tt = ((f32x2){cl[2 * p2], cl[2 * p2 + 1]} + pre) * 1.44269504f;
                const f32x2 e = {__builtin_amdgcn_exp2f(tt.x), __builtin_amdgcn_exp2f(tt.y)}, en = {__builtin_amdgcn_rcpf(e.x), __builtin_amdgcn_rcpf(e.y)}, epv = {ep, e.x};
                ep = e.y;
                const f32x2 at = -(kn2[p2] * epv), bt = (kn2[p2] * aa2[p2]) * en, kt = km2[p2] * en, rt = rr2[p2] * e;
                xa[p2] = cvt_pk_bf16(at.x, at.y); xb[p2] = cvt_pk_bf16(bt.x, bt.y); xkk[p2] = cvt_pk_bf16(kt.x, kt.y); xrr[p2] = cvt_pk_bf16(rt.x, rt.y); xvv[p2] = cvt_pk_bf16(vv2[p2].x, vv2[p2].y);
                const int t = 8 * w + 2 * p2;
                S0[t * PT + lane] = (bf16_t)(xa[p2] & 0xffffu); S0[(t + 1) * PT + lane] = (bf16_t)(xa[p2] >> 16);
                S2[t * PT + lane] = (bf16_t)(xb[p2] & 0xffffu); S2[(t + 1) * PT + lane] = (bf16_t)(xb[p2] >> 16);
                S4[t * PT + lane] = (bf16_t)(xkk[p2] & 0xffffu); S4[(t + 1) * PT + lane] = (bf16_t)(xkk[p2] >> 16);
                S6[t * PT + lane] = (bf16_t)(xrr[p2] & 0xffffu); S6[(t + 1) * PT + lane] = (bf16_t)(xrr[p2] >> 16);
            }
            *(LAS u32x4*)(S1 + lane * PT + 8 * w) = (u32x4){xa[0], xa[1], xa[2], xa[3]};
            *(LAS u32x4*)(S3 + lane * PT + 8 * w) = (u32x4){xb[0], xb[1], xb[2], xb[3]};
            *(LAS u32x4*)(S5 + lane * PT + 8 * w) = (u32x4){xkk[0], xkk[1], xkk[2], xkk[3]};
            *(LAS u32x4*)(S7 + lane * PT + 8 * w) = (u32x4){xvv[0], xvv[1], xvv[2], xvv[3]};
        }
        LSYNC();
        if (ci + F.G < RW_NCH) ra_load(raw, prw, lwag, ci + F.G, w, lane);
        f32x4 acc[2];
        ZACC(acc); mm_acc(acc, S0, S2, ti, tj0, r, q);
#pragma unroll
        for (int e = 0; e < 2; ++e) { const int tj = tj0 + e, j = 16 * tj + r;
            if (tj == ti) {
#pragma unroll
                for (int g = 0; g < 4; ++g) DB[(ti * 16 + 4 * q + g) * PD + r] = (4 * q + g > r) ? acc[e][g] : 0.f;
            }
            const f32x4 ev = (ti > tj) ? acc[e] : (f32x4){0.f, 0.f, 0.f, 0.f};
            st_tr(S8, ev, i0, j); }
        ZACC(acc); mm_acc(acc, S0, S4, ti, tj0, r, q);
#pragma unroll
        for (int e = 0; e < 2; ++e) { const int j = 16 * (tj0 + e) + r; f32x4 v = acc[e];
#pragma unroll
            for (int g = 0; g < 4; ++g) v[g] = (i0 + g > j) ? v[g] : 0.f;
            st_rm(S9, v, i0, j); }
        ZACC(acc); mm_acc(acc, S6, S2, ti, tj0, r, q);
#pragma unroll
        for (int e = 0; e < 2; ++e) { const int j = 16 * (tj0 + e) + r; f32x4 v = acc[e];
#pragma unroll
            for (int g = 0; g < 4; ++g) v[g] = (i0 + g >= j) ? v[g] : 0.f;
            st_rm(S10, v, i0, j); }
        ZACC(acc); mm_acc(acc, S6, S4, ti, tj0, r, q);
#pragma unroll
        for (int e = 0; e < 2; ++e) { const int j = 16 * (tj0 + e) + r; f32x4 v = acc[e];
#pragma unroll
            for (int g = 0; g < 4; ++g) v[g] = (i0 + g >= j) ? v[g] : 0.f;
            st_rm(S11, v, i0, j); }
        LSYNC();
        ZACC(acc); mm_acc(acc, S9, S7, ti, tj0, r, q);
#pragma unroll
        for (int e = 0; e < 2; ++e) st_tr(S2, acc[e], i0, 16 * (tj0 + e) + r);
        if (w < 4) {
            const int i = lane >> 2, p = lane & 3;
            const LAS float* Dp = DB + (w * 16 + p) * PD;
            f32x4 Dm[4][4];
#pragma unroll
            for (int m = 0; m < 4; ++m)
#pragma unroll
                for (int c4 = 0; c4 < 4; ++c4) Dm[m][c4] = *(const LAS f32x4*)(Dp + 4 * m * PD + 4 * c4);
            float mine[4] = {0.f, 0.f, 0.f, 0.f}, tr[16];
#pragma unroll
            for (int j = 15; j >= 0; --j) { float part = 0.f;
#pragma unroll
                for (int m = 3; m >= 0; --m) if (4 * m + 3 > j) part = __builtin_fmaf(mine[m], Dm[m][j >> 2][j & 3], part);
                float tot = part + __builtin_bit_cast(float, __builtin_amdgcn_update_dpp(0, __builtin_bit_cast(int, part), 0xB1, 0xf, 0xf, false));
                tot = tot + __builtin_bit_cast(float, __builtin_amdgcn_update_dpp(0, __builtin_bit_cast(int, tot), 0x4E, 0xf, 0xf, false));
                const float trj = (j > i) ? 0.f : ((j == i) ? 1.0f : tot);
                tr[j] = trj; mine[j >> 2] = (p == (j & 3)) ? trj : mine[j >> 2]; }
            u32x4 z = (u32x4){0u, 0u, 0u, 0u}, x0, x1;
            x0.x = cvt_pk_bf16(tr[0], tr[1]); x0.y = cvt_pk_bf16(tr[2], tr[3]); x0.z = cvt_pk_bf16(tr[4], tr[5]); x0.w = cvt_pk_bf16(tr[6], tr[7]);
            x1.x = cvt_pk_bf16(tr[8], tr[9]); x1.y = cvt_pk_bf16(tr[10], tr[11]); x1.z = cvt_pk_bf16(tr[12], tr[13]); x1.w = cvt_pk_bf16(tr[14], tr[15]);
            LAS bf16_t* dst = S0 + (16 * w + i) * PT + 16 * p;
            *(LAS u32x4*)dst = (p == w) ? x0 : z; *(LAS u32x4*)(dst + 8) = (p == w) ? x1 : z;
        }
        LSYNC();
        ZACC(acc); mm_acc(acc, S0, S8, ti, tj0, r, q);
#pragma unroll
        for (int e = 0; e < 2; ++e) { const int j = 16 * (tj0 + e) + r; st_rm(S4, acc[e], i0, j); st_tr(S12, acc[e], i0, j); }
        LSYNC();
        ZACC(acc); mm_acc(acc, S4, S12, ti, tj0, r, q);
#pragma unroll
        for (int e = 0; e < 2; ++e) st_rm(S13, acc[e], i0, 16 * (tj0 + e) + r);
#pragma unroll
        for (int e = 0; e < 2; ++e) acc[e] = ld_rm(S0, i0, 16 * (tj0 + e) + r);
        mm_acc_bnat(acc, S4, S0, ti, tj0, r, q);
#pragma unroll
        for (int e = 0; e < 2; ++e) { const int j = 16 * (tj0 + e) + r; st_rm(S8, acc[e], i0, j); st_tr(S9, acc[e], i0, j); }
        LSYNC();
#pragma unroll
        for (int e = 0; e < 2; ++e) acc[e] = ld_rm(S8, i0, 16 * (tj0 + e) + r);
        mm_acc(acc, S13, S9, ti, tj0, r, q);
#pragma unroll
        for (int e = 0; e < 2; ++e) st_rm(S12, acc[e], i0, 16 * (tj0 + e) + r);
        LSYNC();
        ZACC(acc); mm_acc(acc, S12, S1, ti, tj0, r, q);
#pragma unroll
        for (int e = 0; e < 2; ++e) st_tr(S0, acc[e], i0, 16 * (tj0 + e) + r);
        ZACC(acc); mm_acc(acc, S12, S2, ti, tj0, r, q);
#pragma unroll
        for (int e = 0; e < 2; ++e) st_tr(S4, acc[e], i0, 16 * (tj0 + e) + r);
        LSYNC();
        f32x4 aq[2], ay[2], am[2], an[2];
#pragma unroll
        for (int e = 0; e < 2; ++e) aq[e] = ld_rm(S6, i0, 16 * (tj0 + e) + r);
        mm_acc(aq, S10, S0, ti, tj0, r, q);
        ZACC(ay); mm_acc(ay, S10, S4, ti, tj0, r, q); mm_acc(ay, S11, S7, ti, tj0, r, q);
        ZACC(am); mm_acc(am, S3, S0, ti, tj0, r, q);
        ZACC(an); mm_acc(an, S3, S4, ti, tj0, r, q); mm_acc(an, S5, S7, ti, tj0, r, q);
#pragma unroll
        for (int e = 0; e < 2; ++e) { const int j = 16 * (tj0 + e) + r;
            f32x4 pm, pn2;
#pragma unroll
            for (int g = 0; g < 4; ++g) { const float pl = PLs[i0 + g]; pm[g] = pl * (am[e][g] + ((i0 + g == j) ? 1.0f : 0.f)); pn2[g] = pl * an[e][g]; }
            st_rm(S1, aq[e], i0, j); st_rm(S2, ay[e], i0, j); st_rm(S8, pm, i0, j); st_tr(S9, pn2, i0, j); }
        LSYNC();
        { const int row = F.tid >> 3, seg = (F.tid & 7) * 8; const size_t go = (size_t)ci * 4096 + row * 64 + seg;
          *(u32x4*)(gQ + go) = *(const LAS u32x4*)(S1 + row * PT + seg); *(u32x4*)(gY0 + go) = *(const LAS u32x4*)(S2 + row * PT + seg);
          *(u32x4*)(gM + go) = *(const LAS u32x4*)(S8 + row * PT + seg); *(u32x4*)(gN0T + go) = *(const LAS u32x4*)(S9 + row * PT + seg); }
        LSYNC();
    }
    asm volatile("s_waitcnt vmcnt(0)" ::: "memory");
}

struct ScanOps { u32x2 m[4][2][2]; u32x2 n0[4]; };
DI void scan_load(ScanOps& o, const bf16_t* gM, const bf16_t* gN0T, size_t ci, int col, int q, int v) {
#pragma unroll
    for (int m = 0; m < 4; ++m) {
#pragma unroll
        for (int s2 = 0; s2 < 2; ++s2) { const bf16_t* p = gM + ci * 4096 + (16 * m + col) * 64 + 32 * s2 + 4 * q; o.m[m][s2][0] = *(const u32x2*)p; o.m[m][s2][1] = *(const u32x2*)(p + 16); }
        o.n0[m] = *(const u32x2*)(gN0T + ci * 4096 + v * 64 + 16 * m + 4 * q); }
}
DI void scan_step(const ScanOps& o, f32x4 (&H)[4], bf16_t* gHT, size_t ci, int q, int v) {
    u32x4 bfr[2];
#pragma unroll
    for (int s2 = 0; s2 < 2; ++s2) { bfr[s2].x = cvt_pk_bf16(H[2 * s2][0], H[2 * s2][1]); bfr[s2].y = cvt_pk_bf16(H[2 * s2][2], H[2 * s2][3]);
        bfr[s2].z = cvt_pk_bf16(H[2 * s2 + 1][0], H[2 * s2 + 1][1]); bfr[s2].w = cvt_pk_bf16(H[2 * s2 + 1][2], H[2 * s2 + 1][3]);
        bf16_t* hp = gHT + ci * 4096 + v * 64 + 32 * s2 + 4 * q;
        *(u32x2*)hp = (u32x2){bfr[s2].x, bfr[s2].y}; *(u32x2*)(hp + 16) = (u32x2){bfr[s2].z, bfr[s2].w}; }
#pragma unroll
    for (int m = 0; m < 4; ++m) {
        f32x4 a2 = (f32x4){bf_lo(o.n0[m].x), bf_hi(o.n0[m].x), bf_lo(o.n0[m].y), bf_hi(o.n0[m].y)};
#pragma unroll
        for (int s2 = 0; s2 < 2; ++s2) { const u32x4 af = (u32x4){o.m[m][s2][0].x, o.m[m][s2][0].y, o.m[m][s2][1].x, o.m[m][s2][1].y};
            a2 = __builtin_amdgcn_mfma_f32_16x16x32_bf16(__builtin_bit_cast(bf16x8, af), __builtin_bit_cast(bf16x8, bfr[s2]), a2, 0, 0, 0); }
        H[m] = a2; }
}
DI void p_rw_scan(const Frame& F) {
    const bf16_t* gM = (const bf16_t*)(F.ws + WS_CHK_M); const bf16_t* gN0T = (const bf16_t*)(F.ws + WS_CHK_N0T); bf16_t* gHT = (bf16_t*)(F.ws + WS_CHK_HT);
    for (int item = F.wave * F.G + F.bid; item < 512; item += NWAVES * F.G) {
        const int bh = item >> 2, vb = item & 3, col = F.lane & 15, q = F.lane >> 4, v = 16 * vb + col;
        f32x4 H[4];
#pragma unroll
        for (int m = 0; m < 4; ++m) H[m] = (f32x4){0.f, 0.f, 0.f, 0.f};
        const size_t c0 = (size_t)bh * 64;
        ScanOps A, B, C, Dd;
        scan_load(A, gM, gN0T, c0, col, q, v); scan_load(B, gM, gN0T, c0 + 1, col, q, v); scan_load(C, gM, gN0T, c0 + 2, col, q, v);
        for (int c = 0; c < 64; c += 4) {
            scan_load(Dd, gM, gN0T, c0 + c + 3, col, q, v);
            scan_step(A, H, gHT, c0 + c, q, v);
            if (c + 4 < 64) scan_load(A, gM, gN0T, c0 + c + 4, col, q, v);
            scan_step(B, H, gHT, c0 + c + 1, q, v);
            if (c + 4 < 64) scan_load(B, gM, gN0T, c0 + c + 5, col, q, v);
            scan_step(C, H, gHT, c0 + c + 2, q, v);
            if (c + 4 < 64) scan_load(C, gM, gN0T, c0 + c + 6, col, q, v);
            scan_step(Dd, H, gHT, c0 + c + 3, q, v);
        }
    }
}

struct RcIn { bf16x8 qf[2], hb[4][2]; u32x2 y0[4], cv[4], pv[4], gw[4]; float bn; };
DI void rc_load(RcIn& x, const bf16_t* gQ, const bf16_t* gY0, const bf16_t* gHT, const bf16_t* prw, const bf16_t* lwag, const float* bonus, int item, int r, int q) {
    const int ci = item >> 2, ti = item & 3, bh = ci >> 6, c = ci & 63, b = bh >> 3, h = bh & 7;
    const size_t cb = (size_t)ci * 4096; const size_t tok = (size_t)b * SEQ + c * 64 + 16 * ti + r;
    const bool first = (tok & (SEQ - 1)) == 0; const size_t tp = first ? tok : tok - 1;
#pragma unroll
    for (int s2 = 0; s2 < 2; ++s2) x.qf[s2] = *(const bf16x8*)(gQ + cb + (16 * ti + r) * 64 + 32 * s2 + 8 * q);
#pragma unroll
    for (int n = 0; n < 4; ++n) { const int cch = h * 64 + 16 * n + 4 * q;
        x.y0[n] = *(const u32x2*)(gY0 + cb + (16 * ti + r) * 64 + 16 * n + 4 * q);
#pragma unroll
        for (int s2 = 0; s2 < 2; ++s2) x.hb[n][s2] = *(const bf16x8*)(gHT + cb + (16 * n + r) * 64 + 32 * s2 + 8 * q);
        x.cv[n] = *(const u32x2*)(prw + tok * RWC + 1024 + cch); x.pv[n] = *(const u32x2*)(prw + tp * RWC + 1024 + cch);
        x.gw[n] = *(const u32x2*)(lwag + tok * 1536 + 1024 + cch); }
    x.bn = bonus[tok * 8 + h];
}
DI void rc_compute(const RcIn& x, bf16_t* yrw, const float* mu, const float* ln_g, const float* ln_b, int item, int r, int q) {
    const int ci = item >> 2, ti = item & 3, bh = ci >> 6, c = ci & 63, b = bh >> 3, h = bh & 7;
    const size_t tok = (size_t)b * SEQ + c * 64 + 16 * ti + r; const bool first = (tok & (SEQ - 1)) == 0;
    f32x4 y[4];
#pragma unroll
    for (int n = 0; n < 4; ++n) { y[n] = (f32x4){bf_lo(x.y0[n].x), bf_hi(x.y0[n].x), bf_lo(x.y0[n].y), bf_hi(x.y0[n].y)};
#pragma unroll
        for (int s2 = 0; s2 < 2; ++s2) y[n] = __builtin_amdgcn_mfma_f32_16x16x32_bf16(x.hb[n][s2], x.qf[s2], y[n], 0, 0, 0); }
    float s1 = 0.f;
#pragma unroll
    for (int n = 0; n < 4; ++n) s1 += (y[n][0] + y[n][1]) + (y[n][2] + y[n][3]);
    s1 = xrow_sum(s1);
    const float mean = s1 * (1.0f / 64.0f);
    float s2 = 0.f;
#pragma unroll
    for (int n = 0; n < 4; ++n) { y[n] = y[n] - mean; s2 += (y[n][0] * y[n][0] + y[n][1] * y[n][1]) + (y[n][2] * y[n][2] + y[n][3] * y[n][3]); }
    s2 = xrow_sum(s2);
    const float rstd = rsqrtf(s2 * (1.0f / 64.0f) + 64e-5f);
#pragma unroll
    for (int n = 0; n < 4; ++n) { const int cch = h * 64 + 16 * n + 4 * q;
        const f32x4 muv = *(const f32x4*)(mu + 1024 + cch), lg = *(const f32x4*)(ln_g + cch), lb = *(const f32x4*)(ln_b + cch);
        const float cv[4] = {bf_lo(x.cv[n].x), bf_hi(x.cv[n].x), bf_lo(x.cv[n].y), bf_hi(x.cv[n].y)};
        const float pv[4] = {first ? 0.f : bf_lo(x.pv[n].x), first ? 0.f : bf_hi(x.pv[n].x), first ? 0.f : bf_lo(x.pv[n].y), first ? 0.f : bf_hi(x.pv[n].y)};
        const float gg[4] = {bf_lo(x.gw[n].x), bf_hi(x.gw[n].x), bf_lo(x.gw[n].y), bf_hi(x.gw[n].y)};
        float o[4];
#pragma unroll
        for (int g = 0; g < 4; ++g) { const float vsh = cv[g] + muv[g] * (pv[g] - cv[g]); o[g] = (y[n][g] * rstd * lg[g] + lb[g] + x.bn * vsh) * gg[g]; }
        u32x2 ow; ow.x = cvt_pk_bf16(o[0], o[1]); ow.y = cvt_pk_bf16(o[2], o[3]);
        *(u32x2*)(yrw + tok * 512 + cch) = ow; }
}
DI void p_rw_out(const Frame& F) {
    const bf16_t* gQ = (const bf16_t*)(F.ws + WS_CHK_Q); const bf16_t* gY0 = (const bf16_t*)(F.ws + WS_CHK_Y0T); const bf16_t* gHT = (const bf16_t*)(F.ws + WS_CHK_HT);
    const bf16_t* prw = (const bf16_t*)(F.ws + WS_PRW); const bf16_t* lwag = (const bf16_t*)(F.ws + WS_LWAG); const float* bonus = (const float*)(F.ws + WS_BONUS);
    bf16_t* yrw = (bf16_t*)(F.ws + WS_YRW);
    const float* mu = F.in[13]; const float* ln_g = F.in[22]; const float* ln_b = F.in[23];
    const int r = F.lane & 15, q = F.lane >> 4, stride = F.G * NWAVES, NIT = RW_NCH * 4;
    for (int item = F.bid * NWAVES + F.wave; item < NIT; item += 2 * stride) {
        const int item2 = (item + stride < NIT) ? item + stride : item;
        RcIn xa, xb;
        rc_load(xa, gQ, gY0, gHT, prw, lwag, bonus, item, r, q); rc_load(xb, gQ, gY0, gHT, prw, lwag, bonus, item2, r, q);
        rc_compute(xa, yrw, mu, ln_g, ln_b, item, r, q); rc_compute(xb, yrw, mu, ln_g, ln_b, item2, r, q);
    }
}

DI void p_moe_prep(const Frame& F) {
    const bf16_t* hb = (const bf16_t*)(F.ws + WS_HB); float* rsv = (float*)(F.ws + WS_RS); unsigned char* out8 = (unsigned char*)(F.ws + WS_XN2F8); const float* g = F.in[26];
    const int stride = F.G * NWAVES;
    for (int row = F.bid * NWAVES + F.wave; row < T; row += 2 * stride) {
        const int row2 = (row + stride < T) ? row + stride : row;
        u32x4 a[2], b[2];
        a[0] = *(const u32x4*)(hb + (size_t)row * D + F.lane * 16); a[1] = *(const u32x4*)(hb + (size_t)row * D + F.lane * 16 + 8);
        b[0] = *(const u32x4*)(hb + (size_t)row2 * D + F.lane * 16); b[1] = *(const u32x4*)(hb + (size_t)row2 * D + F.lane * 16 + 8);
        float v[16], u[16]; float ss = 0.f, su = 0.f;
#pragma unroll
        for (int j = 0; j < 8; ++j) { v[2 * j] = bf_lo(a[j >> 2][j & 3]); v[2 * j + 1] = bf_hi(a[j >> 2][j & 3]); u[2 * j] = bf_lo(b[j >> 2][j & 3]); u[2 * j + 1] = bf_hi(b[j >> 2][j & 3]); }
#pragma unroll
        for (int j = 0; j < 16; ++j) { ss += v[j] * v[j]; su += u[j] * u[j]; }
        ss = wave_sum(ss); su = wave_sum(su);
        const float rs = rsqrtf(ss * (1.0f / D) + 1e-5f), ru = rsqrtf(su * (1.0f / D) + 1e-5f);
        float gv[16];
#pragma unroll
        for (int q = 0; q < 4; ++q) { const f32x4 t = *(const f32x4*)(g + F.lane * 16 + q * 4); gv[4 * q] = t[0]; gv[4 * q + 1] = t[1]; gv[4 * q + 2] = t[2]; gv[4 * q + 3] = t[3]; }
#pragma unroll
        for (int j = 0; j < 16; ++j) { v[j] *= rs * gv[j]; u[j] *= ru * gv[j]; }
        u32x4 q0, q1;
        if (F.lane == 0) { rsv[row] = rs; rsv[row2] = ru; }
        q0.x = pk4_fp8(v[0] * F8_SX, v[1] * F8_SX, v[2] * F8_SX, v[3] * F8_SX); q0.y = pk4_fp8(v[4] * F8_SX, v[5] * F8_SX, v[6] * F8_SX, v[7] * F8_SX);
        q0.z = pk4_fp8(v[8] * F8_SX, v[9] * F8_SX, v[10] * F8_SX, v[11] * F8_SX); q0.w = pk4_fp8(v[12] * F8_SX, v[13] * F8_SX, v[14] * F8_SX, v[15] * F8_SX);
        q1.x = pk4_fp8(u[0] * F8_SX, u[1] * F8_SX, u[2] * F8_SX, u[3] * F8_SX); q1.y = pk4_fp8(u[4] * F8_SX, u[5] * F8_SX, u[6] * F8_SX, u[7] * F8_SX);
        q1.z = pk4_fp8(u[8] * F8_SX, u[9] * F8_SX, u[10] * F8_SX, u[11] * F8_SX); q1.w = pk4_fp8(u[12] * F8_SX, u[13] * F8_SX, u[14] * F8_SX, u[15] * F8_SX);
        *(u32x4*)(out8 + (size_t)row * D + F.lane * 16) = q0; *(u32x4*)(out8 + (size_t)row2 * D + F.lane * 16) = q1;
    }
    float* b1p = (float*)(F.ws + WS_B1P); const float* b1 = F.in[30]; CmSwi cm;
    for (int idx = F.bid * NTHR + F.tid; idx < 32 * 2048; idx += F.G * NTHR) { const int e = idx >> 11, n = idx & 2047; b1p[idx] = b1[e * 2048 + cm(n)]; }
}
DI void p_conv_part(const Frame& F, int part) {
    if (part == 0) conv_T8(F, F.in[29], (size_t)1024 * 2048, 2048, (unsigned char*)(F.ws + WS_W1), 2048, 1024, 32, MpSwi(), F8_SW, 0, 2048);
    else if (part == 1) conv_T8(F, F.in[29], (size_t)1024 * 2048, 2048, (unsigned char*)(F.ws + WS_W1), 2048, 1024, 32, MpSwi(), F8_SW, 2048, 4096);
    else conv_T8(F, F.in[31], (size_t)1024 * 1024, 1024, (unsigned char*)(F.ws + WS_W2), 1024, 1024, 32, MpId(), F8_SW);
}

DI void topk_rows(const Frame& F, int row0) {
    LAS unsigned* cnt = (LAS unsigned*)F.lds; LAS unsigned* base = cnt + 32;
    const float* logits = (const float*)(F.ws + WS_LOG); unsigned* epos = (unsigned*)(F.ws + WS_EPOS); float* gatev = (float*)(F.ws + WS_GATEV);
    const int pass = row0 / TPP;
    unsigned* gcnt = (unsigned*)(F.ws + WS_CTL) + CW_GCNT + pass * 32;
    if (F.tid < 32) cnt[F.tid] = 0u;
    __syncthreads();
    int e4[4] = {0, 0, 0, 0}; unsigned p4[4] = {0u, 0u, 0u, 0u}; float g4[4] = {0.f, 0.f, 0.f, 0.f};
    const int token = row0 + F.tid;
    if (F.tid < 256) {
        float l[32]; const float rsc = ((const float*)(F.ws + WS_RS))[token];
#pragma unroll
        for (int q = 0; q < 8; ++q) { const f32x4 v = *(const f32x4*)(logits + (size_t)token * 32 + q * 4), bq = *(const f32x4*)(F.in[28] + q * 4); l[q * 4] = v[0] * rsc + bq[0]; l[q * 4 + 1] = v[1] * rsc + bq[1]; l[q * 4 + 2] = v[2] * rsc + bq[2]; l[q * 4 + 3] = v[3] * rsc + bq[3]; }
        unsigned used = 0u; float tv[4];
#pragma unroll
        for (int k = 0; k < 4; ++k) { float best = -3.0e38f; int bi = 0;
#pragma unroll
            for (int e = 0; e < 32; ++e) { const bool ok = !((used >> e) & 1u) && (l[e] > best); best = ok ? l[e] : best; bi = ok ? e : bi; }
            used |= 1u << bi; e4[k] = bi; tv[k] = best; }
        const float m = tv[0]; float ex[4], sum = 0.f;
#pragma unroll
        for (int k = 0; k < 4; ++k) { ex[k] = __expf(tv[k] - m); sum += ex[k]; }
#pragma unroll
        for (int k = 0; k < 4; ++k) { g4[k] = ex[k] / sum; p4[k] = atomicAdd((unsigned*)&cnt[e4[k]], 1u); }
    }
    __syncthreads();
    if (F.tid < 32) base[F.tid] = __hip_atomic_fetch_add(&gcnt[F.tid], cnt[F.tid], __ATOMIC_RELAXED, __HIP_MEMORY_SCOPE_AGENT);
    __syncthreads();
    if (F.tid < 256) {
#pragma unroll
        for (int k = 0; k < 4; ++k) { epos[(size_t)token * 4 + k] = ((unsigned)e4[k] << 24) | (base[e4[k]] + p4[k]); gatev[(size_t)token * 4 + k] = g4[k]; }
    }
    __syncthreads();
}
DI void p_gather(const Frame& F, int pass) {
    LAS int* poff = (LAS int*)F.lds;
    LAS int* pcnt = poff + 40;
    unsigned* gcnt = (unsigned*)(F.ws + WS_CTL) + CW_GCNT + pass * 32;
    int* tile_e = (int*)(F.ws + WS_TILEE) + pass * TE_STRIDE;
    __syncthreads();
    if (F.tid == 0) { int acc = 0; for (int e = 0; e < 32; ++e) { poff[e] = acc; const int c = (int)__hip_atomic_load(&gcnt[e], __ATOMIC_RELAXED, __HIP_MEMORY_SCOPE_AGENT); pcnt[e] = c; acc += ((c + 255) >> 8) << 8; } poff[32] = acc; }
    __syncthreads();
    if (F.bid == 0) {
        const int nt = poff[32] >> 8;
        for (int t = F.tid; t < nt; t += NTHR) { int e = 0; for (int q = 1; q < 32; ++q) if (poff[q] <= t * 256) e = q; tile_e[1 + t] = e; }
        if (F.tid == 0) tile_e[0] = nt;
    }
    const unsigned* epos = (const unsigned*)(F.ws + WS_EPOS); const float* gatev = (const float*)(F.ws + WS_GATEV);
    int* slot = (int*)(F.ws + WS_SLOT); float* rowg = (float*)(F.ws + WS_ROWG) + (size_t)pass * MAXTILES * 256;
    int* rowtok = (int*)(F.ws + WS_ROWTOK) + (size_t)pass * MAXTILES * 256;
    for (int i = F.bid * NTHR + F.tid; i < 32 * 256; i += F.G * NTHR) { const int e = i >> 8, sl = poff[e] + pcnt[e] + (i & 255); if (sl < poff[e + 1]) rowtok[sl] = 0; }
    for (int i = F.bid * NTHR + F.tid; i < TPP * 4; i += F.G * NTHR) {
        const int token = pass * TPP + (i >> 2);
        const unsigned ep = epos[(size_t)pass * TPP * 4 + i]; const int sl = poff[ep >> 24] + (int)(ep & 0xffffffu);
        slot[(size_t)pass * TPP * 4 + i] = sl; rowg[sl] = gatev[(size_t)pass * TPP * 4 + i]; rowtok[sl] = token;
    }
    __syncthreads();
}
DI void p_combine(const Frame& F, int pass) {
    int tz_ = threadIdx.x; asm volatile("" : "+v"(tz_)); const int lane_ = tz_ & 63;
    const int* slot = (const int*)(F.ws + WS_SLOT); const unsigned char* y2 = (const unsigned char*)(F.ws + WS_XS) + (size_t)pass * PASS_BUF; const float* gf = F.in[33];
    for (int t = F.bid * NWAVES + F.wave; t < TPP; t += F.G * NWAVES) {
        const int token = pass * TPP + t;
        float v[16];
        { const bf16_t* hb = (const bf16_t*)(F.ws + WS_HB) + (size_t)token * D + lane_ * 16; const u32x4 h0 = *(const u32x4*)hb, h1 = *(const u32x4*)(hb + 8);
#pragma unroll
          for (int j = 0; j < 4; ++j) { v[2 * j] = bf_lo(h0[j]); v[2 * j + 1] = bf_hi(h0[j]); v[8 + 2 * j] = bf_lo(h1[j]); v[8 + 2 * j + 1] = bf_hi(h1[j]); } }
        u32x4 yw[4];
#pragma unroll
        for (int k = 0; k < 4; ++k) { const int s = slot[(size_t)token * 4 + k]; yw[k] = *(const u32x4*)(y2 + (size_t)s * D + lane_ * 16); }
#pragma unroll
        for (int k = 0; k < 4; ++k)
#pragma unroll
            for (int j = 0; j < 4; ++j) { const f32x2 lo = __builtin_amdgcn_cvt_pk_f32_fp8((int)yw[k][j], false), hi = __builtin_amdgcn_cvt_pk_f32_fp8((int)yw[k][j], true);
                v[4 * j] += lo[0] * (1.0f / F8_SY); v[4 * j + 1] += lo[1] * (1.0f / F8_SY); v[4 * j + 2] += hi[0] * (1.0f / F8_SY); v[4 * j + 3] += hi[1] * (1.0f / F8_SY); }
        float ss = 0.f;
#pragma unroll
        for (int j = 0; j < 16; ++j) ss += v[j] * v[j];
        ss = wave_sum(ss);
        const float rs = rsqrtf(ss * (1.0f / D) + 1e-5f);
        f32x4* orow = (f32x4*)(F.out + (size_t)token * D + lane_ * 16);
#pragma unroll
        for (int q = 0; q < 4; ++q) { const f32x4 gv = *(const f32x4*)(gf + lane_ * 16 + q * 4);
            orow[q] = (f32x4){v[q * 4] * rs * gv[0], v[q * 4 + 1] * rs * gv[1], v[q * 4 + 2] * rs * gv[2], v[q * 4 + 3] * rs * gv[3]}; }
    }
}

constexpr int N_PHASES = 18;
__global__ void __launch_bounds__(NTHR, 2) fwd_kernel(KArgs args) {
    extern __shared__ __attribute__((aligned(16))) unsigned char lds_raw[];
    Frame F; F.lds = (LAS unsigned char*)lds_raw; F.tid = threadIdx.x; F.lane = F.tid & 63; F.wave = __builtin_amdgcn_readfirstlane(F.tid >> 6);
    F.G = gridDim.x; F.bid = blockIdx.x; F.in = args.in; F.out = args.out; F.ws = args.ws;
    unsigned char* ws = args.ws;
    volatile LAS unsigned* MISC = (volatile LAS unsigned*)(F.lds + MISC_OFF);
    if (F.tid < 4) MISC[F.tid] = 0u;
    __syncthreads();
    XcdBarrier bar; bar.bar = (unsigned*)(ws + WS_CTL) + CW_BAR; bar.x = 0; bar.st = MISC;
    if (N_LAUNCH_MODE == 1) bar = xcd_barrier_post((unsigned*)(ws + WS_CTL) + CW_BAR, MISC);
    const int lo = args.ph_lo, hi = args.ph_hi;
#define IN(k) (lo <= (k) && (k) < hi)
#define REP(k) for (int _r = 0; _r < 1 + (int)((PROBE_MASK >> (k)) & 1u); ++_r)
#define SEAM(k) do { if (N_LAUNCH_MODE == 1 && IN(k) && IN((k) + 1)) xcd_barrier(bar); } while (0)
    bf16_t* gates = (bf16_t*)args.out;

    if (IN(0)) { REP(0) p0_prologue(F); SEAM(0); }
    if (IN(1)) {
        PlainSched S; S.init(ws + WS_XN, ws + WS_WIN, T, INC, D, D, D, F.G, F.bid);
        EpiWin E{(bf16_t*)(ws + WS_US5), (bf16_t*)(ws + WS_PRW), gates};
        REP(1) gemm_phase(F.lds, S, E); SEAM(1);
    }
    if (IN(2)) {
        GroupSched S; S.init(ws + WS_US5, ws + WS_WST, 512, LDU, 512, S5ROWS / BM, 1, F.G, F.bid);
        EpiS5State E{(float*)(ws + WS_SLOC)};
        REP(2) { gemm_phase(F.lds, S, E); p_rw_prep(F); } SEAM(2);
    }
    if (IN(3)) {
        REP(3) p_s5_carry(F);
        PlainSched S; S.init(ws + WS_ALORA, ws + WS_WLORA, T, 1536, 128, 256, 128, F.G, F.bid); S.akoff_pn = 4; S.akoff_bytes = 256;
        EpiLora E{(bf16_t*)(ws + WS_LWAG), F.in[14], F.in[16]};
        REP(3) gemm_phase(F.lds, S, E); SEAM(3);
    }
    if (IN(4)) {
        GroupSched S; S.init(ws + WS_US5, ws + WS_TOEP, LDU, LDU, LDU, S5ROWS / BM, 2, F.G, F.bid);
        EpiS5Out E{(bf16_t*)(ws + WS_YS)};
        REP(4) gemm_phase(F.lds, S, E); SEAM(4);
    }
    if (IN(5)) { REP(5) p_rw_chunk(F); SEAM(5); }
    if (IN(6)) { REP(6) p_rw_scan(F); SEAM(6); }
    if (IN(7)) { REP(7) p_rw_out(F); SEAM(7); }
    if (IN(8)) {
        PlainSched S; S.init(ws + WS_YS, ws + WS_WGLU, T, 2048, 512, 512, 512, F.G, F.bid);
        EpiGlu E{(bf16_t*)(ws + WS_XN), gates, (const float*)(ws + WS_BGLU)};
        if (F.bid & 1) p_conv_part(F, 0);
        gemm_phase(F.lds, S, E);
        if (!(F.bid & 1)) p_conv_part(F, 0);
        SEAM(8);
    }
    if (IN(9)) {
        PlainSched S; S.init(ws + WS_YRW, ws + WS_WO, T, 1024, 512, 512, 512, F.G, F.bid);
        EpiWo E{(bf16_t*)(ws + WS_XN), gates};
        if (F.bid & 1) p_conv_part(F, 1);
        gemm_phase(F.lds, S, E);
        if (!(F.bid & 1)) p_conv_part(F, 1);
        SEAM(9);
    }
    if (IN(10)) {
        PlainSched S; S.init(ws + WS_XN, ws + WS_WOUT, T, 1024, 1024, 1024, 1024, F.G, F.bid);
        EpiOut E{(bf16_t*)(ws + WS_HB), F.in[0]};
        if (F.bid & 1) p_conv_part(F, 2);
        gemm_phase(F.lds, S, E);
        if (!(F.bid & 1)) p_conv_part(F, 2);
        SEAM(10);
    }
    if (IN(11)) { REP(11) p_moe_prep(F); SEAM(11); }
    if (IN(12)) {
        PlainSched S; S.init(ws + WS_HB, ws + WS_WR, T, 256, 1024, 1024, 1024, F.G, F.bid);
        EpiRouter E{(float*)(ws + WS_LOG)};
        gemm_phase(F.lds, S, E);
        { Unit u; for (int i = 0; S.next(i, u); ++i) topk_rows(F, u.pm * BM); }
        SEAM(12);
    }
    if (IN(13)) { p_gather(F, 0); p_gather(F, 1); SEAM(13); }
#define MOE_G1(PASS, CIDX) \
            const int* te = (const int*)(ws + WS_TILEE) + (PASS) * TE_STRIDE; const int ntl = __builtin_amdgcn_readfirstlane(__hip_atomic_load(te, __ATOMIC_RELAXED, __HIP_MEMORY_SCOPE_AGENT)); \
            MoeSched<true> S; S.init(ws + WS_XN2F8, ws + WS_W1, te + 1, (const int*)(ws + WS_ROWTOK) + (size_t)(PASS) * MAXTILES * 256, ntl, 512, 8, F.G, (CIDX)); \
            EpiMoe1 E{(unsigned char*)(ws + WS_ACT) + (size_t)(PASS) * PASS_BUF, (const float*)(ws + WS_B1P)};
#define MOE_G2(PASS) \
            const int* te = (const int*)(ws + WS_TILEE) + (PASS) * TE_STRIDE; const int ntl = __builtin_amdgcn_readfirstlane(__hip_atomic_load(te, __ATOMIC_RELAXED, __HIP_MEMORY_SCOPE_AGENT)); \
            MoeSched<false> S; S.init(ws + WS_ACT + (size_t)(PASS) * PASS_BUF, ws + WS_W2, te + 1, nullptr, ntl, 512, 4, F.G, F.bid); \
            EpiMoe2 E{(unsigned char*)(ws + WS_XS) + (size_t)(PASS) * PASS_BUF, F.in[32], (const float*)(ws + WS_ROWG) + (size_t)(PASS) * MAXTILES * 256};
    if (IN(14)) { MOE_G1(0, F.bid) gemm_phase(F.lds, S, E); SEAM(14); }
    if (IN(15)) {
        { MOE_G2(0) gemm_phase(F.lds, S, E); }
        { MOE_G1(1, F.G - 1 - F.bid) gemm_phase(F.lds, S, E); }
        SEAM(15);
    }
    if (IN(16)) {
        if (F.bid & 1) p_combine(F, 0);
        { MOE_G2(1) gemm_phase(F.lds, S, E); }
        if (!(F.bid & 1)) p_combine(F, 0);
        SEAM(16);
    }
    if (IN(17)) { p_combine(F, 1); }
#undef MOE_G1
#undef MOE_G2
#undef IN
#undef SEAM
#undef REP
}

extern "C" void kernel_launch(void* const* d_in, const int* in_sizes, int n_in, void* d_out, int out_size, void* d_ws, size_t ws_size, hipStream_t stream) {
    static int grid = 0;
    if (grid == 0) {
        if (n_in != 34 || in_sizes[0] != T * D || out_size != T * D || ws_size < WS_END) { fprintf(stderr, "kernel_launch: unexpected shapes (n_in %d, in0 %d, out %d, ws %zu < %zu)\n", n_in, n_in > 0 ? in_sizes[0] : -1, out_size, ws_size, (size_t)WS_END); grid = -1; return; }
        int dev = 0, cus = 0, per_cu = 0;
        if (hipGetDevice(&dev) != hipSuccess || hipDeviceGetAttribute(&cus, hipDeviceAttributeMultiprocessorCount, dev) != hipSuccess) { grid = -1; return; }
        if (hipFuncSetAttribute((const void*)fwd_kernel, hipFuncAttributeMaxDynamicSharedMemorySize, LDS_BYTES) != hipSuccess) { fprintf(stderr, "kernel_launch: hipFuncSetAttribute failed\n"); grid = -1; return; }
        if (hipOccupancyMaxActiveBlocksPerMultiprocessor(&per_cu, (const void*)fwd_kernel, NTHR, LDS_BYTES) != hipSuccess || per_cu < 1) { fprintf(stderr, "kernel_launch: occupancy query says %d\n", per_cu); }
        (void)hipGetLastError();
        grid = cus;
    }
    if (grid < 0) return;
    (void)hipMemsetAsync((char*)d_ws + WS_CTL, 0, CTL_BYTES, stream);
    KArgs a{};
    for (int i = 0; i < 34; ++i) a.in[i] = (const float*)d_in[i];
    a.out = (float*)d_out; a.ws = (unsigned char*)d_ws;
    if (N_LAUNCH_MODE == 1) {
        a.ph_lo = 0; a.ph_hi = N_PHASES;
        hipLaunchKernelGGL(fwd_kernel, dim3(grid), dim3(NTHR), LDS_BYTES, stream, a);
    } else {
        for (int p = 0; p < N_PHASES; ++p) { a.ph_lo = p; a.ph_hi = p + 1; hipLaunchKernelGGL(fwd_kernel, dim3(grid), dim3(NTHR), LDS_BYTES, stream, a); }
    }
}
```

```cpp
#include <hip/hip_runtime.h>
#include <stdint.h>
#include <stdio.h>

#ifndef N_LAUNCH_MODE
#define N_LAUNCH_MODE 1
#endif

#ifndef GEMM_SP2
#define GEMM_SP2 1
#endif
#ifndef GEMM_ALIGN
#define GEMM_ALIGN 1
#endif
#ifndef PROBE_MASK
#define PROBE_MASK 0u
#endif
#define LAS __attribute__((address_space(3)))
#define DI __device__ __forceinline__
typedef unsigned short bf16_t;
typedef short bf16x8 __attribute__((ext_vector_type(8)));
typedef float f32x4 __attribute__((ext_vector_type(4)));
typedef float f32x2 __attribute__((ext_vector_type(2)));
typedef unsigned u32x4 __attribute__((ext_vector_type(4)));
typedef unsigned u32x2 __attribute__((ext_vector_type(2)));
typedef int i32x8 __attribute__((ext_vector_type(8)));
typedef int i32x4 __attribute__((ext_vector_type(4)));

constexpr int T = 65536, D = 1024, SEQ = 4096, NB = 16;
constexpr int INC = 4352, RWC = 1792;
constexpr int S5L = 32;
constexpr int S5NC = SEQ / S5L;
constexpr int S5ROWS = T / S5L;
constexpr int LDU = 16 * S5L + 128;
constexpr int NE = 32, TOPK = 4;
constexpr int NPASS = 2, TPP = T / NPASS;
constexpr int MAXTILES = (TPP * TOPK) / 256 + NE;
constexpr int NWAVES = 8, NTHR = 512;

constexpr size_t al(size_t x) { return (x + 4095) & ~(size_t)4095; }
constexpr size_t WS_CTL = 0, CTL_BYTES = 1 << 20;
constexpr size_t WS_WIN = WS_CTL + CTL_BYTES;
constexpr size_t WS_WGLU = WS_WIN + al((size_t)INC * D * 2);
constexpr size_t WS_WO = WS_WGLU + al((size_t)2048 * 512 * 2);
constexpr size_t WS_WOUT = WS_WO + al((size_t)1024 * 512 * 2);
constexpr size_t WS_WLORA = WS_WOUT + al((size_t)1024 * 1024 * 2);
constexpr size_t WS_WR = WS_WLORA + al((size_t)1536 * 256 * 2);
constexpr size_t WS_TOEP = WS_WR + al((size_t)256 * 1024 * 2);
constexpr size_t WS_WST = WS_TOEP + al((size_t)32 * 512 * LDU * 2);
constexpr size_t WS_BGLU = WS_WST + al((size_t)32 * 256 * 512 * 2);
constexpr size_t WS_B1P = WS_BGLU + al(2048 * 4);
constexpr size_t WS_SHARED = WS_B1P + al((size_t)32 * 2048 * 4);
constexpr size_t WS_PRW = WS_SHARED;
constexpr size_t WS_LWAG = WS_PRW + al((size_t)T * RWC * 2);
constexpr size_t WS_YS = WS_LWAG + al((size_t)T * 1536 * 2);
constexpr size_t WS_YRW = WS_YS + al((size_t)T * 512 * 2);
constexpr size_t WS_BONUS = WS_YRW + al((size_t)T * 512 * 2);
constexpr size_t WS_XN = WS_BONUS + al((size_t)T * 8 * 4);
constexpr size_t WS_US5 = WS_XN + al((size_t)T * D * 2);
constexpr size_t WS_ALORA = WS_US5 + al((size_t)32 * S5ROWS * LDU * 2);
constexpr size_t WS_SLOC = WS_ALORA + al((size_t)T * 256 * 2);
constexpr int RW_NCH = 128 * 64;
constexpr size_t CHK_BYTES = (size_t)RW_NCH * 4096 * 2;
constexpr size_t WS_CHK_M = WS_XN, WS_CHK_N0T = WS_CHK_M + CHK_BYTES, WS_CHK_Q = WS_CHK_N0T + CHK_BYTES, WS_CHK_Y0T = WS_CHK_Q + CHK_BYTES, WS_CHK_HT = WS_CHK_Y0T + CHK_BYTES;
constexpr size_t WS_MIX_END0 = WS_SLOC + al((size_t)32 * S5ROWS * 128 * 4);
constexpr size_t WS_MIX_END = (WS_CHK_HT + CHK_BYTES) > WS_MIX_END0 ? (WS_CHK_HT + CHK_BYTES) : WS_MIX_END0;
constexpr size_t WS_HB = WS_SHARED;
constexpr size_t WS_W1 = WS_HB + al((size_t)T * D * 2);
constexpr size_t WS_W2 = WS_W1 + al((size_t)32 * 2048 * 1024);
constexpr size_t WS_RS = WS_W2 + al((size_t)32 * 1024 * 1024);
constexpr size_t WS_LOG = WS_RS + al((size_t)T * 4);
constexpr size_t WS_EPOS = WS_LOG + al((size_t)T * 32 * 4);
constexpr size_t WS_GATEV = WS_EPOS + al((size_t)T * 4 * 4);
constexpr size_t WS_SLOT = WS_GATEV + al((size_t)T * 4 * 4);
constexpr size_t WS_ROWG = WS_SLOT + al((size_t)T * 4 * 4);
constexpr size_t WS_ROWTOK = WS_ROWG + al((size_t)NPASS * MAXTILES * 256 * 4);
constexpr size_t WS_TILEE = WS_ROWTOK + al((size_t)NPASS * MAXTILES * 256 * 4);
constexpr int TE_STRIDE = MAXTILES + 64;
constexpr size_t WS_XS = WS_TILEE + al((size_t)NPASS * (MAXTILES + 64) * 4);
constexpr size_t PASS_BUF = al((size_t)MAXTILES * 256 * 1024);
constexpr size_t WS_ACT = WS_XS + NPASS * PASS_BUF;
constexpr size_t WS_XN2F8 = WS_ACT + NPASS * PASS_BUF;
constexpr size_t WS_MOE_END = WS_XN2F8 + al((size_t)T * D);
static_assert(WS_W2 + (size_t)32 * 1024 * 1024 <= WS_SHARED + (size_t)T * RWC * 2, "converted expert weights must stay inside the (dead) PRW buffer while the GLU/Wo/out GEMM phases run");
constexpr size_t WS_END = WS_MIX_END > WS_MOE_END ? WS_MIX_END : WS_MOE_END;
static_assert(WS_END <= ((size_t)1 << 30), "workspace over 1 GiB");

constexpr int CW_BAR = 0;
constexpr int CW_GCNT = 4096;

constexpr float F8_SX = 16.f, F8_SW = 32.f, F8_SA = 4.f, F8_SY = 32.f;
constexpr int LDS_BYTES = 144 * 1024;
constexpr int MISC_OFF = 140 * 1024;

typedef __bf16 bf16x2_t __attribute__((ext_vector_type(2)));
DI unsigned cvt_pk_bf16(float lo, float hi) { f32x2 v = {lo, hi}; bf16x2_t b = __builtin_convertvector(v, bf16x2_t); return __builtin_bit_cast(unsigned, b); }
DI unsigned pk4_fp8(float a, float b, float c, float d) {
    a = fminf(fmaxf(a, -448.f), 448.f); b = fminf(fmaxf(b, -448.f), 448.f); c = fminf(fmaxf(c, -448.f), 448.f); d = fminf(fmaxf(d, -448.f), 448.f);
    int w = __builtin_amdgcn_cvt_pk_fp8_f32(a, b, 0, false); w = __builtin_amdgcn_cvt_pk_fp8_f32(c, d, w, true); return (unsigned)w; }
DI float bf_lo(unsigned u) { return __uint_as_float(u << 16); }
DI float bf_hi(unsigned u) { return __uint_as_float(u & 0xffff0000u); }
DI float bf2f(bf16_t b) { return __uint_as_float(((unsigned)b) << 16); }
DI bf16_t f2bf(float f) { return (bf16_t)(cvt_pk_bf16(f, 0.f) & 0xffffu); }
DI float fsigmoid(float x) { return __builtin_amdgcn_rcpf(1.0f + __expf(-x)); }
DI float ftanh(float x) { float e = __expf(2.0f * x); return 1.0f - 2.0f * __builtin_amdgcn_rcpf(e + 1.0f); }
DI float fgelu_tanh(float x) { float u = 0.7978845608f * (x + 0.044715f * x * x * x); return x * fsigmoid(2.0f * u); }
DI f32x2 lo2(const f32x4& v) { return __builtin_shufflevector(v, v, 0, 1); }
DI f32x2 hi2(const f32x4& v) { return __builtin_shufflevector(v, v, 2, 3); }
DI f32x2 pk_sigmoid_scaled(f32x2 x, float negk) {
    const f32x2 t = x * negk; f32x2 e; e.x = __builtin_amdgcn_exp2f(t.x); e.y = __builtin_amdgcn_exp2f(t.y);
    const f32x2 d = e + 1.0f; f32x2 r; r.x = __builtin_amdgcn_rcpf(d.x); r.y = __builtin_amdgcn_rcpf(d.y); return r; }
DI f32x2 pk_sigmoid(f32x2 x) { return pk_sigmoid_scaled(x, -1.44269504f); }
DI f32x2 pk_gelu_tanh(f32x2 x) { const f32x2 x2 = x * x; const f32x2 u = x * (x2 * (0.044715f * 0.7978845608f) + 0.7978845608f); return x * pk_sigmoid_scaled(u, -2.0f * 1.44269504f); }
DI unsigned pk4_fp8_nc(f32x2 a, f32x2 b) { int w = __builtin_amdgcn_cvt_pk_fp8_f32(a.x, a.y, 0, false); w = __builtin_amdgcn_cvt_pk_fp8_f32(b.x, b.y, w, true); return (unsigned)w; }
#define DPP_ROR_ADD(v, n) ((v) + __builtin_bit_cast(float, __builtin_amdgcn_update_dpp(0, __builtin_bit_cast(int, (v)), 0x120 + (n), 0xf, 0xf, false)))
DI float row_sum16(float v) { v = DPP_ROR_ADD(v, 8); v = DPP_ROR_ADD(v, 4); v = DPP_ROR_ADD(v, 2); v = DPP_ROR_ADD(v, 1); return v; }
DI float xrow_sum(float x) {
    float y = x;
    asm("s_nop 1\n\tv_permlane16_swap_b32 %0, %1\n\ts_nop 1" : "+v"(x), "+v"(y));
    x = x + y; y = x;
    asm("s_nop 1\n\tv_permlane32_swap_b32 %0, %1\n\ts_nop 1" : "+v"(x), "+v"(y));
    return x + y;
}
DI float wave_sum(float v) { return xrow_sum(row_sum16(v)); }
DI float sum16(float v) {
    v += __shfl_xor(v, 1); v += __shfl_xor(v, 2); v += __shfl_xor(v, 4); v += __shfl_xor(v, 8); return v;
}

#define XB_TMO      128
#define XB_XCNT(j)  (256  + 64 * (j))
#define XB_XSUB(j)  (1280 + 64 * (j))
#define XB_XGEN(j)  (2304 + 64 * (j))
#define XB_TOP      3328
#define XB_TOPGEN   3392
#define XCD_BAR_WORDS 3456
#define XB_SPIN_CAP (1u << 22)
DI unsigned xb_ld(unsigned* p)              { return __hip_atomic_load(p, __ATOMIC_RELAXED, __HIP_MEMORY_SCOPE_AGENT); }
DI unsigned xb_add(unsigned* p, unsigned v) { return __hip_atomic_fetch_add(p, v, __ATOMIC_RELAXED, __HIP_MEMORY_SCOPE_AGENT); }
DI unsigned xb_xcc_id() { return (unsigned)__builtin_amdgcn_s_getreg((3 << 11) | 20) & 0xFu; }
#define XB_SPIN(cond, bar) do { unsigned _sp = 0; while (cond) { __builtin_amdgcn_s_sleep(1); \
    if ((++_sp & 255u) == 0u) { if (xb_ld(&(bar)[XB_TMO])) break; if (_sp > XB_SPIN_CAP) { atomicAdd(&(bar)[XB_TMO], 1u); break; } } } } while (0)
struct XcdBarrier { unsigned* bar; unsigned x; volatile LAS unsigned* st; };
DI XcdBarrier xcd_barrier_post(unsigned* bar, volatile LAS unsigned* st) {
    XcdBarrier b; b.bar = bar; b.x = xb_xcc_id(); b.st = st;
    if (threadIdx.x == 0) (void)xb_add(&bar[XB_XCNT(b.x)], 1u);
    return b;
}
DI void xcd_barrier_complete(unsigned* bar, unsigned x, unsigned& nloc, unsigned& nx) {
    const unsigned G = gridDim.x * gridDim.y * gridDim.z;
    unsigned sum, cnt, mine, sp = 0u;
    for (;;) {
        sum = 0u; cnt = 0u; mine = 0u;
#pragma unroll
        for (unsigned j = 0; j < 16; ++j) { const unsigned c = xb_ld(&bar[XB_XCNT(j)]); sum += c; cnt += (c > 0u) ? 1u : 0u; mine = (j == x) ? c : mine; }
        if (sum == G) break;
        __builtin_amdgcn_s_sleep(1);
        if ((++sp & 255u) == 0u) { if (xb_ld(&bar[XB_TMO])) break; if (sp > XB_SPIN_CAP) { atomicAdd(&bar[XB_TMO], 1u); break; } }
    }
    nloc = mine > 0u ? mine : 1u; nx = cnt > 0u ? cnt : 1u;
}
DI void xcd_barrier(const XcdBarrier& b) {
    asm volatile("s_waitcnt vmcnt(0)" ::: "memory");
    __syncthreads();
    if (threadIdx.x == 0) {
        unsigned* bar = b.bar;
        __builtin_amdgcn_s_waitcnt(0);
        unsigned nloc = b.st[0], nx = b.st[1];
        if (nloc == 0u) { xcd_barrier_complete(bar, b.x, nloc, nx); b.st[0] = nloc; b.st[1] = nx; }
        const unsigned old = xb_add(&bar[XB_XSUB(b.x)], 1u);
        const unsigned gen = old / nloc;
        if (old + 1u == (gen + 1u) * nloc) {
            __builtin_amdgcn_fence(__ATOMIC_RELEASE, "agent");
            asm volatile("s_waitcnt vmcnt(0)" ::: "memory");
            const unsigned og = xb_add(&bar[XB_TOP], 1u);
            const unsigned tg = og / nx;
            if (og + 1u == (tg + 1u) * nx) xb_add(&bar[XB_TOPGEN], 1u);
            else XB_SPIN(xb_ld(&bar[XB_TOPGEN]) == tg, bar);
            __builtin_amdgcn_fence(__ATOMIC_ACQUIRE, "agent");
            xb_add(&bar[XB_XGEN(b.x)], 1u);
            asm volatile("s_waitcnt vmcnt(0)" ::: "memory");
        } else {
            XB_SPIN(xb_ld(&bar[XB_XGEN(b.x)]) == gen, bar);
            __builtin_amdgcn_fence(__ATOMIC_ACQUIRE, "agent");
            asm volatile("s_waitcnt vmcnt(0)" ::: "memory");
        }
    }
    __syncthreads();
}

constexpr int BM = 256, BK = 64, HALF = 128, HTB = HALF * BK * 2;
DI int lds_byte(int r, int c) { const int st = (r >> 4) * 2 + (c >> 5), rr = r & 15, cc = c & 31, ob = rr * 64 + cc * 2; return st * 1024 + (ob ^ (((ob >> 9) & 1) << 5)); }
DI void stage_rc(int b, int& R, int& C) { const int st = b / 1024, sb = b % 1024, swz = sb ^ (((sb >> 9) & 1) << 5); R = (st >> 1) * 16 + swz / 64; C = (st & 1) * 32 + (swz % 64) / 2; }
DI int perm32(int rho) { const int n = rho >> 4, i = rho & 15; return 8 * (i >> 2) + 4 * n + (i & 3); }
struct Unit { int pm, pn, aux; };

template <class Sched, class Epi>
DI void gemm_phase(LAS unsigned char* lds, const Sched& S, const Epi& E) {
    const int tid = threadIdx.x, wid = __builtin_amdgcn_readfirstlane(tid >> 6), lane = tid & 63, wr = wid >> 2, wc = wid & 3, fr = lane & 15, fq = lane >> 4;
    const int K = S.K, nt = K / BK;
    unsigned voffA[2], voffB[2];
#pragma unroll
    for (int i = 0; i < 2; ++i) { int R, C; stage_rc(tid * 16 + i * 8192, R, C); const int Rb = Epi::PERM ? ((R & ~31) + perm32(R & 31)) : R;
        voffA[i] = (unsigned)(R * S.lda + C) * 2u; voffB[i] = (unsigned)(Rb * S.ldb + C) * 2u; }
    const size_t kstep = (size_t)(BK * 2);
    const size_t hstepA = (size_t)HALF * S.lda * 2, hstepB = (size_t)HALF * S.ldb * 2;
    const unsigned ldsw = (unsigned)wid * 1024u;
    const int aoff = lds_byte(wr * 64 + fr, fq * 8), boff = lds_byte(wc * 32 + fr, fq * 8);
#define PG8_SA(b, h) (((b) * 2 + (h)) * HTB)
#define PG8_SB(b, h) ((4 + (b) * 2 + (h)) * HTB)
    const unsigned ldsbase = (unsigned)(size_t)lds;
#define PG8_STAGE(bufoff, gbase, voff) do { _Pragma("unroll") for (int _i = 0; _i < 2; ++_i) \
        asm volatile("s_mov_b32 m0, %0\n\ts_nop 0\n\tglobal_load_lds_dwordx4 %1, %2" :: "s"(ldsbase + (unsigned)(bufoff) + ldsw + (unsigned)(_i * 8192)), "v"((voff)[_i]), "s"((const char*)(gbase)) : "memory"); } while (0)
#define PG8_LDA(dst, b, h) do { _Pragma("unroll") for (int m = 0; m < 4; ++m) _Pragma("unroll") for (int k = 0; k < 2; ++k) dst[m][k] = *(const LAS bf16x8*)(lds + PG8_SA(b, h) + aoff + m * 2048 + k * 1024); } while (0)
#define PG8_LDB(dst, b, h) do { _Pragma("unroll") for (int n = 0; n < 2; ++n) _Pragma("unroll") for (int k = 0; k < 2; ++k) dst[n][k] = *(const LAS bf16x8*)(lds + PG8_SB(b, h) + boff + n * 2048 + k * 1024); } while (0)
#define PG8_MMA(ai, bj, At, Bt) do { __builtin_amdgcn_s_setprio(1); _Pragma("unroll") for (int m = 0; m < 4; ++m) _Pragma("unroll") for (int n = 0; n < 2; ++n) _Pragma("unroll") for (int k = 0; k < 2; ++k) \
        acc[ai][bj][m][n] = __builtin_amdgcn_mfma_f32_16x16x32_bf16(Bt[n][k], At[m][k], acc[ai][bj][m][n], 0, 0, 0); __builtin_amdgcn_s_setprio(0); } while (0)
#define PG8_WAIT_V(n) asm volatile("s_waitcnt vmcnt(" #n ")" ::: "memory")
#define PG8_WAIT_L(n) asm volatile("s_waitcnt lgkmcnt(" #n ")" ::: "memory")
#define PG8_BAR __builtin_amdgcn_s_barrier()
#define PG8_SCHED __builtin_amdgcn_sched_barrier(0)
    Unit cur, nxt; int ui = 0;
    if (!S.next(0, cur)) return;
    f32x4 acc[2][2][4][2];
#pragma unroll
    for (int a = 0; a < 2; ++a)
#pragma unroll
        for (int b = 0; b < 2; ++b)
#pragma unroll
            for (int m = 0; m < 4; ++m)
#pragma unroll
                for (int n = 0; n < 2; ++n) { if constexpr (Sched::FP8) { f32x2 z0_, z1_; asm volatile("v_pk_mov_b32 %0, 0, 0" : "=v"(z0_)); asm volatile("v_pk_mov_b32 %0, 0, 0" : "=v"(z1_)); acc[a][b][m][n] = (f32x4){z0_.x, z0_.y, z1_.x, z1_.y}; } else acc[a][b][m][n] = (f32x4){0.f, 0.f, 0.f, 0.f}; }
    bf16x8 At[4][2], B0[2][2], B1[2][2];
    i32x8 At8[4], B08[2], B18[2];
    const int aoff8a = lds_byte(wr * 64 + fr, 16 * fq) & ~16, boff8a = lds_byte(wc * 32 + fr, 16 * fq) & ~16;
#define PG8_LDA8(dst, b, h) do { _Pragma("unroll") for (int m = 0; m < 4; ++m) dst[m] = *(const LAS i32x8*)(lds + PG8_SA(b, h) + aoff8a + m * 2048); } while (0)
#define PG8_LDB8(dst, b, h) do { _Pragma("unroll") for (int n = 0; n < 2; ++n) dst[n] = *(const LAS i32x8*)(lds + PG8_SB(b, h) + boff8a + n * 2048); } while (0)
#define PG8_MMA8(ai, bj, At_, Bt_) do { __builtin_amdgcn_s_setprio(1); _Pragma("unroll") for (int m = 0; m < 4; ++m) _Pragma("unroll") for (int n = 0; n < 2; ++n) \
        acc[ai][bj][m][n] = __builtin_amdgcn_mfma_scale_f32_16x16x128_f8f6f4(Bt_[n], At_[m], acc[ai][bj][m][n], 0, 0, 0, 0x7f7f7f7f, 0, 0x7f7f7f7f); __builtin_amdgcn_s_setprio(0); } while (0)
#define XLDA(b, h) do { if constexpr (Sched::FP8) PG8_LDA8(At8, b, h); else PG8_LDA(At, b, h); } while (0)
#define XLDB0(b, h) do { if constexpr (Sched::FP8) PG8_LDB8(B08, b, h); else PG8_LDB(B0, b, h); } while (0)
#define XLDB1(b, h) do { if constexpr (Sched::FP8) PG8_LDB8(B18, b, h); else PG8_LDB(B1, b, h); } while (0)
#define XMMA0(ai, bj) do { if constexpr (Sched::FP8) PG8_MMA8(ai, bj, At8, B08); else PG8_MMA(ai, bj, At, B0); } while (0)
#define XMMA1(ai, bj) do { if constexpr (Sched::FP8) PG8_MMA8(ai, bj, At8, B18); else PG8_MMA(ai, bj, At, B1); } while (0)
    const char* cA = S.a_ptr(cur); const char* cB = S.b_ptr(cur);
    unsigned offA[2][2], offN[2][2];
    if constexpr (Sched::GATHER) {
#pragma unroll
        for (int h = 0; h < 2; ++h)
#pragma unroll
            for (int i = 0; i < 2; ++i) { int R, C; stage_rc(tid * 16 + i * 8192, R, C); offA[h][i] = S.a_rowoff(cur, h * HALF + R) + (unsigned)C * 2u; offN[h][i] = offA[h][i]; }
    }
#define A_STG(bufoff, plainptr, kt, h, nx) do { if constexpr (Sched::GATHER) { PG8_STAGE(bufoff, cA + (size_t)(kt) * kstep, offA[h]); } \
        else PG8_STAGE(bufoff, plainptr, voffA); } while (0)
    if constexpr (GEMM_SP2) {
        PG8_STAGE(PG8_SB(0, 0), cB, voffB); PG8_STAGE(PG8_SB(0, 1), cB + hstepB, voffB); A_STG(PG8_SA(0, 0), cA, 0, 0, false); A_STG(PG8_SA(0, 1), cA + hstepA, 0, 1, false);
        if (wr == 1) PG8_BAR;
        PG8_WAIT_V(2); PG8_BAR;
        PG8_STAGE(PG8_SB(1, 0), cB + kstep, voffB); A_STG(PG8_SA(1, 0), cA + kstep, 1, 0, false); PG8_STAGE(PG8_SB(1, 1), cB + hstepB + kstep, voffB);
        PG8_WAIT_V(6); PG8_BAR;
    } else {
    PG8_STAGE(PG8_SB(0, 0), cB, voffB); A_STG(PG8_SA(0, 0), cA, 0, 0, false); PG8_STAGE(PG8_SB(0, 1), cB + hstepB, voffB); A_STG(PG8_SA(0, 1), cA + hstepA, 0, 1, false);
    if (wr == 1) PG8_BAR;
    PG8_WAIT_V(4); PG8_BAR;
    PG8_STAGE(PG8_SB(1, 0), cB + kstep, voffB); A_STG(PG8_SA(1, 0), cA + kstep, 1, 0, false); PG8_STAGE(PG8_SB(1, 1), cB + hstepB + kstep, voffB);
    PG8_WAIT_V(6); PG8_BAR;
    }
    for (;;) {
        const bool has_next = S.next(ui + 1, nxt);
        const char* nA = has_next ? S.a_ptr(nxt) : cA; const char* nB = has_next ? S.b_ptr(nxt) : cB;
        for (int t = 0; t < nt; t += 2) {
            const bool last = (t == nt - 2);
            const char* a1 = cA + (size_t)(t + 1) * kstep;
            const char* a2 = last ? nA : cA + (size_t)(t + 2) * kstep; const char* b2 = last ? nB : cB + (size_t)(t + 2) * kstep;
            const char* a3 = a2 + kstep; const char* b3 = b2 + kstep;
            const int k2 = last ? 0 : t + 2, k3 = k2 + 1;
            if constexpr (GEMM_SP2) {
            XLDB0(0, 0); XLDB1(0, 1); PG8_SCHED; XLDA(0, 0); A_STG(PG8_SA(1, 1), a1 + hstepA, t + 1, 1, false);
            if constexpr (Sched::GATHER) {
                if (has_next && (t == nt - 4 || nt < 4)) {
#pragma unroll
                    for (int h = 0; h < 2; ++h)
#pragma unroll
                        for (int i = 0; i < 2; ++i) { int R, C; stage_rc(tid * 16 + i * 8192, R, C); offN[h][i] = S.a_rowoff(nxt, h * HALF + R) + (unsigned)C * 2u; } }
                if (last && has_next) { offA[0][0] = offN[0][0]; offA[0][1] = offN[0][1]; offA[1][0] = offN[1][0]; offA[1][1] = offN[1][1]; }
            }
            PG8_WAIT_V(8); PG8_WAIT_L(0); PG8_BAR; XMMA0(0, 0); XMMA1(0, 1); PG8_BAR; PG8_SCHED;
            XLDA(0, 1); PG8_STAGE(PG8_SB(0, 0), b2, voffB); PG8_STAGE(PG8_SB(0, 1), b2 + hstepB, voffB); A_STG(PG8_SA(0, 0), a2, k2, 0, last);
            PG8_WAIT_V(8); PG8_WAIT_L(0); PG8_BAR; XMMA0(1, 0); XMMA1(1, 1); PG8_BAR; PG8_SCHED;
            XLDB0(1, 0); XLDB1(1, 1); PG8_SCHED; XLDA(1, 0); A_STG(PG8_SA(0, 1), a2 + hstepA, k2, 1, last);
            PG8_WAIT_V(8); PG8_WAIT_L(0); PG8_BAR; XMMA0(0, 0); XMMA1(0, 1); PG8_BAR; PG8_SCHED;
            XLDA(1, 1); PG8_STAGE(PG8_SB(1, 0), b3, voffB); PG8_STAGE(PG8_SB(1, 1), b3 + hstepB, voffB); A_STG(PG8_SA(1, 0), a3, k3, 0, last);
            PG8_WAIT_V(8); PG8_WAIT_L(0); PG8_BAR; XMMA0(1, 0); XMMA1(1, 1); PG8_BAR; PG8_SCHED;
            } else {
            XLDB0(0, 0); PG8_SCHED; XLDA(0, 0); A_STG(PG8_SA(1, 1), a1 + hstepA, t + 1, 1, false);
            if constexpr (Sched::GATHER) {
                if (has_next && (t == nt - 4 || nt < 4)) {
#pragma unroll
                    for (int h = 0; h < 2; ++h)
#pragma unroll
                        for (int i = 0; i < 2; ++i) { int R, C; stage_rc(tid * 16 + i * 8192, R, C); offN[h][i] = S.a_rowoff(nxt, h * HALF + R) + (unsigned)C * 2u; } }
                if (last && has_next) { offA[0][0] = offN[0][0]; offA[0][1] = offN[0][1]; offA[1][0] = offN[1][0]; offA[1][1] = offN[1][1]; }
            }
            PG8_WAIT_L(8); PG8_BAR; PG8_WAIT_L(0); XMMA0(0, 0); PG8_BAR; PG8_SCHED;
            XLDB1(0, 1); PG8_STAGE(PG8_SB(0, 0), b2, voffB);
            PG8_BAR; PG8_WAIT_L(0); XMMA1(0, 1); PG8_BAR;
            XLDA(0, 1); A_STG(PG8_SA(0, 0), a2, k2, 0, last);
            PG8_BAR; PG8_WAIT_L(0); XMMA0(1, 0); PG8_BAR; PG8_SCHED;
            PG8_STAGE(PG8_SB(0, 1), b2 + hstepB, voffB);
            PG8_WAIT_V(6); PG8_BAR; XMMA1(1, 1); PG8_BAR;
            XLDB0(1, 0); PG8_SCHED; XLDA(1, 0); A_STG(PG8_SA(0, 1), a2 + hstepA, k2, 1, last);
            PG8_WAIT_L(8); PG8_BAR; PG8_WAIT_L(0); XMMA0(0, 0); PG8_BAR; PG8_SCHED;
            XLDB1(1, 1); PG8_STAGE(PG8_SB(1, 0), b3, voffB);
            PG8_BAR; PG8_WAIT_L(0); XMMA1(0, 1); PG8_BAR;
            XLDA(1, 1); A_STG(PG8_SA(1, 0), a3, k3, 0, last);
            PG8_BAR; PG8_WAIT_L(0); XMMA0(1, 0); PG8_BAR; PG8_SCHED;
            PG8_STAGE(PG8_SB(1, 1), b3 + hstepB, voffB);
            PG8_WAIT_V(6); PG8_BAR; XMMA1(1, 1); PG8_BAR;
            }
        }
        if constexpr (GEMM_ALIGN) { if (wr == 0) PG8_BAR; }
        {
            int tz = threadIdx.x; asm volatile("" : "+v"(tz));
            const int wid2 = tz >> 6, lane2 = tz & 63;
            E(acc, cur, wid2 >> 2, wid2 & 3, lane2 & 15, lane2 >> 4); }
        if (!has_next) break;
#pragma unroll
        for (int a = 0; a < 2; ++a)
#pragma unroll
            for (int b = 0; b < 2; ++b)
#pragma unroll
                for (int m = 0; m < 4; ++m)
#pragma unroll
                    for (int n = 0; n < 2; ++n) { if constexpr (Sched::FP8) { f32x2 z0_, z1_; asm volatile("v_pk_mov_b32 %0, 0, 0" : "=v"(z0_)); asm volatile("v_pk_mov_b32 %0, 0, 0" : "=v"(z1_)); acc[a][b][m][n] = (f32x4){z0_.x, z0_.y, z1_.x, z1_.y}; } else acc[a][b][m][n] = (f32x4){0.f, 0.f, 0.f, 0.f}; }
        cur = nxt; cA = nA; cB = nB; ++ui;
        if constexpr (GEMM_ALIGN) { if (wr == 1) PG8_BAR; }
    }
    PG8_WAIT_V(0);
    if constexpr (!GEMM_ALIGN) { if (wr == 0) PG8_BAR; }
    PG8_BAR;
#undef XLDA
#undef XLDB0
#undef XLDB1
#undef XMMA0
#undef XMMA1
#undef PG8_LDA8
#undef PG8_LDB8
#undef PG8_MMA8
#undef A_STG
#undef PG8_SA
#undef PG8_SB
#undef PG8_STAGE
#undef PG8_LDA
#undef PG8_LDB
#undef PG8_MMA
#undef PG8_WAIT_V
#undef PG8_WAIT_L
#undef PG8_BAR
#undef PG8_SCHED
}

struct PlainSched {
    static constexpr bool GATHER = false, FP8 = false;
    const char* A; const char* B; int K, lda, ldb, nM, nN, nwg, G, c; int akoff_pn = 1 << 30, akoff_bytes = 0;
    DI void init(const void* A_, const void* B_, int M, int N, int K_, int lda_, int ldb_, int G_, int c_) { A = (const char*)A_; B = (const char*)B_; K = K_; lda = lda_; ldb = ldb_; nM = M / BM; nN = N / BM; nwg = nM * nN; G = G_; c = c_; }
    DI bool next(int i, Unit& u) const {
        const long L = (long)i * G + c; if (L >= nwg) return false;
        int wgid = (int)L; { const int q = nwg / 8, r = nwg % 8, xcd = wgid % 8, off = wgid / 8; wgid = (xcd < r ? xcd * (q + 1) : r * (q + 1) + (xcd - r) * q) + off; }
        const int nig = 8 * nN, gid = wgid / nig, fm = gid * 8, gsz = (nM - fm) < 8 ? (nM - fm) : 8;
        u.pm = fm + ((wgid % nig) % gsz); u.pn = (wgid % nig) / gsz; u.aux = 0; return true;
    }
    DI const char* a_ptr(const Unit& u) const { return A + (size_t)u.pm * BM * lda * 2 + (u.pn >= akoff_pn ? akoff_bytes : 0); }
    DI const char* b_ptr(const Unit& u) const { return B + (size_t)u.pn * BM * ldb * 2; }
};
struct GroupSched {
    static constexpr bool GATHER = false, FP8 = false;
    const char* A; const char* B; int K, lda, ldb, nMg, nN, nwg, G, c;
    DI void init(const void* A_, const void* B_, int K_, int lda_, int ldb_, int nMg_, int nN_, int G_, int c_) { A = (const char*)A_; B = (const char*)B_; K = K_; lda = lda_; ldb = ldb_; nMg = nMg_; nN = nN_; nwg = 32 * nMg * nN; G = G_; c = c_; }
    DI bool next(int i, Unit& u) const {
        const int L = i * G + c; if (L >= nwg) return false;
        const int per = nMg * nN, g = L / per, rem = L % per; u.pm = g * nMg + rem / nN; u.pn = rem % nN; u.aux = g; return true;
    }
    DI const char* a_ptr(const Unit& u) const { return A + (size_t)u.pm * BM * lda * 2; }
    DI const char* b_ptr(const Unit& u) const { return B + ((size_t)u.aux * nN + u.pn) * BM * ldb * 2; }
};
template <bool GATH>
struct MoeSched {
    static constexpr bool GATHER = GATH, FP8 = true;
    const char* A; const char* B; const int* tile_e; const int* rowtok; int K, lda, ldb, nN, NperE, nwg, G, c;
    DI void init(const void* A_, const void* B_, const int* te, const int* rt, int ntiles, int K_, int nN_, int G_, int c_) { A = (const char*)A_; B = (const char*)B_; tile_e = te; rowtok = rt; K = K_; lda = K_; ldb = K_; nN = nN_; NperE = nN_ * BM; nwg = ntiles * nN_; G = G_; c = c_; }
    DI bool next(int i, Unit& u) const {
        int L = i * G + c; if (L >= nwg) return false;
        if (G == 256 && (i + 1) * G <= nwg) { const int x = c & 7, sl = c >> 3, mt = G / nN / 8;
            L = i * G + (x * mt + sl / nN) * nN + (sl % nN); }
        u.pm = L / nN; u.pn = L % nN; u.aux = __builtin_amdgcn_readfirstlane(__hip_atomic_load(tile_e + u.pm, __ATOMIC_RELAXED, __HIP_MEMORY_SCOPE_AGENT)); return true;
    }
    DI const char* a_ptr(const Unit& u) const { return GATH ? A : A + (size_t)u.pm * BM * lda * 2; }
    DI unsigned a_rowoff(const Unit& u, int row) const { return (unsigned)__hip_atomic_load(rowtok + u.pm * BM + row, __ATOMIC_RELAXED, __HIP_MEMORY_SCOPE_AGENT) * (unsigned)(lda * 2); }
    DI const char* b_ptr(const Unit& u) const { return B + ((size_t)u.aux * NperE + (size_t)u.pn * BM) * ldb * 2; }
};

typedef f32x4 AccT[2][2][4][2];
struct EpiWin {
    static constexpr bool PERM = true;
    bf16_t* us5; bf16_t* prw; bf16_t* gates;
    DI static u32x4 pack8(const f32x4& v0, const f32x4& v1) { u32x4 w; w.x = cvt_pk_bf16(v0[0], v0[1]); w.y = cvt_pk_bf16(v0[2], v0[3]); w.z = cvt_pk_bf16(v1[0], v1[1]); w.w = cvt_pk_bf16(v1[2], v1[3]); return w; }
    DI void operator()(const AccT& acc, const Unit& u, int wr, int wc, int fr, int fq) const {
        if (u.pn < 2) {
#pragma unroll
            for (int ai = 0; ai < 2; ++ai)
#pragma unroll
                for (int m = 0; m < 4; ++m) { const int r = u.pm * BM + ai * HALF + wr * 64 + m * 16 + fr, b = r >> 12, sq = r & 4095, ch = sq / S5L, j = sq % S5L;
#pragma unroll
                    for (int bj = 0; bj < 2; ++bj) { const int c0 = u.pn * BM + bj * HALF + wc * 32 + 8 * fq, g = c0 >> 4, ci = c0 & 15;
                        *(u32x4*)(us5 + ((size_t)(g * S5ROWS + b * S5NC + ch) * LDU + j * 16 + ci)) = pack8(acc[ai][bj][m][0], acc[ai][bj][m][1]); } }
        } else if (u.pn < 9) {
#pragma unroll
            for (int ai = 0; ai < 2; ++ai)
#pragma unroll
                for (int m = 0; m < 4; ++m) { const int r = u.pm * BM + ai * HALF + wr * 64 + m * 16 + fr;
#pragma unroll
                    for (int bj = 0; bj < 2; ++bj) { const int c0 = u.pn * BM + bj * HALF + wc * 32 + 8 * fq;
                        *(u32x4*)(prw + (size_t)r * RWC + (c0 - 512)) = pack8(acc[ai][bj][m][0], acc[ai][bj][m][1]); } }
        } else {
#pragma unroll
            for (int ai = 0; ai < 2; ++ai)
#pragma unroll
                for (int m = 0; m < 4; ++m) { const int r = u.pm * BM + ai * HALF + wr * 64 + m * 16 + fr;
#pragma unroll
                    for (int bj = 0; bj < 2; ++bj) { const int c0 = u.pn * BM + bj * HALF + wc * 32 + 8 * fq;
                        const f32x4& v0 = acc[ai][bj][m][0]; const f32x4& v1 = acc[ai][bj][m][1];
                        const f32x2 a_ = pk_sigmoid(lo2(v0)), b_ = pk_sigmoid(hi2(v0)), c_ = pk_sigmoid(lo2(v1)), d_ = pk_sigmoid(hi2(v1));
                        u32x4 w; w.x = cvt_pk_bf16(a_.x, a_.y); w.y = cvt_pk_bf16(b_.x, b_.y); w.z = cvt_pk_bf16(c_.x, c_.y); w.w = cvt_pk_bf16(d_.x, d_.y);
                        *(u32x4*)(gates + (size_t)r * 2048 + (c0 - 2304)) = w; } }
        }
    }
};
struct EpiS5State {
    static constexpr bool PERM = false;
    float* sloc;
    DI void operator()(const AccT& acc, const Unit& u, int wr, int wc, int fr, int fq) const {
#pragma unroll
        for (int ai = 0; ai < 2; ++ai)
#pragma unroll
            for (int m = 0; m < 4; ++m) {
                const int r = u.pm * BM + ai * HALF + wr * 64 + m * 16 + fr;
#pragma unroll
                for (int n = 0; n < 2; ++n) *(f32x4*)(sloc + (size_t)r * 128 + wc * 32 + 16 * n + 4 * fq) = acc[ai][0][m][n];
            }
    }
};
struct EpiS5Out {
    static constexpr bool PERM = true;
    bf16_t* ys;
    DI void operator()(const AccT& acc, const Unit& u, int wr, int wc, int fr, int fq) const {
        const int g = u.aux;
#pragma unroll
        for (int ai = 0; ai < 2; ++ai)
#pragma unroll
            for (int m = 0; m < 4; ++m) {
                const int r = u.pm * BM + ai * HALF + wr * 64 + m * 16 + fr;
                const int rc = r - g * S5ROWS;
#pragma unroll
                for (int bj = 0; bj < 2; ++bj) {
                    const int c0 = u.pn * BM + bj * HALF + wc * 32 + 8 * fq;
                    const int t = c0 >> 4, co = c0 & 15;
                    const size_t tok = (size_t)rc * S5L + t;
                    f32x4 v0 = acc[ai][bj][m][0], v1 = acc[ai][bj][m][1];
                    { const f32x2 a_ = pk_gelu_tanh(lo2(v0)), b_ = pk_gelu_tanh(hi2(v0)), c_ = pk_gelu_tanh(lo2(v1)), d_ = pk_gelu_tanh(hi2(v1));
                      v0 = (f32x4){a_.x, a_.y, b_.x, b_.y}; v1 = (f32x4){c_.x, c_.y, d_.x, d_.y}; }
                    u32x4 w; w.x = cvt_pk_bf16(v0[0], v0[1]); w.y = cvt_pk_bf16(v0[2], v0[3]); w.z = cvt_pk_bf16(v1[0], v1[1]); w.w = cvt_pk_bf16(v1[2], v1[3]);
                    *(u32x4*)(ys + tok * 512 + g * 16 + co) = w;
                }
            }
    }
};
struct EpiLora {
    static constexpr bool PERM = true;
    bf16_t* lwag; const float* w0; const float* a0;
    DI void operator()(const AccT& acc, const Unit& u, int wr, int wc, int fr, int fq) const {
#pragma unroll
        for (int bj = 0; bj < 2; ++bj) {
            const int c0 = u.pn * BM + bj * HALF + wc * 32 + 8 * fq;
            f32x4 b0 = (f32x4){0.f, 0.f, 0.f, 0.f}, b1 = b0;
            if (c0 < 512) { b0 = *(const f32x4*)(w0 + c0); b1 = *(const f32x4*)(w0 + c0 + 4); } else if (c0 < 1024) { b0 = *(const f32x4*)(a0 + c0 - 512); b1 = *(const f32x4*)(a0 + c0 - 508); }
            const f32x2 bias[4] = {lo2(b0), hi2(b0), lo2(b1), hi2(b1)};
            const float osc = (c0 < 512) ? -0.6065306597f : 1.0f;
            if (c0 < 1024) {
#pragma unroll
                for (int ai = 0; ai < 2; ++ai)
#pragma unroll
                    for (int m = 0; m < 4; ++m) { const int r = u.pm * BM + ai * HALF + wr * 64 + m * 16 + fr; u32x4 w;
#pragma unroll
                        for (int jp = 0; jp < 4; ++jp) { const f32x4& a = acc[ai][bj][m][jp >> 1]; const f32x2 v = pk_sigmoid(((jp & 1) ? hi2(a) : lo2(a)) + bias[jp]) * osc; w[jp] = cvt_pk_bf16(v.x, v.y); }
                        *(u32x4*)(lwag + (size_t)r * 1536 + c0) = w; }
            } else {
#pragma unroll
                for (int ai = 0; ai < 2; ++ai)
#pragma unroll
                    for (int m = 0; m < 4; ++m) { const int r = u.pm * BM + ai * HALF + wr * 64 + m * 16 + fr; u32x4 w;
#pragma unroll
                        for (int jp = 0; jp < 4; ++jp) { const f32x4& a = acc[ai][bj][m][jp >> 1]; const f32x2 v = (jp & 1) ? hi2(a) : lo2(a); w[jp] = cvt_pk_bf16(v.x, v.y); }
                        *(u32x4*)(lwag + (size_t)r * 1536 + c0) = w; }
            }
        }
    }
};
struct EpiGlu {
    static constexpr bool PERM = true;
    bf16_t* mixed; const bf16_t* gates; const float* bglu;
    DI void operator()(const AccT& acc, const Unit& u, int wr, int wc, int fr, int fq) const {
        const int cw = wc * 32 + 8 * fq, j0 = u.pn * 128 + cw;
        const float* bp = bglu + u.pn * 256 + cw;
        const f32x4 ba0 = *(const f32x4*)bp, ba1 = *(const f32x4*)(bp + 4), bb0 = *(const f32x4*)(bp + 128), bb1 = *(const f32x4*)(bp + 132);
        const f32x2 ba[4] = {lo2(ba0), hi2(ba0), lo2(ba1), hi2(ba1)}, bb[4] = {lo2(bb0), hi2(bb0), lo2(bb1), hi2(bb1)};
        u32x4 gw[2][4];
#pragma unroll
        for (int ai = 0; ai < 2; ++ai)
#pragma unroll
            for (int m = 0; m < 4; ++m) gw[ai][m] = *(const u32x4*)(gates + (size_t)(u.pm * BM + ai * HALF + wr * 64 + m * 16 + fr) * 2048 + j0);
#pragma unroll
        for (int ai = 0; ai < 2; ++ai)
#pragma unroll
            for (int m = 0; m < 4; ++m) {
                const int r = u.pm * BM + ai * HALF + wr * 64 + m * 16 + fr;
                u32x4 w;
#pragma unroll
                for (int jp = 0; jp < 4; ++jp) {
                    const f32x4& aa = acc[ai][0][m][jp >> 1]; const f32x4& ab = acc[ai][1][m][jp >> 1];
                    const f32x2 za = ((jp & 1) ? hi2(aa) : lo2(aa)) + ba[jp], zb = ((jp & 1) ? hi2(ab) : lo2(ab)) + bb[jp];
                    const unsigned gwd = gw[ai][m][jp]; const f32x2 gt = {bf_lo(gwd), bf_hi(gwd)};
                    const f32x2 o = (gt * za) * pk_sigmoid(zb);
                    w[jp] = cvt_pk_bf16(o.x, o.y);
                }
                *(u32x4*)(mixed + (size_t)r * 1024 + j0) = w;
            }
    }
};
struct EpiWo {
    static constexpr bool PERM = true;
    bf16_t* mixed; const bf16_t* gates;
    DI void operator()(const AccT& acc, const Unit& u, int wr, int wc, int fr, int fq) const {
#pragma unroll
        for (int ai = 0; ai < 2; ++ai) {
            u32x4 gw[4][2], mw[4][2];
#pragma unroll
            for (int m = 0; m < 4; ++m)
#pragma unroll
                for (int bj = 0; bj < 2; ++bj) { const size_t r = (size_t)(u.pm * BM + ai * HALF + wr * 64 + m * 16 + fr); const int c0 = u.pn * BM + bj * HALF + wc * 32 + 8 * fq;
                    gw[m][bj] = *(const u32x4*)(gates + r * 2048 + 1024 + c0); mw[m][bj] = *(const u32x4*)(mixed + r * 1024 + c0); }
#pragma unroll
            for (int m = 0; m < 4; ++m)
#pragma unroll
                for (int bj = 0; bj < 2; ++bj) { const size_t r = (size_t)(u.pm * BM + ai * HALF + wr * 64 + m * 16 + fr); const int c0 = u.pn * BM + bj * HALF + wc * 32 + 8 * fq;
                    u32x4 w;
#pragma unroll
                    for (int jp = 0; jp < 4; ++jp) { const unsigned gwd = gw[m][bj][jp], mwd = mw[m][bj][jp]; const f32x4& a = acc[ai][bj][m][jp >> 1];
                        const f32x2 o = (f32x2){bf_lo(mwd), bf_hi(mwd)} + (f32x2){bf_lo(gwd), bf_hi(gwd)} * ((jp & 1) ? hi2(a) : lo2(a));
                        w[jp] = cvt_pk_bf16(o.x, o.y); }
                    *(u32x4*)(mixed + r * 1024 + c0) = w; }
        }
    }
};
struct EpiOut {
    static constexpr bool PERM = true;
    bf16_t* hb; const float* x;
    DI void operator()(const AccT& acc, const Unit& u, int wr, int wc, int fr, int fq) const {
#pragma unroll
        for (int ai = 0; ai < 2; ++ai) {
            f32x4 xv[4][2][2];
#pragma unroll
            for (int m = 0; m < 4; ++m) { const size_t r = (size_t)(u.pm * BM + ai * HALF + wr * 64 + m * 16 + fr);
#pragma unroll
                for (int bj = 0; bj < 2; ++bj) { const float* xp = x + r * 1024 + u.pn * BM + bj * HALF + wc * 32 + 8 * fq; xv[m][bj][0] = *(const f32x4*)xp; xv[m][bj][1] = *(const f32x4*)(xp + 4); } }
#pragma unroll
            for (int m = 0; m < 4; ++m) { const size_t r = (size_t)(u.pm * BM + ai * HALF + wr * 64 + m * 16 + fr);
#pragma unroll
                for (int bj = 0; bj < 2; ++bj) { const f32x4 v0 = xv[m][bj][0] + acc[ai][bj][m][0], v1 = xv[m][bj][1] + acc[ai][bj][m][1];
                    u32x4 w; w.x = cvt_pk_bf16(v0[0], v0[1]); w.y = cvt_pk_bf16(v0[2], v0[3]); w.z = cvt_pk_bf16(v1[0], v1[1]); w.w = cvt_pk_bf16(v1[2], v1[3]);
                    *(u32x4*)(hb + r * 1024 + u.pn * BM + bj * HALF + wc * 32 + 8 * fq) = w; } }
        }
    }
};
struct EpiRouter {
    static constexpr bool PERM = false;
    float* logits;
    DI void operator()(const AccT& acc, const Unit& u, int wr, int wc, int fr, int fq) const {
        if (wc != 0) return;
#pragma unroll
        for (int n = 0; n < 2; ++n) {
            const int c = 16 * n + 4 * fq;
#pragma unroll
            for (int ai = 0; ai < 2; ++ai)
#pragma unroll
                for (int m = 0; m < 4; ++m) {
                    const size_t r = (size_t)(u.pm * BM + ai * HALF + wr * 64 + m * 16 + fr);
                    *(f32x4*)(logits + r * 32 + c) = acc[ai][0][m][n];
                }
        }
    }
};
struct EpiMoe1 {
    static constexpr bool PERM = true;
    unsigned char* act; const float* b1p;
    DI void operator()(const AccT& acc, const Unit& u, int wr, int wc, int fr, int fq) const {
        const int cw = wc * 32 + 8 * fq, j0 = u.pn * 128 + cw;
        const float* bp = b1p + (size_t)u.aux * 2048 + u.pn * 256 + cw;
        const f32x4 ba0 = *(const f32x4*)bp, ba1 = *(const f32x4*)(bp + 4), bb0 = *(const f32x4*)(bp + 128), bb1 = *(const f32x4*)(bp + 132);
        const f32x2 ba[4] = {lo2(ba0), hi2(ba0), lo2(ba1), hi2(ba1)}, bb[4] = {lo2(bb0), hi2(bb0), lo2(bb1), hi2(bb1)};
        constexpr float sc = 1.0f / (F8_SX * F8_SW);
#pragma unroll
        for (int ai = 0; ai < 2; ++ai)
#pragma unroll
            for (int m = 0; m < 4; ++m) {
                const size_t r = (size_t)(u.pm * BM + ai * HALF + wr * 64 + m * 16 + fr);
                f32x2 o[4];
#pragma unroll
                for (int jp = 0; jp < 4; ++jp) {
                    const f32x4& ag = acc[ai][0][m][jp >> 1]; const f32x4& al_ = acc[ai][1][m][jp >> 1];
                    const f32x2 g = ((jp & 1) ? hi2(ag) : lo2(ag)) * sc + ba[jp], l = ((jp & 1) ? hi2(al_) : lo2(al_)) * sc + bb[jp];
                    const f32x2 xg = __builtin_elementwise_min(g, (f32x2){7.0f, 7.0f});
                    const f32x2 xl = __builtin_elementwise_min(__builtin_elementwise_max(l, (f32x2){-7.0f, -7.0f}), (f32x2){7.0f, 7.0f});
                    o[jp] = (xg * pk_sigmoid_scaled(xg, -1.702f * 1.44269504f)) * (xl * F8_SA + F8_SA);
                }
                u32x2 w; w.x = pk4_fp8_nc(o[0], o[1]); w.y = pk4_fp8_nc(o[2], o[3]);
                *(u32x2*)(act + r * 1024 + j0) = w;
            }
    }
};
struct EpiMoe2 {
    static constexpr bool PERM = true;
    unsigned char* y2; const float* b2; const float* rowg;
    DI void operator()(const AccT& acc, const Unit& u, int wr, int wc, int fr, int fq) const {
        float gt[2][4];
#pragma unroll
        for (int ai = 0; ai < 2; ++ai)
#pragma unroll
            for (int m = 0; m < 4; ++m) gt[ai][m] = rowg[(size_t)(u.pm * BM + ai * HALF + wr * 64 + m * 16 + fr)] * F8_SY;
#pragma unroll
        for (int bj = 0; bj < 2; ++bj) {
            const int c0 = u.pn * BM + bj * HALF + wc * 32 + 8 * fq;
            const f32x4 bva = *(const f32x4*)(b2 + (size_t)u.aux * 1024 + c0), bvb = *(const f32x4*)(b2 + (size_t)u.aux * 1024 + c0 + 4);
            const f32x2 bv[4] = {lo2(bva), hi2(bva), lo2(bvb), hi2(bvb)};
#pragma unroll
            for (int ai = 0; ai < 2; ++ai)
#pragma unroll
                for (int m = 0; m < 4; ++m) {
                    const size_t r = (size_t)(u.pm * BM + ai * HALF + wr * 64 + m * 16 + fr);
                    const float g = gt[ai][m];
                    f32x2 o[4];
#pragma unroll
                    for (int jp = 0; jp < 4; ++jp) { const f32x4& a = acc[ai][bj][m][jp >> 1];
                        o[jp] = (((jp & 1) ? hi2(a) : lo2(a)) * (1.0f / (F8_SA * F8_SW)) + bv[jp]) * g;
                        o[jp] = __builtin_elementwise_min(__builtin_elementwise_max(o[jp], (f32x2){-448.f, -448.f}), (f32x2){448.f, 448.f}); }
                    u32x2 w; w.x = pk4_fp8_nc(o[0], o[1]); w.y = pk4_fp8_nc(o[2], o[3]);
                    *(u32x2*)(y2 + r * 1024 + c0) = w;
                }
        }
    }
};
struct KArgs { const float* in[34]; float* out; unsigned char* ws; int ph_lo, ph_hi; };
struct Frame {
    LAS unsigned char* lds; int tid, lane, wave, G, bid;
    const float* const* in; float* out; unsigned char* ws;
};

template <class MP>
DI void conv_T(const Frame& F, const float* src, size_t src_bstride, int ld, bf16_t* dst, int N, int K, int nbatch, MP mp, int t0 = 0, int t1 = 0x7fffffff) {
    LAS unsigned* tile = (LAS unsigned*)F.lds;
    const int ntk = K / 64, ntn = N / 256, per = ntk * ntn;
    const int tend = (per * nbatch) < t1 ? (per * nbatch) : t1;
    for (int t = t0 + F.bid; t < tend; t += F.G) {
        const int bt = t / per, tt = t % per, tk = tt % ntk, pn = tt / ntk;
        const float* s = src + (size_t)bt * src_bstride + (size_t)(tk * 64) * ld + mp.src(pn, F.lane);
        f32x4 va[4], vb[4];
#pragma unroll
        for (int i = 0; i < 4; ++i) { const int kp = F.wave + 8 * i; va[i] = *(const f32x4*)(s + (size_t)(2 * kp) * ld); vb[i] = *(const f32x4*)(s + (size_t)(2 * kp + 1) * ld); }
#pragma unroll
        for (int i = 0; i < 4; ++i) { const int kp = F.wave + 8 * i;
#pragma unroll
            for (int j = 0; j < 4; ++j) tile[mp.dst(F.lane, j) * 33 + kp] = cvt_pk_bf16(va[i][j], vb[i][j]); }
        __syncthreads();
        unsigned* d = (unsigned*)(dst + (size_t)bt * N * K + (size_t)(pn * 256) * K + tk * 64);
#pragma unroll
        for (int i = 0; i < 4; ++i) { const int pc = F.tid + NTHR * i, nn = pc >> 3, seg = pc & 7;
            u32x4 w; w.x = tile[nn * 33 + seg * 4]; w.y = tile[nn * 33 + seg * 4 + 1]; w.z = tile[nn * 33 + seg * 4 + 2]; w.w = tile[nn * 33 + seg * 4 + 3];
            *(u32x4*)(d + ((size_t)nn * K) / 2 + seg * 4) = w; }
        __syncthreads();
    }
}
template <class MP>
DI void conv_T8(const Frame& F, const float* src, size_t src_bstride, int ld, unsigned char* dst, int N, int K, int nbatch, MP mp, float scale, int t0 = 0, int t1 = 0x7fffffff) {
    LAS unsigned* tile = (LAS unsigned*)F.lds;
    const int ntk = K / 64, ntn = N / 256, per = ntk * ntn;
    const int tend = (per * nbatch) < t1 ? (per * nbatch) : t1;
    for (int t = t0 + F.bid; t < tend; t += F.G) {
        const int bt = t / per, tt = t % per, tk = tt % ntk, pn = tt / ntk;
        const float* s = src + (size_t)bt * src_bstride + (size_t)(tk * 64) * ld + mp.src(pn, F.lane);
        f32x4 v[2][4];
#pragma unroll
        for (int i = 0; i < 2; ++i) { const int kq = F.wave + 8 * i;
#pragma unroll
            for (int e = 0; e < 4; ++e) v[i][e] = *(const f32x4*)(s + (size_t)(4 * kq + e) * ld); }
#pragma unroll
        for (int i = 0; i < 2; ++i) { const int kq = F.wave + 8 * i;
#pragma unroll
            for (int j = 0; j < 4; ++j) tile[mp.dst(F.lane, j) * 17 + kq] = pk4_fp8(v[i][0][j] * scale, v[i][1][j] * scale, v[i][2][j] * scale, v[i][3][j] * scale); }
        __syncthreads();
        unsigned char* d = dst + ((size_t)bt * N + (size_t)pn * 256) * K + tk * 64;
#pragma unroll
        for (int i = 0; i < 2; ++i) { const int pc = F.tid + NTHR * i, nn = pc >> 2, seg = pc & 3;
            u32x4 w; w.x = tile[nn * 17 + seg * 4]; w.y = tile[nn * 17 + seg * 4 + 1]; w.z = tile[nn * 17 + seg * 4 + 2]; w.w = tile[nn * 17 + seg * 4 + 3];
            *(u32x4*)(d + (size_t)nn * K + seg * 16) = w; }
        __syncthreads();
    }
}
struct MpId  { DI int src(int pn, int f) const { return pn * 256 + 4 * f; } DI int dst(int f, int j) const { return 4 * f + j; } };
struct MpSwi { DI int src(int pn, int f) const { return pn * 256 + 4 * f; } DI int dst(int f, int j) const { const int n = 4 * f + j; return (n >> 1) + 128 * (n & 1); } };
struct MpGlu { DI int src(int pn, int f) const { const int w = 4 * f; return pn * 128 + (w & 127) + 1024 * (w >> 7); } DI int dst(int f, int j) const { return 4 * f + j; } };
struct CmGlu { DI int operator()(int n) const { const int pn = n >> 8, w = n & 255; return pn * 128 + (w & 127) + 1024 * (w >> 7); } };
struct CmSwi { DI int operator()(int n) const { const int pn = n >> 8, w = n & 255; return 2 * (pn * 128 + (w & 127)) + (w >> 7); } };

DI void rmsnorm_rows(const Frame& F, const float* x, const float* g, bf16_t* out, int row0, int nrows, unsigned char* out8 = nullptr) {
    const int stride = F.G * NWAVES;
    for (int row = row0 + F.bid * NWAVES + F.wave; row < row0 + nrows; row += 2 * stride) {
        const int row2 = (row + stride < row0 + nrows) ? row + stride : row;
        const f32x4* xr = (const f32x4*)(x + (size_t)row * D); const f32x4* xr2 = (const f32x4*)(x + (size_t)row2 * D);
        f32x4 v[4], u[4]; float ss = 0.f, su = 0.f;
#pragma unroll
        for (int i = 0; i < 4; ++i) { v[i] = xr[i * 64 + F.lane]; u[i] = xr2[i * 64 + F.lane]; }
#pragma unroll
        for (int i = 0; i < 4; ++i) { ss += v[i][0] * v[i][0] + v[i][1] * v[i][1] + v[i][2] * v[i][2] + v[i][3] * v[i][3]; su += u[i][0] * u[i][0] + u[i][1] * u[i][1] + u[i][2] * u[i][2] + u[i][3] * u[i][3]; }
        ss = wave_sum(ss); su = wave_sum(su);
        const float rs = rsqrtf(ss * (1.0f / D) + 1e-5f), ru = rsqrtf(su * (1.0f / D) + 1e-5f);
#pragma unroll
        for (int i = 0; i < 4; ++i) { const f32x4 gv = ((const f32x4*)g)[i * 64 + F.lane];
            u32x2 w; w.x = cvt_pk_bf16(v[i][0] * rs * gv[0], v[i][1] * rs * gv[1]); w.y = cvt_pk_bf16(v[i][2] * rs * gv[2], v[i][3] * rs * gv[3]);
            *(u32x2*)(out + (size_t)row * D + (i * 64 + F.lane) * 4) = w;
            u32x2 w2; w2.x = cvt_pk_bf16(u[i][0] * ru * gv[0], u[i][1] * ru * gv[1]); w2.y = cvt_pk_bf16(u[i][2] * ru * gv[2], u[i][3] * ru * gv[3]);
            *(u32x2*)(out + (size_t)row2 * D + (i * 64 + F.lane) * 4) = w2;
            if (out8) { *(unsigned*)(out8 + (size_t)row * D + (i * 64 + F.lane) * 4) = pk4_fp8(v[i][0] * rs * gv[0] * F8_SX, v[i][1] * rs * gv[1] * F8_SX, v[i][2] * rs * gv[2] * F8_SX, v[i][3] * rs * gv[3] * F8_SX);
                *(unsigned*)(out8 + (size_t)row2 * D + (i * 64 + F.lane) * 4) = pk4_fp8(u[i][0] * ru * gv[0] * F8_SX, u[i][1] * ru * gv[1] * F8_SX, u[i][2] * ru * gv[2] * F8_SX, u[i][3] * ru * gv[3] * F8_SX); } }
    }
}

DI void p0_prologue(const Frame& F) {
    unsigned char* ws = F.ws;
    conv_T(F, F.in[2], 0, INC, (bf16_t*)(ws + WS_WIN), INC, D, 1, MpId());
    conv_T(F, F.in[11], 0, 2048, (bf16_t*)(ws + WS_WGLU), 2048, 512, 1, MpGlu());
    conv_T(F, F.in[24], 0, 1024, (bf16_t*)(ws + WS_WO), 1024, 512, 1, MpId());
    conv_T(F, F.in[25], 0, 1024, (bf16_t*)(ws + WS_WOUT), 1024, 1024, 1, MpId());
    {
        bf16_t* wl = (bf16_t*)(ws + WS_WLORA); const float* w2 = F.in[15]; const float* a2 = F.in[17]; const float* g2 = F.in[18];
        for (int idx = F.bid * NTHR + F.tid; idx < 1536 * 128; idx += F.G * NTHR) { const int n = idx >> 7, k = idx & 127; float v = 0.f;
            if (n < 512) { if (k < 64) v = w2[k * 512 + n]; } else if (n < 1024) { if (k >= 64) v = a2[(k - 64) * 512 + (n - 512)]; } else { v = g2[k * 512 + (n - 1024)]; }
            wl[idx] = f2bf(v); }
        bf16_t* wrt = (bf16_t*)(ws + WS_WR); const float* rw = F.in[27];
        for (int idx = F.bid * NTHR + F.tid; idx < 256 * 1024; idx += F.G * NTHR) { const int n = idx >> 10, k = idx & 1023; wrt[idx] = f2bf(n < 32 ? rw[k * 32 + n] * F.in[26][k] : 0.f); }
        float* bg = (float*)(ws + WS_BGLU); const float* bsrc = F.in[12]; CmGlu cm;
        for (int idx = F.bid * NTHR + F.tid; idx < 2048; idx += F.G * NTHR) bg[idx] = bsrc[cm(idx)];
    }
    if (F.bid & 1) rmsnorm_rows(F, F.in[0], F.in[1], (bf16_t*)(ws + WS_XN), 0, T);
    {
        LAS float* L = (LAS float*)F.lds;
        LAS float* pwr = L, *pwi = L + 64, *p1r = L + 128, *p1i = L + 192, *ffr = L + 256, *ffi = L + 320;
        LAS float* bbr = L + 384, *bbi = bbr + 1024, *ccr = bbi + 1024, *cci = ccr + 1024, *kj = cci + 1024;
        const float* lam_re = F.in[3]; const float* lam_im = F.in[4]; const float* log_dt = F.in[5];
        const float* b_re = F.in[6]; const float* b_im = F.in[7]; const float* c_re = F.in[8]; const float* c_im = F.in[9]; const float* dsk = F.in[10];
        unsigned* toep = (unsigned*)(ws + WS_TOEP); unsigned* wst = (unsigned*)(ws + WS_WST);
        for (int it = F.bid; it < 32 * S5L; it += F.G) {
            const int g = it / S5L, j = it % S5L;
            if (F.tid < 64) { const int p = F.tid; const float lr = lam_re[g * 64 + p], li = lam_im[g * 64 + p], dt = __expf(log_dt[g]);
                float sn, cs; { const float mg = expf((float)j * lr * dt); sincosf((float)j * (li * dt), &sn, &cs); pwr[p] = mg * cs; pwi[p] = mg * sn; }
                { const float mg = expf((float)(j + 1) * lr * dt); sincosf((float)(j + 1) * (li * dt), &sn, &cs); p1r[p] = mg * cs; p1i[p] = mg * sn; }
                { const float mg = expf(lr * dt); sincosf(li * dt, &sn, &cs); const float nr = mg * cs - 1.0f, ni = mg * sn, den = lr * lr + li * li;
                  ffr[p] = (nr * lr + ni * li) / den; ffi[p] = (ni * lr - nr * li) / den; } }
            __syncthreads();
            for (int idx = F.tid; idx < 1024; idx += NTHR) { const int p = idx >> 4; const float br = b_re[g * 1024 + idx], bi = b_im[g * 1024 + idx];
                bbr[idx] = ffr[p] * br - ffi[p] * bi; bbi[idx] = ffr[p] * bi + ffi[p] * br;
                ccr[idx] = c_re[g * 1024 + idx]; cci[idx] = c_im[g * 1024 + idx]; }
            __syncthreads();
            if (F.tid < 256) { const int co = F.tid >> 4, ci = F.tid & 15; float s = 0.f;
                for (int p = 0; p < 64; ++p) { const float zr = pwr[p] * bbr[p * 16 + ci] - pwi[p] * bbi[p * 16 + ci], zi = pwr[p] * bbi[p * 16 + ci] + pwi[p] * bbr[p * 16 + ci];
                    s += ccr[co * 64 + p] * zr - cci[co * 64 + p] * zi; }
                if (j == 0 && co == ci) s += dsk[g * 16 + co];
                kj[F.tid] = s; }
            __syncthreads();
            for (int idx = F.tid; idx < (S5L - j) * 128; idx += NTHR) { const int t = j + idx / 128, rem = idx % 128, co = rem >> 3, ci = (rem & 7) * 2;
                toep[((size_t)(g * 512 + t * 16 + co) * LDU + (t - j) * 16 + ci) / 2] = cvt_pk_bf16(kj[co * 16 + ci], kj[co * 16 + ci + 1]);
                if (j > 0) toep[((size_t)(g * 512 + (t - j) * 16 + co) * LDU + t * 16 + ci) / 2] = 0u; }
            for (int idx = F.tid; idx < 16 * 64; idx += NTHR) { const int co = idx >> 6, q = (idx & 63) * 2; float o[2];
#pragma unroll
                for (int e = 0; e < 2; ++e) { const int qq = q + e, p = qq & 63; const float cr = ccr[co * 64 + p], cim = cci[co * 64 + p];
                    o[e] = (qq < 64) ? (cr * p1r[p] - cim * p1i[p]) : -(cr * p1i[p] + cim * p1r[p]); }
                toep[((size_t)(g * 512 + j * 16 + co) * LDU + 512 + q) / 2] = cvt_pk_bf16(o[0], o[1]); }
            { const int s = S5L - 1 - j;
              for (int idx = F.tid; idx < 256 * 8; idx += NTHR) { const int q = idx >> 3, ci = (idx & 7) * 2; float o[2] = {0.f, 0.f};
                if (q < 128) { const int p = q & 63;
#pragma unroll
                    for (int e = 0; e < 2; ++e) { const float br = bbr[p * 16 + ci + e], bi = bbi[p * 16 + ci + e];
                        o[e] = (q < 64) ? (pwr[p] * br - pwi[p] * bi) : (pwr[p] * bi + pwi[p] * br); } }
                wst[((size_t)(g * 256 + q) * 512 + s * 16 + ci) / 2] = cvt_pk_bf16(o[0], o[1]); } }
            __syncthreads();
        }
    }
    if (!(F.bid & 1)) rmsnorm_rows(F, F.in[0], F.in[1], (bf16_t*)(ws + WS_XN), 0, T);
}

DI void p_rw_prep(const Frame& F) {
    const bf16_t* prw = (const bf16_t*)(F.ws + WS_PRW); bf16_t* al_ = (bf16_t*)(F.ws + WS_ALORA); const float* mu = F.in[13];
    for (int idx = F.bid * NTHR + F.tid; idx < T * 32; idx += F.G * NTHR) {
        const int t = idx >> 5, c8 = (idx & 31) * 8;
        const u32x4 cur = *(const u32x4*)(prw + (size_t)t * RWC + 1536 + c8);
        u32x4 prv = (u32x4){0u, 0u, 0u, 0u};
        if ((t & (SEQ - 1)) != 0) prv = *(const u32x4*)(prw + (size_t)(t - 1) * RWC + 1536 + c8);
        float o[8];
#pragma unroll
        for (int j = 0; j < 8; ++j) { const float c = (j & 1) ? bf_hi(cur[j >> 1]) : bf_lo(cur[j >> 1]), p = (j & 1) ? bf_hi(prv[j >> 1]) : bf_lo(prv[j >> 1]);
            const float xs = c + mu[1536 + c8 + j] * (p - c);
            o[j] = (c8 < 64) ? ftanh(xs) : ((c8 < 128) ? xs : fsigmoid(xs)); }
        u32x4 w; w.x = cvt_pk_bf16(o[0], o[1]); w.y = cvt_pk_bf16(o[2], o[3]); w.z = cvt_pk_bf16(o[4], o[5]); w.w = cvt_pk_bf16(o[6], o[7]);
        *(u32x4*)(al_ + (size_t)t * 256 + c8) = w;
    }
}

DI void p_s5_carry(const Frame& F) {
    const float* lam_re = F.in[3]; const float* lam_im = F.in[4]; const float* log_dt = F.in[5];
    const float* sloc = (const float*)(F.ws + WS_SLOC); bf16_t* us5 = (bf16_t*)(F.ws + WS_US5);
    for (int gt = F.bid * NTHR + F.tid; gt < NB * 32 * 64; gt += F.G * NTHR) {
        const int p = gt & 63, g = (gt >> 6) & 31, b = gt >> 11;
        const float lr = lam_re[g * 64 + p], li = lam_im[g * 64 + p], dt = __expf(log_dt[g]);
        float sn, cs; const float mg = expf((float)S5L * lr * dt); sincosf((float)S5L * (li * dt), &sn, &cs);
        const float ar = mg * cs, ai = mg * sn;
        float xr = 0.f, xi = 0.f;
        const size_t row0 = (size_t)g * S5ROWS + (size_t)b * S5NC;
        for (int cb = 0; cb < S5NC; cb += 16) {
            float sr[16], si[16];
#pragma unroll
            for (int j = 0; j < 16; ++j) { sr[j] = sloc[(row0 + cb + j) * 128 + p]; si[j] = sloc[(row0 + cb + j) * 128 + 64 + p]; }
#pragma unroll
            for (int j = 0; j < 16; ++j) { const size_t row = row0 + cb + j;
                us5[row * LDU + 512 + p] = f2bf(xr); us5[row * LDU + 576 + p] = f2bf(xi);
                const float nr = ar * xr - ai * xi + sr[j], ni = ar * xi + ai * xr + si[j];
                xr = nr; xi = ni; }
        }
    }
}

constexpr int PT = 72, SLOTB = 64 * PT * 2;
DI LAS bf16_t* rslot(LAS unsigned char* lds, int i) { return (LAS bf16_t*)(lds + i * SLOTB); }
DI void mm_acc(f32x4 (&acc)[2], const LAS bf16_t* A, const LAS bf16_t* Bt, int ti, int tj0, int r, int q) {
#pragma unroll
    for (int s2 = 0; s2 < 2; ++s2) {
        const bf16x8 a = *(const LAS bf16x8*)(A + (16 * ti + r) * PT + 32 * s2 + 8 * q);
#pragma unroll
        for (int e = 0; e < 2; ++e) { const bf16x8 b = *(const LAS bf16x8*)(Bt + (16 * (tj0 + e) + r) * PT + 32 * s2 + 8 * q);
            acc[e] = __builtin_amdgcn_mfma_f32_16x16x32_bf16(a, b, acc[e], 0, 0, 0); }
    }
}
DI void mm_acc_bnat(f32x4 (&acc)[2], const LAS bf16_t* A, const LAS bf16_t* Bn, int ti, int tj0, int r, int q) {
#pragma unroll
    for (int s2 = 0; s2 < 2; ++s2) {
        const bf16x8 a = *(const LAS bf16x8*)(A + (16 * ti + r) * PT + 32 * s2 + 8 * q);
#pragma unroll
        for (int e = 0; e < 2; ++e) { bf16x8 b;
#pragma unroll
            for (int jj = 0; jj < 8; ++jj) b[jj] = (short)Bn[(32 * s2 + 8 * q + jj) * PT + 16 * (tj0 + e) + r];
            acc[e] = __builtin_amdgcn_mfma_f32_16x16x32_bf16(a, b, acc[e], 0, 0, 0); }
    }
}
DI void st_rm(LAS bf16_t* Dm, const f32x4& v, int i0, int j) {
#pragma unroll
    for (int g = 0; g < 4; ++g) Dm[(i0 + g) * PT + j] = f2bf(v[g]);
}
DI void st_tr(LAS bf16_t* Dm, const f32x4& v, int i0, int j) { u32x2 w; w.x = cvt_pk_bf16(v[0], v[1]); w.y = cvt_pk_bf16(v[2], v[3]); *(LAS u32x2*)(Dm + j * PT + i0) = w; }
DI f32x4 ld_rm(const LAS bf16_t* Sm, int i0, int j) { f32x4 v;
#pragma unroll
    for (int g = 0; g < 4; ++g) v[g] = bf2f(Sm[(i0 + g) * PT + j]);
    return v; }
DI void ld_frag(bf16x8 (&f)[2], const LAS bf16_t* M, int row, int q) { f[0] = *(const LAS bf16x8*)(M + row * PT + 8 * q); f[1] = *(const LAS bf16x8*)(M + row * PT + 32 + 8 * q); }
DI f32x4 mm2(const bf16x8 (&x)[2], const bf16x8 (&y)[2], f32x4 c) { c = __builtin_amdgcn_mfma_f32_16x16x32_bf16(x[0], y[0], c, 0, 0, 0); return __builtin_amdgcn_mfma_f32_16x16x32_bf16(x[1], y[1], c, 0, 0, 0); }
DI void st_sw(LAS bf16_t* Dm, const f32x4& v, int i, int j0) { u32x2 w; w.x = cvt_pk_bf16(v[0], v[1]); w.y = cvt_pk_bf16(v[2], v[3]); *(LAS u32x2*)(Dm + i * PT + j0) = w; }
DI f32x4 ld_sw(const LAS bf16_t* Sm, int i, int j0) { const u32x2 w = *(const LAS u32x2*)(Sm + i * PT + j0); return (f32x4){bf_lo(w.x), bf_hi(w.x), bf_lo(w.y), bf_hi(w.y)}; }
#define ZACC(a) do { a[0] = (f32x4){0.f, 0.f, 0.f, 0.f}; a[1] = (f32x4){0.f, 0.f, 0.f, 0.f}; } while (0)

DI float wave_sum2(float v) { return xrow_sum(row_sum16(v)); }
#define LSYNC() do { asm volatile("s_waitcnt lgkmcnt(0)" ::: "memory"); __builtin_amdgcn_s_barrier(); asm volatile("" ::: "memory"); } while (0)

struct RaRaw { bf16_t r[9], k[9], v[9], lw[8], a[8]; };
DI void ra_load(RaRaw& x, const bf16_t* prw, const bf16_t* lwag, int ci, int w, int lane) {
    const int bh = ci >> 6, c = ci & 63, b = bh >> 3, h = bh & 7, ch = h * 64 + lane;
    const size_t tok0 = (size_t)b * SEQ + c * 64 + 8 * w;
    const bool has_prev = !(c == 0 && w == 0);
    const size_t tp = has_prev ? tok0 - 1 : tok0;
    x.r[0] = prw[tp * RWC + ch]; x.k[0] = prw[tp * RWC + 512 + ch]; x.v[0] = prw[tp * RWC + 1024 + ch];
#pragma unroll
    for (int i = 0; i < 8; ++i) { const size_t tok = tok0 + i;
        x.r[i + 1] = prw[tok * RWC + ch]; x.k[i + 1] = prw[tok * RWC + 512 + ch]; x.v[i + 1] = prw[tok * RWC + 1024 + ch];
        x.lw[i] = lwag[tok * 1536 + ch]; x.a[i] = lwag[tok * 1536 + 512 + ch]; }
}
DI void p_rw_chunk(const Frame& F) {
    const bf16_t* prw = (const bf16_t*)(F.ws + WS_PRW); const bf16_t* lwag = (const bf16_t*)(F.ws + WS_LWAG);
    const float* mu = F.in[13]; const float* k_k = F.in[19]; const float* k_a = F.in[20]; const float* r_k = F.in[21];
    float* bonus = (float*)(F.ws + WS_BONUS);
    bf16_t* gM = (bf16_t*)(F.ws + WS_CHK_M); bf16_t* gN0T = (bf16_t*)(F.ws + WS_CHK_N0T); bf16_t* gQ = (bf16_t*)(F.ws + WS_CHK_Q); bf16_t* gY0 = (bf16_t*)(F.ws + WS_CHK_Y0T);
    LAS unsigned char* lds = F.lds;
    LAS float* segtot = (LAS float*)(lds + 14 * SLOTB);
    LAS float* PLs = segtot + 512;
    LAS float* DB = PLs + 64;
    constexpr int PD = 20;
    const int w = F.wave, lane = F.lane, r = lane & 15, q = lane >> 4, ti = w >> 1, tj0 = 2 * (w & 1), i0 = 16 * ti + 4 * q;
    LAS bf16_t* S0 = rslot(lds, 0); LAS bf16_t* S1 = rslot(lds, 1); LAS bf16_t* S2 = rslot(lds, 2); LAS bf16_t* S3 = rslot(lds, 3);
    LAS bf16_t* S4 = rslot(lds, 4); LAS bf16_t* S5 = rslot(lds, 5); LAS bf16_t* S6 = rslot(lds, 6); LAS bf16_t* S7 = rslot(lds, 7);
    LAS bf16_t* S8 = rslot(lds, 8); LAS bf16_t* S9 = rslot(lds, 9); LAS bf16_t* S10 = rslot(lds, 10); LAS bf16_t* S11 = rslot(lds, 11);
    LAS bf16_t* S12 = rslot(lds, 12); LAS bf16_t* S13 = rslot(lds, 13);
    RaRaw raw;
    if (F.bid < RW_NCH) ra_load(raw, prw, lwag, F.bid, w, lane);
    for (int ci = F.bid; ci < RW_NCH; ci += F.G) {
        const int bh = ci >> 6, c = ci & 63, b = bh >> 3, h = bh & 7, ch = h * 64 + lane;
        {
            const size_t tok0 = (size_t)b * SEQ + c * 64 + 8 * w;
            const float mur = mu[ch], muk = mu[512 + ch], muv = mu[1024 + ch], kkw = k_k[ch], ka = k_a[ch], rk = r_k[ch];
            const bool has_prev = !(c == 0 && w == 0);
            float xr[9], xk[9], xv[9];
            xr[0] = has_prev ? bf2f(raw.r[0]) : 0.f; xk[0] = has_prev ? bf2f(raw.k[0]) : 0.f; xv[0] = has_prev ? bf2f(raw.v[0]) : 0.f;
#pragma unroll
            for (int i = 1; i < 9; ++i) { xr[i] = bf2f(raw.r[i]); xk[i] = bf2f(raw.k[i]); xv[i] = bf2f(raw.v[i]); }
            f32x2 rr2[4], vv2[4], aa2[4], km2[4], kn2[4]; float cl[8];
            float run = 0.f;
#pragma unroll
            for (int p2 = 0; p2 < 4; ++p2) {
                const f32x2 cr = {xr[2 * p2 + 1], xr[2 * p2 + 2]}, pr = {xr[2 * p2], xr[2 * p2 + 1]};
                const f32x2 ck = {xk[2 * p2 + 1], xk[2 * p2 + 2]}, pk = {xk[2 * p2], xk[2 * p2 + 1]};
                const f32x2 cv = {xv[2 * p2 + 1], xv[2 * p2 + 2]}, pv = {xv[2 * p2], xv[2 * p2 + 1]};
                const f32x2 r_ = cr + (pr - cr) * mur, k_ = ck + (pk - ck) * muk, v_ = cv + (pv - cv) * muv;
                const f32x2 a_ = {bf2f(raw.a[2 * p2]), bf2f(raw.a[2 * p2 + 1])};
                f32x2 kx = k_ * kkw; const f32x2 sq = kx * kx;
                const float ss0 = wave_sum2(sq.x), ss1 = wave_sum2(sq.y);
                kx = kx * (f32x2){fminf(__builtin_amdgcn_rsqf(ss0), 1e12f), fminf(__builtin_amdgcn_rsqf(ss1), 1e12f)};
                const f32x2 kmod = k_ * (a_ * ka + (1.0f - ka));
                const f32x2 bq = (r_ * kmod) * rk;
                const float bn0 = wave_sum2(bq.x), bn1 = wave_sum2(bq.y);
                if (lane == 0) { bonus[(tok0 + 2 * p2) * 8 + h] = bn0; bonus[(tok0 + 2 * p2 + 1) * 8 + h] = bn1; }
                rr2[p2] = r_; vv2[p2] = v_; aa2[p2] = a_; km2[p2] = kmod; kn2[p2] = kx;
                run += bf2f(raw.lw[2 * p2]); cl[2 * p2] = run; run += bf2f(raw.lw[2 * p2 + 1]); cl[2 * p2 + 1] = run;
            }
            segtot[w * 64 + lane] = run;
            LSYNC();
            float pre = 0.f;
            for (int w2 = 0; w2 < w; ++w2) pre += segtot[w2 * 64 + lane];
            if (w == 7) PLs[lane] = __expf(pre + run);
            float ep = __expf(pre);
            unsigned xa[4], xb[4], xkk[4], xrr[4], xvv[4];
#pragma unroll
            for (int p2 = 0; p2 < 4; ++p2) {
                const f32x2 tt = ((f32x2){cl[2 * p2], cl[2 * p2 + 1]} + pre) * 1.44269504f;
                const f32x2 e = {__builtin_amdgcn_exp2f(tt.x), __builtin_amdgcn_exp2f(tt.y)}, en = {__builtin_amdgcn_rcpf(e.x), __builtin_amdgcn_rcpf(e.y)}, epv = {ep, e.x};
                ep = e.y;
                const f32x2 at = -(kn2[p2] * epv), bt = (kn2[p2] * aa2[p2]) * en, kt = km2[p2] * en, rt = rr2[p2] * e;
                xa[p2] = cvt_pk_bf16(at.x, at.y); xb[p2] = cvt_pk_bf16(bt.x, bt.y); xkk[p2] = cvt_pk_bf16(kt.x, kt.y); xrr[p2] = cvt_pk_bf16(rt.x, rt.y); xvv[p2] = cvt_pk_bf16(vv2[p2].x, vv2[p2].y);
                const int t = 8 * w + 2 * p2;
                S0[t * PT + lane] = (bf16_t)(xa[p2] & 0xffffu); S0[(t + 1) * PT + lane] = (bf16_t)(xa[p2] >> 16);
                S2[t * PT + lane] = (bf16_t)(xb[p2] & 0xffffu); S2[(t + 1) * PT + lane] = (bf16_t)(xb[p2] >> 16);
                S4[t * PT + lane] = (bf16_t)(xkk[p2] & 0xffffu); S4[(t + 1) * PT + lane] = (bf16_t)(xkk[p2] >> 16);
                S6[t * PT + lane] = (bf16_t)(xrr[p2] & 0xffffu); S6[(t + 1) * PT + lane] = (bf16_t)(xrr[p2] >> 16);
            }
            *(LAS u32x4*)(S1 + lane * PT + 8 * w) = (u32x4){xa[0], xa[1], xa[2], xa[3]};
            *(LAS u32x4*)(S3 + lane * PT + 8 * w) = (u32x4){xb[0], xb[1], xb[2], xb[3]};
            *(LAS u32x4*)(S5 + lane * PT + 8 * w) = (u32x4){xkk[0], xkk[1], xkk[2], xkk[3]};
            *(LAS u32x4*)(S7 + lane * PT + 8 * w) = (u32x4){xvv[0], xvv[1], xvv[2], xvv[3]};
        }
        LSYNC();
        if (ci + F.G < RW_NCH) ra_load(raw, prw, lwag, ci + F.G, w, lane);
        f32x4 acc[2];
        const f32x4 Z4 = (f32x4){0.f, 0.f, 0.f, 0.f};
        const int ia = 16 * ti + r, jb0 = 16 * tj0 + r;
        { bf16x8 a0[2], a6[2], b2[2][2], b4[2][2];
          ld_frag(a0, S0, ia, q); ld_frag(a6, S6, ia, q);
#pragma unroll
          for (int e = 0; e < 2; ++e) { ld_frag(b2[e], S2, jb0 + 16 * e, q); ld_frag(b4[e], S4, jb0 + 16 * e, q); }
#pragma unroll
          for (int e = 0; e < 2; ++e) { const int tj = tj0 + e, j = 16 * tj + r, js = 16 * tj + 4 * q;
            const f32x4 c = mm2(a0, b2[e], Z4);
            if (tj == ti) {
#pragma unroll
                for (int g = 0; g < 4; ++g) DB[(ti * 16 + 4 * q + g) * PD + r] = (4 * q + g > r) ? c[g] : 0.f;
            }
            st_tr(S8, (ti > tj) ? c : Z4, i0, j);
            f32x4 v = mm2(b4[e], a0, Z4);
#pragma unroll
            for (int g = 0; g < 4; ++g) v[g] = (ia > js + g) ? v[g] : 0.f;
            st_sw(S9, v, ia, js);
            v = mm2(b2[e], a6, Z4);
#pragma unroll
            for (int g = 0; g < 4; ++g) v[g] = (ia >= js + g) ? v[g] : 0.f;
            st_sw(S10, v, ia, js);
            v = mm2(b4[e], a6, Z4);
#pragma unroll
            for (int g = 0; g < 4; ++g) v[g] = (ia >= js + g) ? v[g] : 0.f;
            st_sw(S11, v, ia, js); } }
        LSYNC();
        ZACC(acc); mm_acc(acc, S9, S7, ti, tj0, r, q);
#pragma unroll
        for (int e = 0; e < 2; ++e) st_tr(S2, acc[e], i0, 16 * (tj0 + e) + r);
        if (w < 4) {
            const int i = lane >> 2, p = lane & 3;
            const LAS float* Dp = DB + (w * 16 + p) * PD;
            f32x4 Dm[4][4];
#pragma unroll
            for (int m = 0; m < 4; ++m)
#pragma unroll
                for (int c4 = 0; c4 < 4; ++c4) Dm[m][c4] = *(const LAS f32x4*)(Dp + 4 * m * PD + 4 * c4);
            float mine[4] = {0.f, 0.f, 0.f, 0.f}, tr[16];
#pragma unroll
            for (int j = 15; j >= 0; --j) { float part = 0.f;
#pragma unroll
                for (int m = 3; m >= 0; --m) if (4 * m + 3 > j) part = __builtin_fmaf(mine[m], Dm[m][j >> 2][j & 3], part);
                float tot = part + __builtin_bit_cast(float, __builtin_amdgcn_update_dpp(0, __builtin_bit_cast(int, part), 0xB1, 0xf, 0xf, false));
                tot = tot + __builtin_bit_cast(float, __builtin_amdgcn_update_dpp(0, __builtin_bit_cast(int, tot), 0x4E, 0xf, 0xf, false));
                const float trj = (j > i) ? 0.f : ((j == i) ? 1.0f : tot);
                tr[j] = trj; mine[j >> 2] = (p == (j & 3)) ? trj : mine[j >> 2]; }
            u32x4 z = (u32x4){0u, 0u, 0u, 0u}, x0, x1;
            x0.x = cvt_pk_bf16(tr[0], tr[1]); x0.y = cvt_pk_bf16(tr[2], tr[3]); x0.z = cvt_pk_bf16(tr[4], tr[5]); x0.w = cvt_pk_bf16(tr[6], tr[7]);
            x1.x = cvt_pk_bf16(tr[8], tr[9]); x1.y = cvt_pk_bf16(tr[10], tr[11]); x1.z = cvt_pk_bf16(tr[12], tr[13]); x1.w = cvt_pk_bf16(tr[14], tr[15]);
            LAS bf16_t* dst = S0 + (16 * w + i) * PT + 16 * p;
            *(LAS u32x4*)dst = (p == w) ? x0 : z; *(LAS u32x4*)(dst + 8) = (p == w) ? x1 : z;
        }
        LSYNC();
        { bf16x8 a[2], b[2][2]; ld_frag(a, S0, ia, q);
#pragma unroll
          for (int e = 0; e < 2; ++e) ld_frag(b[e], S8, jb0 + 16 * e, q);
#pragma unroll
          for (int e = 0; e < 2; ++e) { st_tr(S12, mm2(a, b[e], Z4), i0, 16 * (tj0 + e) + r); st_sw(S4, mm2(b[e], a, Z4), ia, 16 * (tj0 + e) + 4 * q); } }
        LSYNC();
        { bf16x8 a[2], b[2][2], bn[2][2]; ld_frag(a, S4, ia, q);
#pragma unroll
          for (int e = 0; e < 2; ++e) { ld_frag(b[e], S12, jb0 + 16 * e, q);
#pragma unroll
            for (int s2 = 0; s2 < 2; ++s2)
#pragma unroll
                for (int jj = 0; jj < 8; ++jj) bn[e][s2][jj] = (short)S0[(32 * s2 + 8 * q + jj) * PT + 16 * (tj0 + e) + r]; }
#pragma unroll
          for (int e = 0; e < 2; ++e) { const int j = 16 * (tj0 + e) + r, js = 16 * (tj0 + e) + 4 * q;
            st_sw(S13, mm2(b[e], a, Z4), ia, js);
            st_tr(S9, mm2(a, bn[e], ld_rm(S0, i0, j)), i0, j);
            st_sw(S8, mm2(bn[e], a, ld_sw(S0, ia, js)), ia, js); } }
        LSYNC();
        { bf16x8 a[2], b[2][2]; ld_frag(a, S13, ia, q);
#pragma unroll
          for (int e = 0; e < 2; ++e) ld_frag(b[e], S9, jb0 + 16 * e, q);
#pragma unroll
          for (int e = 0; e < 2; ++e) { const int js = 16 * (tj0 + e) + 4 * q; st_sw(S12, mm2(b[e], a, ld_sw(S8, ia, js)), ia, js); } }
        LSYNC();
        { bf16x8 a[2], b1[2][2], bx[2][2]; ld_frag(a, S12, ia, q);
#pragma unroll
          for (int e = 0; e < 2; ++e) { ld_frag(b1[e], S1, jb0 + 16 * e, q); ld_frag(bx[e], S2, jb0 + 16 * e, q); }
#pragma unroll
          for (int e = 0; e < 2; ++e) { const int j = 16 * (tj0 + e) + r; st_tr(S0, mm2(a, b1[e], Z4), i0, j); st_tr(S4, mm2(a, bx[e], Z4), i0, j); } }
        LSYNC();
        { bf16x8 a10[2], a11[2], a3[2], a5[2], b0[2][2], b4[2][2], b7[2][2];
          ld_frag(a10, S10, ia, q); ld_frag(a11, S11, ia, q); ld_frag(a3, S3, ia, q); ld_frag(a5, S5, ia, q);
#pragma unroll
          for (int e = 0; e < 2; ++e) { ld_frag(b0[e], S0, jb0 + 16 * e, q); ld_frag(b4[e], S4, jb0 + 16 * e, q); ld_frag(b7[e], S7, jb0 + 16 * e, q); }
          const float pli = PLs[ia];
          f32x4 plg;
#pragma unroll
          for (int g = 0; g < 4; ++g) plg[g] = PLs[i0 + g];
#pragma unroll
          for (int e = 0; e < 2; ++e) { const int j = 16 * (tj0 + e) + r, js = 16 * (tj0 + e) + 4 * q;
            const f32x4 vq = mm2(b0[e], a10, ld_sw(S6, ia, js));
            const f32x4 vy = mm2(b7[e], a11, mm2(b4[e], a10, Z4));
            f32x4 vm = mm2(b0[e], a3, Z4);
#pragma unroll
            for (int g = 0; g < 4; ++g) vm[g] = pli * (vm[g] + ((ia == js + g) ? 1.0f : 0.f));
            const f32x4 vn = mm2(a5, b7[e], mm2(a3, b4[e], Z4)) * plg;
            st_sw(S1, vq, ia, js); st_sw(S2, vy, ia, js); st_sw(S8, vm, ia, js); st_tr(S9, vn, i0, j); } }
        LSYNC();
        { const int row = F.tid >> 3, seg = (F.tid & 7) * 8; const size_t go = (size_t)ci * 4096 + row * 64 + seg;
          *(u32x4*)(gQ + go) = *(const LAS u32x4*)(S1 + row * PT + seg); *(u32x4*)(gY0 + go) = *(const LAS u32x4*)(S2 + row * PT + seg);
          *(u32x4*)(gM + go) = *(const LAS u32x4*)(S8 + row * PT + seg); *(u32x4*)(gN0T + go) = *(const LAS u32x4*)(S9 + row * PT + seg); }
        LSYNC();
    }
    asm volatile("s_waitcnt vmcnt(0)" ::: "memory");
}

struct ScanOps { u32x2 m[4][2][2]; u32x2 n0[4]; };
DI void scan_load(ScanOps& o, const bf16_t* gM, const bf16_t* gN0T, size_t ci, int col, int q, int v) {
#pragma unroll
    for (int m = 0; m < 4; ++m) {
#pragma unroll
        for (int s2 = 0; s2 < 2; ++s2) { const bf16_t* p = gM + ci * 4096 + (16 * m + col) * 64 + 32 * s2 + 4 * q; o.m[m][s2][0] = *(const u32x2*)p; o.m[m][s2][1] = *(const u32x2*)(p + 16); }
        o.n0[m] = *(const u32x2*)(gN0T + ci * 4096 + v * 64 + 16 * m + 4 * q); }
}
DI void scan_step(const ScanOps& o, f32x4 (&H)[4], bf16_t* gHT, size_t ci, int q, int v) {
    u32x4 bfr[2];
#pragma unroll
    for (int s2 = 0; s2 < 2; ++s2) { bfr[s2].x = cvt_pk_bf16(H[2 * s2][0], H[2 * s2][1]); bfr[s2].y = cvt_pk_bf16(H[2 * s2][2], H[2 * s2][3]);
        bfr[s2].z = cvt_pk_bf16(H[2 * s2 + 1][0], H[2 * s2 + 1][1]); bfr[s2].w = cvt_pk_bf16(H[2 * s2 + 1][2], H[2 * s2 + 1][3]);
        bf16_t* hp = gHT + ci * 4096 + v * 64 + 32 * s2 + 4 * q;
        *(u32x2*)hp = (u32x2){bfr[s2].x, bfr[s2].y}; *(u32x2*)(hp + 16) = (u32x2){bfr[s2].z, bfr[s2].w}; }
#pragma unroll
    for (int m = 0; m < 4; ++m) {
        f32x4 a2 = (f32x4){bf_lo(o.n0[m].x), bf_hi(o.n0[m].x), bf_lo(o.n0[m].y), bf_hi(o.n0[m].y)};
#pragma unroll
        for (int s2 = 0; s2 < 2; ++s2) { const u32x4 af = (u32x4){o.m[m][s2][0].x, o.m[m][s2][0].y, o.m[m][s2][1].x, o.m[m][s2][1].y};
            a2 = __builtin_amdgcn_mfma_f32_16x16x32_bf16(__builtin_bit_cast(bf16x8, af), __builtin_bit_cast(bf16x8, bfr[s2]), a2, 0, 0, 0); }
        H[m] = a2; }
}
DI void p_rw_scan(const Frame& F) {
    const bf16_t* gM = (const bf16_t*)(F.ws + WS_CHK_M); const bf16_t* gN0T = (const bf16_t*)(F.ws + WS_CHK_N0T); bf16_t* gHT = (bf16_t*)(F.ws + WS_CHK_HT);
    for (int item = F.wave * F.G + F.bid; item < 512; item += NWAVES * F.G) {
        const int bh = item >> 2, vb = item & 3, col = F.lane & 15, q = F.lane >> 4, v = 16 * vb + col;
        f32x4 H[4];
#pragma unroll
        for (int m = 0; m < 4; ++m) H[m] = (f32x4){0.f, 0.f, 0.f, 0.f};
        const size_t c0 = (size_t)bh * 64;
        ScanOps A, B, C, Dd;
        scan_load(A, gM, gN0T, c0, col, q, v); scan_load(B, gM, gN0T, c0 + 1, col, q, v); scan_load(C, gM, gN0T, c0 + 2, col, q, v);
        for (int c = 0; c < 64; c += 4) {
            scan_load(Dd, gM, gN0T, c0 + c + 3, col, q, v);
            scan_step(A, H, gHT, c0 + c, q, v);
            if (c + 4 < 64) scan_load(A, gM, gN0T, c0 + c + 4, col, q, v);
            scan_step(B, H, gHT, c0 + c + 1, q, v);
            if (c + 4 < 64) scan_load(B, gM, gN0T, c0 + c + 5, col, q, v);
            scan_step(C, H, gHT, c0 + c + 2, q, v);
            if (c + 4 < 64) scan_load(C, gM, gN0T, c0 + c + 6, col, q, v);
            scan_step(Dd, H, gHT, c0 + c + 3, q, v);
        }
    }
}

struct RcIn { bf16x8 qf[2], hb[4][2]; u32x2 y0[4], cv[4], pv[4], gw[4]; float bn; };
DI void rc_load(RcIn& x, const bf16_t* gQ, const bf16_t* gY0, const bf16_t* gHT, const bf16_t* prw, const bf16_t* lwag, const float* bonus, int item, int r, int q) {
    const int ci = item >> 2, ti = item & 3, bh = ci >> 6, c = ci & 63, b = bh >> 3, h = bh & 7;
    const size_t cb = (size_t)ci * 4096; const size_t tok = (size_t)b * SEQ + c * 64 + 16 * ti + r;
    const bool first = (tok & (SEQ - 1)) == 0; const size_t tp = first ? tok : tok - 1;
#pragma unroll
    for (int s2 = 0; s2 < 2; ++s2) x.qf[s2] = *(const bf16x8*)(gQ + cb + (16 * ti + r) * 64 + 32 * s2 + 8 * q);
#pragma unroll
    for (int n = 0; n < 4; ++n) { const int cch = h * 64 + 16 * n + 4 * q;
        x.y0[n] = *(const u32x2*)(gY0 + cb + (16 * ti + r) * 64 + 16 * n + 4 * q);
#pragma unroll
        for (int s2 = 0; s2 < 2; ++s2) x.hb[n][s2] = *(const bf16x8*)(gHT + cb + (16 * n + r) * 64 + 32 * s2 + 8 * q);
        x.cv[n] = *(const u32x2*)(prw + tok * RWC + 1024 + cch); x.pv[n] = *(const u32x2*)(prw + tp * RWC + 1024 + cch);
        x.gw[n] = *(const u32x2*)(lwag + tok * 1536 + 1024 + cch); }
    x.bn = bonus[tok * 8 + h];
}
DI void rc_compute(const RcIn& x, bf16_t* yrw, const float* mu, const float* ln_g, const float* ln_b, int item, int r, int q) {
    const int ci = item >> 2, ti = item & 3, bh = ci >> 6, c = ci & 63, b = bh >> 3, h = bh & 7;
    const size_t tok = (size_t)b * SEQ + c * 64 + 16 * ti + r; const bool first = (tok & (SEQ - 1)) == 0;
    f32x4 y[4];
#pragma unroll
    for (int n = 0; n < 4; ++n) { y[n] = (f32x4){bf_lo(x.y0[n].x), bf_hi(x.y0[n].x), bf_lo(x.y0[n].y), bf_hi(x.y0[n].y)};
#pragma unroll
        for (int s2 = 0; s2 < 2; ++s2) y[n] = __builtin_amdgcn_mfma_f32_16x16x32_bf16(x.hb[n][s2], x.qf[s2], y[n], 0, 0, 0); }
    float s1 = 0.f;
#pragma unroll
    for (int n = 0; n < 4; ++n) s1 += (y[n][0] + y[n][1]) + (y[n][2] + y[n][3]);
    s1 = xrow_sum(s1);
    const float mean = s1 * (1.0f / 64.0f);
    float s2 = 0.f;
#pragma unroll
    for (int n = 0; n < 4; ++n) { y[n] = y[n] - mean; s2 += (y[n][0] * y[n][0] + y[n][1] * y[n][1]) + (y[n][2] * y[n][2] + y[n][3] * y[n][3]); }
    s2 = xrow_sum(s2);
    const float rstd = rsqrtf(s2 * (1.0f / 64.0f) + 64e-5f);
#pragma unroll
    for (int n = 0; n < 4; ++n) { const int cch = h * 64 + 16 * n + 4 * q;
        const f32x4 muv = *(const f32x4*)(mu + 1024 + cch), lg = *(const f32x4*)(ln_g + cch), lb = *(const f32x4*)(ln_b + cch);
        const float cv[4] = {bf_lo(x.cv[n].x), bf_hi(x.cv[n].x), bf_lo(x.cv[n].y), bf_hi(x.cv[n].y)};
        const float pv[4] = {first ? 0.f : bf_lo(x.pv[n].x), first ? 0.f : bf_hi(x.pv[n].x), first ? 0.f : bf_lo(x.pv[n].y), first ? 0.f : bf_hi(x.pv[n].y)};
        const float gg[4] = {bf_lo(x.gw[n].x), bf_hi(x.gw[n].x), bf_lo(x.gw[n].y), bf_hi(x.gw[n].y)};
        float o[4];
#pragma unroll
        for (int g = 0; g < 4; ++g) { const float vsh = cv[g] + muv[g] * (pv[g] - cv[g]); o[g] = (y[n][g] * rstd * lg[g] + lb[g] + x.bn * vsh) * gg[g]; }
        u32x2 ow; ow.x = cvt_pk_bf16(o[0], o[1]); ow.y = cvt_pk_bf16(o[2], o[3]);
        *(u32x2*)(yrw + tok * 512 + cch) = ow; }
}
DI void p_rw_out(const Frame& F) {
    const bf16_t* gQ = (const bf16_t*)(F.ws + WS_CHK_Q); const bf16_t* gY0 = (const bf16_t*)(F.ws + WS_CHK_Y0T); const bf16_t* gHT = (const bf16_t*)(F.ws + WS_CHK_HT);
    const bf16_t* prw = (const bf16_t*)(F.ws + WS_PRW); const bf16_t* lwag = (const bf16_t*)(F.ws + WS_LWAG); const float* bonus = (const float*)(F.ws + WS_BONUS);
    bf16_t* yrw = (bf16_t*)(F.ws + WS_YRW);
    const float* mu = F.in[13]; const float* ln_g = F.in[22]; const float* ln_b = F.in[23];
    const int r = F.lane & 15, q = F.lane >> 4, stride = F.G * NWAVES, NIT = RW_NCH * 4;
    for (int item = F.bid * NWAVES + F.wave; item < NIT; item += 2 * stride) {
        const int item2 = (item + stride < NIT) ? item + stride : item;
        RcIn xa, xb;
        rc_load(xa, gQ, gY0, gHT, prw, lwag, bonus, item, r, q); rc_load(xb, gQ, gY0, gHT, prw, lwag, bonus, item2, r, q);
        rc_compute(xa, yrw, mu, ln_g, ln_b, item, r, q); rc_compute(xb, yrw, mu, ln_g, ln_b, item2, r, q);
    }
}

DI void p_moe_prep(const Frame& F) {
    const bf16_t* hb = (const bf16_t*)(F.ws + WS_HB); float* rsv = (float*)(F.ws + WS_RS); unsigned char* out8 = (unsigned char*)(F.ws + WS_XN2F8); const float* g = F.in[26];
    const int stride = F.G * NWAVES;
    for (int row = F.bid * NWAVES + F.wave; row < T; row += 2 * stride) {
        const int row2 = (row + stride < T) ? row + stride : row;
        u32x4 a[2], b[2];
        a[0] = *(const u32x4*)(hb + (size_t)row * D + F.lane * 16); a[1] = *(const u32x4*)(hb + (size_t)row * D + F.lane * 16 + 8);
        b[0] = *(const u32x4*)(hb + (size_t)row2 * D + F.lane * 16); b[1] = *(const u32x4*)(hb + (size_t)row2 * D + F.lane * 16 + 8);
        float v[16], u[16]; float ss = 0.f, su = 0.f;
#pragma unroll
        for (int j = 0; j < 8; ++j) { v[2 * j] = bf_lo(a[j >> 2][j & 3]); v[2 * j + 1] = bf_hi(a[j >> 2][j & 3]); u[2 * j] = bf_lo(b[j >> 2][j & 3]); u[2 * j + 1] = bf_hi(b[j >> 2][j & 3]); }
#pragma unroll
        for (int j = 0; j < 16; ++j) { ss += v[j] * v[j]; su += u[j] * u[j]; }
        ss = wave_sum(ss); su = wave_sum(su);
        const float rs = rsqrtf(ss * (1.0f / D) + 1e-5f), ru = rsqrtf(su * (1.0f / D) + 1e-5f);
        float gv[16];
#pragma unroll
        for (int q = 0; q < 4; ++q) { const f32x4 t = *(const f32x4*)(g + F.lane * 16 + q * 4); gv[4 * q] = t[0]; gv[4 * q + 1] = t[1]; gv[4 * q + 2] = t[2]; gv[4 * q + 3] = t[3]; }
#pragma unroll
        for (int j = 0; j < 16; ++j) { v[j] *= rs * gv[j]; u[j] *= ru * gv[j]; }
        u32x4 q0, q1;
        if (F.lane == 0) { rsv[row] = rs; rsv[row2] = ru; }
        q0.x = pk4_fp8(v[0] * F8_SX, v[1] * F8_SX, v[2] * F8_SX, v[3] * F8_SX); q0.y = pk4_fp8(v[4] * F8_SX, v[5] * F8_SX, v[6] * F8_SX, v[7] * F8_SX);
        q0.z = pk4_fp8(v[8] * F8_SX, v[9] * F8_SX, v[10] * F8_SX, v[11] * F8_SX); q0.w = pk4_fp8(v[12] * F8_SX, v[13] * F8_SX, v[14] * F8_SX, v[15] * F8_SX);
        q1.x = pk4_fp8(u[0] * F8_SX, u[1] * F8_SX, u[2] * F8_SX, u[3] * F8_SX); q1.y = pk4_fp8(u[4] * F8_SX, u[5] * F8_SX, u[6] * F8_SX, u[7] * F8_SX);
        q1.z = pk4_fp8(u[8] * F8_SX, u[9] * F8_SX, u[10] * F8_SX, u[11] * F8_SX); q1.w = pk4_fp8(u[12] * F8_SX, u[13] * F8_SX, u[14] * F8_SX, u[15] * F8_SX);
        *(u32x4*)(out8 + (size_t)row * D + F.lane * 16) = q0; *(u32x4*)(out8 + (size_t)row2 * D + F.lane * 16) = q1;
    }
    float* b1p = (float*)(F.ws + WS_B1P); const float* b1 = F.in[30]; CmSwi cm;
    for (int idx = F.bid * NTHR + F.tid; idx < 32 * 2048; idx += F.G * NTHR) { const int e = idx >> 11, n = idx & 2047; b1p[idx] = b1[e * 2048 + cm(n)]; }
}
DI void p_conv_part(const Frame& F, int part) {
    if (part == 0) conv_T8(F, F.in[29], (size_t)1024 * 2048, 2048, (unsigned char*)(F.ws + WS_W1), 2048, 1024, 32, MpSwi(), F8_SW, 0, 2048);
    else if (part == 1) conv_T8(F, F.in[29], (size_t)1024 * 2048, 2048, (unsigned char*)(F.ws + WS_W1), 2048, 1024, 32, MpSwi(), F8_SW, 2048, 4096);
    else conv_T8(F, F.in[31], (size_t)1024 * 1024, 1024, (unsigned char*)(F.ws + WS_W2), 1024, 1024, 32, MpId(), F8_SW);
}

DI void topk_rows(const Frame& F, int row0) {
    LAS unsigned* cnt = (LAS unsigned*)F.lds; LAS unsigned* base = cnt + 32;
    const float* logits = (const float*)(F.ws + WS_LOG); unsigned* epos = (unsigned*)(F.ws + WS_EPOS); float* gatev = (float*)(F.ws + WS_GATEV);
    const int pass = row0 / TPP;
    unsigned* gcnt = (unsigned*)(F.ws + WS_CTL) + CW_GCNT + pass * 32;
    if (F.tid < 32) cnt[F.tid] = 0u;
    __syncthreads();
    int e4[4] = {0, 0, 0, 0}; unsigned p4[4] = {0u, 0u, 0u, 0u}; float g4[4] = {0.f, 0.f, 0.f, 0.f};
    const int token = row0 + F.tid;
    if (F.tid < 256) {
        float l[32]; const float rsc = ((const float*)(F.ws + WS_RS))[token];
#pragma unroll
        for (int q = 0; q < 8; ++q) { const f32x4 v = *(const f32x4*)(logits + (size_t)token * 32 + q * 4), bq = *(const f32x4*)(F.in[28] + q * 4); l[q * 4] = v[0] * rsc + bq[0]; l[q * 4 + 1] = v[1] * rsc + bq[1]; l[q * 4 + 2] = v[2] * rsc + bq[2]; l[q * 4 + 3] = v[3] * rsc + bq[3]; }
        unsigned used = 0u; float tv[4];
#pragma unroll
        for (int k = 0; k < 4; ++k) { float best = -3.0e38f; int bi = 0;
#pragma unroll
            for (int e = 0; e < 32; ++e) { const bool ok = !((used >> e) & 1u) && (l[e] > best); best = ok ? l[e] : best; bi = ok ? e : bi; }
            used |= 1u << bi; e4[k] = bi; tv[k] = best; }
        const float m = tv[0]; float ex[4], sum = 0.f;
#pragma unroll
        for (int k = 0; k < 4; ++k) { ex[k] = __expf(tv[k] - m); sum += ex[k]; }
#pragma unroll
        for (int k = 0; k < 4; ++k) { g4[k] = ex[k] / sum; p4[k] = atomicAdd((unsigned*)&cnt[e4[k]], 1u); }
    }
    __syncthreads();
    if (F.tid < 32) base[F.tid] = __hip_atomic_fetch_add(&gcnt[F.tid], cnt[F.tid], __ATOMIC_RELAXED, __HIP_MEMORY_SCOPE_AGENT);
    __syncthreads();
    if (F.tid < 256) {
#pragma unroll
        for (int k = 0; k < 4; ++k) { epos[(size_t)token * 4 + k] = ((unsigned)e4[k] << 24) | (base[e4[k]] + p4[k]); gatev[(size_t)token * 4 + k] = g4[k]; }
    }
    __syncthreads();
}
DI void p_gather(const Frame& F, int pass) {
    LAS int* poff = (LAS int*)F.lds;
    LAS int* pcnt = poff + 40;
    unsigned* gcnt = (unsigned*)(F.ws + WS_CTL) + CW_GCNT + pass * 32;
    int* tile_e = (int*)(F.ws + WS_TILEE) + pass * TE_STRIDE;
    __syncthreads();
    if (F.tid == 0) { int acc = 0; for (int e = 0; e < 32; ++e) { poff[e] = acc; const int c = (int)__hip_atomic_load(&gcnt[e], __ATOMIC_RELAXED, __HIP_MEMORY_SCOPE_AGENT); pcnt[e] = c; acc += ((c + 255) >> 8) << 8; } poff[32] = acc; }
    __syncthreads();
    if (F.bid == 0) {
        const int nt = poff[32] >> 8;
        for (int t = F.tid; t < nt; t += NTHR) { int e = 0; for (int q = 1; q < 32; ++q) if (poff[q] <= t * 256) e = q; tile_e[1 + t] = e; }
        if (F.tid == 0) tile_e[0] = nt;
    }
    const unsigned* epos = (const unsigned*)(F.ws + WS_EPOS); const float* gatev = (const float*)(F.ws + WS_GATEV);
    int* slot = (int*)(F.ws + WS_SLOT); float* rowg = (float*)(F.ws + WS_ROWG) + (size_t)pass * MAXTILES * 256;
    int* rowtok = (int*)(F.ws + WS_ROWTOK) + (size_t)pass * MAXTILES * 256;
    for (int i = F.bid * NTHR + F.tid; i < 32 * 256; i += F.G * NTHR) { const int e = i >> 8, sl = poff[e] + pcnt[e] + (i & 255); if (sl < poff[e + 1]) rowtok[sl] = 0; }
    for (int i = F.bid * NTHR + F.tid; i < TPP * 4; i += F.G * NTHR) {
        const int token = pass * TPP + (i >> 2);
        const unsigned ep = epos[(size_t)pass * TPP * 4 + i]; const int sl = poff[ep >> 24] + (int)(ep & 0xffffffu);
        slot[(size_t)pass * TPP * 4 + i] = sl; rowg[sl] = gatev[(size_t)pass * TPP * 4 + i]; rowtok[sl] = token;
    }
    __syncthreads();
}
DI void p_combine(const Frame& F, int pass) {
    int tz_ = threadIdx.x; asm volatile("" : "+v"(tz_)); const int lane_ = tz_ & 63;
    const int* slot = (const int*)(F.ws + WS_SLOT); const unsigned char* y2 = (const unsigned char*)(F.ws + WS_XS) + (size_t)pass * PASS_BUF; const float* gf = F.in[33];
    for (int t = F.bid * NWAVES + F.wave; t < TPP; t += F.G * NWAVES) {
        const int token = pass * TPP + t;
        float v[16];
        { const bf16_t* hb = (const bf16_t*)(F.ws + WS_HB) + (size_t)token * D + lane_ * 16; const u32x4 h0 = *(const u32x4*)hb, h1 = *(const u32x4*)(hb + 8);
#pragma unroll
          for (int j = 0; j < 4; ++j) { v[2 * j] = bf_lo(h0[j]); v[2 * j + 1] = bf_hi(h0[j]); v[8 + 2 * j] = bf_lo(h1[j]); v[8 + 2 * j + 1] = bf_hi(h1[j]); } }
        u32x4 yw[4];
#pragma unroll
        for (int k = 0; k < 4; ++k) { const int s = slot[(size_t)token * 4 + k]; yw[k] = *(const u32x4*)(y2 + (size_t)s * D + lane_ * 16); }
#pragma unroll
        for (int k = 0; k < 4; ++k)
#pragma unroll
            for (int j = 0; j < 4; ++j) { const f32x2 lo = __builtin_amdgcn_cvt_pk_f32_fp8((int)yw[k][j], false), hi = __builtin_amdgcn_cvt_pk_f32_fp8((int)yw[k][j], true);
                v[4 * j] += lo[0] * (1.0f / F8_SY); v[4 * j + 1] += lo[1] * (1.0f / F8_SY); v[4 * j + 2] += hi[0] * (1.0f / F8_SY); v[4 * j + 3] += hi[1] * (1.0f / F8_SY); }
        float ss = 0.f;
#pragma unroll
        for (int j = 0; j < 16; ++j) ss += v[j] * v[j];
        ss = wave_sum(ss);
        const float rs = rsqrtf(ss * (1.0f / D) + 1e-5f);
        f32x4* orow = (f32x4*)(F.out + (size_t)token * D + lane_ * 16);
#pragma unroll
        for (int q = 0; q < 4; ++q) { const f32x4 gv = *(const f32x4*)(gf + lane_ * 16 + q * 4);
            orow[q] = (f32x4){v[q * 4] * rs * gv[0], v[q * 4 + 1] * rs * gv[1], v[q * 4 + 2] * rs * gv[2], v[q * 4 + 3] * rs * gv[3]}; }
    }
}

constexpr int N_PHASES = 18;
__global__ void __launch_bounds__(NTHR, 2) fwd_kernel(KArgs args) {
    extern __shared__ __attribute__((aligned(16))) unsigned char lds_raw[];
    Frame F; F.lds = (LAS unsigned char*)lds_raw; F.tid = threadIdx.x; F.lane = F.tid & 63; F.wave = __builtin_amdgcn_readfirstlane(F.tid >> 6);
    F.G = gridDim.x; F.bid = blockIdx.x; F.in = args.in; F.out = args.out; F.ws = args.ws;
    unsigned char* ws = args.ws;
    volatile LAS unsigned* MISC = (volatile LAS unsigned*)(F.lds + MISC_OFF);
    if (F.tid < 4) MISC[F.tid] = 0u;
    __syncthreads();
    XcdBarrier bar; bar.bar = (unsigned*)(ws + WS_CTL) + CW_BAR; bar.x = 0; bar.st = MISC;
    if (N_LAUNCH_MODE == 1) bar = xcd_barrier_post((unsigned*)(ws + WS_CTL) + CW_BAR, MISC);
    const int lo = args.ph_lo, hi = args.ph_hi;
#define IN(k) (lo <= (k) && (k) < hi)
#define REP(k) for (int _r = 0; _r < 1 + (int)((PROBE_MASK >> (k)) & 1u); ++_r)
#define SEAM(k) do { if (N_LAUNCH_MODE == 1 && IN(k) && IN((k) + 1)) xcd_barrier(bar); } while (0)
    bf16_t* gates = (bf16_t*)args.out;

    if (IN(0)) { REP(0) p0_prologue(F); SEAM(0); }
    if (IN(1)) {
        PlainSched S; S.init(ws + WS_XN, ws + WS_WIN, T, INC, D, D, D, F.G, F.bid);
        EpiWin E{(bf16_t*)(ws + WS_US5), (bf16_t*)(ws + WS_PRW), gates};
        REP(1) gemm_phase(F.lds, S, E); SEAM(1);
    }
    if (IN(2)) {
        GroupSched S; S.init(ws + WS_US5, ws + WS_WST, 512, LDU, 512, S5ROWS / BM, 1, F.G, F.bid);
        EpiS5State E{(float*)(ws + WS_SLOC)};
        REP(2) { gemm_phase(F.lds, S, E); p_rw_prep(F); } SEAM(2);
    }
    if (IN(3)) {
        REP(3) p_s5_carry(F);
        PlainSched S; S.init(ws + WS_ALORA, ws + WS_WLORA, T, 1536, 128, 256, 128, F.G, F.bid); S.akoff_pn = 4; S.akoff_bytes = 256;
        EpiLora E{(bf16_t*)(ws + WS_LWAG), F.in[14], F.in[16]};
        REP(3) gemm_phase(F.lds, S, E); SEAM(3);
    }
    if (IN(4)) {
        GroupSched S; S.init(ws + WS_US5, ws + WS_TOEP, LDU, LDU, LDU, S5ROWS / BM, 2, F.G, F.bid);
        EpiS5Out E{(bf16_t*)(ws + WS_YS)};
        REP(4) gemm_phase(F.lds, S, E); SEAM(4);
    }
    if (IN(5)) { REP(5) p_rw_chunk(F); SEAM(5); }
    if (IN(6)) { REP(6) p_rw_scan(F); SEAM(6); }
    if (IN(7)) { REP(7) p_rw_out(F); SEAM(7); }
    if (IN(8)) {
        PlainSched S; S.init(ws + WS_YS, ws + WS_WGLU, T, 2048, 512, 512, 512, F.G, F.bid);
        EpiGlu E{(bf16_t*)(ws + WS_XN), gates, (const float*)(ws + WS_BGLU)};
        if (F.bid & 1) p_conv_part(F, 0);
        gemm_phase(F.lds, S, E);
        if (!(F.bid & 1)) p_conv_part(F, 0);
        SEAM(8);
    }
    if (IN(9)) {
        PlainSched S; S.init(ws + WS_YRW, ws + WS_WO, T, 1024, 512, 512, 512, F.G, F.bid);
        EpiWo E{(bf16_t*)(ws + WS_XN), gates};
        if (F.bid & 1) p_conv_part(F, 1);
        gemm_phase(F.lds, S, E);
        if (!(F.bid & 1)) p_conv_part(F, 1);
        SEAM(9);
    }
    if (IN(10)) {
        PlainSched S; S.init(ws + WS_XN, ws + WS_WOUT, T, 1024, 1024, 1024, 1024, F.G, F.bid);
        EpiOut E{(bf16_t*)(ws + WS_HB), F.in[0]};
        if (F.bid & 1) p_conv_part(F, 2);
        gemm_phase(F.lds, S, E);
        if (!(F.bid & 1)) p_conv_part(F, 2);
        SEAM(10);
    }
    if (IN(11)) { REP(11) p_moe_prep(F); SEAM(11); }
    if (IN(12)) {
        PlainSched S; S.init(ws + WS_HB, ws + WS_WR, T, 256, 1024, 1024, 1024, F.G, F.bid);
        EpiRouter E{(float*)(ws + WS_LOG)};
        gemm_phase(F.lds, S, E);
        { Unit u; for (int i = 0; S.next(i, u); ++i) topk_rows(F, u.pm * BM); }
        SEAM(12);
    }
    if (IN(13)) { p_gather(F, 0); p_gather(F, 1); SEAM(13); }
#define MOE_G1(PASS, CIDX) \
            const int* te = (const int*)(ws + WS_TILEE) + (PASS) * TE_STRIDE; const int ntl = __builtin_amdgcn_readfirstlane(__hip_atomic_load(te, __ATOMIC_RELAXED, __HIP_MEMORY_SCOPE_AGENT)); \
            MoeSched<true> S; S.init(ws + WS_XN2F8, ws + WS_W1, te + 1, (const int*)(ws + WS_ROWTOK) + (size_t)(PASS) * MAXTILES * 256, ntl, 512, 8, F.G, (CIDX)); \
            EpiMoe1 E{(unsigned char*)(ws + WS_ACT) + (size_t)(PASS) * PASS_BUF, (const float*)(ws + WS_B1P)};
#define MOE_G2(PASS) \
            const int* te = (const int*)(ws + WS_TILEE) + (PASS) * TE_STRIDE; const int ntl = __builtin_amdgcn_readfirstlane(__hip_atomic_load(te, __ATOMIC_RELAXED, __HIP_MEMORY_SCOPE_AGENT)); \
            MoeSched<false> S; S.init(ws + WS_ACT + (size_t)(PASS) * PASS_BUF, ws + WS_W2, te + 1, nullptr, ntl, 512, 4, F.G, F.bid); \
            EpiMoe2 E{(unsigned char*)(ws + WS_XS) + (size_t)(PASS) * PASS_BUF, F.in[32], (const float*)(ws + WS_ROWG) + (size_t)(PASS) * MAXTILES * 256};
    if (IN(14)) { MOE_G1(0, F.bid) gemm_phase(F.lds, S, E); SEAM(14); }
    if (IN(15)) {
        { MOE_G2(0) gemm_phase(F.lds, S, E); }
        { MOE_G1(1, F.G - 1 - F.bid) gemm_phase(F.lds, S, E); }
        SEAM(15);
    }
    if (IN(16)) {
        if (F.bid & 1) p_combine(F, 0);
        { MOE_G2(1) gemm_phase(F.lds, S, E); }
        if (!(F.bid & 1)) p_combine(F, 0);
        SEAM(16);
    }
    if (IN(17)) { p_combine(F, 1); }
#undef MOE_G1
#undef MOE_G2
#undef IN
#undef SEAM
#undef REP
}

extern "C" void kernel_launch(void* const* d_in, const int* in_sizes, int n_in, void* d_out, int out_size, void* d_ws, size_t ws_size, hipStream_t stream) {
    static int grid = 0;
    if (grid == 0) {
        if (n_in != 34 || in_sizes[0] != T * D || out_size != T * D || ws_size < WS_END) { fprintf(stderr, "kernel_launch: unexpected shapes (n_in %d, in0 %d, out %d, ws %zu < %zu)\n", n_in, n_in > 0 ? in_sizes[0] : -1, out_size, ws_size, (size_t)WS_END); grid = -1; return; }
        int dev = 0, cus = 0, per_cu = 0;
        if (hipGetDevice(&dev) != hipSuccess || hipDeviceGetAttribute(&cus, hipDeviceAttributeMultiprocessorCount, dev) != hipSuccess) { grid = -1; return; }
        if (hipFuncSetAttribute((const void*)fwd_kernel, hipFuncAttributeMaxDynamicSharedMemorySize, LDS_BYTES) != hipSuccess) { fprintf(stderr, "kernel_launch: hipFuncSetAttribute failed\n"); grid = -1; return; }
        if (hipOccupancyMaxActiveBlocksPerMultiprocessor(&per_cu, (const void*)fwd_kernel, NTHR, LDS_BYTES) != hipSuccess || per_cu < 1) { fprintf(stderr, "kernel_launch: occupancy query says %d\n", per_cu); }
        (void)hipGetLastError();
        grid = cus;
    }
    if (grid < 0) return;
    (void)hipMemsetAsync((char*)d_ws + WS_CTL, 0, CTL_BYTES, stream);
    KArgs a{};
    for (int i = 0; i < 34; ++i) a.in[i] = (const float*)d_in[i];
    a.out = (float*)d_out; a.ws = (unsigned char*)d_ws;
    if (N_LAUNCH_MODE == 1) {
        a.ph_lo = 0; a.ph_hi = N_PHASES;
        hipLaunchKernelGGL(fwd_kernel, dim3(grid), dim3(NTHR), LDS_BYTES, stream, a);
    } else {
        for (int p = 0; p < N_PHASES; ++p) { a.ph_lo = p; a.ph_hi = p + 1; hipLaunchKernelGGL(fwd_kernel, dim3(grid), dim3(NTHR), LDS_BYTES, stream, a); }
    }
}
```

```cpp
#include <hip/hip_runtime.h>
#include <stdint.h>
#include <stdio.h>

#ifndef N_LAUNCH_MODE
#define N_LAUNCH_MODE 1
#endif

#ifndef GEMM_SP2
#define GEMM_SP2 1
#endif
#ifndef GEMM_ALIGN
#define GEMM_ALIGN 1
#endif
#ifndef PROBE_MASK
#define PROBE_MASK 0u
#endif
#define LAS __attribute__((address_space(3)))
#define DI __device__ __forceinline__
typedef unsigned short bf16_t;
typedef short bf16x8 __attribute__((ext_vector_type(8)));
typedef float f32x4 __attribute__((ext_vector_type(4)));
typedef float f32x2 __attribute__((ext_vector_type(2)));
typedef unsigned u32x4 __attribute__((ext_vector_type(4)));
typedef unsigned u32x2 __attribute__((ext_vector_type(2)));
typedef int i32x8 __attribute__((ext_vector_type(8)));
typedef int i32x4 __attribute__((ext_vector_type(4)));

constexpr int T = 65536, D = 1024, SEQ = 4096, NB = 16;
constexpr int INC = 4352, RWC = 1792;
constexpr int S5L = 32;
constexpr int S5NC = SEQ / S5L;
constexpr int S5ROWS = T / S5L;
constexpr int LDU = 16 * S5L + 128;
constexpr int NE = 32, TOPK = 4;
constexpr int NPASS = 2, TPP = T / NPASS;
constexpr int MAXTILES = (TPP * TOPK) / 256 + NE;
constexpr int NWAVES = 8, NTHR = 512;

constexpr size_t al(size_t x) { return (x + 4095) & ~(size_t)4095; }
constexpr size_t WS_CTL = 0, CTL_BYTES = 1 << 20;
constexpr size_t WS_WIN = WS_CTL + CTL_BYTES;
constexpr size_t WS_WGLU = WS_WIN + al((size_t)INC * D * 2);
constexpr size_t WS_WO = WS_WGLU + al((size_t)2048 * 512 * 2);
constexpr size_t WS_WOUT = WS_WO + al((size_t)1024 * 512 * 2);
constexpr size_t WS_WLORA = WS_WOUT + al((size_t)1024 * 1024 * 2);
constexpr size_t WS_WR = WS_WLORA + al((size_t)1536 * 256 * 2);
constexpr size_t WS_TOEP = WS_WR + al((size_t)256 * 1024 * 2);
constexpr size_t WS_WST = WS_TOEP + al((size_t)32 * 512 * LDU * 2);
constexpr size_t WS_BGLU = WS_WST + al((size_t)32 * 256 * 512 * 2);
constexpr size_t WS_B1P = WS_BGLU + al(2048 * 4);
constexpr size_t WS_SHARED = WS_B1P + al((size_t)32 * 2048 * 4);
constexpr size_t WS_PRW = WS_SHARED;
constexpr size_t WS_LWAG = WS_PRW + al((size_t)T * RWC * 2);
constexpr size_t WS_YS = WS_LWAG + al((size_t)T * 1536 * 2);
constexpr size_t WS_YRW = WS_YS + al((size_t)T * 512 * 2);
constexpr size_t WS_BONUS = WS_YRW + al((size_t)T * 512 * 2);
constexpr size_t WS_XN = WS_BONUS + al((size_t)T * 8 * 4);
constexpr size_t WS_US5 = WS_XN + al((size_t)T * D * 2);
constexpr size_t WS_ALORA = WS_US5 + al((size_t)32 * S5ROWS * LDU * 2);
constexpr size_t WS_SLOC = WS_ALORA + al((size_t)T * 256 * 2);
constexpr int RW_NCH = 128 * 64;
constexpr size_t CHK_BYTES = (size_t)RW_NCH * 4096 * 2;
constexpr size_t WS_CHK_M = WS_XN, WS_CHK_N0T = WS_CHK_M + CHK_BYTES, WS_CHK_Q = WS_CHK_N0T + CHK_BYTES, WS_CHK_Y0T = WS_CHK_Q + CHK_BYTES, WS_CHK_HT = WS_CHK_Y0T + CHK_BYTES;
constexpr size_t WS_MIX_END0 = WS_SLOC + al((size_t)32 * S5ROWS * 128 * 4);
constexpr size_t WS_MIX_END = (WS_CHK_HT + CHK_BYTES) > WS_MIX_END0 ? (WS_CHK_HT + CHK_BYTES) : WS_MIX_END0;
constexpr size_t WS_HB = WS_SHARED;
constexpr size_t WS_W1 = WS_HB + al((size_t)T * D * 2);
constexpr size_t WS_W2 = WS_W1 + al((size_t)32 * 2048 * 1024);
constexpr size_t WS_RS = WS_W2 + al((size_t)32 * 1024 * 1024);
constexpr size_t WS_LOG = WS_RS + al((size_t)T * 4);
constexpr size_t WS_EPOS = WS_LOG + al((size_t)T * 32 * 4);
constexpr size_t WS_GATEV = WS_EPOS + al((size_t)T * 4 * 4);
constexpr size_t WS_SLOT = WS_GATEV + al((size_t)T * 4 * 4);
constexpr size_t WS_ROWG = WS_SLOT + al((size_t)T * 4 * 4);
constexpr size_t WS_ROWTOK = WS_ROWG + al((size_t)NPASS * MAXTILES * 256 * 4);
constexpr size_t WS_TILEE = WS_ROWTOK + al((size_t)NPASS * MAXTILES * 256 * 4);
constexpr int TE_STRIDE = MAXTILES + 64;
constexpr size_t WS_XS = WS_TILEE + al((size_t)NPASS * (MAXTILES + 64) * 4);
constexpr size_t PASS_BUF = al((size_t)MAXTILES * 256 * 1024);
constexpr size_t WS_ACT = WS_XS + NPASS * PASS_BUF;
constexpr size_t WS_XN2F8 = WS_ACT + NPASS * PASS_BUF;
constexpr size_t WS_MOE_END = WS_XN2F8 + al((size_t)T * D);
static_assert(WS_W2 + (size_t)32 * 1024 * 1024 <= WS_SHARED + (size_t)T * RWC * 2, "converted expert weights must stay inside the (dead) PRW buffer while the GLU/Wo/out GEMM phases run");
constexpr size_t WS_END = WS_MIX_END > WS_MOE_END ? WS_MIX_END : WS_MOE_END;
static_assert(WS_END <= ((size_t)1 << 30), "workspace over 1 GiB");

constexpr int CW_BAR = 0;
constexpr int CW_GCNT = 4096;

constexpr float F8_SX = 16.f, F8_SW = 32.f, F8_SA = 4.f, F8_SY = 32.f;
constexpr int LDS_BYTES = 144 * 1024;
constexpr int MISC_OFF = 140 * 1024;

typedef __bf16 bf16x2_t __attribute__((ext_vector_type(2)));
DI unsigned cvt_pk_bf16(float lo, float hi) { f32x2 v = {lo, hi}; bf16x2_t b = __builtin_convertvector(v, bf16x2_t); return __builtin_bit_cast(unsigned, b); }
DI unsigned pk4_fp8(float a, float b, float c, float d) {
    a = fminf(fmaxf(a, -448.f), 448.f); b = fminf(fmaxf(b, -448.f), 448.f); c = fminf(fmaxf(c, -448.f), 448.f); d = fminf(fmaxf(d, -448.f), 448.f);
    int w = __builtin_amdgcn_cvt_pk_fp8_f32(a, b, 0, false); w = __builtin_amdgcn_cvt_pk_fp8_f32(c, d, w, true); return (unsigned)w; }
DI float bf_lo(unsigned u) { return __uint_as_float(u << 16); }
DI float bf_hi(unsigned u) { return __uint_as_float(u & 0xffff0000u); }
DI float bf2f(bf16_t b) { return __uint_as_float(((unsigned)b) << 16); }
DI bf16_t f2bf(float f) { return (bf16_t)(cvt_pk_bf16(f, 0.f) & 0xffffu); }
DI float fsigmoid(float x) { return __builtin_amdgcn_rcpf(1.0f + __expf(-x)); }
DI float ftanh(float x) { float e = __expf(2.0f * x); return 1.0f - 2.0f * __builtin_amdgcn_rcpf(e + 1.0f); }
DI float fgelu_tanh(float x) { float u = 0.7978845608f * (x + 0.044715f * x * x * x); return x * fsigmoid(2.0f * u); }
DI f32x2 lo2(const f32x4& v) { return __builtin_shufflevector(v, v, 0, 1); }
DI f32x2 hi2(const f32x4& v) { return __builtin_shufflevector(v, v, 2, 3); }
DI f32x2 pk_sigmoid_scaled(f32x2 x, float negk) {
    const f32x2 t = x * negk; f32x2 e; e.x = __builtin_amdgcn_exp2f(t.x); e.y = __builtin_amdgcn_exp2f(t.y);
    const f32x2 d = e + 1.0f; f32x2 r; r.x = __builtin_amdgcn_rcpf(d.x); r.y = __builtin_amdgcn_rcpf(d.y); return r; }
DI f32x2 pk_sigmoid(f32x2 x) { return pk_sigmoid_scaled(x, -1.44269504f); }
DI f32x2 pk_gelu_tanh(f32x2 x) { const f32x2 x2 = x * x; const f32x2 u = x * (x2 * (0.044715f * 0.7978845608f) + 0.7978845608f); return x * pk_sigmoid_scaled(u, -2.0f * 1.44269504f); }
DI unsigned pk4_fp8_nc(f32x2 a, f32x2 b) { int w = __builtin_amdgcn_cvt_pk_fp8_f32(a.x, a.y, 0, false); w = __builtin_amdgcn_cvt_pk_fp8_f32(b.x, b.y, w, true); return (unsigned)w; }
#define DPP_ROR_ADD(v, n) ((v) + __builtin_bit_cast(float, __builtin_amdgcn_update_dpp(0, __builtin_bit_cast(int, (v)), 0x120 + (n), 0xf, 0xf, false)))
DI float row_sum16(float v) { v = DPP_ROR_ADD(v, 8); v = DPP_ROR_ADD(v, 4); v = DPP_ROR_ADD(v, 2); v = DPP_ROR_ADD(v, 1); return v; }
DI float xrow_sum(float x) {
    float y = x;
    asm("s_nop 1\n\tv_permlane16_swap_b32 %0, %1\n\ts_nop 1" : "+v"(x), "+v"(y));
    x = x + y; y = x;
    asm("s_nop 1\n\tv_permlane32_swap_b32 %0, %1\n\ts_nop 1" : "+v"(x), "+v"(y));
    return x + y;
}
DI float wave_sum(float v) { return xrow_sum(row_sum16(v)); }
DI float sum16(float v) {
    v += __shfl_xor(v, 1); v += __shfl_xor(v, 2); v += __shfl_xor(v, 4); v += __shfl_xor(v, 8); return v;
}

#define XB_TMO      128
#define XB_XCNT(j)  (256  + 64 * (j))
#define XB_XSUB(j)  (1280 + 64 * (j))
#define XB_XGEN(j)  (2304 + 64 * (j))
#define XB_TOP      3328
#define XB_TOPGEN   3392
#define XCD_BAR_WORDS 3456
#define XB_SPIN_CAP (1u << 22)
DI unsigned xb_ld(unsigned* p)              { return __hip_atomic_load(p, __ATOMIC_RELAXED, __HIP_MEMORY_SCOPE_AGENT); }
DI unsigned xb_add(unsigned* p, unsigned v) { return __hip_atomic_fetch_add(p, v, __ATOMIC_RELAXED, __HIP_MEMORY_SCOPE_AGENT); }
DI unsigned xb_xcc_id() { return (unsigned)__builtin_amdgcn_s_getreg((3 << 11) | 20) & 0xFu; }
#define XB_SPIN(cond, bar) do { unsigned _sp = 0; while (cond) { __builtin_amdgcn_s_sleep(1); \
    if ((++_sp & 255u) == 0u) { if (xb_ld(&(bar)[XB_TMO])) break; if (_sp > XB_SPIN_CAP) { atomicAdd(&(bar)[XB_TMO], 1u); break; } } } } while (0)
struct XcdBarrier { unsigned* bar; unsigned x; volatile LAS unsigned* st; };
DI XcdBarrier xcd_barrier_post(unsigned* bar, volatile LAS unsigned* st) {
    XcdBarrier b; b.bar = bar; b.x = xb_xcc_id(); b.st = st;
    if (threadIdx.x == 0) (void)xb_add(&bar[XB_XCNT(b.x)], 1u);
    return b;
}
DI void xcd_barrier_complete(unsigned* bar, unsigned x, unsigned& nloc, unsigned& nx) {
    const unsigned G = gridDim.x * gridDim.y * gridDim.z;
    unsigned sum, cnt, mine, sp = 0u;
    for (;;) {
        sum = 0u; cnt = 0u; mine = 0u;
#pragma unroll
        for (unsigned j = 0; j < 16; ++j) { const unsigned c = xb_ld(&bar[XB_XCNT(j)]); sum += c; cnt += (c > 0u) ? 1u : 0u; mine = (j == x) ? c : mine; }
        if (sum == G) break;
        __builtin_amdgcn_s_sleep(1);
        if ((++sp & 255u) == 0u) { if (xb_ld(&bar[XB_TMO])) break; if (sp > XB_SPIN_CAP) { atomicAdd(&bar[XB_TMO], 1u); break; } }
    }
    nloc = mine > 0u ? mine : 1u; nx = cnt > 0u ? cnt : 1u;
}
DI void xcd_barrier(const XcdBarrier& b) {
    asm volatile("s_waitcnt vmcnt(0)" ::: "memory");
    __syncthreads();
    if (threadIdx.x == 0) {
        unsigned* bar = b.bar;
        __builtin_amdgcn_s_waitcnt(0);
        unsigned nloc = b.st[0], nx = b.st[1];
        if (nloc == 0u) { xcd_barrier_complete(bar, b.x, nloc, nx); b.st[0] = nloc; b.st[1] = nx; }
        const unsigned old = xb_add(&bar[XB_XSUB(b.x)], 1u);
        const unsigned gen = old / nloc;
        if (old + 1u == (gen + 1u) * nloc) {
            __builtin_amdgcn_fence(__ATOMIC_RELEASE, "agent");
            asm volatile("s_waitcnt vmcnt(0)" ::: "memory");
            const unsigned og = xb_add(&bar[XB_TOP], 1u);
            const unsigned tg = og / nx;
            if (og + 1u == (tg + 1u) * nx) xb_add(&bar[XB_TOPGEN], 1u);
            else XB_SPIN(xb_ld(&bar[XB_TOPGEN]) == tg, bar);
            __builtin_amdgcn_fence(__ATOMIC_ACQUIRE, "agent");
            xb_add(&bar[XB_XGEN(b.x)], 1u);
            asm volatile("s_waitcnt vmcnt(0)" ::: "memory");
        } else {
            XB_SPIN(xb_ld(&bar[XB_XGEN(b.x)]) == gen, bar);
            __builtin_amdgcn_fence(__ATOMIC_ACQUIRE, "agent");
            asm volatile("s_waitcnt vmcnt(0)" ::: "memory");
        }
    }
    __syncthreads();
}

constexpr int BM = 256, BK = 64, HALF = 128, HTB = HALF * BK * 2;
DI int lds_byte(int r, int c) { const int st = (r >> 4) * 2 + (c >> 5), rr = r & 15, cc = c & 31, ob = rr * 64 + cc * 2; return st * 1024 + (ob ^ (((ob >> 9) & 1) << 5)); }
DI void stage_rc(int b, int& R, int& C) { const int st = b / 1024, sb = b % 1024, swz = sb ^ (((sb >> 9) & 1) << 5); R = (st >> 1) * 16 + swz / 64; C = (st & 1) * 32 + (swz % 64) / 2; }
DI int perm32(int rho) { const int n = rho >> 4, i = rho & 15; return 8 * (i >> 2) + 4 * n + (i & 3); }
struct Unit { int pm, pn, aux; };

template <class Sched, class Epi>
DI void gemm_phase(LAS unsigned char* lds, const Sched& S, const Epi& E) {
    const int tid = threadIdx.x, wid = __builtin_amdgcn_readfirstlane(tid >> 6), lane = tid & 63, wr = wid >> 2, wc = wid & 3, fr = lane & 15, fq = lane >> 4;
    const int K = S.K, nt = K / BK;
    unsigned voffA[2], voffB[2];
#pragma unroll
    for (int i = 0; i < 2; ++i) { int R, C; stage_rc(tid * 16 + i * 8192, R, C); const int Rb = Epi::PERM ? ((R & ~31) + perm32(R & 31)) : R;
        voffA[i] = (unsigned)(R * S.lda + C) * 2u; voffB[i] = (unsigned)(Rb * S.ldb + C) * 2u; }
    const size_t kstep = (size_t)(BK * 2);
    const size_t hstepA = (size_t)HALF * S.lda * 2, hstepB = (size_t)HALF * S.ldb * 2;
    const unsigned ldsw = (unsigned)wid * 1024u;
    const int aoff = lds_byte(wr * 64 + fr, fq * 8), boff = lds_byte(wc * 32 + fr, fq * 8);
#define PG8_SA(b, h) (((b) * 2 + (h)) * HTB)
#define PG8_SB(b, h) ((4 + (b) * 2 + (h)) * HTB)
    const unsigned ldsbase = (unsigned)(size_t)lds;
#define PG8_STAGE(bufoff, gbase, voff) do { _Pragma("unroll") for (int _i = 0; _i < 2; ++_i) \
        asm volatile("s_mov_b32 m0, %0\n\ts_nop 0\n\tglobal_load_lds_dwordx4 %1, %2" :: "s"(ldsbase + (unsigned)(bufoff) + ldsw + (unsigned)(_i * 8192)), "v"((voff)[_i]), "s"((const char*)(gbase)) : "memory"); } while (0)
#define PG8_LDA(dst, b, h) do { _Pragma("unroll") for (int m = 0; m < 4; ++m) _Pragma("unroll") for (int k = 0; k < 2; ++k) dst[m][k] = *(const LAS bf16x8*)(lds + PG8_SA(b, h) + aoff + m * 2048 + k * 1024); } while (0)
#define PG8_LDB(dst, b, h) do { _Pragma("unroll") for (int n = 0; n < 2; ++n) _Pragma("unroll") for (int k = 0; k < 2; ++k) dst[n][k] = *(const LAS bf16x8*)(lds + PG8_SB(b, h) + boff + n * 2048 + k * 1024); } while (0)
#define PG8_MMA(ai, bj, At, Bt) do { __builtin_amdgcn_s_setprio(1); _Pragma("unroll") for (int m = 0; m < 4; ++m) _Pragma("unroll") for (int n = 0; n < 2; ++n) _Pragma("unroll") for (int k = 0; k < 2; ++k) \
        acc[ai][bj][m][n] = __builtin_amdgcn_mfma_f32_16x16x32_bf16(Bt[n][k], At[m][k], acc[ai][bj][m][n], 0, 0, 0); __builtin_amdgcn_s_setprio(0); } while (0)
#define PG8_WAIT_V(n) asm volatile("s_waitcnt vmcnt(" #n ")" ::: "memory")
#define PG8_WAIT_L(n) asm volatile("s_waitcnt lgkmcnt(" #n ")" ::: "memory")
#define PG8_BAR __builtin_amdgcn_s_barrier()
#define PG8_SCHED __builtin_amdgcn_sched_barrier(0)
    Unit cur, nxt; int ui = 0;
    if (!S.next(0, cur)) return;
    f32x4 acc[2][2][4][2];
#pragma unroll
    for (int a = 0; a < 2; ++a)
#pragma unroll
        for (int b = 0; b < 2; ++b)
#pragma unroll
            for (int m = 0; m < 4; ++m)
#pragma unroll
                for (int n = 0; n < 2; ++n) { if constexpr (Sched::FP8) { f32x2 z0_, z1_; asm volatile("v_pk_mov_b32 %0, 0, 0" : "=v"(z0_)); asm volatile("v_pk_mov_b32 %0, 0, 0" : "=v"(z1_)); acc[a][b][m][n] = (f32x4){z0_.x, z0_.y, z1_.x, z1_.y}; } else acc[a][b][m][n] = (f32x4){0.f, 0.f, 0.f, 0.f}; }
    bf16x8 At[4][2], B0[2][2], B1[2][2];
    i32x8 At8[4], B08[2], B18[2];
    const int aoff8a = lds_byte(wr * 64 + fr, 16 * fq) & ~16, boff8a = lds_byte(wc * 32 + fr, 16 * fq) & ~16;
#define PG8_LDA8(dst, b, h) do { _Pragma("unroll") for (int m = 0; m < 4; ++m) dst[m] = *(const LAS i32x8*)(lds + PG8_SA(b, h) + aoff8a + m * 2048); } while (0)
#define PG8_LDB8(dst, b, h) do { _Pragma("unroll") for (int n = 0; n < 2; ++n) dst[n] = *(const LAS i32x8*)(lds + PG8_SB(b, h) + boff8a + n * 2048); } while (0)
#define PG8_MMA8(ai, bj, At_, Bt_) do { __builtin_amdgcn_s_setprio(1); _Pragma("unroll") for (int m = 0; m < 4; ++m) _Pragma("unroll") for (int n = 0; n < 2; ++n) \
        acc[ai][bj][m][n] = __builtin_amdgcn_mfma_scale_f32_16x16x128_f8f6f4(Bt_[n], At_[m], acc[ai][bj][m][n], 0, 0, 0, 0x7f7f7f7f, 0, 0x7f7f7f7f); __builtin_amdgcn_s_setprio(0); } while (0)
#define XLDA(b, h) do { if constexpr (Sched::FP8) PG8_LDA8(At8, b, h); else PG8_LDA(At, b, h); } while (0)
#define XLDB0(b, h) do { if constexpr (Sched::FP8) PG8_LDB8(B08, b, h); else PG8_LDB(B0, b, h); } while (0)
#define XLDB1(b, h) do { if constexpr (Sched::FP8) PG8_LDB8(B18, b, h); else PG8_LDB(B1, b, h); } while (0)
#define XMMA0(ai, bj) do { if constexpr (Sched::FP8) PG8_MMA8(ai, bj, At8, B08); else PG8_MMA(ai, bj, At, B0); } while (0)
#define XMMA1(ai, bj) do { if constexpr (Sched::FP8) PG8_MMA8(ai, bj, At8, B18); else PG8_MMA(ai, bj, At, B1); } while (0)
    const char* cA = S.a_ptr(cur); const char* cB = S.b_ptr(cur);
    unsigned offA[2][2], offN[2][2];
    if constexpr (Sched::GATHER) {
#pragma unroll
        for (int h = 0; h < 2; ++h)
#pragma unroll
            for (int i = 0; i < 2; ++i) { int R, C; stage_rc(tid * 16 + i * 8192, R, C); offA[h][i] = S.a_rowoff(cur, h * HALF + R) + (unsigned)C * 2u; offN[h][i] = offA[h][i]; }
    }
#define A_STG(bufoff, plainptr, kt, h, nx) do { if constexpr (Sched::GATHER) { PG8_STAGE(bufoff, cA + (size_t)(kt) * kstep, offA[h]); } \
        else PG8_STAGE(bufoff, plainptr, voffA); } while (0)
    if constexpr (GEMM_SP2) {
        PG8_STAGE(PG8_SB(0, 0), cB, voffB); PG8_STAGE(PG8_SB(0, 1), cB + hstepB, voffB); A_STG(PG8_SA(0, 0), cA, 0, 0, false); A_STG(PG8_SA(0, 1), cA + hstepA, 0, 1, false);
        if (wr == 1) PG8_BAR;
        PG8_WAIT_V(2); PG8_BAR;
        PG8_STAGE(PG8_SB(1, 0), cB + kstep, voffB); A_STG(PG8_SA(1, 0), cA + kstep, 1, 0, false); PG8_STAGE(PG8_SB(1, 1), cB + hstepB + kstep, voffB);
        PG8_WAIT_V(6); PG8_BAR;
    } else {
    PG8_STAGE(PG8_SB(0, 0), cB, voffB); A_STG(PG8_SA(0, 0), cA, 0, 0, false); PG8_STAGE(PG8_SB(0, 1), cB + hstepB, voffB); A_STG(PG8_SA(0, 1), cA + hstepA, 0, 1, false);
    if (wr == 1) PG8_BAR;
    PG8_WAIT_V(4); PG8_BAR;
    PG8_STAGE(PG8_SB(1, 0), cB + kstep, voffB); A_STG(PG8_SA(1, 0), cA + kstep, 1, 0, false); PG8_STAGE(PG8_SB(1, 1), cB + hstepB + kstep, voffB);
    PG8_WAIT_V(6); PG8_BAR;
    }
    for (;;) {
        const bool has_next = S.next(ui + 1, nxt);
        const char* nA = has_next ? S.a_ptr(nxt) : cA; const char* nB = has_next ? S.b_ptr(nxt) : cB;
        for (int t = 0; t < nt; t += 2) {
            const bool last = (t == nt - 2);
            const char* a1 = cA + (size_t)(t + 1) * kstep;
            const char* a2 = last ? nA : cA + (size_t)(t + 2) * kstep; const char* b2 = last ? nB : cB + (size_t)(t + 2) * kstep;
            const char* a3 = a2 + kstep; const char* b3 = b2 + kstep;
            const int k2 = last ? 0 : t + 2, k3 = k2 + 1;
            if constexpr (GEMM_SP2) {
            XLDB0(0, 0); XLDB1(0, 1); PG8_SCHED; XLDA(0, 0); A_STG(PG8_SA(1, 1), a1 + hstepA, t + 1, 1, false);
            if constexpr (Sched::GATHER) {
                if (has_next && (t == nt - 4 || nt < 4)) {
#pragma unroll
                    for (int h = 0; h < 2; ++h)
#pragma unroll
                        for (int i = 0; i < 2; ++i) { int R, C; stage_rc(tid * 16 + i * 8192, R, C); offN[h][i] = S.a_rowoff(nxt, h * HALF + R) + (unsigned)C * 2u; } }
                if (last && has_next) { offA[0][0] = offN[0][0]; offA[0][1] = offN[0][1]; offA[1][0] = offN[1][0]; offA[1][1] = offN[1][1]; }
            }
            PG8_WAIT_V(8); PG8_WAIT_L(0); PG8_BAR; XMMA0(0, 0); XMMA1(0, 1); PG8_BAR; PG8_SCHED;
            XLDA(0, 1); PG8_STAGE(PG8_SB(0, 0), b2, voffB); PG8_STAGE(PG8_SB(0, 1), b2 + hstepB, voffB); A_STG(PG8_SA(0, 0), a2, k2, 0, last);
            PG8_WAIT_V(8); PG8_WAIT_L(0); PG8_BAR; XMMA0(1, 0); XMMA1(1, 1); PG8_BAR; PG8_SCHED;
            XLDB0(1, 0); XLDB1(1, 1); PG8_SCHED; XLDA(1, 0); A_STG(PG8_SA(0, 1), a2 + hstepA, k2, 1, last);
            PG8_WAIT_V(8); PG8_WAIT_L(0); PG8_BAR; XMMA0(0, 0); XMMA1(0, 1); PG8_BAR; PG8_SCHED;
            XLDA(1, 1); PG8_STAGE(PG8_SB(1, 0), b3, voffB); PG8_STAGE(PG8_SB(1, 1), b3 + hstepB, voffB); A_STG(PG8_SA(1, 0), a3, k3, 0, last);
            PG8_WAIT_V(8); PG8_WAIT_L(0); PG8_BAR; XMMA0(1, 0); XMMA1(1, 1); PG8_BAR; PG8_SCHED;
            } else {
            XLDB0(0, 0); PG8_SCHED; XLDA(0, 0); A_STG(PG8_SA(1, 1), a1 + hstepA, t + 1, 1, false);
            if constexpr (Sched::GATHER) {
                if (has_next && (t == nt - 4 || nt < 4)) {
#pragma unroll
                    for (int h = 0; h < 2; ++h)
#pragma unroll
                        for (int i = 0; i < 2; ++i) { int R, C; stage_rc(tid * 16 + i * 8192, R, C); offN[h][i] = S.a_rowoff(nxt, h * HALF + R) + (unsigned)C * 2u; } }
                if (last && has_next) { offA[0][0] = offN[0][0]; offA[0][1] = offN[0][1]; offA[1][0] = offN[1][0]; offA[1][1] = offN[1][1]; }
            }
            PG8_WAIT_L(8); PG8_BAR; PG8_WAIT_L(0); XMMA0(0, 0); PG8_BAR; PG8_SCHED;
            XLDB1(0, 1); PG8_STAGE(PG8_SB(0, 0), b2, voffB);
            PG8_BAR; PG8_WAIT_L(0); XMMA1(0, 1); PG8_BAR;
            XLDA(0, 1); A_STG(PG8_SA(0, 0), a2, k2, 0, last);
            PG8_BAR; PG8_WAIT_L(0); XMMA0(1, 0); PG8_BAR; PG8_SCHED;
            PG8_STAGE(PG8_SB(0, 1), b2 + hstepB, voffB);
            PG8_WAIT_V(6); PG8_BAR; XMMA1(1, 1); PG8_BAR;
            XLDB0(1, 0); PG8_SCHED; XLDA(1, 0); A_STG(PG8_SA(0, 1), a2 + hstepA, k2, 1, last);
            PG8_WAIT_L(8); PG8_BAR; PG8_WAIT_L(0); XMMA0(0, 0); PG8_BAR; PG8_SCHED;
            XLDB1(1, 1); PG8_STAGE(PG8_SB(1, 0), b3, voffB);
            PG8_BAR; PG8_WAIT_L(0); XMMA1(0, 1); PG8_BAR;
            XLDA(1, 1); A_STG(PG8_SA(1, 0), a3, k3, 0, last);
            PG8_BAR; PG8_WAIT_L(0); XMMA0(1, 0); PG8_BAR; PG8_SCHED;
            PG8_STAGE(PG8_SB(1, 1), b3 + hstepB, voffB);
            PG8_WAIT_V(6); PG8_BAR; XMMA1(1, 1); PG8_BAR;
            }
        }
        if constexpr (GEMM_ALIGN) { if (wr == 0) PG8_BAR; }
        {
            int tz = threadIdx.x; asm volatile("" : "+v"(tz));
            const int wid2 = tz >> 6, lane2 = tz & 63;
            E(acc, cur, wid2 >> 2, wid2 & 3, lane2 & 15, lane2 >> 4); }
        if (!has_next) break;
#pragma unroll
        for (int a = 0; a < 2; ++a)
#pragma unroll
            for (int b = 0; b < 2; ++b)
#pragma unroll
                for (int m = 0; m < 4; ++m)
#pragma unroll
                    for (int n = 0; n < 2; ++n) { if constexpr (Sched::FP8) { f32x2 z0_, z1_; asm volatile("v_pk_mov_b32 %0, 0, 0" : "=v"(z0_)); asm volatile("v_pk_mov_b32 %0, 0, 0" : "=v"(z1_)); acc[a][b][m][n] = (f32x4){z0_.x, z0_.y, z1_.x, z1_.y}; } else acc[a][b][m][n] = (f32x4){0.f, 0.f, 0.f, 0.f}; }
        cur = nxt; cA = nA; cB = nB; ++ui;
        if constexpr (GEMM_ALIGN) { if (wr == 1) PG8_BAR; }
    }
    PG8_WAIT_V(0);
    if constexpr (!GEMM_ALIGN) { if (wr == 0) PG8_BAR; }
    PG8_BAR;
#undef XLDA
#undef XLDB0
#undef XLDB1
#undef XMMA0
#undef XMMA1
#undef PG8_LDA8
#undef PG8_LDB8
#undef PG8_MMA8
#undef A_STG
#undef PG8_SA
#undef PG8_SB
#undef PG8_STAGE
#undef PG8_LDA
#undef PG8_LDB
#undef PG8_MMA
#undef PG8_WAIT_V
#undef PG8_WAIT_L
#undef PG8_BAR
#undef PG8_SCHED
}

struct PlainSched {
    static constexpr bool GATHER = false, FP8 = false;
    const char* A; const char* B; int K, lda, ldb, nM, nN, nwg, G, c; int akoff_pn = 1 << 30, akoff_bytes = 0;
    DI void init(const void* A_, const void* B_, int M, int N, int K_, int lda_, int ldb_, int G_, int c_) { A = (const char*)A_; B = (const char*)B_; K = K_; lda = lda_; ldb = ldb_; nM = M / BM; nN = N / BM; nwg = nM * nN; G = G_; c = c_; }
    DI bool next(int i, Unit& u) const {
        const long L = (long)i * G + c; if (L >= nwg) return false;
        int wgid = (int)L; { const int q = nwg / 8, r = nwg % 8, xcd = wgid % 8, off = wgid / 8; wgid = (xcd < r ? xcd * (q + 1) : r * (q + 1) + (xcd - r) * q) + off; }
        const int nig = 8 * nN, gid = wgid / nig, fm = gid * 8, gsz = (nM - fm) < 8 ? (nM - fm) : 8;
        u.pm = fm + ((wgid % nig) % gsz); u.pn = (wgid % nig) / gsz; u.aux = 0; return true;
    }
    DI const char* a_ptr(const Unit& u) const { return A + (size_t)u.pm * BM * lda * 2 + (u.pn >= akoff_pn ? akoff_bytes : 0); }
    DI const char* b_ptr(const Unit& u) const { return B + (size_t)u.pn * BM * ldb * 2; }
};
struct GroupSched {
    static constexpr bool GATHER = false, FP8 = false;
    const char* A; const char* B; int K, lda, ldb, nMg, nN, nwg, G, c;
    DI void init(const void* A_, const void* B_, int K_, int lda_, int ldb_, int nMg_, int nN_, int G_, int c_) { A = (const char*)A_; B = (const char*)B_; K = K_; lda = lda_; ldb = ldb_; nMg = nMg_; nN = nN_; nwg = 32 * nMg * nN; G = G_; c = c_; }
    DI bool next(int i, Unit& u) const {
        const int L = i * G + c; if (L >= nwg) return false;
        const int per = nMg * nN, g = L / per, rem = L % per; u.pm = g * nMg + rem / nN; u.pn = rem % nN; u.aux = g; return true;
    }
    DI const char* a_ptr(const Unit& u) const { return A + (size_t)u.pm * BM * lda * 2; }
    DI const char* b_ptr(const Unit& u) const { return B + ((size_t)u.aux * nN + u.pn) * BM * ldb * 2; }
};
template <bool GATH>
struct MoeSched {
    static constexpr bool GATHER = GATH, FP8 = true;
    const char* A; const char* B; const int* tile_e; const int* rowtok; int K, lda, ldb, nN, NperE, nwg, G, c;
    DI void init(const void* A_, const void* B_, const int* te, const int* rt, int ntiles, int K_, int nN_, int G_, int c_) { A = (const char*)A_; B = (const char*)B_; tile_e = te; rowtok = rt; K = K_; lda = K_; ldb = K_; nN = nN_; NperE = nN_ * BM; nwg = ntiles * nN_; G = G_; c = c_; }
    DI bool next(int i, Unit& u) const {
        int L = i * G + c; if (L >= nwg) return false;
        if (G == 256 && (i + 1) * G <= nwg) { const int x = c & 7, sl = c >> 3, mt = G / nN / 8;
            L = i * G + (x * mt + sl / nN) * nN + (sl % nN); }
        u.pm = L / nN; u.pn = L % nN; u.aux = __builtin_amdgcn_readfirstlane(__hip_atomic_load(tile_e + u.pm, __ATOMIC_RELAXED, __HIP_MEMORY_SCOPE_AGENT)); return true;
    }
    DI const char* a_ptr(const Unit& u) const { return GATH ? A : A + (size_t)u.pm * BM * lda * 2; }
    DI unsigned a_rowoff(const Unit& u, int row) const { return (unsigned)__hip_atomic_load(rowtok + u.pm * BM + row, __ATOMIC_RELAXED, __HIP_MEMORY_SCOPE_AGENT) * (unsigned)(lda * 2); }
    DI const char* b_ptr(const Unit& u) const { return B + ((size_t)u.aux * NperE + (size_t)u.pn * BM) * ldb * 2; }
};

typedef f32x4 AccT[2][2][4][2];
struct EpiWin {
    static constexpr bool PERM = true;
    bf16_t* us5; bf16_t* prw; bf16_t* gates;
    DI static u32x4 pack8(const f32x4& v0, const f32x4& v1) { u32x4 w; w.x = cvt_pk_bf16(v0[0], v0[1]); w.y = cvt_pk_bf16(v0[2], v0[3]); w.z = cvt_pk_bf16(v1[0], v1[1]); w.w = cvt_pk_bf16(v1[2], v1[3]); return w; }
    DI void operator()(const AccT& acc, const Unit& u, int wr, int wc, int fr, int fq) const {
        if (u.pn < 2) {
#pragma unroll
            for (int ai = 0; ai < 2; ++ai)
#pragma unroll
                for (int m = 0; m < 4; ++m) { const int r = u.pm * BM + ai * HALF + wr * 64 + m * 16 + fr, b = r >> 12, sq = r & 4095, ch = sq / S5L, j = sq % S5L;
#pragma unroll
                    for (int bj = 0; bj < 2; ++bj) { const int c0 = u.pn * BM + bj * HALF + wc * 32 + 8 * fq, g = c0 >> 4, ci = c0 & 15;
                        *(u32x4*)(us5 + ((size_t)(g * S5ROWS + b * S5NC + ch) * LDU + j * 16 + ci)) = pack8(acc[ai][bj][m][0], acc[ai][bj][m][1]); } }
        } else if (u.pn < 9) {
#pragma unroll
            for (int ai = 0; ai < 2; ++ai)
#pragma unroll
                for (int m = 0; m < 4; ++m) { const int r = u.pm * BM + ai * HALF + wr * 64 + m * 16 + fr;
#pragma unroll
                    for (int bj = 0; bj < 2; ++bj) { const int c0 = u.pn * BM + bj * HALF + wc * 32 + 8 * fq;
                        *(u32x4*)(prw + (size_t)r * RWC + (c0 - 512)) = pack8(acc[ai][bj][m][0], acc[ai][bj][m][1]); } }
        } else {
#pragma unroll
            for (int ai = 0; ai < 2; ++ai)
#pragma unroll
                for (int m = 0; m < 4; ++m) { const int r = u.pm * BM + ai * HALF + wr * 64 + m * 16 + fr;
#pragma unroll
                    for (int bj = 0; bj < 2; ++bj) { const int c0 = u.pn * BM + bj * HALF + wc * 32 + 8 * fq;
                        const f32x4& v0 = acc[ai][bj][m][0]; const f32x4& v1 = acc[ai][bj][m][1];
                        const f32x2 a_ = pk_sigmoid(lo2(v0)), b_ = pk_sigmoid(hi2(v0)), c_ = pk_sigmoid(lo2(v1)), d_ = pk_sigmoid(hi2(v1));
                        u32x4 w; w.x = cvt_pk_bf16(a_.x, a_.y); w.y = cvt_pk_bf16(b_.x, b_.y); w.z = cvt_pk_bf16(c_.x, c_.y); w.w = cvt_pk_bf16(d_.x, d_.y);
                        *(u32x4*)(gates + (size_t)r * 2048 + (c0 - 2304)) = w; } }
        }
    }
};
struct EpiS5State {
    static constexpr bool PERM = false;
    float* sloc;
    DI void operator()(const AccT& acc, const Unit& u, int wr, int wc, int fr, int fq) const {
#pragma unroll
        for (int ai = 0; ai < 2; ++ai)
#pragma unroll
            for (int m = 0; m < 4; ++m) {
                const int r = u.pm * BM + ai * HALF + wr * 64 + m * 16 + fr;
#pragma unroll
                for (int n = 0; n < 2; ++n) *(f32x4*)(sloc + (size_t)r * 128 + wc * 32 + 16 * n + 4 * fq) = acc[ai][0][m][n];
            }
    }
};
struct EpiS5Out {
    static constexpr bool PERM = true;
    bf16_t* ys;
    DI void operator()(const AccT& acc, const Unit& u, int wr, int wc, int fr, int fq) const {
        const int g = u.aux;
#pragma unroll
        for (int ai = 0; ai < 2; ++ai)
#pragma unroll
            for (int m = 0; m < 4; ++m) {
                const int r = u.pm * BM + ai * HALF + wr * 64 + m * 16 + fr;
                const int rc = r - g * S5ROWS;
#pragma unroll
                for (int bj = 0; bj < 2; ++bj) {
                    const int c0 = u.pn * BM + bj * HALF + wc * 32 + 8 * fq;
                    const int t = c0 >> 4, co = c0 & 15;
                    const size_t tok = (size_t)rc * S5L + t;
                    f32x4 v0 = acc[ai][bj][m][0], v1 = acc[ai][bj][m][1];
                    { const f32x2 a_ = pk_gelu_tanh(lo2(v0)), b_ = pk_gelu_tanh(hi2(v0)), c_ = pk_gelu_tanh(lo2(v1)), d_ = pk_gelu_tanh(hi2(v1));
                      v0 = (f32x4){a_.x, a_.y, b_.x, b_.y}; v1 = (f32x4){c_.x, c_.y, d_.x, d_.y}; }
                    u32x4 w; w.x = cvt_pk_bf16(v0[0], v0[1]); w.y = cvt_pk_bf16(v0[2], v0[3]); w.z = cvt_pk_bf16(v1[0], v1[1]); w.w = cvt_pk_bf16(v1[2], v1[3]);
                    *(u32x4*)(ys + tok * 512 + g * 16 + co) = w;
                }
            }
    }
};
struct EpiLora {
    static constexpr bool PERM = true;
    bf16_t* lwag; const float* w0; const float* a0;
    DI void operator()(const AccT& acc, const Unit& u, int wr, int wc, int fr, int fq) const {
#pragma unroll
        for (int bj = 0; bj < 2; ++bj) {
            const int c0 = u.pn * BM + bj * HALF + wc * 32 + 8 * fq;
            f32x4 b0 = (f32x4){0.f, 0.f, 0.f, 0.f}, b1 = b0;
            if (c0 < 512) { b0 = *(const f32x4*)(w0 + c0); b1 = *(const f32x4*)(w0 + c0 + 4); } else if (c0 < 1024) { b0 = *(const f32x4*)(a0 + c0 - 512); b1 = *(const f32x4*)(a0 + c0 - 508); }
            const f32x2 bias[4] = {lo2(b0), hi2(b0), lo2(b1), hi2(b1)};
            const float osc = (c0 < 512) ? -0.6065306597f : 1.0f;
            if (c0 < 1024) {
#pragma unroll
                for (int ai = 0; ai < 2; ++ai)
#pragma unroll
                    for (int m = 0; m < 4; ++m) { const int r = u.pm * BM + ai * HALF + wr * 64 + m * 16 + fr; u32x4 w;
#pragma unroll
                        for (int jp = 0; jp < 4; ++jp) { const f32x4& a = acc[ai][bj][m][jp >> 1]; const f32x2 v = pk_sigmoid(((jp & 1) ? hi2(a) : lo2(a)) + bias[jp]) * osc; w[jp] = cvt_pk_bf16(v.x, v.y); }
                        *(u32x4*)(lwag + (size_t)r * 1536 + c0) = w; }
            } else {
#pragma unroll
                for (int ai = 0; ai < 2; ++ai)
#pragma unroll
                    for (int m = 0; m < 4; ++m) { const int r = u.pm * BM + ai * HALF + wr * 64 + m * 16 + fr; u32x4 w;
#pragma unroll
                        for (int jp = 0; jp < 4; ++jp) { const f32x4& a = acc[ai][bj][m][jp >> 1]; const f32x2 v = (jp & 1) ? hi2(a) : lo2(a); w[jp] = cvt_pk_bf16(v.x, v.y); }
                        *(u32x4*)(lwag + (size_t)r * 1536 + c0) = w; }
            }
        }
    }
};
struct EpiGlu {
    static constexpr bool PERM = true;
    bf16_t* mixed; const bf16_t* gates; const float* bglu;
    DI void operator()(const AccT& acc, const Unit& u, int wr, int wc, int fr, int fq) const {
        const int cw = wc * 32 + 8 * fq, j0 = u.pn * 128 + cw;
        const float* bp = bglu + u.pn * 256 + cw;
        const f32x4 ba0 = *(const f32x4*)bp, ba1 = *(const f32x4*)(bp + 4), bb0 = *(const f32x4*)(bp + 128), bb1 = *(const f32x4*)(bp + 132);
        const f32x2 ba[4] = {lo2(ba0), hi2(ba0), lo2(ba1), hi2(ba1)}, bb[4] = {lo2(bb0), hi2(bb0), lo2(bb1), hi2(bb1)};
        u32x4 gw[2][4];
#pragma unroll
        for (int ai = 0; ai < 2; ++ai)
#pragma unroll
            for (int m = 0; m < 4; ++m) gw[ai][m] = *(const u32x4*)(gates + (size_t)(u.pm * BM + ai * HALF + wr * 64 + m * 16 + fr) * 2048 + j0);
#pragma unroll
        for (int ai = 0; ai < 2; ++ai)
#pragma unroll
            for (int m = 0; m < 4; ++m) {
                const int r = u.pm * BM + ai * HALF + wr * 64 + m * 16 + fr;
                u32x4 w;
#pragma unroll
                for (int jp = 0; jp < 4; ++jp) {
                    const f32x4& aa = acc[ai][0][m][jp >> 1]; const f32x4& ab = acc[ai][1][m][jp >> 1];
                    const f32x2 za = ((jp & 1) ? hi2(aa) : lo2(aa)) + ba[jp], zb = ((jp & 1) ? hi2(ab) : lo2(ab)) + bb[jp];
                    const unsigned gwd = gw[ai][m][jp]; const f32x2 gt = {bf_lo(gwd), bf_hi(gwd)};
                    const f32x2 o = (gt * za) * pk_sigmoid(zb);
                    w[jp] = cvt_pk_bf16(o.x, o.y);
                }
                *(u32x4*)(mixed + (size_t)r * 1024 + j0) = w;
            }
    }
};
struct EpiWo {
    static constexpr bool PERM = true;
    bf16_t* mixed; const bf16_t* gates;
    DI void operator()(const AccT& acc, const Unit& u, int wr, int wc, int fr, int fq) const {
#pragma unroll
        for (int ai = 0; ai < 2; ++ai) {
            u32x4 gw[4][2], mw[4][2];
#pragma unroll
            for (int m = 0; m < 4; ++m)
#pragma unroll
                for (int bj = 0; bj < 2; ++bj) { const size_t r = (size_t)(u.pm * BM + ai * HALF + wr * 64 + m * 16 + fr); const int c0 = u.pn * BM + bj * HALF + wc * 32 + 8 * fq;
                    gw[m][bj] = *(const u32x4*)(gates + r * 2048 + 1024 + c0); mw[m][bj] = *(const u32x4*)(mixed + r * 1024 + c0); }
#pragma unroll
            for (int m = 0; m < 4; ++m)
#pragma unroll
                for (int bj = 0; bj < 2; ++bj) { const size_t r = (size_t)(u.pm * BM + ai * HALF + wr * 64 + m * 16 + fr); const int c0 = u.pn * BM + bj * HALF + wc * 32 + 8 * fq;
                    u32x4 w;
#pragma unroll
                    for (int jp = 0; jp < 4; ++jp) { const unsigned gwd = gw[m][bj][jp], mwd = mw[m][bj][jp]; const f32x4& a = acc[ai][bj][m][jp >> 1];
                        const f32x2 o = (f32x2){bf_lo(mwd), bf_hi(mwd)} + (f32x2){bf_lo(gwd), bf_hi(gwd)} * ((jp & 1) ? hi2(a) : lo2(a));
                        w[jp] = cvt_pk_bf16(o.x, o.y); }
                    *(u32x4*)(mixed + r * 1024 + c0) = w; }
        }
    }
};
struct EpiOut {
    static constexpr bool PERM = true;
    bf16_t* hb; const float* x;
    DI void operator()(const AccT& acc, const Unit& u, int wr, int wc, int fr, int fq) const {
#pragma unroll
        for (int ai = 0; ai < 2; ++ai) {
            f32x4 xv[4][2][2];
#pragma unroll
            for (int m = 0; m < 4; ++m) { const size_t r = (size_t)(u.pm * BM + ai * HALF + wr * 64 + m * 16 + fr);
#pragma unroll
                for (int bj = 0; bj < 2; ++bj) { const float* xp = x + r * 1024 + u.pn * BM + bj * HALF + wc * 32 + 8 * fq; xv[m][bj][0] = *(const f32x4*)xp; xv[m][bj][1] = *(const f32x4*)(xp + 4); } }
#pragma unroll
            for (int m = 0; m < 4; ++m) { const size_t r = (size_t)(u.pm * BM + ai * HALF + wr * 64 + m * 16 + fr);
#pragma unroll
                for (int bj = 0; bj < 2; ++bj) { const f32x4 v0 = xv[m][bj][0] + acc[ai][bj][m][0], v1 = xv[m][bj][1] + acc[ai][bj][m][1];
                    u32x4 w; w.x = cvt_pk_bf16(v0[0], v0[1]); w.y = cvt_pk_bf16(v0[2], v0[3]); w.z = cvt_pk_bf16(v1[0], v1[1]); w.w = cvt_pk_bf16(v1[2], v1[3]);
                    *(u32x4*)(hb + r * 1024 + u.pn * BM + bj * HALF + wc * 32 + 8 * fq) = w; } }
        }
    }
};
struct EpiRouter {
    static constexpr bool PERM = false;
    float* logits;
    DI void operator()(const AccT& acc, const Unit& u, int wr, int wc, int fr, int fq) const {
        if (wc != 0) return;
#pragma unroll
        for (int n = 0; n < 2; ++n) {
            const int c = 16 * n + 4 * fq;
#pragma unroll
            for (int ai = 0; ai < 2; ++ai)
#pragma unroll
                for (int m = 0; m < 4; ++m) {
                    const size_t r = (size_t)(u.pm * BM + ai * HALF + wr * 64 + m * 16 + fr);
                    *(f32x4*)(logits + r * 32 + c) = acc[ai][0][m][n];
                }
        }
    }
};
struct EpiMoe1 {
    static constexpr bool PERM = true;
    unsigned char* act; const float* b1p;
    DI void operator()(const AccT& acc, const Unit& u, int wr, int wc, int fr, int fq) const {
        const int cw = wc * 32 + 8 * fq, j0 = u.pn * 128 + cw;
        const float* bp = b1p + (size_t)u.aux * 2048 + u.pn * 256 + cw;
        const f32x4 ba0 = *(const f32x4*)bp, ba1 = *(const f32x4*)(bp + 4), bb0 = *(const f32x4*)(bp + 128), bb1 = *(const f32x4*)(bp + 132);
        const f32x2 ba[4] = {lo2(ba0), hi2(ba0), lo2(ba1), hi2(ba1)}, bb[4] = {lo2(bb0), hi2(bb0), lo2(bb1), hi2(bb1)};
        constexpr float sc = 1.0f / (F8_SX * F8_SW);
#pragma unroll
        for (int ai = 0; ai < 2; ++ai)
#pragma unroll
            for (int m = 0; m < 4; ++m) {
                const size_t r = (size_t)(u.pm * BM + ai * HALF + wr * 64 + m * 16 + fr);
                f32x2 o[4];
#pragma unroll
                for (int jp = 0; jp < 4; ++jp) {
                    const f32x4& ag = acc[ai][0][m][jp >> 1]; const f32x4& al_ = acc[ai][1][m][jp >> 1];
                    const f32x2 g = ((jp & 1) ? hi2(ag) : lo2(ag)) * sc + ba[jp], l = ((jp & 1) ? hi2(al_) : lo2(al_)) * sc + bb[jp];
                    const f32x2 xg = __builtin_elementwise_min(g, (f32x2){7.0f, 7.0f});
                    const f32x2 xl = __builtin_elementwise_min(__builtin_elementwise_max(l, (f32x2){-7.0f, -7.0f}), (f32x2){7.0f, 7.0f});
                    o[jp] = (xg * pk_sigmoid_scaled(xg, -1.702f * 1.44269504f)) * (xl * F8_SA + F8_SA);
                }
                u32x2 w; w.x = pk4_fp8_nc(o[0], o[1]); w.y = pk4_fp8_nc(o[2], o[3]);
                *(u32x2*)(act + r * 1024 + j0) = w;
            }
    }
};
struct EpiMoe2 {
    static constexpr bool PERM = true;
    unsigned char* y2; const float* b2; const float* rowg;
    DI void operator()(const AccT& acc, const Unit& u, int wr, int wc, int fr, int fq) const {
        float gt[2][4];
#pragma unroll
        for (int ai = 0; ai < 2; ++ai)
#pragma unroll
            for (int m = 0; m < 4; ++m) gt[ai][m] = rowg[(size_t)(u.pm * BM + ai * HALF + wr * 64 + m * 16 + fr)] * F8_SY;
#pragma unroll
        for (int bj = 0; bj < 2; ++bj) {
            const int c0 = u.pn * BM + bj * HALF + wc * 32 + 8 * fq;
            const f32x4 bva = *(const f32x4*)(b2 + (size_t)u.aux * 1024 + c0), bvb = *(const f32x4*)(b2 + (size_t)u.aux * 1024 + c0 + 4);
            const f32x2 bv[4] = {lo2(bva), hi2(bva), lo2(bvb), hi2(bvb)};
#pragma unroll
            for (int ai = 0; ai < 2; ++ai)
#pragma unroll
                for (int m = 0; m < 4; ++m) {
                    const size_t r = (size_t)(u.pm * BM + ai * HALF + wr * 64 + m * 16 + fr);
                    const float g = gt[ai][m];
                    f32x2 o[4];
#pragma unroll
                    for (int jp = 0; jp < 4; ++jp) { const f32x4& a = acc[ai][bj][m][jp >> 1];
                        o[jp] = (((jp & 1) ? hi2(a) : lo2(a)) * (1.0f / (F8_SA * F8_SW)) + bv[jp]) * g;
                        o[jp] = __builtin_elementwise_min(__builtin_elementwise_max(o[jp], (f32x2){-448.f, -448.f}), (f32x2){448.f, 448.f}); }
                    u32x2 w; w.x = pk4_fp8_nc(o[0], o[1]); w.y = pk4_fp8_nc(o[2], o[3]);
                    *(u32x2*)(y2 + r * 1024 + c0) = w;
                }
        }
    }
};
struct KArgs { const float* in[34]; float* out; unsigned char* ws; int ph_lo, ph_hi; };
struct Frame {
    LAS unsigned char* lds; int tid, lane, wave, G, bid;
    const float* const* in; float* out; unsigned char* ws;
};

template <class MP>
DI void conv_T(const Frame& F, const float* src, size_t src_bstride, int ld, bf16_t* dst, int N, int K, int nbatch, MP mp, int t0 = 0, int t1 = 0x7fffffff) {
    LAS unsigned* tile = (LAS unsigned*)F.lds;
    const int ntk = K / 64, ntn = N / 256, per = ntk * ntn;
    const int tend = (per * nbatch) < t1 ? (per * nbatch) : t1;
    for (int t = t0 + F.bid; t < tend; t += F.G) {
        const int bt = t / per, tt = t % per, tk = tt % ntk, pn = tt / ntk;
        const float* s = src + (size_t)bt * src_bstride + (size_t)(tk * 64) * ld + mp.src(pn, F.lane);
        f32x4 va[4], vb[4];
#pragma unroll
        for (int i = 0; i < 4; ++i) { const int kp = F.wave + 8 * i; va[i] = *(const f32x4*)(s + (size_t)(2 * kp) * ld); vb[i] = *(const f32x4*)(s + (size_t)(2 * kp + 1) * ld); }
#pragma unroll
        for (int i = 0; i < 4; ++i) { const int kp = F.wave + 8 * i;
#pragma unroll
            for (int j = 0; j < 4; ++j) tile[mp.dst(F.lane, j) * 33 + kp] = cvt_pk_bf16(va[i][j], vb[i][j]); }
        __syncthreads();
        unsigned* d = (unsigned*)(dst + (size_t)bt * N * K + (size_t)(pn * 256) * K + tk * 64);
#pragma unroll
        for (int i = 0; i < 4; ++i) { const int pc = F.tid + NTHR * i, nn = pc >> 3, seg = pc & 7;
            u32x4 w; w.x = tile[nn * 33 + seg * 4]; w.y = tile[nn * 33 + seg * 4 + 1]; w.z = tile[nn * 33 + seg * 4 + 2]; w.w = tile[nn * 33 + seg * 4 + 3];
            *(u32x4*)(d + ((size_t)nn * K) / 2 + seg * 4) = w; }
        __syncthreads();
    }
}
template <class MP>
DI void conv_T8(const Frame& F, const float* src, size_t src_bstride, int ld, unsigned char* dst, int N, int K, int nbatch, MP mp, float scale, int t0 = 0, int t1 = 0x7fffffff) {
    LAS unsigned* tile = (LAS unsigned*)F.lds;
    const int ntk = K / 64, ntn = N / 256, per = ntk * ntn;
    const int tend = (per * nbatch) < t1 ? (per * nbatch) : t1;
    for (int t = t0 + F.bid; t < tend; t += F.G) {
        const int bt = t / per, tt = t % per, tk = tt % ntk, pn = tt / ntk;
        const float* s = src + (size_t)bt * src_bstride + (size_t)(tk * 64) * ld + mp.src(pn, F.lane);
        f32x4 v[2][4];
#pragma unroll
        for (int i = 0; i < 2; ++i) { const int kq = F.wave + 8 * i;
#pragma unroll
            for (int e = 0; e < 4; ++e) v[i][e] = *(const f32x4*)(s + (size_t)(4 * kq + e) * ld); }
#pragma unroll
        for (int i = 0; i < 2; ++i) { const int kq = F.wave + 8 * i;
#pragma unroll
            for (int j = 0; j < 4; ++j) tile[mp.dst(F.lane, j) * 17 + kq] = pk4_fp8(v[i][0][j] * scale, v[i][1][j] * scale, v[i][2][j] * scale, v[i][3][j] * scale); }
        __syncthreads();
        unsigned char* d = dst + ((size_t)bt * N + (size_t)pn * 256) * K + tk * 64;
#pragma unroll
        for (int i = 0; i < 2; ++i) { const int pc = F.tid + NTHR * i, nn = pc >> 2, seg = pc & 3;
            u32x4 w; w.x = tile[nn * 17 + seg * 4]; w.y = tile[nn * 17 + seg * 4 + 1]; w.z = tile[nn * 17 + seg * 4 + 2]; w.w = tile[nn * 17 + seg * 4 + 3];
            *(u32x4*)(d + (size_t)nn * K + seg * 16) = w; }
        __syncthreads();
    }
}
struct MpId  { DI int src(int pn, int f) const { return pn * 256 + 4 * f; } DI int dst(int f, int j) const { return 4 * f + j; } };
struct MpSwi { DI int src(int pn, int f) const { return pn * 256 + 4 * f; } DI int dst(int f, int j) const { const int n = 4 * f + j; return (n >> 1) + 128 * (n & 1); } };
struct MpGlu { DI int src(int pn, int f) const { const int w = 4 * f; return pn * 128 + (w & 127) + 1024 * (w >> 7); } DI int dst(int f, int j) const { return 4 * f + j; } };
struct CmGlu { DI int operator()(int n) const { const int pn = n >> 8, w = n & 255; return pn * 128 + (w & 127) + 1024 * (w >> 7); } };
struct CmSwi { DI int operator()(int n) const { const int pn = n >> 8, w = n & 255; return 2 * (pn * 128 + (w & 127)) + (w >> 7); } };

DI void rmsnorm_rows(const Frame& F, const float* x, const float* g, bf16_t* out, int row0, int nrows, unsigned char* out8 = nullptr) {
    const int stride = F.G * NWAVES;
    for (int row = row0 + F.bid * NWAVES + F.wave; row < row0 + nrows; row += 2 * stride) {
        const int row2 = (row + stride < row0 + nrows) ? row + stride : row;
        const f32x4* xr = (const f32x4*)(x + (size_t)row * D); const f32x4* xr2 = (const f32x4*)(x + (size_t)row2 * D);
        f32x4 v[4], u[4]; float ss = 0.f, su = 0.f;
#pragma unroll
        for (int i = 0; i < 4; ++i) { v[i] = xr[i * 64 + F.lane]; u[i] = xr2[i * 64 + F.lane]; }
#pragma unroll
        for (int i = 0; i < 4; ++i) { ss += v[i][0] * v[i][0] + v[i][1] * v[i][1] + v[i][2] * v[i][2] + v[i][3] * v[i][3]; su += u[i][0] * u[i][0] + u[i][1] * u[i][1] + u[i][2] * u[i][2] + u[i][3] * u[i][3]; }
        ss = wave_sum(ss); su = wave_sum(su);
        const float rs = rsqrtf(ss * (1.0f / D) + 1e-5f), ru = rsqrtf(su * (1.0f / D) + 1e-5f);
#pragma unroll
        for (int i = 0; i < 4; ++i) { const f32x4 gv = ((const f32x4*)g)[i * 64 + F.lane];
            u32x2 w; w.x = cvt_pk_bf16(v[i][0] * rs * gv[0], v[i][1] * rs * gv[1]); w.y = cvt_pk_bf16(v[i][2] * rs * gv[2], v[i][3] * rs * gv[3]);
            *(u32x2*)(out + (size_t)row * D + (i * 64 + F.lane) * 4) = w;
            u32x2 w2; w2.x = cvt_pk_bf16(u[i][0] * ru * gv[0], u[i][1] * ru * gv[1]); w2.y = cvt_pk_bf16(u[i][2] * ru * gv[2], u[i][3] * ru * gv[3]);
            *(u32x2*)(out + (size_t)row2 * D + (i * 64 + F.lane) * 4) = w2;
            if (out8) { *(unsigned*)(out8 + (size_t)row * D + (i * 64 + F.lane) * 4) = pk4_fp8(v[i][0] * rs * gv[0] * F8_SX, v[i][1] * rs * gv[1] * F8_SX, v[i][2] * rs * gv[2] * F8_SX, v[i][3] * rs * gv[3] * F8_SX);
                *(unsigned*)(out8 + (size_t)row2 * D + (i * 64 + F.lane) * 4) = pk4_fp8(u[i][0] * ru * gv[0] * F8_SX, u[i][1] * ru * gv[1] * F8_SX, u[i][2] * ru * gv[2] * F8_SX, u[i][3] * ru * gv[3] * F8_SX); } }
    }
}

DI void p0_prologue(const Frame& F) {
    unsigned char* ws = F.ws;
    conv_T(F, F.in[2], 0, INC, (bf16_t*)(ws + WS_WIN), INC, D, 1, MpId());
    conv_T(F, F.in[11], 0, 2048, (bf16_t*)(ws + WS_WGLU), 2048, 512, 1, MpGlu());
    conv_T(F, F.in[24], 0, 1024, (bf16_t*)(ws + WS_WO), 1024, 512, 1, MpId());
    conv_T(F, F.in[25], 0, 1024, (bf16_t*)(ws + WS_WOUT), 1024, 1024, 1, MpId());
    {
        bf16_t* wl = (bf16_t*)(ws + WS_WLORA); const float* w2 = F.in[15]; const float* a2 = F.in[17]; const float* g2 = F.in[18];
        for (int idx = F.bid * NTHR + F.tid; idx < 1536 * 128; idx += F.G * NTHR) { const int n = idx >> 7, k = idx & 127; float v = 0.f;
            if (n < 512) { if (k < 64) v = w2[k * 512 + n]; } else if (n < 1024) { if (k >= 64) v = a2[(k - 64) * 512 + (n - 512)]; } else { v = g2[k * 512 + (n - 1024)]; }
            wl[idx] = f2bf(v); }
        bf16_t* wrt = (bf16_t*)(ws + WS_WR); const float* rw = F.in[27];
        for (int idx = F.bid * NTHR + F.tid; idx < 256 * 1024; idx += F.G * NTHR) { const int n = idx >> 10, k = idx & 1023; wrt[idx] = f2bf(n < 32 ? rw[k * 32 + n] * F.in[26][k] : 0.f); }
        float* bg = (float*)(ws + WS_BGLU); const float* bsrc = F.in[12]; CmGlu cm;
        for (int idx = F.bid * NTHR + F.tid; idx < 2048; idx += F.G * NTHR) bg[idx] = bsrc[cm(idx)];
    }
    if (F.bid & 1) rmsnorm_rows(F, F.in[0], F.in[1], (bf16_t*)(ws + WS_XN), 0, T);
    {
        LAS float* L = (LAS float*)F.lds;
        LAS float* pwr = L, *pwi = L + 64, *p1r = L + 128, *p1i = L + 192, *ffr = L + 256, *ffi = L + 320;
        LAS float* bbr = L + 384, *bbi = bbr + 1024, *ccr = bbi + 1024, *cci = ccr + 1024, *kj = cci + 1024;
        const float* lam_re = F.in[3]; const float* lam_im = F.in[4]; const float* log_dt = F.in[5];
        const float* b_re = F.in[6]; const float* b_im = F.in[7]; const float* c_re = F.in[8]; const float* c_im = F.in[9]; const float* dsk = F.in[10];
        unsigned* toep = (unsigned*)(ws + WS_TOEP); unsigned* wst = (unsigned*)(ws + WS_WST);
        for (int it = F.bid; it < 32 * S5L; it += F.G) {
            const int g = it / S5L, j = it % S5L;
            if (F.tid < 64) { const int p = F.tid; const float lr = lam_re[g * 64 + p], li = lam_im[g * 64 + p], dt = __expf(log_dt[g]);
                float sn, cs; { const float mg = expf((float)j * lr * dt); sincosf((float)j * (li * dt), &sn, &cs); pwr[p] = mg * cs; pwi[p] = mg * sn; }
                { const float mg = expf((float)(j + 1) * lr * dt); sincosf((float)(j + 1) * (li * dt), &sn, &cs); p1r[p] = mg * cs; p1i[p] = mg * sn; }
                { const float mg = expf(lr * dt); sincosf(li * dt, &sn, &cs); const float nr = mg * cs - 1.0f, ni = mg * sn, den = lr * lr + li * li;
                  ffr[p] = (nr * lr + ni * li) / den; ffi[p] = (ni * lr - nr * li) / den; } }
            __syncthreads();
            for (int idx = F.tid; idx < 1024; idx += NTHR) { const int p = idx >> 4; const float br = b_re[g * 1024 + idx], bi = b_im[g * 1024 + idx];
                bbr[idx] = ffr[p] * br - ffi[p] * bi; bbi[idx] = ffr[p] * bi + ffi[p] * br;
                ccr[idx] = c_re[g * 1024 + idx]; cci[idx] = c_im[g * 1024 + idx]; }
            __syncthreads();
            if (F.tid < 256) { const int co = F.tid >> 4, ci = F.tid & 15; float s = 0.f;
                for (int p = 0; p < 64; ++p) { const float zr = pwr[p] * bbr[p * 16 + ci] - pwi[p] * bbi[p * 16 + ci], zi = pwr[p] * bbi[p * 16 + ci] + pwi[p] * bbr[p * 16 + ci];
                    s += ccr[co * 64 + p] * zr - cci[co * 64 + p] * zi; }
                if (j == 0 && co == ci) s += dsk[g * 16 + co];
                kj[F.tid] = s; }
            __syncthreads();
            for (int idx = F.tid; idx < (S5L - j) * 128; idx += NTHR) { const int t = j + idx / 128, rem = idx % 128, co = rem >> 3, ci = (rem & 7) * 2;
                toep[((size_t)(g * 512 + t * 16 + co) * LDU + (t - j) * 16 + ci) / 2] = cvt_pk_bf16(kj[co * 16 + ci], kj[co * 16 + ci + 1]);
                if (j > 0) toep[((size_t)(g * 512 + (t - j) * 16 + co) * LDU + t * 16 + ci) / 2] = 0u; }
            for (int idx = F.tid; idx < 16 * 64; idx += NTHR) { const int co = idx >> 6, q = (idx & 63) * 2; float o[2];
#pragma unroll
                for (int e = 0; e < 2; ++e) { const int qq = q + e, p = qq & 63; const float cr = ccr[co * 64 + p], cim = cci[co * 64 + p];
                    o[e] = (qq < 64) ? (cr * p1r[p] - cim * p1i[p]) : -(cr * p1i[p] + cim * p1r[p]); }
                toep[((size_t)(g * 512 + j * 16 + co) * LDU + 512 + q) / 2] = cvt_pk_bf16(o[0], o[1]); }
            { const int s = S5L - 1 - j;
              for (int idx = F.tid; idx < 256 * 8; idx += NTHR) { const int q = idx >> 3, ci = (idx & 7) * 2; float o[2] = {0.f, 0.f};
                if (q < 128) { const int p = q & 63;
#pragma unroll
                    for (int e = 0; e < 2; ++e) { const float br = bbr[p * 16 + ci + e], bi = bbi[p * 16 + ci + e];
                        o[e] = (q < 64) ? (pwr[p] * br - pwi[p] * bi) : (pwr[p] * bi + pwi[p] * br); } }
                wst[((size_t)(g * 256 + q) * 512 + s * 16 + ci) / 2] = cvt_pk_bf16(o[0], o[1]); } }
            __syncthreads();
        }
    }
    if (!(F.bid & 1)) rmsnorm_rows(F, F.in[0], F.in[1], (bf16_t*)(ws + WS_XN), 0, T);
}

DI void p_rw_prep(const Frame& F) {
    const bf16_t* prw = (const bf16_t*)(F.ws + WS_PRW); bf16_t* al_ = (bf16_t*)(F.ws + WS_ALORA); const float* mu = F.in[13];
    for (int idx = F.bid * NTHR + F.tid; idx < T * 32; idx += F.G * NTHR) {
        const int t = idx >> 5, c8 = (idx & 31) * 8;
        const u32x4 cur = *(const u32x4*)(prw + (size_t)t * RWC + 1536 + c8);
        u32x4 prv = (u32x4){0u, 0u, 0u, 0u};
        if ((t & (SEQ - 1)) != 0) prv = *(const u32x4*)(prw + (size_t)(t - 1) * RWC + 1536 + c8);
        float o[8];
#pragma unroll
        for (int j = 0; j < 8; ++j) { const float c = (j & 1) ? bf_hi(cur[j >> 1]) : bf_lo(cur[j >> 1]), p = (j & 1) ? bf_hi(prv[j >> 1]) : bf_lo(prv[j >> 1]);
            const float xs = c + mu[1536 + c8 + j] * (p - c);
            o[j] = (c8 < 64) ? ftanh(xs) : ((c8 < 128) ? xs : fsigmoid(xs)); }
        u32x4 w; w.x = cvt_pk_bf16(o[0], o[1]); w.y = cvt_pk_bf16(o[2], o[3]); w.z = cvt_pk_bf16(o[4], o[5]); w.w = cvt_pk_bf16(o[6], o[7]);
        *(u32x4*)(al_ + (size_t)t * 256 + c8) = w;
    }
}

DI void p_s5_carry(const Frame& F) {
    const float* lam_re = F.in[3]; const float* lam_im = F.in[4]; const float* log_dt = F.in[5];
    const float* sloc = (const float*)(F.ws + WS_SLOC); bf16_t* us5 = (bf16_t*)(F.ws + WS_US5);
    for (int gt = F.bid * NTHR + F.tid; gt < NB * 32 * 64; gt += F.G * NTHR) {
        const int p = gt & 63, g = (gt >> 6) & 31, b = gt >> 11;
        const float lr = lam_re[g * 64 + p], li = lam_im[g * 64 + p], dt = __expf(log_dt[g]);
        float sn, cs; const float mg = expf((float)S5L * lr * dt); sincosf((float)S5L * (li * dt), &sn, &cs);
        const float ar = mg * cs, ai = mg * sn;
        float xr = 0.f, xi = 0.f;
        const size_t row0 = (size_t)g * S5ROWS + (size_t)b * S5NC;
        for (int cb = 0; cb < S5NC; cb += 16) {
            float sr[16], si[16];
#pragma unroll
            for (int j = 0; j < 16; ++j) { sr[j] = sloc[(row0 + cb + j) * 128 + p]; si[j] = sloc[(row0 + cb + j) * 128 + 64 + p]; }
#pragma unroll
            for (int j = 0; j < 16; ++j) { const size_t row = row0 + cb + j;
                us5[row * LDU + 512 + p] = f2bf(xr); us5[row * LDU + 576 + p] = f2bf(xi);
                const float nr = ar * xr - ai * xi + sr[j], ni = ar * xi + ai * xr + si[j];
                xr = nr; xi = ni; }
        }
    }
}

constexpr int PT = 72, SLOTB = 64 * PT * 2;
DI LAS bf16_t* rslot(LAS unsigned char* lds, int i) { return (LAS bf16_t*)(lds + i * SLOTB); }
DI void mm_acc(f32x4 (&acc)[2], const LAS bf16_t* A, const LAS bf16_t* Bt, int ti, int tj0, int r, int q) {
#pragma unroll
    for (int s2 = 0; s2 < 2; ++s2) {
        const bf16x8 a = *(const LAS bf16x8*)(A + (16 * ti + r) * PT + 32 * s2 + 8 * q);
#pragma unroll
        for (int e = 0; e < 2; ++e) { const bf16x8 b = *(const LAS bf16x8*)(Bt + (16 * (tj0 + e) + r) * PT + 32 * s2 + 8 * q);
            acc[e] = __builtin_amdgcn_mfma_f32_16x16x32_bf16(a, b, acc[e], 0, 0, 0); }
    }
}
DI void mm_acc_bnat(f32x4 (&acc)[2], const LAS bf16_t* A, const LAS bf16_t* Bn, int ti, int tj0, int r, int q) {
#pragma unroll
    for (int s2 = 0; s2 < 2; ++s2) {
        const bf16x8 a = *(const LAS bf16x8*)(A + (16 * ti + r) * PT + 32 * s2 + 8 * q);
#pragma unroll
        for (int e = 0; e < 2; ++e) { bf16x8 b;
#pragma unroll
            for (int jj = 0; jj < 8; ++jj) b[jj] = (short)Bn[(32 * s2 + 8 * q + jj) * PT + 16 * (tj0 + e) + r];
            acc[e] = __builtin_amdgcn_mfma_f32_16x16x32_bf16(a, b, acc[e], 0, 0, 0); }
    }
}
DI void st_rm(LAS bf16_t* Dm, const f32x4& v, int i0, int j) {
#pragma unroll
    for (int g = 0; g < 4; ++g) Dm[(i0 + g) * PT + j] = f2bf(v[g]);
}
DI void st_tr(LAS bf16_t* Dm, const f32x4& v, int i0, int j) { u32x2 w; w.x = cvt_pk_bf16(v[0], v[1]); w.y = cvt_pk_bf16(v[2], v[3]); *(LAS u32x2*)(Dm + j * PT + i0) = w; }
DI f32x4 ld_rm(const LAS bf16_t* Sm, int i0, int j) { f32x4 v;
#pragma unroll
    for (int g = 0; g < 4; ++g) v[g] = bf2f(Sm[(i0 + g) * PT + j]);
    return v; }
DI void ld_frag(bf16x8 (&f)[2], const LAS bf16_t* M, int row, int q) { f[0] = *(const LAS bf16x8*)(M + row * PT + 8 * q); f[1] = *(const LAS bf16x8*)(M + row * PT + 32 + 8 * q); }
DI f32x4 mm2(const bf16x8 (&x)[2], const bf16x8 (&y)[2], f32x4 c) { c = __builtin_amdgcn_mfma_f32_16x16x32_bf16(x[0], y[0], c, 0, 0, 0); return __builtin_amdgcn_mfma_f32_16x16x32_bf16(x[1], y[1], c, 0, 0, 0); }
DI void st_sw(LAS bf16_t* Dm, const f32x4& v, int i, int j0) { u32x2 w; w.x = cvt_pk_bf16(v[0], v[1]); w.y = cvt_pk_bf16(v[2], v[3]); *(LAS u32x2*)(Dm + i * PT + j0) = w; }
DI f32x4 ld_sw(const LAS bf16_t* Sm, int i, int j0) { const u32x2 w = *(const LAS u32x2*)(Sm + i * PT + j0); return (f32x4){bf_lo(w.x), bf_hi(w.x), bf_lo(w.y), bf_hi(w.y)}; }
#define ZACC(a) do { a[0] = (f32x4){0.f, 0.f, 0.f, 0.f}; a[1] = (f32x4){0.f, 0.f, 0.f, 0.f}; } while (0)

DI float wave_sum2(float v) { return xrow_sum(row_sum16(v)); }
#define LSYNC() do { asm volatile("s_waitcnt lgkmcnt(0)" ::: "memory"); __builtin_amdgcn_s_barrier(); asm volatile("" ::: "memory"); } while (0)

struct RaRaw { bf16_t r[9], k[9], v[9], lw[8], a[8]; };
DI void ra_load(RaRaw& x, const bf16_t* prw, const bf16_t* lwag, int ci, int w, int lane) {
    const int bh = ci >> 6, c = ci & 63, b = bh >> 3, h = bh & 7, ch = h * 64 + lane;
    const size_t tok0 = (size_t)b * SEQ + c * 64 + 8 * w;
    const bool has_prev = !(c == 0 && w == 0);
    const size_t tp = has_prev ? tok0 - 1 : tok0;
    x.r[0] = prw[tp * RWC + ch]; x.k[0] = prw[tp * RWC + 512 + ch]; x.v[0] = prw[tp * RWC + 1024 + ch];
#pragma unroll
    for (int i = 0; i < 8; ++i) { const size_t tok = tok0 + i;
        x.r[i + 1] = prw[tok * RWC + ch]; x.k[i + 1] = prw[tok * RWC + 512 + ch]; x.v[i + 1] = prw[tok * RWC + 1024 + ch];
        x.lw[i] = lwag[tok * 1536 + ch]; x.a[i] = lwag[tok * 1536 + 512 + ch]; }
}
DI void p_rw_chunk(const Frame& F) {
    const bf16_t* prw = (const bf16_t*)(F.ws + WS_PRW); const bf16_t* lwag = (const bf16_t*)(F.ws + WS_LWAG);
    const float* mu = F.in[13]; const float* k_k = F.in[19]; const float* k_a = F.in[20]; const float* r_k = F.in[21];
    float* bonus = (float*)(F.ws + WS_BONUS);
    bf16_t* gM = (bf16_t*)(F.ws + WS_CHK_M); bf16_t* gN0T = (bf16_t*)(F.ws + WS_CHK_N0T); bf16_t* gQ = (bf16_t*)(F.ws + WS_CHK_Q); bf16_t* gY0 = (bf16_t*)(F.ws + WS_CHK_Y0T);
    LAS unsigned char* lds = F.lds;
    LAS float* segtot = (LAS float*)(lds + 14 * SLOTB);
    LAS float* PLs = segtot + 512;
    LAS float* DB = PLs + 64;
    constexpr int PD = 20;
    const int w = F.wave, lane = F.lane, r = lane & 15, q = lane >> 4, ti = w >> 1, tj0 = 2 * (w & 1), i0 = 16 * ti + 4 * q;
    LAS bf16_t* S0 = rslot(lds, 0); LAS bf16_t* S1 = rslot(lds, 1); LAS bf16_t* S2 = rslot(lds, 2); LAS bf16_t* S3 = rslot(lds, 3);
    LAS bf16_t* S4 = rslot(lds, 4); LAS bf16_t* S5 = rslot(lds, 5); LAS bf16_t* S6 = rslot(lds, 6); LAS bf16_t* S7 = rslot(lds, 7);
    LAS bf16_t* S8 = rslot(lds, 8); LAS bf16_t* S9 = rslot(lds, 9); LAS bf16_t* S10 = rslot(lds, 10); LAS bf16_t* S11 = rslot(lds, 11);
    LAS bf16_t* S12 = rslot(lds, 12); LAS bf16_t* S13 = rslot(lds, 13);
    RaRaw raw;
    if (F.bid < RW_NCH) ra_load(raw, prw, lwag, F.bid, w, lane);
    for (int ci = F.bid; ci < RW_NCH; ci += F.G) {
        const int bh = ci >> 6, c = ci & 63, b = bh >> 3, h = bh & 7, ch = h * 64 + lane;
        {
            const size_t tok0 = (size_t)b * SEQ + c * 64 + 8 * w;
            const float mur = mu[ch], muk = mu[512 + ch], muv = mu[1024 + ch], kkw = k_k[ch], ka = k_a[ch], rk = r_k[ch];
            const bool has_prev = !(c == 0 && w == 0);
            float xr[9], xk[9], xv[9];
            xr[0] = has_prev ? bf2f(raw.r[0]) : 0.f; xk[0] = has_prev ? bf2f(raw.k[0]) : 0.f; xv[0] = has_prev ? bf2f(raw.v[0]) : 0.f;
#pragma unroll
            for (int i = 1; i < 9; ++i) { xr[i] = bf2f(raw.r[i]); xk[i] = bf2f(raw.k[i]); xv[i] = bf2f(raw.v[i]); }
            f32x2 rr2[4], vv2[4], aa2[4], km2[4], kn2[4]; float cl[8];
            float run = 0.f;
#pragma unroll
            for (int p2 = 0; p2 < 4; ++p2) {
                const f32x2 cr = {xr[2 * p2 + 1], xr[2 * p2 + 2]}, pr = {xr[2 * p2], xr[2 * p2 + 1]};
                const f32x2 ck = {xk[2 * p2 + 1], xk[2 * p2 + 2]}, pk = {xk[2 * p2], xk[2 * p2 + 1]};
                const f32x2 cv = {xv[2 * p2 + 1], xv[2 * p2 + 2]}, pv = {xv[2 * p2], xv[2 * p2 + 1]};
                const f32x2 r_ = cr + (pr - cr) * mur, k_ = ck + (pk - ck) * muk, v_ = cv + (pv - cv) * muv;
                const f32x2 a_ = {bf2f(raw.a[2 * p2]), bf2f(raw.a[2 * p2 + 1])};
                f32x2 kx = k_ * kkw; const f32x2 sq = kx * kx;
                const float ss0 = wave_sum2(sq.x), ss1 = wave_sum2(sq.y);
                kx = kx * (f32x2){fminf(__builtin_amdgcn_rsqf(ss0), 1e12f), fminf(__builtin_amdgcn_rsqf(ss1), 1e12f)};
                const f32x2 kmod = k_ * (a_ * ka + (1.0f - ka));
                const f32x2 bq = (r_ * kmod) * rk;
                const float bn0 = wave_sum2(bq.x), bn1 = wave_sum2(bq.y);
                if (lane == 0) { bonus[(tok0 + 2 * p2) * 8 + h] = bn0; bonus[(tok0 + 2 * p2 + 1) * 8 + h] = bn1; }
                rr2[p2] = r_; vv2[p2] = v_; aa2[p2] = a_; km2[p2] = kmod; kn2[p2] = kx;
                run += bf2f(raw.lw[2 * p2]); cl[2 * p2] = run; run += bf2f(raw.lw[2 * p2 + 1]); cl[2 * p2 + 1] = run;
            }
            segtot[w * 64 + lane] = run;
            LSYNC();
            float pre = 0.f;
            for (int w2 = 0; w2 < w; ++w2) pre += segtot[w2 * 64 + lane];
            if (w == 7) PLs[lane] = __expf(pre + run);
            float ep = __expf(pre);
            unsigned xa[4], xb[4], xkk[4], xrr[4], xvv[4];
#pragma unroll
            for (int p2 = 0; p2 < 4; ++p2) {
                const f32x2 tt = ((f32x2){cl[2 * p2], cl[2 * p2 + 1]} + pre) * 1.44269504f;
                const f32x2 e = {__builtin_amdgcn_exp2f(tt.x), __builtin_amdgcn_exp2f(tt.y)}, en = {__builtin_amdgcn_rcpf(e.x), __builtin_amdgcn_rcpf(e.y)}, epv = {ep, e.x};
                ep = e.y;
                const f32x2 at = -(kn2[p2] * epv), bt = (kn2[p2] * aa2[p2]) * en, kt = km2[p2] * en, rt = rr2[p2] * e;
                xa[p2] = cvt_pk_bf16(at.x, at.y); xb[p2] = cvt_pk_bf16(bt.x, bt.y); xkk[p2] = cvt_pk_bf16(kt.x, kt.y); xrr[p2] = cvt_pk_bf16(rt.x, rt.y); xvv[p2] = cvt_pk_bf16(vv2[p2].x, vv2[p2].y);
                const int t = 8 * w + 2 * p2;
                S0[t * PT + lane] = (bf16_t)(xa[p2] & 0xffffu); S0[(t + 1) * PT + lane] = (bf16_t)(xa[p2] >> 16);
                S2[t * PT + lane] = (bf16_t)(xb[p2] & 0xffffu); S2[(t + 1) * PT + lane] = (bf16_t)(xb[p2] >> 16);
                S4[t * PT + lane] = (bf16_t)(xkk[p2] & 0xffffu); S4[(t + 1) * PT + lane] = (bf16_t)(xkk[p2] >> 16);
                S6[t * PT + lane] = (bf16_t)(xrr[p2] & 0xffffu); S6[(t + 1) * PT + lane] = (bf16_t)(xrr[p2] >> 16);
            }
            *(LAS u32x4*)(S1 + lane * PT + 8 * w) = (u32x4){xa[0], xa[1], xa[2], xa[3]};
            *(LAS u32x4*)(S3 + lane * PT + 8 * w) = (u32x4){xb[0], xb[1], xb[2], xb[3]};
            *(LAS u32x4*)(S5 + lane * PT + 8 * w) = (u32x4){xkk[0], xkk[1], xkk[2], xkk[3]};
            *(LAS u32x4*)(S7 + lane * PT + 8 * w) = (u32x4){xvv[0], xvv[1], xvv[2], xvv[3]};
        }
        LSYNC();
        if (ci + F.G < RW_NCH) ra_load(raw, prw, lwag, ci + F.G, w, lane);
        f32x4 acc[2];
        const f32x4 Z4 = (f32x4){0.f, 0.f, 0.f, 0.f};
        const int ia = 16 * ti + r, jb0 = 16 * tj0 + r;
        { bf16x8 a0[2], a6[2], b2[2][2], b4[2][2];
          ld_frag(a0, S0, ia, q); ld_frag(a6, S6, ia, q);
#pragma unroll
          for (int e = 0; e < 2; ++e) { ld_frag(b2[e], S2, jb0 + 16 * e, q); ld_frag(b4[e], S4, jb0 + 16 * e, q); }
#pragma unroll
          for (int e = 0; e < 2; ++e) { const int tj = tj0 + e, j = 16 * tj + r, js = 16 * tj + 4 * q;
            const f32x4 c = mm2(a0, b2[e], Z4);
            if (tj == ti) {
#pragma unroll
                for (int g = 0; g < 4; ++g) DB[(ti * 16 + 4 * q + g) * PD + r] = (4 * q + g > r) ? c[g] : 0.f;
            }
            st_tr(S8, (ti > tj) ? c : Z4, i0, j);
            f32x4 v = mm2(b4[e], a0, Z4);
#pragma unroll
            for (int g = 0; g < 4; ++g) v[g] = (ia > js + g) ? v[g] : 0.f;
            st_sw(S9, v, ia, js);
            v = mm2(b2[e], a6, Z4);
#pragma unroll
            for (int g = 0; g < 4; ++g) v[g] = (ia >= js + g) ? v[g] : 0.f;
            st_sw(S10, v, ia, js);
            v = mm2(b4[e], a6, Z4);
#pragma unroll
            for (int g = 0; g < 4; ++g) v[g] = (ia >= js + g) ? v[g] : 0.f;
            st_sw(S11, v, ia, js); } }
        LSYNC();
        ZACC(acc); mm_acc(acc, S9, S7, ti, tj0, r, q);
#pragma unroll
        for (int e = 0; e < 2; ++e) st_tr(S2, acc[e], i0, 16 * (tj0 + e) + r);
        if (w < 4) {
            const int i = lane >> 2, p = lane & 3;
            const LAS float* Dp = DB + (w * 16 + p) * PD;
            f32x4 Dm[4][4];
#pragma unroll
            for (int m = 0; m < 4; ++m)
#pragma unroll
                for (int c4 = 0; c4 < 4; ++c4) Dm[m][c4] = *(const LAS f32x4*)(Dp + 4 * m * PD + 4 * c4);
            float mine[4] = {0.f, 0.f, 0.f, 0.f}, tr[16];
#pragma unroll
            for (int j = 15; j >= 0; --j) { float part = 0.f;
#pragma unroll
                for (int m = 3; m >= 0; --m) if (4 * m + 3 > j) part = __builtin_fmaf(mine[m], Dm[m][j >> 2][j & 3], part);
                float tot = part + __builtin_bit_cast(float, __builtin_amdgcn_update_dpp(0, __builtin_bit_cast(int, part), 0xB1, 0xf, 0xf, false));
                tot = tot + __builtin_bit_cast(float, __builtin_amdgcn_update_dpp(0, __builtin_bit_cast(int, tot), 0x4E, 0xf, 0xf, false));
                const float trj = (j > i) ? 0.f : ((j == i) ? 1.0f : tot);
                tr[j] = trj; mine[j >> 2] = (p == (j & 3)) ? trj : mine[j >> 2]; }
            u32x4 z = (u32x4){0u, 0u, 0u, 0u}, x0, x1;
            x0.x = cvt_pk_bf16(tr[0], tr[1]); x0.y = cvt_pk_bf16(tr[2], tr[3]); x0.z = cvt_pk_bf16(tr[4], tr[5]); x0.w = cvt_pk_bf16(tr[6], tr[7]);
            x1.x = cvt_pk_bf16(tr[8], tr[9]); x1.y = cvt_pk_bf16(tr[10], tr[11]); x1.z = cvt_pk_bf16(tr[12], tr[13]); x1.w = cvt_pk_bf16(tr[14], tr[15]);
            LAS bf16_t* dst = S0 + (16 * w + i) * PT + 16 * p;
            *(LAS u32x4*)dst = (p == w) ? x0 : z; *(LAS u32x4*)(dst + 8) = (p == w) ? x1 : z;
        }
        LSYNC();
        { bf16x8 a[2], b[2][2]; ld_frag(a, S0, ia, q);
#pragma unroll
          for (int e = 0; e < 2; ++e) ld_frag(b[e], S8, jb0 + 16 * e, q);
#pragma unroll
          for (int e = 0; e < 2; ++e) { st_tr(S12, mm2(a, b[e], Z4), i0, 16 * (tj0 + e) + r); st_sw(S4, mm2(b[e], a, Z4), ia, 16 * (tj0 + e) + 4 * q); } }
        LSYNC();
        { bf16x8 a[2], b[2][2], bn[2][2]; ld_frag(a, S4, ia, q);
#pragma unroll
          for (int e = 0; e < 2; ++e) { ld_frag(b[e], S12, jb0 + 16 * e, q);
#pragma unroll
            for (int s2 = 0; s2 < 2; ++s2)
#pragma unroll
                for (int jj = 0; jj < 8; ++jj) bn[e][s2][jj] = (short)S0[(32 * s2 + 8 * q + jj) * PT + 16 * (tj0 + e) + r]; }
#pragma unroll
          for (int e = 0; e < 2; ++e) { const int j = 16 * (tj0 + e) + r, js = 16 * (tj0 + e) + 4 * q;
            st_sw(S13, mm2(b[e], a, Z4), ia, js);
            st_tr(S9, mm2(a, bn[e], ld_rm(S0, i0, j)), i0, j);
            st_sw(S8, mm2(bn[e], a, ld_sw(S0, ia, js)), ia, js); } }
        LSYNC();
        { bf16x8 a[2], b[2][2]; ld_frag(a, S13, ia, q);
#pragma unroll
          for (int e = 0; e < 2; ++e) ld_frag(b[e], S9, jb0 + 16 * e, q);
#pragma unroll
          for (int e = 0; e < 2; ++e) { const int js = 16 * (tj0 + e) + 4 * q; st_sw(S12, mm2(b[e], a, ld_sw(S8, ia, js)), ia, js); } }
        LSYNC();
        { bf16x8 a[2], b1[2][2], bx[2][2]; ld_frag(a, S12, ia, q);
#pragma unroll
          for (int e = 0; e < 2; ++e) { ld_frag(b1[e], S1, jb0 + 16 * e, q); ld_frag(bx[e], S2, jb0 + 16 * e, q); }
#pragma unroll
          for (int e = 0; e < 2; ++e) { const int j = 16 * (tj0 + e) + r; st_tr(S0, mm2(a, b1[e], Z4), i0, j); st_tr(S4, mm2(a, bx[e], Z4), i0, j); } }
        LSYNC();
        { bf16x8 a10[2], a11[2], a3[2], a5[2], b0[2][2], b4[2][2], b7[2][2];
          ld_frag(a10, S10, ia, q); ld_frag(a11, S11, ia, q); ld_frag(a3, S3, ia, q); ld_frag(a5, S5, ia, q);
#pragma unroll
          for (int e = 0; e < 2; ++e) { ld_frag(b0[e], S0, jb0 + 16 * e, q); ld_frag(b4[e], S4, jb0 + 16 * e, q); ld_frag(b7[e], S7, jb0 + 16 * e, q); }
          const float pli = PLs[ia];
          f32x4 plg;
#pragma unroll
          for (int g = 0; g < 4; ++g) plg[g] = PLs[i0 + g];
#pragma unroll
          for (int e = 0; e < 2; ++e) { const int j = 16 * (tj0 + e) + r, js = 16 * (tj0 + e) + 4 * q;
            const f32x4 vq = mm2(b0[e], a10, ld_sw(S6, ia, js));
            const f32x4 vy = mm2(b7[e], a11, mm2(b4[e], a10, Z4));
            f32x4 vm = mm2(b0[e], a3, Z4);
#pragma unroll
            for (int g = 0; g < 4; ++g) vm[g] = pli * (vm[g] + ((ia == js + g) ? 1.0f : 0.f));
            const f32x4 vn = mm2(a5, b7[e], mm2(a3, b4[e], Z4)) * plg;
            st_sw(S1, vq, ia, js); st_sw(S2, vy, ia, js); st_sw(S8, vm, ia, js); st_tr(S9, vn, i0, j); } }
        LSYNC();
        { const int row = F.tid >> 3, seg = (F.tid & 7) * 8; const size_t go = (size_t)ci * 4096 + row * 64 + seg;
          *(u32x4*)(gQ + go) = *(const LAS u32x4*)(S1 + row * PT + seg); *(u32x4*)(gY0 + go) = *(const LAS u32x4*)(S2 + row * PT + seg);
          *(u32x4*)(gM + go) = *(const LAS u32x4*)(S8 + row * PT + seg); *(u32x4*)(gN0T + go) = *(const LAS u32x4*)(S9 + row * PT + seg); }
        LSYNC();
    }
    asm volatile("s_waitcnt vmcnt(0)" ::: "memory");
}

struct ScanOps { u32x2 m[4][2][2]; u32x2 n0[4]; };
DI void scan_load(ScanOps& o, const bf16_t* gM, const bf16_t* gN0T, size_t ci, int col, int q, int v) {
#pragma unroll
    for (int m = 0; m < 4; ++m) {
#pragma unroll
        for (int s2 = 0; s2 < 2; ++s2) { const bf16_t* p = gM + ci * 4096 + (16 * m + col) * 64 + 32 * s2 + 4 * q; o.m[m][s2][0] = *(const u32x2*)p; o.m[m][s2][1] = *(const u32x2*)(p + 16); }
        o.n0[m] = *(const u32x2*)(gN0T + ci * 4096 + v * 64 + 16 * m + 4 * q); }
}
DI void scan_step(const ScanOps& o, f32x4 (&H)[4], bf16_t* gHT, size_t ci, int q, int v) {
    u32x4 bfr[2];
#pragma unroll
    for (int s2 = 0; s2 < 2; ++s2) { bfr[s2].x = cvt_pk_bf16(H[2 * s2][0], H[2 * s2][1]); bfr[s2].y = cvt_pk_bf16(H[2 * s2][2], H[2 * s2][3]);
        bfr[s2].z = cvt_pk_bf16(H[2 * s2 + 1][0], H[2 * s2 + 1][1]); bfr[s2].w = cvt_pk_bf16(H[2 * s2 + 1][2], H[2 * s2 + 1][3]);
        bf16_t* hp = gHT + ci * 4096 + v * 64 + 32 * s2 + 4 * q;
        *(u32x2*)hp = (u32x2){bfr[s2].x, bfr[s2].y}; *(u32x2*)(hp + 16) = (u32x2){bfr[s2].z, bfr[s2].w}; }
#pragma unroll
    for (int m = 0; m < 4; ++m) {
        f32x4 a2 = (f32x4){bf_lo(o.n0[m].x), bf_hi(o.n0[m].x), bf_lo(o.n0[m].y), bf_hi(o.n0[m].y)};
#pragma unroll
        for (int s2 = 0; s2 < 2; ++s2) { const u32x4 af = (u32x4){o.m[m][s2][0].x, o.m[m][s2][0].y, o.m[m][s2][1].x, o.m[m][s2][1].y};
            a2 = __builtin_amdgcn_mfma_f32_16x16x32_bf16(__builtin_bit_cast(bf16x8, af), __builtin_bit_cast(bf16x8, bfr[s2]), a2, 0, 0, 0); }
        H[m] = a2; }
}
constexpr int SC_DEPTH = 10, SC_SLOT = 12288;
DI void scan_dma(unsigned lds_dst, unsigned voff, const char* base) { asm volatile("s_mov_b32 m0, %0\n\ts_nop 0\n\tglobal_load_lds_dwordx4 %1, %2" :: "s"(lds_dst), "v"(voff), "s"(base) : "memory"); }
DI void scan_lds_load(ScanOps& o, const LAS unsigned char* slot, int lbM, int lbN, const int (&xo)[2][2], int c7) {
#pragma unroll
    for (int m = 0; m < 4; ++m) {
#pragma unroll
        for (int s2 = 0; s2 < 2; ++s2) { o.m[m][s2][0] = *(const LAS u32x2*)(slot + lbM + m * 2048 + xo[s2][0]); o.m[m][s2][1] = *(const LAS u32x2*)(slot + lbM + m * 2048 + xo[s2][1]); }
        o.n0[m] = *(const LAS u32x2*)(slot + 8192 + lbN + (((2 * m) << 4) ^ c7)); }
}
DI void p_rw_scan(const Frame& F) {
    const bf16_t* gM = (const bf16_t*)(F.ws + WS_CHK_M); const bf16_t* gN0T = (const bf16_t*)(F.ws + WS_CHK_N0T); bf16_t* gHT = (bf16_t*)(F.ws + WS_CHK_HT);
    const unsigned ldsbase = (unsigned)(size_t)F.lds;
    const int w = F.wave, col = F.lane & 15, q = F.lane >> 4;
    const int lw = w - 2, lt = F.tid - 128;
    const int P1 = (384 + lt) & 511;
    const unsigned voff0 = (unsigned)((lt >> 3) * 128 + (((lt & 7) ^ ((lt >> 3) & 7)) << 4));
    const unsigned voff1 = (unsigned)((P1 >> 3) * 128 + (((P1 & 7) ^ ((P1 >> 3) & 7)) << 4));
    const int c7 = (col & 7) << 4, qh = (q >> 1) << 4;
    const int lbM = col * 128 + 8 * (q & 1), lbN = (16 * (w & 1) + col) * 128 + 8 * (q & 1);
    int xo[2][2];
#pragma unroll
    for (int s2 = 0; s2 < 2; ++s2)
#pragma unroll
        for (int h = 0; h < 2; ++h) xo[s2][h] = (((4 * s2 + 2 * h) << 4) + qh) ^ c7;
    const int c7n = c7 ^ qh;
    for (int p = F.bid; p < 256; p += F.G) {
        const int bh = p >> 1, half = p & 1, v = 32 * half + 16 * (w & 1) + col;
        const size_t c0 = (size_t)bh * 64;
        const char* baseM = (const char*)(gM + c0 * 4096);
        const char* baseN = (const char*)(gN0T + c0 * 4096 + half * 2048);
        const char* base1 = (lw < 2) ? baseM : baseN;
#define SC_ISSUE(c, slot) do { if (w >= 2) { const unsigned _d = ldsbase + (unsigned)(slot) * SC_SLOT + (unsigned)lw * 1024u; \
            scan_dma(_d, voff0 + (unsigned)(c) * 8192u, baseM); scan_dma(_d + 6144u, voff1 + (unsigned)(c) * 8192u, base1); } } while (0)
#pragma unroll 1
        for (int c = 0; c < SC_DEPTH; ++c) SC_ISSUE(c, c);
        asm volatile("s_waitcnt vmcnt(0)" ::: "memory"); __builtin_amdgcn_s_barrier();
        f32x4 H[4];
#pragma unroll
        for (int m = 0; m < 4; ++m) H[m] = (f32x4){0.f, 0.f, 0.f, 0.f};
        ScanOps A, B;
        if (w < 2) scan_lds_load(A, F.lds, lbM, lbN, xo, c7n);
        int slot = 0;
#define SC_STEP(X, Y, c) do { \
            if (w < 2) asm volatile("s_waitcnt lgkmcnt(0)" ::: "memory"); else asm volatile("s_waitcnt vmcnt(16)" ::: "memory"); \
            __builtin_amdgcn_s_barrier(); \
            const int _sn = (slot + 1 == SC_DEPTH) ? 0 : slot + 1; \
            if (w < 2) scan_lds_load(Y, F.lds + _sn * SC_SLOT, lbM, lbN, xo, c7n); \
            { const int _cn = ((c) + SC_DEPTH < 64) ? (c) + SC_DEPTH : 63; SC_ISSUE(_cn, slot); } \
            if (w < 2) scan_step(X, H, gHT, c0 + (c), q, v); \
            slot = _sn; } while (0)
        static_assert(2 * (SC_DEPTH - 2) == 16, "vmcnt literal in SC_STEP");
#pragma unroll 1
        for (int c = 0; c < 64; c += 2) { SC_STEP(A, B, c); SC_STEP(B, A, c + 1); }
#undef SC_STEP
#undef SC_ISSUE
        asm volatile("s_waitcnt vmcnt(0)" ::: "memory"); __builtin_amdgcn_s_barrier();
    }
}

struct RcIn { bf16x8 qf[2], hb[4][2]; u32x2 y0[4], cv[4], pv[4], gw[4]; float bn; };
DI void rc_load(RcIn& x, const bf16_t* gQ, const bf16_t* gY0, const bf16_t* gHT, const bf16_t* prw, const bf16_t* lwag, const float* bonus, int item, int r, int q) {
    const int ci = item >> 2, ti = item & 3, bh = ci >> 6, c = ci & 63, b = bh >> 3, h = bh & 7;
    const size_t cb = (size_t)ci * 4096; const size_t tok = (size_t)b * SEQ + c * 64 + 16 * ti + r;
    const bool first = (tok & (SEQ - 1)) == 0; const size_t tp = first ? tok : tok - 1;
#pragma unroll
    for (int s2 = 0; s2 < 2; ++s2) x.qf[s2] = *(const bf16x8*)(gQ + cb + (16 * ti + r) * 64 + 32 * s2 + 8 * q);
#pragma unroll
    for (int n = 0; n < 4; ++n) { const int cch = h * 64 + 16 * n + 4 * q;
        x.y0[n] = *(const u32x2*)(gY0 + cb + (16 * ti + r) * 64 + 16 * n + 4 * q);
#pragma unroll
        for (int s2 = 0; s2 < 2; ++s2) x.hb[n][s2] = *(const bf16x8*)(gHT + cb + (16 * n + r) * 64 + 32 * s2 + 8 * q);
        x.cv[n] = *(const u32x2*)(prw + tok * RWC + 1024 + cch); x.pv[n] = *(const u32x2*)(prw + tp * RWC + 1024 + cch);
        x.gw[n] = *(const u32x2*)(lwag + tok * 1536 + 1024 + cch); }
    x.bn = bonus[tok * 8 + h];
}
DI void rc_compute(const RcIn& x, bf16_t* yrw, const float* mu, const float* ln_g, const float* ln_b, int item, int r, int q) {
    const int ci = item >> 2, ti = item & 3, bh = ci >> 6, c = ci & 63, b = bh >> 3, h = bh & 7;
    const size_t tok = (size_t)b * SEQ + c * 64 + 16 * ti + r; const bool first = (tok & (SEQ - 1)) == 0;
    f32x4 y[4];
#pragma unroll
    for (int n = 0; n < 4; ++n) { y[n] = (f32x4){bf_lo(x.y0[n].x), bf_hi(x.y0[n].x), bf_lo(x.y0[n].y), bf_hi(x.y0[n].y)};
#pragma unroll
        for (int s2 = 0; s2 < 2; ++s2) y[n] = __builtin_amdgcn_mfma_f32_16x16x32_bf16(x.hb[n][s2], x.qf[s2], y[n], 0, 0, 0); }
    float s1 = 0.f;
#pragma unroll
    for (int n = 0; n < 4; ++n) s1 += (y[n][0] + y[n][1]) + (y[n][2] + y[n][3]);
    s1 = xrow_sum(s1);
    const float mean = s1 * (1.0f / 64.0f);
    float s2 = 0.f;
#pragma unroll
    for (int n = 0; n < 4; ++n) { y[n] = y[n] - mean; s2 += (y[n][0] * y[n][0] + y[n][1] * y[n][1]) + (y[n][2] * y[n][2] + y[n][3] * y[n][3]); }
    s2 = xrow_sum(s2);
    const float rstd = rsqrtf(s2 * (1.0f / 64.0f) + 64e-5f);
#pragma unroll
    for (int n = 0; n < 4; ++n) { const int cch = h * 64 + 16 * n + 4 * q;
        const f32x4 muv = *(const f32x4*)(mu + 1024 + cch), lg = *(const f32x4*)(ln_g + cch), lb = *(const f32x4*)(ln_b + cch);
        const float cv[4] = {bf_lo(x.cv[n].x), bf_hi(x.cv[n].x), bf_lo(x.cv[n].y), bf_hi(x.cv[n].y)};
        const float pv[4] = {first ? 0.f : bf_lo(x.pv[n].x), first ? 0.f : bf_hi(x.pv[n].x), first ? 0.f : bf_lo(x.pv[n].y), first ? 0.f : bf_hi(x.pv[n].y)};
        const float gg[4] = {bf_lo(x.gw[n].x), bf_hi(x.gw[n].x), bf_lo(x.gw[n].y), bf_hi(x.gw[n].y)};
        float o[4];
#pragma unroll
        for (int g = 0; g < 4; ++g) { const float vsh = cv[g] + muv[g] * (pv[g] - cv[g]); o[g] = (y[n][g] * rstd * lg[g] + lb[g] + x.bn * vsh) * gg[g]; }
        u32x2 ow; ow.x = cvt_pk_bf16(o[0], o[1]); ow.y = cvt_pk_bf16(o[2], o[3]);
        *(u32x2*)(yrw + tok * 512 + cch) = ow; }
}
DI void p_rw_out(const Frame& F) {
    const bf16_t* gQ = (const bf16_t*)(F.ws + WS_CHK_Q); const bf16_t* gY0 = (const bf16_t*)(F.ws + WS_CHK_Y0T); const bf16_t* gHT = (const bf16_t*)(F.ws + WS_CHK_HT);
    const bf16_t* prw = (const bf16_t*)(F.ws + WS_PRW); const bf16_t* lwag = (const bf16_t*)(F.ws + WS_LWAG); const float* bonus = (const float*)(F.ws + WS_BONUS);
    bf16_t* yrw = (bf16_t*)(F.ws + WS_YRW);
    const float* mu = F.in[13]; const float* ln_g = F.in[22]; const float* ln_b = F.in[23];
    const int r = F.lane & 15, q = F.lane >> 4, stride = F.G * NWAVES, NIT = RW_NCH * 4;
    for (int item = F.bid * NWAVES + F.wave; item < NIT; item += 2 * stride) {
        const int item2 = (item + stride < NIT) ? item + stride : item;
        RcIn xa, xb;
        rc_load(xa, gQ, gY0, gHT, prw, lwag, bonus, item, r, q); rc_load(xb, gQ, gY0, gHT, prw, lwag, bonus, item2, r, q);
        rc_compute(xa, yrw, mu, ln_g, ln_b, item, r, q); rc_compute(xb, yrw, mu, ln_g, ln_b, item2, r, q);
    }
}

DI void p_moe_prep(const Frame& F) {
    const bf16_t* hb = (const bf16_t*)(F.ws + WS_HB); float* rsv = (float*)(F.ws + WS_RS); unsigned char* out8 = (unsigned char*)(F.ws + WS_XN2F8); const float* g = F.in[26];
    const int stride = F.G * NWAVES;
    for (int row = F.bid * NWAVES + F.wave; row < T; row += 2 * stride) {
        const int row2 = (row + stride < T) ? row + stride : row;
        u32x4 a[2], b[2];
        a[0] = *(const u32x4*)(hb + (size_t)row * D + F.lane * 16); a[1] = *(const u32x4*)(hb + (size_t)row * D + F.lane * 16 + 8);
        b[0] = *(const u32x4*)(hb + (size_t)row2 * D + F.lane * 16); b[1] = *(const u32x4*)(hb + (size_t)row2 * D + F.lane * 16 + 8);
        float v[16], u[16]; float ss = 0.f, su = 0.f;
#pragma unroll
        for (int j = 0; j < 8; ++j) { v[2 * j] = bf_lo(a[j >> 2][j & 3]); v[2 * j + 1] = bf_hi(a[j >> 2][j & 3]); u[2 * j] = bf_lo(b[j >> 2][j & 3]); u[2 * j + 1] = bf_hi(b[j >> 2][j & 3]); }
#pragma unroll
        for (int j = 0; j < 16; ++j) { ss += v[j] * v[j]; su += u[j] * u[j]; }
        ss = wave_sum(ss); su = wave_sum(su);
        const float rs = rsqrtf(ss * (1.0f / D) + 1e-5f), ru = rsqrtf(su * (1.0f / D) + 1e-5f);
        float gv[16];
#pragma unroll
        for (int q = 0; q < 4; ++q) { const f32x4 t = *(const f32x4*)(g + F.lane * 16 + q * 4); gv[4 * q] = t[0]; gv[4 * q + 1] = t[1]; gv[4 * q + 2] = t[2]; gv[4 * q + 3] = t[3]; }
#pragma unroll
        for (int j = 0; j < 16; ++j) { v[j] *= rs * gv[j]; u[j] *= ru * gv[j]; }
        u32x4 q0, q1;
        if (F.lane == 0) { rsv[row] = rs; rsv[row2] = ru; }
        q0.x = pk4_fp8(v[0] * F8_SX, v[1] * F8_SX, v[2] * F8_SX, v[3] * F8_SX); q0.y = pk4_fp8(v[4] * F8_SX, v[5] * F8_SX, v[6] * F8_SX, v[7] * F8_SX);
        q0.z = pk4_fp8(v[8] * F8_SX, v[9] * F8_SX, v[10] * F8_SX, v[11] * F8_SX); q0.w = pk4_fp8(v[12] * F8_SX, v[13] * F8_SX, v[14] * F8_SX, v[15] * F8_SX);
        q1.x = pk4_fp8(u[0] * F8_SX, u[1] * F8_SX, u[2] * F8_SX, u[3] * F8_SX); q1.y = pk4_fp8(u[4] * F8_SX, u[5] * F8_SX, u[6] * F8_SX, u[7] * F8_SX);
        q1.z = pk4_fp8(u[8] * F8_SX, u[9] * F8_SX, u[10] * F8_SX, u[11] * F8_SX); q1.w = pk4_fp8(u[12] * F8_SX, u[13] * F8_SX, u[14] * F8_SX, u[15] * F8_SX);
        *(u32x4*)(out8 + (size_t)row * D + F.lane * 16) = q0; *(u32x4*)(out8 + (size_t)row2 * D + F.lane * 16) = q1;
    }
    float* b1p = (float*)(F.ws + WS_B1P); const float* b1 = F.in[30]; CmSwi cm;
    for (int idx = F.bid * NTHR + F.tid; idx < 32 * 2048; idx += F.G * NTHR) { const int e = idx >> 11, n = idx & 2047; b1p[idx] = b1[e * 2048 + cm(n)]; }
}
DI void p_conv_part(const Frame& F, int part) {
    if (part == 0) conv_T8(F, F.in[29], (size_t)1024 * 2048, 2048, (unsigned char*)(F.ws + WS_W1), 2048, 1024, 32, MpSwi(), F8_SW, 0, 2048);
    else if (part == 1) conv_T8(F, F.in[29], (size_t)1024 * 2048, 2048, (unsigned char*)(F.ws + WS_W1), 2048, 1024, 32, MpSwi(), F8_SW, 2048, 4096);
    else conv_T8(F, F.in[31], (size_t)1024 * 1024, 1024, (unsigned char*)(F.ws + WS_W2), 1024, 1024, 32, MpId(), F8_SW);
}

DI void topk_rows(const Frame& F, int row0) {
    LAS unsigned* cnt = (LAS unsigned*)F.lds; LAS unsigned* base = cnt + 32;
    const float* logits = (const float*)(F.ws + WS_LOG); unsigned* epos = (unsigned*)(F.ws + WS_EPOS); float* gatev = (float*)(F.ws + WS_GATEV);
    const int pass = row0 / TPP;
    unsigned* gcnt = (unsigned*)(F.ws + WS_CTL) + CW_GCNT + pass * 32;
    if (F.tid < 32) cnt[F.tid] = 0u;
    __syncthreads();
    int e4[4] = {0, 0, 0, 0}; unsigned p4[4] = {0u, 0u, 0u, 0u}; float g4[4] = {0.f, 0.f, 0.f, 0.f};
    const int token = row0 + F.tid;
    if (F.tid < 256) {
        float l[32]; const float rsc = ((const float*)(F.ws + WS_RS))[token];
#pragma unroll
        for (int q = 0; q < 8; ++q) { const f32x4 v = *(const f32x4*)(logits + (size_t)token * 32 + q * 4), bq = *(const f32x4*)(F.in[28] + q * 4); l[q * 4] = v[0] * rsc + bq[0]; l[q * 4 + 1] = v[1] * rsc + bq[1]; l[q * 4 + 2] = v[2] * rsc + bq[2]; l[q * 4 + 3] = v[3] * rsc + bq[3]; }
        unsigned used = 0u; float tv[4];
#pragma unroll
        for (int k = 0; k < 4; ++k) { float best = -3.0e38f; int bi = 0;
#pragma unroll
            for (int e = 0; e < 32; ++e) { const bool ok = !((used >> e) & 1u) && (l[e] > best); best = ok ? l[e] : best; bi = ok ? e : bi; }
            used |= 1u << bi; e4[k] = bi; tv[k] = best; }
        const float m = tv[0]; float ex[4], sum = 0.f;
#pragma unroll
        for (int k = 0; k < 4; ++k) { ex[k] = __expf(tv[k] - m); sum += ex[k]; }
#pragma unroll
        for (int k = 0; k < 4; ++k) { g4[k] = ex[k] / sum; p4[k] = atomicAdd((unsigned*)&cnt[e4[k]], 1u); }
    }
    __syncthreads();
    if (F.tid < 32) base[F.tid] = __hip_atomic_fetch_add(&gcnt[F.tid], cnt[F.tid], __ATOMIC_RELAXED, __HIP_MEMORY_SCOPE_AGENT);
    __syncthreads();
    if (F.tid < 256) {
#pragma unroll
        for (int k = 0; k < 4; ++k) { epos[(size_t)token * 4 + k] = ((unsigned)e4[k] << 24) | (base[e4[k]] + p4[k]); gatev[(size_t)token * 4 + k] = g4[k]; }
    }
    __syncthreads();
}
DI void p_gather(const Frame& F, int pass) {
    LAS int* poff = (LAS int*)F.lds;
    LAS int* pcnt = poff + 40;
    unsigned* gcnt = (unsigned*)(F.ws + WS_CTL) + CW_GCNT + pass * 32;
    int* tile_e = (int*)(F.ws + WS_TILEE) + pass * TE_STRIDE;
    __syncthreads();
    if (F.tid == 0) { int acc = 0; for (int e = 0; e < 32; ++e) { poff[e] = acc; const int c = (int)__hip_atomic_load(&gcnt[e], __ATOMIC_RELAXED, __HIP_MEMORY_SCOPE_AGENT); pcnt[e] = c; acc += ((c + 255) >> 8) << 8; } poff[32] = acc; }
    __syncthreads();
    if (F.bid == 0) {
        const int nt = poff[32] >> 8;
        for (int t = F.tid; t < nt; t += NTHR) { int e = 0; for (int q = 1; q < 32; ++q) if (poff[q] <= t * 256) e = q; tile_e[1 + t] = e; }
        if (F.tid == 0) tile_e[0] = nt;
    }
    const unsigned* epos = (const unsigned*)(F.ws + WS_EPOS); const float* gatev = (const float*)(F.ws + WS_GATEV);
    int* slot = (int*)(F.ws + WS_SLOT); float* rowg = (float*)(F.ws + WS_ROWG) + (size_t)pass * MAXTILES * 256;
    int* rowtok = (int*)(F.ws + WS_ROWTOK) + (size_t)pass * MAXTILES * 256;
    for (int i = F.bid * NTHR + F.tid; i < 32 * 256; i += F.G * NTHR) { const int e = i >> 8, sl = poff[e] + pcnt[e] + (i & 255); if (sl < poff[e + 1]) rowtok[sl] = 0; }
    for (int i = F.bid * NTHR + F.tid; i < TPP * 4; i += F.G * NTHR) {
        const int token = pass * TPP + (i >> 2);
        const unsigned ep = epos[(size_t)pass * TPP * 4 + i]; const int sl = poff[ep >> 24] + (int)(ep & 0xffffffu);
        slot[(size_t)pass * TPP * 4 + i] = sl; rowg[sl] = gatev[(size_t)pass * TPP * 4 + i]; rowtok[sl] = token;
    }
    __syncthreads();
}
DI void p_combine(const Frame& F, int pass) {
    int tz_ = threadIdx.x; asm volatile("" : "+v"(tz_)); const int lane_ = tz_ & 63;
    const int* slot = (const int*)(F.ws + WS_SLOT); const unsigned char* y2 = (const unsigned char*)(F.ws + WS_XS) + (size_t)pass * PASS_BUF; const float* gf = F.in[33];
    for (int t = F.bid * NWAVES + F.wave; t < TPP; t += F.G * NWAVES) {
        const int token = pass * TPP + t;
        float v[16];
        { const bf16_t* hb = (const bf16_t*)(F.ws + WS_HB) + (size_t)token * D + lane_ * 16; const u32x4 h0 = *(const u32x4*)hb, h1 = *(const u32x4*)(hb + 8);
#pragma unroll
          for (int j = 0; j < 4; ++j) { v[2 * j] = bf_lo(h0[j]); v[2 * j + 1] = bf_hi(h0[j]); v[8 + 2 * j] = bf_lo(h1[j]); v[8 + 2 * j + 1] = bf_hi(h1[j]); } }
        u32x4 yw[4];
#pragma unroll
        for (int k = 0; k < 4; ++k) { const int s = slot[(size_t)token * 4 + k]; yw[k] = *(const u32x4*)(y2 + (size_t)s * D + lane_ * 16); }
#pragma unroll
        for (int k = 0; k < 4; ++k)
#pragma unroll
            for (int j = 0; j < 4; ++j) { const f32x2 lo = __builtin_amdgcn_cvt_pk_f32_fp8((int)yw[k][j], false), hi = __builtin_amdgcn_cvt_pk_f32_fp8((int)yw[k][j], true);
                v[4 * j] += lo[0] * (1.0f / F8_SY); v[4 * j + 1] += lo[1] * (1.0f / F8_SY); v[4 * j + 2] += hi[0] * (1.0f / F8_SY); v[4 * j + 3] += hi[1] * (1.0f / F8_SY); }
        float ss = 0.f;
#pragma unroll
        for (int j = 0; j < 16; ++j) ss += v[j] * v[j];
        ss = wave_sum(ss);
        const float rs = rsqrtf(ss * (1.0f / D) + 1e-5f);
        f32x4* orow = (f32x4*)(F.out + (size_t)token * D + lane_ * 16);
#pragma unroll
        for (int q = 0; q < 4; ++q) { const f32x4 gv = *(const f32x4*)(gf + lane_ * 16 + q * 4);
            orow[q] = (f32x4){v[q * 4] * rs * gv[0], v[q * 4 + 1] * rs * gv[1], v[q * 4 + 2] * rs * gv[2], v[q * 4 + 3] * rs * gv[3]}; }
    }
}

constexpr int N_PHASES = 18;
__global__ void __launch_bounds__(NTHR, 2) fwd_kernel(KArgs args) {
    extern __shared__ __attribute__((aligned(16))) unsigned char lds_raw[];
    Frame F; F.lds = (LAS unsigned char*)lds_raw; F.tid = threadIdx.x; F.lane = F.tid & 63; F.wave = __builtin_amdgcn_readfirstlane(F.tid >> 6);
    F.G = gridDim.x; F.bid = blockIdx.x; F.in = args.in; F.out = args.out; F.ws = args.ws;
    unsigned char* ws = args.ws;
    volatile LAS unsigned* MISC = (volatile LAS unsigned*)(F.lds + MISC_OFF);
    if (F.tid < 4) MISC[F.tid] = 0u;
    __syncthreads();
    XcdBarrier bar; bar.bar = (unsigned*)(ws + WS_CTL) + CW_BAR; bar.x = 0; bar.st = MISC;
    if (N_LAUNCH_MODE == 1) bar = xcd_barrier_post((unsigned*)(ws + WS_CTL) + CW_BAR, MISC);
    const int lo = args.ph_lo, hi = args.ph_hi;
#define IN(k) (lo <= (k) && (k) < hi)
#define REP(k) for (int _r = 0; _r < 1 + (int)((PROBE_MASK >> (k)) & 1u); ++_r)
#define SEAM(k) do { if (N_LAUNCH_MODE == 1 && IN(k) && IN((k) + 1)) xcd_barrier(bar); } while (0)
    bf16_t* gates = (bf16_t*)args.out;

    if (IN(0)) { REP(0) p0_prologue(F); SEAM(0); }
    if (IN(1)) {
        PlainSched S; S.init(ws + WS_XN, ws + WS_WIN, T, INC, D, D, D, F.G, F.bid);
        EpiWin E{(bf16_t*)(ws + WS_US5), (bf16_t*)(ws + WS_PRW), gates};
        REP(1) gemm_phase(F.lds, S, E); SEAM(1);
    }
    if (IN(2)) {
        GroupSched S; S.init(ws + WS_US5, ws + WS_WST, 512, LDU, 512, S5ROWS / BM, 1, F.G, F.bid);
        EpiS5State E{(float*)(ws + WS_SLOC)};
        REP(2) { gemm_phase(F.lds, S, E); p_rw_prep(F); } SEAM(2);
    }
    if (IN(3)) {
        REP(3) p_s5_carry(F);
        PlainSched S; S.init(ws + WS_ALORA, ws + WS_WLORA, T, 1536, 128, 256, 128, F.G, F.bid); S.akoff_pn = 4; S.akoff_bytes = 256;
        EpiLora E{(bf16_t*)(ws + WS_LWAG), F.in[14], F.in[16]};
        REP(3) gemm_phase(F.lds, S, E); SEAM(3);
    }
    if (IN(4)) {
        GroupSched S; S.init(ws + WS_US5, ws + WS_TOEP, LDU, LDU, LDU, S5ROWS / BM, 2, F.G, F.bid);
        EpiS5Out E{(bf16_t*)(ws + WS_YS)};
        REP(4) gemm_phase(F.lds, S, E); SEAM(4);
    }
    if (IN(5)) { REP(5) p_rw_chunk(F); SEAM(5); }
    if (IN(6)) { REP(6) p_rw_scan(F); SEAM(6); }
    if (IN(7)) { REP(7) p_rw_out(F); SEAM(7); }
    if (IN(8)) {
        PlainSched S; S.init(ws + WS_YS, ws + WS_WGLU, T, 2048, 512, 512, 512, F.G, F.bid);
        EpiGlu E{(bf16_t*)(ws + WS_XN), gates, (const float*)(ws + WS_BGLU)};
        if (F.bid & 1) p_conv_part(F, 0);
        gemm_phase(F.lds, S, E);
        if (!(F.bid & 1)) p_conv_part(F, 0);
        SEAM(8);
    }
    if (IN(9)) {
        PlainSched S; S.init(ws + WS_YRW, ws + WS_WO, T, 1024, 512, 512, 512, F.G, F.bid);
        EpiWo E{(bf16_t*)(ws + WS_XN), gates};
        if (F.bid & 1) p_conv_part(F, 1);
        gemm_phase(F.lds, S, E);
        if (!(F.bid & 1)) p_conv_part(F, 1);
        SEAM(9);
    }
    if (IN(10)) {
        PlainSched S; S.init(ws + WS_XN, ws + WS_WOUT, T, 1024, 1024, 1024, 1024, F.G, F.bid);
        EpiOut E{(bf16_t*)(ws + WS_HB), F.in[0]};
        if (F.bid & 1) p_conv_part(F, 2);
        gemm_phase(F.lds, S, E);
        if (!(F.bid & 1)) p_conv_part(F, 2);
        SEAM(10);
    }
    if (IN(11)) { REP(11) p_moe_prep(F); SEAM(11); }
    if (IN(12)) {
        PlainSched S; S.init(ws + WS_HB, ws + WS_WR, T, 256, 1024, 1024, 1024, F.G, F.bid);
        EpiRouter E{(float*)(ws + WS_LOG)};
        gemm_phase(F.lds, S, E);
        { Unit u; for (int i = 0; S.next(i, u); ++i) topk_rows(F, u.pm * BM); }
        SEAM(12);
    }
    if (IN(13)) { p_gather(F, 0); p_gather(F, 1); SEAM(13); }
#define MOE_G1(PASS, CIDX) \
            const int* te = (const int*)(ws + WS_TILEE) + (PASS) * TE_STRIDE; const int ntl = __builtin_amdgcn_readfirstlane(__hip_atomic_load(te, __ATOMIC_RELAXED, __HIP_MEMORY_SCOPE_AGENT)); \
            MoeSched<true> S; S.init(ws + WS_XN2F8, ws + WS_W1, te + 1, (const int*)(ws + WS_ROWTOK) + (size_t)(PASS) * MAXTILES * 256, ntl, 512, 8, F.G, (CIDX)); \
            EpiMoe1 E{(unsigned char*)(ws + WS_ACT) + (size_t)(PASS) * PASS_BUF, (const float*)(ws + WS_B1P)};
#define MOE_G2(PASS) \
            const int* te = (const int*)(ws + WS_TILEE) + (PASS) * TE_STRIDE; const int ntl = __builtin_amdgcn_readfirstlane(__hip_atomic_load(te, __ATOMIC_RELAXED, __HIP_MEMORY_SCOPE_AGENT)); \
            MoeSched<false> S; S.init(ws + WS_ACT + (size_t)(PASS) * PASS_BUF, ws + WS_W2, te + 1, nullptr, ntl, 512, 4, F.G, F.bid); \
            EpiMoe2 E{(unsigned char*)(ws + WS_XS) + (size_t)(PASS) * PASS_BUF, F.in[32], (const float*)(ws + WS_ROWG) + (size_t)(PASS) * MAXTILES * 256};
    if (IN(14)) { MOE_G1(0, F.bid) gemm_phase(F.lds, S, E); SEAM(14); }
    if (IN(15)) {
        { MOE_G2(0) gemm_phase(F.lds, S, E); }
        { MOE_G1(1, F.G - 1 - F.bid) gemm_phase(F.lds, S, E); }
        SEAM(15);
    }
    if (IN(16)) {
        if (F.bid & 1) p_combine(F, 0);
        { MOE_G2(1) gemm_phase(F.lds, S, E); }
        if (!(F.bid & 1)) p_combine(F, 0);
        SEAM(16);
    }
    if (IN(17)) { p_combine(F, 1); }
#undef MOE_G1
#undef MOE_G2
#undef IN
#undef SEAM
#undef REP
}

extern "C" void kernel_launch(void* const* d_in, const int* in_sizes, int n_in, void* d_out, int out_size, void* d_ws, size_t ws_size, hipStream_t stream) {
    static int grid = 0;
    if (grid == 0) {
        if (n_in != 34 || in_sizes[0] != T * D || out_size != T * D || ws_size < WS_END) { fprintf(stderr, "kernel_launch: unexpected shapes (n_in %d, in0 %d, out %d, ws %zu < %zu)\n", n_in, n_in > 0 ? in_sizes[0] : -1, out_size, ws_size, (size_t)WS_END); grid = -1; return; }
        int dev = 0, cus = 0, per_cu = 0;
        if (hipGetDevice(&dev) != hipSuccess || hipDeviceGetAttribute(&cus, hipDeviceAttributeMultiprocessorCount, dev) != hipSuccess) { grid = -1; return; }
        if (hipFuncSetAttribute((const void*)fwd_kernel, hipFuncAttributeMaxDynamicSharedMemorySize, LDS_BYTES) != hipSuccess) { fprintf(stderr, "kernel_launch: hipFuncSetAttribute failed\n"); grid = -1; return; }
        if (hipOccupancyMaxActiveBlocksPerMultiprocessor(&per_cu, (const void*)fwd_kernel, NTHR, LDS_BYTES) != hipSuccess || per_cu < 1) { fprintf(stderr, "kernel_launch: occupancy query says %d\n", per_cu); }
        (void)hipGetLastError();
        grid = cus;
    }
    if (grid < 0) return;
    (void)hipMemsetAsync((char*)d_ws + WS_CTL, 0, CTL_BYTES, stream);
    KArgs a{};
    for (int i = 0; i < 34; ++i) a.in[i] = (const float*)d_in[i];
    a.out = (float*)d_out; a.ws = (unsigned char*)d_ws;
    if (N_LAUNCH_MODE == 1) {
        a.ph_lo = 0; a.ph_hi = N_PHASES;
        hipLaunchKernelGGL(fwd_kernel, dim3(grid), dim3(NTHR), LDS_BYTES, stream, a);
    } else {
        for (int p = 0; p < N_PHASES; ++p) { a.ph_lo = p; a.ph_hi = p + 1; hipLaunchKernelGGL(fwd_kernel, dim3(grid), dim3(NTHR), LDS_BYTES, stream, a); }
    }
}
```

```cpp
#include <hip/hip_runtime.h>
#include <stdint.h>
#include <stdio.h>

#ifndef N_LAUNCH_MODE
#define N_LAUNCH_MODE 1
#endif

#ifndef GEMM_SP2
#define GEMM_SP2 1
#endif
#ifndef GEMM_ALIGN
#define GEMM_ALIGN 1
#endif
#ifndef PROBE_MASK
#define PROBE_MASK 0u
#endif
#define LAS __attribute__((address_space(3)))
#define DI __device__ __forceinline__
typedef unsigned short bf16_t;
typedef short bf16x8 __attribute__((ext_vector_type(8)));
typedef float f32x4 __attribute__((ext_vector_type(4)));
typedef float f32x2 __attribute__((ext_vector_type(2)));
typedef unsigned u32x4 __attribute__((ext_vector_type(4)));
typedef unsigned u32x2 __attribute__((ext_vector_type(2)));
typedef int i32x8 __attribute__((ext_vector_type(8)));
typedef int i32x4 __attribute__((ext_vector_type(4)));

constexpr int T = 65536, D = 1024, SEQ = 4096, NB = 16;
constexpr int INC = 4352, RWC = 1792;
constexpr int S5L = 32;
constexpr int S5NC = SEQ / S5L;
constexpr int S5ROWS = T / S5L;
constexpr int LDU = 16 * S5L + 128;
constexpr int NE = 32, TOPK = 4;
constexpr int NPASS = 2, TPP = T / NPASS;
constexpr int MAXTILES = (TPP * TOPK) / 256 + NE;
constexpr int NWAVES = 8, NTHR = 512;

constexpr size_t al(size_t x) { return (x + 4095) & ~(size_t)4095; }
constexpr size_t WS_CTL = 0, CTL_BYTES = 1 << 20;
constexpr size_t WS_WIN = WS_CTL + CTL_BYTES;
constexpr size_t WS_WGLU = WS_WIN + al((size_t)INC * D * 2);
constexpr size_t WS_WO = WS_WGLU + al((size_t)2048 * 512 * 2);
constexpr size_t WS_WOUT = WS_WO + al((size_t)1024 * 512 * 2);
constexpr size_t WS_WLORA = WS_WOUT + al((size_t)1024 * 1024 * 2);
constexpr size_t WS_WR = WS_WLORA + al((size_t)1536 * 256 * 2);
constexpr size_t WS_TOEP = WS_WR + al((size_t)256 * 1024 * 2);
constexpr size_t WS_WST = WS_TOEP + al((size_t)32 * 512 * LDU * 2);
constexpr size_t WS_BGLU = WS_WST + al((size_t)32 * 256 * 512 * 2);
constexpr size_t WS_B1P = WS_BGLU + al(2048 * 4);
constexpr size_t WS_SHARED = WS_B1P + al((size_t)32 * 2048 * 4);
constexpr size_t WS_PRW = WS_SHARED;
constexpr size_t WS_LWAG = WS_PRW + al((size_t)T * RWC * 2);
constexpr size_t WS_YS = WS_LWAG + al((size_t)T * 1536 * 2);
constexpr size_t WS_YRW = WS_YS + al((size_t)T * 512 * 2);
constexpr size_t WS_BONUS = WS_YRW + al((size_t)T * 512 * 2);
constexpr size_t WS_XN = WS_BONUS + al((size_t)T * 8 * 4);
constexpr size_t WS_US5 = WS_XN + al((size_t)T * D * 2);
constexpr size_t WS_ALORA = WS_US5 + al((size_t)32 * S5ROWS * LDU * 2);
constexpr size_t WS_SLOC = WS_ALORA + al((size_t)T * 256 * 2);
constexpr int RW_NCH = 128 * 64;
constexpr size_t CHK_BYTES = (size_t)RW_NCH * 4096 * 2;
constexpr size_t WS_CHK_M = WS_XN, WS_CHK_N0T = WS_CHK_M + CHK_BYTES, WS_CHK_Q = WS_CHK_N0T + CHK_BYTES, WS_CHK_Y0T = WS_CHK_Q + CHK_BYTES, WS_CHK_HT = WS_CHK_Y0T + CHK_BYTES;
constexpr size_t WS_MIX_END0 = WS_SLOC + al((size_t)32 * S5ROWS * 128 * 4);
constexpr size_t WS_MIX_END = (WS_CHK_HT + CHK_BYTES) > WS_MIX_END0 ? (WS_CHK_HT + CHK_BYTES) : WS_MIX_END0;
constexpr size_t WS_HB = WS_SHARED;
constexpr size_t WS_W1 = WS_HB + al((size_t)T * D * 2);
constexpr size_t WS_W2 = WS_W1 + al((size_t)32 * 2048 * 1024);
constexpr size_t WS_RS = WS_W2 + al((size_t)32 * 1024 * 1024);
constexpr size_t WS_LOG = WS_RS + al((size_t)T * 4);
constexpr size_t WS_EPOS = WS_LOG + al((size_t)T * 32 * 4);
constexpr size_t WS_GATEV = WS_EPOS + al((size_t)T * 4 * 4);
constexpr size_t WS_SLOT = WS_GATEV + al((size_t)T * 4 * 4);
constexpr size_t WS_ROWG = WS_SLOT + al((size_t)T * 4 * 4);
constexpr size_t WS_ROWTOK = WS_ROWG + al((size_t)NPASS * MAXTILES * 256 * 4);
constexpr size_t WS_TILEE = WS_ROWTOK + al((size_t)NPASS * MAXTILES * 256 * 4);
constexpr int TE_STRIDE = MAXTILES + 64;
constexpr size_t WS_XS = WS_TILEE + al((size_t)NPASS * (MAXTILES + 64) * 4);
constexpr size_t PASS_BUF = al((size_t)MAXTILES * 256 * 1024);
constexpr size_t WS_ACT = WS_XS + NPASS * PASS_BUF;
constexpr size_t WS_XN2F8 = WS_ACT + NPASS * PASS_BUF;
constexpr size_t WS_MOE_END = WS_XN2F8 + al((size_t)T * D);
static_assert(WS_W2 + (size_t)32 * 1024 * 1024 <= WS_SHARED + (size_t)T * RWC * 2, "converted expert weights must stay inside the (dead) PRW buffer while the GLU/Wo/out GEMM phases run");
constexpr size_t WS_END = WS_MIX_END > WS_MOE_END ? WS_MIX_END : WS_MOE_END;
static_assert(WS_END <= ((size_t)1 << 30), "workspace over 1 GiB");

constexpr int CW_BAR = 0;
constexpr int CW_GCNT = 4096;

constexpr float F8_SX = 16.f, F8_SW = 32.f, F8_SA = 4.f, F8_SY = 32.f;
constexpr int LDS_BYTES = 144 * 1024;
constexpr int MISC_OFF = 140 * 1024;

typedef __bf16 bf16x2_t __attribute__((ext_vector_type(2)));
DI unsigned cvt_pk_bf16(float lo, float hi) { f32x2 v = {lo, hi}; bf16x2_t b = __builtin_convertvector(v, bf16x2_t); return __builtin_bit_cast(unsigned, b); }
DI unsigned pk4_fp8(float a, float b, float c, float d) {
    a = fminf(fmaxf(a, -448.f), 448.f); b = fminf(fmaxf(b, -448.f), 448.f); c = fminf(fmaxf(c, -448.f), 448.f); d = fminf(fmaxf(d, -448.f), 448.f);
    int w = __builtin_amdgcn_cvt_pk_fp8_f32(a, b, 0, false); w = __builtin_amdgcn_cvt_pk_fp8_f32(c, d, w, true); return (unsigned)w; }
DI float bf_lo(unsigned u) { return __uint_as_float(u << 16); }
DI float bf_hi(unsigned u) { return __uint_as_float(u & 0xffff0000u); }
DI float bf2f(bf16_t b) { return __uint_as_float(((unsigned)b) << 16); }
DI bf16_t f2bf(float f) { return (bf16_t)(cvt_pk_bf16(f, 0.f) & 0xffffu); }
DI float fsigmoid(float x) { return __builtin_amdgcn_rcpf(1.0f + __expf(-x)); }
DI float ftanh(float x) { float e = __expf(2.0f * x); return 1.0f - 2.0f * __builtin_amdgcn_rcpf(e + 1.0f); }
DI float fgelu_tanh(float x) { float u = 0.7978845608f * (x + 0.044715f * x * x * x); return x * fsigmoid(2.0f * u); }
DI f32x2 lo2(const f32x4& v) { return __builtin_shufflevector(v, v, 0, 1); }
DI f32x2 hi2(const f32x4& v) { return __builtin_shufflevector(v, v, 2, 3); }
DI f32x2 pk_sigmoid_scaled(f32x2 x, float negk) {
    const f32x2 t = x * negk; f32x2 e; e.x = __builtin_amdgcn_exp2f(t.x); e.y = __builtin_amdgcn_exp2f(t.y);
    const f32x2 d = e + 1.0f; f32x2 r; r.x = __builtin_amdgcn_rcpf(d.x); r.y = __builtin_amdgcn_rcpf(d.y); return r; }
DI f32x2 pk_sigmoid(f32x2 x) { return pk_sigmoid_scaled(x, -1.44269504f); }
DI f32x2 pk_gelu_tanh(f32x2 x) { const f32x2 x2 = x * x; const f32x2 u = x * (x2 * (0.044715f * 0.7978845608f) + 0.7978845608f); return x * pk_sigmoid_scaled(u, -2.0f * 1.44269504f); }
DI unsigned pk4_fp8_nc(f32x2 a, f32x2 b) { int w = __builtin_amdgcn_cvt_pk_fp8_f32(a.x, a.y, 0, false); w = __builtin_amdgcn_cvt_pk_fp8_f32(b.x, b.y, w, true); return (unsigned)w; }
#define DPP_ROR_ADD(v, n) ((v) + __builtin_bit_cast(float, __builtin_amdgcn_update_dpp(0, __builtin_bit_cast(int, (v)), 0x120 + (n), 0xf, 0xf, false)))
DI float row_sum16(float v) { v = DPP_ROR_ADD(v, 8); v = DPP_ROR_ADD(v, 4); v = DPP_ROR_ADD(v, 2); v = DPP_ROR_ADD(v, 1); return v; }
DI float xrow_sum(float x) {
    float y = x;
    asm("s_nop 1\n\tv_permlane16_swap_b32 %0, %1\n\ts_nop 1" : "+v"(x), "+v"(y));
    x = x + y; y = x;
    asm("s_nop 1\n\tv_permlane32_swap_b32 %0, %1\n\ts_nop 1" : "+v"(x), "+v"(y));
    return x + y;
}
DI float wave_sum(float v) { return xrow_sum(row_sum16(v)); }
DI float sum16(float v) {
    v += __shfl_xor(v, 1); v += __shfl_xor(v, 2); v += __shfl_xor(v, 4); v += __shfl_xor(v, 8); return v;
}

#define XB_TMO      128
#define XB_XCNT(j)  (256  + 64 * (j))
#define XB_XSUB(j)  (1280 + 64 * (j))
#define XB_XGEN(j)  (2304 + 64 * (j))
#define XB_TOP      3328
#define XB_TOPGEN   3392
#define XCD_BAR_WORDS 3456
#define XB_SPIN_CAP (1u << 22)
DI unsigned xb_ld(unsigned* p)              { return __hip_atomic_load(p, __ATOMIC_RELAXED, __HIP_MEMORY_SCOPE_AGENT); }
DI unsigned xb_add(unsigned* p, unsigned v) { return __hip_atomic_fetch_add(p, v, __ATOMIC_RELAXED, __HIP_MEMORY_SCOPE_AGENT); }
DI unsigned xb_xcc_id() { return (unsigned)__builtin_amdgcn_s_getreg((3 << 11) | 20) & 0xFu; }
#define XB_SPIN(cond, bar) do { unsigned _sp = 0; while (cond) { __builtin_amdgcn_s_sleep(1); \
    if ((++_sp & 255u) == 0u) { if (xb_ld(&(bar)[XB_TMO])) break; if (_sp > XB_SPIN_CAP) { atomicAdd(&(bar)[XB_TMO], 1u); break; } } } } while (0)
struct XcdBarrier { unsigned* bar; unsigned x; volatile LAS unsigned* st; };
DI XcdBarrier xcd_barrier_post(unsigned* bar, volatile LAS unsigned* st) {
    XcdBarrier b; b.bar = bar; b.x = xb_xcc_id(); b.st = st;
    if (threadIdx.x == 0) (void)xb_add(&bar[XB_XCNT(b.x)], 1u);
    return b;
}
DI void xcd_barrier_complete(unsigned* bar, unsigned x, unsigned& nloc, unsigned& nx) {
    const unsigned G = gridDim.x * gridDim.y * gridDim.z;
    unsigned sum, cnt, mine, sp = 0u;
    for (;;) {
        sum = 0u; cnt = 0u; mine = 0u;
#pragma unroll
        for (unsigned j = 0; j < 16; ++j) { const unsigned c = xb_ld(&bar[XB_XCNT(j)]); sum += c; cnt += (c > 0u) ? 1u : 0u; mine = (j == x) ? c : mine; }
        if (sum == G) break;
        __builtin_amdgcn_s_sleep(1);
        if ((++sp & 255u) == 0u) { if (xb_ld(&bar[XB_TMO])) break; if (sp > XB_SPIN_CAP) { atomicAdd(&bar[XB_TMO], 1u); break; } }
    }
    nloc = mine > 0u ? mine : 1u; nx = cnt > 0u ? cnt : 1u;
}
DI void xcd_barrier(const XcdBarrier& b) {
    asm volatile("s_waitcnt vmcnt(0)" ::: "memory");
    __syncthreads();
    if (threadIdx.x == 0) {
        unsigned* bar = b.bar;
        __builtin_amdgcn_s_waitcnt(0);
        unsigned nloc = b.st[0], nx = b.st[1];
        if (nloc == 0u) { xcd_barrier_complete(bar, b.x, nloc, nx); b.st[0] = nloc; b.st[1] = nx; }
        const unsigned old = xb_add(&bar[XB_XSUB(b.x)], 1u);
        const unsigned gen = old / nloc;
        if (old + 1u == (gen + 1u) * nloc) {
            __builtin_amdgcn_fence(__ATOMIC_RELEASE, "agent");
            asm volatile("s_waitcnt vmcnt(0)" ::: "memory");
            const unsigned og = xb_add(&bar[XB_TOP], 1u);
            const unsigned tg = og / nx;
            if (og + 1u == (tg + 1u) * nx) xb_add(&bar[XB_TOPGEN], 1u);
            else XB_SPIN(xb_ld(&bar[XB_TOPGEN]) == tg, bar);
            __builtin_amdgcn_fence(__ATOMIC_ACQUIRE, "agent");
            xb_add(&bar[XB_XGEN(b.x)], 1u);
            asm volatile("s_waitcnt vmcnt(0)" ::: "memory");
        } else {
            XB_SPIN(xb_ld(&bar[XB_XGEN(b.x)]) == gen, bar);
            __builtin_amdgcn_fence(__ATOMIC_ACQUIRE, "agent");
            asm volatile("s_waitcnt vmcnt(0)" ::: "memory");
        }
    }
    __syncthreads();
}

constexpr int BM = 256, BK = 64, HALF = 128, HTB = HALF * BK * 2;
DI int lds_byte(int r, int c) { const int st = (r >> 4) * 2 + (c >> 5), rr = r & 15, cc = c & 31, ob = rr * 64 + cc * 2; return st * 1024 + (ob ^ (((ob >> 9) & 1) << 5)); }
DI void stage_rc(int b, int& R, int& C) { const int st = b / 1024, sb = b % 1024, swz = sb ^ (((sb >> 9) & 1) << 5); R = (st >> 1) * 16 + swz / 64; C = (st & 1) * 32 + (swz % 64) / 2; }
DI int perm32(int rho) { const int n = rho >> 4, i = rho & 15; return 8 * (i >> 2) + 4 * n + (i & 3); }
struct Unit { int pm, pn, aux; };

template <class Sched, class Epi>
DI void gemm_phase(LAS unsigned char* lds, const Sched& S, const Epi& E) {
    const int tid = threadIdx.x, wid = __builtin_amdgcn_readfirstlane(tid >> 6), lane = tid & 63, wr = wid >> 2, wc = wid & 3, fr = lane & 15, fq = lane >> 4;
    const int K = S.K, nt = K / BK;
    unsigned voffA[2], voffB[2];
#pragma unroll
    for (int i = 0; i < 2; ++i) { int R, C; stage_rc(tid * 16 + i * 8192, R, C); const int Rb = Epi::PERM ? ((R & ~31) + perm32(R & 31)) : R;
        voffA[i] = (unsigned)(R * S.lda + C) * 2u; voffB[i] = (unsigned)(Rb * S.ldb + C) * 2u; }
    const size_t kstep = (size_t)(BK * 2);
    const size_t hstepA = (size_t)HALF * S.lda * 2, hstepB = (size_t)HALF * S.ldb * 2;
    const unsigned ldsw = (unsigned)wid * 1024u;
    const int aoff = lds_byte(wr * 64 + fr, fq * 8), boff = lds_byte(wc * 32 + fr, fq * 8);
#define PG8_SA(b, h) (((b) * 2 + (h)) * HTB)
#define PG8_SB(b, h) ((4 + (b) * 2 + (h)) * HTB)
    const unsigned ldsbase = (unsigned)(size_t)lds;
#define PG8_STAGE(bufoff, gbase, voff) do { _Pragma("unroll") for (int _i = 0; _i < 2; ++_i) \
        asm volatile("s_mov_b32 m0, %0\n\ts_nop 0\n\tglobal_load_lds_dwordx4 %1, %2" :: "s"(ldsbase + (unsigned)(bufoff) + ldsw + (unsigned)(_i * 8192)), "v"((voff)[_i]), "s"((const char*)(gbase)) : "memory"); } while (0)
#define PG8_LDA(dst, b, h) do { _Pragma("unroll") for (int m = 0; m < 4; ++m) _Pragma("unroll") for (int k = 0; k < 2; ++k) dst[m][k] = *(const LAS bf16x8*)(lds + PG8_SA(b, h) + aoff + m * 2048 + k * 1024); } while (0)
#define PG8_LDB(dst, b, h) do { _Pragma("unroll") for (int n = 0; n < 2; ++n) _Pragma("unroll") for (int k = 0; k < 2; ++k) dst[n][k] = *(const LAS bf16x8*)(lds + PG8_SB(b, h) + boff + n * 2048 + k * 1024); } while (0)
#define PG8_MMA(ai, bj, At, Bt) do { __builtin_amdgcn_s_setprio(1); _Pragma("unroll") for (int m = 0; m < 4; ++m) _Pragma("unroll") for (int n = 0; n < 2; ++n) _Pragma("unroll") for (int k = 0; k < 2; ++k) \
        acc[ai][bj][m][n] = __builtin_amdgcn_mfma_f32_16x16x32_bf16(Bt[n][k], At[m][k], acc[ai][bj][m][n], 0, 0, 0); __builtin_amdgcn_s_setprio(0); } while (0)
#define PG8_WAIT_V(n) asm volatile("s_waitcnt vmcnt(" #n ")" ::: "memory")
#define PG8_WAIT_L(n) asm volatile("s_waitcnt lgkmcnt(" #n ")" ::: "memory")
#define PG8_BAR __builtin_amdgcn_s_barrier()
#define PG8_SCHED __builtin_amdgcn_sched_barrier(0)
    Unit cur, nxt; int ui = 0;
    if (!S.next(0, cur)) return;
    f32x4 acc[2][2][4][2];
#pragma unroll
    for (int a = 0; a < 2; ++a)
#pragma unroll
        for (int b = 0; b < 2; ++b)
#pragma unroll
            for (int m = 0; m < 4; ++m)
#pragma unroll
                for (int n = 0; n < 2; ++n) { if constexpr (Sched::FP8) { f32x2 z0_, z1_; asm volatile("v_pk_mov_b32 %0, 0, 0" : "=v"(z0_)); asm volatile("v_pk_mov_b32 %0, 0, 0" : "=v"(z1_)); acc[a][b][m][n] = (f32x4){z0_.x, z0_.y, z1_.x, z1_.y}; } else acc[a][b][m][n] = (f32x4){0.f, 0.f, 0.f, 0.f}; }
    bf16x8 At[4][2], B0[2][2], B1[2][2];
    i32x8 At8[4], B08[2], B18[2];
    const int aoff8a = lds_byte(wr * 64 + fr, 16 * fq) & ~16, boff8a = lds_byte(wc * 32 + fr, 16 * fq) & ~16;
#define PG8_LDA8(dst, b, h) do { _Pragma("unroll") for (int m = 0; m < 4; ++m) dst[m] = *(const LAS i32x8*)(lds + PG8_SA(b, h) + aoff8a + m * 2048); } while (0)
#define PG8_LDB8(dst, b, h) do { _Pragma("unroll") for (int n = 0; n < 2; ++n) dst[n] = *(const LAS i32x8*)(lds + PG8_SB(b, h) + boff8a + n * 2048); } while (0)
#define PG8_MMA8(ai, bj, At_, Bt_) do { __builtin_amdgcn_s_setprio(1); _Pragma("unroll") for (int m = 0; m < 4; ++m) _Pragma("unroll") for (int n = 0; n < 2; ++n) \
        acc[ai][bj][m][n] = __builtin_amdgcn_mfma_scale_f32_16x16x128_f8f6f4(Bt_[n], At_[m], acc[ai][bj][m][n], 0, 0, 0, 0x7f7f7f7f, 0, 0x7f7f7f7f); __builtin_amdgcn_s_setprio(0); } while (0)
#define XLDA(b, h) do { if constexpr (Sched::FP8) PG8_LDA8(At8, b, h); else PG8_LDA(At, b, h); } while (0)
#define XLDB0(b, h) do { if constexpr (Sched::FP8) PG8_LDB8(B08, b, h); else PG8_LDB(B0, b, h); } while (0)
#define XLDB1(b, h) do { if constexpr (Sched::FP8) PG8_LDB8(B18, b, h); else PG8_LDB(B1, b, h); } while (0)
#define XMMA0(ai, bj) do { if constexpr (Sched::FP8) PG8_MMA8(ai, bj, At8, B08); else PG8_MMA(ai, bj, At, B0); } while (0)
#define XMMA1(ai, bj) do { if constexpr (Sched::FP8) PG8_MMA8(ai, bj, At8, B18); else PG8_MMA(ai, bj, At, B1); } while (0)
    const char* cA = S.a_ptr(cur); const char* cB = S.b_ptr(cur);
    unsigned offA[2][2], offN[2][2];
    if constexpr (Sched::GATHER) {
#pragma unroll
        for (int h = 0; h < 2; ++h)
#pragma unroll
            for (int i = 0; i < 2; ++i) { int R, C; stage_rc(tid * 16 + i * 8192, R, C); offA[h][i] = S.a_rowoff(cur, h * HALF + R) + (unsigned)C * 2u; offN[h][i] = offA[h][i]; }
    }
#define A_STG(bufoff, plainptr, kt, h, nx) do { if constexpr (Sched::GATHER) { PG8_STAGE(bufoff, cA + (size_t)(kt) * kstep, offA[h]); } \
        else PG8_STAGE(bufoff, plainptr, voffA); } while (0)
    if constexpr (GEMM_SP2) {
        PG8_STAGE(PG8_SB(0, 0), cB, voffB); PG8_STAGE(PG8_SB(0, 1), cB + hstepB, voffB); A_STG(PG8_SA(0, 0), cA, 0, 0, false); A_STG(PG8_SA(0, 1), cA + hstepA, 0, 1, false);
        if (wr == 1) PG8_BAR;
        PG8_WAIT_V(2); PG8_BAR;
        PG8_STAGE(PG8_SB(1, 0), cB + kstep, voffB); A_STG(PG8_SA(1, 0), cA + kstep, 1, 0, false); PG8_STAGE(PG8_SB(1, 1), cB + hstepB + kstep, voffB);
        PG8_WAIT_V(6); PG8_BAR;
    } else {
    PG8_STAGE(PG8_SB(0, 0), cB, voffB); A_STG(PG8_SA(0, 0), cA, 0, 0, false); PG8_STAGE(PG8_SB(0, 1), cB + hstepB, voffB); A_STG(PG8_SA(0, 1), cA + hstepA, 0, 1, false);
    if (wr == 1) PG8_BAR;
    PG8_WAIT_V(4); PG8_BAR;
    PG8_STAGE(PG8_SB(1, 0), cB + kstep, voffB); A_STG(PG8_SA(1, 0), cA + kstep, 1, 0, false); PG8_STAGE(PG8_SB(1, 1), cB + hstepB + kstep, voffB);
    PG8_WAIT_V(6); PG8_BAR;
    }
    for (;;) {
        const bool has_next = S.next(ui + 1, nxt);
        const char* nA = has_next ? S.a_ptr(nxt) : cA; const char* nB = has_next ? S.b_ptr(nxt) : cB;
        for (int t = 0; t < nt; t += 2) {
            const bool last = (t == nt - 2);
            const char* a1 = cA + (size_t)(t + 1) * kstep;
            const char* a2 = last ? nA : cA + (size_t)(t + 2) * kstep; const char* b2 = last ? nB : cB + (size_t)(t + 2) * kstep;
            const char* a3 = a2 + kstep; const char* b3 = b2 + kstep;
            const int k2 = last ? 0 : t + 2, k3 = k2 + 1;
            if constexpr (GEMM_SP2) {
            XLDB0(0, 0); XLDB1(0, 1); PG8_SCHED; XLDA(0, 0); A_STG(PG8_SA(1, 1), a1 + hstepA, t + 1, 1, false);
            if constexpr (Sched::GATHER) {
                if (has_next && (t == nt - 4 || nt < 4)) {
#pragma unroll
                    for (int h = 0; h < 2; ++h)
#pragma unroll
                        for (int i = 0; i < 2; ++i) { int R, C; stage_rc(tid * 16 + i * 8192, R, C); offN[h][i] = S.a_rowoff(nxt, h * HALF + R) + (unsigned)C * 2u; } }
                if (last && has_next) { offA[0][0] = offN[0][0]; offA[0][1] = offN[0][1]; offA[1][0] = offN[1][0]; offA[1][1] = offN[1][1]; }
            }
            PG8_WAIT_V(8); PG8_WAIT_L(0); PG8_BAR; XMMA0(0, 0); XMMA1(0, 1); PG8_BAR; PG8_SCHED;
            XLDA(0, 1); PG8_STAGE(PG8_SB(0, 0), b2, voffB); PG8_STAGE(PG8_SB(0, 1), b2 + hstepB, voffB); A_STG(PG8_SA(0, 0), a2, k2, 0, last);
            PG8_WAIT_V(8); PG8_WAIT_L(0); PG8_BAR; XMMA0(1, 0); XMMA1(1, 1); PG8_BAR; PG8_SCHED;
            XLDB0(1, 0); XLDB1(1, 1); PG8_SCHED; XLDA(1, 0); A_STG(PG8_SA(0, 1), a2 + hstepA, k2, 1, last);
            PG8_WAIT_V(8); PG8_WAIT_L(0); PG8_BAR; XMMA0(0, 0); XMMA1(0, 1); PG8_BAR; PG8_SCHED;
            XLDA(1, 1); PG8_STAGE(PG8_SB(1, 0), b3, voffB); PG8_STAGE(PG8_SB(1, 1), b3 + hstepB, voffB); A_STG(PG8_SA(1, 0), a3, k3, 0, last);
            PG8_WAIT_V(8); PG8_WAIT_L(0); PG8_BAR; XMMA0(1, 0); XMMA1(1, 1); PG8_BAR; PG8_SCHED;
            } else {
            XLDB0(0, 0); PG8_SCHED; XLDA(0, 0); A_STG(PG8_SA(1, 1), a1 + hstepA, t + 1, 1, false);
            if constexpr (Sched::GATHER) {
                if (has_next && (t == nt - 4 || nt < 4)) {
#pragma unroll
                    for (int h = 0; h < 2; ++h)
#pragma unroll
                        for (int i = 0; i < 2; ++i) { int R, C; stage_rc(tid * 16 + i * 8192, R, C); offN[h][i] = S.a_rowoff(nxt, h * HALF + R) + (unsigned)C * 2u; } }
                if (last && has_next) { offA[0][0] = offN[0][0]; offA[0][1] = offN[0][1]; offA[1][0] = offN[1][0]; offA[1][1] = offN[1][1]; }
            }
            PG8_WAIT_L(8); PG8_BAR; PG8_WAIT_L(0); XMMA0(0, 0); PG8_BAR; PG8_SCHED;
            XLDB1(0, 1); PG8_STAGE(PG8_SB(0, 0), b2, voffB);
            PG8_BAR; PG8_WAIT_L(0); XMMA1(0, 1); PG8_BAR;
            XLDA(0, 1); A_STG(PG8_SA(0, 0), a2, k2, 0, last);
            PG8_BAR; PG8_WAIT_L(0); XMMA0(1, 0); PG8_BAR; PG8_SCHED;
            PG8_STAGE(PG8_SB(0, 1), b2 + hstepB, voffB);
            PG8_WAIT_V(6); PG8_BAR; XMMA1(1, 1); PG8_BAR;
            XLDB0(1, 0); PG8_SCHED; XLDA(1, 0); A_STG(PG8_SA(0, 1), a2 + hstepA, k2, 1, last);
            PG8_WAIT_L(8); PG8_BAR; PG8_WAIT_L(0); XMMA0(0, 0); PG8_BAR; PG8_SCHED;
            XLDB1(1, 1); PG8_STAGE(PG8_SB(1, 0), b3, voffB);
            PG8_BAR; PG8_WAIT_L(0); XMMA1(0, 1); PG8_BAR;
            XLDA(1, 1); A_STG(PG8_SA(1, 0), a3, k3, 0, last);
            PG8_BAR; PG8_WAIT_L(0); XMMA0(1, 0); PG8_BAR; PG8_SCHED;
            PG8_STAGE(PG8_SB(1, 1), b3 + hstepB, voffB);
            PG8_WAIT_V(6); PG8_BAR; XMMA1(1, 1); PG8_BAR;
            }
        }
        if constexpr (GEMM_ALIGN) { if (wr == 0) PG8_BAR; }
        {
            int tz = threadIdx.x; asm volatile("" : "+v"(tz));
            const int wid2 = tz >> 6, lane2 = tz & 63;
            E(acc, cur, wid2 >> 2, wid2 & 3, lane2 & 15, lane2 >> 4); }
        if (!has_next) break;
#pragma unroll
        for (int a = 0; a < 2; ++a)
#pragma unroll
            for (int b = 0; b < 2; ++b)
#pragma unroll
                for (int m = 0; m < 4; ++m)
#pragma unroll
                    for (int n = 0; n < 2; ++n) { if constexpr (Sched::FP8) { f32x2 z0_, z1_; asm volatile("v_pk_mov_b32 %0, 0, 0" : "=v"(z0_)); asm volatile("v_pk_mov_b32 %0, 0, 0" : "=v"(z1_)); acc[a][b][m][n] = (f32x4){z0_.x, z0_.y, z1_.x, z1_.y}; } else acc[a][b][m][n] = (f32x4){0.f, 0.f, 0.f, 0.f}; }
        cur = nxt; cA = nA; cB = nB; ++ui;
        if constexpr (GEMM_ALIGN) { if (wr == 1) PG8_BAR; }
    }
    PG8_WAIT_V(0);
    if constexpr (!GEMM_ALIGN) { if (wr == 0) PG8_BAR; }
    PG8_BAR;
#undef XLDA
#undef XLDB0
#undef XLDB1
#undef XMMA0
#undef XMMA1
#undef PG8_LDA8
#undef PG8_LDB8
#undef PG8_MMA8
#undef A_STG
#undef PG8_SA
#undef PG8_SB
#undef PG8_STAGE
#undef PG8_LDA
#undef PG8_LDB
#undef PG8_MMA
#undef PG8_WAIT_V
#undef PG8_WAIT_L
#undef PG8_BAR
#undef PG8_SCHED
}

struct PlainSched {
    static constexpr bool GATHER = false, FP8 = false;
    const char* A; const char* B; int K, lda, ldb, nM, nN, nwg, G, c; int akoff_pn = 1 << 30, akoff_bytes = 0;
    DI void init(const void* A_, const void* B_, int M, int N, int K_, int lda_, int ldb_, int G_, int c_) { A = (const char*)A_; B = (const char*)B_; K = K_; lda = lda_; ldb = ldb_; nM = M / BM; nN = N / BM; nwg = nM * nN; G = G_; c = c_; }
    DI bool next(int i, Unit& u) const {
        const long L = (long)i * G + c; if (L >= nwg) return false;
        int wgid = (int)L; { const int q = nwg / 8, r = nwg % 8, xcd = wgid % 8, off = wgid / 8; wgid = (xcd < r ? xcd * (q + 1) : r * (q + 1) + (xcd - r) * q) + off; }
        const int nig = 8 * nN, gid = wgid / nig, fm = gid * 8, gsz = (nM - fm) < 8 ? (nM - fm) : 8;
        u.pm = fm + ((wgid % nig) % gsz); u.pn = (wgid % nig) / gsz; u.aux = 0; return true;
    }
    DI const char* a_ptr(const Unit& u) const { return A + (size_t)u.pm * BM * lda * 2 + (u.pn >= akoff_pn ? akoff_bytes : 0); }
    DI const char* b_ptr(const Unit& u) const { return B + (size_t)u.pn * BM * ldb * 2; }
};
struct GroupSched {
    static constexpr bool GATHER = false, FP8 = false;
    const char* A; const char* B; int K, lda, ldb, nMg, nN, nwg, G, c;
    DI void init(const void* A_, const void* B_, int K_, int lda_, int ldb_, int nMg_, int nN_, int G_, int c_) { A = (const char*)A_; B = (const char*)B_; K = K_; lda = lda_; ldb = ldb_; nMg = nMg_; nN = nN_; nwg = 32 * nMg * nN; G = G_; c = c_; }
    DI bool next(int i, Unit& u) const {
        const int L = i * G + c; if (L >= nwg) return false;
        const int per = nMg * nN, g = L / per, rem = L % per; u.pm = g * nMg + rem / nN; u.pn = rem % nN; u.aux = g; return true;
    }
    DI const char* a_ptr(const Unit& u) const { return A + (size_t)u.pm * BM * lda * 2; }
    DI const char* b_ptr(const Unit& u) const { return B + ((size_t)u.aux * nN + u.pn) * BM * ldb * 2; }
};
template <bool GATH>
struct MoeSched {
    static constexpr bool GATHER = GATH, FP8 = true;
    const char* A; const char* B; const int* tile_e; const int* rowtok; int K, lda, ldb, nN, NperE, nwg, G, c;
    DI void init(const void* A_, const void* B_, const int* te, const int* rt, int ntiles, int K_, int nN_, int G_, int c_) { A = (const char*)A_; B = (const char*)B_; tile_e = te; rowtok = rt; K = K_; lda = K_; ldb = K_; nN = nN_; NperE = nN_ * BM; nwg = ntiles * nN_; G = G_; c = c_; }
    DI bool next(int i, Unit& u) const {
        int L = i * G + c; if (L >= nwg) return false;
        if (G == 256 && (i + 1) * G <= nwg) { const int x = c & 7, sl = c >> 3, mt = G / nN / 8;
            L = i * G + (x * mt + sl / nN) * nN + (sl % nN); }
        u.pm = L / nN; u.pn = L % nN; u.aux = __builtin_amdgcn_readfirstlane(__hip_atomic_load(tile_e + u.pm, __ATOMIC_RELAXED, __HIP_MEMORY_SCOPE_AGENT)); return true;
    }
    DI const char* a_ptr(const Unit& u) const { return GATH ? A : A + (size_t)u.pm * BM * lda * 2; }
    DI unsigned a_rowoff(const Unit& u, int row) const { return (unsigned)__hip_atomic_load(rowtok + u.pm * BM + row, __ATOMIC_RELAXED, __HIP_MEMORY_SCOPE_AGENT) * (unsigned)(lda * 2); }
    DI const char* b_ptr(const Unit& u) const { return B + ((size_t)u.aux * NperE + (size_t)u.pn * BM) * ldb * 2; }
};

typedef f32x4 AccT[2][2][4][2];
struct EpiWin {
    static constexpr bool PERM = true;
    bf16_t* us5; bf16_t* prw; bf16_t* gates;
    DI static u32x4 pack8(const f32x4& v0, const f32x4& v1) { u32x4 w; w.x = cvt_pk_bf16(v0[0], v0[1]); w.y = cvt_pk_bf16(v0[2], v0[3]); w.z = cvt_pk_bf16(v1[0], v1[1]); w.w = cvt_pk_bf16(v1[2], v1[3]); return w; }
    DI void operator()(const AccT& acc, const Unit& u, int wr, int wc, int fr, int fq) const {
        if (u.pn < 2) {
#pragma unroll
            for (int ai = 0; ai < 2; ++ai)
#pragma unroll
                for (int m = 0; m < 4; ++m) { const int r = u.pm * BM + ai * HALF + wr * 64 + m * 16 + fr, b = r >> 12, sq = r & 4095, ch = sq / S5L, j = sq % S5L;
#pragma unroll
                    for (int bj = 0; bj < 2; ++bj) { const int c0 = u.pn * BM + bj * HALF + wc * 32 + 8 * fq, g = c0 >> 4, ci = c0 & 15;
                        *(u32x4*)(us5 + ((size_t)(g * S5ROWS + b * S5NC + ch) * LDU + j * 16 + ci)) = pack8(acc[ai][bj][m][0], acc[ai][bj][m][1]); } }
        } else if (u.pn < 9) {
#pragma unroll
            for (int ai = 0; ai < 2; ++ai)
#pragma unroll
                for (int m = 0; m < 4; ++m) { const int r = u.pm * BM + ai * HALF + wr * 64 + m * 16 + fr;
#pragma unroll
                    for (int bj = 0; bj < 2; ++bj) { const int c0 = u.pn * BM + bj * HALF + wc * 32 + 8 * fq;
                        *(u32x4*)(prw + (size_t)r * RWC + (c0 - 512)) = pack8(acc[ai][bj][m][0], acc[ai][bj][m][1]); } }
        } else {
#pragma unroll
            for (int ai = 0; ai < 2; ++ai)
#pragma unroll
                for (int m = 0; m < 4; ++m) { const int r = u.pm * BM + ai * HALF + wr * 64 + m * 16 + fr;
#pragma unroll
                    for (int bj = 0; bj < 2; ++bj) { const int c0 = u.pn * BM + bj * HALF + wc * 32 + 8 * fq;
                        const f32x4& v0 = acc[ai][bj][m][0]; const f32x4& v1 = acc[ai][bj][m][1];
                        const f32x2 a_ = pk_sigmoid(lo2(v0)), b_ = pk_sigmoid(hi2(v0)), c_ = pk_sigmoid(lo2(v1)), d_ = pk_sigmoid(hi2(v1));
                        u32x4 w; w.x = cvt_pk_bf16(a_.x, a_.y); w.y = cvt_pk_bf16(b_.x, b_.y); w.z = cvt_pk_bf16(c_.x, c_.y); w.w = cvt_pk_bf16(d_.x, d_.y);
                        *(u32x4*)(gates + (size_t)r * 2048 + (c0 - 2304)) = w; } }
        }
    }
};
struct EpiS5State {
    static constexpr bool PERM = false;
    float* sloc;
    DI void operator()(const AccT& acc, const Unit& u, int wr, int wc, int fr, int fq) const {
#pragma unroll
        for (int ai = 0; ai < 2; ++ai)
#pragma unroll
            for (int m = 0; m < 4; ++m) {
                const int r = u.pm * BM + ai * HALF + wr * 64 + m * 16 + fr;
#pragma unroll
                for (int n = 0; n < 2; ++n) *(f32x4*)(sloc + (size_t)r * 128 + wc * 32 + 16 * n + 4 * fq) = acc[ai][0][m][n];
            }
    }
};
struct EpiS5Out {
    static constexpr bool PERM = true;
    bf16_t* ys;
    DI void operator()(const AccT& acc, const Unit& u, int wr, int wc, int fr, int fq) const {
        const int g = u.aux;
#pragma unroll
        for (int ai = 0; ai < 2; ++ai)
#pragma unroll
            for (int m = 0; m < 4; ++m) {
                const int r = u.pm * BM + ai * HALF + wr * 64 + m * 16 + fr;
                const int rc = r - g * S5ROWS;
#pragma unroll
                for (int bj = 0; bj < 2; ++bj) {
                    const int c0 = u.pn * BM + bj * HALF + wc * 32 + 8 * fq;
                    const int t = c0 >> 4, co = c0 & 15;
                    const size_t tok = (size_t)rc * S5L + t;
                    f32x4 v0 = acc[ai][bj][m][0], v1 = acc[ai][bj][m][1];
                    { const f32x2 a_ = pk_gelu_tanh(lo2(v0)), b_ = pk_gelu_tanh(hi2(v0)), c_ = pk_gelu_tanh(lo2(v1)), d_ = pk_gelu_tanh(hi2(v1));
                      v0 = (f32x4){a_.x, a_.y, b_.x, b_.y}; v1 = (f32x4){c_.x, c_.y, d_.x, d_.y}; }
                    u32x4 w; w.x = cvt_pk_bf16(v0[0], v0[1]); w.y = cvt_pk_bf16(v0[2], v0[3]); w.z = cvt_pk_bf16(v1[0], v1[1]); w.w = cvt_pk_bf16(v1[2], v1[3]);
                    *(u32x4*)(ys + tok * 512 + g * 16 + co) = w;
                }
            }
    }
};
struct EpiLora {
    static constexpr bool PERM = true;
    bf16_t* lwag; const float* w0; const float* a0;
    DI void operator()(const AccT& acc, const Unit& u, int wr, int wc, int fr, int fq) const {
#pragma unroll
        for (int bj = 0; bj < 2; ++bj) {
            const int c0 = u.pn * BM + bj * HALF + wc * 32 + 8 * fq;
            f32x4 b0 = (f32x4){0.f, 0.f, 0.f, 0.f}, b1 = b0;
            if (c0 < 512) { b0 = *(const f32x4*)(w0 + c0); b1 = *(const f32x4*)(w0 + c0 + 4); } else if (c0 < 1024) { b0 = *(const f32x4*)(a0 + c0 - 512); b1 = *(const f32x4*)(a0 + c0 - 508); }
            const f32x2 bias[4] = {lo2(b0), hi2(b0), lo2(b1), hi2(b1)};
            const float osc = (c0 < 512) ? -0.6065306597f : 1.0f;
            if (c0 < 1024) {
#pragma unroll
                for (int ai = 0; ai < 2; ++ai)
#pragma unroll
                    for (int m = 0; m < 4; ++m) { const int r = u.pm * BM + ai * HALF + wr * 64 + m * 16 + fr; u32x4 w;
#pragma unroll
                        for (int jp = 0; jp < 4; ++jp) { const f32x4& a = acc[ai][bj][m][jp >> 1]; const f32x2 v = pk_sigmoid(((jp & 1) ? hi2(a) : lo2(a)) + bias[jp]) * osc; w[jp] = cvt_pk_bf16(v.x, v.y); }
                        *(u32x4*)(lwag + (size_t)r * 1536 + c0) = w; }
            } else {
#pragma unroll
                for (int ai = 0; ai < 2; ++ai)
#pragma unroll
                    for (int m = 0; m < 4; ++m) { const int r = u.pm * BM + ai * HALF + wr * 64 + m * 16 + fr; u32x4 w;
#pragma unroll
                        for (int jp = 0; jp < 4; ++jp) { const f32x4& a = acc[ai][bj][m][jp >> 1]; const f32x2 v = (jp & 1) ? hi2(a) : lo2(a); w[jp] = cvt_pk_bf16(v.x, v.y); }
                        *(u32x4*)(lwag + (size_t)r * 1536 + c0) = w; }
            }
        }
    }
};
struct EpiGlu {
    static constexpr bool PERM = true;
    bf16_t* mixed; const bf16_t* gates; const float* bglu;
    DI void operator()(const AccT& acc, const Unit& u, int wr, int wc, int fr, int fq) const {
        const int cw = wc * 32 + 8 * fq, j0 = u.pn * 128 + cw;
        const float* bp = bglu + u.pn * 256 + cw;
        const f32x4 ba0 = *(const f32x4*)bp, ba1 = *(const f32x4*)(bp + 4), bb0 = *(const f32x4*)(bp + 128), bb1 = *(const f32x4*)(bp + 132);
        const f32x2 ba[4] = {lo2(ba0), hi2(ba0), lo2(ba1), hi2(ba1)}, bb[4] = {lo2(bb0), hi2(bb0), lo2(bb1), hi2(bb1)};
        u32x4 gw[2][4];
#pragma unroll
        for (int ai = 0; ai < 2; ++ai)
#pragma unroll
            for (int m = 0; m < 4; ++m) gw[ai][m] = *(const u32x4*)(gates + (size_t)(u.pm * BM + ai * HALF + wr * 64 + m * 16 + fr) * 2048 + j0);
#pragma unroll
        for (int ai = 0; ai < 2; ++ai)
#pragma unroll
            for (int m = 0; m < 4; ++m) {
                const int r = u.pm * BM + ai * HALF + wr * 64 + m * 16 + fr;
                u32x4 w;
#pragma unroll
                for (int jp = 0; jp < 4; ++jp) {
                    const f32x4& aa = acc[ai][0][m][jp >> 1]; const f32x4& ab = acc[ai][1][m][jp >> 1];
                    const f32x2 za = ((jp & 1) ? hi2(aa) : lo2(aa)) + ba[jp], zb = ((jp & 1) ? hi2(ab) : lo2(ab)) + bb[jp];
                    const unsigned gwd = gw[ai][m][jp]; const f32x2 gt = {bf_lo(gwd), bf_hi(gwd)};
                    const f32x2 o = (gt * za) * pk_sigmoid(zb);
                    w[jp] = cvt_pk_bf16(o.x, o.y);
                }
                *(u32x4*)(mixed + (size_t)r * 1024 + j0) = w;
            }
    }
};
struct EpiWo {
    static constexpr bool PERM = true;
    bf16_t* mixed; const bf16_t* gates;
    DI void operator()(const AccT& acc, const Unit& u, int wr, int wc, int fr, int fq) const {
#pragma unroll
        for (int ai = 0; ai < 2; ++ai) {
            u32x4 gw[4][2], mw[4][2];
#pragma unroll
            for (int m = 0; m < 4; ++m)
#pragma unroll
                for (int bj = 0; bj < 2; ++bj) { const size_t r = (size_t)(u.pm * BM + ai * HALF + wr * 64 + m * 16 + fr); const int c0 = u.pn * BM + bj * HALF + wc * 32 + 8 * fq;
                    gw[m][bj] = *(const u32x4*)(gates + r * 2048 + 1024 + c0); mw[m][bj] = *(const u32x4*)(mixed + r * 1024 + c0); }
#pragma unroll
            for (int m = 0; m < 4; ++m)
#pragma unroll
                for (int bj = 0; bj < 2; ++bj) { const size_t r = (size_t)(u.pm * BM + ai * HALF + wr * 64 + m * 16 + fr); const int c0 = u.pn * BM + bj * HALF + wc * 32 + 8 * fq;
                    u32x4 w;
#pragma unroll
                    for (int jp = 0; jp < 4; ++jp) { const unsigned gwd = gw[m][bj][jp], mwd = mw[m][bj][jp]; const f32x4& a = acc[ai][bj][m][jp >> 1];
                        const f32x2 o = (f32x2){bf_lo(mwd), bf_hi(mwd)} + (f32x2){bf_lo(gwd), bf_hi(gwd)} * ((jp & 1) ? hi2(a) : lo2(a));
                        w[jp] = cvt_pk_bf16(o.x, o.y); }
                    *(u32x4*)(mixed + r * 1024 + c0) = w; }
        }
    }
};
struct EpiOut {
    static constexpr bool PERM = true;
    bf16_t* hb; const float* x;
    DI void operator()(const AccT& acc, const Unit& u, int wr, int wc, int fr, int fq) const {
#pragma unroll
        for (int ai = 0; ai < 2; ++ai) {
            f32x4 xv[4][2][2];
#pragma unroll
            for (int m = 0; m < 4; ++m) { const size_t r = (size_t)(u.pm * BM + ai * HALF + wr * 64 + m * 16 + fr);
#pragma unroll
                for (int bj = 0; bj < 2; ++bj) { const float* xp = x + r * 1024 + u.pn * BM + bj * HALF + wc * 32 + 8 * fq; xv[m][bj][0] = *(const f32x4*)xp; xv[m][bj][1] = *(const f32x4*)(xp + 4); } }
#pragma unroll
            for (int m = 0; m < 4; ++m) { const size_t r = (size_t)(u.pm * BM + ai * HALF + wr * 64 + m * 16 + fr);
#pragma unroll
                for (int bj = 0; bj < 2; ++bj) { const f32x4 v0 = xv[m][bj][0] + acc[ai][bj][m][0], v1 = xv[m][bj][1] + acc[ai][bj][m][1];
                    u32x4 w; w.x = cvt_pk_bf16(v0[0], v0[1]); w.y = cvt_pk_bf16(v0[2], v0[3]); w.z = cvt_pk_bf16(v1[0], v1[1]); w.w = cvt_pk_bf16(v1[2], v1[3]);
                    *(u32x4*)(hb + r * 1024 + u.pn * BM + bj * HALF + wc * 32 + 8 * fq) = w; } }
        }
    }
};
struct EpiRouter {
    static constexpr bool PERM = false;
    float* logits;
    DI void operator()(const AccT& acc, const Unit& u, int wr, int wc, int fr, int fq) const {
        if (wc != 0) return;
#pragma unroll
        for (int n = 0; n < 2; ++n) {
            const int c = 16 * n + 4 * fq;
#pragma unroll
            for (int ai = 0; ai < 2; ++ai)
#pragma unroll
                for (int m = 0; m < 4; ++m) {
                    const size_t r = (size_t)(u.pm * BM + ai * HALF + wr * 64 + m * 16 + fr);
                    *(f32x4*)(logits + r * 32 + c) = acc[ai][0][m][n];
                }
        }
    }
};
struct EpiMoe1 {
    static constexpr bool PERM = true;
    unsigned char* act; const float* b1p;
    DI void operator()(const AccT& acc, const Unit& u, int wr, int wc, int fr, int fq) const {
        const int cw = wc * 32 + 8 * fq, j0 = u.pn * 128 + cw;
        const float* bp = b1p + (size_t)u.aux * 2048 + u.pn * 256 + cw;
        const f32x4 ba0 = *(const f32x4*)bp, ba1 = *(const f32x4*)(bp + 4), bb0 = *(const f32x4*)(bp + 128), bb1 = *(const f32x4*)(bp + 132);
        const f32x2 ba[4] = {lo2(ba0), hi2(ba0), lo2(ba1), hi2(ba1)}, bb[4] = {lo2(bb0), hi2(bb0), lo2(bb1), hi2(bb1)};
        constexpr float sc = 1.0f / (F8_SX * F8_SW);
#pragma unroll
        for (int ai = 0; ai < 2; ++ai)
#pragma unroll
            for (int m = 0; m < 4; ++m) {
                const size_t r = (size_t)(u.pm * BM + ai * HALF + wr * 64 + m * 16 + fr);
                f32x2 o[4];
#pragma unroll
                for (int jp = 0; jp < 4; ++jp) {
                    const f32x4& ag = acc[ai][0][m][jp >> 1]; const f32x4& al_ = acc[ai][1][m][jp >> 1];
                    const f32x2 g = ((jp & 1) ? hi2(ag) : lo2(ag)) * sc + ba[jp], l = ((jp & 1) ? hi2(al_) : lo2(al_)) * sc + bb[jp];
                    const f32x2 xg = __builtin_elementwise_min(g, (f32x2){7.0f, 7.0f});
                    const f32x2 xl = __builtin_elementwise_min(__builtin_elementwise_max(l, (f32x2){-7.0f, -7.0f}), (f32x2){7.0f, 7.0f});
                    o[jp] = (xg * pk_sigmoid_scaled(xg, -1.702f * 1.44269504f)) * (xl * F8_SA + F8_SA);
                }
                u32x2 w; w.x = pk4_fp8_nc(o[0], o[1]); w.y = pk4_fp8_nc(o[2], o[3]);
                *(u32x2*)(act + r * 1024 + j0) = w;
            }
    }
};
struct EpiMoe2 {
    static constexpr bool PERM = true;
    unsigned char* y2; const float* b2; const float* rowg;
    DI void operator()(const AccT& acc, const Unit& u, int wr, int wc, int fr, int fq) const {
        float gt[2][4];
#pragma unroll
        for (int ai = 0; ai < 2; ++ai)
#pragma unroll
            for (int m = 0; m < 4; ++m) gt[ai][m] = rowg[(size_t)(u.pm * BM + ai * HALF + wr * 64 + m * 16 + fr)] * F8_SY;
#pragma unroll
        for (int bj = 0; bj < 2; ++bj) {
            const int c0 = u.pn * BM + bj * HALF + wc * 32 + 8 * fq;
            const f32x4 bva = *(const f32x4*)(b2 + (size_t)u.aux * 1024 + c0), bvb = *(const f32x4*)(b2 + (size_t)u.aux * 1024 + c0 + 4);
            const f32x2 bv[4] = {lo2(bva), hi2(bva), lo2(bvb), hi2(bvb)};
#pragma unroll
            for (int ai = 0; ai < 2; ++ai)
#pragma unroll
                for (int m = 0; m < 4; ++m) {
                    const size_t r = (size_t)(u.pm * BM + ai * HALF + wr * 64 + m * 16 + fr);
                    const float g = gt[ai][m];
                    f32x2 o[4];
#pragma unroll
                    for (int jp = 0; jp < 4; ++jp) { const f32x4& a = acc[ai][bj][m][jp >> 1];
                        o[jp] = (((jp & 1) ? hi2(a) : lo2(a)) * (1.0f / (F8_SA * F8_SW)) + bv[jp]) * g;
                        o[jp] = __builtin_elementwise_min(__builtin_elementwise_max(o[jp], (f32x2){-448.f, -448.f}), (f32x2){448.f, 448.f}); }
                    u32x2 w; w.x = pk4_fp8_nc(o[0], o[1]); w.y = pk4_fp8_nc(o[2], o[3]);
                    *(u32x2*)(y2 + r * 1024 + c0) = w;
                }
        }
    }
};
struct KArgs { const float* in[34]; float* out; unsigned char* ws; int ph_lo, ph_hi; };
struct Frame {
    LAS unsigned char* lds; int tid, lane, wave, G, bid;
    const float* const* in; float* out; unsigned char* ws;
};

template <class MP>
DI void conv_T(const Frame& F, const float* src, size_t src_bstride, int ld, bf16_t* dst, int N, int K, int nbatch, MP mp, int t0 = 0, int t1 = 0x7fffffff) {
    LAS unsigned* tile = (LAS unsigned*)F.lds;
    const int ntk = K / 64, ntn = N / 256, per = ntk * ntn;
    const int tend = (per * nbatch) < t1 ? (per * nbatch) : t1;
    for (int t = t0 + F.bid; t < tend; t += F.G) {
        const int bt = t / per, tt = t % per, tk = tt % ntk, pn = tt / ntk;
        const float* s = src + (size_t)bt * src_bstride + (size_t)(tk * 64) * ld + mp.src(pn, F.lane);
        f32x4 va[4], vb[4];
#pragma unroll
        for (int i = 0; i < 4; ++i) { const int kp = F.wave + 8 * i; va[i] = *(const f32x4*)(s + (size_t)(2 * kp) * ld); vb[i] = *(const f32x4*)(s + (size_t)(2 * kp + 1) * ld); }
#pragma unroll
        for (int i = 0; i < 4; ++i) { const int kp = F.wave + 8 * i;
#pragma unroll
            for (int j = 0; j < 4; ++j) tile[mp.dst(F.lane, j) * 33 + kp] = cvt_pk_bf16(va[i][j], vb[i][j]); }
        __syncthreads();
        unsigned* d = (unsigned*)(dst + (size_t)bt * N * K + (size_t)(pn * 256) * K + tk * 64);
#pragma unroll
        for (int i = 0; i < 4; ++i) { const int pc = F.tid + NTHR * i, nn = pc >> 3, seg = pc & 7;
            u32x4 w; w.x = tile[nn * 33 + seg * 4]; w.y = tile[nn * 33 + seg * 4 + 1]; w.z = tile[nn * 33 + seg * 4 + 2]; w.w = tile[nn * 33 + seg * 4 + 3];
            *(u32x4*)(d + ((size_t)nn * K) / 2 + seg * 4) = w; }
        __syncthreads();
    }
}
template <class MP>
DI void conv_T8(const Frame& F, const float* src, size_t src_bstride, int ld, unsigned char* dst, int N, int K, int nbatch, MP mp, float scale, int t0 = 0, int t1 = 0x7fffffff) {
    LAS unsigned* tile = (LAS unsigned*)F.lds;
    const int ntk = K / 64, ntn = N / 256, per = ntk * ntn;
    const int tend = (per * nbatch) < t1 ? (per * nbatch) : t1;
    for (int t = t0 + F.bid; t < tend; t += F.G) {
        const int bt = t / per, tt = t % per, tk = tt % ntk, pn = tt / ntk;
        const float* s = src + (size_t)bt * src_bstride + (size_t)(tk * 64) * ld + mp.src(pn, F.lane);
        f32x4 v[2][4];
#pragma unroll
        for (int i = 0; i < 2; ++i) { const int kq = F.wave + 8 * i;
#pragma unroll
            for (int e = 0; e < 4; ++e) v[i][e] = *(const f32x4*)(s + (size_t)(4 * kq + e) * ld); }
#pragma unroll
        for (int i = 0; i < 2; ++i) { const int kq = F.wave + 8 * i;
#pragma unroll
            for (int j = 0; j < 4; ++j) tile[mp.dst(F.lane, j) * 17 + kq] = pk4_fp8(v[i][0][j] * scale, v[i][1][j] * scale, v[i][2][j] * scale, v[i][3][j] * scale); }
        __syncthreads();
        unsigned char* d = dst + ((size_t)bt * N + (size_t)pn * 256) * K + tk * 64;
#pragma unroll
        for (int i = 0; i < 2; ++i) { const int pc = F.tid + NTHR * i, nn = pc >> 2, seg = pc & 3;
            u32x4 w; w.x = tile[nn * 17 + seg * 4]; w.y = tile[nn * 17 + seg * 4 + 1]; w.z = tile[nn * 17 + seg * 4 + 2]; w.w = tile[nn * 17 + seg * 4 + 3];
            *(u32x4*)(d + (size_t)nn * K + seg * 16) = w; }
        __syncthreads();
    }
}
struct MpId  { DI int src(int pn, int f) const { return pn * 256 + 4 * f; } DI int dst(int f, int j) const { return 4 * f + j; } };
struct MpSwi { DI int src(int pn, int f) const { return pn * 256 + 4 * f; } DI int dst(int f, int j) const { const int n = 4 * f + j; return (n >> 1) + 128 * (n & 1); } };
struct MpGlu { DI int src(int pn, int f) const { const int w = 4 * f; return pn * 128 + (w & 127) + 1024 * (w >> 7); } DI int dst(int f, int j) const { return 4 * f + j; } };
struct CmGlu { DI int operator()(int n) const { const int pn = n >> 8, w = n & 255; return pn * 128 + (w & 127) + 1024 * (w >> 7); } };
struct CmSwi { DI int operator()(int n) const { const int pn = n >> 8, w = n & 255; return 2 * (pn * 128 + (w & 127)) + (w >> 7); } };

DI void rmsnorm_rows(const Frame& F, const float* x, const float* g, bf16_t* out, int row0, int nrows, unsigned char* out8 = nullptr) {
    const int stride = F.G * NWAVES;
    for (int row = row0 + F.bid * NWAVES + F.wave; row < row0 + nrows; row += 2 * stride) {
        const int row2 = (row + stride < row0 + nrows) ? row + stride : row;
        const f32x4* xr = (const f32x4*)(x + (size_t)row * D); const f32x4* xr2 = (const f32x4*)(x + (size_t)row2 * D);
        f32x4 v[4], u[4]; float ss = 0.f, su = 0.f;
#pragma unroll
        for (int i = 0; i < 4; ++i) { v[i] = xr[i * 64 + F.lane]; u[i] = xr2[i * 64 + F.lane]; }
#pragma unroll
        for (int i = 0; i < 4; ++i) { ss += v[i][0] * v[i][0] + v[i][1] * v[i][1] + v[i][2] * v[i][2] + v[i][3] * v[i][3]; su += u[i][0] * u[i][0] + u[i][1] * u[i][1] + u[i][2] * u[i][2] + u[i][3] * u[i][3]; }
        ss = wave_sum(ss); su = wave_sum(su);
        const float rs = rsqrtf(ss * (1.0f / D) + 1e-5f), ru = rsqrtf(su * (1.0f / D) + 1e-5f);
#pragma unroll
        for (int i = 0; i < 4; ++i) { const f32x4 gv = ((const f32x4*)g)[i * 64 + F.lane];
            u32x2 w; w.x = cvt_pk_bf16(v[i][0] * rs * gv[0], v[i][1] * rs * gv[1]); w.y = cvt_pk_bf16(v[i][2] * rs * gv[2], v[i][3] * rs * gv[3]);
            *(u32x2*)(out + (size_t)row * D + (i * 64 + F.lane) * 4) = w;
            u32x2 w2; w2.x = cvt_pk_bf16(u[i][0] * ru * gv[0], u[i][1] * ru * gv[1]); w2.y = cvt_pk_bf16(u[i][2] * ru * gv[2], u[i][3] * ru * gv[3]);
            *(u32x2*)(out + (size_t)row2 * D + (i * 64 + F.lane) * 4) = w2;
            if (out8) { *(unsigned*)(out8 + (size_t)row * D + (i * 64 + F.lane) * 4) = pk4_fp8(v[i][0] * rs * gv[0] * F8_SX, v[i][1] * rs * gv[1] * F8_SX, v[i][2] * rs * gv[2] * F8_SX, v[i][3] * rs * gv[3] * F8_SX);
                *(unsigned*)(out8 + (size_t)row2 * D + (i * 64 + F.lane) * 4) = pk4_fp8(u[i][0] * ru * gv[0] * F8_SX, u[i][1] * ru * gv[1] * F8_SX, u[i][2] * ru * gv[2] * F8_SX, u[i][3] * ru * gv[3] * F8_SX); } }
    }
}

DI void p0_prologue(const Frame& F) {
    unsigned char* ws = F.ws;
    conv_T(F, F.in[2], 0, INC, (bf16_t*)(ws + WS_WIN), INC, D, 1, MpId());
    conv_T(F, F.in[11], 0, 2048, (bf16_t*)(ws + WS_WGLU), 2048, 512, 1, MpGlu());
    conv_T(F, F.in[24], 0, 1024, (bf16_t*)(ws + WS_WO), 1024, 512, 1, MpId());
    conv_T(F, F.in[25], 0, 1024, (bf16_t*)(ws + WS_WOUT), 1024, 1024, 1, MpId());
    {
        bf16_t* wl = (bf16_t*)(ws + WS_WLORA); const float* w2 = F.in[15]; const float* a2 = F.in[17]; const float* g2 = F.in[18];
        for (int idx = F.bid * NTHR + F.tid; idx < 1536 * 128; idx += F.G * NTHR) { const int n = idx >> 7, k = idx & 127; float v = 0.f;
            if (n < 512) { if (k < 64) v = w2[k * 512 + n]; } else if (n < 1024) { if (k >= 64) v = a2[(k - 64) * 512 + (n - 512)]; } else { v = g2[k * 512 + (n - 1024)]; }
            wl[idx] = f2bf(v); }
        bf16_t* wrt = (bf16_t*)(ws + WS_WR); const float* rw = F.in[27];
        for (int idx = F.bid * NTHR + F.tid; idx < 256 * 1024; idx += F.G * NTHR) { const int n = idx >> 10, k = idx & 1023; wrt[idx] = f2bf(n < 32 ? rw[k * 32 + n] * F.in[26][k] : 0.f); }
        float* bg = (float*)(ws + WS_BGLU); const float* bsrc = F.in[12]; CmGlu cm;
        for (int idx = F.bid * NTHR + F.tid; idx < 2048; idx += F.G * NTHR) bg[idx] = bsrc[cm(idx)];
    }
    if (F.bid & 1) rmsnorm_rows(F, F.in[0], F.in[1], (bf16_t*)(ws + WS_XN), 0, T);
    {
        LAS float* L = (LAS float*)F.lds;
        LAS float* pwr = L, *pwi = L + 64, *p1r = L + 128, *p1i = L + 192, *ffr = L + 256, *ffi = L + 320;
        LAS float* bbr = L + 384, *bbi = bbr + 1024, *ccr = bbi + 1024, *cci = ccr + 1024, *kj = cci + 1024;
        const float* lam_re = F.in[3]; const float* lam_im = F.in[4]; const float* log_dt = F.in[5];
        const float* b_re = F.in[6]; const float* b_im = F.in[7]; const float* c_re = F.in[8]; const float* c_im = F.in[9]; const float* dsk = F.in[10];
        unsigned* toep = (unsigned*)(ws + WS_TOEP); unsigned* wst = (unsigned*)(ws + WS_WST);
        for (int it = F.bid; it < 32 * S5L; it += F.G) {
            const int g = it / S5L, j = it % S5L;
            if (F.tid < 64) { const int p = F.tid; const float lr = lam_re[g * 64 + p], li = lam_im[g * 64 + p], dt = __expf(log_dt[g]);
                float sn, cs; { const float mg = expf((float)j * lr * dt); sincosf((float)j * (li * dt), &sn, &cs); pwr[p] = mg * cs; pwi[p] = mg * sn; }
                { const float mg = expf((float)(j + 1) * lr * dt); sincosf((float)(j + 1) * (li * dt), &sn, &cs); p1r[p] = mg * cs; p1i[p] = mg * sn; }
                { const float mg = expf(lr * dt); sincosf(li * dt, &sn, &cs); const float nr = mg * cs - 1.0f, ni = mg * sn, den = lr * lr + li * li;
                  ffr[p] = (nr * lr + ni * li) / den; ffi[p] = (ni * lr - nr * li) / den; } }
            __syncthreads();
            for (int idx = F.tid; idx < 1024; idx += NTHR) { const int p = idx >> 4; const float br = b_re[g * 1024 + idx], bi = b_im[g * 1024 + idx];
                bbr[idx] = ffr[p] * br - ffi[p] * bi; bbi[idx] = ffr[p] * bi + ffi[p] * br;
                ccr[idx] = c_re[g * 1024 + idx]; cci[idx] = c_im[g * 1024 + idx]; }
            __syncthreads();
            if (F.tid < 256) { const int co = F.tid >> 4, ci = F.tid & 15; float s = 0.f;
                for (int p = 0; p < 64; ++p) { const float zr = pwr[p] * bbr[p * 16 + ci] - pwi[p] * bbi[p * 16 + ci], zi = pwr[p] * bbi[p * 16 + ci] + pwi[p] * bbr[p * 16 + ci];
                    s += ccr[co * 64 + p] * zr - cci[co * 64 + p] * zi; }
                if (j == 0 && co == ci) s += dsk[g * 16 + co];
                kj[F.tid] = s; }
            __syncthreads();
            for (int idx = F.tid; idx < (S5L - j) * 128; idx += NTHR) { const int t = j + idx / 128, rem = idx % 128, co = rem >> 3, ci = (rem & 7) * 2;
                toep[((size_t)(g * 512 + t * 16 + co) * LDU + (t - j) * 16 + ci) / 2] = cvt_pk_bf16(kj[co * 16 + ci], kj[co * 16 + ci + 1]);
                if (j > 0) toep[((size_t)(g * 512 + (t - j) * 16 + co) * LDU + t * 16 + ci) / 2] = 0u; }
            for (int idx = F.tid; idx < 16 * 64; idx += NTHR) { const int co = idx >> 6, q = (idx & 63) * 2; float o[2];
#pragma unroll
                for (int e = 0; e < 2; ++e) { const int qq = q + e, p = qq & 63; const float cr = ccr[co * 64 + p], cim = cci[co * 64 + p];
                    o[e] = (qq < 64) ? (cr * p1r[p] - cim * p1i[p]) : -(cr * p1i[p] + cim * p1r[p]); }
                toep[((size_t)(g * 512 + j * 16 + co) * LDU + 512 + q) / 2] = cvt_pk_bf16(o[0], o[1]); }
            { const int s = S5L - 1 - j;
              for (int idx = F.tid; idx < 256 * 8; idx += NTHR) { const int q = idx >> 3, ci = (idx & 7) * 2; float o[2] = {0.f, 0.f};
                if (q < 128) { const int p = q & 63;
#pragma unroll
                    for (int e = 0; e < 2; ++e) { const float br = bbr[p * 16 + ci + e], bi = bbi[p * 16 + ci + e];
                        o[e] = (q < 64) ? (pwr[p] * br - pwi[p] * bi) : (pwr[p] * bi + pwi[p] * br); } }
                wst[((size_t)(g * 256 + q) * 512 + s * 16 + ci) / 2] = cvt_pk_bf16(o[0], o[1]); } }
            __syncthreads();
        }
    }
    if (!(F.bid & 1)) rmsnorm_rows(F, F.in[0], F.in[1], (bf16_t*)(ws + WS_XN), 0, T);
}

DI void p_rw_prep(const Frame& F) {
    const bf16_t* prw = (const bf16_t*)(F.ws + WS_PRW); bf16_t* al_ = (bf16_t*)(F.ws + WS_ALORA); const float* mu = F.in[13];
    for (int idx = F.bid * NTHR + F.tid; idx < T * 32; idx += F.G * NTHR) {
        const int t = idx >> 5, c8 = (idx & 31) * 8;
        const u32x4 cur = *(const u32x4*)(prw + (size_t)t * RWC + 1536 + c8);
        u32x4 prv = (u32x4){0u, 0u, 0u, 0u};
        if ((t & (SEQ - 1)) != 0) prv = *(const u32x4*)(prw + (size_t)(t - 1) * RWC + 1536 + c8);
        float o[8];
#pragma unroll
        for (int j = 0; j < 8; ++j) { const float c = (j & 1) ? bf_hi(cur[j >> 1]) : bf_lo(cur[j >> 1]), p = (j & 1) ? bf_hi(prv[j >> 1]) : bf_lo(prv[j >> 1]);
            const float xs = c + mu[1536 + c8 + j] * (p - c);
            o[j] = (c8 < 64) ? ftanh(xs) : ((c8 < 128) ? xs : fsigmoid(xs)); }
        u32x4 w; w.x = cvt_pk_bf16(o[0], o[1]); w.y = cvt_pk_bf16(o[2], o[3]); w.z = cvt_pk_bf16(o[4], o[5]); w.w = cvt_pk_bf16(o[6], o[7]);
        *(u32x4*)(al_ + (size_t)t * 256 + c8) = w;
    }
}

DI void p_s5_carry(const Frame& F) {
    const float* lam_re = F.in[3]; const float* lam_im = F.in[4]; const float* log_dt = F.in[5];
    const float* sloc = (const float*)(F.ws + WS_SLOC); bf16_t* us5 = (bf16_t*)(F.ws + WS_US5);
    for (int gt = F.bid * NTHR + F.tid; gt < NB * 32 * 64; gt += F.G * NTHR) {
        const int p = gt & 63, g = (gt >> 6) & 31, b = gt >> 11;
        const float lr = lam_re[g * 64 + p], li = lam_im[g * 64 + p], dt = __expf(log_dt[g]);
        float sn, cs; const float mg = expf((float)S5L * lr * dt); sincosf((float)S5L * (li * dt), &sn, &cs);
        const float ar = mg * cs, ai = mg * sn;
        float xr = 0.f, xi = 0.f;
        const size_t row0 = (size_t)g * S5ROWS + (size_t)b * S5NC;
        for (int cb = 0; cb < S5NC; cb += 16) {
            float sr[16], si[16];
#pragma unroll
            for (int j = 0; j < 16; ++j) { sr[j] = sloc[(row0 + cb + j) * 128 + p]; si[j] = sloc[(row0 + cb + j) * 128 + 64 + p]; }
#pragma unroll
            for (int j = 0; j < 16; ++j) { const size_t row = row0 + cb + j;
                us5[row * LDU + 512 + p] = f2bf(xr); us5[row * LDU + 576 + p] = f2bf(xi);
                const float nr = ar * xr - ai * xi + sr[j], ni = ar * xi + ai * xr + si[j];
                xr = nr; xi = ni; }
        }
    }
}

constexpr int PT = 72, SLOTB = 64 * PT * 2;
DI LAS bf16_t* rslot(LAS unsigned char* lds, int i) { return (LAS bf16_t*)(lds + i * SLOTB); }
DI void mm_acc(f32x4 (&acc)[2], const LAS bf16_t* A, const LAS bf16_t* Bt, int ti, int tj0, int r, int q) {
#pragma unroll
    for (int s2 = 0; s2 < 2; ++s2) {
        const bf16x8 a = *(const LAS bf16x8*)(A + (16 * ti + r) * PT + 32 * s2 + 8 * q);
#pragma unroll
        for (int e = 0; e < 2; ++e) { const bf16x8 b = *(const LAS bf16x8*)(Bt + (16 * (tj0 + e) + r) * PT + 32 * s2 + 8 * q);
            acc[e] = __builtin_amdgcn_mfma_f32_16x16x32_bf16(a, b, acc[e], 0, 0, 0); }
    }
}
DI void mm_acc_bnat(f32x4 (&acc)[2], const LAS bf16_t* A, const LAS bf16_t* Bn, int ti, int tj0, int r, int q) {
#pragma unroll
    for (int s2 = 0; s2 < 2; ++s2) {
        const bf16x8 a = *(const LAS bf16x8*)(A + (16 * ti + r) * PT + 32 * s2 + 8 * q);
#pragma unroll
        for (int e = 0; e < 2; ++e) { bf16x8 b;
#pragma unroll
            for (int jj = 0; jj < 8; ++jj) b[jj] = (short)Bn[(32 * s2 + 8 * q + jj) * PT + 16 * (tj0 + e) + r];
            acc[e] = __builtin_amdgcn_mfma_f32_16x16x32_bf16(a, b, acc[e], 0, 0, 0); }
    }
}
DI void st_rm(LAS bf16_t* Dm, const f32x4& v, int i0, int j) {
#pragma unroll
    for (int g = 0; g < 4; ++g) Dm[(i0 + g) * PT + j] = f2bf(v[g]);
}
DI void st_tr(LAS bf16_t* Dm, const f32x4& v, int i0, int j) { u32x2 w; w.x = cvt_pk_bf16(v[0], v[1]); w.y = cvt_pk_bf16(v[2], v[3]); *(LAS u32x2*)(Dm + j * PT + i0) = w; }
DI f32x4 ld_rm(const LAS bf16_t* Sm, int i0, int j) { f32x4 v;
#pragma unroll
    for (int g = 0; g < 4; ++g) v[g] = bf2f(Sm[(i0 + g) * PT + j]);
    return v; }
DI void ld_frag(bf16x8 (&f)[2], const LAS bf16_t* M, int row, int q) { f[0] = *(const LAS bf16x8*)(M + row * PT + 8 * q); f[1] = *(const LAS bf16x8*)(M + row * PT + 32 + 8 * q); }
DI f32x4 mm2(const bf16x8 (&x)[2], const bf16x8 (&y)[2], f32x4 c) { c = __builtin_amdgcn_mfma_f32_16x16x32_bf16(x[0], y[0], c, 0, 0, 0); return __builtin_amdgcn_mfma_f32_16x16x32_bf16(x[1], y[1], c, 0, 0, 0); }
DI void st_sw(LAS bf16_t* Dm, const f32x4& v, int i, int j0) { u32x2 w; w.x = cvt_pk_bf16(v[0], v[1]); w.y = cvt_pk_bf16(v[2], v[3]); *(LAS u32x2*)(Dm + i * PT + j0) = w; }
DI f32x4 ld_sw(const LAS bf16_t* Sm, int i, int j0) { const u32x2 w = *(const LAS u32x2*)(Sm + i * PT + j0); return (f32x4){bf_lo(w.x), bf_hi(w.x), bf_lo(w.y), bf_hi(w.y)}; }
#define ZACC(a) do { a[0] = (f32x4){0.f, 0.f, 0.f, 0.f}; a[1] = (f32x4){0.f, 0.f, 0.f, 0.f}; } while (0)

DI float wave_sum2(float v) { return xrow_sum(row_sum16(v)); }
#define LSYNC() do { asm volatile("s_waitcnt lgkmcnt(0)" ::: "memory"); __builtin_amdgcn_s_barrier(); asm volatile("" ::: "memory"); } while (0)

struct RaRaw { bf16_t r[9], k[9], v[9], lw[8], a[8]; };
DI void ra_load(RaRaw& x, const bf16_t* prw, const bf16_t* lwag, int ci, int w, int lane) {
    const int bh = ci >> 6, c = ci & 63, b = bh >> 3, h = bh & 7, ch = h * 64 + lane;
    const size_t tok0 = (size_t)b * SEQ + c * 64 + 8 * w;
    const bool has_prev = !(c == 0 && w == 0);
    const size_t tp = has_prev ? tok0 - 1 : tok0;
    x.r[0] = prw[tp * RWC + ch]; x.k[0] = prw[tp * RWC + 512 + ch]; x.v[0] = prw[tp * RWC + 1024 + ch];
#pragma unroll
    for (int i = 0; i < 8; ++i) { const size_t tok = tok0 + i;
        x.r[i + 1] = prw[tok * RWC + ch]; x.k[i + 1] = prw[tok * RWC + 512 + ch]; x.v[i + 1] = prw[tok * RWC + 1024 + ch];
        x.lw[i] = lwag[tok * 1536 + ch]; x.a[i] = lwag[tok * 1536 + 512 + ch]; }
}
DI void p_rw_chunk(const Frame& F) {
    const bf16_t* prw = (const bf16_t*)(F.ws + WS_PRW); const bf16_t* lwag = (const bf16_t*)(F.ws + WS_LWAG);
    const float* mu = F.in[13]; const float* k_k = F.in[19]; const float* k_a = F.in[20]; const float* r_k = F.in[21];
    float* bonus = (float*)(F.ws + WS_BONUS);
    bf16_t* gM = (bf16_t*)(F.ws + WS_CHK_M); bf16_t* gN0T = (bf16_t*)(F.ws + WS_CHK_N0T); bf16_t* gQ = (bf16_t*)(F.ws + WS_CHK_Q); bf16_t* gY0 = (bf16_t*)(F.ws + WS_CHK_Y0T);
    LAS unsigned char* lds = F.lds;
    LAS float* segtot = (LAS float*)(lds + 14 * SLOTB);
    LAS float* PLs = segtot + 512;
    LAS float* DB = PLs + 64;
    constexpr int PD = 20;
    constexpr int TP = 24;
    LAS bf16_t* TDT = (LAS bf16_t*)(DB + 64 * PD);
    const int w = F.wave, lane = F.lane, r = lane & 15, q = lane >> 4, ti = w >> 1, tj0 = 2 * (w & 1), i0 = 16 * ti + 4 * q;
    LAS bf16_t* S0 = rslot(lds, 0); LAS bf16_t* S1 = rslot(lds, 1); LAS bf16_t* S2 = rslot(lds, 2); LAS bf16_t* S3 = rslot(lds, 3);
    LAS bf16_t* S4 = rslot(lds, 4); LAS bf16_t* S5 = rslot(lds, 5); LAS bf16_t* S6 = rslot(lds, 6); LAS bf16_t* S7 = rslot(lds, 7);
    LAS bf16_t* S8 = rslot(lds, 8); LAS bf16_t* S9 = rslot(lds, 9); LAS bf16_t* S10 = rslot(lds, 10); LAS bf16_t* S11 = rslot(lds, 11);
    LAS bf16_t* S12 = rslot(lds, 12); LAS bf16_t* S13 = rslot(lds, 13);
    RaRaw raw;
    if (F.bid < RW_NCH) ra_load(raw, prw, lwag, F.bid, w, lane);
    for (int ci = F.bid; ci < RW_NCH; ci += F.G) {
        const int bh = ci >> 6, c = ci & 63, b = bh >> 3, h = bh & 7, ch = h * 64 + lane;
        {
            const size_t tok0 = (size_t)b * SEQ + c * 64 + 8 * w;
            const float mur = mu[ch], muk = mu[512 + ch], muv = mu[1024 + ch], kkw = k_k[ch], ka = k_a[ch], rk = r_k[ch];
            const bool has_prev = !(c == 0 && w == 0);
            float xr[9], xk[9], xv[9];
            xr[0] = has_prev ? bf2f(raw.r[0]) : 0.f; xk[0] = has_prev ? bf2f(raw.k[0]) : 0.f; xv[0] = has_prev ? bf2f(raw.v[0]) : 0.f;
#pragma unroll
            for (int i = 1; i < 9; ++i) { xr[i] = bf2f(raw.r[i]); xk[i] = bf2f(raw.k[i]); xv[i] = bf2f(raw.v[i]); }
            f32x2 rr2[4], vv2[4], aa2[4], km2[4], kn2[4]; float cl[8];
            float run = 0.f;
#pragma unroll
            for (int p2 = 0; p2 < 4; ++p2) {
                const f32x2 cr = {xr[2 * p2 + 1], xr[2 * p2 + 2]}, pr = {xr[2 * p2], xr[2 * p2 + 1]};
                const f32x2 ck = {xk[2 * p2 + 1], xk[2 * p2 + 2]}, pk = {xk[2 * p2], xk[2 * p2 + 1]};
                const f32x2 cv = {xv[2 * p2 + 1], xv[2 * p2 + 2]}, pv = {xv[2 * p2], xv[2 * p2 + 1]};
                const f32x2 r_ = cr + (pr - cr) * mur, k_ = ck + (pk - ck) * muk, v_ = cv + (pv - cv) * muv;
                const f32x2 a_ = {bf2f(raw.a[2 * p2]), bf2f(raw.a[2 * p2 + 1])};
                f32x2 kx = k_ * kkw; const f32x2 sq = kx * kx;
                const float ss0 = wave_sum2(sq.x), ss1 = wave_sum2(sq.y);
                kx = kx * (f32x2){fminf(__builtin_amdgcn_rsqf(ss0), 1e12f), fminf(__builtin_amdgcn_rsqf(ss1), 1e12f)};
                const f32x2 kmod = k_ * (a_ * ka + (1.0f - ka));
                const f32x2 bq = (r_ * kmod) * rk;
                const float bn0 = wave_sum2(bq.x), bn1 = wave_sum2(bq.y);
                if (lane == 0) { bonus[(tok0 + 2 * p2) * 8 + h] = bn0; bonus[(tok0 + 2 * p2 + 1) * 8 + h] = bn1; }
                rr2[p2] = r_; vv2[p2] = v_; aa2[p2] = a_; km2[p2] = kmod; kn2[p2] = kx;
                run += bf2f(raw.lw[2 * p2]); cl[2 * p2] = run; run += bf2f(raw.lw[2 * p2 + 1]); cl[2 * p2 + 1] = run;
            }
            segtot[w * 64 + lane] = run;
            LSYNC();
            float pre = 0.f;
            for (int w2 = 0; w2 < w; ++w2) pre += segtot[w2 * 64 + lane];
            if (w == 7) PLs[lane] = __expf(pre + run);
            float ep = __expf(pre);
            unsigned xa[4], xb[4], xkk[4], xrr[4], xvv[4];
#pragma unroll
            for (int p2 = 0; p2 < 4; ++p2) {
                const f32x2 tt = ((f32x2){cl[2 * p2], cl[2 * p2 + 1]} + pre) * 1.44269504f;
                const f32x2 e = {__builtin_amdgcn_exp2f(tt.x), __builtin_amdgcn_exp2f(tt.y)}, en = {__builtin_amdgcn_rcpf(e.x), __builtin_amdgcn_rcpf(e.y)}, epv = {ep, e.x};
                ep = e.y;
                const f32x2 at = -(kn2[p2] * epv), bt = (kn2[p2] * aa2[p2]) * en, kt = km2[p2] * en, rt = rr2[p2] * e;
                xa[p2] = cvt_pk_bf16(at.x, at.y); xb[p2] = cvt_pk_bf16(bt.x, bt.y); xkk[p2] = cvt_pk_bf16(kt.x, kt.y); xrr[p2] = cvt_pk_bf16(rt.x, rt.y); xvv[p2] = cvt_pk_bf16(vv2[p2].x, vv2[p2].y);
                const int t = 8 * w + 2 * p2;
                S0[t * PT + lane] = (bf16_t)(xa[p2] & 0xffffu); S0[(t + 1) * PT + lane] = (bf16_t)(xa[p2] >> 16);
                S2[t * PT + lane] = (bf16_t)(xb[p2] & 0xffffu); S2[(t + 1) * PT + lane] = (bf16_t)(xb[p2] >> 16);
                S4[t * PT + lane] = (bf16_t)(xkk[p2] & 0xffffu); S4[(t + 1) * PT + lane] = (bf16_t)(xkk[p2] >> 16);
                S6[t * PT + lane] = (bf16_t)(xrr[p2] & 0xffffu); S6[(t + 1) * PT + lane] = (bf16_t)(xrr[p2] >> 16);
            }
            *(LAS u32x4*)(S1 + lane * PT + 8 * w) = (u32x4){xa[0], xa[1], xa[2], xa[3]};
            *(LAS u32x4*)(S3 + lane * PT + 8 * w) = (u32x4){xb[0], xb[1], xb[2], xb[3]};
            *(LAS u32x4*)(S5 + lane * PT + 8 * w) = (u32x4){xkk[0], xkk[1], xkk[2], xkk[3]};
            *(LAS u32x4*)(S7 + lane * PT + 8 * w) = (u32x4){xvv[0], xvv[1], xvv[2], xvv[3]};
        }
        LSYNC();
        if (ci + F.G < RW_NCH) ra_load(raw, prw, lwag, ci + F.G, w, lane);
        f32x4 acc[2];
        const f32x4 Z4 = (f32x4){0.f, 0.f, 0.f, 0.f};
        const int ia = 16 * ti + r, jb0 = 16 * tj0 + r;
        { bf16x8 a0[2], a6[2], b2[2][2], b4[2][2];
          ld_frag(a0, S0, ia, q); ld_frag(a6, S6, ia, q);
#pragma unroll
          for (int e = 0; e < 2; ++e) { ld_frag(b2[e], S2, jb0 + 16 * e, q); ld_frag(b4[e], S4, jb0 + 16 * e, q); }
#pragma unroll
          for (int e = 0; e < 2; ++e) { const int tj = tj0 + e, j = 16 * tj + r, js = 16 * tj + 4 * q;
            const f32x4 c = mm2(a0, b2[e], Z4);
            if (tj == ti) {
#pragma unroll
                for (int g = 0; g < 4; ++g) DB[(ti * 16 + 4 * q + g) * PD + r] = (4 * q + g > r) ? c[g] : 0.f;
            }
            st_tr(S8, (ti > tj) ? c : Z4, i0, j);
            f32x4 v = mm2(b4[e], a0, Z4);
#pragma unroll
            for (int g = 0; g < 4; ++g) v[g] = (ia > js + g) ? v[g] : 0.f;
            st_sw(S9, v, ia, js);
            v = mm2(b2[e], a6, Z4);
#pragma unroll
            for (int g = 0; g < 4; ++g) v[g] = (ia >= js + g) ? v[g] : 0.f;
            st_sw(S10, v, ia, js);
            v = mm2(b4[e], a6, Z4);
#pragma unroll
            for (int g = 0; g < 4; ++g) v[g] = (ia >= js + g) ? v[g] : 0.f;
            st_sw(S11, v, ia, js); } }
        LSYNC();
        ZACC(acc); mm_acc(acc, S9, S7, ti, tj0, r, q);
#pragma unroll
        for (int e = 0; e < 2; ++e) st_tr(S2, acc[e], i0, 16 * (tj0 + e) + r);
        if (w < 4) {
            const int i = lane >> 2, p = lane & 3;
            const LAS float* Dp = DB + (w * 16 + p) * PD;
            f32x4 Dm[4][4];
#pragma unroll
            for (int m = 0; m < 4; ++m)
#pragma unroll
                for (int c4 = 0; c4 < 4; ++c4) Dm[m][c4] = *(const LAS f32x4*)(Dp + 4 * m * PD + 4 * c4);
            float mine[4] = {0.f, 0.f, 0.f, 0.f}, tr[16];
#pragma unroll
            for (int j = 15; j >= 0; --j) { float part = 0.f;
#pragma unroll
                for (int m = 3; m >= 0; --m) if (4 * m + 3 > j) part = __builtin_fmaf(mine[m], Dm[m][j >> 2][j & 3], part);
                float tot = part + __builtin_bit_cast(float, __builtin_amdgcn_update_dpp(0, __builtin_bit_cast(int, part), 0xB1, 0xf, 0xf, false));
                tot = tot + __builtin_bit_cast(float, __builtin_amdgcn_update_dpp(0, __builtin_bit_cast(int, tot), 0x4E, 0xf, 0xf, false));
                const float trj = (j > i) ? 0.f : ((j == i) ? 1.0f : tot);
                tr[j] = trj; mine[j >> 2] = (p == (j & 3)) ? trj : mine[j >> 2]; }
            u32x4 z = (u32x4){0u, 0u, 0u, 0u}, x0, x1;
            x0.x = cvt_pk_bf16(tr[0], tr[1]); x0.y = cvt_pk_bf16(tr[2], tr[3]); x0.z = cvt_pk_bf16(tr[4], tr[5]); x0.w = cvt_pk_bf16(tr[6], tr[7]);
            x1.x = cvt_pk_bf16(tr[8], tr[9]); x1.y = cvt_pk_bf16(tr[10], tr[11]); x1.z = cvt_pk_bf16(tr[12], tr[13]); x1.w = cvt_pk_bf16(tr[14], tr[15]);
            LAS bf16_t* dst = S0 + (16 * w + i) * PT + 16 * p;
            *(LAS u32x4*)dst = (p == w) ? x0 : z; *(LAS u32x4*)(dst + 8) = (p == w) ? x1 : z;
#pragma unroll
            for (int m = 0; m < 4; ++m) TDT[(16 * w + 4 * m + p) * TP + i] = f2bf(mine[m]);
        }
        LSYNC();
        { bf16x8 a[2], b[2][2]; ld_frag(a, S0, ia, q);
#pragma unroll
          for (int e = 0; e < 2; ++e) ld_frag(b[e], S8, jb0 + 16 * e, q);
#pragma unroll
          for (int e = 0; e < 2; ++e) { st_tr(S12, mm2(a, b[e], Z4), i0, 16 * (tj0 + e) + r); st_sw(S4, mm2(b[e], a, Z4), ia, 16 * (tj0 + e) + 4 * q); } }
        LSYNC();
        { bf16x8 a[2], b[2][2]; ld_frag(a, S4, ia, q);
#pragma unroll
          for (int e = 0; e < 2; ++e) ld_frag(b[e], S12, jb0 + 16 * e, q);
          const bf16x8 as = (w & 1) ? a[1] : a[0];
#pragma unroll
          for (int e = 0; e < 2; ++e) { const int tj = tj0 + e, j = 16 * tj + r, js = 16 * tj + 4 * q;
            st_sw(S13, mm2(b[e], a, Z4), ia, js);
            bf16x8 bt = *(const LAS bf16x8*)(TDT + j * TP + 8 * (q & 1));
            if ((q >> 1) != e) bt = (bf16x8){0, 0, 0, 0, 0, 0, 0, 0};
            f32x4 c = Z4;
            if (ti == tj) { const u32x2 wv = *(const LAS u32x2*)(TDT + j * TP + 4 * q); c = (f32x4){bf_lo(wv.x), bf_hi(wv.x), bf_lo(wv.y), bf_hi(wv.y)}; }
            st_tr(S9, __builtin_amdgcn_mfma_f32_16x16x32_bf16(as, bt, c, 0, 0, 0), i0, j);
            st_sw(S8, __builtin_amdgcn_mfma_f32_16x16x32_bf16(bt, as, ld_sw(S0, ia, js), 0, 0, 0), ia, js); } }
        LSYNC();
        { bf16x8 a[2], b[2][2]; ld_frag(a, S13, ia, q);
#pragma unroll
          for (int e = 0; e < 2; ++e) ld_frag(b[e], S9, jb0 + 16 * e, q);
#pragma unroll
          for (int e = 0; e < 2; ++e) { const int js = 16 * (tj0 + e) + 4 * q; st_sw(S12, mm2(b[e], a, ld_sw(S8, ia, js)), ia, js); } }
        LSYNC();
        { bf16x8 a[2], b1[2][2], bx[2][2]; ld_frag(a, S12, ia, q);
#pragma unroll
          for (int e = 0; e < 2; ++e) { ld_frag(b1[e], S1, jb0 + 16 * e, q); ld_frag(bx[e], S2, jb0 + 16 * e, q); }
#pragma unroll
          for (int e = 0; e < 2; ++e) { const int j = 16 * (tj0 + e) + r; st_tr(S0, mm2(a, b1[e], Z4), i0, j); st_tr(S4, mm2(a, bx[e], Z4), i0, j); } }
        LSYNC();
        { bf16x8 a10[2], a11[2], a3[2], a5[2], b0[2][2], b4[2][2], b7[2][2];
          ld_frag(a10, S10, ia, q); ld_frag(a11, S11, ia, q); ld_frag(a3, S3, ia, q); ld_frag(a5, S5, ia, q);
#pragma unroll
          for (int e = 0; e < 2; ++e) { ld_frag(b0[e], S0, jb0 + 16 * e, q); ld_frag(b4[e], S4, jb0 + 16 * e, q); ld_frag(b7[e], S7, jb0 + 16 * e, q); }
          const float pli = PLs[ia];
          f32x4 plg;
#pragma unroll
          for (int g = 0; g < 4; ++g) plg[g] = PLs[i0 + g];
#pragma unroll
          for (int e = 0; e < 2; ++e) { const int j = 16 * (tj0 + e) + r, js = 16 * (tj0 + e) + 4 * q;
            const f32x4 vq = mm2(b0[e], a10, ld_sw(S6, ia, js));
            const f32x4 vy = mm2(b7[e], a11, mm2(b4[e], a10, Z4));
            f32x4 vm = mm2(b0[e], a3, Z4);
#pragma unroll
            for (int g = 0; g < 4; ++g) vm[g] = pli * (vm[g] + ((ia == js + g) ? 1.0f : 0.f));
            const f32x4 vn = mm2(a5, b7[e], mm2(a3, b4[e], Z4)) * plg;
            st_sw(S1, vq, ia, js); st_sw(S2, vy, ia, js); st_sw(S8, vm, ia, js); st_tr(S9, vn, i0, j); } }
        LSYNC();
        { const int row = F.tid >> 3, seg = (F.tid & 7) * 8; const size_t go = (size_t)ci * 4096 + row * 64 + seg;
          *(u32x4*)(gQ + go) = *(const LAS u32x4*)(S1 + row * PT + seg); *(u32x4*)(gY0 + go) = *(const LAS u32x4*)(S2 + row * PT + seg);
          *(u32x4*)(gM + go) = *(const LAS u32x4*)(S8 + row * PT + seg); *(u32x4*)(gN0T + go) = *(const LAS u32x4*)(S9 + row * PT + seg); }
        LSYNC();
    }
    asm volatile("s_waitcnt vmcnt(0)" ::: "memory");
}

struct ScanOps { u32x2 m[4][2][2]; u32x2 n0[4]; };
DI void scan_load(ScanOps& o, const bf16_t* gM, const bf16_t* gN0T, size_t ci, int col, int q, int v) {
#pragma unroll
    for (int m = 0; m < 4; ++m) {
#pragma unroll
        for (int s2 = 0; s2 < 2; ++s2) { const bf16_t* p = gM + ci * 4096 + (16 * m + col) * 64 + 32 * s2 + 4 * q; o.m[m][s2][0] = *(const u32x2*)p; o.m[m][s2][1] = *(const u32x2*)(p + 16); }
        o.n0[m] = *(const u32x2*)(gN0T + ci * 4096 + v * 64 + 16 * m + 4 * q); }
}
DI void scan_step(const ScanOps& o, f32x4 (&H)[4], bf16_t* gHT, size_t ci, int q, int v) {
    u32x4 bfr[2];
#pragma unroll
    for (int s2 = 0; s2 < 2; ++s2) { bfr[s2].x = cvt_pk_bf16(H[2 * s2][0], H[2 * s2][1]); bfr[s2].y = cvt_pk_bf16(H[2 * s2][2], H[2 * s2][3]);
        bfr[s2].z = cvt_pk_bf16(H[2 * s2 + 1][0], H[2 * s2 + 1][1]); bfr[s2].w = cvt_pk_bf16(H[2 * s2 + 1][2], H[2 * s2 + 1][3]);
        bf16_t* hp = gHT + ci * 4096 + v * 64 + 32 * s2 + 4 * q;
        *(u32x2*)hp = (u32x2){bfr[s2].x, bfr[s2].y}; *(u32x2*)(hp + 16) = (u32x2){bfr[s2].z, bfr[s2].w}; }
#pragma unroll
    for (int m = 0; m < 4; ++m) {
        f32x4 a2 = (f32x4){bf_lo(o.n0[m].x), bf_hi(o.n0[m].x), bf_lo(o.n0[m].y), bf_hi(o.n0[m].y)};
#pragma unroll
        for (int s2 = 0; s2 < 2; ++s2) { const u32x4 af = (u32x4){o.m[m][s2][0].x, o.m[m][s2][0].y, o.m[m][s2][1].x, o.m[m][s2][1].y};
            a2 = __builtin_amdgcn_mfma_f32_16x16x32_bf16(__builtin_bit_cast(bf16x8, af), __builtin_bit_cast(bf16x8, bfr[s2]), a2, 0, 0, 0); }
        H[m] = a2; }
}
constexpr int SC_DEPTH = 10, SC_SLOT = 12288;
DI void scan_dma(unsigned lds_dst, unsigned voff, const char* base) { asm volatile("s_mov_b32 m0, %0\n\ts_nop 0\n\tglobal_load_lds_dwordx4 %1, %2" :: "s"(lds_dst), "v"(voff), "s"(base) : "memory"); }
DI void scan_lds_load(ScanOps& o, const LAS unsigned char* slot, int lbM, int lbN, const int (&xo)[2][2], int c7) {
#pragma unroll
    for (int m = 0; m < 4; ++m) {
#pragma unroll
        for (int s2 = 0; s2 < 2; ++s2) { o.m[m][s2][0] = *(const LAS u32x2*)(slot + lbM + m * 2048 + xo[s2][0]); o.m[m][s2][1] = *(const LAS u32x2*)(slot + lbM + m * 2048 + xo[s2][1]); }
        o.n0[m] = *(const LAS u32x2*)(slot + 8192 + lbN + (((2 * m) << 4) ^ c7)); }
}
DI void p_rw_scan(const Frame& F) {
    const bf16_t* gM = (const bf16_t*)(F.ws + WS_CHK_M); const bf16_t* gN0T = (const bf16_t*)(F.ws + WS_CHK_N0T); bf16_t* gHT = (bf16_t*)(F.ws + WS_CHK_HT);
    const unsigned ldsbase = (unsigned)(size_t)F.lds;
    const int w = F.wave, col = F.lane & 15, q = F.lane >> 4;
    const int lw = w - 2, lt = F.tid - 128;
    const int P1 = (384 + lt) & 511;
    const unsigned voff0 = (unsigned)((lt >> 3) * 128 + (((lt & 7) ^ ((lt >> 3) & 7)) << 4));
    const unsigned voff1 = (unsigned)((P1 >> 3) * 128 + (((P1 & 7) ^ ((P1 >> 3) & 7)) << 4));
    const int c7 = (col & 7) << 4, qh = (q >> 1) << 4;
    const int lbM = col * 128 + 8 * (q & 1), lbN = (16 * (w & 1) + col) * 128 + 8 * (q & 1);
    int xo[2][2];
#pragma unroll
    for (int s2 = 0; s2 < 2; ++s2)
#pragma unroll
        for (int h = 0; h < 2; ++h) xo[s2][h] = (((4 * s2 + 2 * h) << 4) + qh) ^ c7;
    const int c7n = c7 ^ qh;
    for (int p = F.bid; p < 256; p += F.G) {
        const int bh = p >> 1, half = p & 1, v = 32 * half + 16 * (w & 1) + col;
        const size_t c0 = (size_t)bh * 64;
        const char* baseM = (const char*)(gM + c0 * 4096);
        const char* baseN = (const char*)(gN0T + c0 * 4096 + half * 2048);
        const char* base1 = (lw < 2) ? baseM : baseN;
#define SC_ISSUE(c, slot) do { if (w >= 2) { const unsigned _d = ldsbase + (unsigned)(slot) * SC_SLOT + (unsigned)lw * 1024u; \
            scan_dma(_d, voff0 + (unsigned)(c) * 8192u, baseM); scan_dma(_d + 6144u, voff1 + (unsigned)(c) * 8192u, base1); } } while (0)
#pragma unroll 1
        for (int c = 0; c < SC_DEPTH; ++c) SC_ISSUE(c, c);
        asm volatile("s_waitcnt vmcnt(0)" ::: "memory"); __builtin_amdgcn_s_barrier();
        f32x4 H[4];
#pragma unroll
        for (int m = 0; m < 4; ++m) H[m] = (f32x4){0.f, 0.f, 0.f, 0.f};
        ScanOps A, B;
        if (w < 2) scan_lds_load(A, F.lds, lbM, lbN, xo, c7n);
        int slot = 0;
#define SC_STEP(X, Y, c) do { \
            if (w < 2) asm volatile("s_waitcnt lgkmcnt(0)" ::: "memory"); else asm volatile("s_waitcnt vmcnt(16)" ::: "memory"); \
            __builtin_amdgcn_s_barrier(); \
            const int _sn = (slot + 1 == SC_DEPTH) ? 0 : slot + 1; \
            if (w < 2) scan_lds_load(Y, F.lds + _sn * SC_SLOT, lbM, lbN, xo, c7n); \
            { const int _cn = ((c) + SC_DEPTH < 64) ? (c) + SC_DEPTH : 63; SC_ISSUE(_cn, slot); } \
            if (w < 2) scan_step(X, H, gHT, c0 + (c), q, v); \
            slot = _sn; } while (0)
        static_assert(2 * (SC_DEPTH - 2) == 16, "vmcnt literal in SC_STEP");
#pragma unroll 1
        for (int c = 0; c < 64; c += 2) { SC_STEP(A, B, c); SC_STEP(B, A, c + 1); }
#undef SC_STEP
#undef SC_ISSUE
        asm volatile("s_waitcnt vmcnt(0)" ::: "memory"); __builtin_amdgcn_s_barrier();
    }
}

struct RcIn { bf16x8 qf[2], hb[4][2]; u32x2 y0[4], cv[4], pv[4], gw[4]; float bn; };
DI void rc_load(RcIn& x, const bf16_t* gQ, const bf16_t* gY0, const bf16_t* gHT, const bf16_t* prw, const bf16_t* lwag, const float* bonus, int item, int r, int q) {
    const int ci = item >> 2, ti = item & 3, bh = ci >> 6, c = ci & 63, b = bh >> 3, h = bh & 7;
    const size_t cb = (size_t)ci * 4096; const size_t tok = (size_t)b * SEQ + c * 64 + 16 * ti + r;
    const bool first = (tok & (SEQ - 1)) == 0; const size_t tp = first ? tok : tok - 1;
#pragma unroll
    for (int s2 = 0; s2 < 2; ++s2) x.qf[s2] = *(const bf16x8*)(gQ + cb + (16 * ti + r) * 64 + 32 * s2 + 8 * q);
#pragma unroll
    for (int n = 0; n < 4; ++n) { const int cch = h * 64 + 16 * n + 4 * q;
        x.y0[n] = *(const u32x2*)(gY0 + cb + (16 * ti + r) * 64 + 16 * n + 4 * q);
#pragma unroll
        for (int s2 = 0; s2 < 2; ++s2) x.hb[n][s2] = *(const bf16x8*)(gHT + cb + (16 * n + r) * 64 + 32 * s2 + 8 * q);
        x.cv[n] = *(const u32x2*)(prw + tok * RWC + 1024 + cch); x.pv[n] = *(const u32x2*)(prw + tp * RWC + 1024 + cch);
        x.gw[n] = *(const u32x2*)(lwag + tok * 1536 + 1024 + cch); }
    x.bn = bonus[tok * 8 + h];
}
DI void rc_compute(const RcIn& x, bf16_t* yrw, const float* mu, const float* ln_g, const float* ln_b, int item, int r, int q) {
    const int ci = item >> 2, ti = item & 3, bh = ci >> 6, c = ci & 63, b = bh >> 3, h = bh & 7;
    const size_t tok = (size_t)b * SEQ + c * 64 + 16 * ti + r; const bool first = (tok & (SEQ - 1)) == 0;
    f32x4 y[4];
#pragma unroll
    for (int n = 0; n < 4; ++n) { y[n] = (f32x4){bf_lo(x.y0[n].x), bf_hi(x.y0[n].x), bf_lo(x.y0[n].y), bf_hi(x.y0[n].y)};
#pragma unroll
        for (int s2 = 0; s2 < 2; ++s2) y[n] = __builtin_amdgcn_mfma_f32_16x16x32_bf16(x.hb[n][s2], x.qf[s2], y[n], 0, 0, 0); }
    float s1 = 0.f;
#pragma unroll
    for (int n = 0; n < 4; ++n) s1 += (y[n][0] + y[n][1]) + (y[n][2] + y[n][3]);
    s1 = xrow_sum(s1);
    const float mean = s1 * (1.0f / 64.0f);
    float s2 = 0.f;
#pragma unroll
    for (int n = 0; n < 4; ++n) { y[n] = y[n] - mean; s2 += (y[n][0] * y[n][0] + y[n][1] * y[n][1]) + (y[n][2] * y[n][2] + y[n][3] * y[n][3]); }
    s2 = xrow_sum(s2);
    const float rstd = rsqrtf(s2 * (1.0f / 64.0f) + 64e-5f);
#pragma unroll
    for (int n = 0; n < 4; ++n) { const int cch = h * 64 + 16 * n + 4 * q;
        const f32x4 muv = *(const f32x4*)(mu + 1024 + cch), lg = *(const f32x4*)(ln_g + cch), lb = *(const f32x4*)(ln_b + cch);
        const float cv[4] = {bf_lo(x.cv[n].x), bf_hi(x.cv[n].x), bf_lo(x.cv[n].y), bf_hi(x.cv[n].y)};
        const float pv[4] = {first ? 0.f : bf_lo(x.pv[n].x), first ? 0.f : bf_hi(x.pv[n].x), first ? 0.f : bf_lo(x.pv[n].y), first ? 0.f : bf_hi(x.pv[n].y)};
        const float gg[4] = {bf_lo(x.gw[n].x), bf_hi(x.gw[n].x), bf_lo(x.gw[n].y), bf_hi(x.gw[n].y)};
        float o[4];
#pragma unroll
        for (int g = 0; g < 4; ++g) { const float vsh = cv[g] + muv[g] * (pv[g] - cv[g]); o[g] = (y[n][g] * rstd * lg[g] + lb[g] + x.bn * vsh) * gg[g]; }
        u32x2 ow; ow.x = cvt_pk_bf16(o[0], o[1]); ow.y = cvt_pk_bf16(o[2], o[3]);
        *(u32x2*)(yrw + tok * 512 + cch) = ow; }
}
DI void p_rw_out(const Frame& F) {
    const bf16_t* gQ = (const bf16_t*)(F.ws + WS_CHK_Q); const bf16_t* gY0 = (const bf16_t*)(F.ws + WS_CHK_Y0T); const bf16_t* gHT = (const bf16_t*)(F.ws + WS_CHK_HT);
    const bf16_t* prw = (const bf16_t*)(F.ws + WS_PRW); const bf16_t* lwag = (const bf16_t*)(F.ws + WS_LWAG); const float* bonus = (const float*)(F.ws + WS_BONUS);
    bf16_t* yrw = (bf16_t*)(F.ws + WS_YRW);
    const float* mu = F.in[13]; const float* ln_g = F.in[22]; const float* ln_b = F.in[23];
    const int r = F.lane & 15, q = F.lane >> 4, stride = F.G * NWAVES, NIT = RW_NCH * 4;
    for (int item = F.bid * NWAVES + F.wave; item < NIT; item += 2 * stride) {
        const int item2 = (item + stride < NIT) ? item + stride : item;
        RcIn xa, xb;
        rc_load(xa, gQ, gY0, gHT, prw, lwag, bonus, item, r, q); rc_load(xb, gQ, gY0, gHT, prw, lwag, bonus, item2, r, q);
        rc_compute(xa, yrw, mu, ln_g, ln_b, item, r, q); rc_compute(xb, yrw, mu, ln_g, ln_b, item2, r, q);
    }
}

DI void p_moe_prep(const Frame& F) {
    const bf16_t* hb = (const bf16_t*)(F.ws + WS_HB); float* rsv = (float*)(F.ws + WS_RS); unsigned char* out8 = (unsigned char*)(F.ws + WS_XN2F8); const float* g = F.in[26];
    const int stride = F.G * NWAVES;
    for (int row = F.bid * NWAVES + F.wave; row < T; row += 2 * stride) {
        const int row2 = (row + stride < T) ? row + stride : row;
        u32x4 a[2], b[2];
        a[0] = *(const u32x4*)(hb + (size_t)row * D + F.lane * 16); a[1] = *(const u32x4*)(hb + (size_t)row * D + F.lane * 16 + 8);
        b[0] = *(const u32x4*)(hb + (size_t)row2 * D + F.lane * 16); b[1] = *(const u32x4*)(hb + (size_t)row2 * D + F.lane * 16 + 8);
        float v[16], u[16]; float ss = 0.f, su = 0.f;
#pragma unroll
        for (int j = 0; j < 8; ++j) { v[2 * j] = bf_lo(a[j >> 2][j & 3]); v[2 * j + 1] = bf_hi(a[j >> 2][j & 3]); u[2 * j] = bf_lo(b[j >> 2][j & 3]); u[2 * j + 1] = bf_hi(b[j >> 2][j & 3]); }
#pragma unroll
        for (int j = 0; j < 16; ++j) { ss += v[j] * v[j]; su += u[j] * u[j]; }
        ss = wave_sum(ss); su = wave_sum(su);
        const float rs = rsqrtf(ss * (1.0f / D) + 1e-5f), ru = rsqrtf(su * (1.0f / D) + 1e-5f);
        float gv[16];
#pragma unroll
        for (int q = 0; q < 4; ++q) { const f32x4 t = *(const f32x4*)(g + F.lane * 16 + q * 4); gv[4 * q] = t[0]; gv[4 * q + 1] = t[1]; gv[4 * q + 2] = t[2]; gv[4 * q + 3] = t[3]; }
#pragma unroll
        for (int j = 0; j < 16; ++j) { v[j] *= rs * gv[j]; u[j] *= ru * gv[j]; }
        u32x4 q0, q1;
        if (F.lane == 0) { rsv[row] = rs; rsv[row2] = ru; }
        q0.x = pk4_fp8(v[0] * F8_SX, v[1] * F8_SX, v[2] * F8_SX, v[3] * F8_SX); q0.y = pk4_fp8(v[4] * F8_SX, v[5] * F8_SX, v[6] * F8_SX, v[7] * F8_SX);
        q0.z = pk4_fp8(v[8] * F8_SX, v[9] * F8_SX, v[10] * F8_SX, v[11] * F8_SX); q0.w = pk4_fp8(v[12] * F8_SX, v[13] * F8_SX, v[14] * F8_SX, v[15] * F8_SX);
        q1.x = pk4_fp8(u[0] * F8_SX, u[1] * F8_SX, u[2] * F8_SX, u[3] * F8_SX); q1.y = pk4_fp8(u[4] * F8_SX, u[5] * F8_SX, u[6] * F8_SX, u[7] * F8_SX);
        q1.z = pk4_fp8(u[8] * F8_SX, u[9] * F8_SX, u[10] * F8_SX, u[11] * F8_SX); q1.w = pk4_fp8(u[12] * F8_SX, u[13] * F8_SX, u[14] * F8_SX, u[15] * F8_SX);
        *(u32x4*)(out8 + (size_t)row * D + F.lane * 16) = q0; *(u32x4*)(out8 + (size_t)row2 * D + F.lane * 16) = q1;
    }
    float* b1p = (float*)(F.ws + WS_B1P); const float* b1 = F.in[30]; CmSwi cm;
    for (int idx = F.bid * NTHR + F.tid; idx < 32 * 2048; idx += F.G * NTHR) { const int e = idx >> 11, n = idx & 2047; b1p[idx] = b1[e * 2048 + cm(n)]; }
}
DI void p_conv_part(const Frame& F, int part) {
    if (part == 0) conv_T8(F, F.in[29], (size_t)1024 * 2048, 2048, (unsigned char*)(F.ws + WS_W1), 2048, 1024, 32, MpSwi(), F8_SW, 0, 2048);
    else if (part == 1) conv_T8(F, F.in[29], (size_t)1024 * 2048, 2048, (unsigned char*)(F.ws + WS_W1), 2048, 1024, 32, MpSwi(), F8_SW, 2048, 4096);
    else conv_T8(F, F.in[31], (size_t)1024 * 1024, 1024, (unsigned char*)(F.ws + WS_W2), 1024, 1024, 32, MpId(), F8_SW);
}

DI void topk_rows(const Frame& F, int row0) {
    LAS unsigned* cnt = (LAS unsigned*)F.lds; LAS unsigned* base = cnt + 32;
    const float* logits = (const float*)(F.ws + WS_LOG); unsigned* epos = (unsigned*)(F.ws + WS_EPOS); float* gatev = (float*)(F.ws + WS_GATEV);
    const int pass = row0 / TPP;
    unsigned* gcnt = (unsigned*)(F.ws + WS_CTL) + CW_GCNT + pass * 32;
    if (F.tid < 32) cnt[F.tid] = 0u;
    __syncthreads();
    int e4[4] = {0, 0, 0, 0}; unsigned p4[4] = {0u, 0u, 0u, 0u}; float g4[4] = {0.f, 0.f, 0.f, 0.f};
    const int token = row0 + F.tid;
    if (F.tid < 256) {
        float l[32]; const float rsc = ((const float*)(F.ws + WS_RS))[token];
#pragma unroll
        for (int q = 0; q < 8; ++q) { const f32x4 v = *(const f32x4*)(logits + (size_t)token * 32 + q * 4), bq = *(const f32x4*)(F.in[28] + q * 4); l[q * 4] = v[0] * rsc + bq[0]; l[q * 4 + 1] = v[1] * rsc + bq[1]; l[q * 4 + 2] = v[2] * rsc + bq[2]; l[q * 4 + 3] = v[3] * rsc + bq[3]; }
        unsigned used = 0u; float tv[4];
#pragma unroll
        for (int k = 0; k < 4; ++k) { float best = -3.0e38f; int bi = 0;
#pragma unroll
            for (int e = 0; e < 32; ++e) { const bool ok = !((used >> e) & 1u) && (l[e] > best); best = ok ? l[e] : best; bi = ok ? e : bi; }
            used |= 1u << bi; e4[k] = bi; tv[k] = best; }
        const float m = tv[0]; float ex[4], sum = 0.f;
#pragma unroll
        for (int k = 0; k < 4; ++k) { ex[k] = __expf(tv[k] - m); sum += ex[k]; }
#pragma unroll
        for (int k = 0; k < 4; ++k) { g4[k] = ex[k] / sum; p4[k] = atomicAdd((unsigned*)&cnt[e4[k]], 1u); }
    }
    __syncthreads();
    if (F.tid < 32) base[F.tid] = __hip_atomic_fetch_add(&gcnt[F.tid], cnt[F.tid], __ATOMIC_RELAXED, __HIP_MEMORY_SCOPE_AGENT);
    __syncthreads();
    if (F.tid < 256) {
#pragma unroll
        for (int k = 0; k < 4; ++k) { epos[(size_t)token * 4 + k] = ((unsigned)e4[k] << 24) | (base[e4[k]] + p4[k]); gatev[(size_t)token * 4 + k] = g4[k]; }
    }
    __syncthreads();
}
DI void p_gather(const Frame& F, int pass) {
    LAS int* poff = (LAS int*)F.lds;
    LAS int* pcnt = poff + 40;
    unsigned* gcnt = (unsigned*)(F.ws + WS_CTL) + CW_GCNT + pass * 32;
    int* tile_e = (int*)(F.ws + WS_TILEE) + pass * TE_STRIDE;
    __syncthreads();
    if (F.tid == 0) { int acc = 0; for (int e = 0; e < 32; ++e) { poff[e] = acc; const int c = (int)__hip_atomic_load(&gcnt[e], __ATOMIC_RELAXED, __HIP_MEMORY_SCOPE_AGENT); pcnt[e] = c; acc += ((c + 255) >> 8) << 8; } poff[32] = acc; }
    __syncthreads();
    if (F.bid == 0) {
        const int nt = poff[32] >> 8;
        for (int t = F.tid; t < nt; t += NTHR) { int e = 0; for (int q = 1; q < 32; ++q) if (poff[q] <= t * 256) e = q; tile_e[1 + t] = e; }
        if (F.tid == 0) tile_e[0] = nt;
    }
    const unsigned* epos = (const unsigned*)(F.ws + WS_EPOS); const float* gatev = (const float*)(F.ws + WS_GATEV);
    int* slot = (int*)(F.ws + WS_SLOT); float* rowg = (float*)(F.ws + WS_ROWG) + (size_t)pass * MAXTILES * 256;
    int* rowtok = (int*)(F.ws + WS_ROWTOK) + (size_t)pass * MAXTILES * 256;
    for (int i = F.bid * NTHR + F.tid; i < 32 * 256; i += F.G * NTHR) { const int e = i >> 8, sl = poff[e] + pcnt[e] + (i & 255); if (sl < poff[e + 1]) rowtok[sl] = 0; }
    for (int i = F.bid * NTHR + F.tid; i < TPP * 4; i += F.G * NTHR) {
        const int token = pass * TPP + (i >> 2);
        const unsigned ep = epos[(size_t)pass * TPP * 4 + i]; const int sl = poff[ep >> 24] + (int)(ep & 0xffffffu);
        slot[(size_t)pass * TPP * 4 + i] = sl; rowg[sl] = gatev[(size_t)pass * TPP * 4 + i]; rowtok[sl] = token;
    }
    __syncthreads();
}
DI void p_combine(const Frame& F, int pass) {
    int tz_ = threadIdx.x; asm volatile("" : "+v"(tz_)); const int lane_ = tz_ & 63;
    const int* slot = (const int*)(F.ws + WS_SLOT); const unsigned char* y2 = (const unsigned char*)(F.ws + WS_XS) + (size_t)pass * PASS_BUF; const float* gf = F.in[33];
    for (int t = F.bid * NWAVES + F.wave; t < TPP; t += F.G * NWAVES) {
        const int token = pass * TPP + t;
        float v[16];
        { const bf16_t* hb = (const bf16_t*)(F.ws + WS_HB) + (size_t)token * D + lane_ * 16; const u32x4 h0 = *(const u32x4*)hb, h1 = *(const u32x4*)(hb + 8);
#pragma unroll
          for (int j = 0; j < 4; ++j) { v[2 * j] = bf_lo(h0[j]); v[2 * j + 1] = bf_hi(h0[j]); v[8 + 2 * j] = bf_lo(h1[j]); v[8 + 2 * j + 1] = bf_hi(h1[j]); } }
        u32x4 yw[4];
#pragma unroll
        for (int k = 0; k < 4; ++k) { const int s = slot[(size_t)token * 4 + k]; yw[k] = *(const u32x4*)(y2 + (size_t)s * D + lane_ * 16); }
#pragma unroll
        for (int k = 0; k < 4; ++k)
#pragma unroll
            for (int j = 0; j < 4; ++j) { const f32x2 lo = __builtin_amdgcn_cvt_pk_f32_fp8((int)yw[k][j], false), hi = __builtin_amdgcn_cvt_pk_f32_fp8((int)yw[k][j], true);
                v[4 * j] += lo[0] * (1.0f / F8_SY); v[4 * j + 1] += lo[1] * (1.0f / F8_SY); v[4 * j + 2] += hi[0] * (1.0f / F8_SY); v[4 * j + 3] += hi[1] * (1.0f / F8_SY); }
        float ss = 0.f;
#pragma unroll
        for (int j = 0; j < 16; ++j) ss += v[j] * v[j];
        ss = wave_sum(ss);
        const float rs = rsqrtf(ss * (1.0f / D) + 1e-5f);
        f32x4* orow = (f32x4*)(F.out + (size_t)token * D + lane_ * 16);
#pragma unroll
        for (int q = 0; q < 4; ++q) { const f32x4 gv = *(const f32x4*)(gf + lane_ * 16 + q * 4);
            orow[q] = (f32x4){v[q * 4] * rs * gv[0], v[q * 4 + 1] * rs * gv[1], v[q * 4 + 2] * rs * gv[2], v[q * 4 + 3] * rs * gv[3]}; }
    }
}

constexpr int N_PHASES = 18;
__global__ void __launch_bounds__(NTHR, 2) fwd_kernel(KArgs args) {
    extern __shared__ __attribute__((aligned(16))) unsigned char lds_raw[];
    Frame F; F.lds = (LAS unsigned char*)lds_raw; F.tid = threadIdx.x; F.lane = F.tid & 63; F.wave = __builtin_amdgcn_readfirstlane(F.tid >> 6);
    F.G = gridDim.x; F.bid = blockIdx.x; F.in = args.in; F.out = args.out; F.ws = args.ws;
    unsigned char* ws = args.ws;
    volatile LAS unsigned* MISC = (volatile LAS unsigned*)(F.lds + MISC_OFF);
    if (F.tid < 4) MISC[F.tid] = 0u;
    __syncthreads();
    XcdBarrier bar; bar.bar = (unsigned*)(ws + WS_CTL) + CW_BAR; bar.x = 0; bar.st = MISC;
    if (N_LAUNCH_MODE == 1) bar = xcd_barrier_post((unsigned*)(ws + WS_CTL) + CW_BAR, MISC);
    const int lo = args.ph_lo, hi = args.ph_hi;
#define IN(k) (lo <= (k) && (k) < hi)
#define REP(k) for (int _r = 0; _r < 1 + (int)((PROBE_MASK >> (k)) & 1u); ++_r)
#define SEAM(k) do { if (N_LAUNCH_MODE == 1 && IN(k) && IN((k) + 1)) xcd_barrier(bar); } while (0)
    bf16_t* gates = (bf16_t*)args.out;

    if (IN(0)) { REP(0) p0_prologue(F); SEAM(0); }
    if (IN(1)) {
        PlainSched S; S.init(ws + WS_XN, ws + WS_WIN, T, INC, D, D, D, F.G, F.bid);
        EpiWin E{(bf16_t*)(ws + WS_US5), (bf16_t*)(ws + WS_PRW), gates};
        REP(1) gemm_phase(F.lds, S, E); SEAM(1);
    }
    if (IN(2)) {
        GroupSched S; S.init(ws + WS_US5, ws + WS_WST, 512, LDU, 512, S5ROWS / BM, 1, F.G, F.bid);
        EpiS5State E{(float*)(ws + WS_SLOC)};
        REP(2) { gemm_phase(F.lds, S, E); p_rw_prep(F); } SEAM(2);
    }
    if (IN(3)) {
        REP(3) p_s5_carry(F);
        PlainSched S; S.init(ws + WS_ALORA, ws + WS_WLORA, T, 1536, 128, 256, 128, F.G, F.bid); S.akoff_pn = 4; S.akoff_bytes = 256;
        EpiLora E{(bf16_t*)(ws + WS_LWAG), F.in[14], F.in[16]};
        REP(3) gemm_phase(F.lds, S, E); SEAM(3);
    }
    if (IN(4)) {
        GroupSched S; S.init(ws + WS_US5, ws + WS_TOEP, LDU, LDU, LDU, S5ROWS / BM, 2, F.G, F.bid);
        EpiS5Out E{(bf16_t*)(ws + WS_YS)};
        REP(4) gemm_phase(F.lds, S, E); SEAM(4);
    }
    if (IN(5)) { REP(5) p_rw_chunk(F); SEAM(5); }
    if (IN(6)) { REP(6) p_rw_scan(F); SEAM(6); }
    if (IN(7)) { REP(7) p_rw_out(F); SEAM(7); }
    if (IN(8)) {
        PlainSched S; S.init(ws + WS_YS, ws + WS_WGLU, T, 2048, 512, 512, 512, F.G, F.bid);
        EpiGlu E{(bf16_t*)(ws + WS_XN), gates, (const float*)(ws + WS_BGLU)};
        if (F.bid & 1) p_conv_part(F, 0);
        gemm_phase(F.lds, S, E);
        if (!(F.bid & 1)) p_conv_part(F, 0);
        SEAM(8);
    }
    if (IN(9)) {
        PlainSched S; S.init(ws + WS_YRW, ws + WS_WO, T, 1024, 512, 512, 512, F.G, F.bid);
        EpiWo E{(bf16_t*)(ws + WS_XN), gates};
        if (F.bid & 1) p_conv_part(F, 1);
        gemm_phase(F.lds, S, E);
        if (!(F.bid & 1)) p_conv_part(F, 1);
        SEAM(9);
    }
    if (IN(10)) {
        PlainSched S; S.init(ws + WS_XN, ws + WS_WOUT, T, 1024, 1024, 1024, 1024, F.G, F.bid);
        EpiOut E{(bf16_t*)(ws + WS_HB), F.in[0]};
        if (F.bid & 1) p_conv_part(F, 2);
        gemm_phase(F.lds, S, E);
        if (!(F.bid & 1)) p_conv_part(F, 2);
        SEAM(10);
    }
    if (IN(11)) { REP(11) p_moe_prep(F); SEAM(11); }
    if (IN(12)) {
        PlainSched S; S.init(ws + WS_HB, ws + WS_WR, T, 256, 1024, 1024, 1024, F.G, F.bid);
        EpiRouter E{(float*)(ws + WS_LOG)};
        gemm_phase(F.lds, S, E);
        { Unit u; for (int i = 0; S.next(i, u); ++i) topk_rows(F, u.pm * BM); }
        SEAM(12);
    }
    if (IN(13)) { p_gather(F, 0); p_gather(F, 1); SEAM(13); }
#define MOE_G1(PASS, CIDX) \
            const int* te = (const int*)(ws + WS_TILEE) + (PASS) * TE_STRIDE; const int ntl = __builtin_amdgcn_readfirstlane(__hip_atomic_load(te, __ATOMIC_RELAXED, __HIP_MEMORY_SCOPE_AGENT)); \
            MoeSched<true> S; S.init(ws + WS_XN2F8, ws + WS_W1, te + 1, (const int*)(ws + WS_ROWTOK) + (size_t)(PASS) * MAXTILES * 256, ntl, 512, 8, F.G, (CIDX)); \
            EpiMoe1 E{(unsigned char*)(ws + WS_ACT) + (size_t)(PASS) * PASS_BUF, (const float*)(ws + WS_B1P)};
#define MOE_G2(PASS) \
            const int* te = (const int*)(ws + WS_TILEE) + (PASS) * TE_STRIDE; const int ntl = __builtin_amdgcn_readfirstlane(__hip_atomic_load(te, __ATOMIC_RELAXED, __HIP_MEMORY_SCOPE_AGENT)); \
            MoeSched<false> S; S.init(ws + WS_ACT + (size_t)(PASS) * PASS_BUF, ws + WS_W2, te + 1, nullptr, ntl, 512, 4, F.G, F.bid); \
            EpiMoe2 E{(unsigned char*)(ws + WS_XS) + (size_t)(PASS) * PASS_BUF, F.in[32], (const float*)(ws + WS_ROWG) + (size_t)(PASS) * MAXTILES * 256};
    if (IN(14)) { MOE_G1(0, F.bid) gemm_phase(F.lds, S, E); SEAM(14); }
    if (IN(15)) {
        { MOE_G2(0) gemm_phase(F.lds, S, E); }
        { MOE_G1(1, F.G - 1 - F.bid) gemm_phase(F.lds, S, E); }
        SEAM(15);
    }
    if (IN(16)) {
        if (F.bid & 1) p_combine(F, 0);
        { MOE_G2(1) gemm_phase(F.lds, S, E); }
        if (!(F.bid & 1)) p_combine(F, 0);
        SEAM(16);
    }
    if (IN(17)) { p_combine(F, 1); }
#undef MOE_G1
#undef MOE_G2
#undef IN
#undef SEAM
#undef REP
}

extern "C" void kernel_launch(void* const* d_in, const int* in_sizes, int n_in, void* d_out, int out_size, void* d_ws, size_t ws_size, hipStream_t stream) {
    static int grid = 0;
    if (grid == 0) {
        if (n_in != 34 || in_sizes[0] != T * D || out_size != T * D || ws_size < WS_END) { fprintf(stderr, "kernel_launch: unexpected shapes (n_in %d, in0 %d, out %d, ws %zu < %zu)\n", n_in, n_in > 0 ? in_sizes[0] : -1, out_size, ws_size, (size_t)WS_END); grid = -1; return; }
        int dev = 0, cus = 0, per_cu = 0;
        if (hipGetDevice(&dev) != hipSuccess || hipDeviceGetAttribute(&cus, hipDeviceAttributeMultiprocessorCount, dev) != hipSuccess) { grid = -1; return; }
        if (hipFuncSetAttribute((const void*)fwd_kernel, hipFuncAttributeMaxDynamicSharedMemorySize, LDS_BYTES) != hipSuccess) { fprintf(stderr, "kernel_launch: hipFuncSetAttribute failed\n"); grid = -1; return; }
        if (hipOccupancyMaxActiveBlocksPerMultiprocessor(&per_cu, (const void*)fwd_kernel, NTHR, LDS_BYTES) != hipSuccess || per_cu < 1) { fprintf(stderr, "kernel_launch: occupancy query says %d\n", per_cu); }
        (void)hipGetLastError();
        grid = cus;
    }
    if (grid < 0) return;
    (void)hipMemsetAsync((char*)d_ws + WS_CTL, 0, CTL_BYTES, stream);
    KArgs a{};
    for (int i = 0; i < 34; ++i) a.in[i] = (const float*)d_in[i];
    a.out = (float*)d_out; a.ws = (unsigned char*)d_ws;
    if (N_LAUNCH_MODE == 1) {
        a.ph_lo = 0; a.ph_hi = N_PHASES;
        hipLaunchKernelGGL(fwd_kernel, dim3(grid), dim3(NTHR), LDS_BYTES, stream, a);
    } else {
        for (int p = 0; p < N_PHASES; ++p) { a.ph_lo = p; a.ph_hi = p + 1; hipLaunchKernelGGL(fwd_kernel, dim3(grid), dim3(NTHR), LDS_BYTES, stream, a); }
    }
}
```

```cpp
#include <hip/hip_runtime.h>
#include <stdint.h>
#include <stdio.h>

#ifndef N_LAUNCH_MODE
#define N_LAUNCH_MODE 1
#endif

#ifndef GEMM_SP2
#define GEMM_SP2 1
#endif
#ifndef GEMM_ALIGN
#define GEMM_ALIGN 1
#endif
#ifndef PROBE_MASK
#define PROBE_MASK 0u
#endif
#define LAS __attribute__((address_space(3)))
#define DI __device__ __forceinline__
typedef unsigned short bf16_t;
typedef short bf16x8 __attribute__((ext_vector_type(8)));
typedef float f32x4 __attribute__((ext_vector_type(4)));
typedef float f32x2 __attribute__((ext_vector_type(2)));
typedef unsigned u32x4 __attribute__((ext_vector_type(4)));
typedef unsigned u32x2 __attribute__((ext_vector_type(2)));
typedef int i32x8 __attribute__((ext_vector_type(8)));
typedef int i32x4 __attribute__((ext_vector_type(4)));

constexpr int T = 65536, D = 1024, SEQ = 4096, NB = 16;
constexpr int INC = 4352, RWC = 1792;
constexpr int S5L = 32;
constexpr int S5NC = SEQ / S5L;
constexpr int S5ROWS = T / S5L;
constexpr int LDU = 16 * S5L + 128;
constexpr int NE = 32, TOPK = 4;
constexpr int NPASS = 2, TPP = T / NPASS;
constexpr int MAXTILES = (TPP * TOPK) / 256 + NE;
constexpr int NWAVES = 8, NTHR = 512;

constexpr size_t al(size_t x) { return (x + 4095) & ~(size_t)4095; }
constexpr size_t WS_CTL = 0, CTL_BYTES = 1 << 20;
constexpr size_t WS_WIN = WS_CTL + CTL_BYTES;
constexpr size_t WS_WGLU = WS_WIN + al((size_t)INC * D * 2);
constexpr size_t WS_WO = WS_WGLU + al((size_t)2048 * 512 * 2);
constexpr size_t WS_WOUT = WS_WO + al((size_t)1024 * 512 * 2);
constexpr size_t WS_WLORA = WS_WOUT + al((size_t)1024 * 1024 * 2);
constexpr size_t WS_WR = WS_WLORA + al((size_t)1536 * 256 * 2);
constexpr size_t WS_TOEP = WS_WR + al((size_t)256 * 1024 * 2);
constexpr size_t WS_WST = WS_TOEP + al((size_t)32 * 512 * LDU * 2);
constexpr size_t WS_BGLU = WS_WST + al((size_t)32 * 256 * 512 * 2);
constexpr size_t WS_B1P = WS_BGLU + al(2048 * 4);
constexpr size_t WS_SHARED = WS_B1P + al((size_t)32 * 2048 * 4);
constexpr size_t WS_PRW = WS_SHARED;
constexpr size_t WS_LWAG = WS_PRW + al((size_t)T * RWC * 2);
constexpr size_t WS_YS = WS_LWAG + al((size_t)T * 1536 * 2);
constexpr size_t WS_YRW = WS_YS + al((size_t)T * 512 * 2);
constexpr size_t WS_BONUS = WS_YRW + al((size_t)T * 512 * 2);
constexpr size_t WS_XN = WS_BONUS + al((size_t)T * 8 * 4);
constexpr size_t WS_US5 = WS_XN + al((size_t)T * D * 2);
constexpr size_t WS_ALORA = WS_US5 + al((size_t)32 * S5ROWS * LDU * 2);
constexpr size_t WS_SLOC = WS_ALORA + al((size_t)T * 256 * 2);
constexpr int RW_NCH = 128 * 64;
constexpr size_t CHK_BYTES = (size_t)RW_NCH * 4096 * 2;
constexpr size_t WS_CHK_M = WS_XN, WS_CHK_N0T = WS_CHK_M + CHK_BYTES, WS_CHK_Q = WS_CHK_N0T + CHK_BYTES, WS_CHK_Y0T = WS_CHK_Q + CHK_BYTES, WS_CHK_HT = WS_CHK_Y0T + CHK_BYTES;
constexpr size_t WS_MIX_END0 = WS_SLOC + al((size_t)32 * S5ROWS * 128 * 4);
constexpr size_t WS_MIX_END = (WS_CHK_HT + CHK_BYTES) > WS_MIX_END0 ? (WS_CHK_HT + CHK_BYTES) : WS_MIX_END0;
constexpr size_t WS_HB = WS_SHARED;
constexpr size_t WS_W1 = WS_HB + al((size_t)T * D * 2);
constexpr size_t WS_W2 = WS_W1 + al((size_t)32 * 2048 * 1024);
constexpr size_t WS_RS = WS_W2 + al((size_t)32 * 1024 * 1024);
constexpr size_t WS_LOG = WS_RS + al((size_t)T * 4);
constexpr size_t WS_EPOS = WS_LOG + al((size_t)T * 32 * 4);
constexpr size_t WS_GATEV = WS_EPOS + al((size_t)T * 4 * 4);
constexpr size_t WS_SLOT = WS_GATEV + al((size_t)T * 4 * 4);
constexpr size_t WS_ROWG = WS_SLOT + al((size_t)T * 4 * 4);
constexpr size_t WS_ROWTOK = WS_ROWG + al((size_t)NPASS * MAXTILES * 256 * 4);
constexpr size_t WS_TILEE = WS_ROWTOK + al((size_t)NPASS * MAXTILES * 256 * 4);
constexpr int TE_STRIDE = MAXTILES + 64;
constexpr size_t WS_XS = WS_TILEE + al((size_t)NPASS * (MAXTILES + 64) * 4);
constexpr size_t PASS_BUF = al((size_t)MAXTILES * 256 * 1024);
constexpr size_t WS_ACT = WS_XS + NPASS * PASS_BUF;
constexpr size_t WS_XN2F8 = WS_ACT + NPASS * PASS_BUF;
constexpr size_t WS_MOE_END = WS_XN2F8 + al((size_t)T * D);
static_assert(WS_W2 + (size_t)32 * 1024 * 1024 <= WS_SHARED + (size_t)T * RWC * 2, "converted expert weights must stay inside the (dead) PRW buffer while the GLU/Wo/out GEMM phases run");
constexpr size_t WS_END = WS_MIX_END > WS_MOE_END ? WS_MIX_END : WS_MOE_END;
static_assert(WS_END <= ((size_t)1 << 30), "workspace over 1 GiB");

constexpr int CW_BAR = 0;
constexpr int CW_GCNT = 4096;

constexpr float F8_SX = 16.f, F8_SW = 32.f, F8_SA = 4.f, F8_SY = 32.f;
constexpr int LDS_BYTES = 144 * 1024;
constexpr int MISC_OFF = 140 * 1024;

typedef __bf16 bf16x2_t __attribute__((ext_vector_type(2)));
DI unsigned cvt_pk_bf16(float lo, float hi) { f32x2 v = {lo, hi}; bf16x2_t b = __builtin_convertvector(v, bf16x2_t); return __builtin_bit_cast(unsigned, b); }
DI unsigned pk4_fp8(float a, float b, float c, float d) {
    a = fminf(fmaxf(a, -448.f), 448.f); b = fminf(fmaxf(b, -448.f), 448.f); c = fminf(fmaxf(c, -448.f), 448.f); d = fminf(fmaxf(d, -448.f), 448.f);
    int w = __builtin_amdgcn_cvt_pk_fp8_f32(a, b, 0, false); w = __builtin_amdgcn_cvt_pk_fp8_f32(c, d, w, true); return (unsigned)w; }
DI float bf_lo(unsigned u) { return __uint_as_float(u << 16); }
DI float bf_hi(unsigned u) { return __uint_as_float(u & 0xffff0000u); }
DI float bf2f(bf16_t b) { return __uint_as_float(((unsigned)b) << 16); }
DI bf16_t f2bf(float f) { return (bf16_t)(cvt_pk_bf16(f, 0.f) & 0xffffu); }
DI float fsigmoid(float x) { return __builtin_amdgcn_rcpf(1.0f + __expf(-x)); }
DI float ftanh(float x) { float e = __expf(2.0f * x); return 1.0f - 2.0f * __builtin_amdgcn_rcpf(e + 1.0f); }
DI float fgelu_tanh(float x) { float u = 0.7978845608f * (x + 0.044715f * x * x * x); return x * fsigmoid(2.0f * u); }
DI f32x2 lo2(const f32x4& v) { return __builtin_shufflevector(v, v, 0, 1); }
DI f32x2 hi2(const f32x4& v) { return __builtin_shufflevector(v, v, 2, 3); }
DI f32x2 pk_sigmoid_scaled(f32x2 x, float negk) {
    const f32x2 t = x * negk; f32x2 e; e.x = __builtin_amdgcn_exp2f(t.x); e.y = __builtin_amdgcn_exp2f(t.y);
    const f32x2 d = e + 1.0f; f32x2 r; r.x = __builtin_amdgcn_rcpf(d.x); r.y = __builtin_amdgcn_rcpf(d.y); return r; }
DI f32x2 pk_sigmoid(f32x2 x) { return pk_sigmoid_scaled(x, -1.44269504f); }
DI f32x2 pk_gelu_tanh(f32x2 x) { const f32x2 x2 = x * x; const f32x2 u = x * (x2 * (0.044715f * 0.7978845608f) + 0.7978845608f); return x * pk_sigmoid_scaled(u, -2.0f * 1.44269504f); }
DI unsigned pk4_fp8_nc(f32x2 a, f32x2 b) { int w = __builtin_amdgcn_cvt_pk_fp8_f32(a.x, a.y, 0, false); w = __builtin_amdgcn_cvt_pk_fp8_f32(b.x, b.y, w, true); return (unsigned)w; }
#define DPP_ROR_ADD(v, n) ((v) + __builtin_bit_cast(float, __builtin_amdgcn_update_dpp(0, __builtin_bit_cast(int, (v)), 0x120 + (n), 0xf, 0xf, false)))
DI float row_sum16(float v) { v = DPP_ROR_ADD(v, 8); v = DPP_ROR_ADD(v, 4); v = DPP_ROR_ADD(v, 2); v = DPP_ROR_ADD(v, 1); return v; }
DI float xrow_sum(float x) {
    float y = x;
    asm("s_nop 1\n\tv_permlane16_swap_b32 %0, %1\n\ts_nop 1" : "+v"(x), "+v"(y));
    x = x + y; y = x;
    asm("s_nop 1\n\tv_permlane32_swap_b32 %0, %1\n\ts_nop 1" : "+v"(x), "+v"(y));
    return x + y;
}
DI float wave_sum(float v) { return xrow_sum(row_sum16(v)); }
DI float sum16(float v) {
    v += __shfl_xor(v, 1); v += __shfl_xor(v, 2); v += __shfl_xor(v, 4); v += __shfl_xor(v, 8); return v;
}

#define XB_TMO      128
#define XB_XCNT(j)  (256  + 64 * (j))
#define XB_XSUB(j)  (1280 + 64 * (j))
#define XB_XGEN(j)  (2304 + 64 * (j))
#define XB_TOP      3328
#define XB_TOPGEN   3392
#define XCD_BAR_WORDS 3456
#define XB_SPIN_CAP (1u << 22)
DI unsigned xb_ld(unsigned* p)              { return __hip_atomic_load(p, __ATOMIC_RELAXED, __HIP_MEMORY_SCOPE_AGENT); }
DI unsigned xb_add(unsigned* p, unsigned v) { return __hip_atomic_fetch_add(p, v, __ATOMIC_RELAXED, __HIP_MEMORY_SCOPE_AGENT); }
DI unsigned xb_xcc_id() { return (unsigned)__builtin_amdgcn_s_getreg((3 << 11) | 20) & 0xFu; }
#define XB_SPIN(cond, bar) do { unsigned _sp = 0; while (cond) { __builtin_amdgcn_s_sleep(1); \
    if ((++_sp & 255u) == 0u) { if (xb_ld(&(bar)[XB_TMO])) break; if (_sp > XB_SPIN_CAP) { atomicAdd(&(bar)[XB_TMO], 1u); break; } } } } while (0)
struct XcdBarrier { unsigned* bar; unsigned x; volatile LAS unsigned* st; };
DI XcdBarrier xcd_barrier_post(unsigned* bar, volatile LAS unsigned* st) {
    XcdBarrier b; b.bar = bar; b.x = xb_xcc_id(); b.st = st;
    if (threadIdx.x == 0) (void)xb_add(&bar[XB_XCNT(b.x)], 1u);
    return b;
}
DI void xcd_barrier_complete(unsigned* bar, unsigned x, unsigned& nloc, unsigned& nx) {
    const unsigned G = gridDim.x * gridDim.y * gridDim.z;
    unsigned sum, cnt, mine, sp = 0u;
    for (;;) {
        sum = 0u; cnt = 0u; mine = 0u;
#pragma unroll
        for (unsigned j = 0; j < 16; ++j) { const unsigned c = xb_ld(&bar[XB_XCNT(j)]); sum += c; cnt += (c > 0u) ? 1u : 0u; mine = (j == x) ? c : mine; }
        if (sum == G) break;
        __builtin_amdgcn_s_sleep(1);
        if ((++sp & 255u) == 0u) { if (xb_ld(&bar[XB_TMO])) break; if (sp > XB_SPIN_CAP) { atomicAdd(&bar[XB_TMO], 1u); break; } }
    }
    nloc = mine > 0u ? mine : 1u; nx = cnt > 0u ? cnt : 1u;
}
DI void xcd_barrier(const XcdBarrier& b) {
    asm volatile("s_waitcnt vmcnt(0)" ::: "memory");
    __syncthreads();
    if (threadIdx.x == 0) {
        unsigned* bar = b.bar;
        __builtin_amdgcn_s_waitcnt(0);
        unsigned nloc = b.st[0], nx = b.st[1];
        if (nloc == 0u) { xcd_barrier_complete(bar, b.x, nloc, nx); b.st[0] = nloc; b.st[1] = nx; }
        const unsigned old = xb_add(&bar[XB_XSUB(b.x)], 1u);
        const unsigned gen = old / nloc;
        if (old + 1u == (gen + 1u) * nloc) {
            __builtin_amdgcn_fence(__ATOMIC_RELEASE, "agent");
            asm volatile("s_waitcnt vmcnt(0)" ::: "memory");
            const unsigned og = xb_add(&bar[XB_TOP], 1u);
            const unsigned tg = og / nx;
            if (og + 1u == (tg + 1u) * nx) xb_add(&bar[XB_TOPGEN], 1u);
            else XB_SPIN(xb_ld(&bar[XB_TOPGEN]) == tg, bar);
            __builtin_amdgcn_fence(__ATOMIC_ACQUIRE, "agent");
            xb_add(&bar[XB_XGEN(b.x)], 1u);
            asm volatile("s_waitcnt vmcnt(0)" ::: "memory");
        } else {
            XB_SPIN(xb_ld(&bar[XB_XGEN(b.x)]) == gen, bar);
            __builtin_amdgcn_fence(__ATOMIC_ACQUIRE, "agent");
            asm volatile("s_waitcnt vmcnt(0)" ::: "memory");
        }
    }
    __syncthreads();
}

constexpr int BM = 256, BK = 64, HALF = 128, HTB = HALF * BK * 2;
DI int lds_byte(int r, int c) { const int st = (r >> 4) * 2 + (c >> 5), rr = r & 15, cc = c & 31, ob = rr * 64 + cc * 2; return st * 1024 + (ob ^ (((ob >> 9) & 1) << 5)); }
DI void stage_rc(int b, int& R, int& C) { const int st = b / 1024, sb = b % 1024, swz = sb ^ (((sb >> 9) & 1) << 5); R = (st >> 1) * 16 + swz / 64; C = (st & 1) * 32 + (swz % 64) / 2; }
DI int perm32(int rho) { const int n = rho >> 4, i = rho & 15; return 8 * (i >> 2) + 4 * n + (i & 3); }
struct Unit { int pm, pn, aux; };

template <class Sched, class Epi>
DI void gemm_phase(LAS unsigned char* lds, const Sched& S, const Epi& E) {
    const int tid = threadIdx.x, wid = __builtin_amdgcn_readfirstlane(tid >> 6), lane = tid & 63, wr = wid >> 2, wc = wid & 3, fr = lane & 15, fq = lane >> 4;
    const int K = S.K, nt = K / BK;
    unsigned voffA[2], voffB[2];
#pragma unroll
    for (int i = 0; i < 2; ++i) { int R, C; stage_rc(tid * 16 + i * 8192, R, C); const int Rb = Epi::PERM ? ((R & ~31) + perm32(R & 31)) : R;
        voffA[i] = (unsigned)(R * S.lda + C) * 2u; voffB[i] = (unsigned)(Rb * S.ldb + C) * 2u; }
    const size_t kstep = (size_t)(BK * 2);
    const size_t hstepA = (size_t)HALF * S.lda * 2, hstepB = (size_t)HALF * S.ldb * 2;
    const unsigned ldsw = (unsigned)wid * 1024u;
    const int aoff = lds_byte(wr * 64 + fr, fq * 8), boff = lds_byte(wc * 32 + fr, fq * 8);
#define PG8_SA(b, h) (((b) * 2 + (h)) * HTB)
#define PG8_SB(b, h) ((4 + (b) * 2 + (h)) * HTB)
    const unsigned ldsbase = (unsigned)(size_t)lds;
#define PG8_STAGE(bufoff, gbase, voff) do { _Pragma("unroll") for (int _i = 0; _i < 2; ++_i) \
        asm volatile("s_mov_b32 m0, %0\n\ts_nop 0\n\tglobal_load_lds_dwordx4 %1, %2" :: "s"(ldsbase + (unsigned)(bufoff) + ldsw + (unsigned)(_i * 8192)), "v"((voff)[_i]), "s"((const char*)(gbase)) : "memory"); } while (0)
#define PG8_LDA(dst, b, h) do { _Pragma("unroll") for (int m = 0; m < 4; ++m) _Pragma("unroll") for (int k = 0; k < 2; ++k) dst[m][k] = *(const LAS bf16x8*)(lds + PG8_SA(b, h) + aoff + m * 2048 + k * 1024); } while (0)
#define PG8_LDB(dst, b, h) do { _Pragma("unroll") for (int n = 0; n < 2; ++n) _Pragma("unroll") for (int k = 0; k < 2; ++k) dst[n][k] = *(const LAS bf16x8*)(lds + PG8_SB(b, h) + boff + n * 2048 + k * 1024); } while (0)
#define PG8_MMA(ai, bj, At, Bt) do { __builtin_amdgcn_s_setprio(1); _Pragma("unroll") for (int m = 0; m < 4; ++m) _Pragma("unroll") for (int n = 0; n < 2; ++n) _Pragma("unroll") for (int k = 0; k < 2; ++k) \
        acc[ai][bj][m][n] = __builtin_amdgcn_mfma_f32_16x16x32_bf16(Bt[n][k], At[m][k], acc[ai][bj][m][n], 0, 0, 0); __builtin_amdgcn_s_setprio(0); } while (0)
#define PG8_WAIT_V(n) asm volatile("s_waitcnt vmcnt(" #n ")" ::: "memory")
#define PG8_WAIT_L(n) asm volatile("s_waitcnt lgkmcnt(" #n ")" ::: "memory")
#define PG8_BAR __builtin_amdgcn_s_barrier()
#define PG8_SCHED __builtin_amdgcn_sched_barrier(0)
    Unit cur, nxt; int ui = 0;
    if (!S.next(0, cur)) return;
    f32x4 acc[2][2][4][2];
#pragma unroll
    for (int a = 0; a < 2; ++a)
#pragma unroll
        for (int b = 0; b < 2; ++b)
#pragma unroll
            for (int m = 0; m < 4; ++m)
#pragma unroll
                for (int n = 0; n < 2; ++n) { if constexpr (Sched::FP8) { f32x2 z0_, z1_; asm volatile("v_pk_mov_b32 %0, 0, 0" : "=v"(z0_)); asm volatile("v_pk_mov_b32 %0, 0, 0" : "=v"(z1_)); acc[a][b][m][n] = (f32x4){z0_.x, z0_.y, z1_.x, z1_.y}; } else acc[a][b][m][n] = (f32x4){0.f, 0.f, 0.f, 0.f}; }
    bf16x8 At[4][2], B0[2][2], B1[2][2];
    i32x8 At8[4], B08[2], B18[2];
    const int aoff8a = lds_byte(wr * 64 + fr, 16 * fq) & ~16, boff8a = lds_byte(wc * 32 + fr, 16 * fq) & ~16;
#define PG8_LDA8(dst, b, h) do { _Pragma("unroll") for (int m = 0; m < 4; ++m) dst[m] = *(const LAS i32x8*)(lds + PG8_SA(b, h) + aoff8a + m * 2048); } while (0)
#define PG8_LDB8(dst, b, h) do { _Pragma("unroll") for (int n = 0; n < 2; ++n) dst[n] = *(const LAS i32x8*)(lds + PG8_SB(b, h) + boff8a + n * 2048); } while (0)
#define PG8_MMA8(ai, bj, At_, Bt_) do { __builtin_amdgcn_s_setprio(1); _Pragma("unroll") for (int m = 0; m < 4; ++m) _Pragma("unroll") for (int n = 0; n < 2; ++n) \
        acc[ai][bj][m][n] = __builtin_amdgcn_mfma_scale_f32_16x16x128_f8f6f4(Bt_[n], At_[m], acc[ai][bj][m][n], 0, 0, 0, 0x7f7f7f7f, 0, 0x7f7f7f7f); __builtin_amdgcn_s_setprio(0); } while (0)
#define XLDA(b, h) do { if constexpr (Sched::FP8) PG8_LDA8(At8, b, h); else PG8_LDA(At, b, h); } while (0)
#define XLDB0(b, h) do { if constexpr (Sched::FP8) PG8_LDB8(B08, b, h); else PG8_LDB(B0, b, h); } while (0)
#define XLDB1(b, h) do { if constexpr (Sched::FP8) PG8_LDB8(B18, b, h); else PG8_LDB(B1, b, h); } while (0)
#define XMMA0(ai, bj) do { if constexpr (Sched::FP8) PG8_MMA8(ai, bj, At8, B08); else PG8_MMA(ai, bj, At, B0); } while (0)
#define XMMA1(ai, bj) do { if constexpr (Sched::FP8) PG8_MMA8(ai, bj, At8, B18); else PG8_MMA(ai, bj, At, B1); } while (0)
    const char* cA = S.a_ptr(cur); const char* cB = S.b_ptr(cur);
    unsigned offA[2][2], offN[2][2];
    if constexpr (Sched::GATHER) {
#pragma unroll
        for (int h = 0; h < 2; ++h)
#pragma unroll
            for (int i = 0; i < 2; ++i) { int R, C; stage_rc(tid * 16 + i * 8192, R, C); offA[h][i] = S.a_rowoff(cur, h * HALF + R) + (unsigned)C * 2u; offN[h][i] = offA[h][i]; }
    }
#define A_STG(bufoff, plainptr, kt, h, nx) do { if constexpr (Sched::GATHER) { PG8_STAGE(bufoff, cA + (size_t)(kt) * kstep, offA[h]); } \
        else PG8_STAGE(bufoff, plainptr, voffA); } while (0)
    if constexpr (GEMM_SP2) {
        PG8_STAGE(PG8_SB(0, 0), cB, voffB); PG8_STAGE(PG8_SB(0, 1), cB + hstepB, voffB); A_STG(PG8_SA(0, 0), cA, 0, 0, false); A_STG(PG8_SA(0, 1), cA + hstepA, 0, 1, false);
        if (wr == 1) PG8_BAR;
        PG8_WAIT_V(2); PG8_BAR;
        PG8_STAGE(PG8_SB(1, 0), cB + kstep, voffB); A_STG(PG8_SA(1, 0), cA + kstep, 1, 0, false); PG8_STAGE(PG8_SB(1, 1), cB + hstepB + kstep, voffB);
        PG8_WAIT_V(6); PG8_BAR;
    } else {
    PG8_STAGE(PG8_SB(0, 0), cB, voffB); A_STG(PG8_SA(0, 0), cA, 0, 0, false); PG8_STAGE(PG8_SB(0, 1), cB + hstepB, voffB); A_STG(PG8_SA(0, 1), cA + hstepA, 0, 1, false);
    if (wr == 1) PG8_BAR;
    PG8_WAIT_V(4); PG8_BAR;
    PG8_STAGE(PG8_SB(1, 0), cB + kstep, voffB); A_STG(PG8_SA(1, 0), cA + kstep, 1, 0, false); PG8_STAGE(PG8_SB(1, 1), cB + hstepB + kstep, voffB);
    PG8_WAIT_V(6); PG8_BAR;
    }
    for (;;) {
        const bool has_next = S.next(ui + 1, nxt);
        const char* nA = has_next ? S.a_ptr(nxt) : cA; const char* nB = has_next ? S.b_ptr(nxt) : cB;
        for (int t = 0; t < nt; t += 2) {
            const bool last = (t == nt - 2);
            const char* a1 = cA + (size_t)(t + 1) * kstep;
            const char* a2 = last ? nA : cA + (size_t)(t + 2) * kstep; const char* b2 = last ? nB : cB + (size_t)(t + 2) * kstep;
            const char* a3 = a2 + kstep; const char* b3 = b2 + kstep;
            const int k2 = last ? 0 : t + 2, k3 = k2 + 1;
            if constexpr (GEMM_SP2) {
            XLDB0(0, 0); XLDB1(0, 1); PG8_SCHED; XLDA(0, 0); A_STG(PG8_SA(1, 1), a1 + hstepA, t + 1, 1, false);
            if constexpr (Sched::GATHER) {
                if (has_next && (t == nt - 4 || nt < 4)) {
#pragma unroll
                    for (int h = 0; h < 2; ++h)
#pragma unroll
                        for (int i = 0; i < 2; ++i) { int R, C; stage_rc(tid * 16 + i * 8192, R, C); offN[h][i] = S.a_rowoff(nxt, h * HALF + R) + (unsigned)C * 2u; } }
                if (last && has_next) { offA[0][0] = offN[0][0]; offA[0][1] = offN[0][1]; offA[1][0] = offN[1][0]; offA[1][1] = offN[1][1]; }
            }
            PG8_WAIT_V(8); PG8_WAIT_L(0); PG8_BAR; XMMA0(0, 0); XMMA1(0, 1); PG8_BAR; PG8_SCHED;
            XLDA(0, 1); PG8_STAGE(PG8_SB(0, 0), b2, voffB); PG8_STAGE(PG8_SB(0, 1), b2 + hstepB, voffB); A_STG(PG8_SA(0, 0), a2, k2, 0, last);
            PG8_WAIT_V(8); PG8_WAIT_L(0); PG8_BAR; XMMA0(1, 0); XMMA1(1, 1); PG8_BAR; PG8_SCHED;
            XLDB0(1, 0); XLDB1(1, 1); PG8_SCHED; XLDA(1, 0); A_STG(PG8_SA(0, 1), a2 + hstepA, k2, 1, last);
            PG8_WAIT_V(8); PG8_WAIT_L(0); PG8_BAR; XMMA0(0, 0); XMMA1(0, 1); PG8_BAR; PG8_SCHED;
            XLDA(1, 1); PG8_STAGE(PG8_SB(1, 0), b3, voffB); PG8_STAGE(PG8_SB(1, 1), b3 + hstepB, voffB); A_STG(PG8_SA(1, 0), a3, k3, 0, last);
            PG8_WAIT_V(8); PG8_WAIT_L(0); PG8_BAR; XMMA0(1, 0); XMMA1(1, 1); PG8_BAR; PG8_SCHED;
            } else {
            XLDB0(0, 0); PG8_SCHED; XLDA(0, 0); A_STG(PG8_SA(1, 1), a1 + hstepA, t + 1, 1, false);
            if constexpr (Sched::GATHER) {
                if (has_next && (t == nt - 4 || nt < 4)) {
#pragma unroll
                    for (int h = 0; h < 2; ++h)
#pragma unroll
                        for (int i = 0; i < 2; ++i) { int R, C; stage_rc(tid * 16 + i * 8192, R, C); offN[h][i] = S.a_rowoff(nxt, h * HALF + R) + (unsigned)C * 2u; } }
                if (last && has_next) { offA[0][0] = offN[0][0]; offA[0][1] = offN[0][1]; offA[1][0] = offN[1][0]; offA[1][1] = offN[1][1]; }
            }
            PG8_WAIT_L(8); PG8_BAR; PG8_WAIT_L(0); XMMA0(0, 0); PG8_BAR; PG8_SCHED;
            XLDB1(0, 1); PG8_STAGE(PG8_SB(0, 0), b2, voffB);
            PG8_BAR; PG8_WAIT_L(0); XMMA1(0, 1); PG8_BAR;
            XLDA(0, 1); A_STG(PG8_SA(0, 0), a2, k2, 0, last);
            PG8_BAR; PG8_WAIT_L(0); XMMA0(1, 0); PG8_BAR; PG8_SCHED;
            PG8_STAGE(PG8_SB(0, 1), b2 + hstepB, voffB);
            PG8_WAIT_V(6); PG8_BAR; XMMA1(1, 1); PG8_BAR;
            XLDB0(1, 0); PG8_SCHED; XLDA(1, 0); A_STG(PG8_SA(0, 1), a2 + hstepA, k2, 1, last);
            PG8_WAIT_L(8); PG8_BAR; PG8_WAIT_L(0); XMMA0(0, 0); PG8_BAR; PG8_SCHED;
            XLDB1(1, 1); PG8_STAGE(PG8_SB(1, 0), b3, voffB);
            PG8_BAR; PG8_WAIT_L(0); XMMA1(0, 1); PG8_BAR;
            XLDA(1, 1); A_STG(PG8_SA(1, 0), a3, k3, 0, last);
            PG8_BAR; PG8_WAIT_L(0); XMMA0(1, 0); PG8_BAR; PG8_SCHED;
            PG8_STAGE(PG8_SB(1, 1), b3 + hstepB, voffB);
            PG8_WAIT_V(6); PG8_BAR; XMMA1(1, 1); PG8_BAR;
            }
        }
        if constexpr (GEMM_ALIGN) { if (wr == 0) PG8_BAR; }
        {
            int tz = threadIdx.x; asm volatile("" : "+v"(tz));
            const int wid2 = tz >> 6, lane2 = tz & 63;
            E(acc, cur, wid2 >> 2, wid2 & 3, lane2 & 15, lane2 >> 4); }
        if (!has_next) break;
#pragma unroll
        for (int a = 0; a < 2; ++a)
#pragma unroll
            for (int b = 0; b < 2; ++b)
#pragma unroll
                for (int m = 0; m < 4; ++m)
#pragma unroll
                    for (int n = 0; n < 2; ++n) { if constexpr (Sched::FP8) { f32x2 z0_, z1_; asm volatile("v_pk_mov_b32 %0, 0, 0" : "=v"(z0_)); asm volatile("v_pk_mov_b32 %0, 0, 0" : "=v"(z1_)); acc[a][b][m][n] = (f32x4){z0_.x, z0_.y, z1_.x, z1_.y}; } else acc[a][b][m][n] = (f32x4){0.f, 0.f, 0.f, 0.f}; }
        cur = nxt; cA = nA; cB = nB; ++ui;
        if constexpr (GEMM_ALIGN) { if (wr == 1) PG8_BAR; }
    }
    PG8_WAIT_V(0);
    if constexpr (!GEMM_ALIGN) { if (wr == 0) PG8_BAR; }
    PG8_BAR;
#undef XLDA
#undef XLDB0
#undef XLDB1
#undef XMMA0
#undef XMMA1
#undef PG8_LDA8
#undef PG8_LDB8
#undef PG8_MMA8
#undef A_STG
#undef PG8_SA
#undef PG8_SB
#undef PG8_STAGE
#undef PG8_LDA
#undef PG8_LDB
#undef PG8_MMA
#undef PG8_WAIT_V
#undef PG8_WAIT_L
#undef PG8_BAR
#undef PG8_SCHED
}

struct PlainSched {
    static constexpr bool GATHER = false, FP8 = false;
    const char* A; const char* B; int K, lda, ldb, nM, nN, nwg, G, c; int akoff_pn = 1 << 30, akoff_bytes = 0;
    DI void init(const void* A_, const void* B_, int M, int N, int K_, int lda_, int ldb_, int G_, int c_) { A = (const char*)A_; B = (const char*)B_; K = K_; lda = lda_; ldb = ldb_; nM = M / BM; nN = N / BM; nwg = nM * nN; G = G_; c = c_; }
    DI bool next(int i, Unit& u) const {
        const long L = (long)i * G + c; if (L >= nwg) return false;
        int wgid = (int)L; { const int q = nwg / 8, r = nwg % 8, xcd = wgid % 8, off = wgid / 8; wgid = (xcd < r ? xcd * (q + 1) : r * (q + 1) + (xcd - r) * q) + off; }
        const int nig = 8 * nN, gid = wgid / nig, fm = gid * 8, gsz = (nM - fm) < 8 ? (nM - fm) : 8;
        u.pm = fm + ((wgid % nig) % gsz); u.pn = (wgid % nig) / gsz; u.aux = 0; return true;
    }
    DI const char* a_ptr(const Unit& u) const { return A + (size_t)u.pm * BM * lda * 2 + (u.pn >= akoff_pn ? akoff_bytes : 0); }
    DI const char* b_ptr(const Unit& u) const { return B + (size_t)u.pn * BM * ldb * 2; }
};
struct GroupSched {
    static constexpr bool GATHER = false, FP8 = false;
    const char* A; const char* B; int K, lda, ldb, nMg, nN, nwg, G, c;
    DI void init(const void* A_, const void* B_, int K_, int lda_, int ldb_, int nMg_, int nN_, int G_, int c_) { A = (const char*)A_; B = (const char*)B_; K = K_; lda = lda_; ldb = ldb_; nMg = nMg_; nN = nN_; nwg = 32 * nMg * nN; G = G_; c = c_; }
    DI bool next(int i, Unit& u) const {
        const int L = i * G + c; if (L >= nwg) return false;
        const int per = nMg * nN, g = L / per, rem = L % per; u.pm = g * nMg + rem / nN; u.pn = rem % nN; u.aux = g; return true;
    }
    DI const char* a_ptr(const Unit& u) const { return A + (size_t)u.pm * BM * lda * 2; }
    DI const char* b_ptr(const Unit& u) const { return B + ((size_t)u.aux * nN + u.pn) * BM * ldb * 2; }
};
template <bool GATH>
struct MoeSched {
    static constexpr bool GATHER = GATH, FP8 = true;
    const char* A; const char* B; const int* tile_e; const int* rowtok; int K, lda, ldb, nN, NperE, nwg, G, c;
    DI void init(const void* A_, const void* B_, const int* te, const int* rt, int ntiles, int K_, int nN_, int G_, int c_) { A = (const char*)A_; B = (const char*)B_; tile_e = te; rowtok = rt; K = K_; lda = K_; ldb = K_; nN = nN_; NperE = nN_ * BM; nwg = ntiles * nN_; G = G_; c = c_; }
    DI bool next(int i, Unit& u) const {
        int L = i * G + c; if (L >= nwg) return false;
        if (G == 256 && (i + 1) * G <= nwg) { const int x = c & 7, sl = c >> 3, mt = G / nN / 8;
            L = i * G + (x * mt + sl / nN) * nN + (sl % nN); }
        u.pm = L / nN; u.pn = L % nN; u.aux = __builtin_amdgcn_readfirstlane(__hip_atomic_load(tile_e + u.pm, __ATOMIC_RELAXED, __HIP_MEMORY_SCOPE_AGENT)); return true;
    }
    DI const char* a_ptr(const Unit& u) const { return GATH ? A : A + (size_t)u.pm * BM * lda * 2; }
    DI unsigned a_rowoff(const Unit& u, int row) const { return (unsigned)__hip_atomic_load(rowtok + u.pm * BM + row, __ATOMIC_RELAXED, __HIP_MEMORY_SCOPE_AGENT) * (unsigned)(lda * 2); }
    DI const char* b_ptr(const Unit& u) const { return B + ((size_t)u.aux * NperE + (size_t)u.pn * BM) * ldb * 2; }
};

typedef f32x4 AccT[2][2][4][2];
struct EpiWin {
    static constexpr bool PERM = true;
    bf16_t* us5; bf16_t* prw; bf16_t* gates;
    DI static u32x4 pack8(const f32x4& v0, const f32x4& v1) { u32x4 w; w.x = cvt_pk_bf16(v0[0], v0[1]); w.y = cvt_pk_bf16(v0[2], v0[3]); w.z = cvt_pk_bf16(v1[0], v1[1]); w.w = cvt_pk_bf16(v1[2], v1[3]); return w; }
    DI void operator()(const AccT& acc, const Unit& u, int wr, int wc, int fr, int fq) const {
        if (u.pn < 2) {
#pragma unroll
            for (int ai = 0; ai < 2; ++ai)
#pragma unroll
                for (int m = 0; m < 4; ++m) { const int r = u.pm * BM + ai * HALF + wr * 64 + m * 16 + fr, b = r >> 12, sq = r & 4095, ch = sq / S5L, j = sq % S5L;
#pragma unroll
                    for (int bj = 0; bj < 2; ++bj) { const int c0 = u.pn * BM + bj * HALF + wc * 32 + 8 * fq, g = c0 >> 4, ci = c0 & 15;
                        *(u32x4*)(us5 + ((size_t)(g * S5ROWS + b * S5NC + ch) * LDU + j * 16 + ci)) = pack8(acc[ai][bj][m][0], acc[ai][bj][m][1]); } }
        } else if (u.pn < 9) {
#pragma unroll
            for (int ai = 0; ai < 2; ++ai)
#pragma unroll
                for (int m = 0; m < 4; ++m) { const int r = u.pm * BM + ai * HALF + wr * 64 + m * 16 + fr;
#pragma unroll
                    for (int bj = 0; bj < 2; ++bj) { const int c0 = u.pn * BM + bj * HALF + wc * 32 + 8 * fq;
                        *(u32x4*)(prw + (size_t)r * RWC + (c0 - 512)) = pack8(acc[ai][bj][m][0], acc[ai][bj][m][1]); } }
        } else {
#pragma unroll
            for (int ai = 0; ai < 2; ++ai)
#pragma unroll
                for (int m = 0; m < 4; ++m) { const int r = u.pm * BM + ai * HALF + wr * 64 + m * 16 + fr;
#pragma unroll
                    for (int bj = 0; bj < 2; ++bj) { const int c0 = u.pn * BM + bj * HALF + wc * 32 + 8 * fq;
                        const f32x4& v0 = acc[ai][bj][m][0]; const f32x4& v1 = acc[ai][bj][m][1];
                        const f32x2 a_ = pk_sigmoid(lo2(v0)), b_ = pk_sigmoid(hi2(v0)), c_ = pk_sigmoid(lo2(v1)), d_ = pk_sigmoid(hi2(v1));
                        u32x4 w; w.x = cvt_pk_bf16(a_.x, a_.y); w.y = cvt_pk_bf16(b_.x, b_.y); w.z = cvt_pk_bf16(c_.x, c_.y); w.w = cvt_pk_bf16(d_.x, d_.y);
                        *(u32x4*)(gates + (size_t)r * 2048 + (c0 - 2304)) = w; } }
        }
    }
};
struct EpiS5State {
    static constexpr bool PERM = false;
    float* sloc;
    DI void operator()(const AccT& acc, const Unit& u, int wr, int wc, int fr, int fq) const {
#pragma unroll
        for (int ai = 0; ai < 2; ++ai)
#pragma unroll
            for (int m = 0; m < 4; ++m) {
                const int r = u.pm * BM + ai * HALF + wr * 64 + m * 16 + fr;
#pragma unroll
                for (int n = 0; n < 2; ++n) *(f32x4*)(sloc + (size_t)r * 128 + wc * 32 + 16 * n + 4 * fq) = acc[ai][0][m][n];
            }
    }
};
struct EpiS5Out {
    static constexpr bool PERM = true;
    bf16_t* ys;
    DI void operator()(const AccT& acc, const Unit& u, int wr, int wc, int fr, int fq) const {
        const int g = u.aux;
#pragma unroll
        for (int ai = 0; ai < 2; ++ai)
#pragma unroll
            for (int m = 0; m < 4; ++m) {
                const int r = u.pm * BM + ai * HALF + wr * 64 + m * 16 + fr;
                const int rc = r - g * S5ROWS;
#pragma unroll
                for (int bj = 0; bj < 2; ++bj) {
                    const int c0 = u.pn * BM + bj * HALF + wc * 32 + 8 * fq;
                    const int t = c0 >> 4, co = c0 & 15;
                    const size_t tok = (size_t)rc * S5L + t;
                    f32x4 v0 = acc[ai][bj][m][0], v1 = acc[ai][bj][m][1];
                    { const f32x2 a_ = pk_gelu_tanh(lo2(v0)), b_ = pk_gelu_tanh(hi2(v0)), c_ = pk_gelu_tanh(lo2(v1)), d_ = pk_gelu_tanh(hi2(v1));
                      v0 = (f32x4){a_.x, a_.y, b_.x, b_.y}; v1 = (f32x4){c_.x, c_.y, d_.x, d_.y}; }
                    u32x4 w; w.x = cvt_pk_bf16(v0[0], v0[1]); w.y = cvt_pk_bf16(v0[2], v0[3]); w.z = cvt_pk_bf16(v1[0], v1[1]); w.w = cvt_pk_bf16(v1[2], v1[3]);
                    *(u32x4*)(ys + tok * 512 + g * 16 + co) = w;
                }
            }
    }
};
struct EpiLora {
    static constexpr bool PERM = true;
    bf16_t* lwag; const float* w0; const float* a0;
    DI void operator()(const AccT& acc, const Unit& u, int wr, int wc, int fr, int fq) const {
#pragma unroll
        for (int bj = 0; bj < 2; ++bj) {
            const int c0 = u.pn * BM + bj * HALF + wc * 32 + 8 * fq;
            f32x4 b0 = (f32x4){0.f, 0.f, 0.f, 0.f}, b1 = b0;
            if (c0 < 512) { b0 = *(const f32x4*)(w0 + c0); b1 = *(const f32x4*)(w0 + c0 + 4); } else if (c0 < 1024) { b0 = *(const f32x4*)(a0 + c0 - 512); b1 = *(const f32x4*)(a0 + c0 - 508); }
            const f32x2 bias[4] = {lo2(b0), hi2(b0), lo2(b1), hi2(b1)};
            const float osc = (c0 < 512) ? -0.6065306597f : 1.0f;
            if (c0 < 1024) {
#pragma unroll
                for (int ai = 0; ai < 2; ++ai)
#pragma unroll
                    for (int m = 0; m < 4; ++m) { const int r = u.pm * BM + ai * HALF + wr * 64 + m * 16 + fr; u32x4 w;
#pragma unroll
                        for (int jp = 0; jp < 4; ++jp) { const f32x4& a = acc[ai][bj][m][jp >> 1]; const f32x2 v = pk_sigmoid(((jp & 1) ? hi2(a) : lo2(a)) + bias[jp]) * osc; w[jp] = cvt_pk_bf16(v.x, v.y); }
                        *(u32x4*)(lwag + (size_t)r * 1536 + c0) = w; }
            } else {
#pragma unroll
                for (int ai = 0; ai < 2; ++ai)
#pragma unroll
                    for (int m = 0; m < 4; ++m) { const int r = u.pm * BM + ai * HALF + wr * 64 + m * 16 + fr; u32x4 w;
#pragma unroll
                        for (int jp = 0; jp < 4; ++jp) { const f32x4& a = acc[ai][bj][m][jp >> 1]; const f32x2 v = (jp & 1) ? hi2(a) : lo2(a); w[jp] = cvt_pk_bf16(v.x, v.y); }
                        *(u32x4*)(lwag + (size_t)r * 1536 + c0) = w; }
            }
        }
    }
};
struct EpiGlu {
    static constexpr bool PERM = true;
    bf16_t* mixed; const bf16_t* gates; const float* bglu;
    DI void operator()(const AccT& acc, const Unit& u, int wr, int wc, int fr, int fq) const {
        const int cw = wc * 32 + 8 * fq, j0 = u.pn * 128 + cw;
        const float* bp = bglu + u.pn * 256 + cw;
        const f32x4 ba0 = *(const f32x4*)bp, ba1 = *(const f32x4*)(bp + 4), bb0 = *(const f32x4*)(bp + 128), bb1 = *(const f32x4*)(bp + 132);
        const f32x2 ba[4] = {lo2(ba0), hi2(ba0), lo2(ba1), hi2(ba1)}, bb[4] = {lo2(bb0), hi2(bb0), lo2(bb1), hi2(bb1)};
        u32x4 gw[2][4];
#pragma unroll
        for (int ai = 0; ai < 2; ++ai)
#pragma unroll
            for (int m = 0; m < 4; ++m) gw[ai][m] = *(const u32x4*)(gates + (size_t)(u.pm * BM + ai * HALF + wr * 64 + m * 16 + fr) * 2048 + j0);
#pragma unroll
        for (int ai = 0; ai < 2; ++ai)
#pragma unroll
            for (int m = 0; m < 4; ++m) {
                const int r = u.pm * BM + ai * HALF + wr * 64 + m * 16 + fr;
                u32x4 w;
#pragma unroll
                for (int jp = 0; jp < 4; ++jp) {
                    const f32x4& aa = acc[ai][0][m][jp >> 1]; const f32x4& ab = acc[ai][1][m][jp >> 1];
                    const f32x2 za = ((jp & 1) ? hi2(aa) : lo2(aa)) + ba[jp], zb = ((jp & 1) ? hi2(ab) : lo2(ab)) + bb[jp];
                    const unsigned gwd = gw[ai][m][jp]; const f32x2 gt = {bf_lo(gwd), bf_hi(gwd)};
                    const f32x2 o = (gt * za) * pk_sigmoid(zb);
                    w[jp] = cvt_pk_bf16(o.x, o.y);
                }
                *(u32x4*)(mixed + (size_t)r * 1024 + j0) = w;
            }
    }
};
struct EpiWo {
    static constexpr bool PERM = true;
    bf16_t* mixed; const bf16_t* gates;
    DI void operator()(const AccT& acc, const Unit& u, int wr, int wc, int fr, int fq) const {
#pragma unroll
        for (int ai = 0; ai < 2; ++ai) {
            u32x4 gw[4][2], mw[4][2];
#pragma unroll
            for (int m = 0; m < 4; ++m)
#pragma unroll
                for (int bj = 0; bj < 2; ++bj) { const size_t r = (size_t)(u.pm * BM + ai * HALF + wr * 64 + m * 16 + fr); const int c0 = u.pn * BM + bj * HALF + wc * 32 + 8 * fq;
                    gw[m][bj] = *(const u32x4*)(gates + r * 2048 + 1024 + c0); mw[m][bj] = *(const u32x4*)(mixed + r * 1024 + c0); }
#pragma unroll
            for (int m = 0; m < 4; ++m)
#pragma unroll
                for (int bj = 0; bj < 2; ++bj) { const size_t r = (size_t)(u.pm * BM + ai * HALF + wr * 64 + m * 16 + fr); const int c0 = u.pn * BM + bj * HALF + wc * 32 + 8 * fq;
                    u32x4 w;
#pragma unroll
                    for (int jp = 0; jp < 4; ++jp) { const unsigned gwd = gw[m][bj][jp], mwd = mw[m][bj][jp]; const f32x4& a = acc[ai][bj][m][jp >> 1];
                        const f32x2 o = (f32x2){bf_lo(mwd), bf_hi(mwd)} + (f32x2){bf_lo(gwd), bf_hi(gwd)} * ((jp & 1) ? hi2(a) : lo2(a));
                        w[jp] = cvt_pk_bf16(o.x, o.y); }
                    *(u32x4*)(mixed + r * 1024 + c0) = w; }
        }
    }
};
struct EpiOut {
    static constexpr bool PERM = true;
    bf16_t* hb; const float* x;
    DI void operator()(const AccT& acc, const Unit& u, int wr, int wc, int fr, int fq) const {
#pragma unroll
        for (int ai = 0; ai < 2; ++ai) {
            f32x4 xv[4][2][2];
#pragma unroll
            for (int m = 0; m < 4; ++m) { const size_t r = (size_t)(u.pm * BM + ai * HALF + wr * 64 + m * 16 + fr);
#pragma unroll
                for (int bj = 0; bj < 2; ++bj) { const float* xp = x + r * 1024 + u.pn * BM + bj * HALF + wc * 32 + 8 * fq; xv[m][bj][0] = *(const f32x4*)xp; xv[m][bj][1] = *(const f32x4*)(xp + 4); } }
#pragma unroll
            for (int m = 0; m < 4; ++m) { const size_t r = (size_t)(u.pm * BM + ai * HALF + wr * 64 + m * 16 + fr);
#pragma unroll
                for (int bj = 0; bj < 2; ++bj) { const f32x4 v0 = xv[m][bj][0] + acc[ai][bj][m][0], v1 = xv[m][bj][1] + acc[ai][bj][m][1];
                    u32x4 w; w.x = cvt_pk_bf16(v0[0], v0[1]); w.y = cvt_pk_bf16(v0[2], v0[3]); w.z = cvt_pk_bf16(v1[0], v1[1]); w.w = cvt_pk_bf16(v1[2], v1[3]);
                    *(u32x4*)(hb + r * 1024 + u.pn * BM + bj * HALF + wc * 32 + 8 * fq) = w; } }
        }
    }
};
struct EpiRouter {
    static constexpr bool PERM = false;
    float* logits;
    DI void operator()(const AccT& acc, const Unit& u, int wr, int wc, int fr, int fq) const {
        if (wc != 0) return;
#pragma unroll
        for (int n = 0; n < 2; ++n) {
            const int c = 16 * n + 4 * fq;
#pragma unroll
            for (int ai = 0; ai < 2; ++ai)
#pragma unroll
                for (int m = 0; m < 4; ++m) {
                    const size_t r = (size_t)(u.pm * BM + ai * HALF + wr * 64 + m * 16 + fr);
                    *(f32x4*)(logits + r * 32 + c) = acc[ai][0][m][n];
                }
        }
    }
};
struct EpiMoe1 {
    static constexpr bool PERM = true;
    unsigned char* act; const float* b1p;
    DI void operator()(const AccT& acc, const Unit& u, int wr, int wc, int fr, int fq) const {
        const int cw = wc * 32 + 8 * fq, j0 = u.pn * 128 + cw;
        const float* bp = b1p + (size_t)u.aux * 2048 + u.pn * 256 + cw;
        const f32x4 ba0 = *(const f32x4*)bp, ba1 = *(const f32x4*)(bp + 4), bb0 = *(const f32x4*)(bp + 128), bb1 = *(const f32x4*)(bp + 132);
        const f32x2 ba[4] = {lo2(ba0), hi2(ba0), lo2(ba1), hi2(ba1)}, bb[4] = {lo2(bb0), hi2(bb0), lo2(bb1), hi2(bb1)};
        constexpr float sc = 1.0f / (F8_SX * F8_SW);
#pragma unroll
        for (int ai = 0; ai < 2; ++ai)
#pragma unroll
            for (int m = 0; m < 4; ++m) {
                const size_t r = (size_t)(u.pm * BM + ai * HALF + wr * 64 + m * 16 + fr);
                f32x2 o[4];
#pragma unroll
                for (int jp = 0; jp < 4; ++jp) {
                    const f32x4& ag = acc[ai][0][m][jp >> 1]; const f32x4& al_ = acc[ai][1][m][jp >> 1];
                    const f32x2 g = ((jp & 1) ? hi2(ag) : lo2(ag)) * sc + ba[jp], l = ((jp & 1) ? hi2(al_) : lo2(al_)) * sc + bb[jp];
                    const f32x2 xg = __builtin_elementwise_min(g, (f32x2){7.0f, 7.0f});
                    const f32x2 xl = __builtin_elementwise_min(__builtin_elementwise_max(l, (f32x2){-7.0f, -7.0f}), (f32x2){7.0f, 7.0f});
                    o[jp] = (xg * pk_sigmoid_scaled(xg, -1.702f * 1.44269504f)) * (xl * F8_SA + F8_SA);
                }
                u32x2 w; w.x = pk4_fp8_nc(o[0], o[1]); w.y = pk4_fp8_nc(o[2], o[3]);
                *(u32x2*)(act + r * 1024 + j0) = w;
            }
    }
};
struct EpiMoe2 {
    static constexpr bool PERM = true;
    unsigned char* y2; const float* b2; const float* rowg;
    DI void operator()(const AccT& acc, const Unit& u, int wr, int wc, int fr, int fq) const {
        float gt[2][4];
#pragma unroll
        for (int ai = 0; ai < 2; ++ai)
#pragma unroll
            for (int m = 0; m < 4; ++m) gt[ai][m] = rowg[(size_t)(u.pm * BM + ai * HALF + wr * 64 + m * 16 + fr)] * F8_SY;
#pragma unroll
        for (int bj = 0; bj < 2; ++bj) {
            const int c0 = u.pn * BM + bj * HALF + wc * 32 + 8 * fq;
            const f32x4 bva = *(const f32x4*)(b2 + (size_t)u.aux * 1024 + c0), bvb = *(const f32x4*)(b2 + (size_t)u.aux * 1024 + c0 + 4);
            const f32x2 bv[4] = {lo2(bva), hi2(bva), lo2(bvb), hi2(bvb)};
#pragma unroll
            for (int ai = 0; ai < 2; ++ai)
#pragma unroll
                for (int m = 0; m < 4; ++m) {
                    const size_t r = (size_t)(u.pm * BM + ai * HALF + wr * 64 + m * 16 + fr);
                    const float g = gt[ai][m];
                    f32x2 o[4];
#pragma unroll
                    for (int jp = 0; jp < 4; ++jp) { const f32x4& a = acc[ai][bj][m][jp >> 1];
                        o[jp] = (((jp & 1) ? hi2(a) : lo2(a)) * (1.0f / (F8_SA * F8_SW)) + bv[jp]) * g;
                        o[jp] = __builtin_elementwise_min(__builtin_elementwise_max(o[jp], (f32x2){-448.f, -448.f}), (f32x2){448.f, 448.f}); }
                    u32x2 w; w.x = pk4_fp8_nc(o[0], o[1]); w.y = pk4_fp8_nc(o[2], o[3]);
                    *(u32x2*)(y2 + r * 1024 + c0) = w;
                }
        }
    }
};
struct KArgs { const float* in[34]; float* out; unsigned char* ws; int ph_lo, ph_hi; };
struct Frame {
    LAS unsigned char* lds; int tid, lane, wave, G, bid;
    const float* const* in; float* out; unsigned char* ws;
};

template <class MP>
DI void conv_T(const Frame& F, const float* src, size_t src_bstride, int ld, bf16_t* dst, int N, int K, int nbatch, MP mp, int t0 = 0, int t1 = 0x7fffffff) {
    LAS unsigned* tile = (LAS unsigned*)F.lds;
    const int ntk = K / 64, ntn = N / 256, per = ntk * ntn;
    const int tend = (per * nbatch) < t1 ? (per * nbatch) : t1;
    for (int t = t0 + F.bid; t < tend; t += F.G) {
        const int bt = t / per, tt = t % per, tk = tt % ntk, pn = tt / ntk;
        const float* s = src + (size_t)bt * src_bstride + (size_t)(tk * 64) * ld + mp.src(pn, F.lane);
        f32x4 va[4], vb[4];
#pragma unroll
        for (int i = 0; i < 4; ++i) { const int kp = F.wave + 8 * i; va[i] = *(const f32x4*)(s + (size_t)(2 * kp) * ld); vb[i] = *(const f32x4*)(s + (size_t)(2 * kp + 1) * ld); }
#pragma unroll
        for (int i = 0; i < 4; ++i) { const int kp = F.wave + 8 * i;
#pragma unroll
            for (int j = 0; j < 4; ++j) tile[mp.dst(F.lane, j) * 33 + kp] = cvt_pk_bf16(va[i][j], vb[i][j]); }
        __syncthreads();
        unsigned* d = (unsigned*)(dst + (size_t)bt * N * K + (size_t)(pn * 256) * K + tk * 64);
#pragma unroll
        for (int i = 0; i < 4; ++i) { const int pc = F.tid + NTHR * i, nn = pc >> 3, seg = pc & 7;
            u32x4 w; w.x = tile[nn * 33 + seg * 4]; w.y = tile[nn * 33 + seg * 4 + 1]; w.z = tile[nn * 33 + seg * 4 + 2]; w.w = tile[nn * 33 + seg * 4 + 3];
            *(u32x4*)(d + ((size_t)nn * K) / 2 + seg * 4) = w; }
        __syncthreads();
    }
}
template <class MP>
DI void conv_T8(const Frame& F, const float* src, size_t src_bstride, int ld, unsigned char* dst, int N, int K, int nbatch, MP mp, float scale, int t0 = 0, int t1 = 0x7fffffff) {
    LAS unsigned* tile = (LAS unsigned*)F.lds;
    const int ntk = K / 64, ntn = N / 256, per = ntk * ntn;
    const int tend = (per * nbatch) < t1 ? (per * nbatch) : t1;
    for (int t = t0 + F.bid; t < tend; t += F.G) {
        const int bt = t / per, tt = t % per, tk = tt % ntk, pn = tt / ntk;
        const float* s = src + (size_t)bt * src_bstride + (size_t)(tk * 64) * ld + mp.src(pn, F.lane);
        f32x4 v[2][4];
#pragma unroll
        for (int i = 0; i < 2; ++i) { const int kq = F.wave + 8 * i;
#pragma unroll
            for (int e = 0; e < 4; ++e) v[i][e] = *(const f32x4*)(s + (size_t)(4 * kq + e) * ld); }
#pragma unroll
        for (int i = 0; i < 2; ++i) { const int kq = F.wave + 8 * i;
#pragma unroll
            for (int j = 0; j < 4; ++j) tile[mp.dst(F.lane, j) * 17 + kq] = pk4_fp8(v[i][0][j] * scale, v[i][1][j] * scale, v[i][2][j] * scale, v[i][3][j] * scale); }
        __syncthreads();
        unsigned char* d = dst + ((size_t)bt * N + (size_t)pn * 256) * K + tk * 64;
#pragma unroll
        for (int i = 0; i < 2; ++i) { const int pc = F.tid + NTHR * i, nn = pc >> 2, seg = pc & 3;
            u32x4 w; w.x = tile[nn * 17 + seg * 4]; w.y = tile[nn * 17 + seg * 4 + 1]; w.z = tile[nn * 17 + seg * 4 + 2]; w.w = tile[nn * 17 + seg * 4 + 3];
            *(u32x4*)(d + (size_t)nn * K + seg * 16) = w; }
        __syncthreads();
    }
}
struct MpId  { DI int src(int pn, int f) const { return pn * 256 + 4 * f; } DI int dst(int f, int j) const { return 4 * f + j; } };
struct MpSwi { DI int src(int pn, int f) const { return pn * 256 + 4 * f; } DI int dst(int f, int j) const { const int n = 4 * f + j; return (n >> 1) + 128 * (n & 1); } };
struct MpGlu { DI int src(int pn, int f) const { const int w = 4 * f; return pn * 128 + (w & 127) + 1024 * (w >> 7); } DI int dst(int f, int j) const { return 4 * f + j; } };
struct CmGlu { DI int operator()(int n) const { const int pn = n >> 8, w = n & 255; return pn * 128 + (w & 127) + 1024 * (w >> 7); } };
struct CmSwi { DI int operator()(int n) const { const int pn = n >> 8, w = n & 255; return 2 * (pn * 128 + (w & 127)) + (w >> 7); } };

DI void rmsnorm_rows(const Frame& F, const float* x, const float* g, bf16_t* out, int row0, int nrows, unsigned char* out8 = nullptr) {
    const int stride = F.G * NWAVES;
    for (int row = row0 + F.bid * NWAVES + F.wave; row < row0 + nrows; row += 2 * stride) {
        const int row2 = (row + stride < row0 + nrows) ? row + stride : row;
        const f32x4* xr = (const f32x4*)(x + (size_t)row * D); const f32x4* xr2 = (const f32x4*)(x + (size_t)row2 * D);
        f32x4 v[4], u[4]; float ss = 0.f, su = 0.f;
#pragma unroll
        for (int i = 0; i < 4; ++i) { v[i] = xr[i * 64 + F.lane]; u[i] = xr2[i * 64 + F.lane]; }
#pragma unroll
        for (int i = 0; i < 4; ++i) { ss += v[i][0] * v[i][0] + v[i][1] * v[i][1] + v[i][2] * v[i][2] + v[i][3] * v[i][3]; su += u[i][0] * u[i][0] + u[i][1] * u[i][1] + u[i][2] * u[i][2] + u[i][3] * u[i][3]; }
        ss = wave_sum(ss); su = wave_sum(su);
        const float rs = rsqrtf(ss * (1.0f / D) + 1e-5f), ru = rsqrtf(su * (1.0f / D) + 1e-5f);
#pragma unroll
        for (int i = 0; i < 4; ++i) { const f32x4 gv = ((const f32x4*)g)[i * 64 + F.lane];
            u32x2 w; w.x = cvt_pk_bf16(v[i][0] * rs * gv[0], v[i][1] * rs * gv[1]); w.y = cvt_pk_bf16(v[i][2] * rs * gv[2], v[i][3] * rs * gv[3]);
            *(u32x2*)(out + (size_t)row * D + (i * 64 + F.lane) * 4) = w;
            u32x2 w2; w2.x = cvt_pk_bf16(u[i][0] * ru * gv[0], u[i][1] * ru * gv[1]); w2.y = cvt_pk_bf16(u[i][2] * ru * gv[2], u[i][3] * ru * gv[3]);
            *(u32x2*)(out + (size_t)row2 * D + (i * 64 + F.lane) * 4) = w2;
            if (out8) { *(unsigned*)(out8 + (size_t)row * D + (i * 64 + F.lane) * 4) = pk4_fp8(v[i][0] * rs * gv[0] * F8_SX, v[i][1] * rs * gv[1] * F8_SX, v[i][2] * rs * gv[2] * F8_SX, v[i][3] * rs * gv[3] * F8_SX);
                *(unsigned*)(out8 + (size_t)row2 * D + (i * 64 + F.lane) * 4) = pk4_fp8(u[i][0] * ru * gv[0] * F8_SX, u[i][1] * ru * gv[1] * F8_SX, u[i][2] * ru * gv[2] * F8_SX, u[i][3] * ru * gv[3] * F8_SX); } }
    }
}

DI void p0_prologue(const Frame& F) {
    unsigned char* ws = F.ws;
    conv_T(F, F.in[2], 0, INC, (bf16_t*)(ws + WS_WIN), INC, D, 1, MpId());
    conv_T(F, F.in[11], 0, 2048, (bf16_t*)(ws + WS_WGLU), 2048, 512, 1, MpGlu());
    conv_T(F, F.in[24], 0, 1024, (bf16_t*)(ws + WS_WO), 1024, 512, 1, MpId());
    conv_T(F, F.in[25], 0, 1024, (bf16_t*)(ws + WS_WOUT), 1024, 1024, 1, MpId());
    {
        bf16_t* wl = (bf16_t*)(ws + WS_WLORA); const float* w2 = F.in[15]; const float* a2 = F.in[17]; const float* g2 = F.in[18];
        for (int idx = F.bid * NTHR + F.tid; idx < 1536 * 128; idx += F.G * NTHR) { const int n = idx >> 7, k = idx & 127; float v = 0.f;
            if (n < 512) { if (k < 64) v = w2[k * 512 + n]; } else if (n < 1024) { if (k >= 64) v = a2[(k - 64) * 512 + (n - 512)]; } else { v = g2[k * 512 + (n - 1024)]; }
            wl[idx] = f2bf(v); }
        bf16_t* wrt = (bf16_t*)(ws + WS_WR); const float* rw = F.in[27];
        for (int idx = F.bid * NTHR + F.tid; idx < 256 * 1024; idx += F.G * NTHR) { const int n = idx >> 10, k = idx & 1023; wrt[idx] = f2bf(n < 32 ? rw[k * 32 + n] * F.in[26][k] : 0.f); }
        float* bg = (float*)(ws + WS_BGLU); const float* bsrc = F.in[12]; CmGlu cm;
        for (int idx = F.bid * NTHR + F.tid; idx < 2048; idx += F.G * NTHR) bg[idx] = bsrc[cm(idx)];
    }
    if (F.bid & 1) rmsnorm_rows(F, F.in[0], F.in[1], (bf16_t*)(ws + WS_XN), 0, T);
    {
        LAS float* L = (LAS float*)F.lds;
        LAS float* pwr = L, *pwi = L + 64, *p1r = L + 128, *p1i = L + 192, *ffr = L + 256, *ffi = L + 320;
        LAS float* bbr = L + 384, *bbi = bbr + 1024, *ccr = bbi + 1024, *cci = ccr + 1024, *kj = cci + 1024;
        const float* lam_re = F.in[3]; const float* lam_im = F.in[4]; const float* log_dt = F.in[5];
        const float* b_re = F.in[6]; const float* b_im = F.in[7]; const float* c_re = F.in[8]; const float* c_im = F.in[9]; const float* dsk = F.in[10];
        unsigned* toep = (unsigned*)(ws + WS_TOEP); unsigned* wst = (unsigned*)(ws + WS_WST);
        for (int it = F.bid; it < 32 * S5L; it += F.G) {
            const int g = it / S5L, j = it % S5L;
            if (F.tid < 64) { const int p = F.tid; const float lr = lam_re[g * 64 + p], li = lam_im[g * 64 + p], dt = __expf(log_dt[g]);
                float sn, cs; { const float mg = expf((float)j * lr * dt); sincosf((float)j * (li * dt), &sn, &cs); pwr[p] = mg * cs; pwi[p] = mg * sn; }
                { const float mg = expf((float)(j + 1) * lr * dt); sincosf((float)(j + 1) * (li * dt), &sn, &cs); p1r[p] = mg * cs; p1i[p] = mg * sn; }
                { const float mg = expf(lr * dt); sincosf(li * dt, &sn, &cs); const float nr = mg * cs - 1.0f, ni = mg * sn, den = lr * lr + li * li;
                  ffr[p] = (nr * lr + ni * li) / den; ffi[p] = (ni * lr - nr * li) / den; } }
            __syncthreads();
            for (int idx = F.tid; idx < 1024; idx += NTHR) { const int p = idx >> 4; const float br = b_re[g * 1024 + idx], bi = b_im[g * 1024 + idx];
                bbr[idx] = ffr[p] * br - ffi[p] * bi; bbi[idx] = ffr[p] * bi + ffi[p] * br;
                ccr[idx] = c_re[g * 1024 + idx]; cci[idx] = c_im[g * 1024 + idx]; }
            __syncthreads();
            if (F.tid < 256) { const int co = F.tid >> 4, ci = F.tid & 15; float s = 0.f;
                for (int p = 0; p < 64; ++p) { const float zr = pwr[p] * bbr[p * 16 + ci] - pwi[p] * bbi[p * 16 + ci], zi = pwr[p] * bbi[p * 16 + ci] + pwi[p] * bbr[p * 16 + ci];
                    s += ccr[co * 64 + p] * zr - cci[co * 64 + p] * zi; }
                if (j == 0 && co == ci) s += dsk[g * 16 + co];
                kj[F.tid] = s; }
            __syncthreads();
            for (int idx = F.tid; idx < (S5L - j) * 128; idx += NTHR) { const int t = j + idx / 128, rem = idx % 128, co = rem >> 3, ci = (rem & 7) * 2;
                toep[((size_t)(g * 512 + t * 16 + co) * LDU + (t - j) * 16 + ci) / 2] = cvt_pk_bf16(kj[co * 16 + ci], kj[co * 16 + ci + 1]);
                if (j > 0) toep[((size_t)(g * 512 + (t - j) * 16 + co) * LDU + t * 16 + ci) / 2] = 0u; }
            for (int idx = F.tid; idx < 16 * 64; idx += NTHR) { const int co = idx >> 6, q = (idx & 63) * 2; float o[2];
#pragma unroll
                for (int e = 0; e < 2; ++e) { const int qq = q + e, p = qq & 63; const float cr = ccr[co * 64 + p], cim = cci[co * 64 + p];
                    o[e] = (qq < 64) ? (cr * p1r[p] - cim * p1i[p]) : -(cr * p1i[p] + cim * p1r[p]); }
                toep[((size_t)(g * 512 + j * 16 + co) * LDU + 512 + q) / 2] = cvt_pk_bf16(o[0], o[1]); }
            { const int s = S5L - 1 - j;
              for (int idx = F.tid; idx < 256 * 8; idx += NTHR) { const int q = idx >> 3, ci = (idx & 7) * 2; float o[2] = {0.f, 0.f};
                if (q < 128) { const int p = q & 63;
#pragma unroll
                    for (int e = 0; e < 2; ++e) { const float br = bbr[p * 16 + ci + e], bi = bbi[p * 16 + ci + e];
                        o[e] = (q < 64) ? (pwr[p] * br - pwi[p] * bi) : (pwr[p] * bi + pwi[p] * br); } }
                wst[((size_t)(g * 256 + q) * 512 + s * 16 + ci) / 2] = cvt_pk_bf16(o[0], o[1]); } }
            __syncthreads();
        }
    }
    if (!(F.bid & 1)) rmsnorm_rows(F, F.in[0], F.in[1], (bf16_t*)(ws + WS_XN), 0, T);
}

DI void p_rw_prep(const Frame& F) {
    const bf16_t* prw = (const bf16_t*)(F.ws + WS_PRW); bf16_t* al_ = (bf16_t*)(F.ws + WS_ALORA); const float* mu = F.in[13];
    for (int idx = F.bid * NTHR + F.tid; idx < T * 32; idx += F.G * NTHR) {
        const int t = idx >> 5, c8 = (idx & 31) * 8;
        const u32x4 cur = *(const u32x4*)(prw + (size_t)t * RWC + 1536 + c8);
        u32x4 prv = (u32x4){0u, 0u, 0u, 0u};
        if ((t & (SEQ - 1)) != 0) prv = *(const u32x4*)(prw + (size_t)(t - 1) * RWC + 1536 + c8);
        float o[8];
#pragma unroll
        for (int j = 0; j < 8; ++j) { const float c = (j & 1) ? bf_hi(cur[j >> 1]) : bf_lo(cur[j >> 1]), p = (j & 1) ? bf_hi(prv[j >> 1]) : bf_lo(prv[j >> 1]);
            const float xs = c + mu[1536 + c8 + j] * (p - c);
            o[j] = (c8 < 64) ? ftanh(xs) : ((c8 < 128) ? xs : fsigmoid(xs)); }
        u32x4 w; w.x = cvt_pk_bf16(o[0], o[1]); w.y = cvt_pk_bf16(o[2], o[3]); w.z = cvt_pk_bf16(o[4], o[5]); w.w = cvt_pk_bf16(o[6], o[7]);
        *(u32x4*)(al_ + (size_t)t * 256 + c8) = w;
    }
}

DI void p_s5_carry(const Frame& F) {
    const float* lam_re = F.in[3]; const float* lam_im = F.in[4]; const float* log_dt = F.in[5];
    const float* sloc = (const float*)(F.ws + WS_SLOC); bf16_t* us5 = (bf16_t*)(F.ws + WS_US5);
    for (int gt = F.bid * NTHR + F.tid; gt < NB * 32 * 64; gt += F.G * NTHR) {
        const int p = gt & 63, g = (gt >> 6) & 31, b = gt >> 11;
        const float lr = lam_re[g * 64 + p], li = lam_im[g * 64 + p], dt = __expf(log_dt[g]);
        float sn, cs; const float mg = expf((float)S5L * lr * dt); sincosf((float)S5L * (li * dt), &sn, &cs);
        const float ar = mg * cs, ai = mg * sn;
        float xr = 0.f, xi = 0.f;
        const size_t row0 = (size_t)g * S5ROWS + (size_t)b * S5NC;
        for (int cb = 0; cb < S5NC; cb += 16) {
            float sr[16], si[16];
#pragma unroll
            for (int j = 0; j < 16; ++j) { sr[j] = sloc[(row0 + cb + j) * 128 + p]; si[j] = sloc[(row0 + cb + j) * 128 + 64 + p]; }
#pragma unroll
            for (int j = 0; j < 16; ++j) { const size_t row = row0 + cb + j;
                us5[row * LDU + 512 + p] = f2bf(xr); us5[row * LDU + 576 + p] = f2bf(xi);
                const float nr = ar * xr - ai * xi + sr[j], ni = ar * xi + ai * xr + si[j];
                xr = nr; xi = ni; }
        }
    }
}

constexpr int PT = 72, SLOTB = 64 * PT * 2;
DI LAS bf16_t* rslot(LAS unsigned char* lds, int i) { return (LAS bf16_t*)(lds + i * SLOTB); }
DI void mm_acc(f32x4 (&acc)[2], const LAS bf16_t* A, const LAS bf16_t* Bt, int ti, int tj0, int r, int q) {
#pragma unroll
    for (int s2 = 0; s2 < 2; ++s2) {
        const bf16x8 a = *(const LAS bf16x8*)(A + (16 * ti + r) * PT + 32 * s2 + 8 * q);
#pragma unroll
        for (int e = 0; e < 2; ++e) { const bf16x8 b = *(const LAS bf16x8*)(Bt + (16 * (tj0 + e) + r) * PT + 32 * s2 + 8 * q);
            acc[e] = __builtin_amdgcn_mfma_f32_16x16x32_bf16(a, b, acc[e], 0, 0, 0); }
    }
}
DI void mm_acc_bnat(f32x4 (&acc)[2], const LAS bf16_t* A, const LAS bf16_t* Bn, int ti, int tj0, int r, int q) {
#pragma unroll
    for (int s2 = 0; s2 < 2; ++s2) {
        const bf16x8 a = *(const LAS bf16x8*)(A + (16 * ti + r) * PT + 32 * s2 + 8 * q);
#pragma unroll
        for (int e = 0; e < 2; ++e) { bf16x8 b;
#pragma unroll
            for (int jj = 0; jj < 8; ++jj) b[jj] = (short)Bn[(32 * s2 + 8 * q + jj) * PT + 16 * (tj0 + e) + r];
            acc[e] = __builtin_amdgcn_mfma_f32_16x16x32_bf16(a, b, acc[e], 0, 0, 0); }
    }
}
DI void st_rm(LAS bf16_t* Dm, const f32x4& v, int i0, int j) {
#pragma unroll
    for (int g = 0; g < 4; ++g) Dm[(i0 + g) * PT + j] = f2bf(v[g]);
}
DI void st_tr(LAS bf16_t* Dm, const f32x4& v, int i0, int j) { u32x2 w; w.x = cvt_pk_bf16(v[0], v[1]); w.y = cvt_pk_bf16(v[2], v[3]); *(LAS u32x2*)(Dm + j * PT + i0) = w; }
DI f32x4 ld_rm(const LAS bf16_t* Sm, int i0, int j) { f32x4 v;
#pragma unroll
    for (int g = 0; g < 4; ++g) v[g] = bf2f(Sm[(i0 + g) * PT + j]);
    return v; }
DI void ld_frag(bf16x8 (&f)[2], const LAS bf16_t* M, int row, int q) { f[0] = *(const LAS bf16x8*)(M + row * PT + 8 * q); f[1] = *(const LAS bf16x8*)(M + row * PT + 32 + 8 * q); }
DI f32x4 mm2(const bf16x8 (&x)[2], const bf16x8 (&y)[2], f32x4 c) { c = __builtin_amdgcn_mfma_f32_16x16x32_bf16(x[0], y[0], c, 0, 0, 0); return __builtin_amdgcn_mfma_f32_16x16x32_bf16(x[1], y[1], c, 0, 0, 0); }
typedef short v4i16_t __attribute__((ext_vector_type(4)));
DI void ld_frag_tr(bf16x8 (&f)[2], const LAS bf16_t* XT, int T0, int r, int q) {
#pragma unroll
    for (int s2 = 0; s2 < 2; ++s2) { const LAS bf16_t* p = XT + (32 * s2 + 8 * q + (r >> 2)) * PT + T0 + 4 * (r & 3);
        const v4i16_t lo = __builtin_amdgcn_ds_read_tr16_b64_v4i16((LAS v4i16_t*)p), hi = __builtin_amdgcn_ds_read_tr16_b64_v4i16((LAS v4i16_t*)(p + 4 * PT));
        f[s2] = __builtin_shufflevector(lo, hi, 0, 1, 2, 3, 4, 5, 6, 7); }
}
DI void st_sw(LAS bf16_t* Dm, const f32x4& v, int i, int j0) { u32x2 w; w.x = cvt_pk_bf16(v[0], v[1]); w.y = cvt_pk_bf16(v[2], v[3]); *(LAS u32x2*)(Dm + i * PT + j0) = w; }
DI f32x4 ld_sw(const LAS bf16_t* Sm, int i, int j0) { const u32x2 w = *(const LAS u32x2*)(Sm + i * PT + j0); return (f32x4){bf_lo(w.x), bf_hi(w.x), bf_lo(w.y), bf_hi(w.y)}; }
#define ZACC(a) do { a[0] = (f32x4){0.f, 0.f, 0.f, 0.f}; a[1] = (f32x4){0.f, 0.f, 0.f, 0.f}; } while (0)

DI float wave_sum2(float v) { return xrow_sum(row_sum16(v)); }
#define LSYNC() do { asm volatile("s_waitcnt lgkmcnt(0)" ::: "memory"); __builtin_amdgcn_s_barrier(); asm volatile("" ::: "memory"); } while (0)

struct RaRaw { bf16_t r[9], k[9], v[9], lw[8], a[8]; };
DI void ra_load(RaRaw& x, const bf16_t* prw, const bf16_t* lwag, int ci, int w, int lane) {
    const int bh = ci >> 6, c = ci & 63, b = bh >> 3, h = bh & 7, ch = h * 64 + lane;
    const size_t tok0 = (size_t)b * SEQ + c * 64 + 8 * w;
    const bool has_prev = !(c == 0 && w == 0);
    const size_t tp = has_prev ? tok0 - 1 : tok0;
    x.r[0] = prw[tp * RWC + ch]; x.k[0] = prw[tp * RWC + 512 + ch]; x.v[0] = prw[tp * RWC + 1024 + ch];
#pragma unroll
    for (int i = 0; i < 8; ++i) { const size_t tok = tok0 + i;
        x.r[i + 1] = prw[tok * RWC + ch]; x.k[i + 1] = prw[tok * RWC + 512 + ch]; x.v[i + 1] = prw[tok * RWC + 1024 + ch];
        x.lw[i] = lwag[tok * 1536 + ch]; x.a[i] = lwag[tok * 1536 + 512 + ch]; }
}
DI void p_rw_chunk(const Frame& F) {
    const bf16_t* prw = (const bf16_t*)(F.ws + WS_PRW); const bf16_t* lwag = (const bf16_t*)(F.ws + WS_LWAG);
    const float* mu = F.in[13]; const float* k_k = F.in[19]; const float* k_a = F.in[20]; const float* r_k = F.in[21];
    float* bonus = (float*)(F.ws + WS_BONUS);
    bf16_t* gM = (bf16_t*)(F.ws + WS_CHK_M); bf16_t* gN0T = (bf16_t*)(F.ws + WS_CHK_N0T); bf16_t* gQ = (bf16_t*)(F.ws + WS_CHK_Q); bf16_t* gY0 = (bf16_t*)(F.ws + WS_CHK_Y0T);
    LAS unsigned char* lds = F.lds;
    LAS float* segtot = (LAS float*)(lds + 14 * SLOTB);
    LAS float* PLs = segtot + 512;
    LAS float* DB = PLs + 64;
    constexpr int PD = 20;
    constexpr int TP = 24;
    LAS bf16_t* TDT = (LAS bf16_t*)(DB + 64 * PD);
    const int w = F.wave, lane = F.lane, r = lane & 15, q = lane >> 4, ti = w >> 1, tj0 = 2 * (w & 1), i0 = 16 * ti + 4 * q;
    LAS bf16_t* S0 = rslot(lds, 0); LAS bf16_t* S1 = rslot(lds, 1); LAS bf16_t* S2 = rslot(lds, 2); LAS bf16_t* S3 = rslot(lds, 3);
    LAS bf16_t* S4 = rslot(lds, 4); LAS bf16_t* S5 = rslot(lds, 5); LAS bf16_t* S6 = rslot(lds, 6); LAS bf16_t* S7 = rslot(lds, 7);
    LAS bf16_t* S8 = rslot(lds, 8); LAS bf16_t* S9 = rslot(lds, 9); LAS bf16_t* S10 = rslot(lds, 10); LAS bf16_t* S11 = rslot(lds, 11);
    LAS bf16_t* S12 = rslot(lds, 12); LAS bf16_t* S13 = rslot(lds, 13);
    RaRaw raw;
    if (F.bid < RW_NCH) ra_load(raw, prw, lwag, F.bid, w, lane);
    for (int ci = F.bid; ci < RW_NCH; ci += F.G) {
        const int bh = ci >> 6, c = ci & 63, b = bh >> 3, h = bh & 7, ch = h * 64 + lane;
        {
            const size_t tok0 = (size_t)b * SEQ + c * 64 + 8 * w;
            const float mur = mu[ch], muk = mu[512 + ch], muv = mu[1024 + ch], kkw = k_k[ch], ka = k_a[ch], rk = r_k[ch];
            const bool has_prev = !(c == 0 && w == 0);
            float xr[9], xk[9], xv[9];
            xr[0] = has_prev ? bf2f(raw.r[0]) : 0.f; xk[0] = has_prev ? bf2f(raw.k[0]) : 0.f; xv[0] = has_prev ? bf2f(raw.v[0]) : 0.f;
#pragma unroll
            for (int i = 1; i < 9; ++i) { xr[i] = bf2f(raw.r[i]); xk[i] = bf2f(raw.k[i]); xv[i] = bf2f(raw.v[i]); }
            f32x2 rr2[4], vv2[4], aa2[4], km2[4], kn2[4]; float cl[8];
            float run = 0.f;
#pragma unroll
            for (int p2 = 0; p2 < 4; ++p2) {
                const f32x2 cr = {xr[2 * p2 + 1], xr[2 * p2 + 2]}, pr = {xr[2 * p2], xr[2 * p2 + 1]};
                const f32x2 ck = {xk[2 * p2 + 1], xk[2 * p2 + 2]}, pk = {xk[2 * p2], xk[2 * p2 + 1]};
                const f32x2 cv = {xv[2 * p2 + 1], xv[2 * p2 + 2]}, pv = {xv[2 * p2], xv[2 * p2 + 1]};
                const f32x2 r_ = cr + (pr - cr) * mur, k_ = ck + (pk - ck) * muk, v_ = cv + (pv - cv) * muv;
                const f32x2 a_ = {bf2f(raw.a[2 * p2]), bf2f(raw.a[2 * p2 + 1])};
                f32x2 kx = k_ * kkw; const f32x2 sq = kx * kx;
                const float ss0 = wave_sum2(sq.x), ss1 = wave_sum2(sq.y);
                kx = kx * (f32x2){fminf(__builtin_amdgcn_rsqf(ss0), 1e12f), fminf(__builtin_amdgcn_rsqf(ss1), 1e12f)};
                const f32x2 kmod = k_ * (a_ * ka + (1.0f - ka));
                const f32x2 bq = (r_ * kmod) * rk;
                const float bn0 = wave_sum2(bq.x), bn1 = wave_sum2(bq.y);
                if (lane == 0) { bonus[(tok0 + 2 * p2) * 8 + h] = bn0; bonus[(tok0 + 2 * p2 + 1) * 8 + h] = bn1; }
                rr2[p2] = r_; vv2[p2] = v_; aa2[p2] = a_; km2[p2] = kmod; kn2[p2] = kx;
                run += bf2f(raw.lw[2 * p2]); cl[2 * p2] = run; run += bf2f(raw.lw[2 * p2 + 1]); cl[2 * p2 + 1] = run;
            }
            segtot[w * 64 + lane] = run;
            LSYNC();
            float pre = 0.f;
            for (int w2 = 0; w2 < w; ++w2) pre += segtot[w2 * 64 + lane];
            if (w == 7) PLs[lane] = __expf(pre + run);
            float ep = __expf(pre);
            unsigned xa[4], xb[4], xkk[4], xrr[4], xvv[4];
#pragma unroll
            for (int p2 = 0; p2 < 4; ++p2) {
                const f32x2 tt = ((f32x2){cl[2 * p2], cl[2 * p2 + 1]} + pre) * 1.44269504f;
                const f32x2 e = {__builtin_amdgcn_exp2f(tt.x), __builtin_amdgcn_exp2f(tt.y)}, en = {__builtin_amdgcn_rcpf(e.x), __builtin_amdgcn_rcpf(e.y)}, epv = {ep, e.x};
                ep = e.y;
                const f32x2 at = -(kn2[p2] * epv), bt = (kn2[p2] * aa2[p2]) * en, kt = km2[p2] * en, rt = rr2[p2] * e;
                xa[p2] = cvt_pk_bf16(at.x, at.y); xb[p2] = cvt_pk_bf16(bt.x, bt.y); xkk[p2] = cvt_pk_bf16(kt.x, kt.y); xrr[p2] = cvt_pk_bf16(rt.x, rt.y); xvv[p2] = cvt_pk_bf16(vv2[p2].x, vv2[p2].y);
                const int t = 8 * w + 2 * p2;
                S6[t * PT + lane] = (bf16_t)(xrr[p2] & 0xffffu); S6[(t + 1) * PT + lane] = (bf16_t)(xrr[p2] >> 16);
            }
            *(LAS u32x4*)(S1 + lane * PT + 8 * w) = (u32x4){xa[0], xa[1], xa[2], xa[3]};
            *(LAS u32x4*)(S3 + lane * PT + 8 * w) = (u32x4){xb[0], xb[1], xb[2], xb[3]};
            *(LAS u32x4*)(S5 + lane * PT + 8 * w) = (u32x4){xkk[0], xkk[1], xkk[2], xkk[3]};
            *(LAS u32x4*)(S7 + lane * PT + 8 * w) = (u32x4){xvv[0], xvv[1], xvv[2], xvv[3]};
        }
        LSYNC();
        if (ci + F.G < RW_NCH) ra_load(raw, prw, lwag, ci + F.G, w, lane);
        f32x4 acc[2];
        const f32x4 Z4 = (f32x4){0.f, 0.f, 0.f, 0.f};
        const int ia = 16 * ti + r, jb0 = 16 * tj0 + r;
        { bf16x8 a0[2], a6[2], b2[2][2], b4[2][2];
          ld_frag_tr(a0, S1, 16 * ti, r, q); ld_frag(a6, S6, ia, q);
#pragma unroll
          for (int e = 0; e < 2; ++e) { ld_frag_tr(b2[e], S3, 16 * (tj0 + e), r, q); ld_frag_tr(b4[e], S5, 16 * (tj0 + e), r, q); }
#pragma unroll
          for (int e = 0; e < 2; ++e) { const int tj = tj0 + e, j = 16 * tj + r, js = 16 * tj + 4 * q;
            const f32x4 c = mm2(a0, b2[e], Z4);
            if (tj == ti) {
#pragma unroll
                for (int g = 0; g < 4; ++g) DB[(ti * 16 + 4 * q + g) * PD + r] = (4 * q + g > r) ? c[g] : 0.f;
            }
            st_tr(S8, (ti > tj) ? c : Z4, i0, j);
            f32x4 v = mm2(b4[e], a0, Z4);
#pragma unroll
            for (int g = 0; g < 4; ++g) v[g] = (ia > js + g) ? v[g] : 0.f;
            st_sw(S9, v, ia, js);
            v = mm2(b2[e], a6, Z4);
#pragma unroll
            for (int g = 0; g < 4; ++g) v[g] = (ia >= js + g) ? v[g] : 0.f;
            st_sw(S10, v, ia, js);
            v = mm2(b4[e], a6, Z4);
#pragma unroll
            for (int g = 0; g < 4; ++g) v[g] = (ia >= js + g) ? v[g] : 0.f;
            st_sw(S11, v, ia, js); } }
        LSYNC();
        ZACC(acc); mm_acc(acc, S9, S7, ti, tj0, r, q);
#pragma unroll
        for (int e = 0; e < 2; ++e) st_tr(S2, acc[e], i0, 16 * (tj0 + e) + r);
        if (w < 4) {
            const int i = lane >> 2, p = lane & 3;
            const LAS float* Dp = DB + (w * 16 + p) * PD;
            f32x4 Dm[4][4];
#pragma unroll
            for (int m = 0; m < 4; ++m)
#pragma unroll
                for (int c4 = 0; c4 < 4; ++c4) Dm[m][c4] = *(const LAS f32x4*)(Dp + 4 * m * PD + 4 * c4);
            float mine[4] = {0.f, 0.f, 0.f, 0.f}, tr[16];
#pragma unroll
            for (int j = 15; j >= 0; --j) { float part = 0.f;
#pragma unroll
                for (int m = 3; m >= 0; --m) if (4 * m + 3 > j) part = __builtin_fmaf(mine[m], Dm[m][j >> 2][j & 3], part);
                float tot = part + __builtin_bit_cast(float, __builtin_amdgcn_update_dpp(0, __builtin_bit_cast(int, part), 0xB1, 0xf, 0xf, false));
                tot = tot + __builtin_bit_cast(float, __builtin_amdgcn_update_dpp(0, __builtin_bit_cast(int, tot), 0x4E, 0xf, 0xf, false));
                const float trj = (j > i) ? 0.f : ((j == i) ? 1.0f : tot);
                tr[j] = trj; mine[j >> 2] = (p == (j & 3)) ? trj : mine[j >> 2]; }
            u32x4 z = (u32x4){0u, 0u, 0u, 0u}, x0, x1;
            x0.x = cvt_pk_bf16(tr[0], tr[1]); x0.y = cvt_pk_bf16(tr[2], tr[3]); x0.z = cvt_pk_bf16(tr[4], tr[5]); x0.w = cvt_pk_bf16(tr[6], tr[7]);
            x1.x = cvt_pk_bf16(tr[8], tr[9]); x1.y = cvt_pk_bf16(tr[10], tr[11]); x1.z = cvt_pk_bf16(tr[12], tr[13]); x1.w = cvt_pk_bf16(tr[14], tr[15]);
            LAS bf16_t* dst = S0 + (16 * w + i) * PT + 16 * p;
            *(LAS u32x4*)dst = (p == w) ? x0 : z; *(LAS u32x4*)(dst + 8) = (p == w) ? x1 : z;
#pragma unroll
            for (int m = 0; m < 4; ++m) TDT[(16 * w + 4 * m + p) * TP + i] = f2bf(mine[m]);
        }
        LSYNC();
        { bf16x8 a[2], b[2][2]; ld_frag(a, S0, ia, q);
#pragma unroll
          for (int e = 0; e < 2; ++e) ld_frag(b[e], S8, jb0 + 16 * e, q);
#pragma unroll
          for (int e = 0; e < 2; ++e) { st_tr(S12, mm2(a, b[e], Z4), i0, 16 * (tj0 + e) + r); st_sw(S4, mm2(b[e], a, Z4), ia, 16 * (tj0 + e) + 4 * q); } }
        LSYNC();
        { bf16x8 a[2], b[2][2]; ld_frag(a, S4, ia, q);
#pragma unroll
          for (int e = 0; e < 2; ++e) ld_frag(b[e], S12, jb0 + 16 * e, q);
          const bf16x8 as = (w & 1) ? a[1] : a[0];
#pragma unroll
          for (int e = 0; e < 2; ++e) { const int tj = tj0 + e, j = 16 * tj + r, js = 16 * tj + 4 * q;
            st_sw(S13, mm2(b[e], a, Z4), ia, js);
            bf16x8 bt = *(const LAS bf16x8*)(TDT + j * TP + 8 * (q & 1));
            if ((q >> 1) != e) bt = (bf16x8){0, 0, 0, 0, 0, 0, 0, 0};
            f32x4 c = Z4;
            if (ti == tj) { const u32x2 wv = *(const LAS u32x2*)(TDT + j * TP + 4 * q); c = (f32x4){bf_lo(wv.x), bf_hi(wv.x), bf_lo(wv.y), bf_hi(wv.y)}; }
            st_tr(S9, __builtin_amdgcn_mfma_f32_16x16x32_bf16(as, bt, c, 0, 0, 0), i0, j);
            st_sw(S8, __builtin_amdgcn_mfma_f32_16x16x32_bf16(bt, as, ld_sw(S0, ia, js), 0, 0, 0), ia, js); } }
        LSYNC();
        { bf16x8 a[2], b[2][2]; ld_frag(a, S13, ia, q);
#pragma unroll
          for (int e = 0; e < 2; ++e) ld_frag(b[e], S9, jb0 + 16 * e, q);
#pragma unroll
          for (int e = 0; e < 2; ++e) { const int js = 16 * (tj0 + e) + 4 * q; st_sw(S12, mm2(b[e], a, ld_sw(S8, ia, js)), ia, js); } }
        LSYNC();
        { bf16x8 a[2], b1[2][2], bx[2][2]; ld_frag(a, S12, ia, q);
#pragma unroll
          for (int e = 0; e < 2; ++e) { ld_frag(b1[e], S1, jb0 + 16 * e, q); ld_frag(bx[e], S2, jb0 + 16 * e, q); }
#pragma unroll
          for (int e = 0; e < 2; ++e) { const int j = 16 * (tj0 + e) + r; st_tr(S0, mm2(a, b1[e], Z4), i0, j); st_tr(S4, mm2(a, bx[e], Z4), i0, j); } }
        LSYNC();
        { bf16x8 a10[2], a11[2], a3[2], a5[2], b0[2][2], b4[2][2], b7[2][2];
          ld_frag(a10, S10, ia, q); ld_frag(a11, S11, ia, q); ld_frag(a3, S3, ia, q); ld_frag(a5, S5, ia, q);
#pragma unroll
          for (int e = 0; e < 2; ++e) { ld_frag(b0[e], S0, jb0 + 16 * e, q); ld_frag(b4[e], S4, jb0 + 16 * e, q); ld_frag(b7[e], S7, jb0 + 16 * e, q); }
          const float pli = PLs[ia];
          f32x4 plg;
#pragma unroll
          for (int g = 0; g < 4; ++g) plg[g] = PLs[i0 + g];
#pragma unroll
          for (int e = 0; e < 2; ++e) { const int j = 16 * (tj0 + e) + r, js = 16 * (tj0 + e) + 4 * q;
            const f32x4 vq = mm2(b0[e], a10, ld_sw(S6, ia, js));
            const f32x4 vy = mm2(b7[e], a11, mm2(b4[e], a10, Z4));
            f32x4 vm = mm2(b0[e], a3, Z4);
#pragma unroll
            for (int g = 0; g < 4; ++g) vm[g] = pli * (vm[g] + ((ia == js + g) ? 1.0f : 0.f));
            const f32x4 vn = mm2(a5, b7[e], mm2(a3, b4[e], Z4)) * plg;
            st_sw(S1, vq, ia, js); st_sw(S2, vy, ia, js); st_sw(S8, vm, ia, js); st_tr(S9, vn, i0, j); } }
        LSYNC();
        { const int row = F.tid >> 3, seg = (F.tid & 7) * 8; const size_t go = (size_t)ci * 4096 + row * 64 + seg;
          *(u32x4*)(gQ + go) = *(const LAS u32x4*)(S1 + row * PT + seg); *(u32x4*)(gY0 + go) = *(const LAS u32x4*)(S2 + row * PT + seg);
          *(u32x4*)(gM + go) = *(const LAS u32x4*)(S8 + row * PT + seg); *(u32x4*)(gN0T + go) = *(const LAS u32x4*)(S9 + row * PT + seg); }
        LSYNC();
    }
    asm volatile("s_waitcnt vmcnt(0)" ::: "memory");
}

struct ScanOps { u32x2 m[4][2][2]; u32x2 n0[4]; };
DI void scan_load(ScanOps& o, const bf16_t* gM, const bf16_t* gN0T, size_t ci, int col, int q, int v) {
#pragma unroll
    for (int m = 0; m < 4; ++m) {
#pragma unroll
        for (int s2 = 0; s2 < 2; ++s2) { const bf16_t* p = gM + ci * 4096 + (16 * m + col) * 64 + 32 * s2 + 4 * q; o.m[m][s2][0] = *(const u32x2*)p; o.m[m][s2][1] = *(const u32x2*)(p + 16); }
        o.n0[m] = *(const u32x2*)(gN0T + ci * 4096 + v * 64 + 16 * m + 4 * q); }
}
DI void scan_step(const ScanOps& o, f32x4 (&H)[4], bf16_t* gHT, size_t ci, int q, int v) {
    u32x4 bfr[2];
#pragma unroll
    for (int s2 = 0; s2 < 2; ++s2) { bfr[s2].x = cvt_pk_bf16(H[2 * s2][0], H[2 * s2][1]); bfr[s2].y = cvt_pk_bf16(H[2 * s2][2], H[2 * s2][3]);
        bfr[s2].z = cvt_pk_bf16(H[2 * s2 + 1][0], H[2 * s2 + 1][1]); bfr[s2].w = cvt_pk_bf16(H[2 * s2 + 1][2], H[2 * s2 + 1][3]);
        bf16_t* hp = gHT + ci * 4096 + v * 64 + 32 * s2 + 4 * q;
        *(u32x2*)hp = (u32x2){bfr[s2].x, bfr[s2].y}; *(u32x2*)(hp + 16) = (u32x2){bfr[s2].z, bfr[s2].w}; }
#pragma unroll
    for (int m = 0; m < 4; ++m) {
        f32x4 a2 = (f32x4){bf_lo(o.n0[m].x), bf_hi(o.n0[m].x), bf_lo(o.n0[m].y), bf_hi(o.n0[m].y)};
#pragma unroll
        for (int s2 = 0; s2 < 2; ++s2) { const u32x4 af = (u32x4){o.m[m][s2][0].x, o.m[m][s2][0].y, o.m[m][s2][1].x, o.m[m][s2][1].y};
            a2 = __builtin_amdgcn_mfma_f32_16x16x32_bf16(__builtin_bit_cast(bf16x8, af), __builtin_bit_cast(bf16x8, bfr[s2]), a2, 0, 0, 0); }
        H[m] = a2; }
}
constexpr int SC_DEPTH = 10, SC_SLOT = 12288;
DI void scan_dma(unsigned lds_dst, unsigned voff, const char* base) { asm volatile("s_mov_b32 m0, %0\n\ts_nop 0\n\tglobal_load_lds_dwordx4 %1, %2" :: "s"(lds_dst), "v"(voff), "s"(base) : "memory"); }
DI void scan_lds_load(ScanOps& o, const LAS unsigned char* slot, int lbM, int lbN, const int (&xo)[2][2], int c7) {
#pragma unroll
    for (int m = 0; m < 4; ++m) {
#pragma unroll
        for (int s2 = 0; s2 < 2; ++s2) { o.m[m][s2][0] = *(const LAS u32x2*)(slot + lbM + m * 2048 + xo[s2][0]); o.m[m][s2][1] = *(const LAS u32x2*)(slot + lbM + m * 2048 + xo[s2][1]); }
        o.n0[m] = *(const LAS u32x2*)(slot + 8192 + lbN + (((2 * m) << 4) ^ c7)); }
}
DI void p_rw_scan(const Frame& F) {
    const bf16_t* gM = (const bf16_t*)(F.ws + WS_CHK_M); const bf16_t* gN0T = (const bf16_t*)(F.ws + WS_CHK_N0T); bf16_t* gHT = (bf16_t*)(F.ws + WS_CHK_HT);
    const unsigned ldsbase = (unsigned)(size_t)F.lds;
    const int w = F.wave, col = F.lane & 15, q = F.lane >> 4;
    const int lw = w - 2, lt = F.tid - 128;
    const int P1 = (384 + lt) & 511;
    const unsigned voff0 = (unsigned)((lt >> 3) * 128 + (((lt & 7) ^ ((lt >> 3) & 7)) << 4));
    const unsigned voff1 = (unsigned)((P1 >> 3) * 128 + (((P1 & 7) ^ ((P1 >> 3) & 7)) << 4));
    const int c7 = (col & 7) << 4, qh = (q >> 1) << 4;
    const int lbM = col * 128 + 8 * (q & 1), lbN = (16 * (w & 1) + col) * 128 + 8 * (q & 1);
    int xo[2][2];
#pragma unroll
    for (int s2 = 0; s2 < 2; ++s2)
#pragma unroll
        for (int h = 0; h < 2; ++h) xo[s2][h] = (((4 * s2 + 2 * h) << 4) + qh) ^ c7;
    const int c7n = c7 ^ qh;
    for (int p = F.bid; p < 256; p += F.G) {
        const int bh = p >> 1, half = p & 1, v = 32 * half + 16 * (w & 1) + col;
        const size_t c0 = (size_t)bh * 64;
        const char* baseM = (const char*)(gM + c0 * 4096);
        const char* baseN = (const char*)(gN0T + c0 * 4096 + half * 2048);
        const char* base1 = (lw < 2) ? baseM : baseN;
#define SC_ISSUE(c, slot) do { if (w >= 2) { const unsigned _d = ldsbase + (unsigned)(slot) * SC_SLOT + (unsigned)lw * 1024u; \
            scan_dma(_d, voff0 + (unsigned)(c) * 8192u, baseM); scan_dma(_d + 6144u, voff1 + (unsigned)(c) * 8192u, base1); } } while (0)
#pragma unroll 1
        for (int c = 0; c < SC_DEPTH; ++c) SC_ISSUE(c, c);
        asm volatile("s_waitcnt vmcnt(0)" ::: "memory"); __builtin_amdgcn_s_barrier();
        f32x4 H[4];
#pragma unroll
        for (int m = 0; m < 4; ++m) H[m] = (f32x4){0.f, 0.f, 0.f, 0.f};
        ScanOps A, B;
        if (w < 2) scan_lds_load(A, F.lds, lbM, lbN, xo, c7n);
        int slot = 0;
#define SC_STEP(X, Y, c) do { \
            if (w < 2) asm volatile("s_waitcnt lgkmcnt(0)" ::: "memory"); else asm volatile("s_waitcnt vmcnt(16)" ::: "memory"); \
            __builtin_amdgcn_s_barrier(); \
            const int _sn = (slot + 1 == SC_DEPTH) ? 0 : slot + 1; \
            if (w < 2) scan_lds_load(Y, F.lds + _sn * SC_SLOT, lbM, lbN, xo, c7n); \
            { const int _cn = ((c) + SC_DEPTH < 64) ? (c) + SC_DEPTH : 63; SC_ISSUE(_cn, slot); } \
            if (w < 2) scan_step(X, H, gHT, c0 + (c), q, v); \
            slot = _sn; } while (0)
        static_assert(2 * (SC_DEPTH - 2) == 16, "vmcnt literal in SC_STEP");
#pragma unroll 1
        for (int c = 0; c < 64; c += 2) { SC_STEP(A, B, c); SC_STEP(B, A, c + 1); }
#undef SC_STEP
#undef SC_ISSUE
        asm volatile("s_waitcnt vmcnt(0)" ::: "memory"); __builtin_amdgcn_s_barrier();
    }
}

struct RcIn { bf16x8 qf[2], hb[4][2]; u32x2 y0[4], cv[4], pv[4], gw[4]; float bn; };
DI void rc_load(RcIn& x, const bf16_t* gQ, const bf16_t* gY0, const bf16_t* gHT, const bf16_t* prw, const bf16_t* lwag, const float* bonus, int item, int r, int q) {
    const int ci = item >> 2, ti = item & 3, bh = ci >> 6, c = ci & 63, b = bh >> 3, h = bh & 7;
    const size_t cb = (size_t)ci * 4096; const size_t tok = (size_t)b * SEQ + c * 64 + 16 * ti + r;
    const bool first = (tok & (SEQ - 1)) == 0; const size_t tp = first ? tok : tok - 1;
#pragma unroll
    for (int s2 = 0; s2 < 2; ++s2) x.qf[s2] = *(const bf16x8*)(gQ + cb + (16 * ti + r) * 64 + 32 * s2 + 8 * q);
#pragma unroll
    for (int n = 0; n < 4; ++n) { const int cch = h * 64 + 16 * n + 4 * q;
        x.y0[n] = *(const u32x2*)(gY0 + cb + (16 * ti + r) * 64 + 16 * n + 4 * q);
#pragma unroll
        for (int s2 = 0; s2 < 2; ++s2) x.hb[n][s2] = *(const bf16x8*)(gHT + cb + (16 * n + r) * 64 + 32 * s2 + 8 * q);
        x.cv[n] = *(const u32x2*)(prw + tok * RWC + 1024 + cch); x.pv[n] = *(const u32x2*)(prw + tp * RWC + 1024 + cch);
        x.gw[n] = *(const u32x2*)(lwag + tok * 1536 + 1024 + cch); }
    x.bn = bonus[tok * 8 + h];
}
DI void rc_compute(const RcIn& x, bf16_t* yrw, const float* mu, const float* ln_g, const float* ln_b, int item, int r, int q) {
    const int ci = item >> 2, ti = item & 3, bh = ci >> 6, c = ci & 63, b = bh >> 3, h = bh & 7;
    const size_t tok = (size_t)b * SEQ + c * 64 + 16 * ti + r; const bool first = (tok & (SEQ - 1)) == 0;
    f32x4 y[4];
#pragma unroll
    for (int n = 0; n < 4; ++n) { y[n] = (f32x4){bf_lo(x.y0[n].x), bf_hi(x.y0[n].x), bf_lo(x.y0[n].y), bf_hi(x.y0[n].y)};
#pragma unroll
        for (int s2 = 0; s2 < 2; ++s2) y[n] = __builtin_amdgcn_mfma_f32_16x16x32_bf16(x.hb[n][s2], x.qf[s2], y[n], 0, 0, 0); }
    float s1 = 0.f;
#pragma unroll
    for (int n = 0; n < 4; ++n) s1 += (y[n][0] + y[n][1]) + (y[n][2] + y[n][3]);
    s1 = xrow_sum(s1);
    const float mean = s1 * (1.0f / 64.0f);
    float s2 = 0.f;
#pragma unroll
    for (int n = 0; n < 4; ++n) { y[n] = y[n] - mean; s2 += (y[n][0] * y[n][0] + y[n][1] * y[n][1]) + (y[n][2] * y[n][2] + y[n][3] * y[n][3]); }
    s2 = xrow_sum(s2);
    const float rstd = rsqrtf(s2 * (1.0f / 64.0f) + 64e-5f);
#pragma unroll
    for (int n = 0; n < 4; ++n) { const int cch = h * 64 + 16 * n + 4 * q;
        const f32x4 muv = *(const f32x4*)(mu + 1024 + cch), lg = *(const f32x4*)(ln_g + cch), lb = *(const f32x4*)(ln_b + cch);
        const float cv[4] = {bf_lo(x.cv[n].x), bf_hi(x.cv[n].x), bf_lo(x.cv[n].y), bf_hi(x.cv[n].y)};
        const float pv[4] = {first ? 0.f : bf_lo(x.pv[n].x), first ? 0.f : bf_hi(x.pv[n].x), first ? 0.f : bf_lo(x.pv[n].y), first ? 0.f : bf_hi(x.pv[n].y)};
        const float gg[4] = {bf_lo(x.gw[n].x), bf_hi(x.gw[n].x), bf_lo(x.gw[n].y), bf_hi(x.gw[n].y)};
        float o[4];
#pragma unroll
        for (int g = 0; g < 4; ++g) { const float vsh = cv[g] + muv[g] * (pv[g] - cv[g]); o[g] = (y[n][g] * rstd * lg[g] + lb[g] + x.bn * vsh) * gg[g]; }
        u32x2 ow; ow.x = cvt_pk_bf16(o[0], o[1]); ow.y = cvt_pk_bf16(o[2], o[3]);
        *(u32x2*)(yrw + tok * 512 + cch) = ow; }
}
DI void p_rw_out(const Frame& F) {
    const bf16_t* gQ = (const bf16_t*)(F.ws + WS_CHK_Q); const bf16_t* gY0 = (const bf16_t*)(F.ws + WS_CHK_Y0T); const bf16_t* gHT = (const bf16_t*)(F.ws + WS_CHK_HT);
    const bf16_t* prw = (const bf16_t*)(F.ws + WS_PRW); const bf16_t* lwag = (const bf16_t*)(F.ws + WS_LWAG); const float* bonus = (const float*)(F.ws + WS_BONUS);
    bf16_t* yrw = (bf16_t*)(F.ws + WS_YRW);
    const float* mu = F.in[13]; const float* ln_g = F.in[22]; const float* ln_b = F.in[23];
    const int r = F.lane & 15, q = F.lane >> 4, stride = F.G * NWAVES, NIT = RW_NCH * 4;
    for (int item = F.bid * NWAVES + F.wave; item < NIT; item += 2 * stride) {
        const int item2 = (item + stride < NIT) ? item + stride : item;
        RcIn xa, xb;
        rc_load(xa, gQ, gY0, gHT, prw, lwag, bonus, item, r, q); rc_load(xb, gQ, gY0, gHT, prw, lwag, bonus, item2, r, q);
        rc_compute(xa, yrw, mu, ln_g, ln_b, item, r, q); rc_compute(xb, yrw, mu, ln_g, ln_b, item2, r, q);
    }
}

DI void p_moe_prep(const Frame& F) {
    const bf16_t* hb = (const bf16_t*)(F.ws + WS_HB); float* rsv = (float*)(F.ws + WS_RS); unsigned char* out8 = (unsigned char*)(F.ws + WS_XN2F8); const float* g = F.in[26];
    const int stride = F.G * NWAVES;
    for (int row = F.bid * NWAVES + F.wave; row < T; row += 2 * stride) {
        const int row2 = (row + stride < T) ? row + stride : row;
        u32x4 a[2], b[2];
        a[0] = *(const u32x4*)(hb + (size_t)row * D + F.lane * 16); a[1] = *(const u32x4*)(hb + (size_t)row * D + F.lane * 16 + 8);
        b[0] = *(const u32x4*)(hb + (size_t)row2 * D + F.lane * 16); b[1] = *(const u32x4*)(hb + (size_t)row2 * D + F.lane * 16 + 8);
        float v[16], u[16]; float ss = 0.f, su = 0.f;
#pragma unroll
        for (int j = 0; j < 8; ++j) { v[2 * j] = bf_lo(a[j >> 2][j & 3]); v[2 * j + 1] = bf_hi(a[j >> 2][j & 3]); u[2 * j] = bf_lo(b[j >> 2][j & 3]); u[2 * j + 1] = bf_hi(b[j >> 2][j & 3]); }
#pragma unroll
        for (int j = 0; j < 16; ++j) { ss += v[j] * v[j]; su += u[j] * u[j]; }
        ss = wave_sum(ss); su = wave_sum(su);
        const float rs = rsqrtf(ss * (1.0f / D) + 1e-5f), ru = rsqrtf(su * (1.0f / D) + 1e-5f);
        float gv[16];
#pragma unroll
        for (int q = 0; q < 4; ++q) { const f32x4 t = *(const f32x4*)(g + F.lane * 16 + q * 4); gv[4 * q] = t[0]; gv[4 * q + 1] = t[1]; gv[4 * q + 2] = t[2]; gv[4 * q + 3] = t[3]; }
#pragma unroll
        for (int j = 0; j < 16; ++j) { v[j] *= rs * gv[j]; u[j] *= ru * gv[j]; }
        u32x4 q0, q1;
        if (F.lane == 0) { rsv[row] = rs; rsv[row2] = ru; }
        q0.x = pk4_fp8(v[0] * F8_SX, v[1] * F8_SX, v[2] * F8_SX, v[3] * F8_SX); q0.y = pk4_fp8(v[4] * F8_SX, v[5] * F8_SX, v[6] * F8_SX, v[7] * F8_SX);
        q0.z = pk4_fp8(v[8] * F8_SX, v[9] * F8_SX, v[10] * F8_SX, v[11] * F8_SX); q0.w = pk4_fp8(v[12] * F8_SX, v[13] * F8_SX, v[14] * F8_SX, v[15] * F8_SX);
        q1.x = pk4_fp8(u[0] * F8_SX, u[1] * F8_SX, u[2] * F8_SX, u[3] * F8_SX); q1.y = pk4_fp8(u[4] * F8_SX, u[5] * F8_SX, u[6] * F8_SX, u[7] * F8_SX);
        q1.z = pk4_fp8(u[8] * F8_SX, u[9] * F8_SX, u[10] * F8_SX, u[11] * F8_SX); q1.w = pk4_fp8(u[12] * F8_SX, u[13] * F8_SX, u[14] * F8_SX, u[15] * F8_SX);
        *(u32x4*)(out8 + (size_t)row * D + F.lane * 16) = q0; *(u32x4*)(out8 + (size_t)row2 * D + F.lane * 16) = q1;
    }
    float* b1p = (float*)(F.ws + WS_B1P); const float* b1 = F.in[30]; CmSwi cm;
    for (int idx = F.bid * NTHR + F.tid; idx < 32 * 2048; idx += F.G * NTHR) { const int e = idx >> 11, n = idx & 2047; b1p[idx] = b1[e * 2048 + cm(n)]; }
}
DI void p_conv_part(const Frame& F, int part) {
    if (part == 0) conv_T8(F, F.in[29], (size_t)1024 * 2048, 2048, (unsigned char*)(F.ws + WS_W1), 2048, 1024, 32, MpSwi(), F8_SW, 0, 2048);
    else if (part == 1) conv_T8(F, F.in[29], (size_t)1024 * 2048, 2048, (unsigned char*)(F.ws + WS_W1), 2048, 1024, 32, MpSwi(), F8_SW, 2048, 4096);
    else conv_T8(F, F.in[31], (size_t)1024 * 1024, 1024, (unsigned char*)(F.ws + WS_W2), 1024, 1024, 32, MpId(), F8_SW);
}

DI void topk_rows(const Frame& F, int row0) {
    LAS unsigned* cnt = (LAS unsigned*)F.lds; LAS unsigned* base = cnt + 32;
    const float* logits = (const float*)(F.ws + WS_LOG); unsigned* epos = (unsigned*)(F.ws + WS_EPOS); float* gatev = (float*)(F.ws + WS_GATEV);
    const int pass = row0 / TPP;
    unsigned* gcnt = (unsigned*)(F.ws + WS_CTL) + CW_GCNT + pass * 32;
    if (F.tid < 32) cnt[F.tid] = 0u;
    __syncthreads();
    int e4[4] = {0, 0, 0, 0}; unsigned p4[4] = {0u, 0u, 0u, 0u}; float g4[4] = {0.f, 0.f, 0.f, 0.f};
    const int token = row0 + F.tid;
    if (F.tid < 256) {
        float l[32]; const float rsc = ((const float*)(F.ws + WS_RS))[token];
#pragma unroll
        for (int q = 0; q < 8; ++q) { const f32x4 v = *(const f32x4*)(logits + (size_t)token * 32 + q * 4), bq = *(const f32x4*)(F.in[28] + q * 4); l[q * 4] = v[0] * rsc + bq[0]; l[q * 4 + 1] = v[1] * rsc + bq[1]; l[q * 4 + 2] = v[2] * rsc + bq[2]; l[q * 4 + 3] = v[3] * rsc + bq[3]; }
        unsigned used = 0u; float tv[4];
#pragma unroll
        for (int k = 0; k < 4; ++k) { float best = -3.0e38f; int bi = 0;
#pragma unroll
            for (int e = 0; e < 32; ++e) { const bool ok = !((used >> e) & 1u) && (l[e] > best); best = ok ? l[e] : best; bi = ok ? e : bi; }
            used |= 1u << bi; e4[k] = bi; tv[k] = best; }
        const float m = tv[0]; float ex[4], sum = 0.f;
#pragma unroll
        for (int k = 0; k < 4; ++k) { ex[k] = __expf(tv[k] - m); sum += ex[k]; }
#pragma unroll
        for (int k = 0; k < 4; ++k) { g4[k] = ex[k] / sum; p4[k] = atomicAdd((unsigned*)&cnt[e4[k]], 1u); }
    }
    __syncthreads();
    if (F.tid < 32) base[F.tid] = __hip_atomic_fetch_add(&gcnt[F.tid], cnt[F.tid], __ATOMIC_RELAXED, __HIP_MEMORY_SCOPE_AGENT);
    __syncthreads();
    if (F.tid < 256) {
#pragma unroll
        for (int k = 0; k < 4; ++k) { epos[(size_t)token * 4 + k] = ((unsigned)e4[k] << 24) | (base[e4[k]] + p4[k]); gatev[(size_t)token * 4 + k] = g4[k]; }
    }
    __syncthreads();
}
DI void p_gather(const Frame& F, int pass) {
    LAS int* poff = (LAS int*)F.lds;
    LAS int* pcnt = poff + 40;
    unsigned* gcnt = (unsigned*)(F.ws + WS_CTL) + CW_GCNT + pass * 32;
    int* tile_e = (int*)(F.ws + WS_TILEE) + pass * TE_STRIDE;
    __syncthreads();
    if (F.tid == 0) { int acc = 0; for (int e = 0; e < 32; ++e) { poff[e] = acc; const int c = (int)__hip_atomic_load(&gcnt[e], __ATOMIC_RELAXED, __HIP_MEMORY_SCOPE_AGENT); pcnt[e] = c; acc += ((c + 255) >> 8) << 8; } poff[32] = acc; }
    __syncthreads();
    if (F.bid == 0) {
        const int nt = poff[32] >> 8;
        for (int t = F.tid; t < nt; t += NTHR) { int e = 0; for (int q = 1; q < 32; ++q) if (poff[q] <= t * 256) e = q; tile_e[1 + t] = e; }
        if (F.tid == 0) tile_e[0] = nt;
    }
    const unsigned* epos = (const unsigned*)(F.ws + WS_EPOS); const float* gatev = (const float*)(F.ws + WS_GATEV);
    int* slot = (int*)(F.ws + WS_SLOT); float* rowg = (float*)(F.ws + WS_ROWG) + (size_t)pass * MAXTILES * 256;
    int* rowtok = (int*)(F.ws + WS_ROWTOK) + (size_t)pass * MAXTILES * 256;
    for (int i = F.bid * NTHR + F.tid; i < 32 * 256; i += F.G * NTHR) { const int e = i >> 8, sl = poff[e] + pcnt[e] + (i & 255); if (sl < poff[e + 1]) rowtok[sl] = 0; }
    for (int i = F.bid * NTHR + F.tid; i < TPP * 4; i += F.G * NTHR) {
        const int token = pass * TPP + (i >> 2);
        const unsigned ep = epos[(size_t)pass * TPP * 4 + i]; const int sl = poff[ep >> 24] + (int)(ep & 0xffffffu);
        slot[(size_t)pass * TPP * 4 + i] = sl; rowg[sl] = gatev[(size_t)pass * TPP * 4 + i]; rowtok[sl] = token;
    }
    __syncthreads();
}
DI void p_combine(const Frame& F, int pass) {
    int tz_ = threadIdx.x; asm volatile("" : "+v"(tz_)); const int lane_ = tz_ & 63;
    const int* slot = (const int*)(F.ws + WS_SLOT); const unsigned char* y2 = (const unsigned char*)(F.ws + WS_XS) + (size_t)pass * PASS_BUF; const float* gf = F.in[33];
    for (int t = F.bid * NWAVES + F.wave; t < TPP; t += F.G * NWAVES) {
        const int token = pass * TPP + t;
        float v[16];
        { const bf16_t* hb = (const bf16_t*)(F.ws + WS_HB) + (size_t)token * D + lane_ * 16; const u32x4 h0 = *(const u32x4*)hb, h1 = *(const u32x4*)(hb + 8);
#pragma unroll
          for (int j = 0; j < 4; ++j) { v[2 * j] = bf_lo(h0[j]); v[2 * j + 1] = bf_hi(h0[j]); v[8 + 2 * j] = bf_lo(h1[j]); v[8 + 2 * j + 1] = bf_hi(h1[j]); } }
        u32x4 yw[4];
#pragma unroll
        for (int k = 0; k < 4; ++k) { const int s = slot[(size_t)token * 4 + k]; yw[k] = *(const u32x4*)(y2 + (size_t)s * D + lane_ * 16); }
#pragma unroll
        for (int k = 0; k < 4; ++k)
#pragma unroll
            for (int j = 0; j < 4; ++j) { const f32x2 lo = __builtin_amdgcn_cvt_pk_f32_fp8((int)yw[k][j], false), hi = __builtin_amdgcn_cvt_pk_f32_fp8((int)yw[k][j], true);
                v[4 * j] += lo[0] * (1.0f / F8_SY); v[4 * j + 1] += lo[1] * (1.0f / F8_SY); v[4 * j + 2] += hi[0] * (1.0f / F8_SY); v[4 * j + 3] += hi[1] * (1.0f / F8_SY); }
        float ss = 0.f;
#pragma unroll
        for (int j = 0; j < 16; ++j) ss += v[j] * v[j];
        ss = wave_sum(ss);
        const float rs = rsqrtf(ss * (1.0f / D) + 1e-5f);
        f32x4* orow = (f32x4*)(F.out + (size_t)token * D + lane_ * 16);
#pragma unroll
        for (int q = 0; q < 4; ++q) { const f32x4 gv = *(const f32x4*)(gf + lane_ * 16 + q * 4);
            orow[q] = (f32x4){v[q * 4] * rs * gv[0], v[q * 4 + 1] * rs * gv[1], v[q * 4 + 2] * rs * gv[2], v[q * 4 + 3] * rs * gv[3]}; }
    }
}

constexpr int N_PHASES = 18;
__global__ void __launch_bounds__(NTHR, 2) fwd_kernel(KArgs args) {
    extern __shared__ __attribute__((aligned(16))) unsigned char lds_raw[];
    Frame F; F.lds = (LAS unsigned char*)lds_raw; F.tid = threadIdx.x; F.lane = F.tid & 63; F.wave = __builtin_amdgcn_readfirstlane(F.tid >> 6);
    F.G = gridDim.x; F.bid = blockIdx.x; F.in = args.in; F.out = args.out; F.ws = args.ws;
    unsigned char* ws = args.ws;
    volatile LAS unsigned* MISC = (volatile LAS unsigned*)(F.lds + MISC_OFF);
    if (F.tid < 4) MISC[F.tid] = 0u;
    __syncthreads();
    XcdBarrier bar; bar.bar = (unsigned*)(ws + WS_CTL) + CW_BAR; bar.x = 0; bar.st = MISC;
    if (N_LAUNCH_MODE == 1) bar = xcd_barrier_post((unsigned*)(ws + WS_CTL) + CW_BAR, MISC);
    const int lo = args.ph_lo, hi = args.ph_hi;
#define IN(k) (lo <= (k) && (k) < hi)
#define REP(k) for (int _r = 0; _r < 1 + (int)((PROBE_MASK >> (k)) & 1u); ++_r)
#define SEAM(k) do { if (N_LAUNCH_MODE == 1 && IN(k) && IN((k) + 1)) xcd_barrier(bar); } while (0)
    bf16_t* gates = (bf16_t*)args.out;

    if (IN(0)) { REP(0) p0_prologue(F); SEAM(0); }
    if (IN(1)) {
        PlainSched S; S.init(ws + WS_XN, ws + WS_WIN, T, INC, D, D, D, F.G, F.bid);
        EpiWin E{(bf16_t*)(ws + WS_US5), (bf16_t*)(ws + WS_PRW), gates};
        REP(1) gemm_phase(F.lds, S, E); SEAM(1);
    }
    if (IN(2)) {
        GroupSched S; S.init(ws + WS_US5, ws + WS_WST, 512, LDU, 512, S5ROWS / BM, 1, F.G, F.bid);
        EpiS5State E{(float*)(ws + WS_SLOC)};
        REP(2) { gemm_phase(F.lds, S, E); p_rw_prep(F); } SEAM(2);
    }
    if (IN(3)) {
        REP(3) p_s5_carry(F);
        PlainSched S; S.init(ws + WS_ALORA, ws + WS_WLORA, T, 1536, 128, 256, 128, F.G, F.bid); S.akoff_pn = 4; S.akoff_bytes = 256;
        EpiLora E{(bf16_t*)(ws + WS_LWAG), F.in[14], F.in[16]};
        REP(3) gemm_phase(F.lds, S, E); SEAM(3);
    }
    if (IN(4)) {
        GroupSched S; S.init(ws + WS_US5, ws + WS_TOEP, LDU, LDU, LDU, S5ROWS / BM, 2, F.G, F.bid);
        EpiS5Out E{(bf16_t*)(ws + WS_YS)};
        REP(4) gemm_phase(F.lds, S, E); SEAM(4);
    }
    if (IN(5)) { REP(5) p_rw_chunk(F); SEAM(5); }
    if (IN(6)) { REP(6) p_rw_scan(F); SEAM(6); }
    if (IN(7)) { REP(7) p_rw_out(F); SEAM(7); }
    if (IN(8)) {
        PlainSched S; S.init(ws + WS_YS, ws + WS_WGLU, T, 2048, 512, 512, 512, F.G, F.bid);
        EpiGlu E{(bf16_t*)(ws + WS_XN), gates, (const float*)(ws + WS_BGLU)};
        if (F.bid & 1) p_conv_part(F, 0);
        gemm_phase(F.lds, S, E);
        if (!(F.bid & 1)) p_conv_part(F, 0);
        SEAM(8);
    }
    if (IN(9)) {
        PlainSched S; S.init(ws + WS_YRW, ws + WS_WO, T, 1024, 512, 512, 512, F.G, F.bid);
        EpiWo E{(bf16_t*)(ws + WS_XN), gates};
        if (F.bid & 1) p_conv_part(F, 1);
        gemm_phase(F.lds, S, E);
        if (!(F.bid & 1)) p_conv_part(F, 1);
        SEAM(9);
    }
    if (IN(10)) {
        PlainSched S; S.init(ws + WS_XN, ws + WS_WOUT, T, 1024, 1024, 1024, 1024, F.G, F.bid);
        EpiOut E{(bf16_t*)(ws + WS_HB), F.in[0]};
        if (F.bid & 1) p_conv_part(F, 2);
        gemm_phase(F.lds, S, E);
        if (!(F.bid & 1)) p_conv_part(F, 2);
        SEAM(10);
    }
    if (IN(11)) { REP(11) p_moe_prep(F); SEAM(11); }
    if (IN(12)) {
        PlainSched S; S.init(ws + WS_HB, ws + WS_WR, T, 256, 1024, 1024, 1024, F.G, F.bid);
        EpiRouter E{(float*)(ws + WS_LOG)};
        gemm_phase(F.lds, S, E);
        { Unit u; for (int i = 0; S.next(i, u); ++i) topk_rows(F, u.pm * BM); }
        SEAM(12);
    }
    if (IN(13)) { p_gather(F, 0); p_gather(F, 1); SEAM(13); }
#define MOE_G1(PASS, CIDX) \
            const int* te = (const int*)(ws + WS_TILEE) + (PASS) * TE_STRIDE; const int ntl = __builtin_amdgcn_readfirstlane(__hip_atomic_load(te, __ATOMIC_RELAXED, __HIP_MEMORY_SCOPE_AGENT)); \
            MoeSched<true> S; S.init(ws + WS_XN2F8, ws + WS_W1, te + 1, (const int*)(ws + WS_ROWTOK) + (size_t)(PASS) * MAXTILES * 256, ntl, 512, 8, F.G, (CIDX)); \
            EpiMoe1 E{(unsigned char*)(ws + WS_ACT) + (size_t)(PASS) * PASS_BUF, (const float*)(ws + WS_B1P)};
#define MOE_G2(PASS) \
            const int* te = (const int*)(ws + WS_TILEE) + (PASS) * TE_STRIDE; const int ntl = __builtin_amdgcn_readfirstlane(__hip_atomic_load(te, __ATOMIC_RELAXED, __HIP_MEMORY_SCOPE_AGENT)); \
            MoeSched<false> S; S.init(ws + WS_ACT + (size_t)(PASS) * PASS_BUF, ws + WS_W2, te + 1, nullptr, ntl, 512, 4, F.G, F.bid); \
            EpiMoe2 E{(unsigned char*)(ws + WS_XS) + (size_t)(PASS) * PASS_BUF, F.in[32], (const float*)(ws + WS_ROWG) + (size_t)(PASS) * MAXTILES * 256};
    if (IN(14)) { MOE_G1(0, F.bid) gemm_phase(F.lds, S, E); SEAM(14); }
    if (IN(15)) {
        { MOE_G2(0) gemm_phase(F.lds, S, E); }
        { MOE_G1(1, F.G - 1 - F.bid) gemm_phase(F.lds, S, E); }
        SEAM(15);
    }
    if (IN(16)) {
        if (F.bid & 1) p_combine(F, 0);
        { MOE_G2(1) gemm_phase(F.lds, S, E); }
        if (!(F.bid & 1)) p_combine(F, 0);
        SEAM(16);
    }
    if (IN(17)) { p_combine(F, 1); }
#undef MOE_G1
#undef MOE_G2
#undef IN
#undef SEAM
#undef REP
}

extern "C" void kernel_launch(void* const* d_in, const int* in_sizes, int n_in, void* d_out, int out_size, void* d_ws, size_t ws_size, hipStream_t stream) {
    static int grid = 0;
    if (grid == 0) {
        if (n_in != 34 || in_sizes[0] != T * D || out_size != T * D || ws_size < WS_END) { fprintf(stderr, "kernel_launch: unexpected shapes (n_in %d, in0 %d, out %d, ws %zu < %zu)\n", n_in, n_in > 0 ? in_sizes[0] : -1, out_size, ws_size, (size_t)WS_END); grid = -1; return; }
        int dev = 0, cus = 0, per_cu = 0;
        if (hipGetDevice(&dev) != hipSuccess || hipDeviceGetAttribute(&cus, hipDeviceAttributeMultiprocessorCount, dev) != hipSuccess) { grid = -1; return; }
        if (hipFuncSetAttribute((const void*)fwd_kernel, hipFuncAttributeMaxDynamicSharedMemorySize, LDS_BYTES) != hipSuccess) { fprintf(stderr, "kernel_launch: hipFuncSetAttribute failed\n"); grid = -1; return; }
        if (hipOccupancyMaxActiveBlocksPerMultiprocessor(&per_cu, (const void*)fwd_kernel, NTHR, LDS_BYTES) != hipSuccess || per_cu < 1) { fprintf(stderr, "kernel_launch: occupancy query says %d\n", per_cu); }
        (void)hipGetLastError();
        grid = cus;
    }
    if (grid < 0) return;
    (void)hipMemsetAsync((char*)d_ws + WS_CTL, 0, CTL_BYTES, stream);
    KArgs a{};
    for (int i = 0; i < 34; ++i) a.in[i] = (const float*)d_in[i];
    a.out = (float*)d_out; a.ws = (unsigned char*)d_ws;
    if (N_LAUNCH_MODE == 1) {
        a.ph_lo = 0; a.ph_hi = N_PHASES;
        hipLaunchKernelGGL(fwd_kernel, dim3(grid), dim3(NTHR), LDS_BYTES, stream, a);
    } else {
        for (int p = 0; p < N_PHASES; ++p) { a.ph_lo = p; a.ph_hi = p + 1; hipLaunchKernelGGL(fwd_kernel, dim3(grid), dim3(NTHR), LDS_BYTES, stream, a); }
    }
}
```

```cpp
#include <hip/hip_runtime.h>
#include <stdint.h>
#include <stdio.h>

#ifndef N_LAUNCH_MODE
#define N_LAUNCH_MODE 1
#endif

#ifndef GEMM_SP2
#define GEMM_SP2 1
#endif
#ifndef GEMM_ALIGN
#define GEMM_ALIGN 1
#endif
#ifndef PROBE_MASK
#define PROBE_MASK 0u
#endif
#define LAS __attribute__((address_space(3)))
#define DI __device__ __forceinline__
typedef unsigned short bf16_t;
typedef short bf16x8 __attribute__((ext_vector_type(8)));
typedef float f32x4 __attribute__((ext_vector_type(4)));
typedef float f32x2 __attribute__((ext_vector_type(2)));
typedef unsigned u32x4 __attribute__((ext_vector_type(4)));
typedef unsigned u32x2 __attribute__((ext_vector_type(2)));
typedef int i32x8 __attribute__((ext_vector_type(8)));
typedef int i32x4 __attribute__((ext_vector_type(4)));

constexpr int T = 65536, D = 1024, SEQ = 4096, NB = 16;
constexpr int INC = 4352, RWC = 1792;
constexpr int S5L = 32;
constexpr int S5NC = SEQ / S5L;
constexpr int S5ROWS = T / S5L;
constexpr int LDU = 16 * S5L + 128;
constexpr int NE = 32, TOPK = 4;
constexpr int NPASS = 2, TPP = T / NPASS;
constexpr int MAXTILES = (TPP * TOPK) / 256 + NE;
constexpr int NWAVES = 8, NTHR = 512;

constexpr size_t al(size_t x) { return (x + 4095) & ~(size_t)4095; }
constexpr size_t WS_CTL = 0, CTL_BYTES = 1 << 20;
constexpr size_t WS_WIN = WS_CTL + CTL_BYTES;
constexpr size_t WS_WGLU = WS_WIN + al((size_t)INC * D * 2);
constexpr size_t WS_WO = WS_WGLU + al((size_t)2048 * 512 * 2);
constexpr size_t WS_WOUT = WS_WO + al((size_t)1024 * 512 * 2);
constexpr size_t WS_WLORA = WS_WOUT + al((size_t)1024 * 1024 * 2);
constexpr size_t WS_WR = WS_WLORA + al((size_t)1536 * 256 * 2);
constexpr size_t WS_TOEP = WS_WR + al((size_t)256 * 1024 * 2);
constexpr size_t WS_WST = WS_TOEP + al((size_t)32 * 512 * LDU * 2);
constexpr size_t WS_BGLU = WS_WST + al((size_t)32 * 256 * 512 * 2);
constexpr size_t WS_B1P = WS_BGLU + al(2048 * 4);
constexpr size_t WS_SHARED = WS_B1P + al((size_t)32 * 2048 * 4);
constexpr size_t WS_PRW = WS_SHARED;
constexpr size_t WS_LWAG = WS_PRW + al((size_t)T * RWC * 2);
constexpr size_t WS_YS = WS_LWAG + al((size_t)T * 1536 * 2);
constexpr size_t WS_YRW = WS_YS + al((size_t)T * 512 * 2);
constexpr size_t WS_BONUS = WS_YRW + al((size_t)T * 512 * 2);
constexpr size_t WS_XN = WS_BONUS + al((size_t)T * 8 * 4);
constexpr size_t WS_US5 = WS_XN + al((size_t)T * D * 2);
constexpr size_t WS_ALORA = WS_US5 + al((size_t)32 * S5ROWS * LDU * 2);
constexpr size_t WS_SLOC = WS_ALORA + al((size_t)T * 256 * 2);
constexpr int RW_NCH = 128 * 64;
constexpr size_t CHK_BYTES = (size_t)RW_NCH * 4096 * 2;
constexpr size_t WS_CHK_M = WS_XN, WS_CHK_N0T = WS_CHK_M + CHK_BYTES, WS_CHK_Q = WS_CHK_N0T + CHK_BYTES, WS_CHK_Y0T = WS_CHK_Q + CHK_BYTES, WS_CHK_HT = WS_CHK_Y0T + CHK_BYTES;
constexpr size_t WS_MIX_END0 = WS_SLOC + al((size_t)32 * S5ROWS * 128 * 4);
constexpr size_t WS_MIX_END = (WS_CHK_HT + CHK_BYTES) > WS_MIX_END0 ? (WS_CHK_HT + CHK_BYTES) : WS_MIX_END0;
constexpr size_t WS_HB = WS_SHARED;
constexpr size_t WS_W1 = WS_HB + al((size_t)T * D * 2);
constexpr size_t WS_W2 = WS_W1 + al((size_t)32 * 2048 * 1024);
constexpr size_t WS_RS = WS_W2 + al((size_t)32 * 1024 * 1024);
constexpr size_t WS_LOG = WS_RS + al((size_t)T * 4);
constexpr size_t WS_EPOS = WS_LOG + al((size_t)T * 32 * 4);
constexpr size_t WS_GATEV = WS_EPOS + al((size_t)T * 4 * 4);
constexpr size_t WS_SLOT = WS_GATEV + al((size_t)T * 4 * 4);
constexpr size_t WS_ROWG = WS_SLOT + al((size_t)T * 4 * 4);
constexpr size_t WS_ROWTOK = WS_ROWG + al((size_t)NPASS * MAXTILES * 256 * 4);
constexpr size_t WS_TILEE = WS_ROWTOK + al((size_t)NPASS * MAXTILES * 256 * 4);
constexpr int TE_STRIDE = MAXTILES + 64;
constexpr size_t WS_XS = WS_TILEE + al((size_t)NPASS * (MAXTILES + 64) * 4);
constexpr size_t PASS_BUF = al((size_t)MAXTILES * 256 * 1024);
constexpr size_t WS_ACT = WS_XS + NPASS * PASS_BUF;
constexpr size_t WS_XN2F8 = WS_ACT + NPASS * PASS_BUF;
constexpr size_t WS_MOE_END = WS_XN2F8 + al((size_t)T * D);
static_assert(WS_W2 + (size_t)32 * 1024 * 1024 <= WS_SHARED + (size_t)T * RWC * 2, "converted expert weights must stay inside the (dead) PRW buffer while the GLU/Wo/out GEMM phases run");
constexpr size_t WS_END = WS_MIX_END > WS_MOE_END ? WS_MIX_END : WS_MOE_END;
static_assert(WS_END <= ((size_t)1 << 30), "workspace over 1 GiB");

constexpr int CW_BAR = 0;
constexpr int CW_GCNT = 4096;

constexpr float F8_SX = 16.f, F8_SW = 32.f, F8_SA = 4.f, F8_SY = 32.f;
constexpr int LDS_BYTES = 144 * 1024;
constexpr int MISC_OFF = 140 * 1024;

typedef __bf16 bf16x2_t __attribute__((ext_vector_type(2)));
DI unsigned cvt_pk_bf16(float lo, float hi) { f32x2 v = {lo, hi}; bf16x2_t b = __builtin_convertvector(v, bf16x2_t); return __builtin_bit_cast(unsigned, b); }
DI unsigned pk4_fp8(float a, float b, float c, float d) {
    a = fminf(fmaxf(a, -448.f), 448.f); b = fminf(fmaxf(b, -448.f), 448.f); c = fminf(fmaxf(c, -448.f), 448.f); d = fminf(fmaxf(d, -448.f), 448.f);
    int w = __builtin_amdgcn_cvt_pk_fp8_f32(a, b, 0, false); w = __builtin_amdgcn_cvt_pk_fp8_f32(c, d, w, true); return (unsigned)w; }
DI float bf_lo(unsigned u) { return __uint_as_float(u << 16); }
DI float bf_hi(unsigned u) { return __uint_as_float(u & 0xffff0000u); }
DI float bf2f(bf16_t b) { return __uint_as_float(((unsigned)b) << 16); }
DI bf16_t f2bf(float f) { return (bf16_t)(cvt_pk_bf16(f, 0.f) & 0xffffu); }
DI float fsigmoid(float x) { return __builtin_amdgcn_rcpf(1.0f + __expf(-x)); }
DI float ftanh(float x) { float e = __expf(2.0f * x); return 1.0f - 2.0f * __builtin_amdgcn_rcpf(e + 1.0f); }
DI float fgelu_tanh(float x) { float u = 0.7978845608f * (x + 0.044715f * x * x * x); return x * fsigmoid(2.0f * u); }
DI f32x2 lo2(const f32x4& v) { return __builtin_shufflevector(v, v, 0, 1); }
DI f32x2 hi2(const f32x4& v) { return __builtin_shufflevector(v, v, 2, 3); }
DI f32x2 pk_sigmoid_scaled(f32x2 x, float negk) {
    const f32x2 t = x * negk; f32x2 e; e.x = __builtin_amdgcn_exp2f(t.x); e.y = __builtin_amdgcn_exp2f(t.y);
    const f32x2 d = e + 1.0f; f32x2 r; r.x = __builtin_amdgcn_rcpf(d.x); r.y = __builtin_amdgcn_rcpf(d.y); return r; }
DI f32x2 pk_sigmoid(f32x2 x) { return pk_sigmoid_scaled(x, -1.44269504f); }
DI f32x2 pk_gelu_tanh(f32x2 x) { const f32x2 x2 = x * x; const f32x2 u = x * (x2 * (0.044715f * 0.7978845608f) + 0.7978845608f); return x * pk_sigmoid_scaled(u, -2.0f * 1.44269504f); }
DI unsigned pk4_fp8_nc(f32x2 a, f32x2 b) { int w = __builtin_amdgcn_cvt_pk_fp8_f32(a.x, a.y, 0, false); w = __builtin_amdgcn_cvt_pk_fp8_f32(b.x, b.y, w, true); return (unsigned)w; }
#define DPP_ROR_ADD(v, n) ((v) + __builtin_bit_cast(float, __builtin_amdgcn_update_dpp(0, __builtin_bit_cast(int, (v)), 0x120 + (n), 0xf, 0xf, false)))
DI float row_sum16(float v) { v = DPP_ROR_ADD(v, 8); v = DPP_ROR_ADD(v, 4); v = DPP_ROR_ADD(v, 2); v = DPP_ROR_ADD(v, 1); return v; }
DI float xrow_sum(float x) {
    float y = x;
    asm("s_nop 1\n\tv_permlane16_swap_b32 %0, %1\n\ts_nop 1" : "+v"(x), "+v"(y));
    x = x + y; y = x;
    asm("s_nop 1\n\tv_permlane32_swap_b32 %0, %1\n\ts_nop 1" : "+v"(x), "+v"(y));
    return x + y;
}
DI float wave_sum(float v) { return xrow_sum(row_sum16(v)); }
#define DPP_ADD(v, ctrl) ((v) + __builtin_bit_cast(float, __builtin_amdgcn_update_dpp(0, __builtin_bit_cast(int, (v)), (ctrl), 0xf, 0xf, false)))
DI float comb32(float x, float y) { asm("s_nop 1\n\tv_permlane32_swap_b32 %0, %1\n\ts_nop 1" : "+v"(x), "+v"(y)); return x + y; }
DI float comb16(float x, float y) { asm("s_nop 1\n\tv_permlane16_swap_b32 %0, %1\n\ts_nop 1" : "+v"(x), "+v"(y)); return x + y; }

DI float sum16(float v) {
    v += __shfl_xor(v, 1); v += __shfl_xor(v, 2); v += __shfl_xor(v, 4); v += __shfl_xor(v, 8); return v;
}

#define XB_TMO      128
#define XB_XCNT(j)  (256  + 64 * (j))
#define XB_XSUB(j)  (1280 + 64 * (j))
#define XB_XGEN(j)  (2304 + 64 * (j))
#define XB_TOP      3328
#define XB_TOPGEN   3392
#define XCD_BAR_WORDS 3456
#define XB_SPIN_CAP (1u << 22)
DI unsigned xb_ld(unsigned* p)              { return __hip_atomic_load(p, __ATOMIC_RELAXED, __HIP_MEMORY_SCOPE_AGENT); }
DI unsigned xb_add(unsigned* p, unsigned v) { return __hip_atomic_fetch_add(p, v, __ATOMIC_RELAXED, __HIP_MEMORY_SCOPE_AGENT); }
DI unsigned xb_xcc_id() { return (unsigned)__builtin_amdgcn_s_getreg((3 << 11) | 20) & 0xFu; }
#define XB_SPIN(cond, bar) do { unsigned _sp = 0; while (cond) { __builtin_amdgcn_s_sleep(1); \
    if ((++_sp & 255u) == 0u) { if (xb_ld(&(bar)[XB_TMO])) break; if (_sp > XB_SPIN_CAP) { atomicAdd(&(bar)[XB_TMO], 1u); break; } } } } while (0)
struct XcdBarrier { unsigned* bar; unsigned x; volatile LAS unsigned* st; };
DI XcdBarrier xcd_barrier_post(unsigned* bar, volatile LAS unsigned* st) {
    XcdBarrier b; b.bar = bar; b.x = xb_xcc_id(); b.st = st;
    if (threadIdx.x == 0) (void)xb_add(&bar[XB_XCNT(b.x)], 1u);
    return b;
}
DI void xcd_barrier_complete(unsigned* bar, unsigned x, unsigned& nloc, unsigned& nx) {
    const unsigned G = gridDim.x * gridDim.y * gridDim.z;
    unsigned sum, cnt, mine, sp = 0u;
    for (;;) {
        sum = 0u; cnt = 0u; mine = 0u;
#pragma unroll
        for (unsigned j = 0; j < 16; ++j) { const unsigned c = xb_ld(&bar[XB_XCNT(j)]); sum += c; cnt += (c > 0u) ? 1u : 0u; mine = (j == x) ? c : mine; }
        if (sum == G) break;
        __builtin_amdgcn_s_sleep(1);
        if ((++sp & 255u) == 0u) { if (xb_ld(&bar[XB_TMO])) break; if (sp > XB_SPIN_CAP) { atomicAdd(&bar[XB_TMO], 1u); break; } }
    }
    nloc = mine > 0u ? mine : 1u; nx = cnt > 0u ? cnt : 1u;
}
DI void xcd_barrier(const XcdBarrier& b) {
    asm volatile("s_waitcnt vmcnt(0)" ::: "memory");
    __syncthreads();
    if (threadIdx.x == 0) {
        unsigned* bar = b.bar;
        __builtin_amdgcn_s_waitcnt(0);
        unsigned nloc = b.st[0], nx = b.st[1];
        if (nloc == 0u) { xcd_barrier_complete(bar, b.x, nloc, nx); b.st[0] = nloc; b.st[1] = nx; }
        const unsigned old = xb_add(&bar[XB_XSUB(b.x)], 1u);
        const unsigned gen = old / nloc;
        if (old + 1u == (gen + 1u) * nloc) {
            __builtin_amdgcn_fence(__ATOMIC_RELEASE, "agent");
            asm volatile("s_waitcnt vmcnt(0)" ::: "memory");
            const unsigned og = xb_add(&bar[XB_TOP], 1u);
            const unsigned tg = og / nx;
            if (og + 1u == (tg + 1u) * nx) xb_add(&bar[XB_TOPGEN], 1u);
            else XB_SPIN(xb_ld(&bar[XB_TOPGEN]) == tg, bar);
            __builtin_amdgcn_fence(__ATOMIC_ACQUIRE, "agent");
            xb_add(&bar[XB_XGEN(b.x)], 1u);
            asm volatile("s_waitcnt vmcnt(0)" ::: "memory");
        } else {
            XB_SPIN(xb_ld(&bar[XB_XGEN(b.x)]) == gen, bar);
            __builtin_amdgcn_fence(__ATOMIC_ACQUIRE, "agent");
            asm volatile("s_waitcnt vmcnt(0)" ::: "memory");
        }
    }
    __syncthreads();
}

constexpr int BM = 256, BK = 64, HALF = 128, HTB = HALF * BK * 2;
DI int lds_byte(int r, int c) { const int st = (r >> 4) * 2 + (c >> 5), rr = r & 15, cc = c & 31, ob = rr * 64 + cc * 2; return st * 1024 + (ob ^ (((ob >> 9) & 1) << 5)); }
DI void stage_rc(int b, int& R, int& C) { const int st = b / 1024, sb = b % 1024, swz = sb ^ (((sb >> 9) & 1) << 5); R = (st >> 1) * 16 + swz / 64; C = (st & 1) * 32 + (swz % 64) / 2; }
DI int perm32(int rho) { const int n = rho >> 4, i = rho & 15; return 8 * (i >> 2) + 4 * n + (i & 3); }
struct Unit { int pm, pn, aux; };

template <class Sched, class Epi>
DI void gemm_phase(LAS unsigned char* lds, const Sched& S, const Epi& E) {
    const int tid = threadIdx.x, wid = __builtin_amdgcn_readfirstlane(tid >> 6), lane = tid & 63, wr = wid >> 2, wc = wid & 3, fr = lane & 15, fq = lane >> 4;
    const int K = S.K, nt = K / BK;
    unsigned voffA[2], voffB[2];
#pragma unroll
    for (int i = 0; i < 2; ++i) { int R, C; stage_rc(tid * 16 + i * 8192, R, C); const int Rb = Epi::PERM ? ((R & ~31) + perm32(R & 31)) : R;
        voffA[i] = (unsigned)(R * S.lda + C) * 2u; voffB[i] = (unsigned)(Rb * S.ldb + C) * 2u; }
    const size_t kstep = (size_t)(BK * 2);
    const size_t hstepA = (size_t)HALF * S.lda * 2, hstepB = (size_t)HALF * S.ldb * 2;
    const unsigned ldsw = (unsigned)wid * 1024u;
    const int aoff = lds_byte(wr * 64 + fr, fq * 8), boff = lds_byte(wc * 32 + fr, fq * 8);
#define PG8_SA(b, h) (((b) * 2 + (h)) * HTB)
#define PG8_SB(b, h) ((4 + (b) * 2 + (h)) * HTB)
    const unsigned ldsbase = (unsigned)(size_t)lds;
#define PG8_STAGE(bufoff, gbase, voff) do { _Pragma("unroll") for (int _i = 0; _i < 2; ++_i) \
        asm volatile("s_mov_b32 m0, %0\n\ts_nop 0\n\tglobal_load_lds_dwordx4 %1, %2" :: "s"(ldsbase + (unsigned)(bufoff) + ldsw + (unsigned)(_i * 8192)), "v"((voff)[_i]), "s"((const char*)(gbase)) : "memory"); } while (0)
#define PG8_LDA(dst, b, h) do { _Pragma("unroll") for (int m = 0; m < 4; ++m) _Pragma("unroll") for (int k = 0; k < 2; ++k) dst[m][k] = *(const LAS bf16x8*)(lds + PG8_SA(b, h) + aoff + m * 2048 + k * 1024); } while (0)
#define PG8_LDB(dst, b, h) do { _Pragma("unroll") for (int n = 0; n < 2; ++n) _Pragma("unroll") for (int k = 0; k < 2; ++k) dst[n][k] = *(const LAS bf16x8*)(lds + PG8_SB(b, h) + boff + n * 2048 + k * 1024); } while (0)
#define PG8_MMA(ai, bj, At, Bt) do { __builtin_amdgcn_s_setprio(1); _Pragma("unroll") for (int m = 0; m < 4; ++m) _Pragma("unroll") for (int n = 0; n < 2; ++n) _Pragma("unroll") for (int k = 0; k < 2; ++k) \
        acc[ai][bj][m][n] = __builtin_amdgcn_mfma_f32_16x16x32_bf16(Bt[n][k], At[m][k], acc[ai][bj][m][n], 0, 0, 0); __builtin_amdgcn_s_setprio(0); } while (0)
#define PG8_WAIT_V(n) asm volatile("s_waitcnt vmcnt(" #n ")" ::: "memory")
#define PG8_WAIT_L(n) asm volatile("s_waitcnt lgkmcnt(" #n ")" ::: "memory")
#define PG8_BAR __builtin_amdgcn_s_barrier()
#define PG8_SCHED __builtin_amdgcn_sched_barrier(0)
    Unit cur, nxt; int ui = 0;
    if (!S.next(0, cur)) return;
    f32x4 acc[2][2][4][2];
#pragma unroll
    for (int a = 0; a < 2; ++a)
#pragma unroll
        for (int b = 0; b < 2; ++b)
#pragma unroll
            for (int m = 0; m < 4; ++m)
#pragma unroll
                for (int n = 0; n < 2; ++n) { if constexpr (Sched::FP8) { f32x2 z0_, z1_; asm volatile("v_pk_mov_b32 %0, 0, 0" : "=v"(z0_)); asm volatile("v_pk_mov_b32 %0, 0, 0" : "=v"(z1_)); acc[a][b][m][n] = (f32x4){z0_.x, z0_.y, z1_.x, z1_.y}; } else acc[a][b][m][n] = (f32x4){0.f, 0.f, 0.f, 0.f}; }
    bf16x8 At[4][2], B0[2][2], B1[2][2];
    i32x8 At8[4], B08[2], B18[2];
    const int aoff8a = lds_byte(wr * 64 + fr, 16 * fq) & ~16, boff8a = lds_byte(wc * 32 + fr, 16 * fq) & ~16;
#define PG8_LDA8(dst, b, h) do { _Pragma("unroll") for (int m = 0; m < 4; ++m) dst[m] = *(const LAS i32x8*)(lds + PG8_SA(b, h) + aoff8a + m * 2048); } while (0)
#define PG8_LDB8(dst, b, h) do { _Pragma("unroll") for (int n = 0; n < 2; ++n) dst[n] = *(const LAS i32x8*)(lds + PG8_SB(b, h) + boff8a + n * 2048); } while (0)
#define PG8_MMA8(ai, bj, At_, Bt_) do { __builtin_amdgcn_s_setprio(1); _Pragma("unroll") for (int m = 0; m < 4; ++m) _Pragma("unroll") for (int n = 0; n < 2; ++n) \
        acc[ai][bj][m][n] = __builtin_amdgcn_mfma_scale_f32_16x16x128_f8f6f4(Bt_[n], At_[m], acc[ai][bj][m][n], 0, 0, 0, 0x7f7f7f7f, 0, 0x7f7f7f7f); __builtin_amdgcn_s_setprio(0); } while (0)
#define XLDA(b, h) do { if constexpr (Sched::FP8) PG8_LDA8(At8, b, h); else PG8_LDA(At, b, h); } while (0)
#define XLDB0(b, h) do { if constexpr (Sched::FP8) PG8_LDB8(B08, b, h); else PG8_LDB(B0, b, h); } while (0)
#define XLDB1(b, h) do { if constexpr (Sched::FP8) PG8_LDB8(B18, b, h); else PG8_LDB(B1, b, h); } while (0)
#define XMMA0(ai, bj) do { if constexpr (Sched::FP8) PG8_MMA8(ai, bj, At8, B08); else PG8_MMA(ai, bj, At, B0); } while (0)
#define XMMA1(ai, bj) do { if constexpr (Sched::FP8) PG8_MMA8(ai, bj, At8, B18); else PG8_MMA(ai, bj, At, B1); } while (0)
    const char* cA = S.a_ptr(cur); const char* cB = S.b_ptr(cur);
    unsigned offA[2][2], offN[2][2];
    if constexpr (Sched::GATHER) {
#pragma unroll
        for (int h = 0; h < 2; ++h)
#pragma unroll
            for (int i = 0; i < 2; ++i) { int R, C; stage_rc(tid * 16 + i * 8192, R, C); offA[h][i] = S.a_rowoff(cur, h * HALF + R) + (unsigned)C * 2u; offN[h][i] = offA[h][i]; }
    }
#define A_STG(bufoff, plainptr, kt, h, nx) do { if constexpr (Sched::GATHER) { PG8_STAGE(bufoff, cA + (size_t)(kt) * kstep, offA[h]); } \
        else PG8_STAGE(bufoff, plainptr, voffA); } while (0)
    if constexpr (GEMM_SP2) {
        PG8_STAGE(PG8_SB(0, 0), cB, voffB); PG8_STAGE(PG8_SB(0, 1), cB + hstepB, voffB); A_STG(PG8_SA(0, 0), cA, 0, 0, false); A_STG(PG8_SA(0, 1), cA + hstepA, 0, 1, false);
        if (wr == 1) PG8_BAR;
        PG8_WAIT_V(2); PG8_BAR;
        PG8_STAGE(PG8_SB(1, 0), cB + kstep, voffB); A_STG(PG8_SA(1, 0), cA + kstep, 1, 0, false); PG8_STAGE(PG8_SB(1, 1), cB + hstepB + kstep, voffB);
        PG8_WAIT_V(6); PG8_BAR;
    } else {
    PG8_STAGE(PG8_SB(0, 0), cB, voffB); A_STG(PG8_SA(0, 0), cA, 0, 0, false); PG8_STAGE(PG8_SB(0, 1), cB + hstepB, voffB); A_STG(PG8_SA(0, 1), cA + hstepA, 0, 1, false);
    if (wr == 1) PG8_BAR;
    PG8_WAIT_V(4); PG8_BAR;
    PG8_STAGE(PG8_SB(1, 0), cB + kstep, voffB); A_STG(PG8_SA(1, 0), cA + kstep, 1, 0, false); PG8_STAGE(PG8_SB(1, 1), cB + hstepB + kstep, voffB);
    PG8_WAIT_V(6); PG8_BAR;
    }
    for (;;) {
        const bool has_next = S.next(ui + 1, nxt);
        const char* nA = has_next ? S.a_ptr(nxt) : cA; const char* nB = has_next ? S.b_ptr(nxt) : cB;
        for (int t = 0; t < nt; t += 2) {
            const bool last = (t == nt - 2);
            const char* a1 = cA + (size_t)(t + 1) * kstep;
            const char* a2 = last ? nA : cA + (size_t)(t + 2) * kstep; const char* b2 = last ? nB : cB + (size_t)(t + 2) * kstep;
            const char* a3 = a2 + kstep; const char* b3 = b2 + kstep;
            const int k2 = last ? 0 : t + 2, k3 = k2 + 1;
            if constexpr (GEMM_SP2) {
            XLDB0(0, 0); XLDB1(0, 1); PG8_SCHED; XLDA(0, 0); A_STG(PG8_SA(1, 1), a1 + hstepA, t + 1, 1, false);
            if constexpr (Sched::GATHER) {
                if (has_next && (t == nt - 4 || nt < 4)) {
#pragma unroll
                    for (int h = 0; h < 2; ++h)
#pragma unroll
                        for (int i = 0; i < 2; ++i) { int R, C; stage_rc(tid * 16 + i * 8192, R, C); offN[h][i] = S.a_rowoff(nxt, h * HALF + R) + (unsigned)C * 2u; } }
                if (last && has_next) { offA[0][0] = offN[0][0]; offA[0][1] = offN[0][1]; offA[1][0] = offN[1][0]; offA[1][1] = offN[1][1]; }
            }
            PG8_WAIT_V(8); PG8_WAIT_L(0); PG8_BAR; XMMA0(0, 0); XMMA1(0, 1); PG8_BAR; PG8_SCHED;
            XLDA(0, 1); PG8_STAGE(PG8_SB(0, 0), b2, voffB); PG8_STAGE(PG8_SB(0, 1), b2 + hstepB, voffB); A_STG(PG8_SA(0, 0), a2, k2, 0, last);
            PG8_WAIT_V(8); PG8_WAIT_L(0); PG8_BAR; XMMA0(1, 0); XMMA1(1, 1); PG8_BAR; PG8_SCHED;
            XLDB0(1, 0); XLDB1(1, 1); PG8_SCHED; XLDA(1, 0); A_STG(PG8_SA(0, 1), a2 + hstepA, k2, 1, last);
            PG8_WAIT_V(8); PG8_WAIT_L(0); PG8_BAR; XMMA0(0, 0); XMMA1(0, 1); PG8_BAR; PG8_SCHED;
            XLDA(1, 1); PG8_STAGE(PG8_SB(1, 0), b3, voffB); PG8_STAGE(PG8_SB(1, 1), b3 + hstepB, voffB); A_STG(PG8_SA(1, 0), a3, k3, 0, last);
            PG8_WAIT_V(8); PG8_WAIT_L(0); PG8_BAR; XMMA0(1, 0); XMMA1(1, 1); PG8_BAR; PG8_SCHED;
            } else {
            XLDB0(0, 0); PG8_SCHED; XLDA(0, 0); A_STG(PG8_SA(1, 1), a1 + hstepA, t + 1, 1, false);
            if constexpr (Sched::GATHER) {
                if (has_next && (t == nt - 4 || nt < 4)) {
#pragma unroll
                    for (int h = 0; h < 2; ++h)
#pragma unroll
                        for (int i = 0; i < 2; ++i) { int R, C; stage_rc(tid * 16 + i * 8192, R, C); offN[h][i] = S.a_rowoff(nxt, h * HALF + R) + (unsigned)C * 2u; } }
                if (last && has_next) { offA[0][0] = offN[0][0]; offA[0][1] = offN[0][1]; offA[1][0] = offN[1][0]; offA[1][1] = offN[1][1]; }
            }
            PG8_WAIT_L(8); PG8_BAR; PG8_WAIT_L(0); XMMA0(0, 0); PG8_BAR; PG8_SCHED;
            XLDB1(0, 1); PG8_STAGE(PG8_SB(0, 0), b2, voffB);
            PG8_BAR; PG8_WAIT_L(0); XMMA1(0, 1); PG8_BAR;
            XLDA(0, 1); A_STG(PG8_SA(0, 0), a2, k2, 0, last);
            PG8_BAR; PG8_WAIT_L(0); XMMA0(1, 0); PG8_BAR; PG8_SCHED;
            PG8_STAGE(PG8_SB(0, 1), b2 + hstepB, voffB);
            PG8_WAIT_V(6); PG8_BAR; XMMA1(1, 1); PG8_BAR;
            XLDB0(1, 0); PG8_SCHED; XLDA(1, 0); A_STG(PG8_SA(0, 1), a2 + hstepA, k2, 1, last);
            PG8_WAIT_L(8); PG8_BAR; PG8_WAIT_L(0); XMMA0(0, 0); PG8_BAR; PG8_SCHED;
            XLDB1(1, 1); PG8_STAGE(PG8_SB(1, 0), b3, voffB);
            PG8_BAR; PG8_WAIT_L(0); XMMA1(0, 1); PG8_BAR;
            XLDA(1, 1); A_STG(PG8_SA(1, 0), a3, k3, 0, last);
            PG8_BAR; PG8_WAIT_L(0); XMMA0(1, 0); PG8_BAR; PG8_SCHED;
            PG8_STAGE(PG8_SB(1, 1), b3 + hstepB, voffB);
            PG8_WAIT_V(6); PG8_BAR; XMMA1(1, 1); PG8_BAR;
            }
        }
        if constexpr (GEMM_ALIGN) { if (wr == 0) PG8_BAR; }
        {
            int tz = threadIdx.x; asm volatile("" : "+v"(tz));
            const int wid2 = tz >> 6, lane2 = tz & 63;
            E(acc, cur, wid2 >> 2, wid2 & 3, lane2 & 15, lane2 >> 4); }
        if (!has_next) break;
#pragma unroll
        for (int a = 0; a < 2; ++a)
#pragma unroll
            for (int b = 0; b < 2; ++b)
#pragma unroll
                for (int m = 0; m < 4; ++m)
#pragma unroll
                    for (int n = 0; n < 2; ++n) { if constexpr (Sched::FP8) { f32x2 z0_, z1_; asm volatile("v_pk_mov_b32 %0, 0, 0" : "=v"(z0_)); asm volatile("v_pk_mov_b32 %0, 0, 0" : "=v"(z1_)); acc[a][b][m][n] = (f32x4){z0_.x, z0_.y, z1_.x, z1_.y}; } else acc[a][b][m][n] = (f32x4){0.f, 0.f, 0.f, 0.f}; }
        cur = nxt; cA = nA; cB = nB; ++ui;
        if constexpr (GEMM_ALIGN) { if (wr == 1) PG8_BAR; }
    }
    PG8_WAIT_V(0);
    if constexpr (!GEMM_ALIGN) { if (wr == 0) PG8_BAR; }
    PG8_BAR;
#undef XLDA
#undef XLDB0
#undef XLDB1
#undef XMMA0
#undef XMMA1
#undef PG8_LDA8
#undef PG8_LDB8
#undef PG8_MMA8
#undef A_STG
#undef PG8_SA
#undef PG8_SB
#undef PG8_STAGE
#undef PG8_LDA
#undef PG8_LDB
#undef PG8_MMA
#undef PG8_WAIT_V
#undef PG8_WAIT_L
#undef PG8_BAR
#undef PG8_SCHED
}

struct PlainSched {
    static constexpr bool GATHER = false, FP8 = false;
    const char* A; const char* B; int K, lda, ldb, nM, nN, nwg, G, c; int akoff_pn = 1 << 30, akoff_bytes = 0;
    DI void init(const void* A_, const void* B_, int M, int N, int K_, int lda_, int ldb_, int G_, int c_) { A = (const char*)A_; B = (const char*)B_; K = K_; lda = lda_; ldb = ldb_; nM = M / BM; nN = N / BM; nwg = nM * nN; G = G_; c = c_; }
    DI bool next(int i, Unit& u) const {
        const long L = (long)i * G + c; if (L >= nwg) return false;
        int wgid = (int)L; { const int q = nwg / 8, r = nwg % 8, xcd = wgid % 8, off = wgid / 8; wgid = (xcd < r ? xcd * (q + 1) : r * (q + 1) + (xcd - r) * q) + off; }
        const int nig = 8 * nN, gid = wgid / nig, fm = gid * 8, gsz = (nM - fm) < 8 ? (nM - fm) : 8;
        u.pm = fm + ((wgid % nig) % gsz); u.pn = (wgid % nig) / gsz; u.aux = 0; return true;
    }
    DI const char* a_ptr(const Unit& u) const { return A + (size_t)u.pm * BM * lda * 2 + (u.pn >= akoff_pn ? akoff_bytes : 0); }
    DI const char* b_ptr(const Unit& u) const { return B + (size_t)u.pn * BM * ldb * 2; }
};
struct GroupSched {
    static constexpr bool GATHER = false, FP8 = false;
    const char* A; const char* B; int K, lda, ldb, nMg, nN, nwg, G, c;
    DI void init(const void* A_, const void* B_, int K_, int lda_, int ldb_, int nMg_, int nN_, int G_, int c_) { A = (const char*)A_; B = (const char*)B_; K = K_; lda = lda_; ldb = ldb_; nMg = nMg_; nN = nN_; nwg = 32 * nMg * nN; G = G_; c = c_; }
    DI bool next(int i, Unit& u) const {
        const int L = i * G + c; if (L >= nwg) return false;
        const int per = nMg * nN, g = L / per, rem = L % per; u.pm = g * nMg + rem / nN; u.pn = rem % nN; u.aux = g; return true;
    }
    DI const char* a_ptr(const Unit& u) const { return A + (size_t)u.pm * BM * lda * 2; }
    DI const char* b_ptr(const Unit& u) const { return B + ((size_t)u.aux * nN + u.pn) * BM * ldb * 2; }
};
template <bool GATH>
struct MoeSched {
    static constexpr bool GATHER = GATH, FP8 = true;
    const char* A; const char* B; const int* tile_e; const int* rowtok; int K, lda, ldb, nN, NperE, nwg, G, c;
    DI void init(const void* A_, const void* B_, const int* te, const int* rt, int ntiles, int K_, int nN_, int G_, int c_) { A = (const char*)A_; B = (const char*)B_; tile_e = te; rowtok = rt; K = K_; lda = K_; ldb = K_; nN = nN_; NperE = nN_ * BM; nwg = ntiles * nN_; G = G_; c = c_; }
    DI bool next(int i, Unit& u) const {
        int L = i * G + c; if (L >= nwg) return false;
        if (G == 256 && (i + 1) * G <= nwg) { const int x = c & 7, sl = c >> 3, mt = G / nN / 8;
            L = i * G + (x * mt + sl / nN) * nN + (sl % nN); }
        u.pm = L / nN; u.pn = L % nN; u.aux = __builtin_amdgcn_readfirstlane(__hip_atomic_load(tile_e + u.pm, __ATOMIC_RELAXED, __HIP_MEMORY_SCOPE_AGENT)); return true;
    }
    DI const char* a_ptr(const Unit& u) const { return GATH ? A : A + (size_t)u.pm * BM * lda * 2; }
    DI unsigned a_rowoff(const Unit& u, int row) const { return (unsigned)__hip_atomic_load(rowtok + u.pm * BM + row, __ATOMIC_RELAXED, __HIP_MEMORY_SCOPE_AGENT) * (unsigned)(lda * 2); }
    DI const char* b_ptr(const Unit& u) const { return B + ((size_t)u.aux * NperE + (size_t)u.pn * BM) * ldb * 2; }
};

typedef f32x4 AccT[2][2][4][2];
struct EpiWin {
    static constexpr bool PERM = true;
    bf16_t* us5; bf16_t* prw; bf16_t* gates;
    DI static u32x4 pack8(const f32x4& v0, const f32x4& v1) { u32x4 w; w.x = cvt_pk_bf16(v0[0], v0[1]); w.y = cvt_pk_bf16(v0[2], v0[3]); w.z = cvt_pk_bf16(v1[0], v1[1]); w.w = cvt_pk_bf16(v1[2], v1[3]); return w; }
    DI void operator()(const AccT& acc, const Unit& u, int wr, int wc, int fr, int fq) const {
        if (u.pn < 2) {
#pragma unroll
            for (int ai = 0; ai < 2; ++ai)
#pragma unroll
                for (int m = 0; m < 4; ++m) { const int r = u.pm * BM + ai * HALF + wr * 64 + m * 16 + fr, b = r >> 12, sq = r & 4095, ch = sq / S5L, j = sq % S5L;
#pragma unroll
                    for (int bj = 0; bj < 2; ++bj) { const int c0 = u.pn * BM + bj * HALF + wc * 32 + 8 * fq, g = c0 >> 4, ci = c0 & 15;
                        *(u32x4*)(us5 + ((size_t)(g * S5ROWS + b * S5NC + ch) * LDU + j * 16 + ci)) = pack8(acc[ai][bj][m][0], acc[ai][bj][m][1]); } }
        } else if (u.pn < 9) {
#pragma unroll
            for (int ai = 0; ai < 2; ++ai)
#pragma unroll
                for (int m = 0; m < 4; ++m) { const int r = u.pm * BM + ai * HALF + wr * 64 + m * 16 + fr;
#pragma unroll
                    for (int bj = 0; bj < 2; ++bj) { const int c0 = u.pn * BM + bj * HALF + wc * 32 + 8 * fq;
                        *(u32x4*)(prw + (size_t)r * RWC + (c0 - 512)) = pack8(acc[ai][bj][m][0], acc[ai][bj][m][1]); } }
        } else {
#pragma unroll
            for (int ai = 0; ai < 2; ++ai)
#pragma unroll
                for (int m = 0; m < 4; ++m) { const int r = u.pm * BM + ai * HALF + wr * 64 + m * 16 + fr;
#pragma unroll
                    for (int bj = 0; bj < 2; ++bj) { const int c0 = u.pn * BM + bj * HALF + wc * 32 + 8 * fq;
                        const f32x4& v0 = acc[ai][bj][m][0]; const f32x4& v1 = acc[ai][bj][m][1];
                        const f32x2 a_ = pk_sigmoid(lo2(v0)), b_ = pk_sigmoid(hi2(v0)), c_ = pk_sigmoid(lo2(v1)), d_ = pk_sigmoid(hi2(v1));
                        u32x4 w; w.x = cvt_pk_bf16(a_.x, a_.y); w.y = cvt_pk_bf16(b_.x, b_.y); w.z = cvt_pk_bf16(c_.x, c_.y); w.w = cvt_pk_bf16(d_.x, d_.y);
                        *(u32x4*)(gates + (size_t)r * 2048 + (c0 - 2304)) = w; } }
        }
    }
};
struct EpiS5State {
    static constexpr bool PERM = false;
    float* sloc;
    DI void operator()(const AccT& acc, const Unit& u, int wr, int wc, int fr, int fq) const {
#pragma unroll
        for (int ai = 0; ai < 2; ++ai)
#pragma unroll
            for (int m = 0; m < 4; ++m) {
                const int r = u.pm * BM + ai * HALF + wr * 64 + m * 16 + fr;
#pragma unroll
                for (int n = 0; n < 2; ++n) *(f32x4*)(sloc + (size_t)r * 128 + wc * 32 + 16 * n + 4 * fq) = acc[ai][0][m][n];
            }
    }
};
struct EpiS5Out {
    static constexpr bool PERM = true;
    bf16_t* ys;
    DI void operator()(const AccT& acc, const Unit& u, int wr, int wc, int fr, int fq) const {
        const int g = u.aux;
#pragma unroll
        for (int ai = 0; ai < 2; ++ai)
#pragma unroll
            for (int m = 0; m < 4; ++m) {
                const int r = u.pm * BM + ai * HALF + wr * 64 + m * 16 + fr;
                const int rc = r - g * S5ROWS;
#pragma unroll
                for (int bj = 0; bj < 2; ++bj) {
                    const int c0 = u.pn * BM + bj * HALF + wc * 32 + 8 * fq;
                    const int t = c0 >> 4, co = c0 & 15;
                    const size_t tok = (size_t)rc * S5L + t;
                    f32x4 v0 = acc[ai][bj][m][0], v1 = acc[ai][bj][m][1];
                    { const f32x2 a_ = pk_gelu_tanh(lo2(v0)), b_ = pk_gelu_tanh(hi2(v0)), c_ = pk_gelu_tanh(lo2(v1)), d_ = pk_gelu_tanh(hi2(v1));
                      v0 = (f32x4){a_.x, a_.y, b_.x, b_.y}; v1 = (f32x4){c_.x, c_.y, d_.x, d_.y}; }
                    u32x4 w; w.x = cvt_pk_bf16(v0[0], v0[1]); w.y = cvt_pk_bf16(v0[2], v0[3]); w.z = cvt_pk_bf16(v1[0], v1[1]); w.w = cvt_pk_bf16(v1[2], v1[3]);
                    *(u32x4*)(ys + tok * 512 + g * 16 + co) = w;
                }
            }
    }
};
struct EpiLora {
    static constexpr bool PERM = true;
    bf16_t* lwag; const float* w0; const float* a0;
    DI void operator()(const AccT& acc, const Unit& u, int wr, int wc, int fr, int fq) const {
#pragma unroll
        for (int bj = 0; bj < 2; ++bj) {
            const int c0 = u.pn * BM + bj * HALF + wc * 32 + 8 * fq;
            f32x4 b0 = (f32x4){0.f, 0.f, 0.f, 0.f}, b1 = b0;
            if (c0 < 512) { b0 = *(const f32x4*)(w0 + c0); b1 = *(const f32x4*)(w0 + c0 + 4); } else if (c0 < 1024) { b0 = *(const f32x4*)(a0 + c0 - 512); b1 = *(const f32x4*)(a0 + c0 - 508); }
            const f32x2 bias[4] = {lo2(b0), hi2(b0), lo2(b1), hi2(b1)};
            const float osc = (c0 < 512) ? -0.6065306597f : 1.0f;
            if (c0 < 1024) {
#pragma unroll
                for (int ai = 0; ai < 2; ++ai)
#pragma unroll
                    for (int m = 0; m < 4; ++m) { const int r = u.pm * BM + ai * HALF + wr * 64 + m * 16 + fr; u32x4 w;
#pragma unroll
                        for (int jp = 0; jp < 4; ++jp) { const f32x4& a = acc[ai][bj][m][jp >> 1]; const f32x2 v = pk_sigmoid(((jp & 1) ? hi2(a) : lo2(a)) + bias[jp]) * osc; w[jp] = cvt_pk_bf16(v.x, v.y); }
                        *(u32x4*)(lwag + (size_t)r * 1536 + c0) = w; }
            } else {
#pragma unroll
                for (int ai = 0; ai < 2; ++ai)
#pragma unroll
                    for (int m = 0; m < 4; ++m) { const int r = u.pm * BM + ai * HALF + wr * 64 + m * 16 + fr; u32x4 w;
#pragma unroll
                        for (int jp = 0; jp < 4; ++jp) { const f32x4& a = acc[ai][bj][m][jp >> 1]; const f32x2 v = (jp & 1) ? hi2(a) : lo2(a); w[jp] = cvt_pk_bf16(v.x, v.y); }
                        *(u32x4*)(lwag + (size_t)r * 1536 + c0) = w; }
            }
        }
    }
};
struct EpiGlu {
    static constexpr bool PERM = true;
    bf16_t* mixed; const bf16_t* gates; const float* bglu;
    DI void operator()(const AccT& acc, const Unit& u, int wr, int wc, int fr, int fq) const {
        const int cw = wc * 32 + 8 * fq, j0 = u.pn * 128 + cw;
        const float* bp = bglu + u.pn * 256 + cw;
        const f32x4 ba0 = *(const f32x4*)bp, ba1 = *(const f32x4*)(bp + 4), bb0 = *(const f32x4*)(bp + 128), bb1 = *(const f32x4*)(bp + 132);
        const f32x2 ba[4] = {lo2(ba0), hi2(ba0), lo2(ba1), hi2(ba1)}, bb[4] = {lo2(bb0), hi2(bb0), lo2(bb1), hi2(bb1)};
        u32x4 gw[2][4];
#pragma unroll
        for (int ai = 0; ai < 2; ++ai)
#pragma unroll
            for (int m = 0; m < 4; ++m) gw[ai][m] = *(const u32x4*)(gates + (size_t)(u.pm * BM + ai * HALF + wr * 64 + m * 16 + fr) * 2048 + j0);
#pragma unroll
        for (int ai = 0; ai < 2; ++ai)
#pragma unroll
            for (int m = 0; m < 4; ++m) {
                const int r = u.pm * BM + ai * HALF + wr * 64 + m * 16 + fr;
                u32x4 w;
#pragma unroll
                for (int jp = 0; jp < 4; ++jp) {
                    const f32x4& aa = acc[ai][0][m][jp >> 1]; const f32x4& ab = acc[ai][1][m][jp >> 1];
                    const f32x2 za = ((jp & 1) ? hi2(aa) : lo2(aa)) + ba[jp], zb = ((jp & 1) ? hi2(ab) : lo2(ab)) + bb[jp];
                    const unsigned gwd = gw[ai][m][jp]; const f32x2 gt = {bf_lo(gwd), bf_hi(gwd)};
                    const f32x2 o = (gt * za) * pk_sigmoid(zb);
                    w[jp] = cvt_pk_bf16(o.x, o.y);
                }
                *(u32x4*)(mixed + (size_t)r * 1024 + j0) = w;
            }
    }
};
struct EpiWo {
    static constexpr bool PERM = true;
    bf16_t* mixed; const bf16_t* gates;
    DI void operator()(const AccT& acc, const Unit& u, int wr, int wc, int fr, int fq) const {
#pragma unroll
        for (int ai = 0; ai < 2; ++ai) {
            u32x4 gw[4][2], mw[4][2];
#pragma unroll
            for (int m = 0; m < 4; ++m)
#pragma unroll
                for (int bj = 0; bj < 2; ++bj) { const size_t r = (size_t)(u.pm * BM + ai * HALF + wr * 64 + m * 16 + fr); const int c0 = u.pn * BM + bj * HALF + wc * 32 + 8 * fq;
                    gw[m][bj] = *(const u32x4*)(gates + r * 2048 + 1024 + c0); mw[m][bj] = *(const u32x4*)(mixed + r * 1024 + c0); }
#pragma unroll
            for (int m = 0; m < 4; ++m)
#pragma unroll
                for (int bj = 0; bj < 2; ++bj) { const size_t r = (size_t)(u.pm * BM + ai * HALF + wr * 64 + m * 16 + fr); const int c0 = u.pn * BM + bj * HALF + wc * 32 + 8 * fq;
                    u32x4 w;
#pragma unroll
                    for (int jp = 0; jp < 4; ++jp) { const unsigned gwd = gw[m][bj][jp], mwd = mw[m][bj][jp]; const f32x4& a = acc[ai][bj][m][jp >> 1];
                        const f32x2 o = (f32x2){bf_lo(mwd), bf_hi(mwd)} + (f32x2){bf_lo(gwd), bf_hi(gwd)} * ((jp & 1) ? hi2(a) : lo2(a));
                        w[jp] = cvt_pk_bf16(o.x, o.y); }
                    *(u32x4*)(mixed + r * 1024 + c0) = w; }
        }
    }
};
struct EpiOut {
    static constexpr bool PERM = true;
    bf16_t* hb; const float* x;
    DI void operator()(const AccT& acc, const Unit& u, int wr, int wc, int fr, int fq) const {
#pragma unroll
        for (int ai = 0; ai < 2; ++ai) {
            f32x4 xv[4][2][2];
#pragma unroll
            for (int m = 0; m < 4; ++m) { const size_t r = (size_t)(u.pm * BM + ai * HALF + wr * 64 + m * 16 + fr);
#pragma unroll
                for (int bj = 0; bj < 2; ++bj) { const float* xp = x + r * 1024 + u.pn * BM + bj * HALF + wc * 32 + 8 * fq; xv[m][bj][0] = *(const f32x4*)xp; xv[m][bj][1] = *(const f32x4*)(xp + 4); } }
#pragma unroll
            for (int m = 0; m < 4; ++m) { const size_t r = (size_t)(u.pm * BM + ai * HALF + wr * 64 + m * 16 + fr);
#pragma unroll
                for (int bj = 0; bj < 2; ++bj) { const f32x4 v0 = xv[m][bj][0] + acc[ai][bj][m][0], v1 = xv[m][bj][1] + acc[ai][bj][m][1];
                    u32x4 w; w.x = cvt_pk_bf16(v0[0], v0[1]); w.y = cvt_pk_bf16(v0[2], v0[3]); w.z = cvt_pk_bf16(v1[0], v1[1]); w.w = cvt_pk_bf16(v1[2], v1[3]);
                    *(u32x4*)(hb + r * 1024 + u.pn * BM + bj * HALF + wc * 32 + 8 * fq) = w; } }
        }
    }
};
struct EpiRouter {
    static constexpr bool PERM = false;
    float* logits;
    DI void operator()(const AccT& acc, const Unit& u, int wr, int wc, int fr, int fq) const {
        if (wc != 0) return;
#pragma unroll
        for (int n = 0; n < 2; ++n) {
            const int c = 16 * n + 4 * fq;
#pragma unroll
            for (int ai = 0; ai < 2; ++ai)
#pragma unroll
                for (int m = 0; m < 4; ++m) {
                    const size_t r = (size_t)(u.pm * BM + ai * HALF + wr * 64 + m * 16 + fr);
                    *(f32x4*)(logits + r * 32 + c) = acc[ai][0][m][n];
                }
        }
    }
};
struct EpiMoe1 {
    static constexpr bool PERM = true;
    unsigned char* act; const float* b1p;
    DI void operator()(const AccT& acc, const Unit& u, int wr, int wc, int fr, int fq) const {
        const int cw = wc * 32 + 8 * fq, j0 = u.pn * 128 + cw;
        const float* bp = b1p + (size_t)u.aux * 2048 + u.pn * 256 + cw;
        const f32x4 ba0 = *(const f32x4*)bp, ba1 = *(const f32x4*)(bp + 4), bb0 = *(const f32x4*)(bp + 128), bb1 = *(const f32x4*)(bp + 132);
        const f32x2 ba[4] = {lo2(ba0), hi2(ba0), lo2(ba1), hi2(ba1)}, bb[4] = {lo2(bb0), hi2(bb0), lo2(bb1), hi2(bb1)};
        constexpr float sc = 1.0f / (F8_SX * F8_SW);
#pragma unroll
        for (int ai = 0; ai < 2; ++ai)
#pragma unroll
            for (int m = 0; m < 4; ++m) {
                const size_t r = (size_t)(u.pm * BM + ai * HALF + wr * 64 + m * 16 + fr);
                f32x2 o[4];
#pragma unroll
                for (int jp = 0; jp < 4; ++jp) {
                    const f32x4& ag = acc[ai][0][m][jp >> 1]; const f32x4& al_ = acc[ai][1][m][jp >> 1];
                    const f32x2 g = ((jp & 1) ? hi2(ag) : lo2(ag)) * sc + ba[jp], l = ((jp & 1) ? hi2(al_) : lo2(al_)) * sc + bb[jp];
                    const f32x2 xg = __builtin_elementwise_min(g, (f32x2){7.0f, 7.0f});
                    const f32x2 xl = __builtin_elementwise_min(__builtin_elementwise_max(l, (f32x2){-7.0f, -7.0f}), (f32x2){7.0f, 7.0f});
                    o[jp] = (xg * pk_sigmoid_scaled(xg, -1.702f * 1.44269504f)) * (xl * F8_SA + F8_SA);
                }
                u32x2 w; w.x = pk4_fp8_nc(o[0], o[1]); w.y = pk4_fp8_nc(o[2], o[3]);
                *(u32x2*)(act + r * 1024 + j0) = w;
            }
    }
};
struct EpiMoe2 {
    static constexpr bool PERM = true;
    unsigned char* y2; const float* b2; const float* rowg;
    DI void operator()(const AccT& acc, const Unit& u, int wr, int wc, int fr, int fq) const {
        float gt[2][4];
#pragma unroll
        for (int ai = 0; ai < 2; ++ai)
#pragma unroll
            for (int m = 0; m < 4; ++m) gt[ai][m] = rowg[(size_t)(u.pm * BM + ai * HALF + wr * 64 + m * 16 + fr)] * F8_SY;
#pragma unroll
        for (int bj = 0; bj < 2; ++bj) {
            const int c0 = u.pn * BM + bj * HALF + wc * 32 + 8 * fq;
            const f32x4 bva = *(const f32x4*)(b2 + (size_t)u.aux * 1024 + c0), bvb = *(const f32x4*)(b2 + (size_t)u.aux * 1024 + c0 + 4);
            const f32x2 bv[4] = {lo2(bva), hi2(bva), lo2(bvb), hi2(bvb)};
#pragma unroll
            for (int ai = 0; ai < 2; ++ai)
#pragma unroll
                for (int m = 0; m < 4; ++m) {
                    const size_t r = (size_t)(u.pm * BM + ai * HALF + wr * 64 + m * 16 + fr);
                    const float g = gt[ai][m];
                    f32x2 o[4];
#pragma unroll
                    for (int jp = 0; jp < 4; ++jp) { const f32x4& a = acc[ai][bj][m][jp >> 1];
                        o[jp] = (((jp & 1) ? hi2(a) : lo2(a)) * (1.0f / (F8_SA * F8_SW)) + bv[jp]) * g;
                        o[jp] = __builtin_elementwise_min(__builtin_elementwise_max(o[jp], (f32x2){-448.f, -448.f}), (f32x2){448.f, 448.f}); }
                    u32x2 w; w.x = pk4_fp8_nc(o[0], o[1]); w.y = pk4_fp8_nc(o[2], o[3]);
                    *(u32x2*)(y2 + r * 1024 + c0) = w;
                }
        }
    }
};
struct KArgs { const float* in[34]; float* out; unsigned char* ws; int ph_lo, ph_hi; };
struct Frame {
    LAS unsigned char* lds; int tid, lane, wave, G, bid;
    const float* const* in; float* out; unsigned char* ws;
};

template <class MP>
DI void conv_T(const Frame& F, const float* src, size_t src_bstride, int ld, bf16_t* dst, int N, int K, int nbatch, MP mp, int t0 = 0, int t1 = 0x7fffffff) {
    LAS unsigned* tile = (LAS unsigned*)F.lds;
    const int ntk = K / 64, ntn = N / 256, per = ntk * ntn;
    const int tend = (per * nbatch) < t1 ? (per * nbatch) : t1;
    for (int t = t0 + F.bid; t < tend; t += F.G) {
        const int bt = t / per, tt = t % per, tk = tt % ntk, pn = tt / ntk;
        const float* s = src + (size_t)bt * src_bstride + (size_t)(tk * 64) * ld + mp.src(pn, F.lane);
        f32x4 va[4], vb[4];
#pragma unroll
        for (int i = 0; i < 4; ++i) { const int kp = F.wave + 8 * i; va[i] = *(const f32x4*)(s + (size_t)(2 * kp) * ld); vb[i] = *(const f32x4*)(s + (size_t)(2 * kp + 1) * ld); }
#pragma unroll
        for (int i = 0; i < 4; ++i) { const int kp = F.wave + 8 * i;
#pragma unroll
            for (int j = 0; j < 4; ++j) tile[mp.dst(F.lane, j) * 33 + kp] = cvt_pk_bf16(va[i][j], vb[i][j]); }
        __syncthreads();
        unsigned* d = (unsigned*)(dst + (size_t)bt * N * K + (size_t)(pn * 256) * K + tk * 64);
#pragma unroll
        for (int i = 0; i < 4; ++i) { const int pc = F.tid + NTHR * i, nn = pc >> 3, seg = pc & 7;
            u32x4 w; w.x = tile[nn * 33 + seg * 4]; w.y = tile[nn * 33 + seg * 4 + 1]; w.z = tile[nn * 33 + seg * 4 + 2]; w.w = tile[nn * 33 + seg * 4 + 3];
            *(u32x4*)(d + ((size_t)nn * K) / 2 + seg * 4) = w; }
        __syncthreads();
    }
}
template <class MP>
DI void conv_T8(const Frame& F, const float* src, size_t src_bstride, int ld, unsigned char* dst, int N, int K, int nbatch, MP mp, float scale, int t0 = 0, int t1 = 0x7fffffff) {
    LAS unsigned* tile = (LAS unsigned*)F.lds;
    const int ntk = K / 64, ntn = N / 256, per = ntk * ntn;
    const int tend = (per * nbatch) < t1 ? (per * nbatch) : t1;
    for (int t = t0 + F.bid; t < tend; t += F.G) {
        const int bt = t / per, tt = t % per, tk = tt % ntk, pn = tt / ntk;
        const float* s = src + (size_t)bt * src_bstride + (size_t)(tk * 64) * ld + mp.src(pn, F.lane);
        f32x4 v[2][4];
#pragma unroll
        for (int i = 0; i < 2; ++i) { const int kq = F.wave + 8 * i;
#pragma unroll
            for (int e = 0; e < 4; ++e) v[i][e] = *(const f32x4*)(s + (size_t)(4 * kq + e) * ld); }
#pragma unroll
        for (int i = 0; i < 2; ++i) { const int kq = F.wave + 8 * i;
#pragma unroll
            for (int j = 0; j < 4; ++j) tile[mp.dst(F.lane, j) * 17 + kq] = pk4_fp8(v[i][0][j] * scale, v[i][1][j] * scale, v[i][2][j] * scale, v[i][3][j] * scale); }
        __syncthreads();
        unsigned char* d = dst + ((size_t)bt * N + (size_t)pn * 256) * K + tk * 64;
#pragma unroll
        for (int i = 0; i < 2; ++i) { const int pc = F.tid + NTHR * i, nn = pc >> 2, seg = pc & 3;
            u32x4 w; w.x = tile[nn * 17 + seg * 4]; w.y = tile[nn * 17 + seg * 4 + 1]; w.z = tile[nn * 17 + seg * 4 + 2]; w.w = tile[nn * 17 + seg * 4 + 3];
            *(u32x4*)(d + (size_t)nn * K + seg * 16) = w; }
        __syncthreads();
    }
}
struct MpId  { DI int src(int pn, int f) const { return pn * 256 + 4 * f; } DI int dst(int f, int j) const { return 4 * f + j; } };
struct MpSwi { DI int src(int pn, int f) const { return pn * 256 + 4 * f; } DI int dst(int f, int j) const { const int n = 4 * f + j; return (n >> 1) + 128 * (n & 1); } };
struct MpGlu { DI int src(int pn, int f) const { const int w = 4 * f; return pn * 128 + (w & 127) + 1024 * (w >> 7); } DI int dst(int f, int j) const { return 4 * f + j; } };
struct CmGlu { DI int operator()(int n) const { const int pn = n >> 8, w = n & 255; return pn * 128 + (w & 127) + 1024 * (w >> 7); } };
struct CmSwi { DI int operator()(int n) const { const int pn = n >> 8, w = n & 255; return 2 * (pn * 128 + (w & 127)) + (w >> 7); } };

DI void rmsnorm_rows(const Frame& F, const float* x, const float* g, bf16_t* out, int row0, int nrows, unsigned char* out8 = nullptr) {
    const int stride = F.G * NWAVES;
    for (int row = row0 + F.bid * NWAVES + F.wave; row < row0 + nrows; row += 2 * stride) {
        const int row2 = (row + stride < row0 + nrows) ? row + stride : row;
        const f32x4* xr = (const f32x4*)(x + (size_t)row * D); const f32x4* xr2 = (const f32x4*)(x + (size_t)row2 * D);
        f32x4 v[4], u[4]; float ss = 0.f, su = 0.f;
#pragma unroll
        for (int i = 0; i < 4; ++i) { v[i] = xr[i * 64 + F.lane]; u[i] = xr2[i * 64 + F.lane]; }
#pragma unroll
        for (int i = 0; i < 4; ++i) { ss += v[i][0] * v[i][0] + v[i][1] * v[i][1] + v[i][2] * v[i][2] + v[i][3] * v[i][3]; su += u[i][0] * u[i][0] + u[i][1] * u[i][1] + u[i][2] * u[i][2] + u[i][3] * u[i][3]; }
        ss = wave_sum(ss); su = wave_sum(su);
        const float rs = rsqrtf(ss * (1.0f / D) + 1e-5f), ru = rsqrtf(su * (1.0f / D) + 1e-5f);
#pragma unroll
        for (int i = 0; i < 4; ++i) { const f32x4 gv = ((const f32x4*)g)[i * 64 + F.lane];
            u32x2 w; w.x = cvt_pk_bf16(v[i][0] * rs * gv[0], v[i][1] * rs * gv[1]); w.y = cvt_pk_bf16(v[i][2] * rs * gv[2], v[i][3] * rs * gv[3]);
            *(u32x2*)(out + (size_t)row * D + (i * 64 + F.lane) * 4) = w;
            u32x2 w2; w2.x = cvt_pk_bf16(u[i][0] * ru * gv[0], u[i][1] * ru * gv[1]); w2.y = cvt_pk_bf16(u[i][2] * ru * gv[2], u[i][3] * ru * gv[3]);
            *(u32x2*)(out + (size_t)row2 * D + (i * 64 + F.lane) * 4) = w2;
            if (out8) { *(unsigned*)(out8 + (size_t)row * D + (i * 64 + F.lane) * 4) = pk4_fp8(v[i][0] * rs * gv[0] * F8_SX, v[i][1] * rs * gv[1] * F8_SX, v[i][2] * rs * gv[2] * F8_SX, v[i][3] * rs * gv[3] * F8_SX);
                *(unsigned*)(out8 + (size_t)row2 * D + (i * 64 + F.lane) * 4) = pk4_fp8(u[i][0] * ru * gv[0] * F8_SX, u[i][1] * ru * gv[1] * F8_SX, u[i][2] * ru * gv[2] * F8_SX, u[i][3] * ru * gv[3] * F8_SX); } }
    }
}

DI void p0_prologue(const Frame& F) {
    unsigned char* ws = F.ws;
    conv_T(F, F.in[2], 0, INC, (bf16_t*)(ws + WS_WIN), INC, D, 1, MpId());
    conv_T(F, F.in[11], 0, 2048, (bf16_t*)(ws + WS_WGLU), 2048, 512, 1, MpGlu());
    conv_T(F, F.in[24], 0, 1024, (bf16_t*)(ws + WS_WO), 1024, 512, 1, MpId());
    conv_T(F, F.in[25], 0, 1024, (bf16_t*)(ws + WS_WOUT), 1024, 1024, 1, MpId());
    {
        bf16_t* wl = (bf16_t*)(ws + WS_WLORA); const float* w2 = F.in[15]; const float* a2 = F.in[17]; const float* g2 = F.in[18];
        for (int idx = F.bid * NTHR + F.tid; idx < 1536 * 128; idx += F.G * NTHR) { const int n = idx >> 7, k = idx & 127; float v = 0.f;
            if (n < 512) { if (k < 64) v = w2[k * 512 + n]; } else if (n < 1024) { if (k >= 64) v = a2[(k - 64) * 512 + (n - 512)]; } else { v = g2[k * 512 + (n - 1024)]; }
            wl[idx] = f2bf(v); }
        bf16_t* wrt = (bf16_t*)(ws + WS_WR); const float* rw = F.in[27];
        for (int idx = F.bid * NTHR + F.tid; idx < 256 * 1024; idx += F.G * NTHR) { const int n = idx >> 10, k = idx & 1023; wrt[idx] = f2bf(n < 32 ? rw[k * 32 + n] * F.in[26][k] : 0.f); }
        float* bg = (float*)(ws + WS_BGLU); const float* bsrc = F.in[12]; CmGlu cm;
        for (int idx = F.bid * NTHR + F.tid; idx < 2048; idx += F.G * NTHR) bg[idx] = bsrc[cm(idx)];
    }
    if (F.bid & 1) rmsnorm_rows(F, F.in[0], F.in[1], (bf16_t*)(ws + WS_XN), 0, T);
    {
        LAS float* L = (LAS float*)F.lds;
        LAS float* pwr = L, *pwi = L + 64, *p1r = L + 128, *p1i = L + 192, *ffr = L + 256, *ffi = L + 320;
        LAS float* bbr = L + 384, *bbi = bbr + 1024, *ccr = bbi + 1024, *cci = ccr + 1024, *kj = cci + 1024;
        const float* lam_re = F.in[3]; const float* lam_im = F.in[4]; const float* log_dt = F.in[5];
        const float* b_re = F.in[6]; const float* b_im = F.in[7]; const float* c_re = F.in[8]; const float* c_im = F.in[9]; const float* dsk = F.in[10];
        unsigned* toep = (unsigned*)(ws + WS_TOEP); unsigned* wst = (unsigned*)(ws + WS_WST);
        for (int it = F.bid; it < 32 * S5L; it += F.G) {
            const int g = it / S5L, j = it % S5L;
            if (F.tid < 64) { const int p = F.tid; const float lr = lam_re[g * 64 + p], li = lam_im[g * 64 + p], dt = __expf(log_dt[g]);
                float sn, cs; { const float mg = expf((float)j * lr * dt); sincosf((float)j * (li * dt), &sn, &cs); pwr[p] = mg * cs; pwi[p] = mg * sn; }
                { const float mg = expf((float)(j + 1) * lr * dt); sincosf((float)(j + 1) * (li * dt), &sn, &cs); p1r[p] = mg * cs; p1i[p] = mg * sn; }
                { const float mg = expf(lr * dt); sincosf(li * dt, &sn, &cs); const float nr = mg * cs - 1.0f, ni = mg * sn, den = lr * lr + li * li;
                  ffr[p] = (nr * lr + ni * li) / den; ffi[p] = (ni * lr - nr * li) / den; } }
            __syncthreads();
            for (int idx = F.tid; idx < 1024; idx += NTHR) { const int p = idx >> 4; const float br = b_re[g * 1024 + idx], bi = b_im[g * 1024 + idx];
                bbr[idx] = ffr[p] * br - ffi[p] * bi; bbi[idx] = ffr[p] * bi + ffi[p] * br;
                ccr[idx] = c_re[g * 1024 + idx]; cci[idx] = c_im[g * 1024 + idx]; }
            __syncthreads();
            if (F.tid < 256) { const int co = F.tid >> 4, ci = F.tid & 15; float s = 0.f;
                for (int p = 0; p < 64; ++p) { const float zr = pwr[p] * bbr[p * 16 + ci] - pwi[p] * bbi[p * 16 + ci], zi = pwr[p] * bbi[p * 16 + ci] + pwi[p] * bbr[p * 16 + ci];
                    s += ccr[co * 64 + p] * zr - cci[co * 64 + p] * zi; }
                if (j == 0 && co == ci) s += dsk[g * 16 + co];
                kj[F.tid] = s; }
            __syncthreads();
            for (int idx = F.tid; idx < (S5L - j) * 128; idx += NTHR) { const int t = j + idx / 128, rem = idx % 128, co = rem >> 3, ci = (rem & 7) * 2;
                toep[((size_t)(g * 512 + t * 16 + co) * LDU + (t - j) * 16 + ci) / 2] = cvt_pk_bf16(kj[co * 16 + ci], kj[co * 16 + ci + 1]);
                if (j > 0) toep[((size_t)(g * 512 + (t - j) * 16 + co) * LDU + t * 16 + ci) / 2] = 0u; }
            for (int idx = F.tid; idx < 16 * 64; idx += NTHR) { const int co = idx >> 6, q = (idx & 63) * 2; float o[2];
#pragma unroll
                for (int e = 0; e < 2; ++e) { const int qq = q + e, p = qq & 63; const float cr = ccr[co * 64 + p], cim = cci[co * 64 + p];
                    o[e] = (qq < 64) ? (cr * p1r[p] - cim * p1i[p]) : -(cr * p1i[p] + cim * p1r[p]); }
                toep[((size_t)(g * 512 + j * 16 + co) * LDU + 512 + q) / 2] = cvt_pk_bf16(o[0], o[1]); }
            { const int s = S5L - 1 - j;
              for (int idx = F.tid; idx < 256 * 8; idx += NTHR) { const int q = idx >> 3, ci = (idx & 7) * 2; float o[2] = {0.f, 0.f};
                if (q < 128) { const int p = q & 63;
#pragma unroll
                    for (int e = 0; e < 2; ++e) { const float br = bbr[p * 16 + ci + e], bi = bbi[p * 16 + ci + e];
                        o[e] = (q < 64) ? (pwr[p] * br - pwi[p] * bi) : (pwr[p] * bi + pwi[p] * br); } }
                wst[((size_t)(g * 256 + q) * 512 + s * 16 + ci) / 2] = cvt_pk_bf16(o[0], o[1]); } }
            __syncthreads();
        }
    }
    if (!(F.bid & 1)) rmsnorm_rows(F, F.in[0], F.in[1], (bf16_t*)(ws + WS_XN), 0, T);
}

DI void p_rw_prep(const Frame& F) {
    const bf16_t* prw = (const bf16_t*)(F.ws + WS_PRW); bf16_t* al_ = (bf16_t*)(F.ws + WS_ALORA); const float* mu = F.in[13];
    for (int idx = F.bid * NTHR + F.tid; idx < T * 32; idx += F.G * NTHR) {
        const int t = idx >> 5, c8 = (idx & 31) * 8;
        const u32x4 cur = *(const u32x4*)(prw + (size_t)t * RWC + 1536 + c8);
        u32x4 prv = (u32x4){0u, 0u, 0u, 0u};
        if ((t & (SEQ - 1)) != 0) prv = *(const u32x4*)(prw + (size_t)(t - 1) * RWC + 1536 + c8);
        float o[8];
#pragma unroll
        for (int j = 0; j < 8; ++j) { const float c = (j & 1) ? bf_hi(cur[j >> 1]) : bf_lo(cur[j >> 1]), p = (j & 1) ? bf_hi(prv[j >> 1]) : bf_lo(prv[j >> 1]);
            const float xs = c + mu[1536 + c8 + j] * (p - c);
            o[j] = (c8 < 64) ? ftanh(xs) : ((c8 < 128) ? xs : fsigmoid(xs)); }
        u32x4 w; w.x = cvt_pk_bf16(o[0], o[1]); w.y = cvt_pk_bf16(o[2], o[3]); w.z = cvt_pk_bf16(o[4], o[5]); w.w = cvt_pk_bf16(o[6], o[7]);
        *(u32x4*)(al_ + (size_t)t * 256 + c8) = w;
    }
}

DI void p_s5_carry(const Frame& F) {
    const float* lam_re = F.in[3]; const float* lam_im = F.in[4]; const float* log_dt = F.in[5];
    const float* sloc = (const float*)(F.ws + WS_SLOC); bf16_t* us5 = (bf16_t*)(F.ws + WS_US5);
    for (int gt = F.bid * NTHR + F.tid; gt < NB * 32 * 64; gt += F.G * NTHR) {
        const int p = gt & 63, g = (gt >> 6) & 31, b = gt >> 11;
        const float lr = lam_re[g * 64 + p], li = lam_im[g * 64 + p], dt = __expf(log_dt[g]);
        float sn, cs; const float mg = expf((float)S5L * lr * dt); sincosf((float)S5L * (li * dt), &sn, &cs);
        const float ar = mg * cs, ai = mg * sn;
        float xr = 0.f, xi = 0.f;
        const size_t row0 = (size_t)g * S5ROWS + (size_t)b * S5NC;
        for (int cb = 0; cb < S5NC; cb += 16) {
            float sr[16], si[16];
#pragma unroll
            for (int j = 0; j < 16; ++j) { sr[j] = sloc[(row0 + cb + j) * 128 + p]; si[j] = sloc[(row0 + cb + j) * 128 + 64 + p]; }
#pragma unroll
            for (int j = 0; j < 16; ++j) { const size_t row = row0 + cb + j;
                us5[row * LDU + 512 + p] = f2bf(xr); us5[row * LDU + 576 + p] = f2bf(xi);
                const float nr = ar * xr - ai * xi + sr[j], ni = ar * xi + ai * xr + si[j];
                xr = nr; xi = ni; }
        }
    }
}

constexpr int PT = 72, SLOTB = 64 * PT * 2;
DI LAS bf16_t* rslot(LAS unsigned char* lds, int i) { return (LAS bf16_t*)(lds + i * SLOTB); }
DI void mm_acc(f32x4 (&acc)[2], const LAS bf16_t* A, const LAS bf16_t* Bt, int ti, int tj0, int r, int q) {
#pragma unroll
    for (int s2 = 0; s2 < 2; ++s2) {
        const bf16x8 a = *(const LAS bf16x8*)(A + (16 * ti + r) * PT + 32 * s2 + 8 * q);
#pragma unroll
        for (int e = 0; e < 2; ++e) { const bf16x8 b = *(const LAS bf16x8*)(Bt + (16 * (tj0 + e) + r) * PT + 32 * s2 + 8 * q);
            acc[e] = __builtin_amdgcn_mfma_f32_16x16x32_bf16(a, b, acc[e], 0, 0, 0); }
    }
}
DI void mm_acc_bnat(f32x4 (&acc)[2], const LAS bf16_t* A, const LAS bf16_t* Bn, int ti, int tj0, int r, int q) {
#pragma unroll
    for (int s2 = 0; s2 < 2; ++s2) {
        const bf16x8 a = *(const LAS bf16x8*)(A + (16 * ti + r) * PT + 32 * s2 + 8 * q);
#pragma unroll
        for (int e = 0; e < 2; ++e) { bf16x8 b;
#pragma unroll
            for (int jj = 0; jj < 8; ++jj) b[jj] = (short)Bn[(32 * s2 + 8 * q + jj) * PT + 16 * (tj0 + e) + r];
            acc[e] = __builtin_amdgcn_mfma_f32_16x16x32_bf16(a, b, acc[e], 0, 0, 0); }
    }
}
DI void st_rm(LAS bf16_t* Dm, const f32x4& v, int i0, int j) {
#pragma unroll
    for (int g = 0; g < 4; ++g) Dm[(i0 + g) * PT + j] = f2bf(v[g]);
}
DI void st_tr(LAS bf16_t* Dm, const f32x4& v, int i0, int j) { u32x2 w; w.x = cvt_pk_bf16(v[0], v[1]); w.y = cvt_pk_bf16(v[2], v[3]); *(LAS u32x2*)(Dm + j * PT + i0) = w; }
DI f32x4 ld_rm(const LAS bf16_t* Sm, int i0, int j) { f32x4 v;
#pragma unroll
    for (int g = 0; g < 4; ++g) v[g] = bf2f(Sm[(i0 + g) * PT + j]);
    return v; }
DI void ld_frag(bf16x8 (&f)[2], const LAS bf16_t* M, int row, int q) { f[0] = *(const LAS bf16x8*)(M + row * PT + 8 * q); f[1] = *(const LAS bf16x8*)(M + row * PT + 32 + 8 * q); }
DI f32x4 mm2(const bf16x8 (&x)[2], const bf16x8 (&y)[2], f32x4 c) { c = __builtin_amdgcn_mfma_f32_16x16x32_bf16(x[0], y[0], c, 0, 0, 0); return __builtin_amdgcn_mfma_f32_16x16x32_bf16(x[1], y[1], c, 0, 0, 0); }
typedef short v4i16_t __attribute__((ext_vector_type(4)));
DI void ld_frag_tr(bf16x8 (&f)[2], const LAS bf16_t* XT, int T0, int r, int q) {
#pragma unroll
    for (int s2 = 0; s2 < 2; ++s2) { const LAS bf16_t* p = XT + (32 * s2 + 8 * q + (r >> 2)) * PT + T0 + 4 * (r & 3);
        const v4i16_t lo = __builtin_amdgcn_ds_read_tr16_b64_v4i16((LAS v4i16_t*)p), hi = __builtin_amdgcn_ds_read_tr16_b64_v4i16((LAS v4i16_t*)(p + 4 * PT));
        f[s2] = __builtin_shufflevector(lo, hi, 0, 1, 2, 3, 4, 5, 6, 7); }
}
DI void st_sw(LAS bf16_t* Dm, const f32x4& v, int i, int j0) { u32x2 w; w.x = cvt_pk_bf16(v[0], v[1]); w.y = cvt_pk_bf16(v[2], v[3]); *(LAS u32x2*)(Dm + i * PT + j0) = w; }
DI f32x4 ld_sw(const LAS bf16_t* Sm, int i, int j0) { const u32x2 w = *(const LAS u32x2*)(Sm + i * PT + j0); return (f32x4){bf_lo(w.x), bf_hi(w.x), bf_lo(w.y), bf_hi(w.y)}; }
#define ZACC(a) do { a[0] = (f32x4){0.f, 0.f, 0.f, 0.f}; a[1] = (f32x4){0.f, 0.f, 0.f, 0.f}; } while (0)

DI float wave_sum2(float v) { return xrow_sum(row_sum16(v)); }
#define LSYNC() do { asm volatile("s_waitcnt lgkmcnt(0)" ::: "memory"); __builtin_amdgcn_s_barrier(); asm volatile("" ::: "memory"); } while (0)

struct RaRaw { bf16_t r[9], k[9], v[9], lw[8], a[8]; };
DI void ra_load(RaRaw& x, const bf16_t* prw, const bf16_t* lwag, int ci, int w, int lane) {
    const int bh = ci >> 6, c = ci & 63, b = bh >> 3, h = bh & 7, ch = h * 64 + lane;
    const size_t tok0 = (size_t)b * SEQ + c * 64 + 8 * w;
    const bool has_prev = !(c == 0 && w == 0);
    const size_t tp = has_prev ? tok0 - 1 : tok0;
    x.r[0] = prw[tp * RWC + ch]; x.k[0] = prw[tp * RWC + 512 + ch]; x.v[0] = prw[tp * RWC + 1024 + ch];
#pragma unroll
    for (int i = 0; i < 8; ++i) { const size_t tok = tok0 + i;
        x.r[i + 1] = prw[tok * RWC + ch]; x.k[i + 1] = prw[tok * RWC + 512 + ch]; x.v[i + 1] = prw[tok * RWC + 1024 + ch];
        x.lw[i] = lwag[tok * 1536 + ch]; x.a[i] = lwag[tok * 1536 + 512 + ch]; }
}
DI void p_rw_chunk(const Frame& F) {
    const bf16_t* prw = (const bf16_t*)(F.ws + WS_PRW); const bf16_t* lwag = (const bf16_t*)(F.ws + WS_LWAG);
    const float* mu = F.in[13]; const float* k_k = F.in[19]; const float* k_a = F.in[20]; const float* r_k = F.in[21];
    float* bonus = (float*)(F.ws + WS_BONUS);
    bf16_t* gM = (bf16_t*)(F.ws + WS_CHK_M); bf16_t* gN0T = (bf16_t*)(F.ws + WS_CHK_N0T); bf16_t* gQ = (bf16_t*)(F.ws + WS_CHK_Q); bf16_t* gY0 = (bf16_t*)(F.ws + WS_CHK_Y0T);
    LAS unsigned char* lds = F.lds;
    LAS float* segtot = (LAS float*)(lds + 14 * SLOTB);
    LAS float* PLs = segtot + 512;
    LAS float* DB = PLs + 64;
    constexpr int PD = 20;
    constexpr int TP = 24;
    LAS bf16_t* TDT = (LAS bf16_t*)(DB + 64 * PD);
    const int w = F.wave, lane = F.lane, r = lane & 15, q = lane >> 4, ti = w >> 1, tj0 = 2 * (w & 1), i0 = 16 * ti + 4 * q;
    LAS bf16_t* S0 = rslot(lds, 0); LAS bf16_t* S1 = rslot(lds, 1); LAS bf16_t* S2 = rslot(lds, 2); LAS bf16_t* S3 = rslot(lds, 3);
    LAS bf16_t* S4 = rslot(lds, 4); LAS bf16_t* S5 = rslot(lds, 5); LAS bf16_t* S6 = rslot(lds, 6); LAS bf16_t* S7 = rslot(lds, 7);
    LAS bf16_t* S8 = rslot(lds, 8); LAS bf16_t* S9 = rslot(lds, 9); LAS bf16_t* S10 = rslot(lds, 10); LAS bf16_t* S11 = rslot(lds, 11);
    LAS bf16_t* S12 = rslot(lds, 12); LAS bf16_t* S13 = rslot(lds, 13);
    RaRaw raw;
    if (F.bid < RW_NCH) ra_load(raw, prw, lwag, F.bid, w, lane);
    for (int ci = F.bid; ci < RW_NCH; ci += F.G) {
        const int bh = ci >> 6, c = ci & 63, b = bh >> 3, h = bh & 7, ch = h * 64 + lane;
        {
            const size_t tok0 = (size_t)b * SEQ + c * 64 + 8 * w;
            const float mur = mu[ch], muk = mu[512 + ch], muv = mu[1024 + ch], kkw = k_k[ch], ka = k_a[ch], rk = r_k[ch];
            const bool has_prev = !(c == 0 && w == 0);
            float xr[9], xk[9], xv[9];
            xr[0] = has_prev ? bf2f(raw.r[0]) : 0.f; xk[0] = has_prev ? bf2f(raw.k[0]) : 0.f; xv[0] = has_prev ? bf2f(raw.v[0]) : 0.f;
#pragma unroll
            for (int i = 1; i < 9; ++i) { xr[i] = bf2f(raw.r[i]); xk[i] = bf2f(raw.k[i]); xv[i] = bf2f(raw.v[i]); }
            f32x2 rr2[4], vv2[4], aa2[4], km2[4], kn2[4], sq2[4], bq2[4]; float cl[8];
            float run = 0.f;
#pragma unroll
            for (int p2 = 0; p2 < 4; ++p2) {
                const f32x2 cr = {xr[2 * p2 + 1], xr[2 * p2 + 2]}, pr = {xr[2 * p2], xr[2 * p2 + 1]};
                const f32x2 ck = {xk[2 * p2 + 1], xk[2 * p2 + 2]}, pk = {xk[2 * p2], xk[2 * p2 + 1]};
                const f32x2 cv = {xv[2 * p2 + 1], xv[2 * p2 + 2]}, pv = {xv[2 * p2], xv[2 * p2 + 1]};
                const f32x2 r_ = cr + (pr - cr) * mur, k_ = ck + (pk - ck) * muk, v_ = cv + (pv - cv) * muv;
                const f32x2 a_ = {bf2f(raw.a[2 * p2]), bf2f(raw.a[2 * p2 + 1])};
                const f32x2 kx = k_ * kkw; sq2[p2] = kx * kx;
                const f32x2 kmod = k_ * (a_ * ka + (1.0f - ka));
                bq2[p2] = (r_ * kmod) * rk;
                rr2[p2] = r_; vv2[p2] = v_; aa2[p2] = a_; km2[p2] = kmod; kn2[p2] = kx;
                run += bf2f(raw.lw[2 * p2]); cl[2 * p2] = run; run += bf2f(raw.lw[2 * p2 + 1]); cl[2 * p2 + 1] = run;
            }
            {
                float A8[8], B4[4], C2[2];
#pragma unroll
                for (int k = 0; k < 4; ++k) { A8[k] = comb32(sq2[k].x, sq2[k].y); A8[4 + k] = comb32(bq2[k].x, bq2[k].y); }
#pragma unroll
                for (int j = 0; j < 4; ++j) B4[j] = comb16(A8[2 * j], A8[2 * j + 1]);
#pragma unroll
                for (int i = 0; i < 2; ++i) { const float t1 = DPP_ADD(B4[2 * i], 0x128), t2 = DPP_ADD(B4[2 * i + 1], 0x128); C2[i] = (lane & 8) ? t2 : t1; }
                const float u1 = DPP_ADD(C2[0], 0x141), u2 = DPP_ADD(C2[1], 0x141);
                float dsum = (lane & 4) ? u2 : u1;
                dsum = DPP_ADD(dsum, 0xB1); dsum = DPP_ADD(dsum, 0x4E);
                if ((lane & 7) == 4) bonus[(tok0 + 4 * ((lane >> 3) & 1) + 2 * ((lane >> 4) & 1) + (lane >> 5)) * 8 + h] = dsum;
                const float rsv = fminf(__builtin_amdgcn_rsqf(dsum), 1e12f);
                const int rsi = __builtin_bit_cast(int, rsv);
                float rs[8];
#pragma unroll
                for (int tt = 0; tt < 8; ++tt) rs[tt] = __builtin_bit_cast(float, __builtin_amdgcn_readlane(rsi, 8 * (tt >> 2) + 16 * ((tt >> 1) & 1) + 32 * (tt & 1)));
#pragma unroll
                for (int p2 = 0; p2 < 4; ++p2) kn2[p2] = kn2[p2] * (f32x2){rs[2 * p2], rs[2 * p2 + 1]};
            }
            segtot[w * 64 + lane] = run;
            LSYNC();
            float pre = 0.f;
            for (int w2 = 0; w2 < w; ++w2) pre += segtot[w2 * 64 + lane];
            if (w == 7) PLs[lane] = __expf(pre + run);
            float ep = __expf(pre);
            unsigned xa[4], xb[4], xkk[4], xrr[4], xvv[4];
#pragma unroll
            for (int p2 = 0; p2 < 4; ++p2) {
                const f32x2 tt = ((f32x2){cl[2 * p2], cl[2 * p2 + 1]} + pre) * 1.44269504f;
                const f32x2 e = {__builtin_amdgcn_exp2f(tt.x), __builtin_amdgcn_exp2f(tt.y)}, en = {__builtin_amdgcn_rcpf(e.x), __builtin_amdgcn_rcpf(e.y)}, epv = {ep, e.x};
                ep = e.y;
                const f32x2 at = -(kn2[p2] * epv), bt = (kn2[p2] * aa2[p2]) * en, kt = km2[p2] * en, rt = rr2[p2] * e;
                xa[p2] = cvt_pk_bf16(at.x, at.y); xb[p2] = cvt_pk_bf16(bt.x, bt.y); xkk[p2] = cvt_pk_bf16(kt.x, kt.y); xrr[p2] = cvt_pk_bf16(rt.x, rt.y); xvv[p2] = cvt_pk_bf16(vv2[p2].x, vv2[p2].y);
                const int t = 8 * w + 2 * p2;
                S6[t * PT + lane] = (bf16_t)(xrr[p2] & 0xffffu); S6[(t + 1) * PT + lane] = (bf16_t)(xrr[p2] >> 16);
            }
            *(LAS u32x4*)(S1 + lane * PT + 8 * w) = (u32x4){xa[0], xa[1], xa[2], xa[3]};
            *(LAS u32x4*)(S3 + lane * PT + 8 * w) = (u32x4){xb[0], xb[1], xb[2], xb[3]};
            *(LAS u32x4*)(S5 + lane * PT + 8 * w) = (u32x4){xkk[0], xkk[1], xkk[2], xkk[3]};
            *(LAS u32x4*)(S7 + lane * PT + 8 * w) = (u32x4){xvv[0], xvv[1], xvv[2], xvv[3]};
        }
        LSYNC();
        if (ci + F.G < RW_NCH) ra_load(raw, prw, lwag, ci + F.G, w, lane);
        f32x4 acc[2];
        const f32x4 Z4 = (f32x4){0.f, 0.f, 0.f, 0.f};
        const int ia = 16 * ti + r, jb0 = 16 * tj0 + r;
        { bf16x8 a0[2], a6[2], b2[2][2], b4[2][2];
          ld_frag_tr(a0, S1, 16 * ti, r, q); ld_frag(a6, S6, ia, q);
#pragma unroll
          for (int e = 0; e < 2; ++e) { ld_frag_tr(b2[e], S3, 16 * (tj0 + e), r, q); ld_frag_tr(b4[e], S5, 16 * (tj0 + e), r, q); }
#pragma unroll
          for (int e = 0; e < 2; ++e) { const int tj = tj0 + e, j = 16 * tj + r, js = 16 * tj + 4 * q;
            const f32x4 c = mm2(a0, b2[e], Z4);
            if (tj == ti) {
#pragma unroll
                for (int g = 0; g < 4; ++g) DB[(ti * 16 + 4 * q + g) * PD + r] = (4 * q + g > r) ? c[g] : 0.f;
            }
            st_tr(S8, (ti > tj) ? c : Z4, i0, j);
            f32x4 v = mm2(b4[e], a0, Z4);
#pragma unroll
            for (int g = 0; g < 4; ++g) v[g] = (ia > js + g) ? v[g] : 0.f;
            st_sw(S9, v, ia, js);
            v = mm2(b2[e], a6, Z4);
#pragma unroll
            for (int g = 0; g < 4; ++g) v[g] = (ia >= js + g) ? v[g] : 0.f;
            st_sw(S10, v, ia, js);
            v = mm2(b4[e], a6, Z4);
#pragma unroll
            for (int g = 0; g < 4; ++g) v[g] = (ia >= js + g) ? v[g] : 0.f;
            st_sw(S11, v, ia, js); } }
        LSYNC();
        ZACC(acc); mm_acc(acc, S9, S7, ti, tj0, r, q);
#pragma unroll
        for (int e = 0; e < 2; ++e) st_tr(S2, acc[e], i0, 16 * (tj0 + e) + r);
        if (w < 4) {
            const int i = lane >> 2, p = lane & 3;
            const LAS float* Dp = DB + (w * 16 + p) * PD;
            f32x4 Dm[4][4];
#pragma unroll
            for (int m = 0; m < 4; ++m)
#pragma unroll
                for (int c4 = 0; c4 < 4; ++c4) Dm[m][c4] = *(const LAS f32x4*)(Dp + 4 * m * PD + 4 * c4);
            float mine[4] = {0.f, 0.f, 0.f, 0.f}, tr[16];
#pragma unroll
            for (int j = 15; j >= 0; --j) { float part = 0.f;
#pragma unroll
                for (int m = 3; m >= 0; --m) if (4 * m + 3 > j) part = __builtin_fmaf(mine[m], Dm[m][j >> 2][j & 3], part);
                float tot = part + __builtin_bit_cast(float, __builtin_amdgcn_update_dpp(0, __builtin_bit_cast(int, part), 0xB1, 0xf, 0xf, false));
                tot = tot + __builtin_bit_cast(float, __builtin_amdgcn_update_dpp(0, __builtin_bit_cast(int, tot), 0x4E, 0xf, 0xf, false));
                const float trj = (j > i) ? 0.f : ((j == i) ? 1.0f : tot);
                tr[j] = trj; mine[j >> 2] = (p == (j & 3)) ? trj : mine[j >> 2]; }
            u32x4 z = (u32x4){0u, 0u, 0u, 0u}, x0, x1;
            x0.x = cvt_pk_bf16(tr[0], tr[1]); x0.y = cvt_pk_bf16(tr[2], tr[3]); x0.z = cvt_pk_bf16(tr[4], tr[5]); x0.w = cvt_pk_bf16(tr[6], tr[7]);
            x1.x = cvt_pk_bf16(tr[8], tr[9]); x1.y = cvt_pk_bf16(tr[10], tr[11]); x1.z = cvt_pk_bf16(tr[12], tr[13]); x1.w = cvt_pk_bf16(tr[14], tr[15]);
            LAS bf16_t* dst = S0 + (16 * w + i) * PT + 16 * p;
            *(LAS u32x4*)dst = (p == w) ? x0 : z; *(LAS u32x4*)(dst + 8) = (p == w) ? x1 : z;
#pragma unroll
            for (int m = 0; m < 4; ++m) TDT[(16 * w + 4 * m + p) * TP + i] = f2bf(mine[m]);
        }
        LSYNC();
        { bf16x8 a[2], b[2][2]; ld_frag(a, S0, ia, q);
#pragma unroll
          for (int e = 0; e < 2; ++e) ld_frag(b[e], S8, jb0 + 16 * e, q);
#pragma unroll
          for (int e = 0; e < 2; ++e) { st_tr(S12, mm2(a, b[e], Z4), i0, 16 * (tj0 + e) + r); st_sw(S4, mm2(b[e], a, Z4), ia, 16 * (tj0 + e) + 4 * q); } }
        LSYNC();
        { bf16x8 a[2], b[2][2]; ld_frag(a, S4, ia, q);
#pragma unroll
          for (int e = 0; e < 2; ++e) ld_frag(b[e], S12, jb0 + 16 * e, q);
          const bf16x8 as = (w & 1) ? a[1] : a[0];
#pragma unroll
          for (int e = 0; e < 2; ++e) { const int tj = tj0 + e, j = 16 * tj + r, js = 16 * tj + 4 * q;
            st_sw(S13, mm2(b[e], a, Z4), ia, js);
            bf16x8 bt = *(const LAS bf16x8*)(TDT + j * TP + 8 * (q & 1));
            if ((q >> 1) != e) bt = (bf16x8){0, 0, 0, 0, 0, 0, 0, 0};
            f32x4 c = Z4;
            if (ti == tj) { const u32x2 wv = *(const LAS u32x2*)(TDT + j * TP + 4 * q); c = (f32x4){bf_lo(wv.x), bf_hi(wv.x), bf_lo(wv.y), bf_hi(wv.y)}; }
            st_tr(S9, __builtin_amdgcn_mfma_f32_16x16x32_bf16(as, bt, c, 0, 0, 0), i0, j);
            st_sw(S8, __builtin_amdgcn_mfma_f32_16x16x32_bf16(bt, as, ld_sw(S0, ia, js), 0, 0, 0), ia, js); } }
        LSYNC();
        { bf16x8 a[2], b[2][2]; ld_frag(a, S13, ia, q);
#pragma unroll
          for (int e = 0; e < 2; ++e) ld_frag(b[e], S9, jb0 + 16 * e, q);
#pragma unroll
          for (int e = 0; e < 2; ++e) { const int js = 16 * (tj0 + e) + 4 * q; st_sw(S12, mm2(b[e], a, ld_sw(S8, ia, js)), ia, js); } }
        LSYNC();
        { bf16x8 a[2], b1[2][2], bx[2][2]; ld_frag(a, S12, ia, q);
#pragma unroll
          for (int e = 0; e < 2; ++e) { ld_frag(b1[e], S1, jb0 + 16 * e, q); ld_frag(bx[e], S2, jb0 + 16 * e, q); }
#pragma unroll
          for (int e = 0; e < 2; ++e) { const int j = 16 * (tj0 + e) + r; st_tr(S0, mm2(a, b1[e], Z4), i0, j); st_tr(S4, mm2(a, bx[e], Z4), i0, j); } }
        LSYNC();
        { bf16x8 a10[2], a11[2], a3[2], a5[2], b0[2][2], b4[2][2], b7[2][2];
          ld_frag(a10, S10, ia, q); ld_frag(a11, S11, ia, q); ld_frag(a3, S3, ia, q); ld_frag(a5, S5, ia, q);
#pragma unroll
          for (int e = 0; e < 2; ++e) { ld_frag(b0[e], S0, jb0 + 16 * e, q); ld_frag(b4[e], S4, jb0 + 16 * e, q); ld_frag(b7[e], S7, jb0 + 16 * e, q); }
          const float pli = PLs[ia];
          f32x4 plg;
#pragma unroll
          for (int g = 0; g < 4; ++g) plg[g] = PLs[i0 + g];
#pragma unroll
          for (int e = 0; e < 2; ++e) { const int j = 16 * (tj0 + e) + r, js = 16 * (tj0 + e) + 4 * q;
            const f32x4 vq = mm2(b0[e], a10, ld_sw(S6, ia, js));
            const f32x4 vy = mm2(b7[e], a11, mm2(b4[e], a10, Z4));
            f32x4 vm = mm2(b0[e], a3, Z4);
#pragma unroll
            for (int g = 0; g < 4; ++g) vm[g] = pli * (vm[g] + ((ia == js + g) ? 1.0f : 0.f));
            const f32x4 vn = mm2(a5, b7[e], mm2(a3, b4[e], Z4)) * plg;
            st_sw(S1, vq, ia, js); st_sw(S2, vy, ia, js); st_sw(S8, vm, ia, js); st_tr(S9, vn, i0, j); } }
        LSYNC();
        { const int row = F.tid >> 3, seg = (F.tid & 7) * 8; const size_t go = (size_t)ci * 4096 + row * 64 + seg;
          *(u32x4*)(gQ + go) = *(const LAS u32x4*)(S1 + row * PT + seg); *(u32x4*)(gY0 + go) = *(const LAS u32x4*)(S2 + row * PT + seg);
          *(u32x4*)(gM + go) = *(const LAS u32x4*)(S8 + row * PT + seg); *(u32x4*)(gN0T + go) = *(const LAS u32x4*)(S9 + row * PT + seg); }
        LSYNC();
    }
    asm volatile("s_waitcnt vmcnt(0)" ::: "memory");
}

struct ScanOps { u32x2 m[4][2][2]; u32x2 n0[4]; };
DI void scan_load(ScanOps& o, const bf16_t* gM, const bf16_t* gN0T, size_t ci, int col, int q, int v) {
#pragma unroll
    for (int m = 0; m < 4; ++m) {
#pragma unroll
        for (int s2 = 0; s2 < 2; ++s2) { const bf16_t* p = gM + ci * 4096 + (16 * m + col) * 64 + 32 * s2 + 4 * q; o.m[m][s2][0] = *(const u32x2*)p; o.m[m][s2][1] = *(const u32x2*)(p + 16); }
        o.n0[m] = *(const u32x2*)(gN0T + ci * 4096 + v * 64 + 16 * m + 4 * q); }
}
DI void scan_step(const ScanOps& o, f32x4 (&H)[4], bf16_t* gHT, size_t ci, int q, int v) {
    u32x4 bfr[2];
#pragma unroll
    for (int s2 = 0; s2 < 2; ++s2) { bfr[s2].x = cvt_pk_bf16(H[2 * s2][0], H[2 * s2][1]); bfr[s2].y = cvt_pk_bf16(H[2 * s2][2], H[2 * s2][3]);
        bfr[s2].z = cvt_pk_bf16(H[2 * s2 + 1][0], H[2 * s2 + 1][1]); bfr[s2].w = cvt_pk_bf16(H[2 * s2 + 1][2], H[2 * s2 + 1][3]);
        bf16_t* hp = gHT + ci * 4096 + v * 64 + 32 * s2 + 4 * q;
        *(u32x2*)hp = (u32x2){bfr[s2].x, bfr[s2].y}; *(u32x2*)(hp + 16) = (u32x2){bfr[s2].z, bfr[s2].w}; }
#pragma unroll
    for (int m = 0; m < 4; ++m) {
        f32x4 a2 = (f32x4){bf_lo(o.n0[m].x), bf_hi(o.n0[m].x), bf_lo(o.n0[m].y), bf_hi(o.n0[m].y)};
#pragma unroll
        for (int s2 = 0; s2 < 2; ++s2) { const u32x4 af = (u32x4){o.m[m][s2][0].x, o.m[m][s2][0].y, o.m[m][s2][1].x, o.m[m][s2][1].y};
            a2 = __builtin_amdgcn_mfma_f32_16x16x32_bf16(__builtin_bit_cast(bf16x8, af), __builtin_bit_cast(bf16x8, bfr[s2]), a2, 0, 0, 0); }
        H[m] = a2; }
}
constexpr int SC_DEPTH = 10, SC_SLOT = 12288;
DI void scan_dma(unsigned lds_dst, unsigned voff, const char* base) { asm volatile("s_mov_b32 m0, %0\n\ts_nop 0\n\tglobal_load_lds_dwordx4 %1, %2" :: "s"(lds_dst), "v"(voff), "s"(base) : "memory"); }
DI void scan_lds_load(ScanOps& o, const LAS unsigned char* slot, int lbM, int lbN, const int (&xo)[2][2], int c7) {
#pragma unroll
    for (int m = 0; m < 4; ++m) {
#pragma unroll
        for (int s2 = 0; s2 < 2; ++s2) { o.m[m][s2][0] = *(const LAS u32x2*)(slot + lbM + m * 2048 + xo[s2][0]); o.m[m][s2][1] = *(const LAS u32x2*)(slot + lbM + m * 2048 + xo[s2][1]); }
        o.n0[m] = *(const LAS u32x2*)(slot + 8192 + lbN + (((2 * m) << 4) ^ c7)); }
}
DI void p_rw_scan(const Frame& F) {
    const bf16_t* gM = (const bf16_t*)(F.ws + WS_CHK_M); const bf16_t* gN0T = (const bf16_t*)(F.ws + WS_CHK_N0T); bf16_t* gHT = (bf16_t*)(F.ws + WS_CHK_HT);
    const unsigned ldsbase = (unsigned)(size_t)F.lds;
    const int w = F.wave, col = F.lane & 15, q = F.lane >> 4;
    const int lw = w - 2, lt = F.tid - 128;
    const int P1 = (384 + lt) & 511;
    const unsigned voff0 = (unsigned)((lt >> 3) * 128 + (((lt & 7) ^ ((lt >> 3) & 7)) << 4));
    const unsigned voff1 = (unsigned)((P1 >> 3) * 128 + (((P1 & 7) ^ ((P1 >> 3) & 7)) << 4));
    const int c7 = (col & 7) << 4, qh = (q >> 1) << 4;
    const int lbM = col * 128 + 8 * (q & 1), lbN = (16 * (w & 1) + col) * 128 + 8 * (q & 1);
    int xo[2][2];
#pragma unroll
    for (int s2 = 0; s2 < 2; ++s2)
#pragma unroll
        for (int h = 0; h < 2; ++h) xo[s2][h] = (((4 * s2 + 2 * h) << 4) + qh) ^ c7;
    const int c7n = c7 ^ qh;
    for (int p = F.bid; p < 256; p += F.G) {
        const int bh = p >> 1, half = p & 1, v = 32 * half + 16 * (w & 1) + col;
        const size_t c0 = (size_t)bh * 64;
        const char* baseM = (const char*)(gM + c0 * 4096);
        const char* baseN = (const char*)(gN0T + c0 * 4096 + half * 2048);
        const char* base1 = (lw < 2) ? baseM : baseN;
#define SC_ISSUE(c, slot) do { if (w >= 2) { const unsigned _d = ldsbase + (unsigned)(slot) * SC_SLOT + (unsigned)lw * 1024u; \
            scan_dma(_d, voff0 + (unsigned)(c) * 8192u, baseM); scan_dma(_d + 6144u, voff1 + (unsigned)(c) * 8192u, base1); } } while (0)
#pragma unroll 1
        for (int c = 0; c < SC_DEPTH; ++c) SC_ISSUE(c, c);
        asm volatile("s_waitcnt vmcnt(0)" ::: "memory"); __builtin_amdgcn_s_barrier();
        f32x4 H[4];
#pragma unroll
        for (int m = 0; m < 4; ++m) H[m] = (f32x4){0.f, 0.f, 0.f, 0.f};
        ScanOps A, B;
        if (w < 2) scan_lds_load(A, F.lds, lbM, lbN, xo, c7n);
        int slot = 0;
#define SC_STEP(X, Y, c) do { \
            if (w < 2) asm volatile("s_waitcnt lgkmcnt(0)" ::: "memory"); else asm volatile("s_waitcnt vmcnt(16)" ::: "memory"); \
            __builtin_amdgcn_s_barrier(); \
            const int _sn = (slot + 1 == SC_DEPTH) ? 0 : slot + 1; \
            if (w < 2) scan_lds_load(Y, F.lds + _sn * SC_SLOT, lbM, lbN, xo, c7n); \
            { const int _cn = ((c) + SC_DEPTH < 64) ? (c) + SC_DEPTH : 63; SC_ISSUE(_cn, slot); } \
            if (w < 2) scan_step(X, H, gHT, c0 + (c), q, v); \
            slot = _sn; } while (0)
        static_assert(2 * (SC_DEPTH - 2) == 16, "vmcnt literal in SC_STEP");
#pragma unroll 1
        for (int c = 0; c < 64; c += 2) { SC_STEP(A, B, c); SC_STEP(B, A, c + 1); }
#undef SC_STEP
#undef SC_ISSUE
        asm volatile("s_waitcnt vmcnt(0)" ::: "memory"); __builtin_amdgcn_s_barrier();
    }
}

struct RcIn { bf16x8 qf[2], hb[4][2]; u32x2 y0[4], cv[4], pv[4], gw[4]; float bn; };
DI void rc_load(RcIn& x, const bf16_t* gQ, const bf16_t* gY0, const bf16_t* gHT, const bf16_t* prw, const bf16_t* lwag, const float* bonus, int item, int r, int q) {
    const int ci = item >> 2, ti = item & 3, bh = ci >> 6, c = ci & 63, b = bh >> 3, h = bh & 7;
    const size_t cb = (size_t)ci * 4096; const size_t tok = (size_t)b * SEQ + c * 64 + 16 * ti + r;
    const bool first = (tok & (SEQ - 1)) == 0; const size_t tp = first ? tok : tok - 1;
#pragma unroll
    for (int s2 = 0; s2 < 2; ++s2) x.qf[s2] = *(const bf16x8*)(gQ + cb + (16 * ti + r) * 64 + 32 * s2 + 8 * q);
#pragma unroll
    for (int n = 0; n < 4; ++n) { const int cch = h * 64 + 16 * n + 4 * q;
        x.y0[n] = *(const u32x2*)(gY0 + cb + (16 * ti + r) * 64 + 16 * n + 4 * q);
#pragma unroll
        for (int s2 = 0; s2 < 2; ++s2) x.hb[n][s2] = *(const bf16x8*)(gHT + cb + (16 * n + r) * 64 + 32 * s2 + 8 * q);
        x.cv[n] = *(const u32x2*)(prw + tok * RWC + 1024 + cch); x.pv[n] = *(const u32x2*)(prw + tp * RWC + 1024 + cch);
        x.gw[n] = *(const u32x2*)(lwag + tok * 1536 + 1024 + cch); }
    x.bn = bonus[tok * 8 + h];
}
DI void rc_compute(const RcIn& x, bf16_t* yrw, const float* mu, const float* ln_g, const float* ln_b, int item, int r, int q) {
    const int ci = item >> 2, ti = item & 3, bh = ci >> 6, c = ci & 63, b = bh >> 3, h = bh & 7;
    const size_t tok = (size_t)b * SEQ + c * 64 + 16 * ti + r; const bool first = (tok & (SEQ - 1)) == 0;
    f32x4 y[4];
#pragma unroll
    for (int n = 0; n < 4; ++n) { y[n] = (f32x4){bf_lo(x.y0[n].x), bf_hi(x.y0[n].x), bf_lo(x.y0[n].y), bf_hi(x.y0[n].y)};
#pragma unroll
        for (int s2 = 0; s2 < 2; ++s2) y[n] = __builtin_amdgcn_mfma_f32_16x16x32_bf16(x.hb[n][s2], x.qf[s2], y[n], 0, 0, 0); }
    float s1 = 0.f;
#pragma unroll
    for (int n = 0; n < 4; ++n) s1 += (y[n][0] + y[n][1]) + (y[n][2] + y[n][3]);
    s1 = xrow_sum(s1);
    const float mean = s1 * (1.0f / 64.0f);
    float s2 = 0.f;
#pragma unroll
    for (int n = 0; n < 4; ++n) { y[n] = y[n] - mean; s2 += (y[n][0] * y[n][0] + y[n][1] * y[n][1]) + (y[n][2] * y[n][2] + y[n][3] * y[n][3]); }
    s2 = xrow_sum(s2);
    const float rstd = rsqrtf(s2 * (1.0f / 64.0f) + 64e-5f);
#pragma unroll
    for (int n = 0; n < 4; ++n) { const int cch = h * 64 + 16 * n + 4 * q;
        const f32x4 muv = *(const f32x4*)(mu + 1024 + cch), lg = *(const f32x4*)(ln_g + cch), lb = *(const f32x4*)(ln_b + cch);
        const float cv[4] = {bf_lo(x.cv[n].x), bf_hi(x.cv[n].x), bf_lo(x.cv[n].y), bf_hi(x.cv[n].y)};
        const float pv[4] = {first ? 0.f : bf_lo(x.pv[n].x), first ? 0.f : bf_hi(x.pv[n].x), first ? 0.f : bf_lo(x.pv[n].y), first ? 0.f : bf_hi(x.pv[n].y)};
        const float gg[4] = {bf_lo(x.gw[n].x), bf_hi(x.gw[n].x), bf_lo(x.gw[n].y), bf_hi(x.gw[n].y)};
        float o[4];
#pragma unroll
        for (int g = 0; g < 4; ++g) { const float vsh = cv[g] + muv[g] * (pv[g] - cv[g]); o[g] = (y[n][g] * rstd * lg[g] + lb[g] + x.bn * vsh) * gg[g]; }
        u32x2 ow; ow.x = cvt_pk_bf16(o[0], o[1]); ow.y = cvt_pk_bf16(o[2], o[3]);
        *(u32x2*)(yrw + tok * 512 + cch) = ow; }
}
DI void p_rw_out(const Frame& F) {
    const bf16_t* gQ = (const bf16_t*)(F.ws + WS_CHK_Q); const bf16_t* gY0 = (const bf16_t*)(F.ws + WS_CHK_Y0T); const bf16_t* gHT = (const bf16_t*)(F.ws + WS_CHK_HT);
    const bf16_t* prw = (const bf16_t*)(F.ws + WS_PRW); const bf16_t* lwag = (const bf16_t*)(F.ws + WS_LWAG); const float* bonus = (const float*)(F.ws + WS_BONUS);
    bf16_t* yrw = (bf16_t*)(F.ws + WS_YRW);
    const float* mu = F.in[13]; const float* ln_g = F.in[22]; const float* ln_b = F.in[23];
    const int r = F.lane & 15, q = F.lane >> 4, stride = F.G * NWAVES, NIT = RW_NCH * 4;
    for (int item = F.bid * NWAVES + F.wave; item < NIT; item += 2 * stride) {
        const int item2 = (item + stride < NIT) ? item + stride : item;
        RcIn xa, xb;
        rc_load(xa, gQ, gY0, gHT, prw, lwag, bonus, item, r, q); rc_load(xb, gQ, gY0, gHT, prw, lwag, bonus, item2, r, q);
        rc_compute(xa, yrw, mu, ln_g, ln_b, item, r, q); rc_compute(xb, yrw, mu, ln_g, ln_b, item2, r, q);
    }
}

DI void p_moe_prep(const Frame& F) {
    const bf16_t* hb = (const bf16_t*)(F.ws + WS_HB); float* rsv = (float*)(F.ws + WS_RS); unsigned char* out8 = (unsigned char*)(F.ws + WS_XN2F8); const float* g = F.in[26];
    const int stride = F.G * NWAVES;
    for (int row = F.bid * NWAVES + F.wave; row < T; row += 2 * stride) {
        const int row2 = (row + stride < T) ? row + stride : row;
        u32x4 a[2], b[2];
        a[0] = *(const u32x4*)(hb + (size_t)row * D + F.lane * 16); a[1] = *(const u32x4*)(hb + (size_t)row * D + F.lane * 16 + 8);
        b[0] = *(const u32x4*)(hb + (size_t)row2 * D + F.lane * 16); b[1] = *(const u32x4*)(hb + (size_t)row2 * D + F.lane * 16 + 8);
        float v[16], u[16]; float ss = 0.f, su = 0.f;
#pragma unroll
        for (int j = 0; j < 8; ++j) { v[2 * j] = bf_lo(a[j >> 2][j & 3]); v[2 * j + 1] = bf_hi(a[j >> 2][j & 3]); u[2 * j] = bf_lo(b[j >> 2][j & 3]); u[2 * j + 1] = bf_hi(b[j >> 2][j & 3]); }
#pragma unroll
        for (int j = 0; j < 16; ++j) { ss += v[j] * v[j]; su += u[j] * u[j]; }
        ss = wave_sum(ss); su = wave_sum(su);
        const float rs = rsqrtf(ss * (1.0f / D) + 1e-5f), ru = rsqrtf(su * (1.0f / D) + 1e-5f);
        float gv[16];
#pragma unroll
        for (int q = 0; q < 4; ++q) { const f32x4 t = *(const f32x4*)(g + F.lane * 16 + q * 4); gv[4 * q] = t[0]; gv[4 * q + 1] = t[1]; gv[4 * q + 2] = t[2]; gv[4 * q + 3] = t[3]; }
#pragma unroll
        for (int j = 0; j < 16; ++j) { v[j] *= rs * gv[j]; u[j] *= ru * gv[j]; }
        u32x4 q0, q1;
        if (F.lane == 0) { rsv[row] = rs; rsv[row2] = ru; }
        q0.x = pk4_fp8(v[0] * F8_SX, v[1] * F8_SX, v[2] * F8_SX, v[3] * F8_SX); q0.y = pk4_fp8(v[4] * F8_SX, v[5] * F8_SX, v[6] * F8_SX, v[7] * F8_SX);
        q0.z = pk4_fp8(v[8] * F8_SX, v[9] * F8_SX, v[10] * F8_SX, v[11] * F8_SX); q0.w = pk4_fp8(v[12] * F8_SX, v[13] * F8_SX, v[14] * F8_SX, v[15] * F8_SX);
        q1.x = pk4_fp8(u[0] * F8_SX, u[1] * F8_SX, u[2] * F8_SX, u[3] * F8_SX); q1.y = pk4_fp8(u[4] * F8_SX, u[5] * F8_SX, u[6] * F8_SX, u[7] * F8_SX);
        q1.z = pk4_fp8(u[8] * F8_SX, u[9] * F8_SX, u[10] * F8_SX, u[11] * F8_SX); q1.w = pk4_fp8(u[12] * F8_SX, u[13] * F8_SX, u[14] * F8_SX, u[15] * F8_SX);
        *(u32x4*)(out8 + (size_t)row * D + F.lane * 16) = q0; *(u32x4*)(out8 + (size_t)row2 * D + F.lane * 16) = q1;
    }
    float* b1p = (float*)(F.ws + WS_B1P); const float* b1 = F.in[30]; CmSwi cm;
    for (int idx = F.bid * NTHR + F.tid; idx < 32 * 2048; idx += F.G * NTHR) { const int e = idx >> 11, n = idx & 2047; b1p[idx] = b1[e * 2048 + cm(n)]; }
}
DI void p_conv_part(const Frame& F, int part) {
    if (part == 0) conv_T8(F, F.in[29], (size_t)1024 * 2048, 2048, (unsigned char*)(F.ws + WS_W1), 2048, 1024, 32, MpSwi(), F8_SW, 0, 2048);
    else if (part == 1) conv_T8(F, F.in[29], (size_t)1024 * 2048, 2048, (unsigned char*)(F.ws + WS_W1), 2048, 1024, 32, MpSwi(), F8_SW, 2048, 4096);
    else conv_T8(F, F.in[31], (size_t)1024 * 1024, 1024, (unsigned char*)(F.ws + WS_W2), 1024, 1024, 32, MpId(), F8_SW);
}

DI void topk_rows(const Frame& F, int row0) {
    LAS unsigned* cnt = (LAS unsigned*)F.lds; LAS unsigned* base = cnt + 32;
    const float* logits = (const float*)(F.ws + WS_LOG); unsigned* epos = (unsigned*)(F.ws + WS_EPOS); float* gatev = (float*)(F.ws + WS_GATEV);
    const int pass = row0 / TPP;
    unsigned* gcnt = (unsigned*)(F.ws + WS_CTL) + CW_GCNT + pass * 32;
    if (F.tid < 32) cnt[F.tid] = 0u;
    __syncthreads();
    int e4[4] = {0, 0, 0, 0}; unsigned p4[4] = {0u, 0u, 0u, 0u}; float g4[4] = {0.f, 0.f, 0.f, 0.f};
    const int token = row0 + F.tid;
    if (F.tid < 256) {
        float l[32]; const float rsc = ((const float*)(F.ws + WS_RS))[token];
#pragma unroll
        for (int q = 0; q < 8; ++q) { const f32x4 v = *(const f32x4*)(logits + (size_t)token * 32 + q * 4), bq = *(const f32x4*)(F.in[28] + q * 4); l[q * 4] = v[0] * rsc + bq[0]; l[q * 4 + 1] = v[1] * rsc + bq[1]; l[q * 4 + 2] = v[2] * rsc + bq[2]; l[q * 4 + 3] = v[3] * rsc + bq[3]; }
        unsigned used = 0u; float tv[4];
#pragma unroll
        for (int k = 0; k < 4; ++k) { float best = -3.0e38f; int bi = 0;
#pragma unroll
            for (int e = 0; e < 32; ++e) { const bool ok = !((used >> e) & 1u) && (l[e] > best); best = ok ? l[e] : best; bi = ok ? e : bi; }
            used |= 1u << bi; e4[k] = bi; tv[k] = best; }
        const float m = tv[0]; float ex[4], sum = 0.f;
#pragma unroll
        for (int k = 0; k < 4; ++k) { ex[k] = __expf(tv[k] - m); sum += ex[k]; }
#pragma unroll
        for (int k = 0; k < 4; ++k) { g4[k] = ex[k] / sum; p4[k] = atomicAdd((unsigned*)&cnt[e4[k]], 1u); }
    }
    __syncthreads();
    if (F.tid < 32) base[F.tid] = __hip_atomic_fetch_add(&gcnt[F.tid], cnt[F.tid], __ATOMIC_RELAXED, __HIP_MEMORY_SCOPE_AGENT);
    __syncthreads();
    if (F.tid < 256) {
#pragma unroll
        for (int k = 0; k < 4; ++k) { epos[(size_t)token * 4 + k] = ((unsigned)e4[k] << 24) | (base[e4[k]] + p4[k]); gatev[(size_t)token * 4 + k] = g4[k]; }
    }
    __syncthreads();
}
DI void p_gather(const Frame& F, int pass) {
    LAS int* poff = (LAS int*)F.lds;
    LAS int* pcnt = poff + 40;
    unsigned* gcnt = (unsigned*)(F.ws + WS_CTL) + CW_GCNT + pass * 32;
    int* tile_e = (int*)(F.ws + WS_TILEE) + pass * TE_STRIDE;
    __syncthreads();
    if (F.tid == 0) { int acc = 0; for (int e = 0; e < 32; ++e) { poff[e] = acc; const int c = (int)__hip_atomic_load(&gcnt[e], __ATOMIC_RELAXED, __HIP_MEMORY_SCOPE_AGENT); pcnt[e] = c; acc += ((c + 255) >> 8) << 8; } poff[32] = acc; }
    __syncthreads();
    if (F.bid == 0) {
        const int nt = poff[32] >> 8;
        for (int t = F.tid; t < nt; t += NTHR) { int e = 0; for (int q = 1; q < 32; ++q) if (poff[q] <= t * 256) e = q; tile_e[1 + t] = e; }
        if (F.tid == 0) tile_e[0] = nt;
    }
    const unsigned* epos = (const unsigned*)(F.ws + WS_EPOS); const float* gatev = (const float*)(F.ws + WS_GATEV);
    int* slot = (int*)(F.ws + WS_SLOT); float* rowg = (float*)(F.ws + WS_ROWG) + (size_t)pass * MAXTILES * 256;
    int* rowtok = (int*)(F.ws + WS_ROWTOK) + (size_t)pass * MAXTILES * 256;
    for (int i = F.bid * NTHR + F.tid; i < 32 * 256; i += F.G * NTHR) { const int e = i >> 8, sl = poff[e] + pcnt[e] + (i & 255); if (sl < poff[e + 1]) rowtok[sl] = 0; }
    for (int i = F.bid * NTHR + F.tid; i < TPP * 4; i += F.G * NTHR) {
        const int token = pass * TPP + (i >> 2);
        const unsigned ep = epos[(size_t)pass * TPP * 4 + i]; const int sl = poff[ep >> 24] + (int)(ep & 0xffffffu);
        slot[(size_t)pass * TPP * 4 + i] = sl; rowg[sl] = gatev[(size_t)pass * TPP * 4 + i]; rowtok[sl] = token;
    }
    __syncthreads();
}
DI void p_combine(const Frame& F, int pass) {
    int tz_ = threadIdx.x; asm volatile("" : "+v"(tz_)); const int lane_ = tz_ & 63;
    const int* slot = (const int*)(F.ws + WS_SLOT); const unsigned char* y2 = (const unsigned char*)(F.ws + WS_XS) + (size_t)pass * PASS_BUF; const float* gf = F.in[33];
    for (int t = F.bid * NWAVES + F.wave; t < TPP; t += F.G * NWAVES) {
        const int token = pass * TPP + t;
        float v[16];
        { const bf16_t* hb = (const bf16_t*)(F.ws + WS_HB) + (size_t)token * D + lane_ * 16; const u32x4 h0 = *(const u32x4*)hb, h1 = *(const u32x4*)(hb + 8);
#pragma unroll
          for (int j = 0; j < 4; ++j) { v[2 * j] = bf_lo(h0[j]); v[2 * j + 1] = bf_hi(h0[j]); v[8 + 2 * j] = bf_lo(h1[j]); v[8 + 2 * j + 1] = bf_hi(h1[j]); } }
        u32x4 yw[4];
#pragma unroll
        for (int k = 0; k < 4; ++k) { const int s = slot[(size_t)token * 4 + k]; yw[k] = *(const u32x4*)(y2 + (size_t)s * D + lane_ * 16); }
#pragma unroll
        for (int k = 0; k < 4; ++k)
#pragma unroll
            for (int j = 0; j < 4; ++j) { const f32x2 lo = __builtin_amdgcn_cvt_pk_f32_fp8((int)yw[k][j], false), hi = __builtin_amdgcn_cvt_pk_f32_fp8((int)yw[k][j], true);
                v[4 * j] += lo[0] * (1.0f / F8_SY); v[4 * j + 1] += lo[1] * (1.0f / F8_SY); v[4 * j + 2] += hi[0] * (1.0f / F8_SY); v[4 * j + 3] += hi[1] * (1.0f / F8_SY); }
        float ss = 0.f;
#pragma unroll
        for (int j = 0; j < 16; ++j) ss += v[j] * v[j];
        ss = wave_sum(ss);
        const float rs = rsqrtf(ss * (1.0f / D) + 1e-5f);
        f32x4* orow = (f32x4*)(F.out + (size_t)token * D + lane_ * 16);
#pragma unroll
        for (int q = 0; q < 4; ++q) { const f32x4 gv = *(const f32x4*)(gf + lane_ * 16 + q * 4);
            orow[q] = (f32x4){v[q * 4] * rs * gv[0], v[q * 4 + 1] * rs * gv[1], v[q * 4 + 2] * rs * gv[2], v[q * 4 + 3] * rs * gv[3]}; }
    }
}

constexpr int N_PHASES = 18;
__global__ void __launch_bounds__(NTHR, 2) fwd_kernel(KArgs args) {
    extern __shared__ __attribute__((aligned(16))) unsigned char lds_raw[];
    Frame F; F.lds = (LAS unsigned char*)lds_raw; F.tid = threadIdx.x; F.lane = F.tid & 63; F.wave = __builtin_amdgcn_readfirstlane(F.tid >> 6);
    F.G = gridDim.x; F.bid = blockIdx.x; F.in = args.in; F.out = args.out; F.ws = args.ws;
    unsigned char* ws = args.ws;
    volatile LAS unsigned* MISC = (volatile LAS unsigned*)(F.lds + MISC_OFF);
    if (F.tid < 4) MISC[F.tid] = 0u;
    __syncthreads();
    XcdBarrier bar; bar.bar = (unsigned*)(ws + WS_CTL) + CW_BAR; bar.x = 0; bar.st = MISC;
    if (N_LAUNCH_MODE == 1) bar = xcd_barrier_post((unsigned*)(ws + WS_CTL) + CW_BAR, MISC);
    const int lo = args.ph_lo, hi = args.ph_hi;
#define IN(k) (lo <= (k) && (k) < hi)
#define REP(k) for (int _r = 0; _r < 1 + (int)((PROBE_MASK >> (k)) & 1u); ++_r)
#define SEAM(k) do { if (N_LAUNCH_MODE == 1 && IN(k) && IN((k) + 1)) xcd_barrier(bar); } while (0)
    bf16_t* gates = (bf16_t*)args.out;

    if (IN(0)) { REP(0) p0_prologue(F); SEAM(0); }
    if (IN(1)) {
        PlainSched S; S.init(ws + WS_XN, ws + WS_WIN, T, INC, D, D, D, F.G, F.bid);
        EpiWin E{(bf16_t*)(ws + WS_US5), (bf16_t*)(ws + WS_PRW), gates};
        REP(1) gemm_phase(F.lds, S, E); SEAM(1);
    }
    if (IN(2)) {
        GroupSched S; S.init(ws + WS_US5, ws + WS_WST, 512, LDU, 512, S5ROWS / BM, 1, F.G, F.bid);
        EpiS5State E{(float*)(ws + WS_SLOC)};
        REP(2) { gemm_phase(F.lds, S, E); p_rw_prep(F); } SEAM(2);
    }
    if (IN(3)) {
        REP(3) p_s5_carry(F);
        PlainSched S; S.init(ws + WS_ALORA, ws + WS_WLORA, T, 1536, 128, 256, 128, F.G, F.bid); S.akoff_pn = 4; S.akoff_bytes = 256;
        EpiLora E{(bf16_t*)(ws + WS_LWAG), F.in[14], F.in[16]};
        REP(3) gemm_phase(F.lds, S, E); SEAM(3);
    }
    if (IN(4)) {
        GroupSched S; S.init(ws + WS_US5, ws + WS_TOEP, LDU, LDU, LDU, S5ROWS / BM, 2, F.G, F.bid);
        EpiS5Out E{(bf16_t*)(ws + WS_YS)};
        REP(4) gemm_phase(F.lds, S, E); SEAM(4);
    }
    if (IN(5)) { REP(5) p_rw_chunk(F); SEAM(5); }
    if (IN(6)) { REP(6) p_rw_scan(F); SEAM(6); }
    if (IN(7)) { REP(7) p_rw_out(F); SEAM(7); }
    if (IN(8)) {
        PlainSched S; S.init(ws + WS_YS, ws + WS_WGLU, T, 2048, 512, 512, 512, F.G, F.bid);
        EpiGlu E{(bf16_t*)(ws + WS_XN), gates, (const float*)(ws + WS_BGLU)};
        if (F.bid & 1) p_conv_part(F, 0);
        gemm_phase(F.lds, S, E);
        if (!(F.bid & 1)) p_conv_part(F, 0);
        SEAM(8);
    }
    if (IN(9)) {
        PlainSched S; S.init(ws + WS_YRW, ws + WS_WO, T, 1024, 512, 512, 512, F.G, F.bid);
        EpiWo E{(bf16_t*)(ws + WS_XN), gates};
        if (F.bid & 1) p_conv_part(F, 1);
        gemm_phase(F.lds, S, E);
        if (!(F.bid & 1)) p_conv_part(F, 1);
        SEAM(9);
    }
    if (IN(10)) {
        PlainSched S; S.init(ws + WS_XN, ws + WS_WOUT, T, 1024, 1024, 1024, 1024, F.G, F.bid);
        EpiOut E{(bf16_t*)(ws + WS_HB), F.in[0]};
        if (F.bid & 1) p_conv_part(F, 2);
        gemm_phase(F.lds, S, E);
        if (!(F.bid & 1)) p_conv_part(F, 2);
        SEAM(10);
    }
    if (IN(11)) { REP(11) p_moe_prep(F); SEAM(11); }
    if (IN(12)) {
        PlainSched S; S.init(ws + WS_HB, ws + WS_WR, T, 256, 1024, 1024, 1024, F.G, F.bid);
        EpiRouter E{(float*)(ws + WS_LOG)};
        gemm_phase(F.lds, S, E);
        { Unit u; for (int i = 0; S.next(i, u); ++i) topk_rows(F, u.pm * BM); }
        SEAM(12);
    }
    if (IN(13)) { p_gather(F, 0); p_gather(F, 1); SEAM(13); }
#define MOE_G1(PASS, CIDX) \
            const int* te = (const int*)(ws + WS_TILEE) + (PASS) * TE_STRIDE; const int ntl = __builtin_amdgcn_readfirstlane(__hip_atomic_load(te, __ATOMIC_RELAXED, __HIP_MEMORY_SCOPE_AGENT)); \
            MoeSched<true> S; S.init(ws + WS_XN2F8, ws + WS_W1, te + 1, (const int*)(ws + WS_ROWTOK) + (size_t)(PASS) * MAXTILES * 256, ntl, 512, 8, F.G, (CIDX)); \
            EpiMoe1 E{(unsigned char*)(ws + WS_ACT) + (size_t)(PASS) * PASS_BUF, (const float*)(ws + WS_B1P)};
#define MOE_G2(PASS) \
            const int* te = (const int*)(ws + WS_TILEE) + (PASS) * TE_STRIDE; const int ntl = __builtin_amdgcn_readfirstlane(__hip_atomic_load(te, __ATOMIC_RELAXED, __HIP_MEMORY_SCOPE_AGENT)); \
            MoeSched<false> S; S.init(ws + WS_ACT + (size_t)(PASS) * PASS_BUF, ws + WS_W2, te + 1, nullptr, ntl, 512, 4, F.G, F.bid); \
            EpiMoe2 E{(unsigned char*)(ws + WS_XS) + (size_t)(PASS) * PASS_BUF, F.in[32], (const float*)(ws + WS_ROWG) + (size_t)(PASS) * MAXTILES * 256};
    if (IN(14)) { MOE_G1(0, F.bid) gemm_phase(F.lds, S, E); SEAM(14); }
    if (IN(15)) {
        { MOE_G2(0) gemm_phase(F.lds, S, E); }
        { MOE_G1(1, F.G - 1 - F.bid) gemm_phase(F.lds, S, E); }
        SEAM(15);
    }
    if (IN(16)) {
        if (F.bid & 1) p_combine(F, 0);
        { MOE_G2(1) gemm_phase(F.lds, S, E); }
        if (!(F.bid & 1)) p_combine(F, 0);
        SEAM(16);
    }
    if (IN(17)) { p_combine(F, 1); }
#undef MOE_G1
#undef MOE_G2
#undef IN
#undef SEAM
#undef REP
}

extern "C" void kernel_launch(void* const* d_in, const int* in_sizes, int n_in, void* d_out, int out_size, void* d_ws, size_t ws_size, hipStream_t stream) {
    static int grid = 0;
    if (grid == 0) {
        if (n_in != 34 || in_sizes[0] != T * D || out_size != T * D || ws_size < WS_END) { fprintf(stderr, "kernel_launch: unexpected shapes (n_in %d, in0 %d, out %d, ws %zu < %zu)\n", n_in, n_in > 0 ? in_sizes[0] : -1, out_size, ws_size, (size_t)WS_END); grid = -1; return; }
        int dev = 0, cus = 0, per_cu = 0;
        if (hipGetDevice(&dev) != hipSuccess || hipDeviceGetAttribute(&cus, hipDeviceAttributeMultiprocessorCount, dev) != hipSuccess) { grid = -1; return; }
        if (hipFuncSetAttribute((const void*)fwd_kernel, hipFuncAttributeMaxDynamicSharedMemorySize, LDS_BYTES) != hipSuccess) { fprintf(stderr, "kernel_launch: hipFuncSetAttribute failed\n"); grid = -1; return; }
        if (hipOccupancyMaxActiveBlocksPerMultiprocessor(&per_cu, (const void*)fwd_kernel, NTHR, LDS_BYTES) != hipSuccess || per_cu < 1) { fprintf(stderr, "kernel_launch: occupancy query says %d\n", per_cu); }
        (void)hipGetLastError();
        grid = cus;
    }
    if (grid < 0) return;
    (void)hipMemsetAsync((char*)d_ws + WS_CTL, 0, CTL_BYTES, stream);
    KArgs a{};
    for (int i = 0; i < 34; ++i) a.in[i] = (const float*)d_in[i];
    a.out = (float*)d_out; a.ws = (unsigned char*)d_ws;
    if (N_LAUNCH_MODE == 1) {
        a.ph_lo = 0; a.ph_hi = N_PHASES;
        hipLaunchKernelGGL(fwd_kernel, dim3(grid), dim3(NTHR), LDS_BYTES, stream, a);
    } else {
        for (int p = 0; p < N_PHASES; ++p) { a.ph_lo = p; a.ph_hi = p + 1; hipLaunchKernelGGL(fwd_kernel, dim3(grid), dim3(NTHR), LDS_BYTES, stream, a); }
    }
}
```

```cpp
#include <hip/hip_runtime.h>
#include <stdint.h>
#include <stdio.h>

#ifndef N_LAUNCH_MODE
#define N_LAUNCH_MODE 1
#endif

#ifndef GEMM_SP2
#define GEMM_SP2 1
#endif
#ifndef GEMM_ALIGN
#define GEMM_ALIGN 1
#endif
#ifndef PROBE_MASK
#define PROBE_MASK 0u
#endif
#define LAS __attribute__((address_space(3)))
#define DI __device__ __forceinline__
typedef unsigned short bf16_t;
typedef short bf16x8 __attribute__((ext_vector_type(8)));
typedef float f32x4 __attribute__((ext_vector_type(4)));
typedef float f32x2 __attribute__((ext_vector_type(2)));
typedef unsigned u32x4 __attribute__((ext_vector_type(4)));
typedef unsigned u32x2 __attribute__((ext_vector_type(2)));
typedef int i32x8 __attribute__((ext_vector_type(8)));
typedef int i32x4 __attribute__((ext_vector_type(4)));

constexpr int T = 65536, D = 1024, SEQ = 4096, NB = 16;
constexpr int INC = 4352, RWC = 1792;
constexpr int S5L = 32;
constexpr int S5NC = SEQ / S5L;
constexpr int S5ROWS = T / S5L;
constexpr int LDU = 16 * S5L + 128;
constexpr int NE = 32, TOPK = 4;
constexpr int NPASS = 2, TPP = T / NPASS;
constexpr int MAXTILES = (TPP * TOPK) / 256 + NE;
constexpr int NWAVES = 8, NTHR = 512;

constexpr size_t al(size_t x) { return (x + 4095) & ~(size_t)4095; }
constexpr size_t WS_CTL = 0, CTL_BYTES = 1 << 20;
constexpr size_t WS_WIN = WS_CTL + CTL_BYTES;
constexpr size_t WS_WGLU = WS_WIN + al((size_t)INC * D * 2);
constexpr size_t WS_WO = WS_WGLU + al((size_t)2048 * 512 * 2);
constexpr size_t WS_WOUT = WS_WO + al((size_t)1024 * 512 * 2);
constexpr size_t WS_WLORA = WS_WOUT + al((size_t)1024 * 1024 * 2);
constexpr size_t WS_WR = WS_WLORA + al((size_t)1536 * 256 * 2);
constexpr size_t WS_TOEP = WS_WR + al((size_t)256 * 1024 * 2);
constexpr size_t WS_WST = WS_TOEP + al((size_t)32 * 512 * LDU * 2);
constexpr size_t WS_BGLU = WS_WST + al((size_t)32 * 256 * 512 * 2);
constexpr size_t WS_B1P = WS_BGLU + al(2048 * 4);
constexpr size_t WS_SHARED = WS_B1P + al((size_t)32 * 2048 * 4);
constexpr size_t WS_PRW = WS_SHARED;
constexpr size_t WS_LWAG = WS_PRW + al((size_t)T * RWC * 2);
constexpr size_t WS_YS = WS_LWAG + al((size_t)T * 1536 * 2);
constexpr size_t WS_YRW = WS_YS + al((size_t)T * 512 * 2);
constexpr size_t WS_BONUS = WS_YRW + al((size_t)T * 512 * 2);
constexpr size_t WS_XN = WS_BONUS + al((size_t)T * 8 * 4);
constexpr size_t WS_US5 = WS_XN + al((size_t)T * D * 2);
constexpr size_t WS_ALORA = WS_US5 + al((size_t)32 * S5ROWS * LDU * 2);
constexpr size_t WS_SLOC = WS_ALORA + al((size_t)T * 256 * 2);
constexpr int RW_NCH = 128 * 64;
constexpr size_t CHK_BYTES = (size_t)RW_NCH * 4096 * 2;
constexpr size_t WS_CHK_M = WS_XN, WS_CHK_N0T = WS_CHK_M + CHK_BYTES, WS_CHK_Q = WS_CHK_N0T + CHK_BYTES, WS_CHK_Y0T = WS_CHK_Q + CHK_BYTES, WS_CHK_HT = WS_CHK_Y0T + CHK_BYTES;
constexpr size_t WS_MIX_END0 = WS_SLOC + al((size_t)32 * S5ROWS * 128 * 4);
constexpr size_t WS_MIX_END = (WS_CHK_HT + CHK_BYTES) > WS_MIX_END0 ? (WS_CHK_HT + CHK_BYTES) : WS_MIX_END0;
constexpr size_t WS_HB = WS_SHARED;
constexpr size_t WS_W1 = WS_HB + al((size_t)T * D * 2);
constexpr size_t WS_W2 = WS_W1 + al((size_t)32 * 2048 * 1024);
constexpr size_t WS_RS = WS_W2 + al((size_t)32 * 1024 * 1024);
constexpr size_t WS_LOG = WS_RS + al((size_t)T * 4);
constexpr size_t WS_EPOS = WS_LOG + al((size_t)T * 32 * 4);
constexpr size_t WS_GATEV = WS_EPOS + al((size_t)T * 4 * 4);
constexpr size_t WS_SLOT = WS_GATEV + al((size_t)T * 4 * 4);
constexpr size_t WS_ROWG = WS_SLOT + al((size_t)T * 4 * 4);
constexpr size_t WS_ROWTOK = WS_ROWG + al((size_t)NPASS * MAXTILES * 256 * 4);
constexpr size_t WS_TILEE = WS_ROWTOK + al((size_t)NPASS * MAXTILES * 256 * 4);
constexpr int TE_STRIDE = MAXTILES + 64;
constexpr size_t WS_XS = WS_TILEE + al((size_t)NPASS * (MAXTILES + 64) * 4);
constexpr size_t PASS_BUF = al((size_t)MAXTILES * 256 * 1024);
constexpr size_t WS_ACT = WS_XS + NPASS * PASS_BUF;
constexpr size_t WS_XN2F8 = WS_ACT + NPASS * PASS_BUF;
constexpr size_t WS_MOE_END = WS_XN2F8 + al((size_t)T * D);
static_assert(WS_W2 + (size_t)32 * 1024 * 1024 <= WS_SHARED + (size_t)T * RWC * 2, "converted expert weights must stay inside the (dead) PRW buffer while the GLU/Wo/out GEMM phases run");
constexpr size_t WS_END = WS_MIX_END > WS_MOE_END ? WS_MIX_END : WS_MOE_END;
static_assert(WS_END <= ((size_t)1 << 30), "workspace over 1 GiB");

constexpr int CW_BAR = 0;
constexpr int CW_GCNT = 4096;

constexpr float F8_SX = 16.f, F8_SW = 32.f, F8_SA = 4.f, F8_SY = 32.f;
constexpr int LDS_BYTES = 144 * 1024;
constexpr int MISC_OFF = 140 * 1024;

typedef __bf16 bf16x2_t __attribute__((ext_vector_type(2)));
DI unsigned cvt_pk_bf16(float lo, float hi) { f32x2 v = {lo, hi}; bf16x2_t b = __builtin_convertvector(v, bf16x2_t); return __builtin_bit_cast(unsigned, b); }
DI unsigned pk4_fp8(float a, float b, float c, float d) {
    a = fminf(fmaxf(a, -448.f), 448.f); b = fminf(fmaxf(b, -448.f), 448.f); c = fminf(fmaxf(c, -448.f), 448.f); d = fminf(fmaxf(d, -448.f), 448.f);
    int w = __builtin_amdgcn_cvt_pk_fp8_f32(a, b, 0, false); w = __builtin_amdgcn_cvt_pk_fp8_f32(c, d, w, true); return (unsigned)w; }
DI float bf_lo(unsigned u) { return __uint_as_float(u << 16); }
DI float bf_hi(unsigned u) { return __uint_as_float(u & 0xffff0000u); }
DI float bf2f(bf16_t b) { return __uint_as_float(((unsigned)b) << 16); }
DI bf16_t f2bf(float f) { return (bf16_t)(cvt_pk_bf16(f, 0.f) & 0xffffu); }
DI float fsigmoid(float x) { return __builtin_amdgcn_rcpf(1.0f + __expf(-x)); }
DI float ftanh(float x) { float e = __expf(2.0f * x); return 1.0f - 2.0f * __builtin_amdgcn_rcpf(e + 1.0f); }
DI float fgelu_tanh(float x) { float u = 0.7978845608f * (x + 0.044715f * x * x * x); return x * fsigmoid(2.0f * u); }
DI f32x2 lo2(const f32x4& v) { return __builtin_shufflevector(v, v, 0, 1); }
DI f32x2 hi2(const f32x4& v) { return __builtin_shufflevector(v, v, 2, 3); }
DI f32x2 pk_sigmoid_scaled(f32x2 x, float negk) {
    const f32x2 t = x * negk; f32x2 e; e.x = __builtin_amdgcn_exp2f(t.x); e.y = __builtin_amdgcn_exp2f(t.y);
    const f32x2 d = e + 1.0f; f32x2 r; r.x = __builtin_amdgcn_rcpf(d.x); r.y = __builtin_amdgcn_rcpf(d.y); return r; }
DI f32x2 pk_sigmoid(f32x2 x) { return pk_sigmoid_scaled(x, -1.44269504f); }
DI f32x2 pk_gelu_tanh(f32x2 x) { const f32x2 x2 = x * x; const f32x2 u = x * (x2 * (0.044715f * 0.7978845608f) + 0.7978845608f); return x * pk_sigmoid_scaled(u, -2.0f * 1.44269504f); }
DI unsigned pk4_fp8_nc(f32x2 a, f32x2 b) { int w = __builtin_amdgcn_cvt_pk_fp8_f32(a.x, a.y, 0, false); w = __builtin_amdgcn_cvt_pk_fp8_f32(b.x, b.y, w, true); return (unsigned)w; }
#define DPP_ROR_ADD(v, n) ((v) + __builtin_bit_cast(float, __builtin_amdgcn_update_dpp(0, __builtin_bit_cast(int, (v)), 0x120 + (n), 0xf, 0xf, false)))
DI float row_sum16(float v) { v = DPP_ROR_ADD(v, 8); v = DPP_ROR_ADD(v, 4); v = DPP_ROR_ADD(v, 2); v = DPP_ROR_ADD(v, 1); return v; }
DI float xrow_sum(float x) {
    float y = x;
    asm("s_nop 1\n\tv_permlane16_swap_b32 %0, %1\n\ts_nop 1" : "+v"(x), "+v"(y));
    x = x + y; y = x;
    asm("s_nop 1\n\tv_permlane32_swap_b32 %0, %1\n\ts_nop 1" : "+v"(x), "+v"(y));
    return x + y;
}
DI float wave_sum(float v) { return xrow_sum(row_sum16(v)); }
#define DPP_ADD(v, ctrl) ((v) + __builtin_bit_cast(float, __builtin_amdgcn_update_dpp(0, __builtin_bit_cast(int, (v)), (ctrl), 0xf, 0xf, false)))
DI float comb32(float x, float y) { asm("s_nop 1\n\tv_permlane32_swap_b32 %0, %1\n\ts_nop 1" : "+v"(x), "+v"(y)); return x + y; }
DI float comb16(float x, float y) { asm("s_nop 1\n\tv_permlane16_swap_b32 %0, %1\n\ts_nop 1" : "+v"(x), "+v"(y)); return x + y; }

DI float sum16(float v) {
    v += __shfl_xor(v, 1); v += __shfl_xor(v, 2); v += __shfl_xor(v, 4); v += __shfl_xor(v, 8); return v;
}

#define XB_TMO      128
#define XB_XCNT(j)  (256  + 64 * (j))
#define XB_XSUB(j)  (1280 + 64 * (j))
#define XB_XGEN(j)  (2304 + 64 * (j))
#define XB_TOP      3328
#define XB_TOPGEN   3392
#define XCD_BAR_WORDS 3456
#define XB_SPIN_CAP (1u << 22)
DI unsigned xb_ld(unsigned* p)              { return __hip_atomic_load(p, __ATOMIC_RELAXED, __HIP_MEMORY_SCOPE_AGENT); }
DI unsigned xb_add(unsigned* p, unsigned v) { return __hip_atomic_fetch_add(p, v, __ATOMIC_RELAXED, __HIP_MEMORY_SCOPE_AGENT); }
DI unsigned xb_xcc_id() { return (unsigned)__builtin_amdgcn_s_getreg((3 << 11) | 20) & 0xFu; }
#define XB_SPIN(cond, bar) do { unsigned _sp = 0; while (cond) { __builtin_amdgcn_s_sleep(1); \
    if ((++_sp & 255u) == 0u) { if (xb_ld(&(bar)[XB_TMO])) break; if (_sp > XB_SPIN_CAP) { atomicAdd(&(bar)[XB_TMO], 1u); break; } } } } while (0)
struct XcdBarrier { unsigned* bar; unsigned x; volatile LAS unsigned* st; };
DI XcdBarrier xcd_barrier_post(unsigned* bar, volatile LAS unsigned* st) {
    XcdBarrier b; b.bar = bar; b.x = xb_xcc_id(); b.st = st;
    if (threadIdx.x == 0) (void)xb_add(&bar[XB_XCNT(b.x)], 1u);
    return b;
}
DI void xcd_barrier_complete(unsigned* bar, unsigned x, unsigned& nloc, unsigned& nx) {
    const unsigned G = gridDim.x * gridDim.y * gridDim.z;
    unsigned sum, cnt, mine, sp = 0u;
    for (;;) {
        sum = 0u; cnt = 0u; mine = 0u;
#pragma unroll
        for (unsigned j = 0; j < 16; ++j) { const unsigned c = xb_ld(&bar[XB_XCNT(j)]); sum += c; cnt += (c > 0u) ? 1u : 0u; mine = (j == x) ? c : mine; }
        if (sum == G) break;
        __builtin_amdgcn_s_sleep(1);
        if ((++sp & 255u) == 0u) { if (xb_ld(&bar[XB_TMO])) break; if (sp > XB_SPIN_CAP) { atomicAdd(&bar[XB_TMO], 1u); break; } }
    }
    nloc = mine > 0u ? mine : 1u; nx = cnt > 0u ? cnt : 1u;
}
DI void xcd_barrier(const XcdBarrier& b) {
    asm volatile("s_waitcnt vmcnt(0)" ::: "memory");
    __syncthreads();
    if (threadIdx.x == 0) {
        unsigned* bar = b.bar;
        __builtin_amdgcn_s_waitcnt(0);
        unsigned nloc = b.st[0], nx = b.st[1];
        if (nloc == 0u) { xcd_barrier_complete(bar, b.x, nloc, nx); b.st[0] = nloc; b.st[1] = nx; }
        const unsigned old = xb_add(&bar[XB_XSUB(b.x)], 1u);
        const unsigned gen = old / nloc;
        if (old + 1u == (gen + 1u) * nloc) {
            __builtin_amdgcn_fence(__ATOMIC_RELEASE, "agent");
            asm volatile("s_waitcnt vmcnt(0)" ::: "memory");
            const unsigned og = xb_add(&bar[XB_TOP], 1u);
            const unsigned tg = og / nx;
            if (og + 1u == (tg + 1u) * nx) xb_add(&bar[XB_TOPGEN], 1u);
            else XB_SPIN(xb_ld(&bar[XB_TOPGEN]) == tg, bar);
            __builtin_amdgcn_fence(__ATOMIC_ACQUIRE, "agent");
            xb_add(&bar[XB_XGEN(b.x)], 1u);
            asm volatile("s_waitcnt vmcnt(0)" ::: "memory");
        } else {
            XB_SPIN(xb_ld(&bar[XB_XGEN(b.x)]) == gen, bar);
            __builtin_amdgcn_fence(__ATOMIC_ACQUIRE, "agent");
            asm volatile("s_waitcnt vmcnt(0)" ::: "memory");
        }
    }
    __syncthreads();
}

constexpr int BM = 256, BK = 64, HALF = 128, HTB = HALF * BK * 2;
DI int lds_byte(int r, int c) { const int st = (r >> 4) * 2 + (c >> 5), rr = r & 15, cc = c & 31, ob = rr * 64 + cc * 2; return st * 1024 + (ob ^ (((ob >> 9) & 1) << 5)); }
DI void stage_rc(int b, int& R, int& C) { const int st = b / 1024, sb = b % 1024, swz = sb ^ (((sb >> 9) & 1) << 5); R = (st >> 1) * 16 + swz / 64; C = (st & 1) * 32 + (swz % 64) / 2; }
DI int perm32(int rho) { const int n = rho >> 4, i = rho & 15; return 8 * (i >> 2) + 4 * n + (i & 3); }
struct Unit { int pm, pn, aux; };

template <class Sched, class Epi>
DI void gemm_phase(LAS unsigned char* lds, const Sched& S, const Epi& E) {
    const int tid = threadIdx.x, wid = __builtin_amdgcn_readfirstlane(tid >> 6), lane = tid & 63, wr = wid >> 2, wc = wid & 3, fr = lane & 15, fq = lane >> 4;
    const int K = S.K, nt = K / BK;
    unsigned voffA[2], voffB[2];
#pragma unroll
    for (int i = 0; i < 2; ++i) { int R, C; stage_rc(tid * 16 + i * 8192, R, C); const int Rb = Epi::PERM ? ((R & ~31) + perm32(R & 31)) : R;
        voffA[i] = (unsigned)(R * S.lda + C) * 2u; voffB[i] = (unsigned)(Rb * S.ldb + C) * 2u; }
    const size_t kstep = (size_t)(BK * 2);
    const size_t hstepA = (size_t)HALF * S.lda * 2, hstepB = (size_t)HALF * S.ldb * 2;
    const unsigned ldsw = (unsigned)wid * 1024u;
    const int aoff = lds_byte(wr * 64 + fr, fq * 8), boff = lds_byte(wc * 32 + fr, fq * 8);
#define PG8_SA(b, h) (((b) * 2 + (h)) * HTB)
#define PG8_SB(b, h) ((4 + (b) * 2 + (h)) * HTB)
    const unsigned ldsbase = (unsigned)(size_t)lds;
#define PG8_STAGE(bufoff, gbase, voff) do { _Pragma("unroll") for (int _i = 0; _i < 2; ++_i) \
        asm volatile("s_mov_b32 m0, %0\n\ts_nop 0\n\tglobal_load_lds_dwordx4 %1, %2" :: "s"(ldsbase + (unsigned)(bufoff) + ldsw + (unsigned)(_i * 8192)), "v"((voff)[_i]), "s"((const char*)(gbase)) : "memory"); } while (0)
#define PG8_LDA(dst, b, h) do { _Pragma("unroll") for (int m = 0; m < 4; ++m) _Pragma("unroll") for (int k = 0; k < 2; ++k) dst[m][k] = *(const LAS bf16x8*)(lds + PG8_SA(b, h) + aoff + m * 2048 + k * 1024); } while (0)
#define PG8_LDB(dst, b, h) do { _Pragma("unroll") for (int n = 0; n < 2; ++n) _Pragma("unroll") for (int k = 0; k < 2; ++k) dst[n][k] = *(const LAS bf16x8*)(lds + PG8_SB(b, h) + boff + n * 2048 + k * 1024); } while (0)
#define PG8_MMA(ai, bj, At, Bt) do { __builtin_amdgcn_s_setprio(1); _Pragma("unroll") for (int m = 0; m < 4; ++m) _Pragma("unroll") for (int n = 0; n < 2; ++n) _Pragma("unroll") for (int k = 0; k < 2; ++k) \
        acc[ai][bj][m][n] = __builtin_amdgcn_mfma_f32_16x16x32_bf16(Bt[n][k], At[m][k], acc[ai][bj][m][n], 0, 0, 0); __builtin_amdgcn_s_setprio(0); } while (0)
#define PG8_WAIT_V(n) asm volatile("s_waitcnt vmcnt(" #n ")" ::: "memory")
#define PG8_WAIT_L(n) asm volatile("s_waitcnt lgkmcnt(" #n ")" ::: "memory")
#define PG8_BAR __builtin_amdgcn_s_barrier()
#define PG8_SCHED __builtin_amdgcn_sched_barrier(0)
    Unit cur, nxt; int ui = 0;
    if (!S.next(0, cur)) return;
    f32x4 acc[2][2][4][2];
#pragma unroll
    for (int a = 0; a < 2; ++a)
#pragma unroll
        for (int b = 0; b < 2; ++b)
#pragma unroll
            for (int m = 0; m < 4; ++m)
#pragma unroll
                for (int n = 0; n < 2; ++n) { if constexpr (Sched::FP8) { f32x2 z0_, z1_; asm volatile("v_pk_mov_b32 %0, 0, 0" : "=v"(z0_)); asm volatile("v_pk_mov_b32 %0, 0, 0" : "=v"(z1_)); acc[a][b][m][n] = (f32x4){z0_.x, z0_.y, z1_.x, z1_.y}; } else acc[a][b][m][n] = (f32x4){0.f, 0.f, 0.f, 0.f}; }
    bf16x8 At[4][2], B0[2][2], B1[2][2];
    i32x8 At8[4], B08[2], B18[2];
    const int aoff8a = lds_byte(wr * 64 + fr, 16 * fq) & ~16, boff8a = lds_byte(wc * 32 + fr, 16 * fq) & ~16;
#define PG8_LDA8(dst, b, h) do { _Pragma("unroll") for (int m = 0; m < 4; ++m) dst[m] = *(const LAS i32x8*)(lds + PG8_SA(b, h) + aoff8a + m * 2048); } while (0)
#define PG8_LDB8(dst, b, h) do { _Pragma("unroll") for (int n = 0; n < 2; ++n) dst[n] = *(const LAS i32x8*)(lds + PG8_SB(b, h) + boff8a + n * 2048); } while (0)
#define PG8_MMA8(ai, bj, At_, Bt_) do { __builtin_amdgcn_s_setprio(1); _Pragma("unroll") for (int m = 0; m < 4; ++m) _Pragma("unroll") for (int n = 0; n < 2; ++n) \
        acc[ai][bj][m][n] = __builtin_amdgcn_mfma_scale_f32_16x16x128_f8f6f4(Bt_[n], At_[m], acc[ai][bj][m][n], 0, 0, 0, 0x7f7f7f7f, 0, 0x7f7f7f7f); __builtin_amdgcn_s_setprio(0); } while (0)
#define XLDA(b, h) do { if constexpr (Sched::FP8) PG8_LDA8(At8, b, h); else PG8_LDA(At, b, h); } while (0)
#define XLDB0(b, h) do { if constexpr (Sched::FP8) PG8_LDB8(B08, b, h); else PG8_LDB(B0, b, h); } while (0)
#define XLDB1(b, h) do { if constexpr (Sched::FP8) PG8_LDB8(B18, b, h); else PG8_LDB(B1, b, h); } while (0)
#define XMMA0(ai, bj) do { if constexpr (Sched::FP8) PG8_MMA8(ai, bj, At8, B08); else PG8_MMA(ai, bj, At, B0); } while (0)
#define XMMA1(ai, bj) do { if constexpr (Sched::FP8) PG8_MMA8(ai, bj, At8, B18); else PG8_MMA(ai, bj, At, B1); } while (0)
    const char* cA = S.a_ptr(cur); const char* cB = S.b_ptr(cur);
    unsigned offA[2][2], offN[2][2];
    if constexpr (Sched::GATHER) {
#pragma unroll
        for (int h = 0; h < 2; ++h)
#pragma unroll
            for (int i = 0; i < 2; ++i) { int R, C; stage_rc(tid * 16 + i * 8192, R, C); offA[h][i] = S.a_rowoff(cur, h * HALF + R) + (unsigned)C * 2u; offN[h][i] = offA[h][i]; }
    }
#define A_STG(bufoff, plainptr, kt, h, nx) do { if constexpr (Sched::GATHER) { PG8_STAGE(bufoff, cA + (size_t)(kt) * kstep, offA[h]); } \
        else PG8_STAGE(bufoff, plainptr, voffA); } while (0)
    if constexpr (GEMM_SP2) {
        PG8_STAGE(PG8_SB(0, 0), cB, voffB); PG8_STAGE(PG8_SB(0, 1), cB + hstepB, voffB); A_STG(PG8_SA(0, 0), cA, 0, 0, false); A_STG(PG8_SA(0, 1), cA + hstepA, 0, 1, false);
        if (wr == 1) PG8_BAR;
        PG8_WAIT_V(2); PG8_BAR;
        PG8_STAGE(PG8_SB(1, 0), cB + kstep, voffB); A_STG(PG8_SA(1, 0), cA + kstep, 1, 0, false); PG8_STAGE(PG8_SB(1, 1), cB + hstepB + kstep, voffB);
        PG8_WAIT_V(6); PG8_BAR;
    } else {
    PG8_STAGE(PG8_SB(0, 0), cB, voffB); A_STG(PG8_SA(0, 0), cA, 0, 0, false); PG8_STAGE(PG8_SB(0, 1), cB + hstepB, voffB); A_STG(PG8_SA(0, 1), cA + hstepA, 0, 1, false);
    if (wr == 1) PG8_BAR;
    PG8_WAIT_V(4); PG8_BAR;
    PG8_STAGE(PG8_SB(1, 0), cB + kstep, voffB); A_STG(PG8_SA(1, 0), cA + kstep, 1, 0, false); PG8_STAGE(PG8_SB(1, 1), cB + hstepB + kstep, voffB);
    PG8_WAIT_V(6); PG8_BAR;
    }
    for (;;) {
        const bool has_next = S.next(ui + 1, nxt);
        const char* nA = has_next ? S.a_ptr(nxt) : cA; const char* nB = has_next ? S.b_ptr(nxt) : cB;
        for (int t = 0; t < nt; t += 2) {
            const bool last = (t == nt - 2);
            const char* a1 = cA + (size_t)(t + 1) * kstep;
            const char* a2 = last ? nA : cA + (size_t)(t + 2) * kstep; const char* b2 = last ? nB : cB + (size_t)(t + 2) * kstep;
            const char* a3 = a2 + kstep; const char* b3 = b2 + kstep;
            const int k2 = last ? 0 : t + 2, k3 = k2 + 1;
            if constexpr (GEMM_SP2) {
            XLDB0(0, 0); XLDB1(0, 1); PG8_SCHED; XLDA(0, 0); A_STG(PG8_SA(1, 1), a1 + hstepA, t + 1, 1, false);
            if constexpr (Sched::GATHER) {
                if (has_next && (t == nt - 4 || nt < 4)) {
#pragma unroll
                    for (int h = 0; h < 2; ++h)
#pragma unroll
                        for (int i = 0; i < 2; ++i) { int R, C; stage_rc(tid * 16 + i * 8192, R, C); offN[h][i] = S.a_rowoff(nxt, h * HALF + R) + (unsigned)C * 2u; } }
                if (last && has_next) { offA[0][0] = offN[0][0]; offA[0][1] = offN[0][1]; offA[1][0] = offN[1][0]; offA[1][1] = offN[1][1]; }
            }
            PG8_WAIT_V(8); PG8_WAIT_L(0); PG8_BAR; XMMA0(0, 0); XMMA1(0, 1); PG8_BAR; PG8_SCHED;
            XLDA(0, 1); PG8_STAGE(PG8_SB(0, 0), b2, voffB); PG8_STAGE(PG8_SB(0, 1), b2 + hstepB, voffB); A_STG(PG8_SA(0, 0), a2, k2, 0, last);
            PG8_WAIT_V(8); PG8_WAIT_L(0); PG8_BAR; XMMA0(1, 0); XMMA1(1, 1); PG8_BAR; PG8_SCHED;
            XLDB0(1, 0); XLDB1(1, 1); PG8_SCHED; XLDA(1, 0); A_STG(PG8_SA(0, 1), a2 + hstepA, k2, 1, last);
            PG8_WAIT_V(8); PG8_WAIT_L(0); PG8_BAR; XMMA0(0, 0); XMMA1(0, 1); PG8_BAR; PG8_SCHED;
            XLDA(1, 1); PG8_STAGE(PG8_SB(1, 0), b3, voffB); PG8_STAGE(PG8_SB(1, 1), b3 + hstepB, voffB); A_STG(PG8_SA(1, 0), a3, k3, 0, last);
            PG8_WAIT_V(8); PG8_WAIT_L(0); PG8_BAR; XMMA0(1, 0); XMMA1(1, 1); PG8_BAR; PG8_SCHED;
            } else {
            XLDB0(0, 0); PG8_SCHED; XLDA(0, 0); A_STG(PG8_SA(1, 1), a1 + hstepA, t + 1, 1, false);
            if constexpr (Sched::GATHER) {
                if (has_next && (t == nt - 4 || nt < 4)) {
#pragma unroll
                    for (int h = 0; h < 2; ++h)
#pragma unroll
                        for (int i = 0; i < 2; ++i) { int R, C; stage_rc(tid * 16 + i * 8192, R, C); offN[h][i] = S.a_rowoff(nxt, h * HALF + R) + (unsigned)C * 2u; } }
                if (last && has_next) { offA[0][0] = offN[0][0]; offA[0][1] = offN[0][1]; offA[1][0] = offN[1][0]; offA[1][1] = offN[1][1]; }
            }
            PG8_WAIT_L(8); PG8_BAR; PG8_WAIT_L(0); XMMA0(0, 0); PG8_BAR; PG8_SCHED;
            XLDB1(0, 1); PG8_STAGE(PG8_SB(0, 0), b2, voffB);
            PG8_BAR; PG8_WAIT_L(0); XMMA1(0, 1); PG8_BAR;
            XLDA(0, 1); A_STG(PG8_SA(0, 0), a2, k2, 0, last);
            PG8_BAR; PG8_WAIT_L(0); XMMA0(1, 0); PG8_BAR; PG8_SCHED;
            PG8_STAGE(PG8_SB(0, 1), b2 + hstepB, voffB);
            PG8_WAIT_V(6); PG8_BAR; XMMA1(1, 1); PG8_BAR;
            XLDB0(1, 0); PG8_SCHED; XLDA(1, 0); A_STG(PG8_SA(0, 1), a2 + hstepA, k2, 1, last);
            PG8_WAIT_L(8); PG8_BAR; PG8_WAIT_L(0); XMMA0(0, 0); PG8_BAR; PG8_SCHED;
            XLDB1(1, 1); PG8_STAGE(PG8_SB(1, 0), b3, voffB);
            PG8_BAR; PG8_WAIT_L(0); XMMA1(0, 1); PG8_BAR;
            XLDA(1, 1); A_STG(PG8_SA(1, 0), a3, k3, 0, last);
            PG8_BAR; PG8_WAIT_L(0); XMMA0(1, 0); PG8_BAR; PG8_SCHED;
            PG8_STAGE(PG8_SB(1, 1), b3 + hstepB, voffB);
            PG8_WAIT_V(6); PG8_BAR; XMMA1(1, 1); PG8_BAR;
            }
        }
        if constexpr (GEMM_ALIGN) { if (wr == 0) PG8_BAR; }
        {
            int tz = threadIdx.x; asm volatile("" : "+v"(tz));
            const int wid2 = tz >> 6, lane2 = tz & 63;
            E(acc, cur, wid2 >> 2, wid2 & 3, lane2 & 15, lane2 >> 4); }
        if (!has_next) break;
#pragma unroll
        for (int a = 0; a < 2; ++a)
#pragma unroll
            for (int b = 0; b < 2; ++b)
#pragma unroll
                for (int m = 0; m < 4; ++m)
#pragma unroll
                    for (int n = 0; n < 2; ++n) { if constexpr (Sched::FP8) { f32x2 z0_, z1_; asm volatile("v_pk_mov_b32 %0, 0, 0" : "=v"(z0_)); asm volatile("v_pk_mov_b32 %0, 0, 0" : "=v"(z1_)); acc[a][b][m][n] = (f32x4){z0_.x, z0_.y, z1_.x, z1_.y}; } else acc[a][b][m][n] = (f32x4){0.f, 0.f, 0.f, 0.f}; }
        cur = nxt; cA = nA; cB = nB; ++ui;
        if constexpr (GEMM_ALIGN) { if (wr == 1) PG8_BAR; }
    }
    PG8_WAIT_V(0);
    if constexpr (!GEMM_ALIGN) { if (wr == 0) PG8_BAR; }
    PG8_BAR;
#undef XLDA
#undef XLDB0
#undef XLDB1
#undef XMMA0
#undef XMMA1
#undef PG8_LDA8
#undef PG8_LDB8
#undef PG8_MMA8
#undef A_STG
#undef PG8_SA
#undef PG8_SB
#undef PG8_STAGE
#undef PG8_LDA
#undef PG8_LDB
#undef PG8_MMA
#undef PG8_WAIT_V
#undef PG8_WAIT_L
#undef PG8_BAR
#undef PG8_SCHED
}

struct PlainSched {
    static constexpr bool GATHER = false, FP8 = false;
    const char* A; const char* B; int K, lda, ldb, nM, nN, nwg, G, c; int akoff_pn = 1 << 30, akoff_bytes = 0;
    DI void init(const void* A_, const void* B_, int M, int N, int K_, int lda_, int ldb_, int G_, int c_) { A = (const char*)A_; B = (const char*)B_; K = K_; lda = lda_; ldb = ldb_; nM = M / BM; nN = N / BM; nwg = nM * nN; G = G_; c = c_; }
    DI bool next(int i, Unit& u) const {
        const long L = (long)i * G + c; if (L >= nwg) return false;
        int wgid = (int)L; { const int q = nwg / 8, r = nwg % 8, xcd = wgid % 8, off = wgid / 8; wgid = (xcd < r ? xcd * (q + 1) : r * (q + 1) + (xcd - r) * q) + off; }
        const int nig = 8 * nN, gid = wgid / nig, fm = gid * 8, gsz = (nM - fm) < 8 ? (nM - fm) : 8;
        u.pm = fm + ((wgid % nig) % gsz); u.pn = (wgid % nig) / gsz; u.aux = 0; return true;
    }
    DI const char* a_ptr(const Unit& u) const { return A + (size_t)u.pm * BM * lda * 2 + (u.pn >= akoff_pn ? akoff_bytes : 0); }
    DI const char* b_ptr(const Unit& u) const { return B + (size_t)u.pn * BM * ldb * 2; }
};
struct GroupSched {
    static constexpr bool GATHER = false, FP8 = false;
    const char* A; const char* B; int K, lda, ldb, nMg, nN, nwg, G, c;
    DI void init(const void* A_, const void* B_, int K_, int lda_, int ldb_, int nMg_, int nN_, int G_, int c_) { A = (const char*)A_; B = (const char*)B_; K = K_; lda = lda_; ldb = ldb_; nMg = nMg_; nN = nN_; nwg = 32 * nMg * nN; G = G_; c = c_; }
    DI bool next(int i, Unit& u) const {
        const int L = i * G + c; if (L >= nwg) return false;
        const int per = nMg * nN, g = L / per, rem = L % per; u.pm = g * nMg + rem / nN; u.pn = rem % nN; u.aux = g; return true;
    }
    DI const char* a_ptr(const Unit& u) const { return A + (size_t)u.pm * BM * lda * 2; }
    DI const char* b_ptr(const Unit& u) const { return B + ((size_t)u.aux * nN + u.pn) * BM * ldb * 2; }
};
template <bool GATH>
struct MoeSched {
    static constexpr bool GATHER = GATH, FP8 = true;
    const char* A; const char* B; const int* tile_e; const int* rowtok; int K, lda, ldb, nN, NperE, nwg, G, c;
    DI void init(const void* A_, const void* B_, const int* te, const int* rt, int ntiles, int K_, int nN_, int G_, int c_) { A = (const char*)A_; B = (const char*)B_; tile_e = te; rowtok = rt; K = K_; lda = K_; ldb = K_; nN = nN_; NperE = nN_ * BM; nwg = ntiles * nN_; G = G_; c = c_; }
    DI bool next(int i, Unit& u) const {
        int L = i * G + c; if (L >= nwg) return false;
        if (G == 256 && (i + 1) * G <= nwg) { const int x = c & 7, sl = c >> 3, mt = G / nN / 8;
            L = i * G + (x * mt + sl / nN) * nN + (sl % nN); }
        u.pm = L / nN; u.pn = L % nN; u.aux = __builtin_amdgcn_readfirstlane(__hip_atomic_load(tile_e + u.pm, __ATOMIC_RELAXED, __HIP_MEMORY_SCOPE_AGENT)); return true;
    }
    DI const char* a_ptr(const Unit& u) const { return GATH ? A : A + (size_t)u.pm * BM * lda * 2; }
    DI unsigned a_rowoff(const Unit& u, int row) const { return (unsigned)__hip_atomic_load(rowtok + u.pm * BM + row, __ATOMIC_RELAXED, __HIP_MEMORY_SCOPE_AGENT) * (unsigned)(lda * 2); }
    DI const char* b_ptr(const Unit& u) const { return B + ((size_t)u.aux * NperE + (size_t)u.pn * BM) * ldb * 2; }
};

typedef f32x4 AccT[2][2][4][2];
struct EpiWin {
    static constexpr bool PERM = true;
    bf16_t* us5; bf16_t* prw; bf16_t* gates;
    DI static u32x4 pack8(const f32x4& v0, const f32x4& v1) { u32x4 w; w.x = cvt_pk_bf16(v0[0], v0[1]); w.y = cvt_pk_bf16(v0[2], v0[3]); w.z = cvt_pk_bf16(v1[0], v1[1]); w.w = cvt_pk_bf16(v1[2], v1[3]); return w; }
    DI void operator()(const AccT& acc, const Unit& u, int wr, int wc, int fr, int fq) const {
        if (u.pn < 2) {
#pragma unroll
            for (int ai = 0; ai < 2; ++ai)
#pragma unroll
                for (int m = 0; m < 4; ++m) { const int r = u.pm * BM + ai * HALF + wr * 64 + m * 16 + fr, b = r >> 12, sq = r & 4095, ch = sq / S5L, j = sq % S5L;
#pragma unroll
                    for (int bj = 0; bj < 2; ++bj) { const int c0 = u.pn * BM + bj * HALF + wc * 32 + 8 * fq, g = c0 >> 4, ci = c0 & 15;
                        *(u32x4*)(us5 + ((size_t)(g * S5ROWS + b * S5NC + ch) * LDU + j * 16 + ci)) = pack8(acc[ai][bj][m][0], acc[ai][bj][m][1]); } }
        } else if (u.pn < 9) {
#pragma unroll
            for (int ai = 0; ai < 2; ++ai)
#pragma unroll
                for (int m = 0; m < 4; ++m) { const int r = u.pm * BM + ai * HALF + wr * 64 + m * 16 + fr;
#pragma unroll
                    for (int bj = 0; bj < 2; ++bj) { const int c0 = u.pn * BM + bj * HALF + wc * 32 + 8 * fq;
                        *(u32x4*)(prw + (size_t)r * RWC + (c0 - 512)) = pack8(acc[ai][bj][m][0], acc[ai][bj][m][1]); } }
        } else {
#pragma unroll
            for (int ai = 0; ai < 2; ++ai)
#pragma unroll
                for (int m = 0; m < 4; ++m) { const int r = u.pm * BM + ai * HALF + wr * 64 + m * 16 + fr;
#pragma unroll
                    for (int bj = 0; bj < 2; ++bj) { const int c0 = u.pn * BM + bj * HALF + wc * 32 + 8 * fq;
                        const f32x4& v0 = acc[ai][bj][m][0]; const f32x4& v1 = acc[ai][bj][m][1];
                        const f32x2 a_ = pk_sigmoid(lo2(v0)), b_ = pk_sigmoid(hi2(v0)), c_ = pk_sigmoid(lo2(v1)), d_ = pk_sigmoid(hi2(v1));
                        u32x4 w; w.x = cvt_pk_bf16(a_.x, a_.y); w.y = cvt_pk_bf16(b_.x, b_.y); w.z = cvt_pk_bf16(c_.x, c_.y); w.w = cvt_pk_bf16(d_.x, d_.y);
                        *(u32x4*)(gates + (size_t)r * 2048 + (c0 - 2304)) = w; } }
        }
    }
};
struct EpiS5State {
    static constexpr bool PERM = false;
    float* sloc;
    DI void operator()(const AccT& acc, const Unit& u, int wr, int wc, int fr, int fq) const {
#pragma unroll
        for (int ai = 0; ai < 2; ++ai)
#pragma unroll
            for (int m = 0; m < 4; ++m) {
                const int r = u.pm * BM + ai * HALF + wr * 64 + m * 16 + fr;
#pragma unroll
                for (int n = 0; n < 2; ++n) *(f32x4*)(sloc + (size_t)r * 128 + wc * 32 + 16 * n + 4 * fq) = acc[ai][0][m][n];
            }
    }
};
struct EpiS5Out {
    static constexpr bool PERM = true;
    bf16_t* ys;
    DI void operator()(const AccT& acc, const Unit& u, int wr, int wc, int fr, int fq) const {
        const int g = u.aux;
#pragma unroll
        for (int ai = 0; ai < 2; ++ai)
#pragma unroll
            for (int m = 0; m < 4; ++m) {
                const int r = u.pm * BM + ai * HALF + wr * 64 + m * 16 + fr;
                const int rc = r - g * S5ROWS;
#pragma unroll
                for (int bj = 0; bj < 2; ++bj) {
                    const int c0 = u.pn * BM + bj * HALF + wc * 32 + 8 * fq;
                    const int t = c0 >> 4, co = c0 & 15;
                    const size_t tok = (size_t)rc * S5L + t;
                    f32x4 v0 = acc[ai][bj][m][0], v1 = acc[ai][bj][m][1];
                    { const f32x2 a_ = pk_gelu_tanh(lo2(v0)), b_ = pk_gelu_tanh(hi2(v0)), c_ = pk_gelu_tanh(lo2(v1)), d_ = pk_gelu_tanh(hi2(v1));
                      v0 = (f32x4){a_.x, a_.y, b_.x, b_.y}; v1 = (f32x4){c_.x, c_.y, d_.x, d_.y}; }
                    u32x4 w; w.x = cvt_pk_bf16(v0[0], v0[1]); w.y = cvt_pk_bf16(v0[2], v0[3]); w.z = cvt_pk_bf16(v1[0], v1[1]); w.w = cvt_pk_bf16(v1[2], v1[3]);
                    *(u32x4*)(ys + tok * 512 + g * 16 + co) = w;
                }
            }
    }
};
struct EpiLora {
    static constexpr bool PERM = true;
    bf16_t* lwag; const float* w0; const float* a0;
    DI void operator()(const AccT& acc, const Unit& u, int wr, int wc, int fr, int fq) const {
#pragma unroll
        for (int bj = 0; bj < 2; ++bj) {
            const int c0 = u.pn * BM + bj * HALF + wc * 32 + 8 * fq;
            f32x4 b0 = (f32x4){0.f, 0.f, 0.f, 0.f}, b1 = b0;
            if (c0 < 512) { b0 = *(const f32x4*)(w0 + c0); b1 = *(const f32x4*)(w0 + c0 + 4); } else if (c0 < 1024) { b0 = *(const f32x4*)(a0 + c0 - 512); b1 = *(const f32x4*)(a0 + c0 - 508); }
            const f32x2 bias[4] = {lo2(b0), hi2(b0), lo2(b1), hi2(b1)};
            const float osc = (c0 < 512) ? -0.6065306597f : 1.0f;
            if (c0 < 1024) {
#pragma unroll
                for (int ai = 0; ai < 2; ++ai)
#pragma unroll
                    for (int m = 0; m < 4; ++m) { const int r = u.pm * BM + ai * HALF + wr * 64 + m * 16 + fr; u32x4 w;
#pragma unroll
                        for (int jp = 0; jp < 4; ++jp) { const f32x4& a = acc[ai][bj][m][jp >> 1]; const f32x2 v = pk_sigmoid(((jp & 1) ? hi2(a) : lo2(a)) + bias[jp]) * osc; w[jp] = cvt_pk_bf16(v.x, v.y); }
                        *(u32x4*)(lwag + (size_t)r * 1536 + c0) = w; }
            } else {
#pragma unroll
                for (int ai = 0; ai < 2; ++ai)
#pragma unroll
                    for (int m = 0; m < 4; ++m) { const int r = u.pm * BM + ai * HALF + wr * 64 + m * 16 + fr; u32x4 w;
#pragma unroll
                        for (int jp = 0; jp < 4; ++jp) { const f32x4& a = acc[ai][bj][m][jp >> 1]; const f32x2 v = (jp & 1) ? hi2(a) : lo2(a); w[jp] = cvt_pk_bf16(v.x, v.y); }
                        *(u32x4*)(lwag + (size_t)r * 1536 + c0) = w; }
            }
        }
    }
};
struct EpiGlu {
    static constexpr bool PERM = true;
    bf16_t* mixed; const bf16_t* gates; const float* bglu;
    DI void operator()(const AccT& acc, const Unit& u, int wr, int wc, int fr, int fq) const {
        const int cw = wc * 32 + 8 * fq, j0 = u.pn * 128 + cw;
        const float* bp = bglu + u.pn * 256 + cw;
        const f32x4 ba0 = *(const f32x4*)bp, ba1 = *(const f32x4*)(bp + 4), bb0 = *(const f32x4*)(bp + 128), bb1 = *(const f32x4*)(bp + 132);
        const f32x2 ba[4] = {lo2(ba0), hi2(ba0), lo2(ba1), hi2(ba1)}, bb[4] = {lo2(bb0), hi2(bb0), lo2(bb1), hi2(bb1)};
        u32x4 gw[2][4];
#pragma unroll
        for (int ai = 0; ai < 2; ++ai)
#pragma unroll
            for (int m = 0; m < 4; ++m) gw[ai][m] = *(const u32x4*)(gates + (size_t)(u.pm * BM + ai * HALF + wr * 64 + m * 16 + fr) * 2048 + j0);
#pragma unroll
        for (int ai = 0; ai < 2; ++ai)
#pragma unroll
            for (int m = 0; m < 4; ++m) {
                const int r = u.pm * BM + ai * HALF + wr * 64 + m * 16 + fr;
                u32x4 w;
#pragma unroll
                for (int jp = 0; jp < 4; ++jp) {
                    const f32x4& aa = acc[ai][0][m][jp >> 1]; const f32x4& ab = acc[ai][1][m][jp >> 1];
                    const f32x2 za = ((jp & 1) ? hi2(aa) : lo2(aa)) + ba[jp], zb = ((jp & 1) ? hi2(ab) : lo2(ab)) + bb[jp];
                    const unsigned gwd = gw[ai][m][jp]; const f32x2 gt = {bf_lo(gwd), bf_hi(gwd)};
                    const f32x2 o = (gt * za) * pk_sigmoid(zb);
                    w[jp] = cvt_pk_bf16(o.x, o.y);
                }
                *(u32x4*)(mixed + (size_t)r * 1024 + j0) = w;
            }
    }
};
struct EpiWo {
    static constexpr bool PERM = true;
    bf16_t* mixed; const bf16_t* gates;
    DI void operator()(const AccT& acc, const Unit& u, int wr, int wc, int fr, int fq) const {
#pragma unroll
        for (int ai = 0; ai < 2; ++ai) {
            u32x4 gw[4][2], mw[4][2];
#pragma unroll
            for (int m = 0; m < 4; ++m)
#pragma unroll
                for (int bj = 0; bj < 2; ++bj) { const size_t r = (size_t)(u.pm * BM + ai * HALF + wr * 64 + m * 16 + fr); const int c0 = u.pn * BM + bj * HALF + wc * 32 + 8 * fq;
                    gw[m][bj] = *(const u32x4*)(gates + r * 2048 + 1024 + c0); mw[m][bj] = *(const u32x4*)(mixed + r * 1024 + c0); }
#pragma unroll
            for (int m = 0; m < 4; ++m)
#pragma unroll
                for (int bj = 0; bj < 2; ++bj) { const size_t r = (size_t)(u.pm * BM + ai * HALF + wr * 64 + m * 16 + fr); const int c0 = u.pn * BM + bj * HALF + wc * 32 + 8 * fq;
                    u32x4 w;
#pragma unroll
                    for (int jp = 0; jp < 4; ++jp) { const unsigned gwd = gw[m][bj][jp], mwd = mw[m][bj][jp]; const f32x4& a = acc[ai][bj][m][jp >> 1];
                        const f32x2 o = (f32x2){bf_lo(mwd), bf_hi(mwd)} + (f32x2){bf_lo(gwd), bf_hi(gwd)} * ((jp & 1) ? hi2(a) : lo2(a));
                        w[jp] = cvt_pk_bf16(o.x, o.y); }
                    *(u32x4*)(mixed + r * 1024 + c0) = w; }
        }
    }
};
struct EpiOut {
    static constexpr bool PERM = true;
    bf16_t* hb; const float* x;
    DI void operator()(const AccT& acc, const Unit& u, int wr, int wc, int fr, int fq) const {
#pragma unroll
        for (int ai = 0; ai < 2; ++ai) {
            f32x4 xv[4][2][2];
#pragma unroll
            for (int m = 0; m < 4; ++m) { const size_t r = (size_t)(u.pm * BM + ai * HALF + wr * 64 + m * 16 + fr);
#pragma unroll
                for (int bj = 0; bj < 2; ++bj) { const float* xp = x + r * 1024 + u.pn * BM + bj * HALF + wc * 32 + 8 * fq; xv[m][bj][0] = *(const f32x4*)xp; xv[m][bj][1] = *(const f32x4*)(xp + 4); } }
#pragma unroll
            for (int m = 0; m < 4; ++m) { const size_t r = (size_t)(u.pm * BM + ai * HALF + wr * 64 + m * 16 + fr);
#pragma unroll
                for (int bj = 0; bj < 2; ++bj) { const f32x4 v0 = xv[m][bj][0] + acc[ai][bj][m][0], v1 = xv[m][bj][1] + acc[ai][bj][m][1];
                    u32x4 w; w.x = cvt_pk_bf16(v0[0], v0[1]); w.y = cvt_pk_bf16(v0[2], v0[3]); w.z = cvt_pk_bf16(v1[0], v1[1]); w.w = cvt_pk_bf16(v1[2], v1[3]);
                    *(u32x4*)(hb + r * 1024 + u.pn * BM + bj * HALF + wc * 32 + 8 * fq) = w; } }
        }
    }
};
struct EpiRouter {
    static constexpr bool PERM = false;
    float* logits;
    DI void operator()(const AccT& acc, const Unit& u, int wr, int wc, int fr, int fq) const {
        if (wc != 0) return;
#pragma unroll
        for (int n = 0; n < 2; ++n) {
            const int c = 16 * n + 4 * fq;
#pragma unroll
            for (int ai = 0; ai < 2; ++ai)
#pragma unroll
                for (int m = 0; m < 4; ++m) {
                    const size_t r = (size_t)(u.pm * BM + ai * HALF + wr * 64 + m * 16 + fr);
                    *(f32x4*)(logits + r * 32 + c) = acc[ai][0][m][n];
                }
        }
    }
};
struct EpiMoe1 {
    static constexpr bool PERM = true;
    unsigned char* act; const float* b1p;
    DI void operator()(const AccT& acc, const Unit& u, int wr, int wc, int fr, int fq) const {
        const int cw = wc * 32 + 8 * fq, j0 = u.pn * 128 + cw;
        const float* bp = b1p + (size_t)u.aux * 2048 + u.pn * 256 + cw;
        const f32x4 ba0 = *(const f32x4*)bp, ba1 = *(const f32x4*)(bp + 4), bb0 = *(const f32x4*)(bp + 128), bb1 = *(const f32x4*)(bp + 132);
        const f32x2 ba[4] = {lo2(ba0), hi2(ba0), lo2(ba1), hi2(ba1)}, bb[4] = {lo2(bb0), hi2(bb0), lo2(bb1), hi2(bb1)};
        constexpr float sc = 1.0f / (F8_SX * F8_SW);
#pragma unroll
        for (int ai = 0; ai < 2; ++ai)
#pragma unroll
            for (int m = 0; m < 4; ++m) {
                const size_t r = (size_t)(u.pm * BM + ai * HALF + wr * 64 + m * 16 + fr);
                f32x2 o[4];
#pragma unroll
                for (int jp = 0; jp < 4; ++jp) {
                    const f32x4& ag = acc[ai][0][m][jp >> 1]; const f32x4& al_ = acc[ai][1][m][jp >> 1];
                    const f32x2 g = ((jp & 1) ? hi2(ag) : lo2(ag)) * sc + ba[jp], l = ((jp & 1) ? hi2(al_) : lo2(al_)) * sc + bb[jp];
                    const f32x2 xg = __builtin_elementwise_min(g, (f32x2){7.0f, 7.0f});
                    const f32x2 xl = __builtin_elementwise_min(__builtin_elementwise_max(l, (f32x2){-7.0f, -7.0f}), (f32x2){7.0f, 7.0f});
                    o[jp] = (xg * pk_sigmoid_scaled(xg, -1.702f * 1.44269504f)) * (xl * F8_SA + F8_SA);
                }
                u32x2 w; w.x = pk4_fp8_nc(o[0], o[1]); w.y = pk4_fp8_nc(o[2], o[3]);
                *(u32x2*)(act + r * 1024 + j0) = w;
            }
    }
};
struct EpiMoe2 {
    static constexpr bool PERM = true;
    unsigned char* y2; const float* b2; const float* rowg;
    DI void operator()(const AccT& acc, const Unit& u, int wr, int wc, int fr, int fq) const {
        float gt[2][4];
#pragma unroll
        for (int ai = 0; ai < 2; ++ai)
#pragma unroll
            for (int m = 0; m < 4; ++m) gt[ai][m] = rowg[(size_t)(u.pm * BM + ai * HALF + wr * 64 + m * 16 + fr)] * F8_SY;
#pragma unroll
        for (int bj = 0; bj < 2; ++bj) {
            const int c0 = u.pn * BM + bj * HALF + wc * 32 + 8 * fq;
            const f32x4 bva = *(const f32x4*)(b2 + (size_t)u.aux * 1024 + c0), bvb = *(const f32x4*)(b2 + (size_t)u.aux * 1024 + c0 + 4);
            const f32x2 bv[4] = {lo2(bva), hi2(bva), lo2(bvb), hi2(bvb)};
#pragma unroll
            for (int ai = 0; ai < 2; ++ai)
#pragma unroll
                for (int m = 0; m < 4; ++m) {
                    const size_t r = (size_t)(u.pm * BM + ai * HALF + wr * 64 + m * 16 + fr);
                    const float g = gt[ai][m];
                    f32x2 o[4];
#pragma unroll
                    for (int jp = 0; jp < 4; ++jp) { const f32x4& a = acc[ai][bj][m][jp >> 1];
                        o[jp] = (((jp & 1) ? hi2(a) : lo2(a)) * (1.0f / (F8_SA * F8_SW)) + bv[jp]) * g;
                        o[jp] = __builtin_elementwise_min(__builtin_elementwise_max(o[jp], (f32x2){-448.f, -448.f}), (f32x2){448.f, 448.f}); }
                    u32x2 w; w.x = pk4_fp8_nc(o[0], o[1]); w.y = pk4_fp8_nc(o[2], o[3]);
                    *(u32x2*)(y2 + r * 1024 + c0) = w;
                }
        }
    }
};
struct KArgs { const float* in[34]; float* out; unsigned char* ws; int ph_lo, ph_hi; };
struct Frame {
    LAS unsigned char* lds; int tid, lane, wave, G, bid;
    const float* const* in; float* out; unsigned char* ws;
};

template <class MP>
DI void conv_T(const Frame& F, const float* src, size_t src_bstride, int ld, bf16_t* dst, int N, int K, int nbatch, MP mp, int t0 = 0, int t1 = 0x7fffffff) {
    LAS unsigned* tile = (LAS unsigned*)F.lds;
    const int ntk = K / 64, ntn = N / 256, per = ntk * ntn;
    const int tend = (per * nbatch) < t1 ? (per * nbatch) : t1;
    for (int t = t0 + F.bid; t < tend; t += F.G) {
        const int bt = t / per, tt = t % per, tk = tt % ntk, pn = tt / ntk;
        const float* s = src + (size_t)bt * src_bstride + (size_t)(tk * 64) * ld + mp.src(pn, F.lane);
        f32x4 va[4], vb[4];
#pragma unroll
        for (int i = 0; i < 4; ++i) { const int kp = F.wave + 8 * i; va[i] = *(const f32x4*)(s + (size_t)(2 * kp) * ld); vb[i] = *(const f32x4*)(s + (size_t)(2 * kp + 1) * ld); }
#pragma unroll
        for (int i = 0; i < 4; ++i) { const int kp = F.wave + 8 * i;
#pragma unroll
            for (int j = 0; j < 4; ++j) tile[mp.dst(F.lane, j) * 33 + kp] = cvt_pk_bf16(va[i][j], vb[i][j]); }
        __syncthreads();
        unsigned* d = (unsigned*)(dst + (size_t)bt * N * K + (size_t)(pn * 256) * K + tk * 64);
#pragma unroll
        for (int i = 0; i < 4; ++i) { const int pc = F.tid + NTHR * i, nn = pc >> 3, seg = pc & 7;
            u32x4 w; w.x = tile[nn * 33 + seg * 4]; w.y = tile[nn * 33 + seg * 4 + 1]; w.z = tile[nn * 33 + seg * 4 + 2]; w.w = tile[nn * 33 + seg * 4 + 3];
            *(u32x4*)(d + ((size_t)nn * K) / 2 + seg * 4) = w; }
        __syncthreads();
    }
}
template <class MP>
DI void conv_T8(const Frame& F, const float* src, size_t src_bstride, int ld, unsigned char* dst, int N, int K, int nbatch, MP mp, float scale, int t0 = 0, int t1 = 0x7fffffff) {
    LAS unsigned* tile = (LAS unsigned*)F.lds;
    const int ntk = K / 64, ntn = N / 256, per = ntk * ntn;
    const int tend = (per * nbatch) < t1 ? (per * nbatch) : t1;
    for (int t = t0 + F.bid; t < tend; t += F.G) {
        const int bt = t / per, tt = t % per, tk = tt % ntk, pn = tt / ntk;
        const float* s = src + (size_t)bt * src_bstride + (size_t)(tk * 64) * ld + mp.src(pn, F.lane);
        f32x4 v[2][4];
#pragma unroll
        for (int i = 0; i < 2; ++i) { const int kq = F.wave + 8 * i;
#pragma unroll
            for (int e = 0; e < 4; ++e) v[i][e] = *(const f32x4*)(s + (size_t)(4 * kq + e) * ld); }
#pragma unroll
        for (int i = 0; i < 2; ++i) { const int kq = F.wave + 8 * i;
#pragma unroll
            for (int j = 0; j < 4; ++j) tile[mp.dst(F.lane, j) * 17 + kq] = pk4_fp8(v[i][0][j] * scale, v[i][1][j] * scale, v[i][2][j] * scale, v[i][3][j] * scale); }
        __syncthreads();
        unsigned char* d = dst + ((size_t)bt * N + (size_t)pn * 256) * K + tk * 64;
#pragma unroll
        for (int i = 0; i < 2; ++i) { const int pc = F.tid + NTHR * i, nn = pc >> 2, seg = pc & 3;
            u32x4 w; w.x = tile[nn * 17 + seg * 4]; w.y = tile[nn * 17 + seg * 4 + 1]; w.z = tile[nn * 17 + seg * 4 + 2]; w.w = tile[nn * 17 + seg * 4 + 3];
            *(u32x4*)(d + (size_t)nn * K + seg * 16) = w; }
        __syncthreads();
    }
}
struct MpId  { DI int src(int pn, int f) const { return pn * 256 + 4 * f; } DI int dst(int f, int j) const { return 4 * f + j; } };
struct MpSwi { DI int src(int pn, int f) const { return pn * 256 + 4 * f; } DI int dst(int f, int j) const { const int n = 4 * f + j; return (n >> 1) + 128 * (n & 1); } };
struct MpGlu { DI int src(int pn, int f) const { const int w = 4 * f; return pn * 128 + (w & 127) + 1024 * (w >> 7); } DI int dst(int f, int j) const { return 4 * f + j; } };
struct CmGlu { DI int operator()(int n) const { const int pn = n >> 8, w = n & 255; return pn * 128 + (w & 127) + 1024 * (w >> 7); } };
struct CmSwi { DI int operator()(int n) const { const int pn = n >> 8, w = n & 255; return 2 * (pn * 128 + (w & 127)) + (w >> 7); } };

DI void rmsnorm_rows(const Frame& F, const float* x, const float* g, bf16_t* out, int row0, int nrows, unsigned char* out8 = nullptr) {
    const int stride = F.G * NWAVES;
    for (int row = row0 + F.bid * NWAVES + F.wave; row < row0 + nrows; row += 2 * stride) {
        const int row2 = (row + stride < row0 + nrows) ? row + stride : row;
        const f32x4* xr = (const f32x4*)(x + (size_t)row * D); const f32x4* xr2 = (const f32x4*)(x + (size_t)row2 * D);
        f32x4 v[4], u[4]; float ss = 0.f, su = 0.f;
#pragma unroll
        for (int i = 0; i < 4; ++i) { v[i] = xr[i * 64 + F.lane]; u[i] = xr2[i * 64 + F.lane]; }
#pragma unroll
        for (int i = 0; i < 4; ++i) { ss += v[i][0] * v[i][0] + v[i][1] * v[i][1] + v[i][2] * v[i][2] + v[i][3] * v[i][3]; su += u[i][0] * u[i][0] + u[i][1] * u[i][1] + u[i][2] * u[i][2] + u[i][3] * u[i][3]; }
        ss = wave_sum(ss); su = wave_sum(su);
        const float rs = rsqrtf(ss * (1.0f / D) + 1e-5f), ru = rsqrtf(su * (1.0f / D) + 1e-5f);
#pragma unroll
        for (int i = 0; i < 4; ++i) { const f32x4 gv = ((const f32x4*)g)[i * 64 + F.lane];
            u32x2 w; w.x = cvt_pk_bf16(v[i][0] * rs * gv[0], v[i][1] * rs * gv[1]); w.y = cvt_pk_bf16(v[i][2] * rs * gv[2], v[i][3] * rs * gv[3]);
            *(u32x2*)(out + (size_t)row * D + (i * 64 + F.lane) * 4) = w;
            u32x2 w2; w2.x = cvt_pk_bf16(u[i][0] * ru * gv[0], u[i][1] * ru * gv[1]); w2.y = cvt_pk_bf16(u[i][2] * ru * gv[2], u[i][3] * ru * gv[3]);
            *(u32x2*)(out + (size_t)row2 * D + (i * 64 + F.lane) * 4) = w2;
            if (out8) { *(unsigned*)(out8 + (size_t)row * D + (i * 64 + F.lane) * 4) = pk4_fp8(v[i][0] * rs * gv[0] * F8_SX, v[i][1] * rs * gv[1] * F8_SX, v[i][2] * rs * gv[2] * F8_SX, v[i][3] * rs * gv[3] * F8_SX);
                *(unsigned*)(out8 + (size_t)row2 * D + (i * 64 + F.lane) * 4) = pk4_fp8(u[i][0] * ru * gv[0] * F8_SX, u[i][1] * ru * gv[1] * F8_SX, u[i][2] * ru * gv[2] * F8_SX, u[i][3] * ru * gv[3] * F8_SX); } }
    }
}

DI void p0_prologue(const Frame& F) {
    unsigned char* ws = F.ws;
    conv_T(F, F.in[2], 0, INC, (bf16_t*)(ws + WS_WIN), INC, D, 1, MpId());
    conv_T(F, F.in[11], 0, 2048, (bf16_t*)(ws + WS_WGLU), 2048, 512, 1, MpGlu());
    conv_T(F, F.in[24], 0, 1024, (bf16_t*)(ws + WS_WO), 1024, 512, 1, MpId());
    conv_T(F, F.in[25], 0, 1024, (bf16_t*)(ws + WS_WOUT), 1024, 1024, 1, MpId());
    {
        bf16_t* wl = (bf16_t*)(ws + WS_WLORA); const float* w2 = F.in[15]; const float* a2 = F.in[17]; const float* g2 = F.in[18];
        for (int idx = F.bid * NTHR + F.tid; idx < 1536 * 128; idx += F.G * NTHR) { const int n = idx >> 7, k = idx & 127; float v = 0.f;
            if (n < 512) { if (k < 64) v = w2[k * 512 + n]; } else if (n < 1024) { if (k >= 64) v = a2[(k - 64) * 512 + (n - 512)]; } else { v = g2[k * 512 + (n - 1024)]; }
            wl[idx] = f2bf(v); }
        bf16_t* wrt = (bf16_t*)(ws + WS_WR); const float* rw = F.in[27];
        for (int idx = F.bid * NTHR + F.tid; idx < 256 * 1024; idx += F.G * NTHR) { const int n = idx >> 10, k = idx & 1023; wrt[idx] = f2bf(n < 32 ? rw[k * 32 + n] * F.in[26][k] : 0.f); }
        float* bg = (float*)(ws + WS_BGLU); const float* bsrc = F.in[12]; CmGlu cm;
        for (int idx = F.bid * NTHR + F.tid; idx < 2048; idx += F.G * NTHR) bg[idx] = bsrc[cm(idx)];
    }
    if (F.bid & 1) rmsnorm_rows(F, F.in[0], F.in[1], (bf16_t*)(ws + WS_XN), 0, T);
    {
        LAS float* L = (LAS float*)F.lds;
        LAS float* pwr = L, *pwi = L + 64, *p1r = L + 128, *p1i = L + 192, *ffr = L + 256, *ffi = L + 320;
        LAS float* bbr = L + 384, *bbi = bbr + 1024, *ccr = bbi + 1024, *cci = ccr + 1024, *kj = cci + 1024;
        const float* lam_re = F.in[3]; const float* lam_im = F.in[4]; const float* log_dt = F.in[5];
        const float* b_re = F.in[6]; const float* b_im = F.in[7]; const float* c_re = F.in[8]; const float* c_im = F.in[9]; const float* dsk = F.in[10];
        unsigned* toep = (unsigned*)(ws + WS_TOEP); unsigned* wst = (unsigned*)(ws + WS_WST);
        for (int it = F.bid; it < 32 * S5L; it += F.G) {
            const int g = it / S5L, j = it % S5L;
            if (F.tid < 64) { const int p = F.tid; const float lr = lam_re[g * 64 + p], li = lam_im[g * 64 + p], dt = __expf(log_dt[g]);
                float sn, cs; { const float mg = expf((float)j * lr * dt); sincosf((float)j * (li * dt), &sn, &cs); pwr[p] = mg * cs; pwi[p] = mg * sn; }
                { const float mg = expf((float)(j + 1) * lr * dt); sincosf((float)(j + 1) * (li * dt), &sn, &cs); p1r[p] = mg * cs; p1i[p] = mg * sn; }
                { const float mg = expf(lr * dt); sincosf(li * dt, &sn, &cs); const float nr = mg * cs - 1.0f, ni = mg * sn, den = lr * lr + li * li;
                  ffr[p] = (nr * lr + ni * li) / den; ffi[p] = (ni * lr - nr * li) / den; } }
            __syncthreads();
            for (int idx = F.tid; idx < 1024; idx += NTHR) { const int p = idx >> 4; const float br = b_re[g * 1024 + idx], bi = b_im[g * 1024 + idx];
                bbr[idx] = ffr[p] * br - ffi[p] * bi; bbi[idx] = ffr[p] * bi + ffi[p] * br;
                ccr[idx] = c_re[g * 1024 + idx]; cci[idx] = c_im[g * 1024 + idx]; }
            __syncthreads();
            if (F.tid < 256) { const int co = F.tid >> 4, ci = F.tid & 15; float s = 0.f;
                for (int p = 0; p < 64; ++p) { const float zr = pwr[p] * bbr[p * 16 + ci] - pwi[p] * bbi[p * 16 + ci], zi = pwr[p] * bbi[p * 16 + ci] + pwi[p] * bbr[p * 16 + ci];
                    s += ccr[co * 64 + p] * zr - cci[co * 64 + p] * zi; }
                if (j == 0 && co == ci) s += dsk[g * 16 + co];
                kj[F.tid] = s; }
            __syncthreads();
            for (int idx = F.tid; idx < (S5L - j) * 128; idx += NTHR) { const int t = j + idx / 128, rem = idx % 128, co = rem >> 3, ci = (rem & 7) * 2;
                toep[((size_t)(g * 512 + t * 16 + co) * LDU + (t - j) * 16 + ci) / 2] = cvt_pk_bf16(kj[co * 16 + ci], kj[co * 16 + ci + 1]);
                if (j > 0) toep[((size_t)(g * 512 + (t - j) * 16 + co) * LDU + t * 16 + ci) / 2] = 0u; }
            for (int idx = F.tid; idx < 16 * 64; idx += NTHR) { const int co = idx >> 6, q = (idx & 63) * 2; float o[2];
#pragma unroll
                for (int e = 0; e < 2; ++e) { const int qq = q + e, p = qq & 63; const float cr = ccr[co * 64 + p], cim = cci[co * 64 + p];
                    o[e] = (qq < 64) ? (cr * p1r[p] - cim * p1i[p]) : -(cr * p1i[p] + cim * p1r[p]); }
                toep[((size_t)(g * 512 + j * 16 + co) * LDU + 512 + q) / 2] = cvt_pk_bf16(o[0], o[1]); }
            { const int s = S5L - 1 - j;
              for (int idx = F.tid; idx < 256 * 8; idx += NTHR) { const int q = idx >> 3, ci = (idx & 7) * 2; float o[2] = {0.f, 0.f};
                if (q < 128) { const int p = q & 63;
#pragma unroll
                    for (int e = 0; e < 2; ++e) { const float br = bbr[p * 16 + ci + e], bi = bbi[p * 16 + ci + e];
                        o[e] = (q < 64) ? (pwr[p] * br - pwi[p] * bi) : (pwr[p] * bi + pwi[p] * br); } }
                wst[((size_t)(g * 256 + q) * 512 + s * 16 + ci) / 2] = cvt_pk_bf16(o[0], o[1]); } }
            __syncthreads();
        }
    }
    if (!(F.bid & 1)) rmsnorm_rows(F, F.in[0], F.in[1], (bf16_t*)(ws + WS_XN), 0, T);
}

DI void p_rw_prep(const Frame& F) {
    const bf16_t* prw = (const bf16_t*)(F.ws + WS_PRW); bf16_t* al_ = (bf16_t*)(F.ws + WS_ALORA); const float* mu = F.in[13];
    for (int idx = F.bid * NTHR + F.tid; idx < T * 32; idx += F.G * NTHR) {
        const int t = idx >> 5, c8 = (idx & 31) * 8;
        const u32x4 cur = *(const u32x4*)(prw + (size_t)t * RWC + 1536 + c8);
        u32x4 prv = (u32x4){0u, 0u, 0u, 0u};
        if ((t & (SEQ - 1)) != 0) prv = *(const u32x4*)(prw + (size_t)(t - 1) * RWC + 1536 + c8);
        float o[8];
#pragma unroll
        for (int j = 0; j < 8; ++j) { const float c = (j & 1) ? bf_hi(cur[j >> 1]) : bf_lo(cur[j >> 1]), p = (j & 1) ? bf_hi(prv[j >> 1]) : bf_lo(prv[j >> 1]);
            const float xs = c + mu[1536 + c8 + j] * (p - c);
            o[j] = (c8 < 64) ? ftanh(xs) : ((c8 < 128) ? xs : fsigmoid(xs)); }
        u32x4 w; w.x = cvt_pk_bf16(o[0], o[1]); w.y = cvt_pk_bf16(o[2], o[3]); w.z = cvt_pk_bf16(o[4], o[5]); w.w = cvt_pk_bf16(o[6], o[7]);
        *(u32x4*)(al_ + (size_t)t * 256 + c8) = w;
    }
}

DI void p_s5_carry(const Frame& F) {
    const float* lam_re = F.in[3]; const float* lam_im = F.in[4]; const float* log_dt = F.in[5];
    const float* sloc = (const float*)(F.ws + WS_SLOC); bf16_t* us5 = (bf16_t*)(F.ws + WS_US5);
    for (int gt = F.bid * NTHR + F.tid; gt < NB * 32 * 64; gt += F.G * NTHR) {
        const int p = gt & 63, g = (gt >> 6) & 31, b = gt >> 11;
        const float lr = lam_re[g * 64 + p], li = lam_im[g * 64 + p], dt = __expf(log_dt[g]);
        float sn, cs; const float mg = expf((float)S5L * lr * dt); sincosf((float)S5L * (li * dt), &sn, &cs);
        const float ar = mg * cs, ai = mg * sn;
        float xr = 0.f, xi = 0.f;
        const size_t row0 = (size_t)g * S5ROWS + (size_t)b * S5NC;
        for (int cb = 0; cb < S5NC; cb += 16) {
            float sr[16], si[16];
#pragma unroll
            for (int j = 0; j < 16; ++j) { sr[j] = sloc[(row0 + cb + j) * 128 + p]; si[j] = sloc[(row0 + cb + j) * 128 + 64 + p]; }
#pragma unroll
            for (int j = 0; j < 16; ++j) { const size_t row = row0 + cb + j;
                us5[row * LDU + 512 + p] = f2bf(xr); us5[row * LDU + 576 + p] = f2bf(xi);
                const float nr = ar * xr - ai * xi + sr[j], ni = ar * xi + ai * xr + si[j];
                xr = nr; xi = ni; }
        }
    }
}

constexpr int PT = 72, SLOTB = 64 * PT * 2;
DI LAS bf16_t* rslot(LAS unsigned char* lds, int i) { return (LAS bf16_t*)(lds + i * SLOTB); }
DI void mm_acc(f32x4 (&acc)[2], const LAS bf16_t* A, const LAS bf16_t* Bt, int ti, int tj0, int r, int q) {
#pragma unroll
    for (int s2 = 0; s2 < 2; ++s2) {
        const bf16x8 a = *(const LAS bf16x8*)(A + (16 * ti + r) * PT + 32 * s2 + 8 * q);
#pragma unroll
        for (int e = 0; e < 2; ++e) { const bf16x8 b = *(const LAS bf16x8*)(Bt + (16 * (tj0 + e) + r) * PT + 32 * s2 + 8 * q);
            acc[e] = __builtin_amdgcn_mfma_f32_16x16x32_bf16(a, b, acc[e], 0, 0, 0); }
    }
}
DI void mm_acc_bnat(f32x4 (&acc)[2], const LAS bf16_t* A, const LAS bf16_t* Bn, int ti, int tj0, int r, int q) {
#pragma unroll
    for (int s2 = 0; s2 < 2; ++s2) {
        const bf16x8 a = *(const LAS bf16x8*)(A + (16 * ti + r) * PT + 32 * s2 + 8 * q);
#pragma unroll
        for (int e = 0; e < 2; ++e) { bf16x8 b;
#pragma unroll
            for (int jj = 0; jj < 8; ++jj) b[jj] = (short)Bn[(32 * s2 + 8 * q + jj) * PT + 16 * (tj0 + e) + r];
            acc[e] = __builtin_amdgcn_mfma_f32_16x16x32_bf16(a, b, acc[e], 0, 0, 0); }
    }
}
DI void st_rm(LAS bf16_t* Dm, const f32x4& v, int i0, int j) {
#pragma unroll
    for (int g = 0; g < 4; ++g) Dm[(i0 + g) * PT + j] = f2bf(v[g]);
}
DI void st_tr(LAS bf16_t* Dm, const f32x4& v, int i0, int j) { u32x2 w; w.x = cvt_pk_bf16(v[0], v[1]); w.y = cvt_pk_bf16(v[2], v[3]); *(LAS u32x2*)(Dm + j * PT + i0) = w; }
DI f32x4 ld_rm(const LAS bf16_t* Sm, int i0, int j) { f32x4 v;
#pragma unroll
    for (int g = 0; g < 4; ++g) v[g] = bf2f(Sm[(i0 + g) * PT + j]);
    return v; }
DI void ld_frag(bf16x8 (&f)[2], const LAS bf16_t* M, int row, int q) { f[0] = *(const LAS bf16x8*)(M + row * PT + 8 * q); f[1] = *(const LAS bf16x8*)(M + row * PT + 32 + 8 * q); }
DI f32x4 mm2(const bf16x8 (&x)[2], const bf16x8 (&y)[2], f32x4 c) { c = __builtin_amdgcn_mfma_f32_16x16x32_bf16(x[0], y[0], c, 0, 0, 0); return __builtin_amdgcn_mfma_f32_16x16x32_bf16(x[1], y[1], c, 0, 0, 0); }
typedef short v4i16_t __attribute__((ext_vector_type(4)));
DI void ld_frag_tr(bf16x8 (&f)[2], const LAS bf16_t* XT, int T0, int r, int q) {
#pragma unroll
    for (int s2 = 0; s2 < 2; ++s2) { const LAS bf16_t* p = XT + (32 * s2 + 8 * q + (r >> 2)) * PT + T0 + 4 * (r & 3);
        const v4i16_t lo = __builtin_amdgcn_ds_read_tr16_b64_v4i16((LAS v4i16_t*)p), hi = __builtin_amdgcn_ds_read_tr16_b64_v4i16((LAS v4i16_t*)(p + 4 * PT));
        f[s2] = __builtin_shufflevector(lo, hi, 0, 1, 2, 3, 4, 5, 6, 7); }
}
DI void st_sw(LAS bf16_t* Dm, const f32x4& v, int i, int j0) { u32x2 w; w.x = cvt_pk_bf16(v[0], v[1]); w.y = cvt_pk_bf16(v[2], v[3]); *(LAS u32x2*)(Dm + i * PT + j0) = w; }
DI f32x4 ld_sw(const LAS bf16_t* Sm, int i, int j0) { const u32x2 w = *(const LAS u32x2*)(Sm + i * PT + j0); return (f32x4){bf_lo(w.x), bf_hi(w.x), bf_lo(w.y), bf_hi(w.y)}; }
#define ZACC(a) do { a[0] = (f32x4){0.f, 0.f, 0.f, 0.f}; a[1] = (f32x4){0.f, 0.f, 0.f, 0.f}; } while (0)

DI float wave_sum2(float v) { return xrow_sum(row_sum16(v)); }
#define LSYNC() do { asm volatile("s_waitcnt lgkmcnt(0)" ::: "memory"); __builtin_amdgcn_s_barrier(); asm volatile("" ::: "memory"); } while (0)

struct RaRaw { bf16_t r[9], k[9], v[9], lw[8], a[8]; };
DI void ra_load(RaRaw& x, const bf16_t* prw, const bf16_t* lwag, int ci, int w, int lane) {
    const int bh = ci >> 6, c = ci & 63, b = bh >> 3, h = bh & 7, ch = h * 64 + lane;
    const size_t tok0 = (size_t)b * SEQ + c * 64 + 8 * w;
    const bool has_prev = !(c == 0 && w == 0);
    const size_t tp = has_prev ? tok0 - 1 : tok0;
    x.r[0] = prw[tp * RWC + ch]; x.k[0] = prw[tp * RWC + 512 + ch]; x.v[0] = prw[tp * RWC + 1024 + ch];
#pragma unroll
    for (int i = 0; i < 8; ++i) { const size_t tok = tok0 + i;
        x.r[i + 1] = prw[tok * RWC + ch]; x.k[i + 1] = prw[tok * RWC + 512 + ch]; x.v[i + 1] = prw[tok * RWC + 1024 + ch];
        x.lw[i] = lwag[tok * 1536 + ch]; x.a[i] = lwag[tok * 1536 + 512 + ch]; }
}
DI void p_rw_chunk(const Frame& F) {
    const bf16_t* prw = (const bf16_t*)(F.ws + WS_PRW); const bf16_t* lwag = (const bf16_t*)(F.ws + WS_LWAG);
    const float* mu = F.in[13]; const float* k_k = F.in[19]; const float* k_a = F.in[20]; const float* r_k = F.in[21];
    float* bonus = (float*)(F.ws + WS_BONUS);
    bf16_t* gM = (bf16_t*)(F.ws + WS_CHK_M); bf16_t* gN0T = (bf16_t*)(F.ws + WS_CHK_N0T); bf16_t* gQ = (bf16_t*)(F.ws + WS_CHK_Q); bf16_t* gY0 = (bf16_t*)(F.ws + WS_CHK_Y0T);
    LAS unsigned char* lds = F.lds;
    LAS float* segtot = (LAS float*)(lds + 14 * SLOTB);
    LAS float* PLs = segtot + 512;
    LAS float* DB = PLs + 64;
    constexpr int PD = 20;
    constexpr int TP = 24;
    LAS bf16_t* TDT = (LAS bf16_t*)(DB + 64 * PD);
    const int w = F.wave, lane = F.lane, r = lane & 15, q = lane >> 4, ti = w >> 1, tj0 = 2 * (w & 1), i0 = 16 * ti + 4 * q;
    LAS bf16_t* S0 = rslot(lds, 0); LAS bf16_t* S1 = rslot(lds, 1); LAS bf16_t* S2 = rslot(lds, 2); LAS bf16_t* S3 = rslot(lds, 3);
    LAS bf16_t* S4 = rslot(lds, 4); LAS bf16_t* S5 = rslot(lds, 5); LAS bf16_t* S6 = rslot(lds, 6); LAS bf16_t* S7 = rslot(lds, 7);
    LAS bf16_t* S8 = rslot(lds, 8); LAS bf16_t* S9 = rslot(lds, 9); LAS bf16_t* S10 = rslot(lds, 10); LAS bf16_t* S11 = rslot(lds, 11);
    LAS bf16_t* S12 = rslot(lds, 12); LAS bf16_t* S13 = rslot(lds, 13);
    RaRaw raw;
    if (F.bid < RW_NCH) ra_load(raw, prw, lwag, F.bid, w, lane);
    for (int ci = F.bid; ci < RW_NCH; ci += F.G) {
        const int bh = ci >> 6, c = ci & 63, b = bh >> 3, h = bh & 7, ch = h * 64 + lane;
        {
            const size_t tok0 = (size_t)b * SEQ + c * 64 + 8 * w;
            const float mur = mu[ch], muk = mu[512 + ch], muv = mu[1024 + ch], kkw = k_k[ch], ka = k_a[ch], rk = r_k[ch];
            const bool has_prev = !(c == 0 && w == 0);
            float xr[9], xk[9], xv[9];
            xr[0] = has_prev ? bf2f(raw.r[0]) : 0.f; xk[0] = has_prev ? bf2f(raw.k[0]) : 0.f; xv[0] = has_prev ? bf2f(raw.v[0]) : 0.f;
#pragma unroll
            for (int i = 1; i < 9; ++i) { xr[i] = bf2f(raw.r[i]); xk[i] = bf2f(raw.k[i]); xv[i] = bf2f(raw.v[i]); }
            f32x2 rr2[4], vv2[4], aa2[4], km2[4], kn2[4], sq2[4], bq2[4]; float cl[8];
            float run = 0.f;
#pragma unroll
            for (int p2 = 0; p2 < 4; ++p2) {
                const f32x2 cr = {xr[2 * p2 + 1], xr[2 * p2 + 2]}, pr = {xr[2 * p2], xr[2 * p2 + 1]};
                const f32x2 ck = {xk[2 * p2 + 1], xk[2 * p2 + 2]}, pk = {xk[2 * p2], xk[2 * p2 + 1]};
                const f32x2 cv = {xv[2 * p2 + 1], xv[2 * p2 + 2]}, pv = {xv[2 * p2], xv[2 * p2 + 1]};
                const f32x2 r_ = cr + (pr - cr) * mur, k_ = ck + (pk - ck) * muk, v_ = cv + (pv - cv) * muv;
                const f32x2 a_ = {bf2f(raw.a[2 * p2]), bf2f(raw.a[2 * p2 + 1])};
                const f32x2 kx = k_ * kkw; sq2[p2] = kx * kx;
                const f32x2 kmod = k_ * (a_ * ka + (1.0f - ka));
                bq2[p2] = (r_ * kmod) * rk;
                rr2[p2] = r_; vv2[p2] = v_; aa2[p2] = a_; km2[p2] = kmod; kn2[p2] = kx;
                run += bf2f(raw.lw[2 * p2]); cl[2 * p2] = run; run += bf2f(raw.lw[2 * p2 + 1]); cl[2 * p2 + 1] = run;
            }
            {
                float A8[8], B4[4], C2[2];
#pragma unroll
                for (int k = 0; k < 4; ++k) { A8[k] = comb32(sq2[k].x, sq2[k].y); A8[4 + k] = comb32(bq2[k].x, bq2[k].y); }
#pragma unroll
                for (int j = 0; j < 4; ++j) B4[j] = comb16(A8[2 * j], A8[2 * j + 1]);
#pragma unroll
                for (int i = 0; i < 2; ++i) { const float t1 = DPP_ADD(B4[2 * i], 0x128), t2 = DPP_ADD(B4[2 * i + 1], 0x128); C2[i] = (lane & 8) ? t2 : t1; }
                const float u1 = DPP_ADD(C2[0], 0x141), u2 = DPP_ADD(C2[1], 0x141);
                float dsum = (lane & 4) ? u2 : u1;
                dsum = DPP_ADD(dsum, 0xB1); dsum = DPP_ADD(dsum, 0x4E);
                if ((lane & 7) == 4) bonus[(tok0 + 4 * ((lane >> 3) & 1) + 2 * ((lane >> 4) & 1) + (lane >> 5)) * 8 + h] = dsum;
                const float rsv = fminf(__builtin_amdgcn_rsqf(dsum), 1e12f);
                const int rsi = __builtin_bit_cast(int, rsv);
                float rs[8];
#pragma unroll
                for (int tt = 0; tt < 8; ++tt) rs[tt] = __builtin_bit_cast(float, __builtin_amdgcn_readlane(rsi, 8 * (tt >> 2) + 16 * ((tt >> 1) & 1) + 32 * (tt & 1)));
#pragma unroll
                for (int p2 = 0; p2 < 4; ++p2) kn2[p2] = kn2[p2] * (f32x2){rs[2 * p2], rs[2 * p2 + 1]};
            }
            segtot[w * 64 + lane] = run;
            LSYNC();
            float pre = 0.f;
            for (int w2 = 0; w2 < w; ++w2) pre += segtot[w2 * 64 + lane];
            if (w == 7) PLs[lane] = __expf(pre + run);
            float ep = __expf(pre);
            unsigned xa[4], xb[4], xkk[4], xrr[4], xvv[4];
#pragma unroll
            for (int p2 = 0; p2 < 4; ++p2) {
                const f32x2 tt = ((f32x2){cl[2 * p2], cl[2 * p2 + 1]} + pre) * 1.44269504f;
                const f32x2 e = {__builtin_amdgcn_exp2f(tt.x), __builtin_amdgcn_exp2f(tt.y)}, en = {__builtin_amdgcn_rcpf(e.x), __builtin_amdgcn_rcpf(e.y)}, epv = {ep, e.x};
                ep = e.y;
                const f32x2 at = -(kn2[p2] * epv), bt = (kn2[p2] * aa2[p2]) * en, kt = km2[p2] * en, rt = rr2[p2] * e;
                xa[p2] = cvt_pk_bf16(at.x, at.y); xb[p2] = cvt_pk_bf16(bt.x, bt.y); xkk[p2] = cvt_pk_bf16(kt.x, kt.y); xrr[p2] = cvt_pk_bf16(rt.x, rt.y); xvv[p2] = cvt_pk_bf16(vv2[p2].x, vv2[p2].y);
                const int t = 8 * w + 2 * p2;
                S6[t * PT + lane] = (bf16_t)(xrr[p2] & 0xffffu); S6[(t + 1) * PT + lane] = (bf16_t)(xrr[p2] >> 16);
            }
            *(LAS u32x4*)(S1 + lane * PT + 8 * w) = (u32x4){xa[0], xa[1], xa[2], xa[3]};
            *(LAS u32x4*)(S3 + lane * PT + 8 * w) = (u32x4){xb[0], xb[1], xb[2], xb[3]};
            *(LAS u32x4*)(S5 + lane * PT + 8 * w) = (u32x4){xkk[0], xkk[1], xkk[2], xkk[3]};
            *(LAS u32x4*)(S7 + lane * PT + 8 * w) = (u32x4){xvv[0], xvv[1], xvv[2], xvv[3]};
        }
        LSYNC();
        if (ci + F.G < RW_NCH) ra_load(raw, prw, lwag, ci + F.G, w, lane);
        f32x4 acc[2];
        const f32x4 Z4 = (f32x4){0.f, 0.f, 0.f, 0.f};
        const int ia = 16 * ti + r, jb0 = 16 * tj0 + r;
        { bf16x8 a0[2], a6[2], b2[2][2], b4[2][2];
          ld_frag_tr(a0, S1, 16 * ti, r, q); ld_frag(a6, S6, ia, q);
#pragma unroll
          for (int e = 0; e < 2; ++e) { ld_frag_tr(b2[e], S3, 16 * (tj0 + e), r, q); ld_frag_tr(b4[e], S5, 16 * (tj0 + e), r, q); }
#pragma unroll
          for (int e = 0; e < 2; ++e) { const int tj = tj0 + e, j = 16 * tj + r, js = 16 * tj + 4 * q;
            const f32x4 c = mm2(a0, b2[e], Z4);
            if (tj == ti) {
#pragma unroll
                for (int g = 0; g < 4; ++g) DB[(ti * 16 + 4 * q + g) * PD + r] = (4 * q + g > r) ? c[g] : 0.f;
            }
            st_tr(S8, (ti > tj) ? c : Z4, i0, j);
            f32x4 v = mm2(b4[e], a0, Z4);
#pragma unroll
            for (int g = 0; g < 4; ++g) v[g] = (ia > js + g) ? v[g] : 0.f;
            st_sw(S9, v, ia, js);
            v = mm2(b2[e], a6, Z4);
#pragma unroll
            for (int g = 0; g < 4; ++g) v[g] = (ia >= js + g) ? v[g] : 0.f;
            st_sw(S10, v, ia, js);
            v = mm2(b4[e], a6, Z4);
#pragma unroll
            for (int g = 0; g < 4; ++g) v[g] = (ia >= js + g) ? v[g] : 0.f;
            st_sw(S11, v, ia, js); } }
        LSYNC();
        ZACC(acc); mm_acc(acc, S9, S7, ti, tj0, r, q);
#pragma unroll
        for (int e = 0; e < 2; ++e) st_tr(S2, acc[e], i0, 16 * (tj0 + e) + r);
        if (w < 4) {
            const int i = lane >> 2, p = lane & 3;
            int io = i; asm volatile("" : "+v"(io));
            const LAS float* Dp = DB + (w * 16 + p) * PD;
            f32x4 Dm[4][4];
#pragma unroll
            for (int m = 0; m < 4; ++m)
#pragma unroll
                for (int c4 = 0; c4 < 4; ++c4) Dm[m][c4] = *(const LAS f32x4*)(Dp + 4 * m * PD + 4 * c4);
            float mine[4] = {0.f, 0.f, 0.f, 0.f}, tr[16];
#pragma unroll
            for (int j = 15; j >= 0; --j) { float part = 0.f;
#pragma unroll
                for (int m = 3; m >= 0; --m) if (4 * m + 3 > j) part = __builtin_fmaf(mine[m], Dm[m][j >> 2][j & 3], part);
                float tot = part + __builtin_bit_cast(float, __builtin_amdgcn_update_dpp(0, __builtin_bit_cast(int, part), 0xB1, 0xf, 0xf, false));
                tot = tot + __builtin_bit_cast(float, __builtin_amdgcn_update_dpp(0, __builtin_bit_cast(int, tot), 0x4E, 0xf, 0xf, false));
                const float trj = (j == io) ? 1.0f : tot;
                tr[j] = trj; mine[j >> 2] = (p == (j & 3)) ? trj : mine[j >> 2]; }
            u32x4 z = (u32x4){0u, 0u, 0u, 0u}, x0, x1;
            x0.x = cvt_pk_bf16(tr[0], tr[1]); x0.y = cvt_pk_bf16(tr[2], tr[3]); x0.z = cvt_pk_bf16(tr[4], tr[5]); x0.w = cvt_pk_bf16(tr[6], tr[7]);
            x1.x = cvt_pk_bf16(tr[8], tr[9]); x1.y = cvt_pk_bf16(tr[10], tr[11]); x1.z = cvt_pk_bf16(tr[12], tr[13]); x1.w = cvt_pk_bf16(tr[14], tr[15]);
            LAS bf16_t* dst = S0 + (16 * w + i) * PT + 16 * p;
            *(LAS u32x4*)dst = (p == w) ? x0 : z; *(LAS u32x4*)(dst + 8) = (p == w) ? x1 : z;
#pragma unroll
            for (int m = 0; m < 4; ++m) TDT[(16 * w + 4 * m + p) * TP + i] = f2bf(mine[m]);
        }
        LSYNC();
        { bf16x8 a[2], b[2][2]; ld_frag(a, S0, ia, q);
#pragma unroll
          for (int e = 0; e < 2; ++e) ld_frag(b[e], S8, jb0 + 16 * e, q);
#pragma unroll
          for (int e = 0; e < 2; ++e) { st_tr(S12, mm2(a, b[e], Z4), i0, 16 * (tj0 + e) + r); st_sw(S4, mm2(b[e], a, Z4), ia, 16 * (tj0 + e) + 4 * q); } }
        LSYNC();
        { bf16x8 a[2], b[2][2]; ld_frag(a, S4, ia, q);
#pragma unroll
          for (int e = 0; e < 2; ++e) ld_frag(b[e], S12, jb0 + 16 * e, q);
          const bf16x8 as = (w & 1) ? a[1] : a[0];
#pragma unroll
          for (int e = 0; e < 2; ++e) { const int tj = tj0 + e, j = 16 * tj + r, js = 16 * tj + 4 * q;
            st_sw(S13, mm2(b[e], a, Z4), ia, js);
            bf16x8 bt = *(const LAS bf16x8*)(TDT + j * TP + 8 * (q & 1));
            if ((q >> 1) != e) bt = (bf16x8){0, 0, 0, 0, 0, 0, 0, 0};
            f32x4 c = Z4;
            if (ti == tj) { const u32x2 wv = *(const LAS u32x2*)(TDT + j * TP + 4 * q); c = (f32x4){bf_lo(wv.x), bf_hi(wv.x), bf_lo(wv.y), bf_hi(wv.y)}; }
            st_tr(S9, __builtin_amdgcn_mfma_f32_16x16x32_bf16(as, bt, c, 0, 0, 0), i0, j);
            st_sw(S8, __builtin_amdgcn_mfma_f32_16x16x32_bf16(bt, as, ld_sw(S0, ia, js), 0, 0, 0), ia, js); } }
        LSYNC();
        { bf16x8 a[2], b[2][2]; ld_frag(a, S13, ia, q);
#pragma unroll
          for (int e = 0; e < 2; ++e) ld_frag(b[e], S9, jb0 + 16 * e, q);
#pragma unroll
          for (int e = 0; e < 2; ++e) { const int js = 16 * (tj0 + e) + 4 * q; st_sw(S12, mm2(b[e], a, ld_sw(S8, ia, js)), ia, js); } }
        LSYNC();
        { bf16x8 a[2], b1[2][2], bx[2][2]; ld_frag(a, S12, ia, q);
#pragma unroll
          for (int e = 0; e < 2; ++e) { ld_frag(b1[e], S1, jb0 + 16 * e, q); ld_frag(bx[e], S2, jb0 + 16 * e, q); }
#pragma unroll
          for (int e = 0; e < 2; ++e) { const int j = 16 * (tj0 + e) + r; st_tr(S0, mm2(a, b1[e], Z4), i0, j); st_tr(S4, mm2(a, bx[e], Z4), i0, j); } }
        LSYNC();
        { bf16x8 a10[2], a11[2], a3[2], a5[2], b0[2][2], b4[2][2], b7[2][2];
          ld_frag(a10, S10, ia, q); ld_frag(a11, S11, ia, q); ld_frag(a3, S3, ia, q); ld_frag(a5, S5, ia, q);
#pragma unroll
          for (int e = 0; e < 2; ++e) { ld_frag(b0[e], S0, jb0 + 16 * e, q); ld_frag(b4[e], S4, jb0 + 16 * e, q); ld_frag(b7[e], S7, jb0 + 16 * e, q); }
          const float pli = PLs[ia];
          f32x4 plg;
#pragma unroll
          for (int g = 0; g < 4; ++g) plg[g] = PLs[i0 + g];
#pragma unroll
          for (int e = 0; e < 2; ++e) { const int j = 16 * (tj0 + e) + r, js = 16 * (tj0 + e) + 4 * q;
            const f32x4 vq = mm2(b0[e], a10, ld_sw(S6, ia, js));
            const f32x4 vy = mm2(b7[e], a11, mm2(b4[e], a10, Z4));
            f32x4 vm = mm2(b0[e], a3, Z4);
#pragma unroll
            for (int g = 0; g < 4; ++g) vm[g] = pli * (vm[g] + ((ia == js + g) ? 1.0f : 0.f));
            const f32x4 vn = mm2(a5, b7[e], mm2(a3, b4[e], Z4)) * plg;
            st_sw(S1, vq, ia, js); st_sw(S2, vy, ia, js); st_sw(S8, vm, ia, js); st_tr(S9, vn, i0, j); } }
        LSYNC();
        { const int row = F.tid >> 3, seg = (F.tid & 7) * 8; const size_t go = (size_t)ci * 4096 + row * 64 + seg;
          *(u32x4*)(gQ + go) = *(const LAS u32x4*)(S1 + row * PT + seg); *(u32x4*)(gY0 + go) = *(const LAS u32x4*)(S2 + row * PT + seg);
          *(u32x4*)(gM + go) = *(const LAS u32x4*)(S8 + row * PT + seg); *(u32x4*)(gN0T + go) = *(const LAS u32x4*)(S9 + row * PT + seg); }
        LSYNC();
    }
    asm volatile("s_waitcnt vmcnt(0)" ::: "memory");
}

struct ScanOps { u32x2 m[4][2][2]; u32x2 n0[4]; };
DI void scan_load(ScanOps& o, const bf16_t* gM, const bf16_t* gN0T, size_t ci, int col, int q, int v) {
#pragma unroll
    for (int m = 0; m < 4; ++m) {
#pragma unroll
        for (int s2 = 0; s2 < 2; ++s2) { const bf16_t* p = gM + ci * 4096 + (16 * m + col) * 64 + 32 * s2 + 4 * q; o.m[m][s2][0] = *(const u32x2*)p; o.m[m][s2][1] = *(const u32x2*)(p + 16); }
        o.n0[m] = *(const u32x2*)(gN0T + ci * 4096 + v * 64 + 16 * m + 4 * q); }
}
DI void scan_step(const ScanOps& o, f32x4 (&H)[4], bf16_t* gHT, size_t ci, int q, int v) {
    u32x4 bfr[2];
#pragma unroll
    for (int s2 = 0; s2 < 2; ++s2) { bfr[s2].x = cvt_pk_bf16(H[2 * s2][0], H[2 * s2][1]); bfr[s2].y = cvt_pk_bf16(H[2 * s2][2], H[2 * s2][3]);
        bfr[s2].z = cvt_pk_bf16(H[2 * s2 + 1][0], H[2 * s2 + 1][1]); bfr[s2].w = cvt_pk_bf16(H[2 * s2 + 1][2], H[2 * s2 + 1][3]);
        bf16_t* hp = gHT + ci * 4096 + v * 64 + 32 * s2 + 4 * q;
        *(u32x2*)hp = (u32x2){bfr[s2].x, bfr[s2].y}; *(u32x2*)(hp + 16) = (u32x2){bfr[s2].z, bfr[s2].w}; }
#pragma unroll
    for (int m = 0; m < 4; ++m) {
        f32x4 a2 = (f32x4){bf_lo(o.n0[m].x), bf_hi(o.n0[m].x), bf_lo(o.n0[m].y), bf_hi(o.n0[m].y)};
#pragma unroll
        for (int s2 = 0; s2 < 2; ++s2) { const u32x4 af = (u32x4){o.m[m][s2][0].x, o.m[m][s2][0].y, o.m[m][s2][1].x, o.m[m][s2][1].y};
            a2 = __builtin_amdgcn_mfma_f32_16x16x32_bf16(__builtin_bit_cast(bf16x8, af), __builtin_bit_cast(bf16x8, bfr[s2]), a2, 0, 0, 0); }
        H[m] = a2; }
}
constexpr int SC_DEPTH = 10, SC_SLOT = 12288;
DI void scan_dma(unsigned lds_dst, unsigned voff, const char* base) { asm volatile("s_mov_b32 m0, %0\n\ts_nop 0\n\tglobal_load_lds_dwordx4 %1, %2" :: "s"(lds_dst), "v"(voff), "s"(base) : "memory"); }
DI void scan_lds_load(ScanOps& o, const LAS unsigned char* slot, int lbM, int lbN, const int (&xo)[2][2], int c7) {
#pragma unroll
    for (int m = 0; m < 4; ++m) {
#pragma unroll
        for (int s2 = 0; s2 < 2; ++s2) { o.m[m][s2][0] = *(const LAS u32x2*)(slot + lbM + m * 2048 + xo[s2][0]); o.m[m][s2][1] = *(const LAS u32x2*)(slot + lbM + m * 2048 + xo[s2][1]); }
        o.n0[m] = *(const LAS u32x2*)(slot + 8192 + lbN + (((2 * m) << 4) ^ c7)); }
}
DI void p_rw_scan(const Frame& F) {
    const bf16_t* gM = (const bf16_t*)(F.ws + WS_CHK_M); const bf16_t* gN0T = (const bf16_t*)(F.ws + WS_CHK_N0T); bf16_t* gHT = (bf16_t*)(F.ws + WS_CHK_HT);
    const unsigned ldsbase = (unsigned)(size_t)F.lds;
    const int w = F.wave, col = F.lane & 15, q = F.lane >> 4;
    const int lw = w - 2, lt = F.tid - 128;
    const int P1 = (384 + lt) & 511;
    const unsigned voff0 = (unsigned)((lt >> 3) * 128 + (((lt & 7) ^ ((lt >> 3) & 7)) << 4));
    const unsigned voff1 = (unsigned)((P1 >> 3) * 128 + (((P1 & 7) ^ ((P1 >> 3) & 7)) << 4));
    const int c7 = (col & 7) << 4, qh = (q >> 1) << 4;
    const int lbM = col * 128 + 8 * (q & 1), lbN = (16 * (w & 1) + col) * 128 + 8 * (q & 1);
    int xo[2][2];
#pragma unroll
    for (int s2 = 0; s2 < 2; ++s2)
#pragma unroll
        for (int h = 0; h < 2; ++h) xo[s2][h] = (((4 * s2 + 2 * h) << 4) + qh) ^ c7;
    const int c7n = c7 ^ qh;
    for (int p = F.bid; p < 256; p += F.G) {
        const int bh = p >> 1, half = p & 1, v = 32 * half + 16 * (w & 1) + col;
        const size_t c0 = (size_t)bh * 64;
        const char* baseM = (const char*)(gM + c0 * 4096);
        const char* baseN = (const char*)(gN0T + c0 * 4096 + half * 2048);
        const char* base1 = (lw < 2) ? baseM : baseN;
#define SC_ISSUE(c, slot) do { if (w >= 2) { const unsigned _d = ldsbase + (unsigned)(slot) * SC_SLOT + (unsigned)lw * 1024u; \
            scan_dma(_d, voff0 + (unsigned)(c) * 8192u, baseM); scan_dma(_d + 6144u, voff1 + (unsigned)(c) * 8192u, base1); } } while (0)
#pragma unroll 1
        for (int c = 0; c < SC_DEPTH; ++c) SC_ISSUE(c, c);
        asm volatile("s_waitcnt vmcnt(0)" ::: "memory"); __builtin_amdgcn_s_barrier();
        f32x4 H[4];
#pragma unroll
        for (int m = 0; m < 4; ++m) H[m] = (f32x4){0.f, 0.f, 0.f, 0.f};
        ScanOps A, B;
        if (w < 2) scan_lds_load(A, F.lds, lbM, lbN, xo, c7n);
        int slot = 0;
#define SC_STEP(X, Y, c) do { \
            if (w < 2) asm volatile("s_waitcnt lgkmcnt(0)" ::: "memory"); else asm volatile("s_waitcnt vmcnt(16)" ::: "memory"); \
            __builtin_amdgcn_s_barrier(); \
            const int _sn = (slot + 1 == SC_DEPTH) ? 0 : slot + 1; \
            if (w < 2) scan_lds_load(Y, F.lds + _sn * SC_SLOT, lbM, lbN, xo, c7n); \
            { const int _cn = ((c) + SC_DEPTH < 64) ? (c) + SC_DEPTH : 63; SC_ISSUE(_cn, slot); } \
            if (w < 2) scan_step(X, H, gHT, c0 + (c), q, v); \
            slot = _sn; } while (0)
        static_assert(2 * (SC_DEPTH - 2) == 16, "vmcnt literal in SC_STEP");
#pragma unroll 1
        for (int c = 0; c < 64; c += 2) { SC_STEP(A, B, c); SC_STEP(B, A, c + 1); }
#undef SC_STEP
#undef SC_ISSUE
        asm volatile("s_waitcnt vmcnt(0)" ::: "memory"); __builtin_amdgcn_s_barrier();
    }
}

struct RcIn { bf16x8 qf[2], hb[4][2]; u32x2 y0[4], cv[4], pv[4], gw[4]; float bn; };
DI void rc_load(RcIn& x, const bf16_t* gQ, const bf16_t* gY0, const bf16_t* gHT, const bf16_t* prw, const bf16_t* lwag, const float* bonus, int item, int r, int q) {
    const int ci = item >> 2, ti = item & 3, bh = ci >> 6, c = ci & 63, b = bh >> 3, h = bh & 7;
    const size_t cb = (size_t)ci * 4096; const size_t tok = (size_t)b * SEQ + c * 64 + 16 * ti + r;
    const bool first = (tok & (SEQ - 1)) == 0; const size_t tp = first ? tok : tok - 1;
#pragma unroll
    for (int s2 = 0; s2 < 2; ++s2) x.qf[s2] = *(const bf16x8*)(gQ + cb + (16 * ti + r) * 64 + 32 * s2 + 8 * q);
#pragma unroll
    for (int n = 0; n < 4; ++n) { const int cch = h * 64 + 16 * n + 4 * q;
        x.y0[n] = *(const u32x2*)(gY0 + cb + (16 * ti + r) * 64 + 16 * n + 4 * q);
#pragma unroll
        for (int s2 = 0; s2 < 2; ++s2) x.hb[n][s2] = *(const bf16x8*)(gHT + cb + (16 * n + r) * 64 + 32 * s2 + 8 * q);
        x.cv[n] = *(const u32x2*)(prw + tok * RWC + 1024 + cch); x.pv[n] = *(const u32x2*)(prw + tp * RWC + 1024 + cch);
        x.gw[n] = *(const u32x2*)(lwag + tok * 1536 + 1024 + cch); }
    x.bn = bonus[tok * 8 + h];
}
DI void rc_compute(const RcIn& x, bf16_t* yrw, const float* mu, const float* ln_g, const float* ln_b, int item, int r, int q) {
    const int ci = item >> 2, ti = item & 3, bh = ci >> 6, c = ci & 63, b = bh >> 3, h = bh & 7;
    const size_t tok = (size_t)b * SEQ + c * 64 + 16 * ti + r; const bool first = (tok & (SEQ - 1)) == 0;
    f32x4 y[4];
#pragma unroll
    for (int n = 0; n < 4; ++n) { y[n] = (f32x4){bf_lo(x.y0[n].x), bf_hi(x.y0[n].x), bf_lo(x.y0[n].y), bf_hi(x.y0[n].y)};
#pragma unroll
        for (int s2 = 0; s2 < 2; ++s2) y[n] = __builtin_amdgcn_mfma_f32_16x16x32_bf16(x.hb[n][s2], x.qf[s2], y[n], 0, 0, 0); }
    float s1 = 0.f;
#pragma unroll
    for (int n = 0; n < 4; ++n) s1 += (y[n][0] + y[n][1]) + (y[n][2] + y[n][3]);
    s1 = xrow_sum(s1);
    const float mean = s1 * (1.0f / 64.0f);
    float s2 = 0.f;
#pragma unroll
    for (int n = 0; n < 4; ++n) { y[n] = y[n] - mean; s2 += (y[n][0] * y[n][0] + y[n][1] * y[n][1]) + (y[n][2] * y[n][2] + y[n][3] * y[n][3]); }
    s2 = xrow_sum(s2);
    const float rstd = rsqrtf(s2 * (1.0f / 64.0f) + 64e-5f);
#pragma unroll
    for (int n = 0; n < 4; ++n) { const int cch = h * 64 + 16 * n + 4 * q;
        const f32x4 muv = *(const f32x4*)(mu + 1024 + cch), lg = *(const f32x4*)(ln_g + cch), lb = *(const f32x4*)(ln_b + cch);
        const float cv[4] = {bf_lo(x.cv[n].x), bf_hi(x.cv[n].x), bf_lo(x.cv[n].y), bf_hi(x.cv[n].y)};
        const float pv[4] = {first ? 0.f : bf_lo(x.pv[n].x), first ? 0.f : bf_hi(x.pv[n].x), first ? 0.f : bf_lo(x.pv[n].y), first ? 0.f : bf_hi(x.pv[n].y)};
        const float gg[4] = {bf_lo(x.gw[n].x), bf_hi(x.gw[n].x), bf_lo(x.gw[n].y), bf_hi(x.gw[n].y)};
        float o[4];
#pragma unroll
        for (int g = 0; g < 4; ++g) { const float vsh = cv[g] + muv[g] * (pv[g] - cv[g]); o[g] = (y[n][g] * rstd * lg[g] + lb[g] + x.bn * vsh) * gg[g]; }
        u32x2 ow; ow.x = cvt_pk_bf16(o[0], o[1]); ow.y = cvt_pk_bf16(o[2], o[3]);
        *(u32x2*)(yrw + tok * 512 + cch) = ow; }
}
DI void p_rw_out(const Frame& F) {
    const bf16_t* gQ = (const bf16_t*)(F.ws + WS_CHK_Q); const bf16_t* gY0 = (const bf16_t*)(F.ws + WS_CHK_Y0T); const bf16_t* gHT = (const bf16_t*)(F.ws + WS_CHK_HT);
    const bf16_t* prw = (const bf16_t*)(F.ws + WS_PRW); const bf16_t* lwag = (const bf16_t*)(F.ws + WS_LWAG); const float* bonus = (const float*)(F.ws + WS_BONUS);
    bf16_t* yrw = (bf16_t*)(F.ws + WS_YRW);
    const float* mu = F.in[13]; const float* ln_g = F.in[22]; const float* ln_b = F.in[23];
    const int r = F.lane & 15, q = F.lane >> 4, stride = F.G * NWAVES, NIT = RW_NCH * 4;
    for (int item = F.bid * NWAVES + F.wave; item < NIT; item += 2 * stride) {
        const int item2 = (item + stride < NIT) ? item + stride : item;
        RcIn xa, xb;
        rc_load(xa, gQ, gY0, gHT, prw, lwag, bonus, item, r, q); rc_load(xb, gQ, gY0, gHT, prw, lwag, bonus, item2, r, q);
        rc_compute(xa, yrw, mu, ln_g, ln_b, item, r, q); rc_compute(xb, yrw, mu, ln_g, ln_b, item2, r, q);
    }
}

DI void p_moe_prep(const Frame& F) {
    const bf16_t* hb = (const bf16_t*)(F.ws + WS_HB); float* rsv = (float*)(F.ws + WS_RS); unsigned char* out8 = (unsigned char*)(F.ws + WS_XN2F8); const float* g = F.in[26];
    const int stride = F.G * NWAVES;
    for (int row = F.bid * NWAVES + F.wave; row < T; row += 2 * stride) {
        const int row2 = (row + stride < T) ? row + stride : row;
        u32x4 a[2], b[2];
        a[0] = *(const u32x4*)(hb + (size_t)row * D + F.lane * 16); a[1] = *(const u32x4*)(hb + (size_t)row * D + F.lane * 16 + 8);
        b[0] = *(const u32x4*)(hb + (size_t)row2 * D + F.lane * 16); b[1] = *(const u32x4*)(hb + (size_t)row2 * D + F.lane * 16 + 8);
        float v[16], u[16]; float ss = 0.f, su = 0.f;
#pragma unroll
        for (int j = 0; j < 8; ++j) { v[2 * j] = bf_lo(a[j >> 2][j & 3]); v[2 * j + 1] = bf_hi(a[j >> 2][j & 3]); u[2 * j] = bf_lo(b[j >> 2][j & 3]); u[2 * j + 1] = bf_hi(b[j >> 2][j & 3]); }
#pragma unroll
        for (int j = 0; j < 16; ++j) { ss += v[j] * v[j]; su += u[j] * u[j]; }
        ss = wave_sum(ss); su = wave_sum(su);
        const float rs = rsqrtf(ss * (1.0f / D) + 1e-5f), ru = rsqrtf(su * (1.0f / D) + 1e-5f);
        float gv[16];
#pragma unroll
        for (int q = 0; q < 4; ++q) { const f32x4 t = *(const f32x4*)(g + F.lane * 16 + q * 4); gv[4 * q] = t[0]; gv[4 * q + 1] = t[1]; gv[4 * q + 2] = t[2]; gv[4 * q + 3] = t[3]; }
#pragma unroll
        for (int j = 0; j < 16; ++j) { v[j] *= rs * gv[j]; u[j] *= ru * gv[j]; }
        u32x4 q0, q1;
        if (F.lane == 0) { rsv[row] = rs; rsv[row2] = ru; }
        q0.x = pk4_fp8(v[0] * F8_SX, v[1] * F8_SX, v[2] * F8_SX, v[3] * F8_SX); q0.y = pk4_fp8(v[4] * F8_SX, v[5] * F8_SX, v[6] * F8_SX, v[7] * F8_SX);
        q0.z = pk4_fp8(v[8] * F8_SX, v[9] * F8_SX, v[10] * F8_SX, v[11] * F8_SX); q0.w = pk4_fp8(v[12] * F8_SX, v[13] * F8_SX, v[14] * F8_SX, v[15] * F8_SX);
        q1.x = pk4_fp8(u[0] * F8_SX, u[1] * F8_SX, u[2] * F8_SX, u[3] * F8_SX); q1.y = pk4_fp8(u[4] * F8_SX, u[5] * F8_SX, u[6] * F8_SX, u[7] * F8_SX);
        q1.z = pk4_fp8(u[8] * F8_SX, u[9] * F8_SX, u[10] * F8_SX, u[11] * F8_SX); q1.w = pk4_fp8(u[12] * F8_SX, u[13] * F8_SX, u[14] * F8_SX, u[15] * F8_SX);
        *(u32x4*)(out8 + (size_t)row * D + F.lane * 16) = q0; *(u32x4*)(out8 + (size_t)row2 * D + F.lane * 16) = q1;
    }
    float* b1p = (float*)(F.ws + WS_B1P); const float* b1 = F.in[30]; CmSwi cm;
    for (int idx = F.bid * NTHR + F.tid; idx < 32 * 2048; idx += F.G * NTHR) { const int e = idx >> 11, n = idx & 2047; b1p[idx] = b1[e * 2048 + cm(n)]; }
}
DI void p_conv_part(const Frame& F, int part) {
    if (part == 0) conv_T8(F, F.in[29], (size_t)1024 * 2048, 2048, (unsigned char*)(F.ws + WS_W1), 2048, 1024, 32, MpSwi(), F8_SW, 0, 2048);
    else if (part == 1) conv_T8(F, F.in[29], (size_t)1024 * 2048, 2048, (unsigned char*)(F.ws + WS_W1), 2048, 1024, 32, MpSwi(), F8_SW, 2048, 4096);
    else conv_T8(F, F.in[31], (size_t)1024 * 1024, 1024, (unsigned char*)(F.ws + WS_W2), 1024, 1024, 32, MpId(), F8_SW);
}

DI void topk_rows(const Frame& F, int row0) {
    LAS unsigned* cnt = (LAS unsigned*)F.lds; LAS unsigned* base = cnt + 32;
    const float* logits = (const float*)(F.ws + WS_LOG); unsigned* epos = (unsigned*)(F.ws + WS_EPOS); float* gatev = (float*)(F.ws + WS_GATEV);
    const int pass = row0 / TPP;
    unsigned* gcnt = (unsigned*)(F.ws + WS_CTL) + CW_GCNT + pass * 32;
    if (F.tid < 32) cnt[F.tid] = 0u;
    __syncthreads();
    int e4[4] = {0, 0, 0, 0}; unsigned p4[4] = {0u, 0u, 0u, 0u}; float g4[4] = {0.f, 0.f, 0.f, 0.f};
    const int token = row0 + F.tid;
    if (F.tid < 256) {
        float l[32]; const float rsc = ((const float*)(F.ws + WS_RS))[token];
#pragma unroll
        for (int q = 0; q < 8; ++q) { const f32x4 v = *(const f32x4*)(logits + (size_t)token * 32 + q * 4), bq = *(const f32x4*)(F.in[28] + q * 4); l[q * 4] = v[0] * rsc + bq[0]; l[q * 4 + 1] = v[1] * rsc + bq[1]; l[q * 4 + 2] = v[2] * rsc + bq[2]; l[q * 4 + 3] = v[3] * rsc + bq[3]; }
        unsigned used = 0u; float tv[4];
#pragma unroll
        for (int k = 0; k < 4; ++k) { float best = -3.0e38f; int bi = 0;
#pragma unroll
            for (int e = 0; e < 32; ++e) { const bool ok = !((used >> e) & 1u) && (l[e] > best); best = ok ? l[e] : best; bi = ok ? e : bi; }
            used |= 1u << bi; e4[k] = bi; tv[k] = best; }
        const float m = tv[0]; float ex[4], sum = 0.f;
#pragma unroll
        for (int k = 0; k < 4; ++k) { ex[k] = __expf(tv[k] - m); sum += ex[k]; }
#pragma unroll
        for (int k = 0; k < 4; ++k) { g4[k] = ex[k] / sum; p4[k] = atomicAdd((unsigned*)&cnt[e4[k]], 1u); }
    }
    __syncthreads();
    if (F.tid < 32) base[F.tid] = __hip_atomic_fetch_add(&gcnt[F.tid], cnt[F.tid], __ATOMIC_RELAXED, __HIP_MEMORY_SCOPE_AGENT);
    __syncthreads();
    if (F.tid < 256) {
#pragma unroll
        for (int k = 0; k < 4; ++k) { epos[(size_t)token * 4 + k] = ((unsigned)e4[k] << 24) | (base[e4[k]] + p4[k]); gatev[(size_t)token * 4 + k] = g4[k]; }
    }
    __syncthreads();
}
DI void p_gather(const Frame& F, int pass) {
    LAS int* poff = (LAS int*)F.lds;
    LAS int* pcnt = poff + 40;
    unsigned* gcnt = (unsigned*)(F.ws + WS_CTL) + CW_GCNT + pass * 32;
    int* tile_e = (int*)(F.ws + WS_TILEE) + pass * TE_STRIDE;
    __syncthreads();
    if (F.tid == 0) { int acc = 0; for (int e = 0; e < 32; ++e) { poff[e] = acc; const int c = (int)__hip_atomic_load(&gcnt[e], __ATOMIC_RELAXED, __HIP_MEMORY_SCOPE_AGENT); pcnt[e] = c; acc += ((c + 255) >> 8) << 8; } poff[32] = acc; }
    __syncthreads();
    if (F.bid == 0) {
        const int nt = poff[32] >> 8;
        for (int t = F.tid; t < nt; t += NTHR) { int e = 0; for (int q = 1; q < 32; ++q) if (poff[q] <= t * 256) e = q; tile_e[1 + t] = e; }
        if (F.tid == 0) tile_e[0] = nt;
    }
    const unsigned* epos = (const unsigned*)(F.ws + WS_EPOS); const float* gatev = (const float*)(F.ws + WS_GATEV);
    int* slot = (int*)(F.ws + WS_SLOT); float* rowg = (float*)(F.ws + WS_ROWG) + (size_t)pass * MAXTILES * 256;
    int* rowtok = (int*)(F.ws + WS_ROWTOK) + (size_t)pass * MAXTILES * 256;
    for (int i = F.bid * NTHR + F.tid; i < 32 * 256; i += F.G * NTHR) { const int e = i >> 8, sl = poff[e] + pcnt[e] + (i & 255); if (sl < poff[e + 1]) rowtok[sl] = 0; }
    for (int i = F.bid * NTHR + F.tid; i < TPP * 4; i += F.G * NTHR) {
        const int token = pass * TPP + (i >> 2);
        const unsigned ep = epos[(size_t)pass * TPP * 4 + i]; const int sl = poff[ep >> 24] + (int)(ep & 0xffffffu);
        slot[(size_t)pass * TPP * 4 + i] = sl; rowg[sl] = gatev[(size_t)pass * TPP * 4 + i]; rowtok[sl] = token;
    }
    __syncthreads();
}
DI void p_combine(const Frame& F, int pass) {
    int tz_ = threadIdx.x; asm volatile("" : "+v"(tz_)); const int lane_ = tz_ & 63;
    const int* slot = (const int*)(F.ws + WS_SLOT); const unsigned char* y2 = (const unsigned char*)(F.ws + WS_XS) + (size_t)pass * PASS_BUF; const float* gf = F.in[33];
    for (int t = F.bid * NWAVES + F.wave; t < TPP; t += F.G * NWAVES) {
        const int token = pass * TPP + t;
        float v[16];
        { const bf16_t* hb = (const bf16_t*)(F.ws + WS_HB) + (size_t)token * D + lane_ * 16; const u32x4 h0 = *(const u32x4*)hb, h1 = *(const u32x4*)(hb + 8);
#pragma unroll
          for (int j = 0; j < 4; ++j) { v[2 * j] = bf_lo(h0[j]); v[2 * j + 1] = bf_hi(h0[j]); v[8 + 2 * j] = bf_lo(h1[j]); v[8 + 2 * j + 1] = bf_hi(h1[j]); } }
        u32x4 yw[4];
#pragma unroll
        for (int k = 0; k < 4; ++k) { const int s = slot[(size_t)token * 4 + k]; yw[k] = *(const u32x4*)(y2 + (size_t)s * D + lane_ * 16); }
#pragma unroll
        for (int k = 0; k < 4; ++k)
#pragma unroll
            for (int j = 0; j < 4; ++j) { const f32x2 lo = __builtin_amdgcn_cvt_pk_f32_fp8((int)yw[k][j], false), hi = __builtin_amdgcn_cvt_pk_f32_fp8((int)yw[k][j], true);
                v[4 * j] += lo[0] * (1.0f / F8_SY); v[4 * j + 1] += lo[1] * (1.0f / F8_SY); v[4 * j + 2] += hi[0] * (1.0f / F8_SY); v[4 * j + 3] += hi[1] * (1.0f / F8_SY); }
        float ss = 0.f;
#pragma unroll
        for (int j = 0; j < 16; ++j) ss += v[j] * v[j];
        ss = wave_sum(ss);
        const float rs = rsqrtf(ss * (1.0f / D) + 1e-5f);
        f32x4* orow = (f32x4*)(F.out + (size_t)token * D + lane_ * 16);
#pragma unroll
        for (int q = 0; q < 4; ++q) { const f32x4 gv = *(const f32x4*)(gf + lane_ * 16 + q * 4);
            orow[q] = (f32x4){v[q * 4] * rs * gv[0], v[q * 4 + 1] * rs * gv[1], v[q * 4 + 2] * rs * gv[2], v[q * 4 + 3] * rs * gv[3]}; }
    }
}

constexpr int N_PHASES = 18;
__global__ void __launch_bounds__(NTHR, 2) fwd_kernel(KArgs args) {
    extern __shared__ __attribute__((aligned(16))) unsigned char lds_raw[];
    Frame F; F.lds = (LAS unsigned char*)lds_raw; F.tid = threadIdx.x; F.lane = F.tid & 63; F.wave = __builtin_amdgcn_readfirstlane(F.tid >> 6);
    F.G = gridDim.x; F.bid = blockIdx.x; F.in = args.in; F.out = args.out; F.ws = args.ws;
    unsigned char* ws = args.ws;
    volatile LAS unsigned* MISC = (volatile LAS unsigned*)(F.lds + MISC_OFF);
    if (F.tid < 4) MISC[F.tid] = 0u;
    __syncthreads();
    XcdBarrier bar; bar.bar = (unsigned*)(ws + WS_CTL) + CW_BAR; bar.x = 0; bar.st = MISC;
    if (N_LAUNCH_MODE == 1) bar = xcd_barrier_post((unsigned*)(ws + WS_CTL) + CW_BAR, MISC);
    const int lo = args.ph_lo, hi = args.ph_hi;
#define IN(k) (lo <= (k) && (k) < hi)
#define REP(k) for (int _r = 0; _r < 1 + (int)((PROBE_MASK >> (k)) & 1u); ++_r)
#define SEAM(k) do { if (N_LAUNCH_MODE == 1 && IN(k) && IN((k) + 1)) xcd_barrier(bar); } while (0)
    bf16_t* gates = (bf16_t*)args.out;

    if (IN(0)) { REP(0) p0_prologue(F); SEAM(0); }
    if (IN(1)) {
        PlainSched S; S.init(ws + WS_XN, ws + WS_WIN, T, INC, D, D, D, F.G, F.bid);
        EpiWin E{(bf16_t*)(ws + WS_US5), (bf16_t*)(ws + WS_PRW), gates};
        REP(1) gemm_phase(F.lds, S, E); SEAM(1);
    }
    if (IN(2)) {
        GroupSched S; S.init(ws + WS_US5, ws + WS_WST, 512, LDU, 512, S5ROWS / BM, 1, F.G, F.bid);
        EpiS5State E{(float*)(ws + WS_SLOC)};
        REP(2) { gemm_phase(F.lds, S, E); p_rw_prep(F); } SEAM(2);
    }
    if (IN(3)) {
        REP(3) p_s5_carry(F);
        PlainSched S; S.init(ws + WS_ALORA, ws + WS_WLORA, T, 1536, 128, 256, 128, F.G, F.bid); S.akoff_pn = 4; S.akoff_bytes = 256;
        EpiLora E{(bf16_t*)(ws + WS_LWAG), F.in[14], F.in[16]};
        REP(3) gemm_phase(F.lds, S, E); SEAM(3);
    }
    if (IN(4)) {
        GroupSched S; S.init(ws + WS_US5, ws + WS_TOEP, LDU, LDU, LDU, S5ROWS / BM, 2, F.G, F.bid);
        EpiS5Out E{(bf16_t*)(ws + WS_YS)};
        REP(4) gemm_phase(F.lds, S, E); SEAM(4);
    }
    if (IN(5)) { REP(5) p_rw_chunk(F); SEAM(5); }
    if (IN(6)) { REP(6) p_rw_scan(F); SEAM(6); }
    if (IN(7)) { REP(7) p_rw_out(F); SEAM(7); }
    if (IN(8)) {
        PlainSched S; S.init(ws + WS_YS, ws + WS_WGLU, T, 2048, 512, 512, 512, F.G, F.bid);
        EpiGlu E{(bf16_t*)(ws + WS_XN), gates, (const float*)(ws + WS_BGLU)};
        if (F.bid & 1) p_conv_part(F, 0);
        gemm_phase(F.lds, S, E);
        if (!(F.bid & 1)) p_conv_part(F, 0);
        SEAM(8);
    }
    if (IN(9)) {
        PlainSched S; S.init(ws + WS_YRW, ws + WS_WO, T, 1024, 512, 512, 512, F.G, F.bid);
        EpiWo E{(bf16_t*)(ws + WS_XN), gates};
        if (F.bid & 1) p_conv_part(F, 1);
        gemm_phase(F.lds, S, E);
        if (!(F.bid & 1)) p_conv_part(F, 1);
        SEAM(9);
    }
    if (IN(10)) {
        PlainSched S; S.init(ws + WS_XN, ws + WS_WOUT, T, 1024, 1024, 1024, 1024, F.G, F.bid);
        EpiOut E{(bf16_t*)(ws + WS_HB), F.in[0]};
        if (F.bid & 1) p_conv_part(F, 2);
        gemm_phase(F.lds, S, E);
        if (!(F.bid & 1)) p_conv_part(F, 2);
        SEAM(10);
    }
    if (IN(11)) { REP(11) p_moe_prep(F); SEAM(11); }
    if (IN(12)) {
        PlainSched S; S.init(ws + WS_HB, ws + WS_WR, T, 256, 1024, 1024, 1024, F.G, F.bid);
        EpiRouter E{(float*)(ws + WS_LOG)};
        gemm_phase(F.lds, S, E);
        { Unit u; for (int i = 0; S.next(i, u); ++i) topk_rows(F, u.pm * BM); }
        SEAM(12);
    }
    if (IN(13)) { p_gather(F, 0); p_gather(F, 1); SEAM(13); }
#define MOE_G1(PASS, CIDX) \
            const int* te = (const int*)(ws + WS_TILEE) + (PASS) * TE_STRIDE; const int ntl = __builtin_amdgcn_readfirstlane(__hip_atomic_load(te, __ATOMIC_RELAXED, __HIP_MEMORY_SCOPE_AGENT)); \
            MoeSched<true> S; S.init(ws + WS_XN2F8, ws + WS_W1, te + 1, (const int*)(ws + WS_ROWTOK) + (size_t)(PASS) * MAXTILES * 256, ntl, 512, 8, F.G, (CIDX)); \
            EpiMoe1 E{(unsigned char*)(ws + WS_ACT) + (size_t)(PASS) * PASS_BUF, (const float*)(ws + WS_B1P)};
#define MOE_G2(PASS) \
            const int* te = (const int*)(ws + WS_TILEE) + (PASS) * TE_STRIDE; const int ntl = __builtin_amdgcn_readfirstlane(__hip_atomic_load(te, __ATOMIC_RELAXED, __HIP_MEMORY_SCOPE_AGENT)); \
            MoeSched<false> S; S.init(ws + WS_ACT + (size_t)(PASS) * PASS_BUF, ws + WS_W2, te + 1, nullptr, ntl, 512, 4, F.G, F.bid); \
            EpiMoe2 E{(unsigned char*)(ws + WS_XS) + (size_t)(PASS) * PASS_BUF, F.in[32], (const float*)(ws + WS_ROWG) + (size_t)(PASS) * MAXTILES * 256};
    if (IN(14)) { MOE_G1(0, F.bid) gemm_phase(F.lds, S, E); SEAM(14); }
    if (IN(15)) {
        { MOE_G2(0) gemm_phase(F.lds, S, E); }
        { MOE_G1(1, F.G - 1 - F.bid) gemm_phase(F.lds, S, E); }
        SEAM(15);
    }
    if (IN(16)) {
        if (F.bid & 1) p_combine(F, 0);
        { MOE_G2(1) gemm_phase(F.lds, S, E); }
        if (!(F.bid & 1)) p_combine(F, 0);
        SEAM(16);
    }
    if (IN(17)) { p_combine(F, 1); }
#undef MOE_G1
#undef MOE_G2
#undef IN
#undef SEAM
#undef REP
}

extern "C" void kernel_launch(void* const* d_in, const int* in_sizes, int n_in, void* d_out, int out_size, void* d_ws, size_t ws_size, hipStream_t stream) {
    static int grid = 0;
    if (grid == 0) {
        if (n_in != 34 || in_sizes[0] != T * D || out_size != T * D || ws_size < WS_END) { fprintf(stderr, "kernel_launch: unexpected shapes (n_in %d, in0 %d, out %d, ws %zu < %zu)\n", n_in, n_in > 0 ? in_sizes[0] : -1, out_size, ws_size, (size_t)WS_END); grid = -1; return; }
        int dev = 0, cus = 0, per_cu = 0;
        if (hipGetDevice(&dev) != hipSuccess || hipDeviceGetAttribute(&cus, hipDeviceAttributeMultiprocessorCount, dev) != hipSuccess) { grid = -1; return; }
        if (hipFuncSetAttribute((const void*)fwd_kernel, hipFuncAttributeMaxDynamicSharedMemorySize, LDS_BYTES) != hipSuccess) { fprintf(stderr, "kernel_launch: hipFuncSetAttribute failed\n"); grid = -1; return; }
        if (hipOccupancyMaxActiveBlocksPerMultiprocessor(&per_cu, (const void*)fwd_kernel, NTHR, LDS_BYTES) != hipSuccess || per_cu < 1) { fprintf(stderr, "kernel_launch: occupancy query says %d\n", per_cu); }
        (void)hipGetLastError();
        grid = cus;
    }
    if (grid < 0) return;
    (void)hipMemsetAsync((char*)d_ws + WS_CTL, 0, CTL_BYTES, stream);
    KArgs a{};
    for (int i = 0; i < 34; ++i) a.in[i] = (const float*)d_in[i];
    a.out = (float*)d_out; a.ws = (unsigned char*)d_ws;
    if (N_LAUNCH_MODE == 1) {
        a.ph_lo = 0; a.ph_hi = N_PHASES;
        hipLaunchKernelGGL(fwd_kernel, dim3(grid), dim3(NTHR), LDS_BYTES, stream, a);
    } else {
        for (int p = 0; p < N_PHASES; ++p) { a.ph_lo = p; a.ph_hi = p + 1; hipLaunchKernelGGL(fwd_kernel, dim3(grid), dim3(NTHR), LDS_BYTES, stream, a); }
    }
}
```

```cpp
#include <hip/hip_runtime.h>
#include <stdint.h>
#include <stdio.h>

#ifndef N_LAUNCH_MODE
#define N_LAUNCH_MODE 1
#endif

#ifndef GEMM_SP2
#define GEMM_SP2 1
#endif
#ifndef GEMM_ALIGN
#define GEMM_ALIGN 1
#endif
#ifndef PROBE_MASK
#define PROBE_MASK 0u
#endif
#define LAS __attribute__((address_space(3)))
#define DI __device__ __forceinline__
typedef unsigned short bf16_t;
typedef short bf16x8 __attribute__((ext_vector_type(8)));
typedef float f32x4 __attribute__((ext_vector_type(4)));
typedef float f32x2 __attribute__((ext_vector_type(2)));
typedef unsigned u32x4 __attribute__((ext_vector_type(4)));
typedef unsigned u32x2 __attribute__((ext_vector_type(2)));
typedef int i32x8 __attribute__((ext_vector_type(8)));
typedef int i32x4 __attribute__((ext_vector_type(4)));

constexpr int T = 65536, D = 1024, SEQ = 4096, NB = 16;
constexpr int INC = 4352, RWC = 1792;
constexpr int S5L = 32;
constexpr int S5NC = SEQ / S5L;
constexpr int S5ROWS = T / S5L;
constexpr int LDU = 16 * S5L + 128;
constexpr int NE = 32, TOPK = 4;
constexpr int NPASS = 2, TPP = T / NPASS;
constexpr int MAXTILES = (TPP * TOPK) / 256 + NE;
constexpr int NWAVES = 8, NTHR = 512;

constexpr size_t al(size_t x) { return (x + 4095) & ~(size_t)4095; }
constexpr size_t WS_CTL = 0, CTL_BYTES = 1 << 20;
constexpr size_t WS_WIN = WS_CTL + CTL_BYTES;
constexpr size_t WS_WGLU = WS_WIN + al((size_t)INC * D * 2);
constexpr size_t WS_WO = WS_WGLU + al((size_t)2048 * 512 * 2);
constexpr size_t WS_WOUT = WS_WO + al((size_t)1024 * 512 * 2);
constexpr size_t WS_WLORA = WS_WOUT + al((size_t)1024 * 1024 * 2);
constexpr size_t WS_WR = WS_WLORA + al((size_t)1536 * 256 * 2);
constexpr size_t WS_TOEP = WS_WR + al((size_t)256 * 1024 * 2);
constexpr size_t WS_WST = WS_TOEP + al((size_t)32 * 512 * LDU * 2);
constexpr size_t WS_BGLU = WS_WST + al((size_t)32 * 256 * 512 * 2);
constexpr size_t WS_B1P = WS_BGLU + al(2048 * 4);
constexpr size_t WS_SHARED = WS_B1P + al((size_t)32 * 2048 * 4);
constexpr size_t WS_PRW = WS_SHARED;
constexpr size_t WS_LWAG = WS_PRW + al((size_t)T * RWC * 2);
constexpr size_t WS_YS = WS_LWAG + al((size_t)T * 1536 * 2);
constexpr size_t WS_YRW = WS_YS + al((size_t)T * 512 * 2);
constexpr size_t WS_BONUS = WS_YRW + al((size_t)T * 512 * 2);
constexpr size_t WS_XN = WS_BONUS + al((size_t)T * 8 * 4);
constexpr size_t WS_US5 = WS_XN + al((size_t)T * D * 2);
constexpr size_t WS_ALORA = WS_US5 + al((size_t)32 * S5ROWS * LDU * 2);
constexpr size_t WS_SLOC = WS_ALORA + al((size_t)T * 256 * 2);
constexpr int RW_NCH = 128 * 64;
constexpr size_t CHK_BYTES = (size_t)RW_NCH * 4096 * 2;
constexpr size_t WS_CHK_M = WS_XN, WS_CHK_N0T = WS_CHK_M + CHK_BYTES, WS_CHK_Q = WS_CHK_N0T + CHK_BYTES, WS_CHK_Y0T = WS_CHK_Q + CHK_BYTES, WS_CHK_HT = WS_CHK_Y0T + CHK_BYTES;
constexpr size_t WS_MIX_END0 = WS_SLOC + al((size_t)32 * S5ROWS * 128 * 4);
constexpr size_t WS_MIX_END = (WS_CHK_HT + CHK_BYTES) > WS_MIX_END0 ? (WS_CHK_HT + CHK_BYTES) : WS_MIX_END0;
constexpr size_t WS_HB = WS_SHARED;
constexpr size_t WS_W1 = WS_HB + al((size_t)T * D * 2);
constexpr size_t WS_W2 = WS_W1 + al((size_t)32 * 2048 * 1024);
constexpr size_t WS_RS = WS_W2 + al((size_t)32 * 1024 * 1024);
constexpr size_t WS_LOG = WS_RS + al((size_t)T * 4);
constexpr size_t WS_EPOS = WS_LOG + al((size_t)T * 32 * 4);
constexpr size_t WS_GATEV = WS_EPOS + al((size_t)T * 4 * 4);
constexpr size_t WS_SLOT = WS_GATEV + al((size_t)T * 4 * 4);
constexpr size_t WS_ROWG = WS_SLOT + al((size_t)T * 4 * 4);
constexpr size_t WS_ROWTOK = WS_ROWG + al((size_t)NPASS * MAXTILES * 256 * 4);
constexpr size_t WS_TILEE = WS_ROWTOK + al((size_t)NPASS * MAXTILES * 256 * 4);
constexpr int TE_STRIDE = MAXTILES + 64;
constexpr size_t WS_XS = WS_TILEE + al((size_t)NPASS * (MAXTILES + 64) * 4);
constexpr size_t PASS_BUF = al((size_t)MAXTILES * 256 * 1024);
constexpr size_t WS_ACT = WS_XS + NPASS * PASS_BUF;
constexpr size_t WS_XN2F8 = WS_ACT + NPASS * PASS_BUF;
constexpr size_t WS_MOE_END = WS_XN2F8 + al((size_t)T * D);
static_assert(WS_W2 + (size_t)32 * 1024 * 1024 <= WS_SHARED + (size_t)T * RWC * 2, "converted expert weights must stay inside the (dead) PRW buffer while the GLU/Wo/out GEMM phases run");
constexpr size_t WS_END = WS_MIX_END > WS_MOE_END ? WS_MIX_END : WS_MOE_END;
static_assert(WS_END <= ((size_t)1 << 30), "workspace over 1 GiB");

constexpr int CW_BAR = 0;
constexpr int CW_GCNT = 4096;

constexpr float F8_SX = 16.f, F8_SW = 32.f, F8_SA = 4.f, F8_SY = 32.f;
constexpr int LDS_BYTES = 144 * 1024;
constexpr int MISC_OFF = 140 * 1024;

typedef __bf16 bf16x2_t __attribute__((ext_vector_type(2)));
DI unsigned cvt_pk_bf16(float lo, float hi) { f32x2 v = {lo, hi}; bf16x2_t b = __builtin_convertvector(v, bf16x2_t); return __builtin_bit_cast(unsigned, b); }
DI unsigned pk4_fp8(float a, float b, float c, float d) {
    a = fminf(fmaxf(a, -448.f), 448.f); b = fminf(fmaxf(b, -448.f), 448.f); c = fminf(fmaxf(c, -448.f), 448.f); d = fminf(fmaxf(d, -448.f), 448.f);
    int w = __builtin_amdgcn_cvt_pk_fp8_f32(a, b, 0, false); w = __builtin_amdgcn_cvt_pk_fp8_f32(c, d, w, true); return (unsigned)w; }
DI float bf_lo(unsigned u) { return __uint_as_float(u << 16); }
DI float bf_hi(unsigned u) { return __uint_as_float(u & 0xffff0000u); }
DI float bf2f(bf16_t b) { return __uint_as_float(((unsigned)b) << 16); }
DI bf16_t f2bf(float f) { return (bf16_t)(cvt_pk_bf16(f, 0.f) & 0xffffu); }
DI float fsigmoid(float x) { return __builtin_amdgcn_rcpf(1.0f + __expf(-x)); }
DI float ftanh(float x) { float e = __expf(2.0f * x); return 1.0f - 2.0f * __builtin_amdgcn_rcpf(e + 1.0f); }
DI float fgelu_tanh(float x) { float u = 0.7978845608f * (x + 0.044715f * x * x * x); return x * fsigmoid(2.0f * u); }
DI f32x2 lo2(const f32x4& v) { return __builtin_shufflevector(v, v, 0, 1); }
DI f32x2 hi2(const f32x4& v) { return __builtin_shufflevector(v, v, 2, 3); }
DI f32x2 pk_sigmoid_scaled(f32x2 x, float negk) {
    const f32x2 t = x * negk; f32x2 e; e.x = __builtin_amdgcn_exp2f(t.x); e.y = __builtin_amdgcn_exp2f(t.y);
    const f32x2 d = e + 1.0f; f32x2 r; r.x = __builtin_amdgcn_rcpf(d.x); r.y = __builtin_amdgcn_rcpf(d.y); return r; }
DI f32x2 pk_sigmoid(f32x2 x) { return pk_sigmoid_scaled(x, -1.44269504f); }
DI f32x2 pk_gelu_tanh(f32x2 x) { const f32x2 x2 = x * x; const f32x2 u = x * (x2 * (0.044715f * 0.7978845608f) + 0.7978845608f); return x * pk_sigmoid_scaled(u, -2.0f * 1.44269504f); }
DI unsigned pk4_fp8_nc(f32x2 a, f32x2 b) { int w = __builtin_amdgcn_cvt_pk_fp8_f32(a.x, a.y, 0, false); w = __builtin_amdgcn_cvt_pk_fp8_f32(b.x, b.y, w, true); return (unsigned)w; }
#define DPP_ROR_ADD(v, n) ((v) + __builtin_bit_cast(float, __builtin_amdgcn_update_dpp(0, __builtin_bit_cast(int, (v)), 0x120 + (n), 0xf, 0xf, false)))
DI float row_sum16(float v) { v = DPP_ROR_ADD(v, 8); v = DPP_ROR_ADD(v, 4); v = DPP_ROR_ADD(v, 2); v = DPP_ROR_ADD(v, 1); return v; }
DI float xrow_sum(float x) {
    float y = x;
    asm("s_nop 1\n\tv_permlane16_swap_b32 %0, %1\n\ts_nop 1" : "+v"(x), "+v"(y));
    x = x + y; y = x;
    asm("s_nop 1\n\tv_permlane32_swap_b32 %0, %1\n\ts_nop 1" : "+v"(x), "+v"(y));
    return x + y;
}
DI float wave_sum(float v) { return xrow_sum(row_sum16(v)); }
#define DPP_ADD(v, ctrl) ((v) + __builtin_bit_cast(float, __builtin_amdgcn_update_dpp(0, __builtin_bit_cast(int, (v)), (ctrl), 0xf, 0xf, false)))
DI float comb32(float x, float y) { asm("s_nop 1\n\tv_permlane32_swap_b32 %0, %1\n\ts_nop 1" : "+v"(x), "+v"(y)); return x + y; }
DI float comb16(float x, float y) { asm("s_nop 1\n\tv_permlane16_swap_b32 %0, %1\n\ts_nop 1" : "+v"(x), "+v"(y)); return x + y; }

DI float sum16(float v) {
    v += __shfl_xor(v, 1); v += __shfl_xor(v, 2); v += __shfl_xor(v, 4); v += __shfl_xor(v, 8); return v;
}

#define XB_TMO      128
#define XB_XCNT(j)  (256  + 64 * (j))
#define XB_XSUB(j)  (1280 + 64 * (j))
#define XB_XGEN(j)  (2304 + 64 * (j))
#define XB_TOP      3328
#define XB_TOPGEN   3392
#define XCD_BAR_WORDS 3456
#define XB_SPIN_CAP (1u << 22)
DI unsigned xb_ld(unsigned* p)              { return __hip_atomic_load(p, __ATOMIC_RELAXED, __HIP_MEMORY_SCOPE_AGENT); }
DI unsigned xb_add(unsigned* p, unsigned v) { return __hip_atomic_fetch_add(p, v, __ATOMIC_RELAXED, __HIP_MEMORY_SCOPE_AGENT); }
DI unsigned xb_xcc_id() { return (unsigned)__builtin_amdgcn_s_getreg((3 << 11) | 20) & 0xFu; }
#define XB_SPIN(cond, bar) do { unsigned _sp = 0; while (cond) { __builtin_amdgcn_s_sleep(1); \
    if ((++_sp & 255u) == 0u) { if (xb_ld(&(bar)[XB_TMO])) break; if (_sp > XB_SPIN_CAP) { atomicAdd(&(bar)[XB_TMO], 1u); break; } } } } while (0)
struct XcdBarrier { unsigned* bar; unsigned x; volatile LAS unsigned* st; };
DI XcdBarrier xcd_barrier_post(unsigned* bar, volatile LAS unsigned* st) {
    XcdBarrier b; b.bar = bar; b.x = xb_xcc_id(); b.st = st;
    if (threadIdx.x == 0) (void)xb_add(&bar[XB_XCNT(b.x)], 1u);
    return b;
}
DI void xcd_barrier_complete(unsigned* bar, unsigned x, unsigned& nloc, unsigned& nx) {
    const unsigned G = gridDim.x * gridDim.y * gridDim.z;
    unsigned sum, cnt, mine, sp = 0u;
    for (;;) {
        sum = 0u; cnt = 0u; mine = 0u;
#pragma unroll
        for (unsigned j = 0; j < 16; ++j) { const unsigned c = xb_ld(&bar[XB_XCNT(j)]); sum += c; cnt += (c > 0u) ? 1u : 0u; mine = (j == x) ? c : mine; }
        if (sum == G) break;
        __builtin_amdgcn_s_sleep(1);
        if ((++sp & 255u) == 0u) { if (xb_ld(&bar[XB_TMO])) break; if (sp > XB_SPIN_CAP) { atomicAdd(&bar[XB_TMO], 1u); break; } }
    }
    nloc = mine > 0u ? mine : 1u; nx = cnt > 0u ? cnt : 1u;
}
DI void xcd_barrier(const XcdBarrier& b) {
    asm volatile("s_waitcnt vmcnt(0)" ::: "memory");
    __syncthreads();
    if (threadIdx.x == 0) {
        unsigned* bar = b.bar;
        __builtin_amdgcn_s_waitcnt(0);
        unsigned nloc = b.st[0], nx = b.st[1];
        if (nloc == 0u) { xcd_barrier_complete(bar, b.x, nloc, nx); b.st[0] = nloc; b.st[1] = nx; }
        const unsigned old = xb_add(&bar[XB_XSUB(b.x)], 1u);
        const unsigned gen = old / nloc;
        if (old + 1u == (gen + 1u) * nloc) {
            __builtin_amdgcn_fence(__ATOMIC_RELEASE, "agent");
            asm volatile("s_waitcnt vmcnt(0)" ::: "memory");
            const unsigned og = xb_add(&bar[XB_TOP], 1u);
            const unsigned tg = og / nx;
            if (og + 1u == (tg + 1u) * nx) xb_add(&bar[XB_TOPGEN], 1u);
            else XB_SPIN(xb_ld(&bar[XB_TOPGEN]) == tg, bar);
            __builtin_amdgcn_fence(__ATOMIC_ACQUIRE, "agent");
            xb_add(&bar[XB_XGEN(b.x)], 1u);
            asm volatile("s_waitcnt vmcnt(0)" ::: "memory");
        } else {
            XB_SPIN(xb_ld(&bar[XB_XGEN(b.x)]) == gen, bar);
            __builtin_amdgcn_fence(__ATOMIC_ACQUIRE, "agent");
            asm volatile("s_waitcnt vmcnt(0)" ::: "memory");
        }
    }
    __syncthreads();
}

constexpr int BM = 256, BK = 64, HALF = 128, HTB = HALF * BK * 2;
DI int lds_byte(int r, int c) { const int st = (r >> 4) * 2 + (c >> 5), rr = r & 15, cc = c & 31, ob = rr * 64 + cc * 2; return st * 1024 + (ob ^ (((ob >> 9) & 1) << 5)); }
DI void stage_rc(int b, int& R, int& C) { const int st = b / 1024, sb = b % 1024, swz = sb ^ (((sb >> 9) & 1) << 5); R = (st >> 1) * 16 + swz / 64; C = (st & 1) * 32 + (swz % 64) / 2; }
DI int perm32(int rho) { const int n = rho >> 4, i = rho & 15; return 8 * (i >> 2) + 4 * n + (i & 3); }
struct Unit { int pm, pn, aux; };

template <class Sched, class Epi>
DI void gemm_phase(LAS unsigned char* lds, const Sched& S, const Epi& E) {
    const int tid = threadIdx.x, wid = __builtin_amdgcn_readfirstlane(tid >> 6), lane = tid & 63, wr = wid >> 2, wc = wid & 3, fr = lane & 15, fq = lane >> 4;
    const int K = S.K, nt = K / BK;
    unsigned voffA[2], voffB[2];
#pragma unroll
    for (int i = 0; i < 2; ++i) { int R, C; stage_rc(tid * 16 + i * 8192, R, C); const int Rb = Epi::PERM ? ((R & ~31) + perm32(R & 31)) : R;
        voffA[i] = (unsigned)(R * S.lda + C) * 2u; voffB[i] = (unsigned)(Rb * S.ldb + C) * 2u; }
    const size_t kstep = (size_t)(BK * 2);
    const size_t hstepA = (size_t)HALF * S.lda * 2, hstepB = (size_t)HALF * S.ldb * 2;
    const unsigned ldsw = (unsigned)wid * 1024u;
    const int aoff = lds_byte(wr * 64 + fr, fq * 8), boff = lds_byte(wc * 32 + fr, fq * 8);
#define PG8_SA(b, h) (((b) * 2 + (h)) * HTB)
#define PG8_SB(b, h) ((4 + (b) * 2 + (h)) * HTB)
    const unsigned ldsbase = (unsigned)(size_t)lds;
#define PG8_STAGE(bufoff, gbase, voff) do { _Pragma("unroll") for (int _i = 0; _i < 2; ++_i) \
        asm volatile("s_mov_b32 m0, %0\n\ts_nop 0\n\tglobal_load_lds_dwordx4 %1, %2" :: "s"(ldsbase + (unsigned)(bufoff) + ldsw + (unsigned)(_i * 8192)), "v"((voff)[_i]), "s"((const char*)(gbase)) : "memory"); } while (0)
#define PG8_LDA(dst, b, h) do { _Pragma("unroll") for (int m = 0; m < 4; ++m) _Pragma("unroll") for (int k = 0; k < 2; ++k) dst[m][k] = *(const LAS bf16x8*)(lds + PG8_SA(b, h) + aoff + m * 2048 + k * 1024); } while (0)
#define PG8_LDB(dst, b, h) do { _Pragma("unroll") for (int n = 0; n < 2; ++n) _Pragma("unroll") for (int k = 0; k < 2; ++k) dst[n][k] = *(const LAS bf16x8*)(lds + PG8_SB(b, h) + boff + n * 2048 + k * 1024); } while (0)
#define PG8_MMA(ai, bj, At, Bt) do { __builtin_amdgcn_s_setprio(1); _Pragma("unroll") for (int m = 0; m < 4; ++m) _Pragma("unroll") for (int n = 0; n < 2; ++n) _Pragma("unroll") for (int k = 0; k < 2; ++k) \
        acc[ai][bj][m][n] = __builtin_amdgcn_mfma_f32_16x16x32_bf16(Bt[n][k], At[m][k], acc[ai][bj][m][n], 0, 0, 0); __builtin_amdgcn_s_setprio(0); } while (0)
#define PG8_WAIT_V(n) asm volatile("s_waitcnt vmcnt(" #n ")" ::: "memory")
#define PG8_WAIT_L(n) asm volatile("s_waitcnt lgkmcnt(" #n ")" ::: "memory")
#define PG8_BAR __builtin_amdgcn_s_barrier()
#define PG8_SCHED __builtin_amdgcn_sched_barrier(0)
    Unit cur, nxt; int ui = 0;
    if (!S.next(0, cur)) return;
    f32x4 acc[2][2][4][2];
#pragma unroll
    for (int a = 0; a < 2; ++a)
#pragma unroll
        for (int b = 0; b < 2; ++b)
#pragma unroll
            for (int m = 0; m < 4; ++m)
#pragma unroll
                for (int n = 0; n < 2; ++n) { if constexpr (Sched::FP8) { f32x2 z0_, z1_; asm volatile("v_pk_mov_b32 %0, 0, 0" : "=v"(z0_)); asm volatile("v_pk_mov_b32 %0, 0, 0" : "=v"(z1_)); acc[a][b][m][n] = (f32x4){z0_.x, z0_.y, z1_.x, z1_.y}; } else acc[a][b][m][n] = (f32x4){0.f, 0.f, 0.f, 0.f}; }
    bf16x8 At[4][2], B0[2][2], B1[2][2];
    i32x8 At8[4], B08[2], B18[2];
    const int aoff8a = lds_byte(wr * 64 + fr, 16 * fq) & ~16, boff8a = lds_byte(wc * 32 + fr, 16 * fq) & ~16;
#define PG8_LDA8(dst, b, h) do { _Pragma("unroll") for (int m = 0; m < 4; ++m) dst[m] = *(const LAS i32x8*)(lds + PG8_SA(b, h) + aoff8a + m * 2048); } while (0)
#define PG8_LDB8(dst, b, h) do { _Pragma("unroll") for (int n = 0; n < 2; ++n) dst[n] = *(const LAS i32x8*)(lds + PG8_SB(b, h) + boff8a + n * 2048); } while (0)
#define PG8_MMA8(ai, bj, At_, Bt_) do { __builtin_amdgcn_s_setprio(1); _Pragma("unroll") for (int m = 0; m < 4; ++m) _Pragma("unroll") for (int n = 0; n < 2; ++n) \
        acc[ai][bj][m][n] = __builtin_amdgcn_mfma_scale_f32_16x16x128_f8f6f4(Bt_[n], At_[m], acc[ai][bj][m][n], 0, 0, 0, 0x7f7f7f7f, 0, 0x7f7f7f7f); __builtin_amdgcn_s_setprio(0); } while (0)
#define XLDA(b, h) do { if constexpr (Sched::FP8) PG8_LDA8(At8, b, h); else PG8_LDA(At, b, h); } while (0)
#define XLDB0(b, h) do { if constexpr (Sched::FP8) PG8_LDB8(B08, b, h); else PG8_LDB(B0, b, h); } while (0)
#define XLDB1(b, h) do { if constexpr (Sched::FP8) PG8_LDB8(B18, b, h); else PG8_LDB(B1, b, h); } while (0)
#define XMMA0(ai, bj) do { if constexpr (Sched::FP8) PG8_MMA8(ai, bj, At8, B08); else PG8_MMA(ai, bj, At, B0); } while (0)
#define XMMA1(ai, bj) do { if constexpr (Sched::FP8) PG8_MMA8(ai, bj, At8, B18); else PG8_MMA(ai, bj, At, B1); } while (0)
    const char* cA = S.a_ptr(cur); const char* cB = S.b_ptr(cur);
    unsigned offA[2][2], offN[2][2];
    if constexpr (Sched::GATHER) {
#pragma unroll
        for (int h = 0; h < 2; ++h)
#pragma unroll
            for (int i = 0; i < 2; ++i) { int R, C; stage_rc(tid * 16 + i * 8192, R, C); offA[h][i] = S.a_rowoff(cur, h * HALF + R) + (unsigned)C * 2u; offN[h][i] = offA[h][i]; }
    }
#define A_STG(bufoff, plainptr, kt, h, nx) do { if constexpr (Sched::GATHER) { PG8_STAGE(bufoff, cA + (size_t)(kt) * kstep, offA[h]); } \
        else PG8_STAGE(bufoff, plainptr, voffA); } while (0)
    if constexpr (GEMM_SP2) {
        PG8_STAGE(PG8_SB(0, 0), cB, voffB); PG8_STAGE(PG8_SB(0, 1), cB + hstepB, voffB); A_STG(PG8_SA(0, 0), cA, 0, 0, false); A_STG(PG8_SA(0, 1), cA + hstepA, 0, 1, false);
        if (wr == 1) PG8_BAR;
        PG8_WAIT_V(2); PG8_BAR;
        PG8_STAGE(PG8_SB(1, 0), cB + kstep, voffB); A_STG(PG8_SA(1, 0), cA + kstep, 1, 0, false); PG8_STAGE(PG8_SB(1, 1), cB + hstepB + kstep, voffB);
        PG8_WAIT_V(6); PG8_BAR;
    } else {
    PG8_STAGE(PG8_SB(0, 0), cB, voffB); A_STG(PG8_SA(0, 0), cA, 0, 0, false); PG8_STAGE(PG8_SB(0, 1), cB + hstepB, voffB); A_STG(PG8_SA(0, 1), cA + hstepA, 0, 1, false);
    if (wr == 1) PG8_BAR;
    PG8_WAIT_V(4); PG8_BAR;
    PG8_STAGE(PG8_SB(1, 0), cB + kstep, voffB); A_STG(PG8_SA(1, 0), cA + kstep, 1, 0, false); PG8_STAGE(PG8_SB(1, 1), cB + hstepB + kstep, voffB);
    PG8_WAIT_V(6); PG8_BAR;
    }
    for (;;) {
        const bool has_next = S.next(ui + 1, nxt);
        const char* nA = has_next ? S.a_ptr(nxt) : cA; const char* nB = has_next ? S.b_ptr(nxt) : cB;
        for (int t = 0; t < nt; t += 2) {
            const bool last = (t == nt - 2);
            const char* a1 = cA + (size_t)(t + 1) * kstep;
            const char* a2 = last ? nA : cA + (size_t)(t + 2) * kstep; const char* b2 = last ? nB : cB + (size_t)(t + 2) * kstep;
            const char* a3 = a2 + kstep; const char* b3 = b2 + kstep;
            const int k2 = last ? 0 : t + 2, k3 = k2 + 1;
            if constexpr (GEMM_SP2) {
            XLDB0(0, 0); XLDB1(0, 1); PG8_SCHED; XLDA(0, 0); A_STG(PG8_SA(1, 1), a1 + hstepA, t + 1, 1, false);
            if constexpr (Sched::GATHER) {
                if (has_next && (t == nt - 4 || nt < 4)) {
#pragma unroll
                    for (int h = 0; h < 2; ++h)
#pragma unroll
                        for (int i = 0; i < 2; ++i) { int R, C; stage_rc(tid * 16 + i * 8192, R, C); offN[h][i] = S.a_rowoff(nxt, h * HALF + R) + (unsigned)C * 2u; } }
                if (last && has_next) { offA[0][0] = offN[0][0]; offA[0][1] = offN[0][1]; offA[1][0] = offN[1][0]; offA[1][1] = offN[1][1]; }
            }
            PG8_WAIT_V(8); PG8_WAIT_L(0); PG8_BAR; XMMA0(0, 0); XMMA1(0, 1); PG8_BAR; PG8_SCHED;
            XLDA(0, 1); PG8_STAGE(PG8_SB(0, 0), b2, voffB); PG8_STAGE(PG8_SB(0, 1), b2 + hstepB, voffB); A_STG(PG8_SA(0, 0), a2, k2, 0, last);
            PG8_WAIT_V(8); PG8_WAIT_L(0); PG8_BAR; XMMA0(1, 0); XMMA1(1, 1); PG8_BAR; PG8_SCHED;
            XLDB0(1, 0); XLDB1(1, 1); PG8_SCHED; XLDA(1, 0); A_STG(PG8_SA(0, 1), a2 + hstepA, k2, 1, last);
            PG8_WAIT_V(8); PG8_WAIT_L(0); PG8_BAR; XMMA0(0, 0); XMMA1(0, 1); PG8_BAR; PG8_SCHED;
            XLDA(1, 1); PG8_STAGE(PG8_SB(1, 0), b3, voffB); PG8_STAGE(PG8_SB(1, 1), b3 + hstepB, voffB); A_STG(PG8_SA(1, 0), a3, k3, 0, last);
            PG8_WAIT_V(8); PG8_WAIT_L(0); PG8_BAR; XMMA0(1, 0); XMMA1(1, 1); PG8_BAR; PG8_SCHED;
            } else {
            XLDB0(0, 0); PG8_SCHED; XLDA(0, 0); A_STG(PG8_SA(1, 1), a1 + hstepA, t + 1, 1, false);
            if constexpr (Sched::GATHER) {
                if (has_next && (t == nt - 4 || nt < 4)) {
#pragma unroll
                    for (int h = 0; h < 2; ++h)
#pragma unroll
                        for (int i = 0; i < 2; ++i) { int R, C; stage_rc(tid * 16 + i * 8192, R, C); offN[h][i] = S.a_rowoff(nxt, h * HALF + R) + (unsigned)C * 2u; } }
                if (last && has_next) { offA[0][0] = offN[0][0]; offA[0][1] = offN[0][1]; offA[1][0] = offN[1][0]; offA[1][1] = offN[1][1]; }
            }
            PG8_WAIT_L(8); PG8_BAR; PG8_WAIT_L(0); XMMA0(0, 0); PG8_BAR; PG8_SCHED;
            XLDB1(0, 1); PG8_STAGE(PG8_SB(0, 0), b2, voffB);
            PG8_BAR; PG8_WAIT_L(0); XMMA1(0, 1); PG8_BAR;
            XLDA(0, 1); A_STG(PG8_SA(0, 0), a2, k2, 0, last);
            PG8_BAR; PG8_WAIT_L(0); XMMA0(1, 0); PG8_BAR; PG8_SCHED;
            PG8_STAGE(PG8_SB(0, 1), b2 + hstepB, voffB);
            PG8_WAIT_V(6); PG8_BAR; XMMA1(1, 1); PG8_BAR;
            XLDB0(1, 0); PG8_SCHED; XLDA(1, 0); A_STG(PG8_SA(0, 1), a2 + hstepA, k2, 1, last);
            PG8_WAIT_L(8); PG8_BAR; PG8_WAIT_L(0); XMMA0(0, 0); PG8_BAR; PG8_SCHED;
            XLDB1(1, 1); PG8_STAGE(PG8_SB(1, 0), b3, voffB);
            PG8_BAR; PG8_WAIT_L(0); XMMA1(0, 1); PG8_BAR;
            XLDA(1, 1); A_STG(PG8_SA(1, 0), a3, k3, 0, last);
            PG8_BAR; PG8_WAIT_L(0); XMMA0(1, 0); PG8_BAR; PG8_SCHED;
            PG8_STAGE(PG8_SB(1, 1), b3 + hstepB, voffB);
            PG8_WAIT_V(6); PG8_BAR; XMMA1(1, 1); PG8_BAR;
            }
        }
        if constexpr (GEMM_ALIGN) { if (wr == 0) PG8_BAR; }
        {
            int tz = threadIdx.x; asm volatile("" : "+v"(tz));
            const int wid2 = tz >> 6, lane2 = tz & 63;
            E(acc, cur, wid2 >> 2, wid2 & 3, lane2 & 15, lane2 >> 4); }
        if (!has_next) break;
#pragma unroll
        for (int a = 0; a < 2; ++a)
#pragma unroll
            for (int b = 0; b < 2; ++b)
#pragma unroll
                for (int m = 0; m < 4; ++m)
#pragma unroll
                    for (int n = 0; n < 2; ++n) { if constexpr (Sched::FP8) { f32x2 z0_, z1_; asm volatile("v_pk_mov_b32 %0, 0, 0" : "=v"(z0_)); asm volatile("v_pk_mov_b32 %0, 0, 0" : "=v"(z1_)); acc[a][b][m][n] = (f32x4){z0_.x, z0_.y, z1_.x, z1_.y}; } else acc[a][b][m][n] = (f32x4){0.f, 0.f, 0.f, 0.f}; }
        cur = nxt; cA = nA; cB = nB; ++ui;
        if constexpr (GEMM_ALIGN) { if (wr == 1) PG8_BAR; }
    }
    PG8_WAIT_V(0);
    if constexpr (!GEMM_ALIGN) { if (wr == 0) PG8_BAR; }
    PG8_BAR;
#undef XLDA
#undef XLDB0
#undef XLDB1
#undef XMMA0
#undef XMMA1
#undef PG8_LDA8
#undef PG8_LDB8
#undef PG8_MMA8
#undef A_STG
#undef PG8_SA
#undef PG8_SB
#undef PG8_STAGE
#undef PG8_LDA
#undef PG8_LDB
#undef PG8_MMA
#undef PG8_WAIT_V
#undef PG8_WAIT_L
#undef PG8_BAR
#undef PG8_SCHED
}

struct PlainSched {
    static constexpr bool GATHER = false, FP8 = false;
    const char* A; const char* B; int K, lda, ldb, nM, nN, nwg, G, c; int akoff_pn = 1 << 30, akoff_bytes = 0;
    DI void init(const void* A_, const void* B_, int M, int N, int K_, int lda_, int ldb_, int G_, int c_) { A = (const char*)A_; B = (const char*)B_; K = K_; lda = lda_; ldb = ldb_; nM = M / BM; nN = N / BM; nwg = nM * nN; G = G_; c = c_; }
    DI bool next(int i, Unit& u) const {
        const long L = (long)i * G + c; if (L >= nwg) return false;
        int wgid = (int)L; { const int q = nwg / 8, r = nwg % 8, xcd = wgid % 8, off = wgid / 8; wgid = (xcd < r ? xcd * (q + 1) : r * (q + 1) + (xcd - r) * q) + off; }
        const int nig = 8 * nN, gid = wgid / nig, fm = gid * 8, gsz = (nM - fm) < 8 ? (nM - fm) : 8;
        u.pm = fm + ((wgid % nig) % gsz); u.pn = (wgid % nig) / gsz; u.aux = 0; return true;
    }
    DI const char* a_ptr(const Unit& u) const { return A + (size_t)u.pm * BM * lda * 2 + (u.pn >= akoff_pn ? akoff_bytes : 0); }
    DI const char* b_ptr(const Unit& u) const { return B + (size_t)u.pn * BM * ldb * 2; }
};
struct GroupSched {
    static constexpr bool GATHER = false, FP8 = false;
    const char* A; const char* B; int K, lda, ldb, nMg, nN, nwg, G, c;
    DI void init(const void* A_, const void* B_, int K_, int lda_, int ldb_, int nMg_, int nN_, int G_, int c_) { A = (const char*)A_; B = (const char*)B_; K = K_; lda = lda_; ldb = ldb_; nMg = nMg_; nN = nN_; nwg = 32 * nMg * nN; G = G_; c = c_; }
    DI bool next(int i, Unit& u) const {
        const int L = i * G + c; if (L >= nwg) return false;
        const int per = nMg * nN, g = L / per, rem = L % per; u.pm = g * nMg + rem / nN; u.pn = rem % nN; u.aux = g; return true;
    }
    DI const char* a_ptr(const Unit& u) const { return A + (size_t)u.pm * BM * lda * 2; }
    DI const char* b_ptr(const Unit& u) const { return B + ((size_t)u.aux * nN + u.pn) * BM * ldb * 2; }
};
template <bool GATH>
struct MoeSched {
    static constexpr bool GATHER = GATH, FP8 = true;
    const char* A; const char* B; const int* tile_e; const int* rowtok; int K, lda, ldb, nN, NperE, nwg, G, c;
    DI void init(const void* A_, const void* B_, const int* te, const int* rt, int ntiles, int K_, int nN_, int G_, int c_) { A = (const char*)A_; B = (const char*)B_; tile_e = te; rowtok = rt; K = K_; lda = K_; ldb = K_; nN = nN_; NperE = nN_ * BM; nwg = ntiles * nN_; G = G_; c = c_; }
    DI bool next(int i, Unit& u) const {
        int L = i * G + c; if (L >= nwg) return false;
        if (G == 256 && (i + 1) * G <= nwg) { const int x = c & 7, sl = c >> 3, mt = G / nN / 8;
            L = i * G + (x * mt + sl / nN) * nN + (sl % nN); }
        u.pm = L / nN; u.pn = L % nN; u.aux = __builtin_amdgcn_readfirstlane(__hip_atomic_load(tile_e + u.pm, __ATOMIC_RELAXED, __HIP_MEMORY_SCOPE_AGENT)); return true;
    }
    DI const char* a_ptr(const Unit& u) const { return GATH ? A : A + (size_t)u.pm * BM * lda * 2; }
    DI unsigned a_rowoff(const Unit& u, int row) const { return (unsigned)__hip_atomic_load(rowtok + u.pm * BM + row, __ATOMIC_RELAXED, __HIP_MEMORY_SCOPE_AGENT) * (unsigned)(lda * 2); }
    DI const char* b_ptr(const Unit& u) const { return B + ((size_t)u.aux * NperE + (size_t)u.pn * BM) * ldb * 2; }
};

typedef f32x4 AccT[2][2][4][2];
struct EpiWin {
    static constexpr bool PERM = true;
    bf16_t* us5; bf16_t* prw; bf16_t* gates;
    DI static u32x4 pack8(const f32x4& v0, const f32x4& v1) { u32x4 w; w.x = cvt_pk_bf16(v0[0], v0[1]); w.y = cvt_pk_bf16(v0[2], v0[3]); w.z = cvt_pk_bf16(v1[0], v1[1]); w.w = cvt_pk_bf16(v1[2], v1[3]); return w; }
    DI void operator()(const AccT& acc, const Unit& u, int wr, int wc, int fr, int fq) const {
        if (u.pn < 2) {
#pragma unroll
            for (int ai = 0; ai < 2; ++ai)
#pragma unroll
                for (int m = 0; m < 4; ++m) { const int r = u.pm * BM + ai * HALF + wr * 64 + m * 16 + fr, b = r >> 12, sq = r & 4095, ch = sq / S5L, j = sq % S5L;
#pragma unroll
                    for (int bj = 0; bj < 2; ++bj) { const int c0 = u.pn * BM + bj * HALF + wc * 32 + 8 * fq, g = c0 >> 4, ci = c0 & 15;
                        *(u32x4*)(us5 + ((size_t)(g * S5ROWS + b * S5NC + ch) * LDU + j * 16 + ci)) = pack8(acc[ai][bj][m][0], acc[ai][bj][m][1]); } }
        } else if (u.pn < 9) {
#pragma unroll
            for (int ai = 0; ai < 2; ++ai)
#pragma unroll
                for (int m = 0; m < 4; ++m) { const int r = u.pm * BM + ai * HALF + wr * 64 + m * 16 + fr;
#pragma unroll
                    for (int bj = 0; bj < 2; ++bj) { const int c0 = u.pn * BM + bj * HALF + wc * 32 + 8 * fq;
                        *(u32x4*)(prw + (size_t)r * RWC + (c0 - 512)) = pack8(acc[ai][bj][m][0], acc[ai][bj][m][1]); } }
        } else {
#pragma unroll
            for (int ai = 0; ai < 2; ++ai)
#pragma unroll
                for (int m = 0; m < 4; ++m) { const int r = u.pm * BM + ai * HALF + wr * 64 + m * 16 + fr;
#pragma unroll
                    for (int bj = 0; bj < 2; ++bj) { const int c0 = u.pn * BM + bj * HALF + wc * 32 + 8 * fq;
                        const f32x4& v0 = acc[ai][bj][m][0]; const f32x4& v1 = acc[ai][bj][m][1];
                        const f32x2 a_ = pk_sigmoid(lo2(v0)), b_ = pk_sigmoid(hi2(v0)), c_ = pk_sigmoid(lo2(v1)), d_ = pk_sigmoid(hi2(v1));
                        u32x4 w; w.x = cvt_pk_bf16(a_.x, a_.y); w.y = cvt_pk_bf16(b_.x, b_.y); w.z = cvt_pk_bf16(c_.x, c_.y); w.w = cvt_pk_bf16(d_.x, d_.y);
                        *(u32x4*)(gates + (size_t)r * 2048 + (c0 - 2304)) = w; } }
        }
    }
};
struct EpiS5State {
    static constexpr bool PERM = false;
    float* sloc;
    DI void operator()(const AccT& acc, const Unit& u, int wr, int wc, int fr, int fq) const {
#pragma unroll
        for (int ai = 0; ai < 2; ++ai)
#pragma unroll
            for (int m = 0; m < 4; ++m) {
                const int r = u.pm * BM + ai * HALF + wr * 64 + m * 16 + fr;
#pragma unroll
                for (int n = 0; n < 2; ++n) *(f32x4*)(sloc + (size_t)r * 128 + wc * 32 + 16 * n + 4 * fq) = acc[ai][0][m][n];
            }
    }
};
struct EpiS5Out {
    static constexpr bool PERM = true;
    bf16_t* ys;
    DI void operator()(const AccT& acc, const Unit& u, int wr, int wc, int fr, int fq) const {
        const int g = u.aux;
#pragma unroll
        for (int ai = 0; ai < 2; ++ai)
#pragma unroll
            for (int m = 0; m < 4; ++m) {
                const int r = u.pm * BM + ai * HALF + wr * 64 + m * 16 + fr;
                const int rc = r - g * S5ROWS;
#pragma unroll
                for (int bj = 0; bj < 2; ++bj) {
                    const int c0 = u.pn * BM + bj * HALF + wc * 32 + 8 * fq;
                    const int t = c0 >> 4, co = c0 & 15;
                    const size_t tok = (size_t)rc * S5L + t;
                    f32x4 v0 = acc[ai][bj][m][0], v1 = acc[ai][bj][m][1];
                    { const f32x2 a_ = pk_gelu_tanh(lo2(v0)), b_ = pk_gelu_tanh(hi2(v0)), c_ = pk_gelu_tanh(lo2(v1)), d_ = pk_gelu_tanh(hi2(v1));
                      v0 = (f32x4){a_.x, a_.y, b_.x, b_.y}; v1 = (f32x4){c_.x, c_.y, d_.x, d_.y}; }
                    u32x4 w; w.x = cvt_pk_bf16(v0[0], v0[1]); w.y = cvt_pk_bf16(v0[2], v0[3]); w.z = cvt_pk_bf16(v1[0], v1[1]); w.w = cvt_pk_bf16(v1[2], v1[3]);
                    *(u32x4*)(ys + tok * 512 + g * 16 + co) = w;
                }
            }
    }
};
struct EpiLora {
    static constexpr bool PERM = true;
    bf16_t* lwag; const float* w0; const float* a0;
    DI void operator()(const AccT& acc, const Unit& u, int wr, int wc, int fr, int fq) const {
#pragma unroll
        for (int bj = 0; bj < 2; ++bj) {
            const int c0 = u.pn * BM + bj * HALF + wc * 32 + 8 * fq;
            f32x4 b0 = (f32x4){0.f, 0.f, 0.f, 0.f}, b1 = b0;
            if (c0 < 512) { b0 = *(const f32x4*)(w0 + c0); b1 = *(const f32x4*)(w0 + c0 + 4); } else if (c0 < 1024) { b0 = *(const f32x4*)(a0 + c0 - 512); b1 = *(const f32x4*)(a0 + c0 - 508); }
            const f32x2 bias[4] = {lo2(b0), hi2(b0), lo2(b1), hi2(b1)};
            const float osc = (c0 < 512) ? -0.6065306597f : 1.0f;
            if (c0 < 1024) {
#pragma unroll
                for (int ai = 0; ai < 2; ++ai)
#pragma unroll
                    for (int m = 0; m < 4; ++m) { const int r = u.pm * BM + ai * HALF + wr * 64 + m * 16 + fr; u32x4 w;
#pragma unroll
                        for (int jp = 0; jp < 4; ++jp) { const f32x4& a = acc[ai][bj][m][jp >> 1]; const f32x2 v = pk_sigmoid(((jp & 1) ? hi2(a) : lo2(a)) + bias[jp]) * osc; w[jp] = cvt_pk_bf16(v.x, v.y); }
                        *(u32x4*)(lwag + (size_t)r * 1536 + c0) = w; }
            } else {
#pragma unroll
                for (int ai = 0; ai < 2; ++ai)
#pragma unroll
                    for (int m = 0; m < 4; ++m) { const int r = u.pm * BM + ai * HALF + wr * 64 + m * 16 + fr; u32x4 w;
#pragma unroll
                        for (int jp = 0; jp < 4; ++jp) { const f32x4& a = acc[ai][bj][m][jp >> 1]; const f32x2 v = (jp & 1) ? hi2(a) : lo2(a); w[jp] = cvt_pk_bf16(v.x, v.y); }
                        *(u32x4*)(lwag + (size_t)r * 1536 + c0) = w; }
            }
        }
    }
};
struct EpiGlu {
    static constexpr bool PERM = true;
    bf16_t* mixed; const bf16_t* gates; const float* bglu;
    DI void operator()(const AccT& acc, const Unit& u, int wr, int wc, int fr, int fq) const {
        const int cw = wc * 32 + 8 * fq, j0 = u.pn * 128 + cw;
        const float* bp = bglu + u.pn * 256 + cw;
        const f32x4 ba0 = *(const f32x4*)bp, ba1 = *(const f32x4*)(bp + 4), bb0 = *(const f32x4*)(bp + 128), bb1 = *(const f32x4*)(bp + 132);
        const f32x2 ba[4] = {lo2(ba0), hi2(ba0), lo2(ba1), hi2(ba1)}, bb[4] = {lo2(bb0), hi2(bb0), lo2(bb1), hi2(bb1)};
        u32x4 gw[2][4];
#pragma unroll
        for (int ai = 0; ai < 2; ++ai)
#pragma unroll
            for (int m = 0; m < 4; ++m) gw[ai][m] = *(const u32x4*)(gates + (size_t)(u.pm * BM + ai * HALF + wr * 64 + m * 16 + fr) * 2048 + j0);
#pragma unroll
        for (int ai = 0; ai < 2; ++ai)
#pragma unroll
            for (int m = 0; m < 4; ++m) {
                const int r = u.pm * BM + ai * HALF + wr * 64 + m * 16 + fr;
                u32x4 w;
#pragma unroll
                for (int jp = 0; jp < 4; ++jp) {
                    const f32x4& aa = acc[ai][0][m][jp >> 1]; const f32x4& ab = acc[ai][1][m][jp >> 1];
                    const f32x2 za = ((jp & 1) ? hi2(aa) : lo2(aa)) + ba[jp], zb = ((jp & 1) ? hi2(ab) : lo2(ab)) + bb[jp];
                    const unsigned gwd = gw[ai][m][jp]; const f32x2 gt = {bf_lo(gwd), bf_hi(gwd)};
                    const f32x2 o = (gt * za) * pk_sigmoid(zb);
                    w[jp] = cvt_pk_bf16(o.x, o.y);
                }
                *(u32x4*)(mixed + (size_t)r * 1024 + j0) = w;
            }
    }
};
struct EpiWo {
    static constexpr bool PERM = true;
    bf16_t* mixed; const bf16_t* gates;
    DI void operator()(const AccT& acc, const Unit& u, int wr, int wc, int fr, int fq) const {
#pragma unroll
        for (int ai = 0; ai < 2; ++ai) {
            u32x4 gw[4][2], mw[4][2];
#pragma unroll
            for (int m = 0; m < 4; ++m)
#pragma unroll
                for (int bj = 0; bj < 2; ++bj) { const size_t r = (size_t)(u.pm * BM + ai * HALF + wr * 64 + m * 16 + fr); const int c0 = u.pn * BM + bj * HALF + wc * 32 + 8 * fq;
                    gw[m][bj] = *(const u32x4*)(gates + r * 2048 + 1024 + c0); mw[m][bj] = *(const u32x4*)(mixed + r * 1024 + c0); }
#pragma unroll
            for (int m = 0; m < 4; ++m)
#pragma unroll
                for (int bj = 0; bj < 2; ++bj) { const size_t r = (size_t)(u.pm * BM + ai * HALF + wr * 64 + m * 16 + fr); const int c0 = u.pn * BM + bj * HALF + wc * 32 + 8 * fq;
                    u32x4 w;
#pragma unroll
                    for (int jp = 0; jp < 4; ++jp) { const unsigned gwd = gw[m][bj][jp], mwd = mw[m][bj][jp]; const f32x4& a = acc[ai][bj][m][jp >> 1];
                        const f32x2 o = (f32x2){bf_lo(mwd), bf_hi(mwd)} + (f32x2){bf_lo(gwd), bf_hi(gwd)} * ((jp & 1) ? hi2(a) : lo2(a));
                        w[jp] = cvt_pk_bf16(o.x, o.y); }
                    *(u32x4*)(mixed + r * 1024 + c0) = w; }
        }
    }
};
struct EpiOut {
    static constexpr bool PERM = true;
    bf16_t* hb; const float* x;
    DI void operator()(const AccT& acc, const Unit& u, int wr, int wc, int fr, int fq) const {
#pragma unroll
        for (int ai = 0; ai < 2; ++ai) {
            f32x4 xv[4][2][2];
#pragma unroll
            for (int m = 0; m < 4; ++m) { const size_t r = (size_t)(u.pm * BM + ai * HALF + wr * 64 + m * 16 + fr);
#pragma unroll
                for (int bj = 0; bj < 2; ++bj) { const float* xp = x + r * 1024 + u.pn * BM + bj * HALF + wc * 32 + 8 * fq; xv[m][bj][0] = *(const f32x4*)xp; xv[m][bj][1] = *(const f32x4*)(xp + 4); } }
#pragma unroll
            for (int m = 0; m < 4; ++m) { const size_t r = (size_t)(u.pm * BM + ai * HALF + wr * 64 + m * 16 + fr);
#pragma unroll
                for (int bj = 0; bj < 2; ++bj) { const f32x4 v0 = xv[m][bj][0] + acc[ai][bj][m][0], v1 = xv[m][bj][1] + acc[ai][bj][m][1];
                    u32x4 w; w.x = cvt_pk_bf16(v0[0], v0[1]); w.y = cvt_pk_bf16(v0[2], v0[3]); w.z = cvt_pk_bf16(v1[0], v1[1]); w.w = cvt_pk_bf16(v1[2], v1[3]);
                    *(u32x4*)(hb + r * 1024 + u.pn * BM + bj * HALF + wc * 32 + 8 * fq) = w; } }
        }
    }
};
struct EpiRouter {
    static constexpr bool PERM = false;
    float* logits;
    DI void operator()(const AccT& acc, const Unit& u, int wr, int wc, int fr, int fq) const {
        if (wc != 0) return;
#pragma unroll
        for (int n = 0; n < 2; ++n) {
            const int c = 16 * n + 4 * fq;
#pragma unroll
            for (int ai = 0; ai < 2; ++ai)
#pragma unroll
                for (int m = 0; m < 4; ++m) {
                    const size_t r = (size_t)(u.pm * BM + ai * HALF + wr * 64 + m * 16 + fr);
                    *(f32x4*)(logits + r * 32 + c) = acc[ai][0][m][n];
                }
        }
    }
};
struct EpiMoe1 {
    static constexpr bool PERM = true;
    unsigned char* act; const float* b1p;
    DI void operator()(const AccT& acc, const Unit& u, int wr, int wc, int fr, int fq) const {
        const int cw = wc * 32 + 8 * fq, j0 = u.pn * 128 + cw;
        const float* bp = b1p + (size_t)u.aux * 2048 + u.pn * 256 + cw;
        const f32x4 ba0 = *(const f32x4*)bp, ba1 = *(const f32x4*)(bp + 4), bb0 = *(const f32x4*)(bp + 128), bb1 = *(const f32x4*)(bp + 132);
        const f32x2 ba[4] = {lo2(ba0), hi2(ba0), lo2(ba1), hi2(ba1)}, bb[4] = {lo2(bb0), hi2(bb0), lo2(bb1), hi2(bb1)};
        constexpr float sc = 1.0f / (F8_SX * F8_SW);
#pragma unroll
        for (int ai = 0; ai < 2; ++ai)
#pragma unroll
            for (int m = 0; m < 4; ++m) {
                const size_t r = (size_t)(u.pm * BM + ai * HALF + wr * 64 + m * 16 + fr);
                f32x2 o[4];
#pragma unroll
                for (int jp = 0; jp < 4; ++jp) {
                    const f32x4& ag = acc[ai][0][m][jp >> 1]; const f32x4& al_ = acc[ai][1][m][jp >> 1];
                    const f32x2 g = ((jp & 1) ? hi2(ag) : lo2(ag)) * sc + ba[jp], l = ((jp & 1) ? hi2(al_) : lo2(al_)) * sc + bb[jp];
                    const f32x2 xg = __builtin_elementwise_min(g, (f32x2){7.0f, 7.0f});
                    const f32x2 xl = __builtin_elementwise_min(__builtin_elementwise_max(l, (f32x2){-7.0f, -7.0f}), (f32x2){7.0f, 7.0f});
                    o[jp] = (xg * pk_sigmoid_scaled(xg, -1.702f * 1.44269504f)) * (xl * F8_SA + F8_SA);
                }
                u32x2 w; w.x = pk4_fp8_nc(o[0], o[1]); w.y = pk4_fp8_nc(o[2], o[3]);
                *(u32x2*)(act + r * 1024 + j0) = w;
            }
    }
};
struct EpiMoe2 {
    static constexpr bool PERM = true;
    unsigned char* y2; const float* b2; const float* rowg;
    DI void operator()(const AccT& acc, const Unit& u, int wr, int wc, int fr, int fq) const {
        float gt[2][4];
#pragma unroll
        for (int ai = 0; ai < 2; ++ai)
#pragma unroll
            for (int m = 0; m < 4; ++m) gt[ai][m] = rowg[(size_t)(u.pm * BM + ai * HALF + wr * 64 + m * 16 + fr)] * F8_SY;
#pragma unroll
        for (int bj = 0; bj < 2; ++bj) {
            const int c0 = u.pn * BM + bj * HALF + wc * 32 + 8 * fq;
            const f32x4 bva = *(const f32x4*)(b2 + (size_t)u.aux * 1024 + c0), bvb = *(const f32x4*)(b2 + (size_t)u.aux * 1024 + c0 + 4);
            const f32x2 bv[4] = {lo2(bva), hi2(bva), lo2(bvb), hi2(bvb)};
#pragma unroll
            for (int ai = 0; ai < 2; ++ai)
#pragma unroll
                for (int m = 0; m < 4; ++m) {
                    const size_t r = (size_t)(u.pm * BM + ai * HALF + wr * 64 + m * 16 + fr);
                    const float g = gt[ai][m];
                    f32x2 o[4];
#pragma unroll
                    for (int jp = 0; jp < 4; ++jp) { const f32x4& a = acc[ai][bj][m][jp >> 1];
                        o[jp] = (((jp & 1) ? hi2(a) : lo2(a)) * (1.0f / (F8_SA * F8_SW)) + bv[jp]) * g;
                        o[jp] = __builtin_elementwise_min(__builtin_elementwise_max(o[jp], (f32x2){-448.f, -448.f}), (f32x2){448.f, 448.f}); }
                    u32x2 w; w.x = pk4_fp8_nc(o[0], o[1]); w.y = pk4_fp8_nc(o[2], o[3]);
                    *(u32x2*)(y2 + r * 1024 + c0) = w;
                }
        }
    }
};
struct KArgs { const float* in[34]; float* out; unsigned char* ws; int ph_lo, ph_hi; };
struct Frame {
    LAS unsigned char* lds; int tid, lane, wave, G, bid;
    const float* const* in; float* out; unsigned char* ws;
};

template <class MP>
DI void conv_T(const Frame& F, const float* src, size_t src_bstride, int ld, bf16_t* dst, int N, int K, int nbatch, MP mp, int t0 = 0, int t1 = 0x7fffffff) {
    LAS unsigned* tile = (LAS unsigned*)F.lds;
    const int ntk = K / 64, ntn = N / 256, per = ntk * ntn;
    const int tend = (per * nbatch) < t1 ? (per * nbatch) : t1;
    for (int t = t0 + F.bid; t < tend; t += F.G) {
        const int bt = t / per, tt = t % per, tk = tt % ntk, pn = tt / ntk;
        const float* s = src + (size_t)bt * src_bstride + (size_t)(tk * 64) * ld + mp.src(pn, F.lane);
        f32x4 va[4], vb[4];
#pragma unroll
        for (int i = 0; i < 4; ++i) { const int kp = F.wave + 8 * i; va[i] = *(const f32x4*)(s + (size_t)(2 * kp) * ld); vb[i] = *(const f32x4*)(s + (size_t)(2 * kp + 1) * ld); }
#pragma unroll
        for (int i = 0; i < 4; ++i) { const int kp = F.wave + 8 * i;
#pragma unroll
            for (int j = 0; j < 4; ++j) tile[mp.dst(F.lane, j) * 33 + kp] = cvt_pk_bf16(va[i][j], vb[i][j]); }
        __syncthreads();
        unsigned* d = (unsigned*)(dst + (size_t)bt * N * K + (size_t)(pn * 256) * K + tk * 64);
#pragma unroll
        for (int i = 0; i < 4; ++i) { const int pc = F.tid + NTHR * i, nn = pc >> 3, seg = pc & 7;
            u32x4 w; w.x = tile[nn * 33 + seg * 4]; w.y = tile[nn * 33 + seg * 4 + 1]; w.z = tile[nn * 33 + seg * 4 + 2]; w.w = tile[nn * 33 + seg * 4 + 3];
            *(u32x4*)(d + ((size_t)nn * K) / 2 + seg * 4) = w; }
        __syncthreads();
    }
}
template <class MP>
DI void conv_T8(const Frame& F, const float* src, size_t src_bstride, int ld, unsigned char* dst, int N, int K, int nbatch, MP mp, float scale, int t0 = 0, int t1 = 0x7fffffff) {
    LAS unsigned* tile = (LAS unsigned*)F.lds;
    const int ntk = K / 64, ntn = N / 256, per = ntk * ntn;
    const int tend = (per * nbatch) < t1 ? (per * nbatch) : t1;
    for (int t = t0 + F.bid; t < tend; t += F.G) {
        const int bt = t / per, tt = t % per, tk = tt % ntk, pn = tt / ntk;
        const float* s = src + (size_t)bt * src_bstride + (size_t)(tk * 64) * ld + mp.src(pn, F.lane);
        f32x4 v[2][4];
#pragma unroll
        for (int i = 0; i < 2; ++i) { const int kq = F.wave + 8 * i;
#pragma unroll
            for (int e = 0; e < 4; ++e) v[i][e] = *(const f32x4*)(s + (size_t)(4 * kq + e) * ld); }
#pragma unroll
        for (int i = 0; i < 2; ++i) { const int kq = F.wave + 8 * i;
#pragma unroll
            for (int j = 0; j < 4; ++j) tile[mp.dst(F.lane, j) * 17 + kq] = pk4_fp8(v[i][0][j] * scale, v[i][1][j] * scale, v[i][2][j] * scale, v[i][3][j] * scale); }
        __syncthreads();
        unsigned char* d = dst + ((size_t)bt * N + (size_t)pn * 256) * K + tk * 64;
#pragma unroll
        for (int i = 0; i < 2; ++i) { const int pc = F.tid + NTHR * i, nn = pc >> 2, seg = pc & 3;
            u32x4 w; w.x = tile[nn * 17 + seg * 4]; w.y = tile[nn * 17 + seg * 4 + 1]; w.z = tile[nn * 17 + seg * 4 + 2]; w.w = tile[nn * 17 + seg * 4 + 3];
            *(u32x4*)(d + (size_t)nn * K + seg * 16) = w; }
        __syncthreads();
    }
}
struct MpId  { DI int src(int pn, int f) const { return pn * 256 + 4 * f; } DI int dst(int f, int j) const { return 4 * f + j; } };
struct MpSwi { DI int src(int pn, int f) const { return pn * 256 + 4 * f; } DI int dst(int f, int j) const { const int n = 4 * f + j; return (n >> 1) + 128 * (n & 1); } };
struct MpGlu { DI int src(int pn, int f) const { const int w = 4 * f; return pn * 128 + (w & 127) + 1024 * (w >> 7); } DI int dst(int f, int j) const { return 4 * f + j; } };
struct CmGlu { DI int operator()(int n) const { const int pn = n >> 8, w = n & 255; return pn * 128 + (w & 127) + 1024 * (w >> 7); } };
struct CmSwi { DI int operator()(int n) const { const int pn = n >> 8, w = n & 255; return 2 * (pn * 128 + (w & 127)) + (w >> 7); } };

DI void rmsnorm_rows(const Frame& F, const float* x, const float* g, bf16_t* out, int row0, int nrows, unsigned char* out8 = nullptr) {
    const int stride = F.G * NWAVES;
    for (int row = row0 + F.bid * NWAVES + F.wave; row < row0 + nrows; row += 2 * stride) {
        const int row2 = (row + stride < row0 + nrows) ? row + stride : row;
        const f32x4* xr = (const f32x4*)(x + (size_t)row * D); const f32x4* xr2 = (const f32x4*)(x + (size_t)row2 * D);
        f32x4 v[4], u[4]; float ss = 0.f, su = 0.f;
#pragma unroll
        for (int i = 0; i < 4; ++i) { v[i] = xr[i * 64 + F.lane]; u[i] = xr2[i * 64 + F.lane]; }
#pragma unroll
        for (int i = 0; i < 4; ++i) { ss += v[i][0] * v[i][0] + v[i][1] * v[i][1] + v[i][2] * v[i][2] + v[i][3] * v[i][3]; su += u[i][0] * u[i][0] + u[i][1] * u[i][1] + u[i][2] * u[i][2] + u[i][3] * u[i][3]; }
        ss = wave_sum(ss); su = wave_sum(su);
        const float rs = rsqrtf(ss * (1.0f / D) + 1e-5f), ru = rsqrtf(su * (1.0f / D) + 1e-5f);
#pragma unroll
        for (int i = 0; i < 4; ++i) { const f32x4 gv = ((const f32x4*)g)[i * 64 + F.lane];
            u32x2 w; w.x = cvt_pk_bf16(v[i][0] * rs * gv[0], v[i][1] * rs * gv[1]); w.y = cvt_pk_bf16(v[i][2] * rs * gv[2], v[i][3] * rs * gv[3]);
            *(u32x2*)(out + (size_t)row * D + (i * 64 + F.lane) * 4) = w;
            u32x2 w2; w2.x = cvt_pk_bf16(u[i][0] * ru * gv[0], u[i][1] * ru * gv[1]); w2.y = cvt_pk_bf16(u[i][2] * ru * gv[2], u[i][3] * ru * gv[3]);
            *(u32x2*)(out + (size_t)row2 * D + (i * 64 + F.lane) * 4) = w2;
            if (out8) { *(unsigned*)(out8 + (size_t)row * D + (i * 64 + F.lane) * 4) = pk4_fp8(v[i][0] * rs * gv[0] * F8_SX, v[i][1] * rs * gv[1] * F8_SX, v[i][2] * rs * gv[2] * F8_SX, v[i][3] * rs * gv[3] * F8_SX);
                *(unsigned*)(out8 + (size_t)row2 * D + (i * 64 + F.lane) * 4) = pk4_fp8(u[i][0] * ru * gv[0] * F8_SX, u[i][1] * ru * gv[1] * F8_SX, u[i][2] * ru * gv[2] * F8_SX, u[i][3] * ru * gv[3] * F8_SX); } }
    }
}

DI void p0_prologue(const Frame& F) {
    unsigned char* ws = F.ws;
    conv_T(F, F.in[2], 0, INC, (bf16_t*)(ws + WS_WIN), INC, D, 1, MpId());
    conv_T(F, F.in[11], 0, 2048, (bf16_t*)(ws + WS_WGLU), 2048, 512, 1, MpGlu());
    conv_T(F, F.in[24], 0, 1024, (bf16_t*)(ws + WS_WO), 1024, 512, 1, MpId());
    conv_T(F, F.in[25], 0, 1024, (bf16_t*)(ws + WS_WOUT), 1024, 1024, 1, MpId());
    {
        bf16_t* wl = (bf16_t*)(ws + WS_WLORA); const float* w2 = F.in[15]; const float* a2 = F.in[17]; const float* g2 = F.in[18];
        for (int idx = F.bid * NTHR + F.tid; idx < 1536 * 128; idx += F.G * NTHR) { const int n = idx >> 7, k = idx & 127; float v = 0.f;
            if (n < 512) { if (k < 64) v = w2[k * 512 + n]; } else if (n < 1024) { if (k >= 64) v = a2[(k - 64) * 512 + (n - 512)]; } else { v = g2[k * 512 + (n - 1024)]; }
            wl[idx] = f2bf(v); }
        bf16_t* wrt = (bf16_t*)(ws + WS_WR); const float* rw = F.in[27];
        for (int idx = F.bid * NTHR + F.tid; idx < 256 * 1024; idx += F.G * NTHR) { const int n = idx >> 10, k = idx & 1023; wrt[idx] = f2bf(n < 32 ? rw[k * 32 + n] * F.in[26][k] : 0.f); }
        float* bg = (float*)(ws + WS_BGLU); const float* bsrc = F.in[12]; CmGlu cm;
        for (int idx = F.bid * NTHR + F.tid; idx < 2048; idx += F.G * NTHR) bg[idx] = bsrc[cm(idx)];
    }
    if (F.bid & 1) rmsnorm_rows(F, F.in[0], F.in[1], (bf16_t*)(ws + WS_XN), 0, T);
    {
        LAS float* L = (LAS float*)F.lds;
        LAS float* pwr = L, *pwi = L + 64, *p1r = L + 128, *p1i = L + 192, *ffr = L + 256, *ffi = L + 320;
        LAS float* bbr = L + 384, *bbi = bbr + 1024, *ccr = bbi + 1024, *cci = ccr + 1024, *kj = cci + 1024;
        const float* lam_re = F.in[3]; const float* lam_im = F.in[4]; const float* log_dt = F.in[5];
        const float* b_re = F.in[6]; const float* b_im = F.in[7]; const float* c_re = F.in[8]; const float* c_im = F.in[9]; const float* dsk = F.in[10];
        unsigned* toep = (unsigned*)(ws + WS_TOEP); unsigned* wst = (unsigned*)(ws + WS_WST);
        for (int it = F.bid; it < 32 * S5L; it += F.G) {
            const int g = it / S5L, j = it % S5L;
            if (F.tid < 64) { const int p = F.tid; const float lr = lam_re[g * 64 + p], li = lam_im[g * 64 + p], dt = __expf(log_dt[g]);
                float sn, cs; { const float mg = expf((float)j * lr * dt); sincosf((float)j * (li * dt), &sn, &cs); pwr[p] = mg * cs; pwi[p] = mg * sn; }
                { const float mg = expf((float)(j + 1) * lr * dt); sincosf((float)(j + 1) * (li * dt), &sn, &cs); p1r[p] = mg * cs; p1i[p] = mg * sn; }
                { const float mg = expf(lr * dt); sincosf(li * dt, &sn, &cs); const float nr = mg * cs - 1.0f, ni = mg * sn, den = lr * lr + li * li;
                  ffr[p] = (nr * lr + ni * li) / den; ffi[p] = (ni * lr - nr * li) / den; } }
            __syncthreads();
            for (int idx = F.tid; idx < 1024; idx += NTHR) { const int p = idx >> 4; const float br = b_re[g * 1024 + idx], bi = b_im[g * 1024 + idx];
                bbr[idx] = ffr[p] * br - ffi[p] * bi; bbi[idx] = ffr[p] * bi + ffi[p] * br;
                ccr[idx] = c_re[g * 1024 + idx]; cci[idx] = c_im[g * 1024 + idx]; }
            __syncthreads();
            if (F.tid < 256) { const int co = F.tid >> 4, ci = F.tid & 15; float s = 0.f;
                for (int p = 0; p < 64; ++p) { const float zr = pwr[p] * bbr[p * 16 + ci] - pwi[p] * bbi[p * 16 + ci], zi = pwr[p] * bbi[p * 16 + ci] + pwi[p] * bbr[p * 16 + ci];
                    s += ccr[co * 64 + p] * zr - cci[co * 64 + p] * zi; }
                if (j == 0 && co == ci) s += dsk[g * 16 + co];
                kj[F.tid] = s; }
            __syncthreads();
            for (int idx = F.tid; idx < (S5L - j) * 128; idx += NTHR) { const int t = j + idx / 128, rem = idx % 128, co = rem >> 3, ci = (rem & 7) * 2;
                toep[((size_t)(g * 512 + t * 16 + co) * LDU + (t - j) * 16 + ci) / 2] = cvt_pk_bf16(kj[co * 16 + ci], kj[co * 16 + ci + 1]);
                if (j > 0) toep[((size_t)(g * 512 + (t - j) * 16 + co) * LDU + t * 16 + ci) / 2] = 0u; }
            for (int idx = F.tid; idx < 16 * 64; idx += NTHR) { const int co = idx >> 6, q = (idx & 63) * 2; float o[2];
#pragma unroll
                for (int e = 0; e < 2; ++e) { const int qq = q + e, p = qq & 63; const float cr = ccr[co * 64 + p], cim = cci[co * 64 + p];
                    o[e] = (qq < 64) ? (cr * p1r[p] - cim * p1i[p]) : -(cr * p1i[p] + cim * p1r[p]); }
                toep[((size_t)(g * 512 + j * 16 + co) * LDU + 512 + q) / 2] = cvt_pk_bf16(o[0], o[1]); }
            { const int s = S5L - 1 - j;
              for (int idx = F.tid; idx < 256 * 8; idx += NTHR) { const int q = idx >> 3, ci = (idx & 7) * 2; float o[2] = {0.f, 0.f};
                if (q < 128) { const int p = q & 63;
#pragma unroll
                    for (int e = 0; e < 2; ++e) { const float br = bbr[p * 16 + ci + e], bi = bbi[p * 16 + ci + e];
                        o[e] = (q < 64) ? (pwr[p] * br - pwi[p] * bi) : (pwr[p] * bi + pwi[p] * br); } }
                wst[((size_t)(g * 256 + q) * 512 + s * 16 + ci) / 2] = cvt_pk_bf16(o[0], o[1]); } }
            __syncthreads();
        }
    }
    if (!(F.bid & 1)) rmsnorm_rows(F, F.in[0], F.in[1], (bf16_t*)(ws + WS_XN), 0, T);
}

DI void p_rw_prep(const Frame& F) {
    const bf16_t* prw = (const bf16_t*)(F.ws + WS_PRW); bf16_t* al_ = (bf16_t*)(F.ws + WS_ALORA); const float* mu = F.in[13];
    for (int idx = F.bid * NTHR + F.tid; idx < T * 32; idx += F.G * NTHR) {
        const int t = idx >> 5, c8 = (idx & 31) * 8;
        const u32x4 cur = *(const u32x4*)(prw + (size_t)t * RWC + 1536 + c8);
        u32x4 prv = (u32x4){0u, 0u, 0u, 0u};
        if ((t & (SEQ - 1)) != 0) prv = *(const u32x4*)(prw + (size_t)(t - 1) * RWC + 1536 + c8);
        float o[8];
#pragma unroll
        for (int j = 0; j < 8; ++j) { const float c = (j & 1) ? bf_hi(cur[j >> 1]) : bf_lo(cur[j >> 1]), p = (j & 1) ? bf_hi(prv[j >> 1]) : bf_lo(prv[j >> 1]);
            const float xs = c + mu[1536 + c8 + j] * (p - c);
            o[j] = (c8 < 64) ? ftanh(xs) : ((c8 < 128) ? xs : fsigmoid(xs)); }
        u32x4 w; w.x = cvt_pk_bf16(o[0], o[1]); w.y = cvt_pk_bf16(o[2], o[3]); w.z = cvt_pk_bf16(o[4], o[5]); w.w = cvt_pk_bf16(o[6], o[7]);
        *(u32x4*)(al_ + (size_t)t * 256 + c8) = w;
    }
}

DI void p_s5_carry(const Frame& F) {
    const float* lam_re = F.in[3]; const float* lam_im = F.in[4]; const float* log_dt = F.in[5];
    const float* sloc = (const float*)(F.ws + WS_SLOC); bf16_t* us5 = (bf16_t*)(F.ws + WS_US5);
    for (int gt = F.bid * NTHR + F.tid; gt < NB * 32 * 64; gt += F.G * NTHR) {
        const int p = gt & 63, g = (gt >> 6) & 31, b = gt >> 11;
        const float lr = lam_re[g * 64 + p], li = lam_im[g * 64 + p], dt = __expf(log_dt[g]);
        float sn, cs; const float mg = expf((float)S5L * lr * dt); sincosf((float)S5L * (li * dt), &sn, &cs);
        const float ar = mg * cs, ai = mg * sn;
        float xr = 0.f, xi = 0.f;
        const size_t row0 = (size_t)g * S5ROWS + (size_t)b * S5NC;
        for (int cb = 0; cb < S5NC; cb += 16) {
            float sr[16], si[16];
#pragma unroll
            for (int j = 0; j < 16; ++j) { sr[j] = sloc[(row0 + cb + j) * 128 + p]; si[j] = sloc[(row0 + cb + j) * 128 + 64 + p]; }
#pragma unroll
            for (int j = 0; j < 16; ++j) { const size_t row = row0 + cb + j;
                us5[row * LDU + 512 + p] = f2bf(xr); us5[row * LDU + 576 + p] = f2bf(xi);
                const float nr = ar * xr - ai * xi + sr[j], ni = ar * xi + ai * xr + si[j];
                xr = nr; xi = ni; }
        }
    }
}

constexpr int PT = 72, SLOTB = 64 * PT * 2;
DI LAS bf16_t* rslot(LAS unsigned char* lds, int i) { return (LAS bf16_t*)(lds + i * SLOTB); }
DI void mm_acc(f32x4 (&acc)[2], const LAS bf16_t* A, const LAS bf16_t* Bt, int ti, int tj0, int r, int q) {
#pragma unroll
    for (int s2 = 0; s2 < 2; ++s2) {
        const bf16x8 a = *(const LAS bf16x8*)(A + (16 * ti + r) * PT + 32 * s2 + 8 * q);
#pragma unroll
        for (int e = 0; e < 2; ++e) { const bf16x8 b = *(const LAS bf16x8*)(Bt + (16 * (tj0 + e) + r) * PT + 32 * s2 + 8 * q);
            acc[e] = __builtin_amdgcn_mfma_f32_16x16x32_bf16(a, b, acc[e], 0, 0, 0); }
    }
}
DI void mm_acc_bnat(f32x4 (&acc)[2], const LAS bf16_t* A, const LAS bf16_t* Bn, int ti, int tj0, int r, int q) {
#pragma unroll
    for (int s2 = 0; s2 < 2; ++s2) {
        const bf16x8 a = *(const LAS bf16x8*)(A + (16 * ti + r) * PT + 32 * s2 + 8 * q);
#pragma unroll
        for (int e = 0; e < 2; ++e) { bf16x8 b;
#pragma unroll
            for (int jj = 0; jj < 8; ++jj) b[jj] = (short)Bn[(32 * s2 + 8 * q + jj) * PT + 16 * (tj0 + e) + r];
            acc[e] = __builtin_amdgcn_mfma_f32_16x16x32_bf16(a, b, acc[e], 0, 0, 0); }
    }
}
DI void st_rm(LAS bf16_t* Dm, const f32x4& v, int i0, int j) {
#pragma unroll
    for (int g = 0; g < 4; ++g) Dm[(i0 + g) * PT + j] = f2bf(v[g]);
}
DI void st_tr(LAS bf16_t* Dm, const f32x4& v, int i0, int j) { u32x2 w; w.x = cvt_pk_bf16(v[0], v[1]); w.y = cvt_pk_bf16(v[2], v[3]); *(LAS u32x2*)(Dm + j * PT + i0) = w; }
DI f32x4 ld_rm(const LAS bf16_t* Sm, int i0, int j) { f32x4 v;
#pragma unroll
    for (int g = 0; g < 4; ++g) v[g] = bf2f(Sm[(i0 + g) * PT + j]);
    return v; }
DI void ld_frag(bf16x8 (&f)[2], const LAS bf16_t* M, int row, int q) { f[0] = *(const LAS bf16x8*)(M + row * PT + 8 * q); f[1] = *(const LAS bf16x8*)(M + row * PT + 32 + 8 * q); }
DI f32x4 mm2(const bf16x8 (&x)[2], const bf16x8 (&y)[2], f32x4 c) { c = __builtin_amdgcn_mfma_f32_16x16x32_bf16(x[0], y[0], c, 0, 0, 0); return __builtin_amdgcn_mfma_f32_16x16x32_bf16(x[1], y[1], c, 0, 0, 0); }
typedef short v4i16_t __attribute__((ext_vector_type(4)));
DI void ld_frag_tr(bf16x8 (&f)[2], const LAS bf16_t* XT, int T0, int r, int q) {
#pragma unroll
    for (int s2 = 0; s2 < 2; ++s2) { const LAS bf16_t* p = XT + (32 * s2 + 8 * q + (r >> 2)) * PT + T0 + 4 * (r & 3);
        const v4i16_t lo = __builtin_amdgcn_ds_read_tr16_b64_v4i16((LAS v4i16_t*)p), hi = __builtin_amdgcn_ds_read_tr16_b64_v4i16((LAS v4i16_t*)(p + 4 * PT));
        f[s2] = __builtin_shufflevector(lo, hi, 0, 1, 2, 3, 4, 5, 6, 7); }
}
DI void st_sw(LAS bf16_t* Dm, const f32x4& v, int i, int j0) { u32x2 w; w.x = cvt_pk_bf16(v[0], v[1]); w.y = cvt_pk_bf16(v[2], v[3]); *(LAS u32x2*)(Dm + i * PT + j0) = w; }
DI f32x4 ld_sw(const LAS bf16_t* Sm, int i, int j0) { const u32x2 w = *(const LAS u32x2*)(Sm + i * PT + j0); return (f32x4){bf_lo(w.x), bf_hi(w.x), bf_lo(w.y), bf_hi(w.y)}; }
#define ZACC(a) do { a[0] = (f32x4){0.f, 0.f, 0.f, 0.f}; a[1] = (f32x4){0.f, 0.f, 0.f, 0.f}; } while (0)

DI float wave_sum2(float v) { return xrow_sum(row_sum16(v)); }
#define LSYNC() do { asm volatile("s_waitcnt lgkmcnt(0)" ::: "memory"); __builtin_amdgcn_s_barrier(); asm volatile("" ::: "memory"); } while (0)

struct RaRaw { bf16_t r[9], k[9], v[9], lw[8], a[8]; };
DI void ra_load(RaRaw& x, const bf16_t* prw, const bf16_t* lwag, int ci, int w, int lane) {
    const int bh = ci >> 6, c = ci & 63, b = bh >> 3, h = bh & 7, ch = h * 64 + lane;
    const size_t tok0 = (size_t)b * SEQ + c * 64 + 8 * w;
    const bool has_prev = !(c == 0 && w == 0);
    const size_t tp = has_prev ? tok0 - 1 : tok0;
    x.r[0] = prw[tp * RWC + ch]; x.k[0] = prw[tp * RWC + 512 + ch]; x.v[0] = prw[tp * RWC + 1024 + ch];
#pragma unroll
    for (int i = 0; i < 8; ++i) { const size_t tok = tok0 + i;
        x.r[i + 1] = prw[tok * RWC + ch]; x.k[i + 1] = prw[tok * RWC + 512 + ch]; x.v[i + 1] = prw[tok * RWC + 1024 + ch];
        x.lw[i] = lwag[tok * 1536 + ch]; x.a[i] = lwag[tok * 1536 + 512 + ch]; }
}
DI void p_rw_chunk(const Frame& F) {
    const bf16_t* prw = (const bf16_t*)(F.ws + WS_PRW); const bf16_t* lwag = (const bf16_t*)(F.ws + WS_LWAG);
    const float* mu = F.in[13]; const float* k_k = F.in[19]; const float* k_a = F.in[20]; const float* r_k = F.in[21];
    float* bonus = (float*)(F.ws + WS_BONUS);
    bf16_t* gM = (bf16_t*)(F.ws + WS_CHK_M); bf16_t* gN0T = (bf16_t*)(F.ws + WS_CHK_N0T); bf16_t* gQ = (bf16_t*)(F.ws + WS_CHK_Q); bf16_t* gY0 = (bf16_t*)(F.ws + WS_CHK_Y0T);
    LAS unsigned char* lds = F.lds;
    LAS float* segtot = (LAS float*)(lds + 14 * SLOTB);
    LAS float* PLs = segtot + 512;
    LAS float* DB = PLs + 64;
    constexpr int PD = 20;
    constexpr int TP = 24;
    LAS bf16_t* TDT = (LAS bf16_t*)(DB + 64 * PD);
    const int w = F.wave, lane = F.lane, r = lane & 15, q = lane >> 4, ti = w >> 1, tj0 = 2 * (w & 1), i0 = 16 * ti + 4 * q;
    LAS bf16_t* S0 = rslot(lds, 0); LAS bf16_t* S1 = rslot(lds, 1); LAS bf16_t* S2 = rslot(lds, 2); LAS bf16_t* S3 = rslot(lds, 3);
    LAS bf16_t* S4 = rslot(lds, 4); LAS bf16_t* S5 = rslot(lds, 5); LAS bf16_t* S6 = rslot(lds, 6); LAS bf16_t* S7 = rslot(lds, 7);
    LAS bf16_t* S8 = rslot(lds, 8); LAS bf16_t* S9 = rslot(lds, 9); LAS bf16_t* S10 = rslot(lds, 10); LAS bf16_t* S11 = rslot(lds, 11);
    LAS bf16_t* S12 = rslot(lds, 12); LAS bf16_t* S13 = rslot(lds, 13);
    RaRaw raw;
    if (F.bid < RW_NCH) ra_load(raw, prw, lwag, F.bid, w, lane);
    for (int ci = F.bid; ci < RW_NCH; ci += F.G) {
        const int bh = ci >> 6, c = ci & 63, b = bh >> 3, h = bh & 7, ch = h * 64 + lane;
        {
            const size_t tok0 = (size_t)b * SEQ + c * 64 + 8 * w;
            const float mur = mu[ch], muk = mu[512 + ch], muv = mu[1024 + ch], kkw = k_k[ch], ka = k_a[ch], rk = r_k[ch];
            const bool has_prev = !(c == 0 && w == 0);
            float xr[9], xk[9], xv[9];
            xr[0] = has_prev ? bf2f(raw.r[0]) : 0.f; xk[0] = has_prev ? bf2f(raw.k[0]) : 0.f; xv[0] = has_prev ? bf2f(raw.v[0]) : 0.f;
#pragma unroll
            for (int i = 1; i < 9; ++i) { xr[i] = bf2f(raw.r[i]); xk[i] = bf2f(raw.k[i]); xv[i] = bf2f(raw.v[i]); }
            f32x2 rr2[4], vv2[4], aa2[4], km2[4], kn2[4], sq2[4], bq2[4]; float cl[8];
            float run = 0.f;
#pragma unroll
            for (int p2 = 0; p2 < 4; ++p2) {
                const f32x2 cr = {xr[2 * p2 + 1], xr[2 * p2 + 2]}, pr = {xr[2 * p2], xr[2 * p2 + 1]};
                const f32x2 ck = {xk[2 * p2 + 1], xk[2 * p2 + 2]}, pk = {xk[2 * p2], xk[2 * p2 + 1]};
                const f32x2 cv = {xv[2 * p2 + 1], xv[2 * p2 + 2]}, pv = {xv[2 * p2], xv[2 * p2 + 1]};
                const f32x2 r_ = cr + (pr - cr) * mur, k_ = ck + (pk - ck) * muk, v_ = cv + (pv - cv) * muv;
                const f32x2 a_ = {bf2f(raw.a[2 * p2]), bf2f(raw.a[2 * p2 + 1])};
                const f32x2 kx = k_ * kkw; sq2[p2] = kx * kx;
                const f32x2 kmod = k_ * (a_ * ka + (1.0f - ka));
                bq2[p2] = (r_ * kmod) * rk;
                rr2[p2] = r_; vv2[p2] = v_; aa2[p2] = a_; km2[p2] = kmod; kn2[p2] = kx;
                run += bf2f(raw.lw[2 * p2]); cl[2 * p2] = run; run += bf2f(raw.lw[2 * p2 + 1]); cl[2 * p2 + 1] = run;
            }
            {
                float A8[8], B4[4], C2[2];
#pragma unroll
                for (int k = 0; k < 4; ++k) { A8[k] = comb32(sq2[k].x, sq2[k].y); A8[4 + k] = comb32(bq2[k].x, bq2[k].y); }
#pragma unroll
                for (int j = 0; j < 4; ++j) B4[j] = comb16(A8[2 * j], A8[2 * j + 1]);
#pragma unroll
                for (int i = 0; i < 2; ++i) { const float t1 = DPP_ADD(B4[2 * i], 0x128), t2 = DPP_ADD(B4[2 * i + 1], 0x128); C2[i] = (lane & 8) ? t2 : t1; }
                const float u1 = DPP_ADD(C2[0], 0x141), u2 = DPP_ADD(C2[1], 0x141);
                float dsum = (lane & 4) ? u2 : u1;
                dsum = DPP_ADD(dsum, 0xB1); dsum = DPP_ADD(dsum, 0x4E);
                if ((lane & 7) == 4) bonus[(tok0 + 4 * ((lane >> 3) & 1) + 2 * ((lane >> 4) & 1) + (lane >> 5)) * 8 + h] = dsum;
                const float rsv = fminf(__builtin_amdgcn_rsqf(dsum), 1e12f);
                const int rsi = __builtin_bit_cast(int, rsv);
                float rs[8];
#pragma unroll
                for (int tt = 0; tt < 8; ++tt) rs[tt] = __builtin_bit_cast(float, __builtin_amdgcn_readlane(rsi, 8 * (tt >> 2) + 16 * ((tt >> 1) & 1) + 32 * (tt & 1)));
#pragma unroll
                for (int p2 = 0; p2 < 4; ++p2) kn2[p2] = kn2[p2] * (f32x2){rs[2 * p2], rs[2 * p2 + 1]};
            }
            segtot[w * 64 + lane] = run;
            LSYNC();
            float pre = 0.f;
            for (int w2 = 0; w2 < w; ++w2) pre += segtot[w2 * 64 + lane];
            if (w == 7) PLs[lane] = __expf(pre + run);
            float ep = __expf(pre);
            unsigned xa[4], xb[4], xkk[4], xrr[4], xvv[4];
#pragma unroll
            for (int p2 = 0; p2 < 4; ++p2) {
                const f32x2 tt = ((f32x2){cl[2 * p2], cl[2 * p2 + 1]} + pre) * 1.44269504f;
                const f32x2 e = {__builtin_amdgcn_exp2f(tt.x), __builtin_amdgcn_exp2f(tt.y)}, en = {__builtin_amdgcn_rcpf(e.x), __builtin_amdgcn_rcpf(e.y)}, epv = {ep, e.x};
                ep = e.y;
                const f32x2 at = -(kn2[p2] * epv), bt = (kn2[p2] * aa2[p2]) * en, kt = km2[p2] * en, rt = rr2[p2] * e;
                xa[p2] = cvt_pk_bf16(at.x, at.y); xb[p2] = cvt_pk_bf16(bt.x, bt.y); xkk[p2] = cvt_pk_bf16(kt.x, kt.y); xrr[p2] = cvt_pk_bf16(rt.x, rt.y); xvv[p2] = cvt_pk_bf16(vv2[p2].x, vv2[p2].y);
                const int t = 8 * w + 2 * p2;
                S6[t * PT + lane] = (bf16_t)(xrr[p2] & 0xffffu); S6[(t + 1) * PT + lane] = (bf16_t)(xrr[p2] >> 16);
            }
            *(LAS u32x4*)(S1 + lane * PT + 8 * w) = (u32x4){xa[0], xa[1], xa[2], xa[3]};
            *(LAS u32x4*)(S3 + lane * PT + 8 * w) = (u32x4){xb[0], xb[1], xb[2], xb[3]};
            *(LAS u32x4*)(S5 + lane * PT + 8 * w) = (u32x4){xkk[0], xkk[1], xkk[2], xkk[3]};
            *(LAS u32x4*)(S7 + lane * PT + 8 * w) = (u32x4){xvv[0], xvv[1], xvv[2], xvv[3]};
        }
        LSYNC();
        if (ci + F.G < RW_NCH) ra_load(raw, prw, lwag, ci + F.G, w, lane);
        f32x4 acc[2];
        const f32x4 Z4 = (f32x4){0.f, 0.f, 0.f, 0.f};
        const int ia = 16 * ti + r, jb0 = 16 * tj0 + r;
        { bf16x8 a0[2], a6[2], b2[2][2], b4[2][2];
          ld_frag_tr(a0, S1, 16 * ti, r, q); ld_frag(a6, S6, ia, q);
#pragma unroll
          for (int e = 0; e < 2; ++e) { ld_frag_tr(b2[e], S3, 16 * (tj0 + e), r, q); ld_frag_tr(b4[e], S5, 16 * (tj0 + e), r, q); }
#pragma unroll
          for (int e = 0; e < 2; ++e) { const int tj = tj0 + e, j = 16 * tj + r, js = 16 * tj + 4 * q;
            const f32x4 c = mm2(a0, b2[e], Z4);
            if (tj == ti) {
#pragma unroll
                for (int g = 0; g < 4; ++g) DB[(ti * 16 + 4 * q + g) * PD + r] = (4 * q + g > r) ? c[g] : 0.f;
            }
            st_tr(S8, (ti > tj) ? c : Z4, i0, j);
            f32x4 v = mm2(b4[e], a0, Z4);
#pragma unroll
            for (int g = 0; g < 4; ++g) v[g] = (ia > js + g) ? v[g] : 0.f;
            st_sw(S9, v, ia, js);
            v = mm2(b2[e], a6, Z4);
#pragma unroll
            for (int g = 0; g < 4; ++g) v[g] = (ia >= js + g) ? v[g] : 0.f;
            st_sw(S10, v, ia, js);
            v = mm2(b4[e], a6, Z4);
#pragma unroll
            for (int g = 0; g < 4; ++g) v[g] = (ia >= js + g) ? v[g] : 0.f;
            st_sw(S11, v, ia, js); } }
        LSYNC();
        ZACC(acc); mm_acc(acc, S9, S7, ti, tj0, r, q);
#pragma unroll
        for (int e = 0; e < 2; ++e) st_tr(S2, acc[e], i0, 16 * (tj0 + e) + r);
        if (w < 4) {
            const int i = lane >> 2, p = lane & 3;
            int io = i; asm volatile("" : "+v"(io));
            const LAS float* Dp = DB + (w * 16 + p) * PD;
            f32x4 Dm[4][4];
#pragma unroll
            for (int m = 0; m < 4; ++m)
#pragma unroll
                for (int c4 = 0; c4 < 4; ++c4) Dm[m][c4] = *(const LAS f32x4*)(Dp + 4 * m * PD + 4 * c4);
            float mine[4] = {0.f, 0.f, 0.f, 0.f}, tr[16];
#pragma unroll
            for (int j = 15; j >= 0; --j) { float part = 0.f;
#pragma unroll
                for (int m = 3; m >= 0; --m) if (4 * m + 3 > j) part = __builtin_fmaf(mine[m], Dm[m][j >> 2][j & 3], part);
                float tot = part + __builtin_bit_cast(float, __builtin_amdgcn_update_dpp(0, __builtin_bit_cast(int, part), 0xB1, 0xf, 0xf, false));
                tot = tot + __builtin_bit_cast(float, __builtin_amdgcn_update_dpp(0, __builtin_bit_cast(int, tot), 0x4E, 0xf, 0xf, false));
                const float trj = (j == io) ? 1.0f : tot;
                tr[j] = trj; mine[j >> 2] = (p == (j & 3)) ? trj : mine[j >> 2]; }
            u32x4 z = (u32x4){0u, 0u, 0u, 0u}, x0, x1;
            x0.x = cvt_pk_bf16(tr[0], tr[1]); x0.y = cvt_pk_bf16(tr[2], tr[3]); x0.z = cvt_pk_bf16(tr[4], tr[5]); x0.w = cvt_pk_bf16(tr[6], tr[7]);
            x1.x = cvt_pk_bf16(tr[8], tr[9]); x1.y = cvt_pk_bf16(tr[10], tr[11]); x1.z = cvt_pk_bf16(tr[12], tr[13]); x1.w = cvt_pk_bf16(tr[14], tr[15]);
            LAS bf16_t* dst = S0 + (16 * w + i) * PT + 16 * p;
            *(LAS u32x4*)dst = (p == w) ? x0 : z; *(LAS u32x4*)(dst + 8) = (p == w) ? x1 : z;
#pragma unroll
            for (int m = 0; m < 4; ++m) TDT[(16 * w + 4 * m + p) * TP + i] = f2bf(mine[m]);
        }
        LSYNC();
        { bf16x8 a[2], b[2][2]; ld_frag(a, S0, ia, q);
#pragma unroll
          for (int e = 0; e < 2; ++e) ld_frag(b[e], S8, jb0 + 16 * e, q);
#pragma unroll
          for (int e = 0; e < 2; ++e) { st_tr(S12, mm2(a, b[e], Z4), i0, 16 * (tj0 + e) + r); st_sw(S4, mm2(b[e], a, Z4), ia, 16 * (tj0 + e) + 4 * q); } }
        LSYNC();
        { bf16x8 a[2], b[2][2]; ld_frag(a, S4, ia, q);
#pragma unroll
          for (int e = 0; e < 2; ++e) ld_frag(b[e], S12, jb0 + 16 * e, q);
          const bf16x8 as = (w & 1) ? a[1] : a[0];
#pragma unroll
          for (int e = 0; e < 2; ++e) { const int tj = tj0 + e, j = 16 * tj + r, js = 16 * tj + 4 * q;
            st_sw(S13, mm2(b[e], a, Z4), ia, js);
            bf16x8 bt = *(const LAS bf16x8*)(TDT + j * TP + 8 * (q & 1));
            if ((q >> 1) != e) bt = (bf16x8){0, 0, 0, 0, 0, 0, 0, 0};
            f32x4 c = Z4;
            if (ti == tj) { const u32x2 wv = *(const LAS u32x2*)(TDT + j * TP + 4 * q); c = (f32x4){bf_lo(wv.x), bf_hi(wv.x), bf_lo(wv.y), bf_hi(wv.y)}; }
            st_tr(S9, __builtin_amdgcn_mfma_f32_16x16x32_bf16(as, bt, c, 0, 0, 0), i0, j);
            st_sw(S8, __builtin_amdgcn_mfma_f32_16x16x32_bf16(bt, as, ld_sw(S0, ia, js), 0, 0, 0), ia, js); } }
        LSYNC();
        { bf16x8 a[2], b[2][2]; ld_frag(a, S13, ia, q);
#pragma unroll
          for (int e = 0; e < 2; ++e) ld_frag(b[e], S9, jb0 + 16 * e, q);
#pragma unroll
          for (int e = 0; e < 2; ++e) { const int js = 16 * (tj0 + e) + 4 * q; st_sw(S12, mm2(b[e], a, ld_sw(S8, ia, js)), ia, js); } }
        LSYNC();
        { bf16x8 a[2], b1[2][2], bx[2][2]; ld_frag(a, S12, ia, q);
#pragma unroll
          for (int e = 0; e < 2; ++e) { ld_frag(b1[e], S1, jb0 + 16 * e, q); ld_frag(bx[e], S2, jb0 + 16 * e, q); }
#pragma unroll
          for (int e = 0; e < 2; ++e) { const int j = 16 * (tj0 + e) + r; st_tr(S0, mm2(a, b1[e], Z4), i0, j); st_tr(S4, mm2(a, bx[e], Z4), i0, j); } }
        LSYNC();
        { bf16x8 a10[2], a11[2], a3[2], a5[2], b0[2][2], b4[2][2], b7[2][2];
          ld_frag(a10, S10, ia, q); ld_frag(a11, S11, ia, q); ld_frag(a3, S3, ia, q); ld_frag(a5, S5, ia, q);
#pragma unroll
          for (int e = 0; e < 2; ++e) { ld_frag(b0[e], S0, jb0 + 16 * e, q); ld_frag(b4[e], S4, jb0 + 16 * e, q); ld_frag(b7[e], S7, jb0 + 16 * e, q); }
          const float pli = PLs[ia];
          f32x4 plg;
#pragma unroll
          for (int g = 0; g < 4; ++g) plg[g] = PLs[i0 + g];
#pragma unroll
          for (int e = 0; e < 2; ++e) { const int j = 16 * (tj0 + e) + r, js = 16 * (tj0 + e) + 4 * q;
            const f32x4 vq = mm2(b0[e], a10, ld_sw(S6, ia, js));
            const f32x4 vy = mm2(b7[e], a11, mm2(b4[e], a10, Z4));
            f32x4 vm = mm2(b0[e], a3, Z4);
#pragma unroll
            for (int g = 0; g < 4; ++g) vm[g] = pli * (vm[g] + ((ia == js + g) ? 1.0f : 0.f));
            const f32x4 vn = mm2(a5, b7[e], mm2(a3, b4[e], Z4)) * plg;
            st_sw(S1, vq, ia, js); st_sw(S2, vy, ia, js); st_sw(S8, vm, ia, js); st_tr(S9, vn, i0, j); } }
        LSYNC();
        { const int row = F.tid >> 3, seg = (F.tid & 7) * 8; const size_t go = (size_t)ci * 4096 + row * 64 + seg;
          *(u32x4*)(gQ + go) = *(const LAS u32x4*)(S1 + row * PT + seg); *(u32x4*)(gY0 + go) = *(const LAS u32x4*)(S2 + row * PT + seg);
          *(u32x4*)(gM + go) = *(const LAS u32x4*)(S8 + row * PT + seg); *(u32x4*)(gN0T + go) = *(const LAS u32x4*)(S9 + row * PT + seg); }
        LSYNC();
    }
    asm volatile("s_waitcnt vmcnt(0)" ::: "memory");
}

struct ScanOps { u32x2 m[4][2][2]; u32x2 n0[4]; };
DI void scan_load(ScanOps& o, const bf16_t* gM, const bf16_t* gN0T, size_t ci, int col, int q, int v) {
#pragma unroll
    for (int m = 0; m < 4; ++m) {
#pragma unroll
        for (int s2 = 0; s2 < 2; ++s2) { const bf16_t* p = gM + ci * 4096 + (16 * m + col) * 64 + 32 * s2 + 4 * q; o.m[m][s2][0] = *(const u32x2*)p; o.m[m][s2][1] = *(const u32x2*)(p + 16); }
        o.n0[m] = *(const u32x2*)(gN0T + ci * 4096 + v * 64 + 16 * m + 4 * q); }
}
DI void scan_step(const ScanOps& o, f32x4 (&H)[4], bf16_t* gHT, size_t ci, int q, int v) {
    u32x4 bfr[2];
#pragma unroll
    for (int s2 = 0; s2 < 2; ++s2) { bfr[s2].x = cvt_pk_bf16(H[2 * s2][0], H[2 * s2][1]); bfr[s2].y = cvt_pk_bf16(H[2 * s2][2], H[2 * s2][3]);
        bfr[s2].z = cvt_pk_bf16(H[2 * s2 + 1][0], H[2 * s2 + 1][1]); bfr[s2].w = cvt_pk_bf16(H[2 * s2 + 1][2], H[2 * s2 + 1][3]);
        bf16_t* hp = gHT + ci * 4096 + v * 64 + 32 * s2 + 4 * q;
        *(u32x2*)hp = (u32x2){bfr[s2].x, bfr[s2].y}; *(u32x2*)(hp + 16) = (u32x2){bfr[s2].z, bfr[s2].w}; }
#pragma unroll
    for (int m = 0; m < 4; ++m) {
        f32x4 a2 = (f32x4){bf_lo(o.n0[m].x), bf_hi(o.n0[m].x), bf_lo(o.n0[m].y), bf_hi(o.n0[m].y)};
#pragma unroll
        for (int s2 = 0; s2 < 2; ++s2) { const u32x4 af = (u32x4){o.m[m][s2][0].x, o.m[m][s2][0].y, o.m[m][s2][1].x, o.m[m][s2][1].y};
            a2 = __builtin_amdgcn_mfma_f32_16x16x32_bf16(__builtin_bit_cast(bf16x8, af), __builtin_bit_cast(bf16x8, bfr[s2]), a2, 0, 0, 0); }
        H[m] = a2; }
}
constexpr int SC_DEPTH = 10, SC_SLOT = 12288;
DI void scan_dma(unsigned lds_dst, unsigned voff, const char* base) { asm volatile("s_mov_b32 m0, %0\n\ts_nop 0\n\tglobal_load_lds_dwordx4 %1, %2" :: "s"(lds_dst), "v"(voff), "s"(base) : "memory"); }
DI void scan_lds_load(ScanOps& o, const LAS unsigned char* slot, int lbM, int lbN, const int (&xo)[2][2], int c7) {
#pragma unroll
    for (int m = 0; m < 4; ++m) {
#pragma unroll
        for (int s2 = 0; s2 < 2; ++s2) { o.m[m][s2][0] = *(const LAS u32x2*)(slot + lbM + m * 2048 + xo[s2][0]); o.m[m][s2][1] = *(const LAS u32x2*)(slot + lbM + m * 2048 + xo[s2][1]); }
        o.n0[m] = *(const LAS u32x2*)(slot + 8192 + lbN + (((2 * m) << 4) ^ c7)); }
}
DI void p_rw_scan(const Frame& F) {
    const bf16_t* gM = (const bf16_t*)(F.ws + WS_CHK_M); const bf16_t* gN0T = (const bf16_t*)(F.ws + WS_CHK_N0T); bf16_t* gHT = (bf16_t*)(F.ws + WS_CHK_HT);
    const unsigned ldsbase = (unsigned)(size_t)F.lds;
    const int w = F.wave, col = F.lane & 15, q = F.lane >> 4;
    const int lw = w - 2, lt = F.tid - 128;
    const int P1 = (384 + lt) & 511;
    const unsigned voff0 = (unsigned)((lt >> 3) * 128 + (((lt & 7) ^ ((lt >> 3) & 7)) << 4));
    const unsigned voff1 = (unsigned)((P1 >> 3) * 128 + (((P1 & 7) ^ ((P1 >> 3) & 7)) << 4));
    const int c7 = (col & 7) << 4, qh = (q >> 1) << 4;
    const int lbM = col * 128 + 8 * (q & 1), lbN = (16 * (w & 1) + col) * 128 + 8 * (q & 1);
    int xo[2][2];
#pragma unroll
    for (int s2 = 0; s2 < 2; ++s2)
#pragma unroll
        for (int h = 0; h < 2; ++h) xo[s2][h] = (((4 * s2 + 2 * h) << 4) + qh) ^ c7;
    const int c7n = c7 ^ qh;
    for (int p = F.bid; p < 256; p += F.G) {
        const int bh = p >> 1, half = p & 1, v = 32 * half + 16 * (w & 1) + col;
        const size_t c0 = (size_t)bh * 64;
        const char* baseM = (const char*)(gM + c0 * 4096);
        const char* baseN = (const char*)(gN0T + c0 * 4096 + half * 2048);
        const char* base1 = (lw < 2) ? baseM : baseN;
#define SC_ISSUE(c, slot) do { if (w >= 2) { const unsigned _d = ldsbase + (unsigned)(slot) * SC_SLOT + (unsigned)lw * 1024u; \
            scan_dma(_d, voff0 + (unsigned)(c) * 8192u, baseM); scan_dma(_d + 6144u, voff1 + (unsigned)(c) * 8192u, base1); } } while (0)
#pragma unroll 1
        for (int c = 0; c < SC_DEPTH; ++c) SC_ISSUE(c, c);
        asm volatile("s_waitcnt vmcnt(0)" ::: "memory"); __builtin_amdgcn_s_barrier();
        f32x4 H[4];
#pragma unroll
        for (int m = 0; m < 4; ++m) H[m] = (f32x4){0.f, 0.f, 0.f, 0.f};
        ScanOps A, B;
        if (w < 2) scan_lds_load(A, F.lds, lbM, lbN, xo, c7n);
        int slot = 0;
#define SC_STEP(X, Y, c) do { \
            if (w < 2) asm volatile("s_waitcnt lgkmcnt(0)" ::: "memory"); else asm volatile("s_waitcnt vmcnt(16)" ::: "memory"); \
            __builtin_amdgcn_s_barrier(); \
            const int _sn = (slot + 1 == SC_DEPTH) ? 0 : slot + 1; \
            if (w < 2) scan_lds_load(Y, F.lds + _sn * SC_SLOT, lbM, lbN, xo, c7n); \
            { const int _cn = ((c) + SC_DEPTH < 64) ? (c) + SC_DEPTH : 63; SC_ISSUE(_cn, slot); } \
            if (w < 2) scan_step(X, H, gHT, c0 + (c), q, v); \
            slot = _sn; } while (0)
        static_assert(2 * (SC_DEPTH - 2) == 16, "vmcnt literal in SC_STEP");
#pragma unroll 1
        for (int c = 0; c < 64; c += 2) { SC_STEP(A, B, c); SC_STEP(B, A, c + 1); }
#undef SC_STEP
#undef SC_ISSUE
        asm volatile("s_waitcnt vmcnt(0)" ::: "memory"); __builtin_amdgcn_s_barrier();
    }
}

struct RcIn { bf16x8 qf[2], hb[4][2]; u32x2 y0[4], cv[4], pv[4], gw[4]; float bn; };
DI void rc_load(RcIn& x, const bf16_t* gQ, const bf16_t* gY0, const bf16_t* gHT, const bf16_t* prw, const bf16_t* lwag, const float* bonus, int item, int r, int q) {
    const int ci = item >> 2, ti = item & 3, bh = ci >> 6, c = ci & 63, b = bh >> 3, h = bh & 7;
    const size_t cb = (size_t)ci * 4096; const size_t tok = (size_t)b * SEQ + c * 64 + 16 * ti + r;
    const bool first = (tok & (SEQ - 1)) == 0; const size_t tp = first ? tok : tok - 1;
#pragma unroll
    for (int s2 = 0; s2 < 2; ++s2) x.qf[s2] = *(const bf16x8*)(gQ + cb + (16 * ti + r) * 64 + 32 * s2 + 8 * q);
#pragma unroll
    for (int n = 0; n < 4; ++n) { const int cch = h * 64 + 16 * n + 4 * q;
        x.y0[n] = *(const u32x2*)(gY0 + cb + (16 * ti + r) * 64 + 16 * n + 4 * q);
#pragma unroll
        for (int s2 = 0; s2 < 2; ++s2) x.hb[n][s2] = *(const bf16x8*)(gHT + cb + (16 * n + r) * 64 + 32 * s2 + 8 * q);
        x.cv[n] = *(const u32x2*)(prw + tok * RWC + 1024 + cch); x.pv[n] = *(const u32x2*)(prw + tp * RWC + 1024 + cch);
        x.gw[n] = *(const u32x2*)(lwag + tok * 1536 + 1024 + cch); }
    x.bn = bonus[tok * 8 + h];
}
DI void rc_compute(const RcIn& x, bf16_t* yrw, const float* mu, const float* ln_g, const float* ln_b, int item, int r, int q) {
    const int ci = item >> 2, ti = item & 3, bh = ci >> 6, c = ci & 63, b = bh >> 3, h = bh & 7;
    const size_t tok = (size_t)b * SEQ + c * 64 + 16 * ti + r; const bool first = (tok & (SEQ - 1)) == 0;
    f32x4 y[4];
#pragma unroll
    for (int n = 0; n < 4; ++n) { y[n] = (f32x4){bf_lo(x.y0[n].x), bf_hi(x.y0[n].x), bf_lo(x.y0[n].y), bf_hi(x.y0[n].y)};
#pragma unroll
        for (int s2 = 0; s2 < 2; ++s2) y[n] = __builtin_amdgcn_mfma_f32_16x16x32_bf16(x.hb[n][s2], x.qf[s2], y[n], 0, 0, 0); }
    float s1 = 0.f;
#pragma unroll
    for (int n = 0; n < 4; ++n) s1 += (y[n][0] + y[n][1]) + (y[n][2] + y[n][3]);
    s1 = xrow_sum(s1);
    const float mean = s1 * (1.0f / 64.0f);
    float s2 = 0.f;
#pragma unroll
    for (int n = 0; n < 4; ++n) { y[n] = y[n] - mean; s2 += (y[n][0] * y[n][0] + y[n][1] * y[n][1]) + (y[n][2] * y[n][2] + y[n][3] * y[n][3]); }
    s2 = xrow_sum(s2);
    const float rstd = rsqrtf(s2 * (1.0f / 64.0f) + 64e-5f);
#pragma unroll
    for (int n = 0; n < 4; ++n) { const int cch = h * 64 + 16 * n + 4 * q;
        const f32x4 muv = *(const f32x4*)(mu + 1024 + cch), lg = *(const f32x4*)(ln_g + cch), lb = *(const f32x4*)(ln_b + cch);
        const float cv[4] = {bf_lo(x.cv[n].x), bf_hi(x.cv[n].x), bf_lo(x.cv[n].y), bf_hi(x.cv[n].y)};
        const float pv[4] = {first ? 0.f : bf_lo(x.pv[n].x), first ? 0.f : bf_hi(x.pv[n].x), first ? 0.f : bf_lo(x.pv[n].y), first ? 0.f : bf_hi(x.pv[n].y)};
        const float gg[4] = {bf_lo(x.gw[n].x), bf_hi(x.gw[n].x), bf_lo(x.gw[n].y), bf_hi(x.gw[n].y)};
        float o[4];
#pragma unroll
        for (int g = 0; g < 4; ++g) { const float vsh = cv[g] + muv[g] * (pv[g] - cv[g]); o[g] = (y[n][g] * rstd * lg[g] + lb[g] + x.bn * vsh) * gg[g]; }
        u32x2 ow; ow.x = cvt_pk_bf16(o[0], o[1]); ow.y = cvt_pk_bf16(o[2], o[3]);
        *(u32x2*)(yrw + tok * 512 + cch) = ow; }
}
DI void p_rw_out(const Frame& F) {
    const bf16_t* gQ = (const bf16_t*)(F.ws + WS_CHK_Q); const bf16_t* gY0 = (const bf16_t*)(F.ws + WS_CHK_Y0T); const bf16_t* gHT = (const bf16_t*)(F.ws + WS_CHK_HT);
    const bf16_t* prw = (const bf16_t*)(F.ws + WS_PRW); const bf16_t* lwag = (const bf16_t*)(F.ws + WS_LWAG); const float* bonus = (const float*)(F.ws + WS_BONUS);
    bf16_t* yrw = (bf16_t*)(F.ws + WS_YRW);
    const float* mu = F.in[13]; const float* ln_g = F.in[22]; const float* ln_b = F.in[23];
    const int r = F.lane & 15, q = F.lane >> 4, stride = F.G * NWAVES, NIT = RW_NCH * 4;
    for (int item = F.bid * NWAVES + F.wave; item < NIT; item += 2 * stride) {
        const int item2 = (item + stride < NIT) ? item + stride : item;
        RcIn xa, xb;
        rc_load(xa, gQ, gY0, gHT, prw, lwag, bonus, item, r, q); rc_load(xb, gQ, gY0, gHT, prw, lwag, bonus, item2, r, q);
        rc_compute(xa, yrw, mu, ln_g, ln_b, item, r, q); rc_compute(xb, yrw, mu, ln_g, ln_b, item2, r, q);
    }
}

DI void p_moe_prep_rows(const Frame& F, int row0) {
    const bf16_t* hb = (const bf16_t*)(F.ws + WS_HB); float* rsv = (float*)(F.ws + WS_RS); unsigned char* out8 = (unsigned char*)(F.ws + WS_XN2F8); const float* g = F.in[26];
    for (int row = row0 + F.wave; row < row0 + BM; row += 2 * NWAVES) {
        const int row2 = row + NWAVES;
        u32x4 a[2], b[2];
        a[0] = *(const u32x4*)(hb + (size_t)row * D + F.lane * 16); a[1] = *(const u32x4*)(hb + (size_t)row * D + F.lane * 16 + 8);
        b[0] = *(const u32x4*)(hb + (size_t)row2 * D + F.lane * 16); b[1] = *(const u32x4*)(hb + (size_t)row2 * D + F.lane * 16 + 8);
        float v[16], u[16]; float ss = 0.f, su = 0.f;
#pragma unroll
        for (int j = 0; j < 8; ++j) { v[2 * j] = bf_lo(a[j >> 2][j & 3]); v[2 * j + 1] = bf_hi(a[j >> 2][j & 3]); u[2 * j] = bf_lo(b[j >> 2][j & 3]); u[2 * j + 1] = bf_hi(b[j >> 2][j & 3]); }
#pragma unroll
        for (int j = 0; j < 16; ++j) { ss += v[j] * v[j]; su += u[j] * u[j]; }
        ss = wave_sum(ss); su = wave_sum(su);
        const float rs = rsqrtf(ss * (1.0f / D) + 1e-5f), ru = rsqrtf(su * (1.0f / D) + 1e-5f);
        float gv[16];
#pragma unroll
        for (int q = 0; q < 4; ++q) { const f32x4 t = *(const f32x4*)(g + F.lane * 16 + q * 4); gv[4 * q] = t[0]; gv[4 * q + 1] = t[1]; gv[4 * q + 2] = t[2]; gv[4 * q + 3] = t[3]; }
#pragma unroll
        for (int j = 0; j < 16; ++j) { v[j] *= rs * gv[j]; u[j] *= ru * gv[j]; }
        u32x4 q0, q1;
        if (F.lane == 0) { rsv[row] = rs; rsv[row2] = ru; }
        q0.x = pk4_fp8(v[0] * F8_SX, v[1] * F8_SX, v[2] * F8_SX, v[3] * F8_SX); q0.y = pk4_fp8(v[4] * F8_SX, v[5] * F8_SX, v[6] * F8_SX, v[7] * F8_SX);
        q0.z = pk4_fp8(v[8] * F8_SX, v[9] * F8_SX, v[10] * F8_SX, v[11] * F8_SX); q0.w = pk4_fp8(v[12] * F8_SX, v[13] * F8_SX, v[14] * F8_SX, v[15] * F8_SX);
        q1.x = pk4_fp8(u[0] * F8_SX, u[1] * F8_SX, u[2] * F8_SX, u[3] * F8_SX); q1.y = pk4_fp8(u[4] * F8_SX, u[5] * F8_SX, u[6] * F8_SX, u[7] * F8_SX);
        q1.z = pk4_fp8(u[8] * F8_SX, u[9] * F8_SX, u[10] * F8_SX, u[11] * F8_SX); q1.w = pk4_fp8(u[12] * F8_SX, u[13] * F8_SX, u[14] * F8_SX, u[15] * F8_SX);
        *(u32x4*)(out8 + (size_t)row * D + F.lane * 16) = q0; *(u32x4*)(out8 + (size_t)row2 * D + F.lane * 16) = q1;
    }
}
DI void p_moe_b1p(const Frame& F) {
    float* b1p = (float*)(F.ws + WS_B1P); const float* b1 = F.in[30]; CmSwi cm;
    for (int idx = F.bid * NTHR + F.tid; idx < 32 * 2048; idx += F.G * NTHR) { const int e = idx >> 11, n = idx & 2047; b1p[idx] = b1[e * 2048 + cm(n)]; }
}
DI void p_conv_part(const Frame& F, int part) {
    if (part == 0) conv_T8(F, F.in[29], (size_t)1024 * 2048, 2048, (unsigned char*)(F.ws + WS_W1), 2048, 1024, 32, MpSwi(), F8_SW, 0, 2048);
    else if (part == 1) conv_T8(F, F.in[29], (size_t)1024 * 2048, 2048, (unsigned char*)(F.ws + WS_W1), 2048, 1024, 32, MpSwi(), F8_SW, 2048, 4096);
    else conv_T8(F, F.in[31], (size_t)1024 * 1024, 1024, (unsigned char*)(F.ws + WS_W2), 1024, 1024, 32, MpId(), F8_SW);
}

DI void topk_rows(const Frame& F, int row0) {
    LAS unsigned* cnt = (LAS unsigned*)F.lds; LAS unsigned* base = cnt + 32;
    const float* logits = (const float*)(F.ws + WS_LOG); unsigned* epos = (unsigned*)(F.ws + WS_EPOS); float* gatev = (float*)(F.ws + WS_GATEV);
    const int pass = row0 / TPP;
    unsigned* gcnt = (unsigned*)(F.ws + WS_CTL) + CW_GCNT + pass * 32;
    if (F.tid < 32) cnt[F.tid] = 0u;
    __syncthreads();
    int e4[4] = {0, 0, 0, 0}; unsigned p4[4] = {0u, 0u, 0u, 0u}; float g4[4] = {0.f, 0.f, 0.f, 0.f};
    const int token = row0 + F.tid;
    if (F.tid < 256) {
        float l[32]; const float rsc = ((const float*)(F.ws + WS_RS))[token];
#pragma unroll
        for (int q = 0; q < 8; ++q) { const f32x4 v = *(const f32x4*)(logits + (size_t)token * 32 + q * 4), bq = *(const f32x4*)(F.in[28] + q * 4); l[q * 4] = v[0] * rsc + bq[0]; l[q * 4 + 1] = v[1] * rsc + bq[1]; l[q * 4 + 2] = v[2] * rsc + bq[2]; l[q * 4 + 3] = v[3] * rsc + bq[3]; }
        unsigned used = 0u; float tv[4];
#pragma unroll
        for (int k = 0; k < 4; ++k) { float best = -3.0e38f; int bi = 0;
#pragma unroll
            for (int e = 0; e < 32; ++e) { const bool ok = !((used >> e) & 1u) && (l[e] > best); best = ok ? l[e] : best; bi = ok ? e : bi; }
            used |= 1u << bi; e4[k] = bi; tv[k] = best; }
        const float m = tv[0]; float ex[4], sum = 0.f;
#pragma unroll
        for (int k = 0; k < 4; ++k) { ex[k] = __expf(tv[k] - m); sum += ex[k]; }
#pragma unroll
        for (int k = 0; k < 4; ++k) { g4[k] = ex[k] / sum; p4[k] = atomicAdd((unsigned*)&cnt[e4[k]], 1u); }
    }
    __syncthreads();
    if (F.tid < 32) base[F.tid] = __hip_atomic_fetch_add(&gcnt[F.tid], cnt[F.tid], __ATOMIC_RELAXED, __HIP_MEMORY_SCOPE_AGENT);
    __syncthreads();
    if (F.tid < 256) {
#pragma unroll
        for (int k = 0; k < 4; ++k) { epos[(size_t)token * 4 + k] = ((unsigned)e4[k] << 24) | (base[e4[k]] + p4[k]); gatev[(size_t)token * 4 + k] = g4[k]; }
    }
    __syncthreads();
}
DI void p_gather(const Frame& F, int pass) {
    LAS int* poff = (LAS int*)F.lds;
    LAS int* pcnt = poff + 40;
    unsigned* gcnt = (unsigned*)(F.ws + WS_CTL) + CW_GCNT + pass * 32;
    int* tile_e = (int*)(F.ws + WS_TILEE) + pass * TE_STRIDE;
    __syncthreads();
    if (F.tid == 0) { int acc = 0; for (int e = 0; e < 32; ++e) { poff[e] = acc; const int c = (int)__hip_atomic_load(&gcnt[e], __ATOMIC_RELAXED, __HIP_MEMORY_SCOPE_AGENT); pcnt[e] = c; acc += ((c + 255) >> 8) << 8; } poff[32] = acc; }
    __syncthreads();
    if (F.bid == 0) {
        const int nt = poff[32] >> 8;
        for (int t = F.tid; t < nt; t += NTHR) { int e = 0; for (int q = 1; q < 32; ++q) if (poff[q] <= t * 256) e = q; tile_e[1 + t] = e; }
        if (F.tid == 0) tile_e[0] = nt;
    }
    const unsigned* epos = (const unsigned*)(F.ws + WS_EPOS); const float* gatev = (const float*)(F.ws + WS_GATEV);
    int* slot = (int*)(F.ws + WS_SLOT); float* rowg = (float*)(F.ws + WS_ROWG) + (size_t)pass * MAXTILES * 256;
    int* rowtok = (int*)(F.ws + WS_ROWTOK) + (size_t)pass * MAXTILES * 256;
    for (int i = F.bid * NTHR + F.tid; i < 32 * 256; i += F.G * NTHR) { const int e = i >> 8, sl = poff[e] + pcnt[e] + (i & 255); if (sl < poff[e + 1]) rowtok[sl] = 0; }
    for (int i = F.bid * NTHR + F.tid; i < TPP * 4; i += F.G * NTHR) {
        const int token = pass * TPP + (i >> 2);
        const unsigned ep = epos[(size_t)pass * TPP * 4 + i]; const int sl = poff[ep >> 24] + (int)(ep & 0xffffffu);
        slot[(size_t)pass * TPP * 4 + i] = sl; rowg[sl] = gatev[(size_t)pass * TPP * 4 + i]; rowtok[sl] = token;
    }
    __syncthreads();
}
DI void p_combine(const Frame& F, int pass) {
    int tz_ = threadIdx.x; asm volatile("" : "+v"(tz_)); const int lane_ = tz_ & 63;
    const int* slot = (const int*)(F.ws + WS_SLOT); const unsigned char* y2 = (const unsigned char*)(F.ws + WS_XS) + (size_t)pass * PASS_BUF; const float* gf = F.in[33];
    for (int t = F.bid * NWAVES + F.wave; t < TPP; t += F.G * NWAVES) {
        const int token = pass * TPP + t;
        float v[16];
        { const bf16_t* hb = (const bf16_t*)(F.ws + WS_HB) + (size_t)token * D + lane_ * 16; const u32x4 h0 = *(const u32x4*)hb, h1 = *(const u32x4*)(hb + 8);
#pragma unroll
          for (int j = 0; j < 4; ++j) { v[2 * j] = bf_lo(h0[j]); v[2 * j + 1] = bf_hi(h0[j]); v[8 + 2 * j] = bf_lo(h1[j]); v[8 + 2 * j + 1] = bf_hi(h1[j]); } }
        u32x4 yw[4];
#pragma unroll
        for (int k = 0; k < 4; ++k) { const int s = slot[(size_t)token * 4 + k]; yw[k] = *(const u32x4*)(y2 + (size_t)s * D + lane_ * 16); }
#pragma unroll
        for (int k = 0; k < 4; ++k)
#pragma unroll
            for (int j = 0; j < 4; ++j) { const f32x2 lo = __builtin_amdgcn_cvt_pk_f32_fp8((int)yw[k][j], false), hi = __builtin_amdgcn_cvt_pk_f32_fp8((int)yw[k][j], true);
                v[4 * j] += lo[0] * (1.0f / F8_SY); v[4 * j + 1] += lo[1] * (1.0f / F8_SY); v[4 * j + 2] += hi[0] * (1.0f / F8_SY); v[4 * j + 3] += hi[1] * (1.0f / F8_SY); }
        float ss = 0.f;
#pragma unroll
        for (int j = 0; j < 16; ++j) ss += v[j] * v[j];
        ss = wave_sum(ss);
        const float rs = rsqrtf(ss * (1.0f / D) + 1e-5f);
        f32x4* orow = (f32x4*)(F.out + (size_t)token * D + lane_ * 16);
#pragma unroll
        for (int q = 0; q < 4; ++q) { const f32x4 gv = *(const f32x4*)(gf + lane_ * 16 + q * 4);
            orow[q] = (f32x4){v[q * 4] * rs * gv[0], v[q * 4 + 1] * rs * gv[1], v[q * 4 + 2] * rs * gv[2], v[q * 4 + 3] * rs * gv[3]}; }
    }
}

constexpr int N_PHASES = 17;
__global__ void __launch_bounds__(NTHR, 2) fwd_kernel(KArgs args) {
    extern __shared__ __attribute__((aligned(16))) unsigned char lds_raw[];
    Frame F; F.lds = (LAS unsigned char*)lds_raw; F.tid = threadIdx.x; F.lane = F.tid & 63; F.wave = __builtin_amdgcn_readfirstlane(F.tid >> 6);
    F.G = gridDim.x; F.bid = blockIdx.x; F.in = args.in; F.out = args.out; F.ws = args.ws;
    unsigned char* ws = args.ws;
    volatile LAS unsigned* MISC = (volatile LAS unsigned*)(F.lds + MISC_OFF);
    if (F.tid < 4) MISC[F.tid] = 0u;
    __syncthreads();
    XcdBarrier bar; bar.bar = (unsigned*)(ws + WS_CTL) + CW_BAR; bar.x = 0; bar.st = MISC;
    if (N_LAUNCH_MODE == 1) bar = xcd_barrier_post((unsigned*)(ws + WS_CTL) + CW_BAR, MISC);
    const int lo = args.ph_lo, hi = args.ph_hi;
#define IN(k) (lo <= (k) && (k) < hi)
#define REP(k) for (int _r = 0; _r < 1 + (int)((PROBE_MASK >> (k)) & 1u); ++_r)
#define SEAM(k) do { if (N_LAUNCH_MODE == 1 && IN(k) && IN((k) + 1)) xcd_barrier(bar); } while (0)
    bf16_t* gates = (bf16_t*)args.out;

    if (IN(0)) { REP(0) p0_prologue(F); SEAM(0); }
    if (IN(1)) {
        PlainSched S; S.init(ws + WS_XN, ws + WS_WIN, T, INC, D, D, D, F.G, F.bid);
        EpiWin E{(bf16_t*)(ws + WS_US5), (bf16_t*)(ws + WS_PRW), gates};
        REP(1) gemm_phase(F.lds, S, E); SEAM(1);
    }
    if (IN(2)) {
        GroupSched S; S.init(ws + WS_US5, ws + WS_WST, 512, LDU, 512, S5ROWS / BM, 1, F.G, F.bid);
        EpiS5State E{(float*)(ws + WS_SLOC)};
        REP(2) { gemm_phase(F.lds, S, E); p_rw_prep(F); } SEAM(2);
    }
    if (IN(3)) {
        REP(3) p_s5_carry(F);
        PlainSched S; S.init(ws + WS_ALORA, ws + WS_WLORA, T, 1536, 128, 256, 128, F.G, F.bid); S.akoff_pn = 4; S.akoff_bytes = 256;
        EpiLora E{(bf16_t*)(ws + WS_LWAG), F.in[14], F.in[16]};
        REP(3) gemm_phase(F.lds, S, E); SEAM(3);
    }
    if (IN(4)) {
        GroupSched S; S.init(ws + WS_US5, ws + WS_TOEP, LDU, LDU, LDU, S5ROWS / BM, 2, F.G, F.bid);
        EpiS5Out E{(bf16_t*)(ws + WS_YS)};
        REP(4) gemm_phase(F.lds, S, E); SEAM(4);
    }
    if (IN(5)) { REP(5) p_rw_chunk(F); SEAM(5); }
    if (IN(6)) { REP(6) p_rw_scan(F); SEAM(6); }
    if (IN(7)) { REP(7) p_rw_out(F); SEAM(7); }
    if (IN(8)) {
        PlainSched S; S.init(ws + WS_YS, ws + WS_WGLU, T, 2048, 512, 512, 512, F.G, F.bid);
        EpiGlu E{(bf16_t*)(ws + WS_XN), gates, (const float*)(ws + WS_BGLU)};
        if (F.bid & 1) p_conv_part(F, 0);
        gemm_phase(F.lds, S, E);
        if (!(F.bid & 1)) p_conv_part(F, 0);
        SEAM(8);
    }
    if (IN(9)) {
        PlainSched S; S.init(ws + WS_YRW, ws + WS_WO, T, 1024, 512, 512, 512, F.G, F.bid);
        EpiWo E{(bf16_t*)(ws + WS_XN), gates};
        if (F.bid & 1) p_conv_part(F, 1);
        gemm_phase(F.lds, S, E);
        if (!(F.bid & 1)) p_conv_part(F, 1);
        SEAM(9);
    }
    if (IN(10)) {
        PlainSched S; S.init(ws + WS_XN, ws + WS_WOUT, T, 1024, 1024, 1024, 1024, F.G, F.bid);
        EpiOut E{(bf16_t*)(ws + WS_HB), F.in[0]};
        if (F.bid & 1) p_conv_part(F, 2);
        gemm_phase(F.lds, S, E);
        if (!(F.bid & 1)) p_conv_part(F, 2);
        SEAM(10);
    }
    if (IN(11)) {
        PlainSched S; S.init(ws + WS_HB, ws + WS_WR, T, 256, 1024, 1024, 1024, F.G, F.bid);
        EpiRouter E{(float*)(ws + WS_LOG)};
        { Unit u; for (int i = 0; S.next(i, u); ++i) p_moe_prep_rows(F, u.pm * BM); }
        p_moe_b1p(F);
        asm volatile("s_waitcnt vmcnt(0)" ::: "memory"); __syncthreads();
        gemm_phase(F.lds, S, E);
        { Unit u; for (int i = 0; S.next(i, u); ++i) topk_rows(F, u.pm * BM); }
        SEAM(11);
    }
    if (IN(12)) { p_gather(F, 0); p_gather(F, 1); SEAM(12); }
#define MOE_G1(PASS, CIDX) \
            const int* te = (const int*)(ws + WS_TILEE) + (PASS) * TE_STRIDE; const int ntl = __builtin_amdgcn_readfirstlane(__hip_atomic_load(te, __ATOMIC_RELAXED, __HIP_MEMORY_SCOPE_AGENT)); \
            MoeSched<true> S; S.init(ws + WS_XN2F8, ws + WS_W1, te + 1, (const int*)(ws + WS_ROWTOK) + (size_t)(PASS) * MAXTILES * 256, ntl, 512, 8, F.G, (CIDX)); \
            EpiMoe1 E{(unsigned char*)(ws + WS_ACT) + (size_t)(PASS) * PASS_BUF, (const float*)(ws + WS_B1P)};
#define MOE_G2(PASS) \
            const int* te = (const int*)(ws + WS_TILEE) + (PASS) * TE_STRIDE; const int ntl = __builtin_amdgcn_readfirstlane(__hip_atomic_load(te, __ATOMIC_RELAXED, __HIP_MEMORY_SCOPE_AGENT)); \
            MoeSched<false> S; S.init(ws + WS_ACT + (size_t)(PASS) * PASS_BUF, ws + WS_W2, te + 1, nullptr, ntl, 512, 4, F.G, F.bid); \
            EpiMoe2 E{(unsigned char*)(ws + WS_XS) + (size_t)(PASS) * PASS_BUF, F.in[32], (const float*)(ws + WS_ROWG) + (size_t)(PASS) * MAXTILES * 256};
    if (IN(13)) { MOE_G1(0, F.bid) gemm_phase(F.lds, S, E); SEAM(13); }
    if (IN(14)) {
        { MOE_G2(0) gemm_phase(F.lds, S, E); }
        { MOE_G1(1, F.G - 1 - F.bid) gemm_phase(F.lds, S, E); }
        SEAM(14);
    }
    if (IN(15)) {
        if (F.bid & 1) p_combine(F, 0);
        { MOE_G2(1) gemm_phase(F.lds, S, E); }
        if (!(F.bid & 1)) p_combine(F, 0);
        SEAM(15);
    }
    if (IN(16)) { p_combine(F, 1); }
#undef MOE_G1
#undef MOE_G2
#undef IN
#undef SEAM
#undef REP
}

extern "C" void kernel_launch(void* const* d_in, const int* in_sizes, int n_in, void* d_out, int out_size, void* d_ws, size_t ws_size, hipStream_t stream) {
    static int grid = 0;
    if (grid == 0) {
        if (n_in != 34 || in_sizes[0] != T * D || out_size != T * D || ws_size < WS_END) { fprintf(stderr, "kernel_launch: unexpected shapes (n_in %d, in0 %d, out %d, ws %zu < %zu)\n", n_in, n_in > 0 ? in_sizes[0] : -1, out_size, ws_size, (size_t)WS_END); grid = -1; return; }
        int dev = 0, cus = 0, per_cu = 0;
        if (hipGetDevice(&dev) != hipSuccess || hipDeviceGetAttribute(&cus, hipDeviceAttributeMultiprocessorCount, dev) != hipSuccess) { grid = -1; return; }
        if (hipFuncSetAttribute((const void*)fwd_kernel, hipFuncAttributeMaxDynamicSharedMemorySize, LDS_BYTES) != hipSuccess) { fprintf(stderr, "kernel_launch: hipFuncSetAttribute failed\n"); grid = -1; return; }
        if (hipOccupancyMaxActiveBlocksPerMultiprocessor(&per_cu, (const void*)fwd_kernel, NTHR, LDS_BYTES) != hipSuccess || per_cu < 1) { fprintf(stderr, "kernel_launch: occupancy query says %d\n", per_cu); }
        (void)hipGetLastError();
        grid = cus;
    }
    if (grid < 0) return;
    (void)hipMemsetAsync((char*)d_ws + WS_CTL, 0, CTL_BYTES, stream);
    KArgs a{};
    for (int i = 0; i < 34; ++i) a.in[i] = (const float*)d_in[i];
    a.out = (float*)d_out; a.ws = (unsigned char*)d_ws;
    if (N_LAUNCH_MODE == 1) {
        a.ph_lo = 0; a.ph_hi = N_PHASES;
        hipLaunchKernelGGL(fwd_kernel, dim3(grid), dim3(NTHR), LDS_BYTES, stream, a);
    } else {
        for (int p = 0; p < N_PHASES; ++p) { a.ph_lo = p; a.ph_hi = p + 1; hipLaunchKernelGGL(fwd_kernel, dim3(grid), dim3(NTHR), LDS_BYTES, stream, a); }
    }
}
```

```cpp
#include <hip/hip_runtime.h>
#include <stdint.h>
#include <stdio.h>

#ifndef N_LAUNCH_MODE
#define N_LAUNCH_MODE 1
#endif

#ifndef GEMM_SP2
#define GEMM_SP2 1
#endif
#ifndef GEMM_ALIGN
#define GEMM_ALIGN 1
#endif
#ifndef PROBE_MASK
#define PROBE_MASK 0u
#endif
#define LAS __attribute__((address_space(3)))
#define DI __device__ __forceinline__
typedef unsigned short bf16_t;
typedef short bf16x8 __attribute__((ext_vector_type(8)));
typedef float f32x4 __attribute__((ext_vector_type(4)));
typedef float f32x2 __attribute__((ext_vector_type(2)));
typedef unsigned u32x4 __attribute__((ext_vector_type(4)));
typedef unsigned u32x2 __attribute__((ext_vector_type(2)));
typedef int i32x8 __attribute__((ext_vector_type(8)));
typedef int i32x4 __attribute__((ext_vector_type(4)));

constexpr int T = 65536, D = 1024, SEQ = 4096, NB = 16;
constexpr int INC = 4352, RWC = 1792;
constexpr int S5L = 32;
constexpr int S5NC = SEQ / S5L;
constexpr int S5ROWS = T / S5L;
constexpr int LDU = 16 * S5L + 128;
constexpr int NE = 32, TOPK = 4;
constexpr int NPASS = 2, TPP = T / NPASS;
constexpr int MAXTILES = (TPP * TOPK) / 256 + NE;
constexpr int NWAVES = 8, NTHR = 512;

constexpr size_t al(size_t x) { return (x + 4095) & ~(size_t)4095; }
constexpr size_t WS_CTL = 0, CTL_BYTES = 1 << 20;
constexpr size_t WS_WIN = WS_CTL + CTL_BYTES;
constexpr size_t WS_WGLU = WS_WIN + al((size_t)INC * D * 2);
constexpr size_t WS_WO = WS_WGLU + al((size_t)2048 * 512 * 2);
constexpr size_t WS_WOUT = WS_WO + al((size_t)1024 * 512 * 2);
constexpr size_t WS_WLORA = WS_WOUT + al((size_t)1024 * 1024 * 2);
constexpr size_t WS_WR = WS_WLORA + al((size_t)1536 * 256 * 2);
constexpr size_t WS_TOEP = WS_WR + al((size_t)256 * 1024 * 2);
constexpr size_t WS_WST = WS_TOEP + al((size_t)32 * 512 * LDU * 2);
constexpr size_t WS_BGLU = WS_WST + al((size_t)32 * 256 * 512 * 2);
constexpr size_t WS_B1P = WS_BGLU + al(2048 * 4);
constexpr size_t WS_SHARED = WS_B1P + al((size_t)32 * 2048 * 4);
constexpr size_t WS_PRW = WS_SHARED;
constexpr size_t WS_LWAG = WS_PRW + al((size_t)T * RWC * 2);
constexpr size_t WS_YS = WS_LWAG + al((size_t)T * 1536 * 2);
constexpr size_t WS_YRW = WS_YS + al((size_t)T * 512 * 2);
constexpr size_t WS_BONUS = WS_YRW + al((size_t)T * 512 * 2);
constexpr size_t WS_XN = WS_BONUS + al((size_t)T * 8 * 4);
constexpr size_t WS_US5 = WS_XN + al((size_t)T * D * 2);
constexpr size_t WS_ALORA = WS_US5 + al((size_t)32 * S5ROWS * LDU * 2);
constexpr size_t WS_SLOC = WS_ALORA + al((size_t)T * 256 * 2);
constexpr int RW_NCH = 128 * 64;
constexpr size_t CHK_BYTES = (size_t)RW_NCH * 4096 * 2;
constexpr size_t WS_CHK_M = WS_XN, WS_CHK_N0T = WS_CHK_M + CHK_BYTES, WS_CHK_Q = WS_CHK_N0T + CHK_BYTES, WS_CHK_Y0T = WS_CHK_Q + CHK_BYTES, WS_CHK_HT = WS_CHK_Y0T + CHK_BYTES;
constexpr size_t WS_MIX_END0 = WS_SLOC + al((size_t)32 * S5ROWS * 128 * 4);
constexpr size_t WS_MIX_END = (WS_CHK_HT + CHK_BYTES) > WS_MIX_END0 ? (WS_CHK_HT + CHK_BYTES) : WS_MIX_END0;
constexpr size_t WS_HB = WS_SHARED;
constexpr size_t WS_W1 = WS_HB + al((size_t)T * D * 2);
constexpr size_t WS_W2 = WS_W1 + al((size_t)32 * 2048 * 1024);
constexpr size_t WS_RS = WS_W2 + al((size_t)32 * 1024 * 1024);
constexpr size_t WS_LOG = WS_RS + al((size_t)T * 4);
constexpr size_t WS_EPOS = WS_LOG + al((size_t)T * 32 * 4);
constexpr size_t WS_GATEV = WS_EPOS + al((size_t)T * 4 * 4);
constexpr size_t WS_SLOT = WS_GATEV + al((size_t)T * 4 * 4);
constexpr size_t WS_ROWG = WS_SLOT + al((size_t)T * 4 * 4);
constexpr size_t WS_ROWTOK = WS_ROWG + al((size_t)NPASS * MAXTILES * 256 * 4);
constexpr size_t WS_TILEE = WS_ROWTOK + al((size_t)NPASS * MAXTILES * 256 * 4);
constexpr int TE_STRIDE = MAXTILES + 64;
constexpr size_t WS_XS = WS_TILEE + al((size_t)NPASS * (MAXTILES + 64) * 4);
constexpr size_t PASS_BUF = al((size_t)MAXTILES * 256 * 1024);
constexpr size_t WS_ACT = WS_XS + NPASS * PASS_BUF;
constexpr size_t WS_XN2F8 = WS_ACT + NPASS * PASS_BUF;
constexpr size_t WS_MOE_END = WS_XN2F8 + al((size_t)T * D);
static_assert(WS_W2 + (size_t)32 * 1024 * 1024 <= WS_SHARED + (size_t)T * RWC * 2, "converted expert weights must stay inside the (dead) PRW buffer while the GLU/Wo/out GEMM phases run");
constexpr size_t WS_END = WS_MIX_END > WS_MOE_END ? WS_MIX_END : WS_MOE_END;
static_assert(WS_END <= ((size_t)1 << 30), "workspace over 1 GiB");

constexpr int CW_BAR = 0;
constexpr int CW_GCNT = 4096;

constexpr float F8_SX = 16.f, F8_SW = 32.f, F8_SA = 4.f, F8_SY = 32.f;
constexpr int LDS_BYTES = 144 * 1024;
constexpr int MISC_OFF = 140 * 1024;

typedef __bf16 bf16x2_t __attribute__((ext_vector_type(2)));
DI unsigned cvt_pk_bf16(float lo, float hi) { f32x2 v = {lo, hi}; bf16x2_t b = __builtin_convertvector(v, bf16x2_t); return __builtin_bit_cast(unsigned, b); }
DI unsigned pk4_fp8(float a, float b, float c, float d) {
    a = fminf(fmaxf(a, -448.f), 448.f); b = fminf(fmaxf(b, -448.f), 448.f); c = fminf(fmaxf(c, -448.f), 448.f); d = fminf(fmaxf(d, -448.f), 448.f);
    int w = __builtin_amdgcn_cvt_pk_fp8_f32(a, b, 0, false); w = __builtin_amdgcn_cvt_pk_fp8_f32(c, d, w, true); return (unsigned)w; }
DI float bf_lo(unsigned u) { return __uint_as_float(u << 16); }
DI float bf_hi(unsigned u) { return __uint_as_float(u & 0xffff0000u); }
DI float bf2f(bf16_t b) { return __uint_as_float(((unsigned)b) << 16); }
DI bf16_t f2bf(float f) { return (bf16_t)(cvt_pk_bf16(f, 0.f) & 0xffffu); }
DI float fsigmoid(float x) { return __builtin_amdgcn_rcpf(1.0f + __expf(-x)); }
DI float ftanh(float x) { float e = __expf(2.0f * x); return 1.0f - 2.0f * __builtin_amdgcn_rcpf(e + 1.0f); }
DI float fgelu_tanh(float x) { float u = 0.7978845608f * (x + 0.044715f * x * x * x); return x * fsigmoid(2.0f * u); }
DI f32x2 lo2(const f32x4& v) { return __builtin_shufflevector(v, v, 0, 1); }
DI f32x2 hi2(const f32x4& v) { return __builtin_shufflevector(v, v, 2, 3); }
DI f32x2 pk_sigmoid_scaled(f32x2 x, float negk) {
    const f32x2 t = x * negk; f32x2 e; e.x = __builtin_amdgcn_exp2f(t.x); e.y = __builtin_amdgcn_exp2f(t.y);
    const f32x2 d = e + 1.0f; f32x2 r; r.x = __builtin_amdgcn_rcpf(d.x); r.y = __builtin_amdgcn_rcpf(d.y); return r; }
DI f32x2 pk_sigmoid(f32x2 x) { return pk_sigmoid_scaled(x, -1.44269504f); }
DI f32x2 pk_gelu_tanh(f32x2 x) { const f32x2 x2 = x * x; const f32x2 u = x * (x2 * (0.044715f * 0.7978845608f) + 0.7978845608f); return x * pk_sigmoid_scaled(u, -2.0f * 1.44269504f); }
DI unsigned pk4_fp8_nc(f32x2 a, f32x2 b) { int w = __builtin_amdgcn_cvt_pk_fp8_f32(a.x, a.y, 0, false); w = __builtin_amdgcn_cvt_pk_fp8_f32(b.x, b.y, w, true); return (unsigned)w; }
#define DPP_ROR_ADD(v, n) ((v) + __builtin_bit_cast(float, __builtin_amdgcn_update_dpp(0, __builtin_bit_cast(int, (v)), 0x120 + (n), 0xf, 0xf, false)))
DI float row_sum16(float v) { v = DPP_ROR_ADD(v, 8); v = DPP_ROR_ADD(v, 4); v = DPP_ROR_ADD(v, 2); v = DPP_ROR_ADD(v, 1); return v; }
DI float xrow_sum(float x) {
    float y = x;
    asm("s_nop 1\n\tv_permlane16_swap_b32 %0, %1\n\ts_nop 1" : "+v"(x), "+v"(y));
    x = x + y; y = x;
    asm("s_nop 1\n\tv_permlane32_swap_b32 %0, %1\n\ts_nop 1" : "+v"(x), "+v"(y));
    return x + y;
}
DI float wave_sum(float v) { return xrow_sum(row_sum16(v)); }
#define DPP_ADD(v, ctrl) ((v) + __builtin_bit_cast(float, __builtin_amdgcn_update_dpp(0, __builtin_bit_cast(int, (v)), (ctrl), 0xf, 0xf, false)))
DI float comb32(float x, float y) { asm("s_nop 1\n\tv_permlane32_swap_b32 %0, %1\n\ts_nop 1" : "+v"(x), "+v"(y)); return x + y; }
DI float comb16(float x, float y) { asm("s_nop 1\n\tv_permlane16_swap_b32 %0, %1\n\ts_nop 1" : "+v"(x), "+v"(y)); return x + y; }

DI float sum16(float v) {
    v += __shfl_xor(v, 1); v += __shfl_xor(v, 2); v += __shfl_xor(v, 4); v += __shfl_xor(v, 8); return v;
}

#define XB_TMO      128
#define XB_XCNT(j)  (256  + 64 * (j))
#define XB_XSUB(j)  (1280 + 64 * (j))
#define XB_XGEN(j)  (2304 + 64 * (j))
#define XB_TOP      3328
#define XB_TOPGEN   3392
#define XCD_BAR_WORDS 3456
#define XB_SPIN_CAP (1u << 22)
DI unsigned xb_ld(unsigned* p)              { return __hip_atomic_load(p, __ATOMIC_RELAXED, __HIP_MEMORY_SCOPE_AGENT); }
DI unsigned xb_add(unsigned* p, unsigned v) { return __hip_atomic_fetch_add(p, v, __ATOMIC_RELAXED, __HIP_MEMORY_SCOPE_AGENT); }
DI unsigned xb_xcc_id() { return (unsigned)__builtin_amdgcn_s_getreg((3 << 11) | 20) & 0xFu; }
#define XB_SPIN(cond, bar) do { unsigned _sp = 0; while (cond) { __builtin_amdgcn_s_sleep(1); \
    if ((++_sp & 255u) == 0u) { if (xb_ld(&(bar)[XB_TMO])) break; if (_sp > XB_SPIN_CAP) { atomicAdd(&(bar)[XB_TMO], 1u); break; } } } } while (0)
struct XcdBarrier { unsigned* bar; unsigned x; volatile LAS unsigned* st; };
DI XcdBarrier xcd_barrier_post(unsigned* bar, volatile LAS unsigned* st) {
    XcdBarrier b; b.bar = bar; b.x = xb_xcc_id(); b.st = st;
    if (threadIdx.x == 0) (void)xb_add(&bar[XB_XCNT(b.x)], 1u);
    return b;
}
DI void xcd_barrier_complete(unsigned* bar, unsigned x, unsigned& nloc, unsigned& nx) {
    const unsigned G = gridDim.x * gridDim.y * gridDim.z;
    unsigned sum, cnt, mine, sp = 0u;
    for (;;) {
        sum = 0u; cnt = 0u; mine = 0u;
#pragma unroll
        for (unsigned j = 0; j < 16; ++j) { const unsigned c = xb_ld(&bar[XB_XCNT(j)]); sum += c; cnt += (c > 0u) ? 1u : 0u; mine = (j == x) ? c : mine; }
        if (sum == G) break;
        __builtin_amdgcn_s_sleep(1);
        if ((++sp & 255u) == 0u) { if (xb_ld(&bar[XB_TMO])) break; if (sp > XB_SPIN_CAP) { atomicAdd(&bar[XB_TMO], 1u); break; } }
    }
    nloc = mine > 0u ? mine : 1u; nx = cnt > 0u ? cnt : 1u;
}
DI void xcd_barrier(const XcdBarrier& b) {
    asm volatile("s_waitcnt vmcnt(0)" ::: "memory");
    __syncthreads();
    if (threadIdx.x == 0) {
        unsigned* bar = b.bar;
        __builtin_amdgcn_s_waitcnt(0);
        unsigned nloc = b.st[0], nx = b.st[1];
        if (nloc == 0u) { xcd_barrier_complete(bar, b.x, nloc, nx); b.st[0] = nloc; b.st[1] = nx; }
        const unsigned old = xb_add(&bar[XB_XSUB(b.x)], 1u);
        const unsigned gen = old / nloc;
        if (old + 1u == (gen + 1u) * nloc) {
            __builtin_amdgcn_fence(__ATOMIC_RELEASE, "agent");
            asm volatile("s_waitcnt vmcnt(0)" ::: "memory");
            const unsigned og = xb_add(&bar[XB_TOP], 1u);
            const unsigned tg = og / nx;
            if (og + 1u == (tg + 1u) * nx) xb_add(&bar[XB_TOPGEN], 1u);
            else XB_SPIN(xb_ld(&bar[XB_TOPGEN]) == tg, bar);
            __builtin_amdgcn_fence(__ATOMIC_ACQUIRE, "agent");
            xb_add(&bar[XB_XGEN(b.x)], 1u);
            asm volatile("s_waitcnt vmcnt(0)" ::: "memory");
        } else {
            XB_SPIN(xb_ld(&bar[XB_XGEN(b.x)]) == gen, bar);
            __builtin_amdgcn_fence(__ATOMIC_ACQUIRE, "agent");
            asm volatile("s_waitcnt vmcnt(0)" ::: "memory");
        }
    }
    __syncthreads();
}

constexpr int BM = 256, BK = 64, HALF = 128, HTB = HALF * BK * 2;
DI int lds_byte(int r, int c) { const int st = (r >> 4) * 2 + (c >> 5), rr = r & 15, cc = c & 31, ob = rr * 64 + cc * 2; return st * 1024 + (ob ^ (((ob >> 9) & 1) << 5)); }
DI void stage_rc(int b, int& R, int& C) { const int st = b / 1024, sb = b % 1024, swz = sb ^ (((sb >> 9) & 1) << 5); R = (st >> 1) * 16 + swz / 64; C = (st & 1) * 32 + (swz % 64) / 2; }
DI int perm32(int rho) { const int n = rho >> 4, i = rho & 15; return 8 * (i >> 2) + 4 * n + (i & 3); }
struct Unit { int pm, pn, aux; };

template <class Sched, class Epi>
DI void gemm_phase(LAS unsigned char* lds, const Sched& S, const Epi& E) {
    const int tid = threadIdx.x, wid = __builtin_amdgcn_readfirstlane(tid >> 6), lane = tid & 63, wr = wid >> 2, wc = wid & 3, fr = lane & 15, fq = lane >> 4;
    const int K = S.K, nt = K / BK;
    unsigned voffA[2], voffB[2];
#pragma unroll
    for (int i = 0; i < 2; ++i) { int R, C; stage_rc(tid * 16 + i * 8192, R, C); const int Rb = Epi::PERM ? ((R & ~31) + perm32(R & 31)) : R;
        voffA[i] = (unsigned)(R * S.lda + C) * 2u; voffB[i] = (unsigned)(Rb * S.ldb + C) * 2u; }
    const size_t kstep = (size_t)(BK * 2);
    const size_t hstepA = (size_t)HALF * S.lda * 2, hstepB = (size_t)HALF * S.ldb * 2;
    const unsigned ldsw = (unsigned)wid * 1024u;
    const int aoff = lds_byte(wr * 64 + fr, fq * 8), boff = lds_byte(wc * 32 + fr, fq * 8);
#define PG8_SA(b, h) (((b) * 2 + (h)) * HTB)
#define PG8_SB(b, h) ((4 + (b) * 2 + (h)) * HTB)
    const unsigned ldsbase = (unsigned)(size_t)lds;
#define PG8_STAGE(bufoff, gbase, voff) do { _Pragma("unroll") for (int _i = 0; _i < 2; ++_i) \
        asm volatile("s_mov_b32 m0, %0\n\ts_nop 0\n\tglobal_load_lds_dwordx4 %1, %2" :: "s"(ldsbase + (unsigned)(bufoff) + ldsw + (unsigned)(_i * 8192)), "v"((voff)[_i]), "s"((const char*)(gbase)) : "memory"); } while (0)
#define PG8_LDA(dst, b, h) do { _Pragma("unroll") for (int m = 0; m < 4; ++m) _Pragma("unroll") for (int k = 0; k < 2; ++k) dst[m][k] = *(const LAS bf16x8*)(lds + PG8_SA(b, h) + aoff + m * 2048 + k * 1024); } while (0)
#define PG8_LDB(dst, b, h) do { _Pragma("unroll") for (int n = 0; n < 2; ++n) _Pragma("unroll") for (int k = 0; k < 2; ++k) dst[n][k] = *(const LAS bf16x8*)(lds + PG8_SB(b, h) + boff + n * 2048 + k * 1024); } while (0)
#define PG8_MMA(ai, bj, At, Bt) do { __builtin_amdgcn_s_setprio(1); _Pragma("unroll") for (int m = 0; m < 4; ++m) _Pragma("unroll") for (int n = 0; n < 2; ++n) _Pragma("unroll") for (int k = 0; k < 2; ++k) \
        acc[ai][bj][m][n] = __builtin_amdgcn_mfma_f32_16x16x32_bf16(Bt[n][k], At[m][k], acc[ai][bj][m][n], 0, 0, 0); __builtin_amdgcn_s_setprio(0); } while (0)
#define PG8_WAIT_V(n) asm volatile("s_waitcnt vmcnt(" #n ")" ::: "memory")
#define PG8_WAIT_L(n) asm volatile("s_waitcnt lgkmcnt(" #n ")" ::: "memory")
#define PG8_BAR __builtin_amdgcn_s_barrier()
#define PG8_SCHED __builtin_amdgcn_sched_barrier(0)
    Unit cur, nxt; int ui = 0;
    if (!S.next(0, cur)) return;
    f32x4 acc[2][2][4][2];
#pragma unroll
    for (int a = 0; a < 2; ++a)
#pragma unroll
        for (int b = 0; b < 2; ++b)
#pragma unroll
            for (int m = 0; m < 4; ++m)
#pragma unroll
                for (int n = 0; n < 2; ++n) { if constexpr (Sched::FP8) { f32x2 z0_, z1_; asm volatile("v_pk_mov_b32 %0, 0, 0" : "=v"(z0_)); asm volatile("v_pk_mov_b32 %0, 0, 0" : "=v"(z1_)); acc[a][b][m][n] = (f32x4){z0_.x, z0_.y, z1_.x, z1_.y}; } else acc[a][b][m][n] = (f32x4){0.f, 0.f, 0.f, 0.f}; }
    bf16x8 At[4][2], B0[2][2], B1[2][2];
    i32x8 At8[4], B08[2], B18[2];
    const int aoff8a = lds_byte(wr * 64 + fr, 16 * fq) & ~16, boff8a = lds_byte(wc * 32 + fr, 16 * fq) & ~16;
#define PG8_LDA8(dst, b, h) do { _Pragma("unroll") for (int m = 0; m < 4; ++m) dst[m] = *(const LAS i32x8*)(lds + PG8_SA(b, h) + aoff8a + m * 2048); } while (0)
#define PG8_LDB8(dst, b, h) do { _Pragma("unroll") for (int n = 0; n < 2; ++n) dst[n] = *(const LAS i32x8*)(lds + PG8_SB(b, h) + boff8a + n * 2048); } while (0)
#define PG8_MMA8(ai, bj, At_, Bt_) do { __builtin_amdgcn_s_setprio(1); _Pragma("unroll") for (int m = 0; m < 4; ++m) _Pragma("unroll") for (int n = 0; n < 2; ++n) \
        acc[ai][bj][m][n] = __builtin_amdgcn_mfma_scale_f32_16x16x128_f8f6f4(Bt_[n], At_[m], acc[ai][bj][m][n], 0, 0, 0, 0x7f7f7f7f, 0, 0x7f7f7f7f); __builtin_amdgcn_s_setprio(0); } while (0)
#define XLDA(b, h) do { if constexpr (Sched::FP8) PG8_LDA8(At8, b, h); else PG8_LDA(At, b, h); } while (0)
#define XLDB0(b, h) do { if constexpr (Sched::FP8) PG8_LDB8(B08, b, h); else PG8_LDB(B0, b, h); } while (0)
#define XLDB1(b, h) do { if constexpr (Sched::FP8) PG8_LDB8(B18, b, h); else PG8_LDB(B1, b, h); } while (0)
#define XMMA0(ai, bj) do { if constexpr (Sched::FP8) PG8_MMA8(ai, bj, At8, B08); else PG8_MMA(ai, bj, At, B0); } while (0)
#define XMMA1(ai, bj) do { if constexpr (Sched::FP8) PG8_MMA8(ai, bj, At8, B18); else PG8_MMA(ai, bj, At, B1); } while (0)
    const char* cA = S.a_ptr(cur); const char* cB = S.b_ptr(cur);
    unsigned offA[2][2], offN[2][2];
    if constexpr (Sched::GATHER) {
#pragma unroll
        for (int h = 0; h < 2; ++h)
#pragma unroll
            for (int i = 0; i < 2; ++i) { int R, C; stage_rc(tid * 16 + i * 8192, R, C); offA[h][i] = S.a_rowoff(cur, h * HALF + R) + (unsigned)C * 2u; offN[h][i] = offA[h][i]; }
    }
#define A_STG(bufoff, plainptr, kt, h, nx) do { if constexpr (Sched::GATHER) { PG8_STAGE(bufoff, cA + (size_t)(kt) * kstep, offA[h]); } \
        else PG8_STAGE(bufoff, plainptr, voffA); } while (0)
    if constexpr (GEMM_SP2) {
        PG8_STAGE(PG8_SB(0, 0), cB, voffB); PG8_STAGE(PG8_SB(0, 1), cB + hstepB, voffB); A_STG(PG8_SA(0, 0), cA, 0, 0, false); A_STG(PG8_SA(0, 1), cA + hstepA, 0, 1, false);
        if (wr == 1) PG8_BAR;
        PG8_WAIT_V(2); PG8_BAR;
        PG8_STAGE(PG8_SB(1, 0), cB + kstep, voffB); A_STG(PG8_SA(1, 0), cA + kstep, 1, 0, false); PG8_STAGE(PG8_SB(1, 1), cB + hstepB + kstep, voffB);
        PG8_WAIT_V(6); PG8_BAR;
    } else {
    PG8_STAGE(PG8_SB(0, 0), cB, voffB); A_STG(PG8_SA(0, 0), cA, 0, 0, false); PG8_STAGE(PG8_SB(0, 1), cB + hstepB, voffB); A_STG(PG8_SA(0, 1), cA + hstepA, 0, 1, false);
    if (wr == 1) PG8_BAR;
    PG8_WAIT_V(4); PG8_BAR;
    PG8_STAGE(PG8_SB(1, 0), cB + kstep, voffB); A_STG(PG8_SA(1, 0), cA + kstep, 1, 0, false); PG8_STAGE(PG8_SB(1, 1), cB + hstepB + kstep, voffB);
    PG8_WAIT_V(6); PG8_BAR;
    }
    for (;;) {
        const bool has_next = S.next(ui + 1, nxt);
        const char* nA = has_next ? S.a_ptr(nxt) : cA; const char* nB = has_next ? S.b_ptr(nxt) : cB;
        for (int t = 0; t < nt; t += 2) {
            const bool last = (t == nt - 2);
            const char* a1 = cA + (size_t)(t + 1) * kstep;
            const char* a2 = last ? nA : cA + (size_t)(t + 2) * kstep; const char* b2 = last ? nB : cB + (size_t)(t + 2) * kstep;
            const char* a3 = a2 + kstep; const char* b3 = b2 + kstep;
            const int k2 = last ? 0 : t + 2, k3 = k2 + 1;
            if constexpr (GEMM_SP2) {
            XLDB0(0, 0); XLDB1(0, 1); PG8_SCHED; XLDA(0, 0); A_STG(PG8_SA(1, 1), a1 + hstepA, t + 1, 1, false);
            if constexpr (Sched::GATHER) {
                if (has_next && (t == nt - 4 || nt < 4)) {
#pragma unroll
                    for (int h = 0; h < 2; ++h)
#pragma unroll
                        for (int i = 0; i < 2; ++i) { int R, C; stage_rc(tid * 16 + i * 8192, R, C); offN[h][i] = S.a_rowoff(nxt, h * HALF + R) + (unsigned)C * 2u; } }
                if (last && has_next) { offA[0][0] = offN[0][0]; offA[0][1] = offN[0][1]; offA[1][0] = offN[1][0]; offA[1][1] = offN[1][1]; }
            }
            PG8_WAIT_V(8); PG8_WAIT_L(0); PG8_BAR; XMMA0(0, 0); XMMA1(0, 1); PG8_BAR; PG8_SCHED;
            XLDA(0, 1); PG8_STAGE(PG8_SB(0, 0), b2, voffB); PG8_STAGE(PG8_SB(0, 1), b2 + hstepB, voffB); A_STG(PG8_SA(0, 0), a2, k2, 0, last);
            PG8_WAIT_V(8); PG8_WAIT_L(0); PG8_BAR; XMMA0(1, 0); XMMA1(1, 1); PG8_BAR; PG8_SCHED;
            XLDB0(1, 0); XLDB1(1, 1); PG8_SCHED; XLDA(1, 0); A_STG(PG8_SA(0, 1), a2 + hstepA, k2, 1, last);
            PG8_WAIT_V(8); PG8_WAIT_L(0); PG8_BAR; XMMA0(0, 0); XMMA1(0, 1); PG8_BAR; PG8_SCHED;
            XLDA(1, 1); PG8_STAGE(PG8_SB(1, 0), b3, voffB); PG8_STAGE(PG8_SB(1, 1), b3 + hstepB, voffB); A_STG(PG8_SA(1, 0), a3, k3, 0, last);
            PG8_WAIT_V(8); PG8_WAIT_L(0); PG8_BAR; XMMA0(1, 0); XMMA1(1, 1); PG8_BAR; PG8_SCHED;
            } else {
            XLDB0(0, 0); PG8_SCHED; XLDA(0, 0); A_STG(PG8_SA(1, 1), a1 + hstepA, t + 1, 1, false);
            if constexpr (Sched::GATHER) {
                if (has_next && (t == nt - 4 || nt < 4)) {
#pragma unroll
                    for (int h = 0; h < 2; ++h)
#pragma unroll
                        for (int i = 0; i < 2; ++i) { int R, C; stage_rc(tid * 16 + i * 8192, R, C); offN[h][i] = S.a_rowoff(nxt, h * HALF + R) + (unsigned)C * 2u; } }
                if (last && has_next) { offA[0][0] = offN[0][0]; offA[0][1] = offN[0][1]; offA[1][0] = offN[1][0]; offA[1][1] = offN[1][1]; }
            }
            PG8_WAIT_L(8); PG8_BAR; PG8_WAIT_L(0); XMMA0(0, 0); PG8_BAR; PG8_SCHED;
            XLDB1(0, 1); PG8_STAGE(PG8_SB(0, 0), b2, voffB);
            PG8_BAR; PG8_WAIT_L(0); XMMA1(0, 1); PG8_BAR;
            XLDA(0, 1); A_STG(PG8_SA(0, 0), a2, k2, 0, last);
            PG8_BAR; PG8_WAIT_L(0); XMMA0(1, 0); PG8_BAR; PG8_SCHED;
            PG8_STAGE(PG8_SB(0, 1), b2 + hstepB, voffB);
            PG8_WAIT_V(6); PG8_BAR; XMMA1(1, 1); PG8_BAR;
            XLDB0(1, 0); PG8_SCHED; XLDA(1, 0); A_STG(PG8_SA(0, 1), a2 + hstepA, k2, 1, last);
            PG8_WAIT_L(8); PG8_BAR; PG8_WAIT_L(0); XMMA0(0, 0); PG8_BAR; PG8_SCHED;
            XLDB1(1, 1); PG8_STAGE(PG8_SB(1, 0), b3, voffB);
            PG8_BAR; PG8_WAIT_L(0); XMMA1(0, 1); PG8_BAR;
            XLDA(1, 1); A_STG(PG8_SA(1, 0), a3, k3, 0, last);
            PG8_BAR; PG8_WAIT_L(0); XMMA0(1, 0); PG8_BAR; PG8_SCHED;
            PG8_STAGE(PG8_SB(1, 1), b3 + hstepB, voffB);
            PG8_WAIT_V(6); PG8_BAR; XMMA1(1, 1); PG8_BAR;
            }
        }
        if constexpr (GEMM_ALIGN) { if (wr == 0) PG8_BAR; }
        {
            int tz = threadIdx.x; asm volatile("" : "+v"(tz));
            const int wid2 = tz >> 6, lane2 = tz & 63;
            E(acc, cur, wid2 >> 2, wid2 & 3, lane2 & 15, lane2 >> 4); }
        if (!has_next) break;
#pragma unroll
        for (int a = 0; a < 2; ++a)
#pragma unroll
            for (int b = 0; b < 2; ++b)
#pragma unroll
                for (int m = 0; m < 4; ++m)
#pragma unroll
                    for (int n = 0; n < 2; ++n) { if constexpr (Sched::FP8) { f32x2 z0_, z1_; asm volatile("v_pk_mov_b32 %0, 0, 0" : "=v"(z0_)); asm volatile("v_pk_mov_b32 %0, 0, 0" : "=v"(z1_)); acc[a][b][m][n] = (f32x4){z0_.x, z0_.y, z1_.x, z1_.y}; } else acc[a][b][m][n] = (f32x4){0.f, 0.f, 0.f, 0.f}; }
        cur = nxt; cA = nA; cB = nB; ++ui;
        if constexpr (GEMM_ALIGN) { if (wr == 1) PG8_BAR; }
    }
    PG8_WAIT_V(0);
    if constexpr (!GEMM_ALIGN) { if (wr == 0) PG8_BAR; }
    PG8_BAR;
#undef XLDA
#undef XLDB0
#undef XLDB1
#undef XMMA0
#undef XMMA1
#undef PG8_LDA8
#undef PG8_LDB8
#undef PG8_MMA8
#undef A_STG
#undef PG8_SA
#undef PG8_SB
#undef PG8_STAGE
#undef PG8_LDA
#undef PG8_LDB
#undef PG8_MMA
#undef PG8_WAIT_V
#undef PG8_WAIT_L
#undef PG8_BAR
#undef PG8_SCHED
}

struct PlainSched {
    static constexpr bool GATHER = false, FP8 = false;
    const char* A; const char* B; int K, lda, ldb, nM, nN, nwg, G, c; int akoff_pn = 1 << 30, akoff_bytes = 0;
    int rowown = 0;
    DI void init(const void* A_, const void* B_, int M, int N, int K_, int lda_, int ldb_, int G_, int c_) { A = (const char*)A_; B = (const char*)B_; K = K_; lda = lda_; ldb = ldb_; nM = M / BM; nN = N / BM; nwg = nM * nN; G = G_; c = c_; }
    DI bool next(int i, Unit& u) const {
        if (rowown) { const int pmi = c + (i / nN) * G; if (pmi >= nM) return false; u.pm = pmi; u.pn = i % nN; u.aux = 0; return true; }
        const long L = (long)i * G + c; if (L >= nwg) return false;
        int wgid = (int)L; { const int q = nwg / 8, r = nwg % 8, xcd = wgid % 8, off = wgid / 8; wgid = (xcd < r ? xcd * (q + 1) : r * (q + 1) + (xcd - r) * q) + off; }
        const int nig = 8 * nN, gid = wgid / nig, fm = gid * 8, gsz = (nM - fm) < 8 ? (nM - fm) : 8;
        u.pm = fm + ((wgid % nig) % gsz); u.pn = (wgid % nig) / gsz; u.aux = 0; return true;
    }
    DI const char* a_ptr(const Unit& u) const { return A + (size_t)u.pm * BM * lda * 2 + (u.pn >= akoff_pn ? akoff_bytes : 0); }
    DI const char* b_ptr(const Unit& u) const { return B + (size_t)u.pn * BM * ldb * 2; }
};
struct GroupSched {
    static constexpr bool GATHER = false, FP8 = false;
    const char* A; const char* B; int K, lda, ldb, nMg, nN, nwg, G, c;
    DI void init(const void* A_, const void* B_, int K_, int lda_, int ldb_, int nMg_, int nN_, int G_, int c_) { A = (const char*)A_; B = (const char*)B_; K = K_; lda = lda_; ldb = ldb_; nMg = nMg_; nN = nN_; nwg = 32 * nMg * nN; G = G_; c = c_; }
    DI bool next(int i, Unit& u) const {
        const int L = i * G + c; if (L >= nwg) return false;
        const int per = nMg * nN, g = L / per, rem = L % per; u.pm = g * nMg + rem / nN; u.pn = rem % nN; u.aux = g; return true;
    }
    DI const char* a_ptr(const Unit& u) const { return A + (size_t)u.pm * BM * lda * 2; }
    DI const char* b_ptr(const Unit& u) const { return B + ((size_t)u.aux * nN + u.pn) * BM * ldb * 2; }
};
template <bool GATH>
struct MoeSched {
    static constexpr bool GATHER = GATH, FP8 = true;
    const char* A; const char* B; const int* tile_e; const int* rowtok; int K, lda, ldb, nN, NperE, nwg, G, c;
    DI void init(const void* A_, const void* B_, const int* te, const int* rt, int ntiles, int K_, int nN_, int G_, int c_) { A = (const char*)A_; B = (const char*)B_; tile_e = te; rowtok = rt; K = K_; lda = K_; ldb = K_; nN = nN_; NperE = nN_ * BM; nwg = ntiles * nN_; G = G_; c = c_; }
    DI bool next(int i, Unit& u) const {
        int L = i * G + c; if (L >= nwg) return false;
        if (G == 256 && (i + 1) * G <= nwg) { const int x = c & 7, sl = c >> 3, mt = G / nN / 8;
            L = i * G + (x * mt + sl / nN) * nN + (sl % nN); }
        u.pm = L / nN; u.pn = L % nN; u.aux = __builtin_amdgcn_readfirstlane(__hip_atomic_load(tile_e + u.pm, __ATOMIC_RELAXED, __HIP_MEMORY_SCOPE_AGENT)); return true;
    }
    DI const char* a_ptr(const Unit& u) const { return GATH ? A : A + (size_t)u.pm * BM * lda * 2; }
    DI unsigned a_rowoff(const Unit& u, int row) const { return (unsigned)__hip_atomic_load(rowtok + u.pm * BM + row, __ATOMIC_RELAXED, __HIP_MEMORY_SCOPE_AGENT) * (unsigned)(lda * 2); }
    DI const char* b_ptr(const Unit& u) const { return B + ((size_t)u.aux * NperE + (size_t)u.pn * BM) * ldb * 2; }
};

typedef f32x4 AccT[2][2][4][2];
struct EpiWin {
    static constexpr bool PERM = true;
    bf16_t* us5; bf16_t* prw; bf16_t* gates;
    DI static u32x4 pack8(const f32x4& v0, const f32x4& v1) { u32x4 w; w.x = cvt_pk_bf16(v0[0], v0[1]); w.y = cvt_pk_bf16(v0[2], v0[3]); w.z = cvt_pk_bf16(v1[0], v1[1]); w.w = cvt_pk_bf16(v1[2], v1[3]); return w; }
    DI void operator()(const AccT& acc, const Unit& u, int wr, int wc, int fr, int fq) const {
        if (u.pn < 2) {
#pragma unroll
            for (int ai = 0; ai < 2; ++ai)
#pragma unroll
                for (int m = 0; m < 4; ++m) { const int r = u.pm * BM + ai * HALF + wr * 64 + m * 16 + fr, b = r >> 12, sq = r & 4095, ch = sq / S5L, j = sq % S5L;
#pragma unroll
                    for (int bj = 0; bj < 2; ++bj) { const int c0 = u.pn * BM + bj * HALF + wc * 32 + 8 * fq, g = c0 >> 4, ci = c0 & 15;
                        *(u32x4*)(us5 + ((size_t)(g * S5ROWS + b * S5NC + ch) * LDU + j * 16 + ci)) = pack8(acc[ai][bj][m][0], acc[ai][bj][m][1]); } }
        } else if (u.pn < 9) {
#pragma unroll
            for (int ai = 0; ai < 2; ++ai)
#pragma unroll
                for (int m = 0; m < 4; ++m) { const int r = u.pm * BM + ai * HALF + wr * 64 + m * 16 + fr;
#pragma unroll
                    for (int bj = 0; bj < 2; ++bj) { const int c0 = u.pn * BM + bj * HALF + wc * 32 + 8 * fq;
                        *(u32x4*)(prw + (size_t)r * RWC + (c0 - 512)) = pack8(acc[ai][bj][m][0], acc[ai][bj][m][1]); } }
        } else {
#pragma unroll
            for (int ai = 0; ai < 2; ++ai)
#pragma unroll
                for (int m = 0; m < 4; ++m) { const int r = u.pm * BM + ai * HALF + wr * 64 + m * 16 + fr;
#pragma unroll
                    for (int bj = 0; bj < 2; ++bj) { const int c0 = u.pn * BM + bj * HALF + wc * 32 + 8 * fq;
                        const f32x4& v0 = acc[ai][bj][m][0]; const f32x4& v1 = acc[ai][bj][m][1];
                        const f32x2 a_ = pk_sigmoid(lo2(v0)), b_ = pk_sigmoid(hi2(v0)), c_ = pk_sigmoid(lo2(v1)), d_ = pk_sigmoid(hi2(v1));
                        u32x4 w; w.x = cvt_pk_bf16(a_.x, a_.y); w.y = cvt_pk_bf16(b_.x, b_.y); w.z = cvt_pk_bf16(c_.x, c_.y); w.w = cvt_pk_bf16(d_.x, d_.y);
                        *(u32x4*)(gates + (size_t)r * 2048 + (c0 - 2304)) = w; } }
        }
    }
};
struct EpiS5State {
    static constexpr bool PERM = false;
    float* sloc;
    DI void operator()(const AccT& acc, const Unit& u, int wr, int wc, int fr, int fq) const {
#pragma unroll
        for (int ai = 0; ai < 2; ++ai)
#pragma unroll
            for (int m = 0; m < 4; ++m) {
                const int r = u.pm * BM + ai * HALF + wr * 64 + m * 16 + fr;
#pragma unroll
                for (int n = 0; n < 2; ++n) *(f32x4*)(sloc + (size_t)r * 128 + wc * 32 + 16 * n + 4 * fq) = acc[ai][0][m][n];
            }
    }
};
struct EpiS5Out {
    static constexpr bool PERM = true;
    bf16_t* ys;
    DI void operator()(const AccT& acc, const Unit& u, int wr, int wc, int fr, int fq) const {
        const int g = u.aux;
#pragma unroll
        for (int ai = 0; ai < 2; ++ai)
#pragma unroll
            for (int m = 0; m < 4; ++m) {
                const int r = u.pm * BM + ai * HALF + wr * 64 + m * 16 + fr;
                const int rc = r - g * S5ROWS;
#pragma unroll
                for (int bj = 0; bj < 2; ++bj) {
                    const int c0 = u.pn * BM + bj * HALF + wc * 32 + 8 * fq;
                    const int t = c0 >> 4, co = c0 & 15;
                    const size_t tok = (size_t)rc * S5L + t;
                    f32x4 v0 = acc[ai][bj][m][0], v1 = acc[ai][bj][m][1];
                    { const f32x2 a_ = pk_gelu_tanh(lo2(v0)), b_ = pk_gelu_tanh(hi2(v0)), c_ = pk_gelu_tanh(lo2(v1)), d_ = pk_gelu_tanh(hi2(v1));
                      v0 = (f32x4){a_.x, a_.y, b_.x, b_.y}; v1 = (f32x4){c_.x, c_.y, d_.x, d_.y}; }
                    u32x4 w; w.x = cvt_pk_bf16(v0[0], v0[1]); w.y = cvt_pk_bf16(v0[2], v0[3]); w.z = cvt_pk_bf16(v1[0], v1[1]); w.w = cvt_pk_bf16(v1[2], v1[3]);
                    *(u32x4*)(ys + tok * 512 + g * 16 + co) = w;
                }
            }
    }
};
struct EpiLora {
    static constexpr bool PERM = true;
    bf16_t* lwag; const float* w0; const float* a0;
    DI void operator()(const AccT& acc, const Unit& u, int wr, int wc, int fr, int fq) const {
#pragma unroll
        for (int bj = 0; bj < 2; ++bj) {
            const int c0 = u.pn * BM + bj * HALF + wc * 32 + 8 * fq;
            f32x4 b0 = (f32x4){0.f, 0.f, 0.f, 0.f}, b1 = b0;
            if (c0 < 512) { b0 = *(const f32x4*)(w0 + c0); b1 = *(const f32x4*)(w0 + c0 + 4); } else if (c0 < 1024) { b0 = *(const f32x4*)(a0 + c0 - 512); b1 = *(const f32x4*)(a0 + c0 - 508); }
            const f32x2 bias[4] = {lo2(b0), hi2(b0), lo2(b1), hi2(b1)};
            const float osc = (c0 < 512) ? -0.6065306597f : 1.0f;
            if (c0 < 1024) {
#pragma unroll
                for (int ai = 0; ai < 2; ++ai)
#pragma unroll
                    for (int m = 0; m < 4; ++m) { const int r = u.pm * BM + ai * HALF + wr * 64 + m * 16 + fr; u32x4 w;
#pragma unroll
                        for (int jp = 0; jp < 4; ++jp) { const f32x4& a = acc[ai][bj][m][jp >> 1]; const f32x2 v = pk_sigmoid(((jp & 1) ? hi2(a) : lo2(a)) + bias[jp]) * osc; w[jp] = cvt_pk_bf16(v.x, v.y); }
                        *(u32x4*)(lwag + (size_t)r * 1536 + c0) = w; }
            } else {
#pragma unroll
                for (int ai = 0; ai < 2; ++ai)
#pragma unroll
                    for (int m = 0; m < 4; ++m) { const int r = u.pm * BM + ai * HALF + wr * 64 + m * 16 + fr; u32x4 w;
#pragma unroll
                        for (int jp = 0; jp < 4; ++jp) { const f32x4& a = acc[ai][bj][m][jp >> 1]; const f32x2 v = (jp & 1) ? hi2(a) : lo2(a); w[jp] = cvt_pk_bf16(v.x, v.y); }
                        *(u32x4*)(lwag + (size_t)r * 1536 + c0) = w; }
            }
        }
    }
};
struct EpiGlu {
    static constexpr bool PERM = true;
    bf16_t* mixed; const bf16_t* gates; const float* bglu;
    DI void operator()(const AccT& acc, const Unit& u, int wr, int wc, int fr, int fq) const {
        const int cw = wc * 32 + 8 * fq, j0 = u.pn * 128 + cw;
        const float* bp = bglu + u.pn * 256 + cw;
        const f32x4 ba0 = *(const f32x4*)bp, ba1 = *(const f32x4*)(bp + 4), bb0 = *(const f32x4*)(bp + 128), bb1 = *(const f32x4*)(bp + 132);
        const f32x2 ba[4] = {lo2(ba0), hi2(ba0), lo2(ba1), hi2(ba1)}, bb[4] = {lo2(bb0), hi2(bb0), lo2(bb1), hi2(bb1)};
        u32x4 gw[2][4];
#pragma unroll
        for (int ai = 0; ai < 2; ++ai)
#pragma unroll
            for (int m = 0; m < 4; ++m) gw[ai][m] = *(const u32x4*)(gates + (size_t)(u.pm * BM + ai * HALF + wr * 64 + m * 16 + fr) * 2048 + j0);
#pragma unroll
        for (int ai = 0; ai < 2; ++ai)
#pragma unroll
            for (int m = 0; m < 4; ++m) {
                const int r = u.pm * BM + ai * HALF + wr * 64 + m * 16 + fr;
                u32x4 w;
#pragma unroll
                for (int jp = 0; jp < 4; ++jp) {
                    const f32x4& aa = acc[ai][0][m][jp >> 1]; const f32x4& ab = acc[ai][1][m][jp >> 1];
                    const f32x2 za = ((jp & 1) ? hi2(aa) : lo2(aa)) + ba[jp], zb = ((jp & 1) ? hi2(ab) : lo2(ab)) + bb[jp];
                    const unsigned gwd = gw[ai][m][jp]; const f32x2 gt = {bf_lo(gwd), bf_hi(gwd)};
                    const f32x2 o = (gt * za) * pk_sigmoid(zb);
                    w[jp] = cvt_pk_bf16(o.x, o.y);
                }
                *(u32x4*)(mixed + (size_t)r * 1024 + j0) = w;
            }
    }
};
struct EpiWo {
    static constexpr bool PERM = true;
    bf16_t* mixed; const bf16_t* gates;
    DI void operator()(const AccT& acc, const Unit& u, int wr, int wc, int fr, int fq) const {
#pragma unroll
        for (int ai = 0; ai < 2; ++ai) {
            u32x4 gw[4][2], mw[4][2];
#pragma unroll
            for (int m = 0; m < 4; ++m)
#pragma unroll
                for (int bj = 0; bj < 2; ++bj) { const size_t r = (size_t)(u.pm * BM + ai * HALF + wr * 64 + m * 16 + fr); const int c0 = u.pn * BM + bj * HALF + wc * 32 + 8 * fq;
                    gw[m][bj] = *(const u32x4*)(gates + r * 2048 + 1024 + c0); mw[m][bj] = *(const u32x4*)(mixed + r * 1024 + c0); }
#pragma unroll
            for (int m = 0; m < 4; ++m)
#pragma unroll
                for (int bj = 0; bj < 2; ++bj) { const size_t r = (size_t)(u.pm * BM + ai * HALF + wr * 64 + m * 16 + fr); const int c0 = u.pn * BM + bj * HALF + wc * 32 + 8 * fq;
                    u32x4 w;
#pragma unroll
                    for (int jp = 0; jp < 4; ++jp) { const unsigned gwd = gw[m][bj][jp], mwd = mw[m][bj][jp]; const f32x4& a = acc[ai][bj][m][jp >> 1];
                        const f32x2 o = (f32x2){bf_lo(mwd), bf_hi(mwd)} + (f32x2){bf_lo(gwd), bf_hi(gwd)} * ((jp & 1) ? hi2(a) : lo2(a));
                        w[jp] = cvt_pk_bf16(o.x, o.y); }
                    *(u32x4*)(mixed + r * 1024 + c0) = w; }
        }
    }
};
struct EpiOut {
    static constexpr bool PERM = true;
    bf16_t* hb; const float* x;
    DI void operator()(const AccT& acc, const Unit& u, int wr, int wc, int fr, int fq) const {
#pragma unroll
        for (int ai = 0; ai < 2; ++ai) {
            f32x4 xv[4][2][2];
#pragma unroll
            for (int m = 0; m < 4; ++m) { const size_t r = (size_t)(u.pm * BM + ai * HALF + wr * 64 + m * 16 + fr);
#pragma unroll
                for (int bj = 0; bj < 2; ++bj) { const float* xp = x + r * 1024 + u.pn * BM + bj * HALF + wc * 32 + 8 * fq; xv[m][bj][0] = *(const f32x4*)xp; xv[m][bj][1] = *(const f32x4*)(xp + 4); } }
#pragma unroll
            for (int m = 0; m < 4; ++m) { const size_t r = (size_t)(u.pm * BM + ai * HALF + wr * 64 + m * 16 + fr);
#pragma unroll
                for (int bj = 0; bj < 2; ++bj) { const f32x4 v0 = xv[m][bj][0] + acc[ai][bj][m][0], v1 = xv[m][bj][1] + acc[ai][bj][m][1];
                    u32x4 w; w.x = cvt_pk_bf16(v0[0], v0[1]); w.y = cvt_pk_bf16(v0[2], v0[3]); w.z = cvt_pk_bf16(v1[0], v1[1]); w.w = cvt_pk_bf16(v1[2], v1[3]);
                    *(u32x4*)(hb + r * 1024 + u.pn * BM + bj * HALF + wc * 32 + 8 * fq) = w; } }
        }
    }
};
struct EpiRouter {
    static constexpr bool PERM = false;
    float* logits;
    DI void operator()(const AccT& acc, const Unit& u, int wr, int wc, int fr, int fq) const {
        if (wc != 0) return;
#pragma unroll
        for (int n = 0; n < 2; ++n) {
            const int c = 16 * n + 4 * fq;
#pragma unroll
            for (int ai = 0; ai < 2; ++ai)
#pragma unroll
                for (int m = 0; m < 4; ++m) {
                    const size_t r = (size_t)(u.pm * BM + ai * HALF + wr * 64 + m * 16 + fr);
                    *(f32x4*)(logits + r * 32 + c) = acc[ai][0][m][n];
                }
        }
    }
};
struct EpiMoe1 {
    static constexpr bool PERM = true;
    unsigned char* act; const float* b1p;
    DI void operator()(const AccT& acc, const Unit& u, int wr, int wc, int fr, int fq) const {
        const int cw = wc * 32 + 8 * fq, j0 = u.pn * 128 + cw;
        const float* bp = b1p + (size_t)u.aux * 2048 + u.pn * 256 + cw;
        const f32x4 ba0 = *(const f32x4*)bp, ba1 = *(const f32x4*)(bp + 4), bb0 = *(const f32x4*)(bp + 128), bb1 = *(const f32x4*)(bp + 132);
        const f32x2 ba[4] = {lo2(ba0), hi2(ba0), lo2(ba1), hi2(ba1)}, bb[4] = {lo2(bb0), hi2(bb0), lo2(bb1), hi2(bb1)};
        constexpr float sc = 1.0f / (F8_SX * F8_SW);
#pragma unroll
        for (int ai = 0; ai < 2; ++ai)
#pragma unroll
            for (int m = 0; m < 4; ++m) {
                const size_t r = (size_t)(u.pm * BM + ai * HALF + wr * 64 + m * 16 + fr);
                f32x2 o[4];
#pragma unroll
                for (int jp = 0; jp < 4; ++jp) {
                    const f32x4& ag = acc[ai][0][m][jp >> 1]; const f32x4& al_ = acc[ai][1][m][jp >> 1];
                    const f32x2 g = ((jp & 1) ? hi2(ag) : lo2(ag)) * sc + ba[jp], l = ((jp & 1) ? hi2(al_) : lo2(al_)) * sc + bb[jp];
                    const f32x2 xg = __builtin_elementwise_min(g, (f32x2){7.0f, 7.0f});
                    const f32x2 xl = __builtin_elementwise_min(__builtin_elementwise_max(l, (f32x2){-7.0f, -7.0f}), (f32x2){7.0f, 7.0f});
                    o[jp] = (xg * pk_sigmoid_scaled(xg, -1.702f * 1.44269504f)) * (xl * F8_SA + F8_SA);
                }
                u32x2 w; w.x = pk4_fp8_nc(o[0], o[1]); w.y = pk4_fp8_nc(o[2], o[3]);
                *(u32x2*)(act + r * 1024 + j0) = w;
            }
    }
};
struct EpiMoe2 {
    static constexpr bool PERM = true;
    unsigned char* y2; const float* b2; const float* rowg;
    DI void operator()(const AccT& acc, const Unit& u, int wr, int wc, int fr, int fq) const {
        float gt[2][4];
#pragma unroll
        for (int ai = 0; ai < 2; ++ai)
#pragma unroll
            for (int m = 0; m < 4; ++m) gt[ai][m] = rowg[(size_t)(u.pm * BM + ai * HALF + wr * 64 + m * 16 + fr)] * F8_SY;
#pragma unroll
        for (int bj = 0; bj < 2; ++bj) {
            const int c0 = u.pn * BM + bj * HALF + wc * 32 + 8 * fq;
            const f32x4 bva = *(const f32x4*)(b2 + (size_t)u.aux * 1024 + c0), bvb = *(const f32x4*)(b2 + (size_t)u.aux * 1024 + c0 + 4);
            const f32x2 bv[4] = {lo2(bva), hi2(bva), lo2(bvb), hi2(bvb)};
#pragma unroll
            for (int ai = 0; ai < 2; ++ai)
#pragma unroll
                for (int m = 0; m < 4; ++m) {
                    const size_t r = (size_t)(u.pm * BM + ai * HALF + wr * 64 + m * 16 + fr);
                    const float g = gt[ai][m];
                    f32x2 o[4];
#pragma unroll
                    for (int jp = 0; jp < 4; ++jp) { const f32x4& a = acc[ai][bj][m][jp >> 1];
                        o[jp] = (((jp & 1) ? hi2(a) : lo2(a)) * (1.0f / (F8_SA * F8_SW)) + bv[jp]) * g;
                        o[jp] = __builtin_elementwise_min(__builtin_elementwise_max(o[jp], (f32x2){-448.f, -448.f}), (f32x2){448.f, 448.f}); }
                    u32x2 w; w.x = pk4_fp8_nc(o[0], o[1]); w.y = pk4_fp8_nc(o[2], o[3]);
                    *(u32x2*)(y2 + r * 1024 + c0) = w;
                }
        }
    }
};
struct KArgs { const float* in[34]; float* out; unsigned char* ws; int ph_lo, ph_hi; };
struct Frame {
    LAS unsigned char* lds; int tid, lane, wave, G, bid;
    const float* const* in; float* out; unsigned char* ws;
};

template <class MP>
DI void conv_T(const Frame& F, const float* src, size_t src_bstride, int ld, bf16_t* dst, int N, int K, int nbatch, MP mp, int t0 = 0, int t1 = 0x7fffffff) {
    LAS unsigned* tile = (LAS unsigned*)F.lds;
    const int ntk = K / 64, ntn = N / 256, per = ntk * ntn;
    const int tend = (per * nbatch) < t1 ? (per * nbatch) : t1;
    for (int t = t0 + F.bid; t < tend; t += F.G) {
        const int bt = t / per, tt = t % per, tk = tt % ntk, pn = tt / ntk;
        const float* s = src + (size_t)bt * src_bstride + (size_t)(tk * 64) * ld + mp.src(pn, F.lane);
        f32x4 va[4], vb[4];
#pragma unroll
        for (int i = 0; i < 4; ++i) { const int kp = F.wave + 8 * i; va[i] = *(const f32x4*)(s + (size_t)(2 * kp) * ld); vb[i] = *(const f32x4*)(s + (size_t)(2 * kp + 1) * ld); }
#pragma unroll
        for (int i = 0; i < 4; ++i) { const int kp = F.wave + 8 * i;
#pragma unroll
            for (int j = 0; j < 4; ++j) tile[mp.dst(F.lane, j) * 33 + kp] = cvt_pk_bf16(va[i][j], vb[i][j]); }
        __syncthreads();
        unsigned* d = (unsigned*)(dst + (size_t)bt * N * K + (size_t)(pn * 256) * K + tk * 64);
#pragma unroll
        for (int i = 0; i < 4; ++i) { const int pc = F.tid + NTHR * i, nn = pc >> 3, seg = pc & 7;
            u32x4 w; w.x = tile[nn * 33 + seg * 4]; w.y = tile[nn * 33 + seg * 4 + 1]; w.z = tile[nn * 33 + seg * 4 + 2]; w.w = tile[nn * 33 + seg * 4 + 3];
            *(u32x4*)(d + ((size_t)nn * K) / 2 + seg * 4) = w; }
        __syncthreads();
    }
}
template <class MP>
DI void conv_T8(const Frame& F, const float* src, size_t src_bstride, int ld, unsigned char* dst, int N, int K, int nbatch, MP mp, float scale, int t0 = 0, int t1 = 0x7fffffff) {
    LAS unsigned* tile = (LAS unsigned*)F.lds;
    const int ntk = K / 64, ntn = N / 256, per = ntk * ntn;
    const int tend = (per * nbatch) < t1 ? (per * nbatch) : t1;
    for (int t = t0 + F.bid; t < tend; t += F.G) {
        const int bt = t / per, tt = t % per, tk = tt % ntk, pn = tt / ntk;
        const float* s = src + (size_t)bt * src_bstride + (size_t)(tk * 64) * ld + mp.src(pn, F.lane);
        f32x4 v[2][4];
#pragma unroll
        for (int i = 0; i < 2; ++i) { const int kq = F.wave + 8 * i;
#pragma unroll
            for (int e = 0; e < 4; ++e) v[i][e] = *(const f32x4*)(s + (size_t)(4 * kq + e) * ld); }
#pragma unroll
        for (int i = 0; i < 2; ++i) { const int kq = F.wave + 8 * i;
#pragma unroll
            for (int j = 0; j < 4; ++j) tile[mp.dst(F.lane, j) * 17 + kq] = pk4_fp8(v[i][0][j] * scale, v[i][1][j] * scale, v[i][2][j] * scale, v[i][3][j] * scale); }
        __syncthreads();
        unsigned char* d = dst + ((size_t)bt * N + (size_t)pn * 256) * K + tk * 64;
#pragma unroll
        for (int i = 0; i < 2; ++i) { const int pc = F.tid + NTHR * i, nn = pc >> 2, seg = pc & 3;
            u32x4 w; w.x = tile[nn * 17 + seg * 4]; w.y = tile[nn * 17 + seg * 4 + 1]; w.z = tile[nn * 17 + seg * 4 + 2]; w.w = tile[nn * 17 + seg * 4 + 3];
            *(u32x4*)(d + (size_t)nn * K + seg * 16) = w; }
        __syncthreads();
    }
}
struct MpId  { DI int src(int pn, int f) const { return pn * 256 + 4 * f; } DI int dst(int f, int j) const { return 4 * f + j; } };
struct MpSwi { DI int src(int pn, int f) const { return pn * 256 + 4 * f; } DI int dst(int f, int j) const { const int n = 4 * f + j; return (n >> 1) + 128 * (n & 1); } };
struct MpGlu { DI int src(int pn, int f) const { const int w = 4 * f; return pn * 128 + (w & 127) + 1024 * (w >> 7); } DI int dst(int f, int j) const { return 4 * f + j; } };
struct CmGlu { DI int operator()(int n) const { const int pn = n >> 8, w = n & 255; return pn * 128 + (w & 127) + 1024 * (w >> 7); } };
struct CmSwi { DI int operator()(int n) const { const int pn = n >> 8, w = n & 255; return 2 * (pn * 128 + (w & 127)) + (w >> 7); } };

DI void rmsnorm_rows(const Frame& F, const float* x, const float* g, bf16_t* out, int row0, int nrows, unsigned char* out8 = nullptr) {
    const int stride = F.G * NWAVES;
    for (int row = row0 + F.bid * NWAVES + F.wave; row < row0 + nrows; row += 2 * stride) {
        const int row2 = (row + stride < row0 + nrows) ? row + stride : row;
        const f32x4* xr = (const f32x4*)(x + (size_t)row * D); const f32x4* xr2 = (const f32x4*)(x + (size_t)row2 * D);
        f32x4 v[4], u[4]; float ss = 0.f, su = 0.f;
#pragma unroll
        for (int i = 0; i < 4; ++i) { v[i] = xr[i * 64 + F.lane]; u[i] = xr2[i * 64 + F.lane]; }
#pragma unroll
        for (int i = 0; i < 4; ++i) { ss += v[i][0] * v[i][0] + v[i][1] * v[i][1] + v[i][2] * v[i][2] + v[i][3] * v[i][3]; su += u[i][0] * u[i][0] + u[i][1] * u[i][1] + u[i][2] * u[i][2] + u[i][3] * u[i][3]; }
        ss = wave_sum(ss); su = wave_sum(su);
        const float rs = rsqrtf(ss * (1.0f / D) + 1e-5f), ru = rsqrtf(su * (1.0f / D) + 1e-5f);
#pragma unroll
        for (int i = 0; i < 4; ++i) { const f32x4 gv = ((const f32x4*)g)[i * 64 + F.lane];
            u32x2 w; w.x = cvt_pk_bf16(v[i][0] * rs * gv[0], v[i][1] * rs * gv[1]); w.y = cvt_pk_bf16(v[i][2] * rs * gv[2], v[i][3] * rs * gv[3]);
            *(u32x2*)(out + (size_t)row * D + (i * 64 + F.lane) * 4) = w;
            u32x2 w2; w2.x = cvt_pk_bf16(u[i][0] * ru * gv[0], u[i][1] * ru * gv[1]); w2.y = cvt_pk_bf16(u[i][2] * ru * gv[2], u[i][3] * ru * gv[3]);
            *(u32x2*)(out + (size_t)row2 * D + (i * 64 + F.lane) * 4) = w2;
            if (out8) { *(unsigned*)(out8 + (size_t)row * D + (i * 64 + F.lane) * 4) = pk4_fp8(v[i][0] * rs * gv[0] * F8_SX, v[i][1] * rs * gv[1] * F8_SX, v[i][2] * rs * gv[2] * F8_SX, v[i][3] * rs * gv[3] * F8_SX);
                *(unsigned*)(out8 + (size_t)row2 * D + (i * 64 + F.lane) * 4) = pk4_fp8(u[i][0] * ru * gv[0] * F8_SX, u[i][1] * ru * gv[1] * F8_SX, u[i][2] * ru * gv[2] * F8_SX, u[i][3] * ru * gv[3] * F8_SX); } }
    }
}

DI void p0_prologue(const Frame& F) {
    unsigned char* ws = F.ws;
    conv_T(F, F.in[2], 0, INC, (bf16_t*)(ws + WS_WIN), INC, D, 1, MpId());
    conv_T(F, F.in[11], 0, 2048, (bf16_t*)(ws + WS_WGLU), 2048, 512, 1, MpGlu());
    conv_T(F, F.in[24], 0, 1024, (bf16_t*)(ws + WS_WO), 1024, 512, 1, MpId());
    conv_T(F, F.in[25], 0, 1024, (bf16_t*)(ws + WS_WOUT), 1024, 1024, 1, MpId());
    {
        bf16_t* wl = (bf16_t*)(ws + WS_WLORA); const float* w2 = F.in[15]; const float* a2 = F.in[17]; const float* g2 = F.in[18];
        for (int idx = F.bid * NTHR + F.tid; idx < 1536 * 128; idx += F.G * NTHR) { const int n = idx >> 7, k = idx & 127; float v = 0.f;
            if (n < 512) { if (k < 64) v = w2[k * 512 + n]; } else if (n < 1024) { if (k >= 64) v = a2[(k - 64) * 512 + (n - 512)]; } else { v = g2[k * 512 + (n - 1024)]; }
            wl[idx] = f2bf(v); }
        bf16_t* wrt = (bf16_t*)(ws + WS_WR); const float* rw = F.in[27];
        for (int idx = F.bid * NTHR + F.tid; idx < 256 * 1024; idx += F.G * NTHR) { const int n = idx >> 10, k = idx & 1023; wrt[idx] = f2bf(n < 32 ? rw[k * 32 + n] * F.in[26][k] : 0.f); }
        float* bg = (float*)(ws + WS_BGLU); const float* bsrc = F.in[12]; CmGlu cm;
        for (int idx = F.bid * NTHR + F.tid; idx < 2048; idx += F.G * NTHR) bg[idx] = bsrc[cm(idx)];
    }
    if (F.bid & 1) rmsnorm_rows(F, F.in[0], F.in[1], (bf16_t*)(ws + WS_XN), 0, T);
    {
        LAS float* L = (LAS float*)F.lds;
        LAS float* pwr = L, *pwi = L + 64, *p1r = L + 128, *p1i = L + 192, *ffr = L + 256, *ffi = L + 320;
        LAS float* bbr = L + 384, *bbi = bbr + 1024, *ccr = bbi + 1024, *cci = ccr + 1024, *kj = cci + 1024;
        const float* lam_re = F.in[3]; const float* lam_im = F.in[4]; const float* log_dt = F.in[5];
        const float* b_re = F.in[6]; const float* b_im = F.in[7]; const float* c_re = F.in[8]; const float* c_im = F.in[9]; const float* dsk = F.in[10];
        unsigned* toep = (unsigned*)(ws + WS_TOEP); unsigned* wst = (unsigned*)(ws + WS_WST);
        for (int it = F.bid; it < 32 * S5L; it += F.G) {
            const int g = it / S5L, j = it % S5L;
            if (F.tid < 64) { const int p = F.tid; const float lr = lam_re[g * 64 + p], li = lam_im[g * 64 + p], dt = __expf(log_dt[g]);
                float sn, cs; { const float mg = expf((float)j * lr * dt); sincosf((float)j * (li * dt), &sn, &cs); pwr[p] = mg * cs; pwi[p] = mg * sn; }
                { const float mg = expf((float)(j + 1) * lr * dt); sincosf((float)(j + 1) * (li * dt), &sn, &cs); p1r[p] = mg * cs; p1i[p] = mg * sn; }
                { const float mg = expf(lr * dt); sincosf(li * dt, &sn, &cs); const float nr = mg * cs - 1.0f, ni = mg * sn, den = lr * lr + li * li;
                  ffr[p] = (nr * lr + ni * li) / den; ffi[p] = (ni * lr - nr * li) / den; } }
            __syncthreads();
            for (int idx = F.tid; idx < 1024; idx += NTHR) { const int p = idx >> 4; const float br = b_re[g * 1024 + idx], bi = b_im[g * 1024 + idx];
                bbr[idx] = ffr[p] * br - ffi[p] * bi; bbi[idx] = ffr[p] * bi + ffi[p] * br;
                ccr[idx] = c_re[g * 1024 + idx]; cci[idx] = c_im[g * 1024 + idx]; }
            __syncthreads();
            if (F.tid < 256) { const int co = F.tid >> 4, ci = F.tid & 15; float s = 0.f;
                for (int p = 0; p < 64; ++p) { const float zr = pwr[p] * bbr[p * 16 + ci] - pwi[p] * bbi[p * 16 + ci], zi = pwr[p] * bbi[p * 16 + ci] + pwi[p] * bbr[p * 16 + ci];
                    s += ccr[co * 64 + p] * zr - cci[co * 64 + p] * zi; }
                if (j == 0 && co == ci) s += dsk[g * 16 + co];
                kj[F.tid] = s; }
            __syncthreads();
            for (int idx = F.tid; idx < (S5L - j) * 128; idx += NTHR) { const int t = j + idx / 128, rem = idx % 128, co = rem >> 3, ci = (rem & 7) * 2;
                toep[((size_t)(g * 512 + t * 16 + co) * LDU + (t - j) * 16 + ci) / 2] = cvt_pk_bf16(kj[co * 16 + ci], kj[co * 16 + ci + 1]);
                if (j > 0) toep[((size_t)(g * 512 + (t - j) * 16 + co) * LDU + t * 16 + ci) / 2] = 0u; }
            for (int idx = F.tid; idx < 16 * 64; idx += NTHR) { const int co = idx >> 6, q = (idx & 63) * 2; float o[2];
#pragma unroll
                for (int e = 0; e < 2; ++e) { const int qq = q + e, p = qq & 63; const float cr = ccr[co * 64 + p], cim = cci[co * 64 + p];
                    o[e] = (qq < 64) ? (cr * p1r[p] - cim * p1i[p]) : -(cr * p1i[p] + cim * p1r[p]); }
                toep[((size_t)(g * 512 + j * 16 + co) * LDU + 512 + q) / 2] = cvt_pk_bf16(o[0], o[1]); }
            { const int s = S5L - 1 - j;
              for (int idx = F.tid; idx < 256 * 8; idx += NTHR) { const int q = idx >> 3, ci = (idx & 7) * 2; float o[2] = {0.f, 0.f};
                if (q < 128) { const int p = q & 63;
#pragma unroll
                    for (int e = 0; e < 2; ++e) { const float br = bbr[p * 16 + ci + e], bi = bbi[p * 16 + ci + e];
                        o[e] = (q < 64) ? (pwr[p] * br - pwi[p] * bi) : (pwr[p] * bi + pwi[p] * br); } }
                wst[((size_t)(g * 256 + q) * 512 + s * 16 + ci) / 2] = cvt_pk_bf16(o[0], o[1]); } }
            __syncthreads();
        }
    }
    if (!(F.bid & 1)) rmsnorm_rows(F, F.in[0], F.in[1], (bf16_t*)(ws + WS_XN), 0, T);
}

DI void p_rw_prep(const Frame& F) {
    const bf16_t* prw = (const bf16_t*)(F.ws + WS_PRW); bf16_t* al_ = (bf16_t*)(F.ws + WS_ALORA); const float* mu = F.in[13];
    for (int idx = F.bid * NTHR + F.tid; idx < T * 32; idx += F.G * NTHR) {
        const int t = idx >> 5, c8 = (idx & 31) * 8;
        const u32x4 cur = *(const u32x4*)(prw + (size_t)t * RWC + 1536 + c8);
        u32x4 prv = (u32x4){0u, 0u, 0u, 0u};
        if ((t & (SEQ - 1)) != 0) prv = *(const u32x4*)(prw + (size_t)(t - 1) * RWC + 1536 + c8);
        float o[8];
#pragma unroll
        for (int j = 0; j < 8; ++j) { const float c = (j & 1) ? bf_hi(cur[j >> 1]) : bf_lo(cur[j >> 1]), p = (j & 1) ? bf_hi(prv[j >> 1]) : bf_lo(prv[j >> 1]);
            const float xs = c + mu[1536 + c8 + j] * (p - c);
            o[j] = (c8 < 64) ? ftanh(xs) : ((c8 < 128) ? xs : fsigmoid(xs)); }
        u32x4 w; w.x = cvt_pk_bf16(o[0], o[1]); w.y = cvt_pk_bf16(o[2], o[3]); w.z = cvt_pk_bf16(o[4], o[5]); w.w = cvt_pk_bf16(o[6], o[7]);
        *(u32x4*)(al_ + (size_t)t * 256 + c8) = w;
    }
}

DI void p_s5_carry(const Frame& F) {
    const float* lam_re = F.in[3]; const float* lam_im = F.in[4]; const float* log_dt = F.in[5];
    const float* sloc = (const float*)(F.ws + WS_SLOC); bf16_t* us5 = (bf16_t*)(F.ws + WS_US5);
    for (int gt = F.bid * NTHR + F.tid; gt < NB * 32 * 64; gt += F.G * NTHR) {
        const int p = gt & 63, g = (gt >> 6) & 31, b = gt >> 11;
        const float lr = lam_re[g * 64 + p], li = lam_im[g * 64 + p], dt = __expf(log_dt[g]);
        float sn, cs; const float mg = expf((float)S5L * lr * dt); sincosf((float)S5L * (li * dt), &sn, &cs);
        const float ar = mg * cs, ai = mg * sn;
        float xr = 0.f, xi = 0.f;
        const size_t row0 = (size_t)g * S5ROWS + (size_t)b * S5NC;
        for (int cb = 0; cb < S5NC; cb += 16) {
            float sr[16], si[16];
#pragma unroll
            for (int j = 0; j < 16; ++j) { sr[j] = sloc[(row0 + cb + j) * 128 + p]; si[j] = sloc[(row0 + cb + j) * 128 + 64 + p]; }
#pragma unroll
            for (int j = 0; j < 16; ++j) { const size_t row = row0 + cb + j;
                us5[row * LDU + 512 + p] = f2bf(xr); us5[row * LDU + 576 + p] = f2bf(xi);
                const float nr = ar * xr - ai * xi + sr[j], ni = ar * xi + ai * xr + si[j];
                xr = nr; xi = ni; }
        }
    }
}

constexpr int PT = 72, SLOTB = 64 * PT * 2;
DI LAS bf16_t* rslot(LAS unsigned char* lds, int i) { return (LAS bf16_t*)(lds + i * SLOTB); }
DI void mm_acc(f32x4 (&acc)[2], const LAS bf16_t* A, const LAS bf16_t* Bt, int ti, int tj0, int r, int q) {
#pragma unroll
    for (int s2 = 0; s2 < 2; ++s2) {
        const bf16x8 a = *(const LAS bf16x8*)(A + (16 * ti + r) * PT + 32 * s2 + 8 * q);
#pragma unroll
        for (int e = 0; e < 2; ++e) { const bf16x8 b = *(const LAS bf16x8*)(Bt + (16 * (tj0 + e) + r) * PT + 32 * s2 + 8 * q);
            acc[e] = __builtin_amdgcn_mfma_f32_16x16x32_bf16(a, b, acc[e], 0, 0, 0); }
    }
}
DI void mm_acc_bnat(f32x4 (&acc)[2], const LAS bf16_t* A, const LAS bf16_t* Bn, int ti, int tj0, int r, int q) {
#pragma unroll
    for (int s2 = 0; s2 < 2; ++s2) {
        const bf16x8 a = *(const LAS bf16x8*)(A + (16 * ti + r) * PT + 32 * s2 + 8 * q);
#pragma unroll
        for (int e = 0; e < 2; ++e) { bf16x8 b;
#pragma unroll
            for (int jj = 0; jj < 8; ++jj) b[jj] = (short)Bn[(32 * s2 + 8 * q + jj) * PT + 16 * (tj0 + e) + r];
            acc[e] = __builtin_amdgcn_mfma_f32_16x16x32_bf16(a, b, acc[e], 0, 0, 0); }
    }
}
DI void st_rm(LAS bf16_t* Dm, const f32x4& v, int i0, int j) {
#pragma unroll
    for (int g = 0; g < 4; ++g) Dm[(i0 + g) * PT + j] = f2bf(v[g]);
}
DI void st_tr(LAS bf16_t* Dm, const f32x4& v, int i0, int j) { u32x2 w; w.x = cvt_pk_bf16(v[0], v[1]); w.y = cvt_pk_bf16(v[2], v[3]); *(LAS u32x2*)(Dm + j * PT + i0) = w; }
DI f32x4 ld_rm(const LAS bf16_t* Sm, int i0, int j) { f32x4 v;
#pragma unroll
    for (int g = 0; g < 4; ++g) v[g] = bf2f(Sm[(i0 + g) * PT + j]);
    return v; }
DI void ld_frag(bf16x8 (&f)[2], const LAS bf16_t* M, int row, int q) { f[0] = *(const LAS bf16x8*)(M + row * PT + 8 * q); f[1] = *(const LAS bf16x8*)(M + row * PT + 32 + 8 * q); }
DI f32x4 mm2(const bf16x8 (&x)[2], const bf16x8 (&y)[2], f32x4 c) { c = __builtin_amdgcn_mfma_f32_16x16x32_bf16(x[0], y[0], c, 0, 0, 0); return __builtin_amdgcn_mfma_f32_16x16x32_bf16(x[1], y[1], c, 0, 0, 0); }
typedef short v4i16_t __attribute__((ext_vector_type(4)));
DI void ld_frag_tr(bf16x8 (&f)[2], const LAS bf16_t* XT, int T0, int r, int q) {
#pragma unroll
    for (int s2 = 0; s2 < 2; ++s2) { const LAS bf16_t* p = XT + (32 * s2 + 8 * q + (r >> 2)) * PT + T0 + 4 * (r & 3);
        const v4i16_t lo = __builtin_amdgcn_ds_read_tr16_b64_v4i16((LAS v4i16_t*)p), hi = __builtin_amdgcn_ds_read_tr16_b64_v4i16((LAS v4i16_t*)(p + 4 * PT));
        f[s2] = __builtin_shufflevector(lo, hi, 0, 1, 2, 3, 4, 5, 6, 7); }
}
DI void st_sw(LAS bf16_t* Dm, const f32x4& v, int i, int j0) { u32x2 w; w.x = cvt_pk_bf16(v[0], v[1]); w.y = cvt_pk_bf16(v[2], v[3]); *(LAS u32x2*)(Dm + i * PT + j0) = w; }
DI f32x4 ld_sw(const LAS bf16_t* Sm, int i, int j0) { const u32x2 w = *(const LAS u32x2*)(Sm + i * PT + j0); return (f32x4){bf_lo(w.x), bf_hi(w.x), bf_lo(w.y), bf_hi(w.y)}; }
#define ZACC(a) do { a[0] = (f32x4){0.f, 0.f, 0.f, 0.f}; a[1] = (f32x4){0.f, 0.f, 0.f, 0.f}; } while (0)

DI float wave_sum2(float v) { return xrow_sum(row_sum16(v)); }
#define LSYNC() do { asm volatile("s_waitcnt lgkmcnt(0)" ::: "memory"); __builtin_amdgcn_s_barrier(); asm volatile("" ::: "memory"); } while (0)

struct RaRaw { bf16_t r[9], k[9], v[9], lw[8], a[8]; };
DI void ra_load(RaRaw& x, const bf16_t* prw, const bf16_t* lwag, int ci, int w, int lane) {
    const int bh = ci >> 6, c = ci & 63, b = bh >> 3, h = bh & 7, ch = h * 64 + lane;
    const size_t tok0 = (size_t)b * SEQ + c * 64 + 8 * w;
    const bool has_prev = !(c == 0 && w == 0);
    const size_t tp = has_prev ? tok0 - 1 : tok0;
    x.r[0] = prw[tp * RWC + ch]; x.k[0] = prw[tp * RWC + 512 + ch]; x.v[0] = prw[tp * RWC + 1024 + ch];
#pragma unroll
    for (int i = 0; i < 8; ++i) { const size_t tok = tok0 + i;
        x.r[i + 1] = prw[tok * RWC + ch]; x.k[i + 1] = prw[tok * RWC + 512 + ch]; x.v[i + 1] = prw[tok * RWC + 1024 + ch];
        x.lw[i] = lwag[tok * 1536 + ch]; x.a[i] = lwag[tok * 1536 + 512 + ch]; }
}
DI void p_rw_chunk(const Frame& F) {
    const bf16_t* prw = (const bf16_t*)(F.ws + WS_PRW); const bf16_t* lwag = (const bf16_t*)(F.ws + WS_LWAG);
    const float* mu = F.in[13]; const float* k_k = F.in[19]; const float* k_a = F.in[20]; const float* r_k = F.in[21];
    float* bonus = (float*)(F.ws + WS_BONUS);
    bf16_t* gM = (bf16_t*)(F.ws + WS_CHK_M); bf16_t* gN0T = (bf16_t*)(F.ws + WS_CHK_N0T); bf16_t* gQ = (bf16_t*)(F.ws + WS_CHK_Q); bf16_t* gY0 = (bf16_t*)(F.ws + WS_CHK_Y0T);
    LAS unsigned char* lds = F.lds;
    LAS float* segtot = (LAS float*)(lds + 14 * SLOTB);
    LAS float* PLs = segtot + 512;
    LAS float* DB = PLs + 64;
    constexpr int PD = 20;
    constexpr int TP = 24;
    LAS bf16_t* TDT = (LAS bf16_t*)(DB + 64 * PD);
    const int w = F.wave, lane = F.lane, r = lane & 15, q = lane >> 4, ti = w >> 1, tj0 = 2 * (w & 1), i0 = 16 * ti + 4 * q;
    LAS bf16_t* S0 = rslot(lds, 0); LAS bf16_t* S1 = rslot(lds, 1); LAS bf16_t* S2 = rslot(lds, 2); LAS bf16_t* S3 = rslot(lds, 3);
    LAS bf16_t* S4 = rslot(lds, 4); LAS bf16_t* S5 = rslot(lds, 5); LAS bf16_t* S6 = rslot(lds, 6); LAS bf16_t* S7 = rslot(lds, 7);
    LAS bf16_t* S8 = rslot(lds, 8); LAS bf16_t* S9 = rslot(lds, 9); LAS bf16_t* S10 = rslot(lds, 10); LAS bf16_t* S11 = rslot(lds, 11);
    LAS bf16_t* S12 = rslot(lds, 12); LAS bf16_t* S13 = rslot(lds, 13);
    RaRaw raw;
    if (F.bid < RW_NCH) ra_load(raw, prw, lwag, F.bid, w, lane);
    for (int ci = F.bid; ci < RW_NCH; ci += F.G) {
        const int bh = ci >> 6, c = ci & 63, b = bh >> 3, h = bh & 7, ch = h * 64 + lane;
        {
            const size_t tok0 = (size_t)b * SEQ + c * 64 + 8 * w;
            const float mur = mu[ch], muk = mu[512 + ch], muv = mu[1024 + ch], kkw = k_k[ch], ka = k_a[ch], rk = r_k[ch];
            const bool has_prev = !(c == 0 && w == 0);
            float xr[9], xk[9], xv[9];
            xr[0] = has_prev ? bf2f(raw.r[0]) : 0.f; xk[0] = has_prev ? bf2f(raw.k[0]) : 0.f; xv[0] = has_prev ? bf2f(raw.v[0]) : 0.f;
#pragma unroll
            for (int i = 1; i < 9; ++i) { xr[i] = bf2f(raw.r[i]); xk[i] = bf2f(raw.k[i]); xv[i] = bf2f(raw.v[i]); }
            f32x2 rr2[4], vv2[4], aa2[4], km2[4], kn2[4], sq2[4], bq2[4]; float cl[8];
            float run = 0.f;
#pragma unroll
            for (int p2 = 0; p2 < 4; ++p2) {
                const f32x2 cr = {xr[2 * p2 + 1], xr[2 * p2 + 2]}, pr = {xr[2 * p2], xr[2 * p2 + 1]};
                const f32x2 ck = {xk[2 * p2 + 1], xk[2 * p2 + 2]}, pk = {xk[2 * p2], xk[2 * p2 + 1]};
                const f32x2 cv = {xv[2 * p2 + 1], xv[2 * p2 + 2]}, pv = {xv[2 * p2], xv[2 * p2 + 1]};
                const f32x2 r_ = cr + (pr - cr) * mur, k_ = ck + (pk - ck) * muk, v_ = cv + (pv - cv) * muv;
                const f32x2 a_ = {bf2f(raw.a[2 * p2]), bf2f(raw.a[2 * p2 + 1])};
                const f32x2 kx = k_ * kkw; sq2[p2] = kx * kx;
                const f32x2 kmod = k_ * (a_ * ka + (1.0f - ka));
                bq2[p2] = (r_ * kmod) * rk;
                rr2[p2] = r_; vv2[p2] = v_; aa2[p2] = a_; km2[p2] = kmod; kn2[p2] = kx;
                run += bf2f(raw.lw[2 * p2]); cl[2 * p2] = run; run += bf2f(raw.lw[2 * p2 + 1]); cl[2 * p2 + 1] = run;
            }
            {
                float A8[8], B4[4], C2[2];
#pragma unroll
                for (int k = 0; k < 4; ++k) { A8[k] = comb32(sq2[k].x, sq2[k].y); A8[4 + k] = comb32(bq2[k].x, bq2[k].y); }
#pragma unroll
                for (int j = 0; j < 4; ++j) B4[j] = comb16(A8[2 * j], A8[2 * j + 1]);
#pragma unroll
                for (int i = 0; i < 2; ++i) { const float t1 = DPP_ADD(B4[2 * i], 0x128), t2 = DPP_ADD(B4[2 * i + 1], 0x128); C2[i] = (lane & 8) ? t2 : t1; }
                const float u1 = DPP_ADD(C2[0], 0x141), u2 = DPP_ADD(C2[1], 0x141);
                float dsum = (lane & 4) ? u2 : u1;
                dsum = DPP_ADD(dsum, 0xB1); dsum = DPP_ADD(dsum, 0x4E);
                if ((lane & 7) == 4) bonus[(tok0 + 4 * ((lane >> 3) & 1) + 2 * ((lane >> 4) & 1) + (lane >> 5)) * 8 + h] = dsum;
                const float rsv = fminf(__builtin_amdgcn_rsqf(dsum), 1e12f);
                const int rsi = __builtin_bit_cast(int, rsv);
                float rs[8];
#pragma unroll
                for (int tt = 0; tt < 8; ++tt) rs[tt] = __builtin_bit_cast(float, __builtin_amdgcn_readlane(rsi, 8 * (tt >> 2) + 16 * ((tt >> 1) & 1) + 32 * (tt & 1)));
#pragma unroll
                for (int p2 = 0; p2 < 4; ++p2) kn2[p2] = kn2[p2] * (f32x2){rs[2 * p2], rs[2 * p2 + 1]};
            }
            segtot[w * 64 + lane] = run;
            LSYNC();
            float pre = 0.f;
            for (int w2 = 0; w2 < w; ++w2) pre += segtot[w2 * 64 + lane];
            if (w == 7) PLs[lane] = __expf(pre + run);
            float ep = __expf(pre);
            unsigned xa[4], xb[4], xkk[4], xrr[4], xvv[4];
#pragma unroll
            for (int p2 = 0; p2 < 4; ++p2) {
                const f32x2 tt = ((f32x2){cl[2 * p2], cl[2 * p2 + 1]} + pre) * 1.44269504f;
                const f32x2 e = {__builtin_amdgcn_exp2f(tt.x), __builtin_amdgcn_exp2f(tt.y)}, en = {__builtin_amdgcn_rcpf(e.x), __builtin_amdgcn_rcpf(e.y)}, epv = {ep, e.x};
                ep = e.y;
                const f32x2 at = -(kn2[p2] * epv), bt = (kn2[p2] * aa2[p2]) * en, kt = km2[p2] * en, rt = rr2[p2] * e;
                xa[p2] = cvt_pk_bf16(at.x, at.y); xb[p2] = cvt_pk_bf16(bt.x, bt.y); xkk[p2] = cvt_pk_bf16(kt.x, kt.y); xrr[p2] = cvt_pk_bf16(rt.x, rt.y); xvv[p2] = cvt_pk_bf16(vv2[p2].x, vv2[p2].y);
                const int t = 8 * w + 2 * p2;
                S6[t * PT + lane] = (bf16_t)(xrr[p2] & 0xffffu); S6[(t + 1) * PT + lane] = (bf16_t)(xrr[p2] >> 16);
            }
            *(LAS u32x4*)(S1 + lane * PT + 8 * w) = (u32x4){xa[0], xa[1], xa[2], xa[3]};
            *(LAS u32x4*)(S3 + lane * PT + 8 * w) = (u32x4){xb[0], xb[1], xb[2], xb[3]};
            *(LAS u32x4*)(S5 + lane * PT + 8 * w) = (u32x4){xkk[0], xkk[1], xkk[2], xkk[3]};
            *(LAS u32x4*)(S7 + lane * PT + 8 * w) = (u32x4){xvv[0], xvv[1], xvv[2], xvv[3]};
        }
        LSYNC();
        if (ci + F.G < RW_NCH) ra_load(raw, prw, lwag, ci + F.G, w, lane);
        f32x4 acc[2];
        const f32x4 Z4 = (f32x4){0.f, 0.f, 0.f, 0.f};
        const int ia = 16 * ti + r, jb0 = 16 * tj0 + r;
        { bf16x8 a0[2], a6[2], b2[2][2], b4[2][2];
          ld_frag_tr(a0, S1, 16 * ti, r, q); ld_frag(a6, S6, ia, q);
#pragma unroll
          for (int e = 0; e < 2; ++e) { ld_frag_tr(b2[e], S3, 16 * (tj0 + e), r, q); ld_frag_tr(b4[e], S5, 16 * (tj0 + e), r, q); }
#pragma unroll
          for (int e = 0; e < 2; ++e) { const int tj = tj0 + e, j = 16 * tj + r, js = 16 * tj + 4 * q;
            const f32x4 c = mm2(a0, b2[e], Z4);
            if (tj == ti) {
#pragma unroll
                for (int g = 0; g < 4; ++g) DB[(ti * 16 + 4 * q + g) * PD + r] = (4 * q + g > r) ? c[g] : 0.f;
            }
            st_tr(S8, (ti > tj) ? c : Z4, i0, j);
            f32x4 v = mm2(b4[e], a0, Z4);
#pragma unroll
            for (int g = 0; g < 4; ++g) v[g] = (ia > js + g) ? v[g] : 0.f;
            st_sw(S9, v, ia, js);
            v = mm2(b2[e], a6, Z4);
#pragma unroll
            for (int g = 0; g < 4; ++g) v[g] = (ia >= js + g) ? v[g] : 0.f;
            st_sw(S10, v, ia, js);
            v = mm2(b4[e], a6, Z4);
#pragma unroll
            for (int g = 0; g < 4; ++g) v[g] = (ia >= js + g) ? v[g] : 0.f;
            st_sw(S11, v, ia, js); } }
        LSYNC();
        ZACC(acc); mm_acc(acc, S9, S7, ti, tj0, r, q);
#pragma unroll
        for (int e = 0; e < 2; ++e) st_tr(S2, acc[e], i0, 16 * (tj0 + e) + r);
        if (w < 4) {
            const int i = lane >> 2, p = lane & 3;
            int io = i; asm volatile("" : "+v"(io));
            const LAS float* Dp = DB + (w * 16 + p) * PD;
            f32x4 Dm[4][4];
#pragma unroll
            for (int m = 0; m < 4; ++m)
#pragma unroll
                for (int c4 = 0; c4 < 4; ++c4) Dm[m][c4] = *(const LAS f32x4*)(Dp + 4 * m * PD + 4 * c4);
            float mine[4] = {0.f, 0.f, 0.f, 0.f}, tr[16];
#pragma unroll
            for (int j = 15; j >= 0; --j) { float part = 0.f;
#pragma unroll
                for (int m = 3; m >= 0; --m) if (4 * m + 3 > j) part = __builtin_fmaf(mine[m], Dm[m][j >> 2][j & 3], part);
                float tot = part + __builtin_bit_cast(float, __builtin_amdgcn_update_dpp(0, __builtin_bit_cast(int, part), 0xB1, 0xf, 0xf, false));
                tot = tot + __builtin_bit_cast(float, __builtin_amdgcn_update_dpp(0, __builtin_bit_cast(int, tot), 0x4E, 0xf, 0xf, false));
                const float trj = (j == io) ? 1.0f : tot;
                tr[j] = trj; mine[j >> 2] = (p == (j & 3)) ? trj : mine[j >> 2]; }
            u32x4 z = (u32x4){0u, 0u, 0u, 0u}, x0, x1;
            x0.x = cvt_pk_bf16(tr[0], tr[1]); x0.y = cvt_pk_bf16(tr[2], tr[3]); x0.z = cvt_pk_bf16(tr[4], tr[5]); x0.w = cvt_pk_bf16(tr[6], tr[7]);
            x1.x = cvt_pk_bf16(tr[8], tr[9]); x1.y = cvt_pk_bf16(tr[10], tr[11]); x1.z = cvt_pk_bf16(tr[12], tr[13]); x1.w = cvt_pk_bf16(tr[14], tr[15]);
            LAS bf16_t* dst = S0 + (16 * w + i) * PT + 16 * p;
            *(LAS u32x4*)dst = (p == w) ? x0 : z; *(LAS u32x4*)(dst + 8) = (p == w) ? x1 : z;
#pragma unroll
            for (int m = 0; m < 4; ++m) TDT[(16 * w + 4 * m + p) * TP + i] = f2bf(mine[m]);
        }
        LSYNC();
        { bf16x8 a[2], b[2][2]; ld_frag(a, S0, ia, q);
#pragma unroll
          for (int e = 0; e < 2; ++e) ld_frag(b[e], S8, jb0 + 16 * e, q);
#pragma unroll
          for (int e = 0; e < 2; ++e) { st_tr(S12, mm2(a, b[e], Z4), i0, 16 * (tj0 + e) + r); st_sw(S4, mm2(b[e], a, Z4), ia, 16 * (tj0 + e) + 4 * q); } }
        LSYNC();
        { bf16x8 a[2], b[2][2]; ld_frag(a, S4, ia, q);
#pragma unroll
          for (int e = 0; e < 2; ++e) ld_frag(b[e], S12, jb0 + 16 * e, q);
          const bf16x8 as = (w & 1) ? a[1] : a[0];
#pragma unroll
          for (int e = 0; e < 2; ++e) { const int tj = tj0 + e, j = 16 * tj + r, js = 16 * tj + 4 * q;
            st_sw(S13, mm2(b[e], a, Z4), ia, js);
            bf16x8 bt = *(const LAS bf16x8*)(TDT + j * TP + 8 * (q & 1));
            if ((q >> 1) != e) bt = (bf16x8){0, 0, 0, 0, 0, 0, 0, 0};
            f32x4 c = Z4;
            if (ti == tj) { const u32x2 wv = *(const LAS u32x2*)(TDT + j * TP + 4 * q); c = (f32x4){bf_lo(wv.x), bf_hi(wv.x), bf_lo(wv.y), bf_hi(wv.y)}; }
            st_tr(S9, __builtin_amdgcn_mfma_f32_16x16x32_bf16(as, bt, c, 0, 0, 0), i0, j);
            st_sw(S8, __builtin_amdgcn_mfma_f32_16x16x32_bf16(bt, as, ld_sw(S0, ia, js), 0, 0, 0), ia, js); } }
        LSYNC();
        { bf16x8 a[2], b[2][2]; ld_frag(a, S13, ia, q);
#pragma unroll
          for (int e = 0; e < 2; ++e) ld_frag(b[e], S9, jb0 + 16 * e, q);
#pragma unroll
          for (int e = 0; e < 2; ++e) { const int js = 16 * (tj0 + e) + 4 * q; st_sw(S12, mm2(b[e], a, ld_sw(S8, ia, js)), ia, js); } }
        LSYNC();
        { bf16x8 a[2], b1[2][2], bx[2][2]; ld_frag(a, S12, ia, q);
#pragma unroll
          for (int e = 0; e < 2; ++e) { ld_frag(b1[e], S1, jb0 + 16 * e, q); ld_frag(bx[e], S2, jb0 + 16 * e, q); }
#pragma unroll
          for (int e = 0; e < 2; ++e) { const int j = 16 * (tj0 + e) + r; st_tr(S0, mm2(a, b1[e], Z4), i0, j); st_tr(S4, mm2(a, bx[e], Z4), i0, j); } }
        LSYNC();
        { bf16x8 a10[2], a11[2], a3[2], a5[2], b0[2][2], b4[2][2], b7[2][2];
          ld_frag(a10, S10, ia, q); ld_frag(a11, S11, ia, q); ld_frag(a3, S3, ia, q); ld_frag(a5, S5, ia, q);
#pragma unroll
          for (int e = 0; e < 2; ++e) { ld_frag(b0[e], S0, jb0 + 16 * e, q); ld_frag(b4[e], S4, jb0 + 16 * e, q); ld_frag(b7[e], S7, jb0 + 16 * e, q); }
          const float pli = PLs[ia];
          f32x4 plg;
#pragma unroll
          for (int g = 0; g < 4; ++g) plg[g] = PLs[i0 + g];
#pragma unroll
          for (int e = 0; e < 2; ++e) { const int j = 16 * (tj0 + e) + r, js = 16 * (tj0 + e) + 4 * q;
            const f32x4 vq = mm2(b0[e], a10, ld_sw(S6, ia, js));
            const f32x4 vy = mm2(b7[e], a11, mm2(b4[e], a10, Z4));
            f32x4 vm = mm2(b0[e], a3, Z4);
#pragma unroll
            for (int g = 0; g < 4; ++g) vm[g] = pli * (vm[g] + ((ia == js + g) ? 1.0f : 0.f));
            const f32x4 vn = mm2(a5, b7[e], mm2(a3, b4[e], Z4)) * plg;
            st_sw(S1, vq, ia, js); st_sw(S2, vy, ia, js); st_sw(S8, vm, ia, js); st_tr(S9, vn, i0, j); } }
        LSYNC();
        { const int row = F.tid >> 3, seg = (F.tid & 7) * 8; const size_t go = (size_t)ci * 4096 + row * 64 + seg;
          *(u32x4*)(gQ + go) = *(const LAS u32x4*)(S1 + row * PT + seg); *(u32x4*)(gY0 + go) = *(const LAS u32x4*)(S2 + row * PT + seg);
          *(u32x4*)(gM + go) = *(const LAS u32x4*)(S8 + row * PT + seg); *(u32x4*)(gN0T + go) = *(const LAS u32x4*)(S9 + row * PT + seg); }
        LSYNC();
    }
    asm volatile("s_waitcnt vmcnt(0)" ::: "memory");
}

struct ScanOps { u32x2 m[4][2][2]; u32x2 n0[4]; };
DI void scan_load(ScanOps& o, const bf16_t* gM, const bf16_t* gN0T, size_t ci, int col, int q, int v) {
#pragma unroll
    for (int m = 0; m < 4; ++m) {
#pragma unroll
        for (int s2 = 0; s2 < 2; ++s2) { const bf16_t* p = gM + ci * 4096 + (16 * m + col) * 64 + 32 * s2 + 4 * q; o.m[m][s2][0] = *(const u32x2*)p; o.m[m][s2][1] = *(const u32x2*)(p + 16); }
        o.n0[m] = *(const u32x2*)(gN0T + ci * 4096 + v * 64 + 16 * m + 4 * q); }
}
DI void scan_step(const ScanOps& o, f32x4 (&H)[4], bf16_t* gHT, size_t ci, int q, int v) {
    u32x4 bfr[2];
#pragma unroll
    for (int s2 = 0; s2 < 2; ++s2) { bfr[s2].x = cvt_pk_bf16(H[2 * s2][0], H[2 * s2][1]); bfr[s2].y = cvt_pk_bf16(H[2 * s2][2], H[2 * s2][3]);
        bfr[s2].z = cvt_pk_bf16(H[2 * s2 + 1][0], H[2 * s2 + 1][1]); bfr[s2].w = cvt_pk_bf16(H[2 * s2 + 1][2], H[2 * s2 + 1][3]);
        bf16_t* hp = gHT + ci * 4096 + v * 64 + 32 * s2 + 4 * q;
        *(u32x2*)hp = (u32x2){bfr[s2].x, bfr[s2].y}; *(u32x2*)(hp + 16) = (u32x2){bfr[s2].z, bfr[s2].w}; }
#pragma unroll
    for (int m = 0; m < 4; ++m) {
        f32x4 a2 = (f32x4){bf_lo(o.n0[m].x), bf_hi(o.n0[m].x), bf_lo(o.n0[m].y), bf_hi(o.n0[m].y)};
#pragma unroll
        for (int s2 = 0; s2 < 2; ++s2) { const u32x4 af = (u32x4){o.m[m][s2][0].x, o.m[m][s2][0].y, o.m[m][s2][1].x, o.m[m][s2][1].y};
            a2 = __builtin_amdgcn_mfma_f32_16x16x32_bf16(__builtin_bit_cast(bf16x8, af), __builtin_bit_cast(bf16x8, bfr[s2]), a2, 0, 0, 0); }
        H[m] = a2; }
}
constexpr int SC_DEPTH = 10, SC_SLOT = 12288;
DI void scan_dma(unsigned lds_dst, unsigned voff, const char* base) { asm volatile("s_mov_b32 m0, %0\n\ts_nop 0\n\tglobal_load_lds_dwordx4 %1, %2" :: "s"(lds_dst), "v"(voff), "s"(base) : "memory"); }
DI void scan_lds_load(ScanOps& o, const LAS unsigned char* slot, int lbM, int lbN, const int (&xo)[2][2], int c7) {
#pragma unroll
    for (int m = 0; m < 4; ++m) {
#pragma unroll
        for (int s2 = 0; s2 < 2; ++s2) { o.m[m][s2][0] = *(const LAS u32x2*)(slot + lbM + m * 2048 + xo[s2][0]); o.m[m][s2][1] = *(const LAS u32x2*)(slot + lbM + m * 2048 + xo[s2][1]); }
        o.n0[m] = *(const LAS u32x2*)(slot + 8192 + lbN + (((2 * m) << 4) ^ c7)); }
}
DI void p_rw_scan(const Frame& F) {
    const bf16_t* gM = (const bf16_t*)(F.ws + WS_CHK_M); const bf16_t* gN0T = (const bf16_t*)(F.ws + WS_CHK_N0T); bf16_t* gHT = (bf16_t*)(F.ws + WS_CHK_HT);
    const unsigned ldsbase = (unsigned)(size_t)F.lds;
    const int w = F.wave, col = F.lane & 15, q = F.lane >> 4;
    const int lw = w - 2, lt = F.tid - 128;
    const int P1 = (384 + lt) & 511;
    const unsigned voff0 = (unsigned)((lt >> 3) * 128 + (((lt & 7) ^ ((lt >> 3) & 7)) << 4));
    const unsigned voff1 = (unsigned)((P1 >> 3) * 128 + (((P1 & 7) ^ ((P1 >> 3) & 7)) << 4));
    const int c7 = (col & 7) << 4, qh = (q >> 1) << 4;
    const int lbM = col * 128 + 8 * (q & 1), lbN = (16 * (w & 1) + col) * 128 + 8 * (q & 1);
    int xo[2][2];
#pragma unroll
    for (int s2 = 0; s2 < 2; ++s2)
#pragma unroll
        for (int h = 0; h < 2; ++h) xo[s2][h] = (((4 * s2 + 2 * h) << 4) + qh) ^ c7;
    const int c7n = c7 ^ qh;
    for (int p = F.bid; p < 256; p += F.G) {
        const int bh = p >> 1, half = p & 1, v = 32 * half + 16 * (w & 1) + col;
        const size_t c0 = (size_t)bh * 64;
        const char* baseM = (const char*)(gM + c0 * 4096);
        const char* baseN = (const char*)(gN0T + c0 * 4096 + half * 2048);
        const char* base1 = (lw < 2) ? baseM : baseN;
#define SC_ISSUE(c, slot) do { if (w >= 2) { const unsigned _d = ldsbase + (unsigned)(slot) * SC_SLOT + (unsigned)lw * 1024u; \
            scan_dma(_d, voff0 + (unsigned)(c) * 8192u, baseM); scan_dma(_d + 6144u, voff1 + (unsigned)(c) * 8192u, base1); } } while (0)
#pragma unroll 1
        for (int c = 0; c < SC_DEPTH; ++c) SC_ISSUE(c, c);
        asm volatile("s_waitcnt vmcnt(0)" ::: "memory"); __builtin_amdgcn_s_barrier();
        f32x4 H[4];
#pragma unroll
        for (int m = 0; m < 4; ++m) H[m] = (f32x4){0.f, 0.f, 0.f, 0.f};
        ScanOps A, B;
        if (w < 2) scan_lds_load(A, F.lds, lbM, lbN, xo, c7n);
        int slot = 0;
#define SC_STEP(X, Y, c) do { \
            if (w < 2) asm volatile("s_waitcnt lgkmcnt(0)" ::: "memory"); else asm volatile("s_waitcnt vmcnt(16)" ::: "memory"); \
            __builtin_amdgcn_s_barrier(); \
            const int _sn = (slot + 1 == SC_DEPTH) ? 0 : slot + 1; \
            if (w < 2) scan_lds_load(Y, F.lds + _sn * SC_SLOT, lbM, lbN, xo, c7n); \
            { const int _cn = ((c) + SC_DEPTH < 64) ? (c) + SC_DEPTH : 63; SC_ISSUE(_cn, slot); } \
            if (w < 2) scan_step(X, H, gHT, c0 + (c), q, v); \
            slot = _sn; } while (0)
        static_assert(2 * (SC_DEPTH - 2) == 16, "vmcnt literal in SC_STEP");
#pragma unroll 1
        for (int c = 0; c < 64; c += 2) { SC_STEP(A, B, c); SC_STEP(B, A, c + 1); }
#undef SC_STEP
#undef SC_ISSUE
        asm volatile("s_waitcnt vmcnt(0)" ::: "memory"); __builtin_amdgcn_s_barrier();
    }
}

struct RcIn { bf16x8 qf[2], hb[4][2]; u32x2 y0[4], cv[4], pv[4], gw[4]; float bn; };
DI void rc_load(RcIn& x, const bf16_t* gQ, const bf16_t* gY0, const bf16_t* gHT, const bf16_t* prw, const bf16_t* lwag, const float* bonus, int item, int r, int q) {
    const int ci = item >> 2, ti = item & 3, bh = ci >> 6, c = ci & 63, b = bh >> 3, h = bh & 7;
    const size_t cb = (size_t)ci * 4096; const size_t tok = (size_t)b * SEQ + c * 64 + 16 * ti + r;
    const bool first = (tok & (SEQ - 1)) == 0; const size_t tp = first ? tok : tok - 1;
#pragma unroll
    for (int s2 = 0; s2 < 2; ++s2) x.qf[s2] = *(const bf16x8*)(gQ + cb + (16 * ti + r) * 64 + 32 * s2 + 8 * q);
#pragma unroll
    for (int n = 0; n < 4; ++n) { const int cch = h * 64 + 16 * n + 4 * q;
        x.y0[n] = *(const u32x2*)(gY0 + cb + (16 * ti + r) * 64 + 16 * n + 4 * q);
#pragma unroll
        for (int s2 = 0; s2 < 2; ++s2) x.hb[n][s2] = *(const bf16x8*)(gHT + cb + (16 * n + r) * 64 + 32 * s2 + 8 * q);
        x.cv[n] = *(const u32x2*)(prw + tok * RWC + 1024 + cch); x.pv[n] = *(const u32x2*)(prw + tp * RWC + 1024 + cch);
        x.gw[n] = *(const u32x2*)(lwag + tok * 1536 + 1024 + cch); }
    x.bn = bonus[tok * 8 + h];
}
DI void rc_compute(const RcIn& x, bf16_t* yrw, const float* mu, const float* ln_g, const float* ln_b, int item, int r, int q) {
    const int ci = item >> 2, ti = item & 3, bh = ci >> 6, c = ci & 63, b = bh >> 3, h = bh & 7;
    const size_t tok = (size_t)b * SEQ + c * 64 + 16 * ti + r; const bool first = (tok & (SEQ - 1)) == 0;
    f32x4 y[4];
#pragma unroll
    for (int n = 0; n < 4; ++n) { y[n] = (f32x4){bf_lo(x.y0[n].x), bf_hi(x.y0[n].x), bf_lo(x.y0[n].y), bf_hi(x.y0[n].y)};
#pragma unroll
        for (int s2 = 0; s2 < 2; ++s2) y[n] = __builtin_amdgcn_mfma_f32_16x16x32_bf16(x.hb[n][s2], x.qf[s2], y[n], 0, 0, 0); }
    float s1 = 0.f;
#pragma unroll
    for (int n = 0; n < 4; ++n) s1 += (y[n][0] + y[n][1]) + (y[n][2] + y[n][3]);
    s1 = xrow_sum(s1);
    const float mean = s1 * (1.0f / 64.0f);
    float s2 = 0.f;
#pragma unroll
    for (int n = 0; n < 4; ++n) { y[n] = y[n] - mean; s2 += (y[n][0] * y[n][0] + y[n][1] * y[n][1]) + (y[n][2] * y[n][2] + y[n][3] * y[n][3]); }
    s2 = xrow_sum(s2);
    const float rstd = rsqrtf(s2 * (1.0f / 64.0f) + 64e-5f);
#pragma unroll
    for (int n = 0; n < 4; ++n) { const int cch = h * 64 + 16 * n + 4 * q;
        const f32x4 muv = *(const f32x4*)(mu + 1024 + cch), lg = *(const f32x4*)(ln_g + cch), lb = *(const f32x4*)(ln_b + cch);
        const float cv[4] = {bf_lo(x.cv[n].x), bf_hi(x.cv[n].x), bf_lo(x.cv[n].y), bf_hi(x.cv[n].y)};
        const float pv[4] = {first ? 0.f : bf_lo(x.pv[n].x), first ? 0.f : bf_hi(x.pv[n].x), first ? 0.f : bf_lo(x.pv[n].y), first ? 0.f : bf_hi(x.pv[n].y)};
        const float gg[4] = {bf_lo(x.gw[n].x), bf_hi(x.gw[n].x), bf_lo(x.gw[n].y), bf_hi(x.gw[n].y)};
        float o[4];
#pragma unroll
        for (int g = 0; g < 4; ++g) { const float vsh = cv[g] + muv[g] * (pv[g] - cv[g]); o[g] = (y[n][g] * rstd * lg[g] + lb[g] + x.bn * vsh) * gg[g]; }
        u32x2 ow; ow.x = cvt_pk_bf16(o[0], o[1]); ow.y = cvt_pk_bf16(o[2], o[3]);
        *(u32x2*)(yrw + tok * 512 + cch) = ow; }
}
DI void p_rw_out(const Frame& F) {
    const bf16_t* gQ = (const bf16_t*)(F.ws + WS_CHK_Q); const bf16_t* gY0 = (const bf16_t*)(F.ws + WS_CHK_Y0T); const bf16_t* gHT = (const bf16_t*)(F.ws + WS_CHK_HT);
    const bf16_t* prw = (const bf16_t*)(F.ws + WS_PRW); const bf16_t* lwag = (const bf16_t*)(F.ws + WS_LWAG); const float* bonus = (const float*)(F.ws + WS_BONUS);
    bf16_t* yrw = (bf16_t*)(F.ws + WS_YRW);
    const float* mu = F.in[13]; const float* ln_g = F.in[22]; const float* ln_b = F.in[23];
    const int r = F.lane & 15, q = F.lane >> 4, stride = F.G * NWAVES, NIT = RW_NCH * 4;
    for (int item = F.bid * NWAVES + F.wave; item < NIT; item += 2 * stride) {
        const int item2 = (item + stride < NIT) ? item + stride : item;
        RcIn xa, xb;
        rc_load(xa, gQ, gY0, gHT, prw, lwag, bonus, item, r, q); rc_load(xb, gQ, gY0, gHT, prw, lwag, bonus, item2, r, q);
        rc_compute(xa, yrw, mu, ln_g, ln_b, item, r, q); rc_compute(xb, yrw, mu, ln_g, ln_b, item2, r, q);
    }
}

DI void p_moe_prep_rows(const Frame& F, int row0) {
    const bf16_t* hb = (const bf16_t*)(F.ws + WS_HB); float* rsv = (float*)(F.ws + WS_RS); unsigned char* out8 = (unsigned char*)(F.ws + WS_XN2F8); const float* g = F.in[26];
    for (int row = row0 + F.wave; row < row0 + BM; row += 2 * NWAVES) {
        const int row2 = row + NWAVES;
        u32x4 a[2], b[2];
        a[0] = *(const u32x4*)(hb + (size_t)row * D + F.lane * 16); a[1] = *(const u32x4*)(hb + (size_t)row * D + F.lane * 16 + 8);
        b[0] = *(const u32x4*)(hb + (size_t)row2 * D + F.lane * 16); b[1] = *(const u32x4*)(hb + (size_t)row2 * D + F.lane * 16 + 8);
        float v[16], u[16]; float ss = 0.f, su = 0.f;
#pragma unroll
        for (int j = 0; j < 8; ++j) { v[2 * j] = bf_lo(a[j >> 2][j & 3]); v[2 * j + 1] = bf_hi(a[j >> 2][j & 3]); u[2 * j] = bf_lo(b[j >> 2][j & 3]); u[2 * j + 1] = bf_hi(b[j >> 2][j & 3]); }
#pragma unroll
        for (int j = 0; j < 16; ++j) { ss += v[j] * v[j]; su += u[j] * u[j]; }
        ss = wave_sum(ss); su = wave_sum(su);
        const float rs = rsqrtf(ss * (1.0f / D) + 1e-5f), ru = rsqrtf(su * (1.0f / D) + 1e-5f);
        float gv[16];
#pragma unroll
        for (int q = 0; q < 4; ++q) { const f32x4 t = *(const f32x4*)(g + F.lane * 16 + q * 4); gv[4 * q] = t[0]; gv[4 * q + 1] = t[1]; gv[4 * q + 2] = t[2]; gv[4 * q + 3] = t[3]; }
#pragma unroll
        for (int j = 0; j < 16; ++j) { v[j] *= rs * gv[j]; u[j] *= ru * gv[j]; }
        u32x4 q0, q1;
        if (F.lane == 0) { rsv[row] = rs; rsv[row2] = ru; }
        q0.x = pk4_fp8(v[0] * F8_SX, v[1] * F8_SX, v[2] * F8_SX, v[3] * F8_SX); q0.y = pk4_fp8(v[4] * F8_SX, v[5] * F8_SX, v[6] * F8_SX, v[7] * F8_SX);
        q0.z = pk4_fp8(v[8] * F8_SX, v[9] * F8_SX, v[10] * F8_SX, v[11] * F8_SX); q0.w = pk4_fp8(v[12] * F8_SX, v[13] * F8_SX, v[14] * F8_SX, v[15] * F8_SX);
        q1.x = pk4_fp8(u[0] * F8_SX, u[1] * F8_SX, u[2] * F8_SX, u[3] * F8_SX); q1.y = pk4_fp8(u[4] * F8_SX, u[5] * F8_SX, u[6] * F8_SX, u[7] * F8_SX);
        q1.z = pk4_fp8(u[8] * F8_SX, u[9] * F8_SX, u[10] * F8_SX, u[11] * F8_SX); q1.w = pk4_fp8(u[12] * F8_SX, u[13] * F8_SX, u[14] * F8_SX, u[15] * F8_SX);
        *(u32x4*)(out8 + (size_t)row * D + F.lane * 16) = q0; *(u32x4*)(out8 + (size_t)row2 * D + F.lane * 16) = q1;
    }
}
DI void p_moe_b1p(const Frame& F) {
    float* b1p = (float*)(F.ws + WS_B1P); const float* b1 = F.in[30]; CmSwi cm;
    for (int idx = F.bid * NTHR + F.tid; idx < 32 * 2048; idx += F.G * NTHR) { const int e = idx >> 11, n = idx & 2047; b1p[idx] = b1[e * 2048 + cm(n)]; }
}
DI void p_conv_part(const Frame& F, int part) {
    if (part == 0) conv_T8(F, F.in[29], (size_t)1024 * 2048, 2048, (unsigned char*)(F.ws + WS_W1), 2048, 1024, 32, MpSwi(), F8_SW, 0, 2048);
    else if (part == 1) conv_T8(F, F.in[29], (size_t)1024 * 2048, 2048, (unsigned char*)(F.ws + WS_W1), 2048, 1024, 32, MpSwi(), F8_SW, 2048, 4096);
    else conv_T8(F, F.in[31], (size_t)1024 * 1024, 1024, (unsigned char*)(F.ws + WS_W2), 1024, 1024, 32, MpId(), F8_SW);
}

DI void topk_rows(const Frame& F, int row0) {
    LAS unsigned* cnt = (LAS unsigned*)F.lds; LAS unsigned* base = cnt + 32;
    const float* logits = (const float*)(F.ws + WS_LOG); unsigned* epos = (unsigned*)(F.ws + WS_EPOS); float* gatev = (float*)(F.ws + WS_GATEV);
    const int pass = row0 / TPP;
    unsigned* gcnt = (unsigned*)(F.ws + WS_CTL) + CW_GCNT + pass * 32;
    if (F.tid < 32) cnt[F.tid] = 0u;
    __syncthreads();
    int e4[4] = {0, 0, 0, 0}; unsigned p4[4] = {0u, 0u, 0u, 0u}; float g4[4] = {0.f, 0.f, 0.f, 0.f};
    const int token = row0 + F.tid;
    if (F.tid < 256) {
        float l[32]; const float rsc = ((const float*)(F.ws + WS_RS))[token];
#pragma unroll
        for (int q = 0; q < 8; ++q) { const f32x4 v = *(const f32x4*)(logits + (size_t)token * 32 + q * 4), bq = *(const f32x4*)(F.in[28] + q * 4); l[q * 4] = v[0] * rsc + bq[0]; l[q * 4 + 1] = v[1] * rsc + bq[1]; l[q * 4 + 2] = v[2] * rsc + bq[2]; l[q * 4 + 3] = v[3] * rsc + bq[3]; }
        unsigned used = 0u; float tv[4];
#pragma unroll
        for (int k = 0; k < 4; ++k) { float best = -3.0e38f; int bi = 0;
#pragma unroll
            for (int e = 0; e < 32; ++e) { const bool ok = !((used >> e) & 1u) && (l[e] > best); best = ok ? l[e] : best; bi = ok ? e : bi; }
            used |= 1u << bi; e4[k] = bi; tv[k] = best; }
        const float m = tv[0]; float ex[4], sum = 0.f;
#pragma unroll
        for (int k = 0; k < 4; ++k) { ex[k] = __expf(tv[k] - m); sum += ex[k]; }
#pragma unroll
        for (int k = 0; k < 4; ++k) { g4[k] = ex[k] / sum; p4[k] = atomicAdd((unsigned*)&cnt[e4[k]], 1u); }
    }
    __syncthreads();
    if (F.tid < 32) base[F.tid] = __hip_atomic_fetch_add(&gcnt[F.tid], cnt[F.tid], __ATOMIC_RELAXED, __HIP_MEMORY_SCOPE_AGENT);
    __syncthreads();
    if (F.tid < 256) {
#pragma unroll
        for (int k = 0; k < 4; ++k) { epos[(size_t)token * 4 + k] = ((unsigned)e4[k] << 24) | (base[e4[k]] + p4[k]); gatev[(size_t)token * 4 + k] = g4[k]; }
    }
    __syncthreads();
}
DI void p_gather(const Frame& F, int pass) {
    LAS int* poff = (LAS int*)F.lds;
    LAS int* pcnt = poff + 40;
    unsigned* gcnt = (unsigned*)(F.ws + WS_CTL) + CW_GCNT + pass * 32;
    int* tile_e = (int*)(F.ws + WS_TILEE) + pass * TE_STRIDE;
    __syncthreads();
    if (F.tid == 0) { int acc = 0; for (int e = 0; e < 32; ++e) { poff[e] = acc; const int c = (int)__hip_atomic_load(&gcnt[e], __ATOMIC_RELAXED, __HIP_MEMORY_SCOPE_AGENT); pcnt[e] = c; acc += ((c + 255) >> 8) << 8; } poff[32] = acc; }
    __syncthreads();
    if (F.bid == 0) {
        const int nt = poff[32] >> 8;
        for (int t = F.tid; t < nt; t += NTHR) { int e = 0; for (int q = 1; q < 32; ++q) if (poff[q] <= t * 256) e = q; tile_e[1 + t] = e; }
        if (F.tid == 0) tile_e[0] = nt;
    }
    const unsigned* epos = (const unsigned*)(F.ws + WS_EPOS); const float* gatev = (const float*)(F.ws + WS_GATEV);
    int* slot = (int*)(F.ws + WS_SLOT); float* rowg = (float*)(F.ws + WS_ROWG) + (size_t)pass * MAXTILES * 256;
    int* rowtok = (int*)(F.ws + WS_ROWTOK) + (size_t)pass * MAXTILES * 256;
    for (int i = F.bid * NTHR + F.tid; i < 32 * 256; i += F.G * NTHR) { const int e = i >> 8, sl = poff[e] + pcnt[e] + (i & 255); if (sl < poff[e + 1]) rowtok[sl] = 0; }
    for (int i = F.bid * NTHR + F.tid; i < TPP * 4; i += F.G * NTHR) {
        const int token = pass * TPP + (i >> 2);
        const unsigned ep = epos[(size_t)pass * TPP * 4 + i]; const int sl = poff[ep >> 24] + (int)(ep & 0xffffffu);
        slot[(size_t)pass * TPP * 4 + i] = sl; rowg[sl] = gatev[(size_t)pass * TPP * 4 + i]; rowtok[sl] = token;
    }
    __syncthreads();
}
DI void p_combine(const Frame& F, int pass) {
    int tz_ = threadIdx.x; asm volatile("" : "+v"(tz_)); const int lane_ = tz_ & 63;
    const int* slot = (const int*)(F.ws + WS_SLOT); const unsigned char* y2 = (const unsigned char*)(F.ws + WS_XS) + (size_t)pass * PASS_BUF; const float* gf = F.in[33];
    for (int t = F.bid * NWAVES + F.wave; t < TPP; t += F.G * NWAVES) {
        const int token = pass * TPP + t;
        float v[16];
        { const bf16_t* hb = (const bf16_t*)(F.ws + WS_HB) + (size_t)token * D + lane_ * 16; const u32x4 h0 = *(const u32x4*)hb, h1 = *(const u32x4*)(hb + 8);
#pragma unroll
          for (int j = 0; j < 4; ++j) { v[2 * j] = bf_lo(h0[j]); v[2 * j + 1] = bf_hi(h0[j]); v[8 + 2 * j] = bf_lo(h1[j]); v[8 + 2 * j + 1] = bf_hi(h1[j]); } }
        u32x4 yw[4];
#pragma unroll
        for (int k = 0; k < 4; ++k) { const int s = slot[(size_t)token * 4 + k]; yw[k] = *(const u32x4*)(y2 + (size_t)s * D + lane_ * 16); }
#pragma unroll
        for (int k = 0; k < 4; ++k)
#pragma unroll
            for (int j = 0; j < 4; ++j) { const f32x2 lo = __builtin_amdgcn_cvt_pk_f32_fp8((int)yw[k][j], false), hi = __builtin_amdgcn_cvt_pk_f32_fp8((int)yw[k][j], true);
                v[4 * j] += lo[0] * (1.0f / F8_SY); v[4 * j + 1] += lo[1] * (1.0f / F8_SY); v[4 * j + 2] += hi[0] * (1.0f / F8_SY); v[4 * j + 3] += hi[1] * (1.0f / F8_SY); }
        float ss = 0.f;
#pragma unroll
        for (int j = 0; j < 16; ++j) ss += v[j] * v[j];
        ss = wave_sum(ss);
        const float rs = rsqrtf(ss * (1.0f / D) + 1e-5f);
        f32x4* orow = (f32x4*)(F.out + (size_t)token * D + lane_ * 16);
#pragma unroll
        for (int q = 0; q < 4; ++q) { const f32x4 gv = *(const f32x4*)(gf + lane_ * 16 + q * 4);
            orow[q] = (f32x4){v[q * 4] * rs * gv[0], v[q * 4 + 1] * rs * gv[1], v[q * 4 + 2] * rs * gv[2], v[q * 4 + 3] * rs * gv[3]}; }
    }
}

constexpr int N_PHASES = 17;
__global__ void __launch_bounds__(NTHR, 2) fwd_kernel(KArgs args) {
    extern __shared__ __attribute__((aligned(16))) unsigned char lds_raw[];
    Frame F; F.lds = (LAS unsigned char*)lds_raw; F.tid = threadIdx.x; F.lane = F.tid & 63; F.wave = __builtin_amdgcn_readfirstlane(F.tid >> 6);
    F.G = gridDim.x; F.bid = blockIdx.x; F.in = args.in; F.out = args.out; F.ws = args.ws;
    unsigned char* ws = args.ws;
    volatile LAS unsigned* MISC = (volatile LAS unsigned*)(F.lds + MISC_OFF);
    if (F.tid < 4) MISC[F.tid] = 0u;
    __syncthreads();
    XcdBarrier bar; bar.bar = (unsigned*)(ws + WS_CTL) + CW_BAR; bar.x = 0; bar.st = MISC;
    if (N_LAUNCH_MODE == 1) bar = xcd_barrier_post((unsigned*)(ws + WS_CTL) + CW_BAR, MISC);
    const int lo = args.ph_lo, hi = args.ph_hi;
#define IN(k) (lo <= (k) && (k) < hi)
#define REP(k) for (int _r = 0; _r < 1 + (int)((PROBE_MASK >> (k)) & 1u); ++_r)
#define SEAM(k) do { if (N_LAUNCH_MODE == 1 && IN(k) && IN((k) + 1)) xcd_barrier(bar); } while (0)
    bf16_t* gates = (bf16_t*)args.out;

    if (IN(0)) { REP(0) p0_prologue(F); SEAM(0); }
    if (IN(1)) {
        PlainSched S; S.init(ws + WS_XN, ws + WS_WIN, T, INC, D, D, D, F.G, F.bid);
        EpiWin E{(bf16_t*)(ws + WS_US5), (bf16_t*)(ws + WS_PRW), gates};
        REP(1) gemm_phase(F.lds, S, E); SEAM(1);
    }
    if (IN(2)) {
        GroupSched S; S.init(ws + WS_US5, ws + WS_WST, 512, LDU, 512, S5ROWS / BM, 1, F.G, F.bid);
        EpiS5State E{(float*)(ws + WS_SLOC)};
        REP(2) { gemm_phase(F.lds, S, E); p_rw_prep(F); } SEAM(2);
    }
    if (IN(3)) {
        REP(3) p_s5_carry(F);
        PlainSched S; S.init(ws + WS_ALORA, ws + WS_WLORA, T, 1536, 128, 256, 128, F.G, F.bid); S.akoff_pn = 4; S.akoff_bytes = 256;
        EpiLora E{(bf16_t*)(ws + WS_LWAG), F.in[14], F.in[16]};
        REP(3) gemm_phase(F.lds, S, E); SEAM(3);
    }
    if (IN(4)) {
        GroupSched S; S.init(ws + WS_US5, ws + WS_TOEP, LDU, LDU, LDU, S5ROWS / BM, 2, F.G, F.bid);
        EpiS5Out E{(bf16_t*)(ws + WS_YS)};
        REP(4) gemm_phase(F.lds, S, E); SEAM(4);
    }
    if (IN(5)) { REP(5) p_rw_chunk(F); SEAM(5); }
    if (IN(6)) { REP(6) p_rw_scan(F); SEAM(6); }
    if (IN(7)) { REP(7) p_rw_out(F); SEAM(7); }
    if (IN(8)) {
        PlainSched S; S.init(ws + WS_YS, ws + WS_WGLU, T, 2048, 512, 512, 512, F.G, F.bid);
        EpiGlu E{(bf16_t*)(ws + WS_XN), gates, (const float*)(ws + WS_BGLU)};
        if (F.bid & 1) p_conv_part(F, 0);
        gemm_phase(F.lds, S, E);
        if (!(F.bid & 1)) p_conv_part(F, 0);
        SEAM(8);
    }
    if (IN(9)) {
        PlainSched S; S.init(ws + WS_YRW, ws + WS_WO, T, 1024, 512, 512, 512, F.G, F.bid);
        EpiWo E{(bf16_t*)(ws + WS_XN), gates};
        if (F.bid & 1) p_conv_part(F, 1);
        gemm_phase(F.lds, S, E);
        if (!(F.bid & 1)) p_conv_part(F, 1);
        SEAM(9);
    }
    if (IN(10)) {
        PlainSched S; S.init(ws + WS_XN, ws + WS_WOUT, T, 1024, 1024, 1024, 1024, F.G, F.bid); S.rowown = 1;
        EpiOut E{(bf16_t*)(ws + WS_HB), F.in[0]};
        if (F.bid & 1) p_conv_part(F, 2);
        gemm_phase(F.lds, S, E);
        if (!(F.bid & 1)) p_conv_part(F, 2);
        if (N_LAUNCH_MODE == 1 && IN(10) && IN(11)) { asm volatile("s_waitcnt vmcnt(0)" ::: "memory"); __syncthreads(); __builtin_amdgcn_fence(__ATOMIC_ACQUIRE, "agent"); }
    }
    if (IN(11)) {
        PlainSched S; S.init(ws + WS_HB, ws + WS_WR, T, 256, 1024, 1024, 1024, F.G, F.bid); S.rowown = 1;
        EpiRouter E{(float*)(ws + WS_LOG)};
        { Unit u; for (int i = 0; S.next(i, u); ++i) p_moe_prep_rows(F, u.pm * BM); }
        p_moe_b1p(F);
        asm volatile("s_waitcnt vmcnt(0)" ::: "memory"); __syncthreads();
        gemm_phase(F.lds, S, E);
        { Unit u; for (int i = 0; S.next(i, u); ++i) topk_rows(F, u.pm * BM); }
        SEAM(11);
    }
    if (IN(12)) { p_gather(F, 0); p_gather(F, 1); SEAM(12); }
#define MOE_G1(PASS, CIDX) \
            const int* te = (const int*)(ws + WS_TILEE) + (PASS) * TE_STRIDE; const int ntl = __builtin_amdgcn_readfirstlane(__hip_atomic_load(te, __ATOMIC_RELAXED, __HIP_MEMORY_SCOPE_AGENT)); \
            MoeSched<true> S; S.init(ws + WS_XN2F8, ws + WS_W1, te + 1, (const int*)(ws + WS_ROWTOK) + (size_t)(PASS) * MAXTILES * 256, ntl, 512, 8, F.G, (CIDX)); \
            EpiMoe1 E{(unsigned char*)(ws + WS_ACT) + (size_t)(PASS) * PASS_BUF, (const float*)(ws + WS_B1P)};
#define MOE_G2(PASS) \
            const int* te = (const int*)(ws + WS_TILEE) + (PASS) * TE_STRIDE; const int ntl = __builtin_amdgcn_readfirstlane(__hip_atomic_load(te, __ATOMIC_RELAXED, __HIP_MEMORY_SCOPE_AGENT)); \
            MoeSched<false> S; S.init(ws + WS_ACT + (size_t)(PASS) * PASS_BUF, ws + WS_W2, te + 1, nullptr, ntl, 512, 4, F.G, F.bid); \
            EpiMoe2 E{(unsigned char*)(ws + WS_XS) + (size_t)(PASS) * PASS_BUF, F.in[32], (const float*)(ws + WS_ROWG) + (size_t)(PASS) * MAXTILES * 256};
    if (IN(13)) { MOE_G1(0, F.bid) gemm_phase(F.lds, S, E); SEAM(13); }
    if (IN(14)) {
        { MOE_G2(0) gemm_phase(F.lds, S, E); }
        { MOE_G1(1, F.G - 1 - F.bid) gemm_phase(F.lds, S, E); }
        SEAM(14);
    }
    if (IN(15)) {
        if (F.bid & 1) p_combine(F, 0);
        { MOE_G2(1) gemm_phase(F.lds, S, E); }
        if (!(F.bid & 1)) p_combine(F, 0);
        SEAM(15);
    }
    if (IN(16)) { p_combine(F, 1); }
#undef MOE_G1
#undef MOE_G2
#undef IN
#undef SEAM
#undef REP
}

extern "C" void kernel_launch(void* const* d_in, const int* in_sizes, int n_in, void* d_out, int out_size, void* d_ws, size_t ws_size, hipStream_t stream) {
    static int grid = 0;
    if (grid == 0) {
        if (n_in != 34 || in_sizes[0] != T * D || out_size != T * D || ws_size < WS_END) { fprintf(stderr, "kernel_launch: unexpected shapes (n_in %d, in0 %d, out %d, ws %zu < %zu)\n", n_in, n_in > 0 ? in_sizes[0] : -1, out_size, ws_size, (size_t)WS_END); grid = -1; return; }
        int dev = 0, cus = 0, per_cu = 0;
        if (hipGetDevice(&dev) != hipSuccess || hipDeviceGetAttribute(&cus, hipDeviceAttributeMultiprocessorCount, dev) != hipSuccess) { grid = -1; return; }
        if (hipFuncSetAttribute((const void*)fwd_kernel, hipFuncAttributeMaxDynamicSharedMemorySize, LDS_BYTES) != hipSuccess) { fprintf(stderr, "kernel_launch: hipFuncSetAttribute failed\n"); grid = -1; return; }
        if (hipOccupancyMaxActiveBlocksPerMultiprocessor(&per_cu, (const void*)fwd_kernel, NTHR, LDS_BYTES) != hipSuccess || per_cu < 1) { fprintf(stderr, "kernel_launch: occupancy query says %d\n", per_cu); }
        (void)hipGetLastError();
        grid = cus;
    }
    if (grid < 0) return;
    (void)hipMemsetAsync((char*)d_ws + WS_CTL, 0, CTL_BYTES, stream);
    KArgs a{};
    for (int i = 0; i < 34; ++i) a.in[i] = (const float*)d_in[i];
    a.out = (float*)d_out; a.ws = (unsigned char*)d_ws;
    if (N_LAUNCH_MODE == 1) {
        a.ph_lo = 0; a.ph_hi = N_PHASES;
        hipLaunchKernelGGL(fwd_kernel, dim3(grid), dim3(NTHR), LDS_BYTES, stream, a);
    } else {
        for (int p = 0; p < N_PHASES; ++p) { a.ph_lo = p; a.ph_hi = p + 1; hipLaunchKernelGGL(fwd_kernel, dim3(grid), dim3(NTHR), LDS_BYTES, stream, a); }
    }
}
```

```cpp
#include <hip/hip_runtime.h>
#include <stdint.h>
#include <stdio.h>

#ifndef N_LAUNCH_MODE
#define N_LAUNCH_MODE 1
#endif

#ifndef GEMM_SP2
#define GEMM_SP2 1
#endif
#ifndef GEMM_ALIGN
#define GEMM_ALIGN 1
#endif
#ifndef PROBE_MASK
#define PROBE_MASK 0u
#endif
#define LAS __attribute__((address_space(3)))
#define DI __device__ __forceinline__
typedef unsigned short bf16_t;
typedef short bf16x8 __attribute__((ext_vector_type(8)));
typedef float f32x4 __attribute__((ext_vector_type(4)));
typedef float f32x2 __attribute__((ext_vector_type(2)));
typedef unsigned u32x4 __attribute__((ext_vector_type(4)));
typedef unsigned u32x2 __attribute__((ext_vector_type(2)));
typedef int i32x8 __attribute__((ext_vector_type(8)));
typedef int i32x4 __attribute__((ext_vector_type(4)));

constexpr int T = 65536, D = 1024, SEQ = 4096, NB = 16;
constexpr int INC = 4352, RWC = 1792;
__device__ __forceinline__ size_t hm_off(int t, int col) { return ((size_t)(col >> 6) * T + (size_t)t) * 64 + (col & 63); }
constexpr size_t PRW_XS = (size_t)1536 * T;
constexpr int S5L = 32;
constexpr int S5NC = SEQ / S5L;
constexpr int S5ROWS = T / S5L;
constexpr int LDU = 16 * S5L + 128;
constexpr int NE = 32, TOPK = 4;
constexpr int NPASS = 2, TPP = T / NPASS;
constexpr int MAXTILES = (TPP * TOPK) / 256 + NE;
constexpr int NWAVES = 8, NTHR = 512;

constexpr size_t al(size_t x) { return (x + 4095) & ~(size_t)4095; }
constexpr size_t WS_CTL = 0, CTL_BYTES = 1 << 20;
constexpr size_t WS_WIN = WS_CTL + CTL_BYTES;
constexpr size_t WS_WGLU = WS_WIN + al((size_t)INC * D * 2);
constexpr size_t WS_WO = WS_WGLU + al((size_t)2048 * 512 * 2);
constexpr size_t WS_WOUT = WS_WO + al((size_t)1024 * 512 * 2);
constexpr size_t WS_WLORA = WS_WOUT + al((size_t)1024 * 1024 * 2);
constexpr size_t WS_WR = WS_WLORA + al((size_t)1536 * 256 * 2);
constexpr size_t WS_TOEP = WS_WR + al((size_t)256 * 1024 * 2);
constexpr size_t WS_WST = WS_TOEP + al((size_t)32 * 512 * LDU * 2);
constexpr size_t WS_BGLU = WS_WST + al((size_t)32 * 256 * 512 * 2);
constexpr size_t WS_B1P = WS_BGLU + al(2048 * 4);
constexpr size_t WS_SHARED = WS_B1P + al((size_t)32 * 2048 * 4);
constexpr size_t WS_PRW = WS_SHARED;
constexpr size_t WS_LWAG = WS_PRW + al((size_t)T * RWC * 2);
constexpr size_t WS_YS = WS_LWAG + al((size_t)T * 1536 * 2);
constexpr size_t WS_YRW = WS_YS + al((size_t)T * 512 * 2);
constexpr size_t WS_BONUS = WS_YRW + al((size_t)T * 512 * 2);
constexpr size_t WS_XN = WS_BONUS + al((size_t)T * 8 * 4);
constexpr size_t WS_US5 = WS_XN + al((size_t)T * D * 2);
constexpr size_t WS_ALORA = WS_US5 + al((size_t)32 * S5ROWS * LDU * 2);
constexpr size_t WS_SLOC = WS_ALORA + al((size_t)T * 256 * 2);
constexpr int RW_NCH = 128 * 64;
constexpr size_t CHK_BYTES = (size_t)RW_NCH * 4096 * 2;
constexpr size_t WS_CHK_M = WS_XN, WS_CHK_N0T = WS_CHK_M + CHK_BYTES, WS_CHK_Q = WS_CHK_N0T + CHK_BYTES, WS_CHK_Y0T = WS_CHK_Q + CHK_BYTES, WS_CHK_HT = WS_CHK_Y0T + CHK_BYTES;
constexpr size_t WS_MIX_END0 = WS_SLOC + al((size_t)32 * S5ROWS * 128 * 4);
constexpr size_t WS_MIX_END = (WS_CHK_HT + CHK_BYTES) > WS_MIX_END0 ? (WS_CHK_HT + CHK_BYTES) : WS_MIX_END0;
constexpr size_t WS_HB = WS_SHARED;
constexpr size_t WS_W1 = WS_HB + al((size_t)T * D * 2);
constexpr size_t WS_W2 = WS_W1 + al((size_t)32 * 2048 * 1024);
constexpr size_t WS_RS = WS_W2 + al((size_t)32 * 1024 * 1024);
constexpr size_t WS_LOG = WS_RS + al((size_t)T * 4);
constexpr size_t WS_EPOS = WS_LOG + al((size_t)T * 32 * 4);
constexpr size_t WS_GATEV = WS_EPOS + al((size_t)T * 4 * 4);
constexpr size_t WS_SLOT = WS_GATEV + al((size_t)T * 4 * 4);
constexpr size_t WS_ROWG = WS_SLOT + al((size_t)T * 4 * 4);
constexpr size_t WS_ROWTOK = WS_ROWG + al((size_t)NPASS * MAXTILES * 256 * 4);
constexpr size_t WS_TILEE = WS_ROWTOK + al((size_t)NPASS * MAXTILES * 256 * 4);
constexpr int TE_STRIDE = MAXTILES + 64;
constexpr size_t WS_XS = WS_TILEE + al((size_t)NPASS * (MAXTILES + 64) * 4);
constexpr size_t PASS_BUF = al((size_t)MAXTILES * 256 * 1024);
constexpr size_t WS_ACT = WS_XS + NPASS * PASS_BUF;
constexpr size_t WS_XN2F8 = WS_ACT + NPASS * PASS_BUF;
constexpr size_t WS_MOE_END = WS_XN2F8 + al((size_t)T * D);
static_assert(WS_W2 + (size_t)32 * 1024 * 1024 <= WS_SHARED + (size_t)T * RWC * 2, "converted expert weights must stay inside the (dead) PRW buffer while the GLU/Wo/out GEMM phases run");
constexpr size_t WS_END0 = WS_MIX_END > WS_MOE_END ? WS_MIX_END : WS_MOE_END;
constexpr size_t WS_XN8 = WS_END0;
constexpr size_t WS_WIN8 = WS_XN8 + al((size_t)T * D);
constexpr size_t WS_WOUT8 = WS_WIN8 + al((size_t)3328 * 1024);
constexpr size_t WS_WGLU8 = WS_WOUT8 + al((size_t)1024 * 1024);
constexpr size_t WS_END = WS_WGLU8 + al((size_t)2048 * 512);
constexpr size_t WS_YS8 = WS_YS;
constexpr size_t WS_MIXED8 = WS_YS;
static_assert(WS_END <= ((size_t)1 << 30), "workspace over 1 GiB");

constexpr int CW_BAR = 0;
constexpr int CW_GCNT = 4096;

constexpr float F8_SX = 16.f, F8_SW = 32.f, F8_SA = 4.f, F8_SY = 32.f, F8_SM = 16.f;
constexpr int LDS_BYTES = 144 * 1024;
constexpr int MISC_OFF = 140 * 1024;

typedef __bf16 bf16x2_t __attribute__((ext_vector_type(2)));
DI unsigned cvt_pk_bf16(float lo, float hi) { f32x2 v = {lo, hi}; bf16x2_t b = __builtin_convertvector(v, bf16x2_t); return __builtin_bit_cast(unsigned, b); }
DI unsigned pk4_fp8(float a, float b, float c, float d) {
    a = fminf(fmaxf(a, -448.f), 448.f); b = fminf(fmaxf(b, -448.f), 448.f); c = fminf(fmaxf(c, -448.f), 448.f); d = fminf(fmaxf(d, -448.f), 448.f);
    int w = __builtin_amdgcn_cvt_pk_fp8_f32(a, b, 0, false); w = __builtin_amdgcn_cvt_pk_fp8_f32(c, d, w, true); return (unsigned)w; }
DI float bf_lo(unsigned u) { return __uint_as_float(u << 16); }
DI float bf_hi(unsigned u) { return __uint_as_float(u & 0xffff0000u); }
DI float bf2f(bf16_t b) { return __uint_as_float(((unsigned)b) << 16); }
DI bf16_t f2bf(float f) { return (bf16_t)(cvt_pk_bf16(f, 0.f) & 0xffffu); }
DI float fsigmoid(float x) { return __builtin_amdgcn_rcpf(1.0f + __expf(-x)); }
DI float ftanh(float x) { float e = __expf(2.0f * x); return 1.0f - 2.0f * __builtin_amdgcn_rcpf(e + 1.0f); }
DI float fgelu_tanh(float x) { float u = 0.7978845608f * (x + 0.044715f * x * x * x); return x * fsigmoid(2.0f * u); }
DI f32x2 lo2(const f32x4& v) { return __builtin_shufflevector(v, v, 0, 1); }
DI f32x2 hi2(const f32x4& v) { return __builtin_shufflevector(v, v, 2, 3); }
DI f32x2 pk_sigmoid_scaled(f32x2 x, float negk) {
    const f32x2 t = x * negk; f32x2 e; e.x = __builtin_amdgcn_exp2f(t.x); e.y = __builtin_amdgcn_exp2f(t.y);
    const f32x2 d = e + 1.0f; f32x2 r; r.x = __builtin_amdgcn_rcpf(d.x); r.y = __builtin_amdgcn_rcpf(d.y); return r; }
DI f32x2 pk_sigmoid(f32x2 x) { return pk_sigmoid_scaled(x, -1.44269504f); }
DI f32x2 pk_gelu_tanh(f32x2 x) { const f32x2 x2 = x * x; const f32x2 u = x * (x2 * (0.044715f * 0.7978845608f) + 0.7978845608f); return x * pk_sigmoid_scaled(u, -2.0f * 1.44269504f); }
DI unsigned pk4_fp8_nc(f32x2 a, f32x2 b) { int w = __builtin_amdgcn_cvt_pk_fp8_f32(a.x, a.y, 0, false); w = __builtin_amdgcn_cvt_pk_fp8_f32(b.x, b.y, w, true); return (unsigned)w; }
#define DPP_ROR_ADD(v, n) ((v) + __builtin_bit_cast(float, __builtin_amdgcn_update_dpp(0, __builtin_bit_cast(int, (v)), 0x120 + (n), 0xf, 0xf, false)))
DI float row_sum16(float v) { v = DPP_ROR_ADD(v, 8); v = DPP_ROR_ADD(v, 4); v = DPP_ROR_ADD(v, 2); v = DPP_ROR_ADD(v, 1); return v; }
DI float xrow_sum(float x) {
    float y = x;
    asm("s_nop 1\n\tv_permlane16_swap_b32 %0, %1\n\ts_nop 1" : "+v"(x), "+v"(y));
    x = x + y; y = x;
    asm("s_nop 1\n\tv_permlane32_swap_b32 %0, %1\n\ts_nop 1" : "+v"(x), "+v"(y));
    return x + y;
}
DI float wave_sum(float v) { return xrow_sum(row_sum16(v)); }
#define DPP_ADD(v, ctrl) ((v) + __builtin_bit_cast(float, __builtin_amdgcn_update_dpp(0, __builtin_bit_cast(int, (v)), (ctrl), 0xf, 0xf, false)))
DI float comb32(float x, float y) { asm("s_nop 1\n\tv_permlane32_swap_b32 %0, %1\n\ts_nop 1" : "+v"(x), "+v"(y)); return x + y; }
DI float comb16(float x, float y) { asm("s_nop 1\n\tv_permlane16_swap_b32 %0, %1\n\ts_nop 1" : "+v"(x), "+v"(y)); return x + y; }

DI float sum16(float v) {
    v += __shfl_xor(v, 1); v += __shfl_xor(v, 2); v += __shfl_xor(v, 4); v += __shfl_xor(v, 8); return v;
}

#define XB_TMO      128
#define XB_XCNT(j)  (256  + 64 * (j))
#define XB_XSUB(j)  (1280 + 64 * (j))
#define XB_XGEN(j)  (2304 + 64 * (j))
#define XB_TOP      3328
#define XB_TOPGEN   3392
#define XCD_BAR_WORDS 3456
#define XB_SPIN_CAP (1u << 22)
DI unsigned xb_ld(unsigned* p)              { return __hip_atomic_load(p, __ATOMIC_RELAXED, __HIP_MEMORY_SCOPE_AGENT); }
DI unsigned xb_add(unsigned* p, unsigned v) { return __hip_atomic_fetch_add(p, v, __ATOMIC_RELAXED, __HIP_MEMORY_SCOPE_AGENT); }
DI unsigned xb_xcc_id() { return (unsigned)__builtin_amdgcn_s_getreg((3 << 11) | 20) & 0xFu; }
#define XB_SPIN(cond, bar) do { unsigned _sp = 0; while (cond) { __builtin_amdgcn_s_sleep(1); \
    if ((++_sp & 255u) == 0u) { if (xb_ld(&(bar)[XB_TMO])) break; if (_sp > XB_SPIN_CAP) { atomicAdd(&(bar)[XB_TMO], 1u); break; } } } } while (0)
struct XcdBarrier { unsigned* bar; unsigned x; volatile LAS unsigned* st; };
DI XcdBarrier xcd_barrier_post(unsigned* bar, volatile LAS unsigned* st) {
    XcdBarrier b; b.bar = bar; b.x = xb_xcc_id(); b.st = st;
    if (threadIdx.x == 0) (void)xb_add(&bar[XB_XCNT(b.x)], 1u);
    return b;
}
DI void xcd_barrier_complete(unsigned* bar, unsigned x, unsigned& nloc, unsigned& nx) {
    const unsigned G = gridDim.x * gridDim.y * gridDim.z;
    unsigned sum, cnt, mine, sp = 0u;
    for (;;) {
        sum = 0u; cnt = 0u; mine = 0u;
#pragma unroll
        for (unsigned j = 0; j < 16; ++j) { const unsigned c = xb_ld(&bar[XB_XCNT(j)]); sum += c; cnt += (c > 0u) ? 1u : 0u; mine = (j == x) ? c : mine; }
        if (sum == G) break;
        __builtin_amdgcn_s_sleep(1);
        if ((++sp & 255u) == 0u) { if (xb_ld(&bar[XB_TMO])) break; if (sp > XB_SPIN_CAP) { atomicAdd(&bar[XB_TMO], 1u); break; } }
    }
    nloc = mine > 0u ? mine : 1u; nx = cnt > 0u ? cnt : 1u;
}
DI void xcd_barrier(const XcdBarrier& b) {
    asm volatile("s_waitcnt vmcnt(0)" ::: "memory");
    __syncthreads();
    if (threadIdx.x == 0) {
        unsigned* bar = b.bar;
        __builtin_amdgcn_s_waitcnt(0);
        unsigned nloc = b.st[0], nx = b.st[1];
        if (nloc == 0u) { xcd_barrier_complete(bar, b.x, nloc, nx); b.st[0] = nloc; b.st[1] = nx; }
        const unsigned old = xb_add(&bar[XB_XSUB(b.x)], 1u);
        const unsigned gen = old / nloc;
        if (old + 1u == (gen + 1u) * nloc) {
            __builtin_amdgcn_fence(__ATOMIC_RELEASE, "agent");
            asm volatile("s_waitcnt vmcnt(0)" ::: "memory");
            const unsigned og = xb_add(&bar[XB_TOP], 1u);
            const unsigned tg = og / nx;
            if (og + 1u == (tg + 1u) * nx) xb_add(&bar[XB_TOPGEN], 1u);
            else XB_SPIN(xb_ld(&bar[XB_TOPGEN]) == tg, bar);
            __builtin_amdgcn_fence(__ATOMIC_ACQUIRE, "agent");
            xb_add(&bar[XB_XGEN(b.x)], 1u);
            asm volatile("s_waitcnt vmcnt(0)" ::: "memory");
        } else {
            XB_SPIN(xb_ld(&bar[XB_XGEN(b.x)]) == gen, bar);
            __builtin_amdgcn_fence(__ATOMIC_ACQUIRE, "agent");
            asm volatile("s_waitcnt vmcnt(0)" ::: "memory");
        }
    }
    __syncthreads();
}

constexpr int BM = 256, BK = 64, HALF = 128, HTB = HALF * BK * 2;
DI int lds_byte(int r, int c) { const int st = (r >> 4) * 2 + (c >> 5), rr = r & 15, cc = c & 31, ob = rr * 64 + cc * 2; return st * 1024 + (ob ^ (((ob >> 9) & 1) << 5)); }
DI void stage_rc(int b, int& R, int& C) { const int st = b / 1024, sb = b % 1024, swz = sb ^ (((sb >> 9) & 1) << 5); R = (st >> 1) * 16 + swz / 64; C = (st & 1) * 32 + (swz % 64) / 2; }
DI int perm32(int rho) { const int n = rho >> 4, i = rho & 15; return 8 * (i >> 2) + 4 * n + (i & 3); }
struct Unit { int pm, pn, aux; };

template <class Sched, class Epi>
DI void gemm_phase(LAS unsigned char* lds, const Sched& S, const Epi& E) {
    const int tid = threadIdx.x, wid = __builtin_amdgcn_readfirstlane(tid >> 6), lane = tid & 63, wr = wid >> 2, wc = wid & 3, fr = lane & 15, fq = lane >> 4;
    const int K = S.K, nt = K / BK;
    unsigned voffA[2], voffB[2];
#pragma unroll
    for (int i = 0; i < 2; ++i) { int R, C; stage_rc(tid * 16 + i * 8192, R, C); const int Rb = Epi::PERM ? ((R & ~31) + perm32(R & 31)) : R;
        voffA[i] = (unsigned)(R * S.lda + C) * 2u; voffB[i] = (unsigned)(Rb * S.ldb + C) * 2u; }
    const size_t kstep = (size_t)(BK * 2);
    const size_t hstepA = (size_t)HALF * S.lda * 2, hstepB = (size_t)HALF * S.ldb * 2;
    const unsigned ldsw = (unsigned)wid * 1024u;
    const int aoff = lds_byte(wr * 64 + fr, fq * 8), boff = lds_byte(wc * 32 + fr, fq * 8);
#define PG8_SA(b, h) (((b) * 2 + (h)) * HTB)
#define PG8_SB(b, h) ((4 + (b) * 2 + (h)) * HTB)
    const unsigned ldsbase = (unsigned)(size_t)lds;
#define PG8_STAGE(bufoff, gbase, voff) do { _Pragma("unroll") for (int _i = 0; _i < 2; ++_i) \
        asm volatile("s_mov_b32 m0, %0\n\ts_nop 0\n\tglobal_load_lds_dwordx4 %1, %2" :: "s"(ldsbase + (unsigned)(bufoff) + ldsw + (unsigned)(_i * 8192)), "v"((voff)[_i]), "s"((const char*)(gbase)) : "memory"); } while (0)
#define PG8_LDA(dst, b, h) do { _Pragma("unroll") for (int m = 0; m < 4; ++m) _Pragma("unroll") for (int k = 0; k < 2; ++k) dst[m][k] = *(const LAS bf16x8*)(lds + PG8_SA(b, h) + aoff + m * 2048 + k * 1024); } while (0)
#define PG8_LDB(dst, b, h) do { _Pragma("unroll") for (int n = 0; n < 2; ++n) _Pragma("unroll") for (int k = 0; k < 2; ++k) dst[n][k] = *(const LAS bf16x8*)(lds + PG8_SB(b, h) + boff + n * 2048 + k * 1024); } while (0)
#define PG8_MMA(ai, bj, At, Bt) do { __builtin_amdgcn_s_setprio(1); _Pragma("unroll") for (int m = 0; m < 4; ++m) _Pragma("unroll") for (int n = 0; n < 2; ++n) _Pragma("unroll") for (int k = 0; k < 2; ++k) \
        acc[ai][bj][m][n] = __builtin_amdgcn_mfma_f32_16x16x32_bf16(Bt[n][k], At[m][k], acc[ai][bj][m][n], 0, 0, 0); __builtin_amdgcn_s_setprio(0); } while (0)
#define PG8_WAIT_V(n) asm volatile("s_waitcnt vmcnt(" #n ")" ::: "memory")
#define PG8_WAIT_L(n) asm volatile("s_waitcnt lgkmcnt(" #n ")" ::: "memory")
#define PG8_BAR __builtin_amdgcn_s_barrier()
#define PG8_SCHED __builtin_amdgcn_sched_barrier(0)
    Unit cur, nxt; int ui = 0;
    if (!S.next(0, cur)) return;
    f32x4 acc[2][2][4][2];
#pragma unroll
    for (int a = 0; a < 2; ++a)
#pragma unroll
        for (int b = 0; b < 2; ++b)
#pragma unroll
            for (int m = 0; m < 4; ++m)
#pragma unroll
                for (int n = 0; n < 2; ++n) { if constexpr (Sched::FP8) { f32x2 z0_, z1_; asm volatile("v_pk_mov_b32 %0, 0, 0" : "=v"(z0_)); asm volatile("v_pk_mov_b32 %0, 0, 0" : "=v"(z1_)); acc[a][b][m][n] = (f32x4){z0_.x, z0_.y, z1_.x, z1_.y}; } else acc[a][b][m][n] = (f32x4){0.f, 0.f, 0.f, 0.f}; }
    bf16x8 At[4][2], B0[2][2], B1[2][2];
    i32x8 At8[4], B08[2], B18[2];
    const int aoff8a = lds_byte(wr * 64 + fr, 16 * fq) & ~16, boff8a = lds_byte(wc * 32 + fr, 16 * fq) & ~16;
#define PG8_LDA8(dst, b, h) do { _Pragma("unroll") for (int m = 0; m < 4; ++m) dst[m] = *(const LAS i32x8*)(lds + PG8_SA(b, h) + aoff8a + m * 2048); } while (0)
#define PG8_LDB8(dst, b, h) do { _Pragma("unroll") for (int n = 0; n < 2; ++n) dst[n] = *(const LAS i32x8*)(lds + PG8_SB(b, h) + boff8a + n * 2048); } while (0)
#define PG8_MMA8(ai, bj, At_, Bt_) do { __builtin_amdgcn_s_setprio(1); _Pragma("unroll") for (int m = 0; m < 4; ++m) _Pragma("unroll") for (int n = 0; n < 2; ++n) \
        acc[ai][bj][m][n] = __builtin_amdgcn_mfma_scale_f32_16x16x128_f8f6f4(Bt_[n], At_[m], acc[ai][bj][m][n], 0, 0, 0, 0x7f7f7f7f, 0, 0x7f7f7f7f); __builtin_amdgcn_s_setprio(0); } while (0)
#define XLDA(b, h) do { if constexpr (Sched::FP8) PG8_LDA8(At8, b, h); else PG8_LDA(At, b, h); } while (0)
#define XLDB0(b, h) do { if constexpr (Sched::FP8) PG8_LDB8(B08, b, h); else PG8_LDB(B0, b, h); } while (0)
#define XLDB1(b, h) do { if constexpr (Sched::FP8) PG8_LDB8(B18, b, h); else PG8_LDB(B1, b, h); } while (0)
#define XMMA0(ai, bj) do { if constexpr (Sched::FP8) PG8_MMA8(ai, bj, At8, B08); else PG8_MMA(ai, bj, At, B0); } while (0)
#define XMMA1(ai, bj) do { if constexpr (Sched::FP8) PG8_MMA8(ai, bj, At8, B18); else PG8_MMA(ai, bj, At, B1); } while (0)
    const char* cA = S.a_ptr(cur); const char* cB = S.b_ptr(cur);
    unsigned offA[2][2], offN[2][2];
    if constexpr (Sched::GATHER) {
#pragma unroll
        for (int h = 0; h < 2; ++h)
#pragma unroll
            for (int i = 0; i < 2; ++i) { int R, C; stage_rc(tid * 16 + i * 8192, R, C); offA[h][i] = S.a_rowoff(cur, h * HALF + R) + (unsigned)C * 2u; offN[h][i] = offA[h][i]; }
    }
#define A_STG(bufoff, plainptr, kt, h, nx) do { if constexpr (Sched::GATHER) { PG8_STAGE(bufoff, cA + (size_t)(kt) * kstep, offA[h]); } \
        else PG8_STAGE(bufoff, plainptr, voffA); } while (0)
    if constexpr (GEMM_SP2) {
        PG8_STAGE(PG8_SB(0, 0), cB, voffB); PG8_STAGE(PG8_SB(0, 1), cB + hstepB, voffB); A_STG(PG8_SA(0, 0), cA, 0, 0, false); A_STG(PG8_SA(0, 1), cA + hstepA, 0, 1, false);
        if (wr == 1) PG8_BAR;
        PG8_WAIT_V(2); PG8_BAR;
        PG8_STAGE(PG8_SB(1, 0), cB + kstep, voffB); A_STG(PG8_SA(1, 0), cA + kstep, 1, 0, false); PG8_STAGE(PG8_SB(1, 1), cB + hstepB + kstep, voffB);
        PG8_WAIT_V(6); PG8_BAR;
    } else {
    PG8_STAGE(PG8_SB(0, 0), cB, voffB); A_STG(PG8_SA(0, 0), cA, 0, 0, false); PG8_STAGE(PG8_SB(0, 1), cB + hstepB, voffB); A_STG(PG8_SA(0, 1), cA + hstepA, 0, 1, false);
    if (wr == 1) PG8_BAR;
    PG8_WAIT_V(4); PG8_BAR;
    PG8_STAGE(PG8_SB(1, 0), cB + kstep, voffB); A_STG(PG8_SA(1, 0), cA + kstep, 1, 0, false); PG8_STAGE(PG8_SB(1, 1), cB + hstepB + kstep, voffB);
    PG8_WAIT_V(6); PG8_BAR;
    }
    for (;;) {
        const bool has_next = S.next(ui + 1, nxt);
        const char* nA = has_next ? S.a_ptr(nxt) : cA; const char* nB = has_next ? S.b_ptr(nxt) : cB;
        for (int t = 0; t < nt; t += 2) {
            const bool last = (t == nt - 2);
            const char* a1 = cA + (size_t)(t + 1) * kstep;
            const char* a2 = last ? nA : cA + (size_t)(t + 2) * kstep; const char* b2 = last ? nB : cB + (size_t)(t + 2) * kstep;
            const char* a3 = a2 + kstep; const char* b3 = b2 + kstep;
            const int k2 = last ? 0 : t + 2, k3 = k2 + 1;
            if constexpr (GEMM_SP2) {
            XLDB0(0, 0); XLDB1(0, 1); PG8_SCHED; XLDA(0, 0); A_STG(PG8_SA(1, 1), a1 + hstepA, t + 1, 1, false);
            if constexpr (Sched::GATHER) {
                if (has_next && (t == nt - 4 || nt < 4)) {
#pragma unroll
                    for (int h = 0; h < 2; ++h)
#pragma unroll
                        for (int i = 0; i < 2; ++i) { int R, C; stage_rc(tid * 16 + i * 8192, R, C); offN[h][i] = S.a_rowoff(nxt, h * HALF + R) + (unsigned)C * 2u; } }
                if (last && has_next) { offA[0][0] = offN[0][0]; offA[0][1] = offN[0][1]; offA[1][0] = offN[1][0]; offA[1][1] = offN[1][1]; }
            }
            PG8_WAIT_V(8); PG8_WAIT_L(0); PG8_BAR; XMMA0(0, 0); XMMA1(0, 1); PG8_BAR; PG8_SCHED;
            XLDA(0, 1); PG8_STAGE(PG8_SB(0, 0), b2, voffB); PG8_STAGE(PG8_SB(0, 1), b2 + hstepB, voffB); A_STG(PG8_SA(0, 0), a2, k2, 0, last);
            PG8_WAIT_V(8); PG8_WAIT_L(0); PG8_BAR; XMMA0(1, 0); XMMA1(1, 1); PG8_BAR; PG8_SCHED;
            XLDB0(1, 0); XLDB1(1, 1); PG8_SCHED; XLDA(1, 0); A_STG(PG8_SA(0, 1), a2 + hstepA, k2, 1, last);
            PG8_WAIT_V(8); PG8_WAIT_L(0); PG8_BAR; XMMA0(0, 0); XMMA1(0, 1); PG8_BAR; PG8_SCHED;
            XLDA(1, 1); PG8_STAGE(PG8_SB(1, 0), b3, voffB); PG8_STAGE(PG8_SB(1, 1), b3 + hstepB, voffB); A_STG(PG8_SA(1, 0), a3, k3, 0, last);
            PG8_WAIT_V(8); PG8_WAIT_L(0); PG8_BAR; XMMA0(1, 0); XMMA1(1, 1); PG8_BAR; PG8_SCHED;
            } else {
            XLDB0(0, 0); PG8_SCHED; XLDA(0, 0); A_STG(PG8_SA(1, 1), a1 + hstepA, t + 1, 1, false);
            if constexpr (Sched::GATHER) {
                if (has_next && (t == nt - 4 || nt < 4)) {
#pragma unroll
                    for (int h = 0; h < 2; ++h)
#pragma unroll
                        for (int i = 0; i < 2; ++i) { int R, C; stage_rc(tid * 16 + i * 8192, R, C); offN[h][i] = S.a_rowoff(nxt, h * HALF + R) + (unsigned)C * 2u; } }
                if (last && has_next) { offA[0][0] = offN[0][0]; offA[0][1] = offN[0][1]; offA[1][0] = offN[1][0]; offA[1][1] = offN[1][1]; }
            }
            PG8_WAIT_L(8); PG8_BAR; PG8_WAIT_L(0); XMMA0(0, 0); PG8_BAR; PG8_SCHED;
            XLDB1(0, 1); PG8_STAGE(PG8_SB(0, 0), b2, voffB);
            PG8_BAR; PG8_WAIT_L(0); XMMA1(0, 1); PG8_BAR;
            XLDA(0, 1); A_STG(PG8_SA(0, 0), a2, k2, 0, last);
            PG8_BAR; PG8_WAIT_L(0); XMMA0(1, 0); PG8_BAR; PG8_SCHED;
            PG8_STAGE(PG8_SB(0, 1), b2 + hstepB, voffB);
            PG8_WAIT_V(6); PG8_BAR; XMMA1(1, 1); PG8_BAR;
            XLDB0(1, 0); PG8_SCHED; XLDA(1, 0); A_STG(PG8_SA(0, 1), a2 + hstepA, k2, 1, last);
            PG8_WAIT_L(8); PG8_BAR; PG8_WAIT_L(0); XMMA0(0, 0); PG8_BAR; PG8_SCHED;
            XLDB1(1, 1); PG8_STAGE(PG8_SB(1, 0), b3, voffB);
            PG8_BAR; PG8_WAIT_L(0); XMMA1(0, 1); PG8_BAR;
            XLDA(1, 1); A_STG(PG8_SA(1, 0), a3, k3, 0, last);
            PG8_BAR; PG8_WAIT_L(0); XMMA0(1, 0); PG8_BAR; PG8_SCHED;
            PG8_STAGE(PG8_SB(1, 1), b3 + hstepB, voffB);
            PG8_WAIT_V(6); PG8_BAR; XMMA1(1, 1); PG8_BAR;
            }
        }
        if constexpr (GEMM_ALIGN) { if (wr == 0) PG8_BAR; }
        {
            int tz = threadIdx.x; asm volatile("" : "+v"(tz));
            const int wid2 = tz >> 6, lane2 = tz & 63;
            E(acc, cur, wid2 >> 2, wid2 & 3, lane2 & 15, lane2 >> 4); }
        if (!has_next) break;
#pragma unroll
        for (int a = 0; a < 2; ++a)
#pragma unroll
            for (int b = 0; b < 2; ++b)
#pragma unroll
                for (int m = 0; m < 4; ++m)
#pragma unroll
                    for (int n = 0; n < 2; ++n) { if constexpr (Sched::FP8) { f32x2 z0_, z1_; asm volatile("v_pk_mov_b32 %0, 0, 0" : "=v"(z0_)); asm volatile("v_pk_mov_b32 %0, 0, 0" : "=v"(z1_)); acc[a][b][m][n] = (f32x4){z0_.x, z0_.y, z1_.x, z1_.y}; } else acc[a][b][m][n] = (f32x4){0.f, 0.f, 0.f, 0.f}; }
        cur = nxt; cA = nA; cB = nB; ++ui;
        if constexpr (GEMM_ALIGN) { if (wr == 1) PG8_BAR; }
    }
    PG8_WAIT_V(0);
    if constexpr (!GEMM_ALIGN) { if (wr == 0) PG8_BAR; }
    PG8_BAR;
#undef XLDA
#undef XLDB0
#undef XLDB1
#undef XMMA0
#undef XMMA1
#undef PG8_LDA8
#undef PG8_LDB8
#undef PG8_MMA8
#undef A_STG
#undef PG8_SA
#undef PG8_SB
#undef PG8_STAGE
#undef PG8_LDA
#undef PG8_LDB
#undef PG8_MMA
#undef PG8_WAIT_V
#undef PG8_WAIT_L
#undef PG8_BAR
#undef PG8_SCHED
}

template <bool F8>
struct PlainSchedT {
    static constexpr bool GATHER = false, FP8 = F8;
    const char* A; const char* B; int K, lda, ldb, nM, nN, nwg, G, c; int akoff_pn = 1 << 30, akoff_bytes = 0;
    int pn_base = 0;
    int rowown = 0;
    DI void init(const void* A_, const void* B_, int M, int N, int K_, int lda_, int ldb_, int G_, int c_) { A = (const char*)A_; B = (const char*)B_; K = K_; lda = lda_; ldb = ldb_; nM = M / BM; nN = N / BM; nwg = nM * nN; G = G_; c = c_; }
    DI bool next(int i, Unit& u) const {
        if (rowown) { const int pmi = c + (i / nN) * G; if (pmi >= nM) return false; u.pm = pmi; u.pn = i % nN; u.aux = 0; return true; }
        const long L = (long)i * G + c; if (L >= nwg) return false;
        int wgid = (int)L; { const int q = nwg / 8, r = nwg % 8, xcd = wgid % 8, off = wgid / 8; wgid = (xcd < r ? xcd * (q + 1) : r * (q + 1) + (xcd - r) * q) + off; }
        const int nig = 8 * nN, gid = wgid / nig, fm = gid * 8, gsz = (nM - fm) < 8 ? (nM - fm) : 8;
        u.pm = fm + ((wgid % nig) % gsz); u.pn = (wgid % nig) / gsz + pn_base; u.aux = 0; return true;
    }
    DI const char* a_ptr(const Unit& u) const { return A + (size_t)u.pm * BM * lda * 2 + (u.pn >= akoff_pn ? akoff_bytes : 0); }
    DI const char* b_ptr(const Unit& u) const { return B + (size_t)u.pn * BM * ldb * 2; }
};
typedef PlainSchedT<false> PlainSched;
struct GroupSched {
    static constexpr bool GATHER = false, FP8 = false;
    const char* A; const char* B; int K, lda, ldb, nMg, nN, nwg, G, c;
    DI void init(const void* A_, const void* B_, int K_, int lda_, int ldb_, int nMg_, int nN_, int G_, int c_) { A = (const char*)A_; B = (const char*)B_; K = K_; lda = lda_; ldb = ldb_; nMg = nMg_; nN = nN_; nwg = 32 * nMg * nN; G = G_; c = c_; }
    DI bool next(int i, Unit& u) const {
        const int L = i * G + c; if (L >= nwg) return false;
        const int per = nMg * nN, g = L / per, rem = L % per; u.pm = g * nMg + rem / nN; u.pn = rem % nN; u.aux = g; return true;
    }
    DI const char* a_ptr(const Unit& u) const { return A + (size_t)u.pm * BM * lda * 2; }
    DI const char* b_ptr(const Unit& u) const { return B + ((size_t)u.aux * nN + u.pn) * BM * ldb * 2; }
};
template <bool GATH>
struct MoeSched {
    static constexpr bool GATHER = GATH, FP8 = true;
    const char* A; const char* B; const int* tile_e; const int* rowtok; int K, lda, ldb, nN, NperE, nwg, G, c;
    DI void init(const void* A_, const void* B_, const int* te, const int* rt, int ntiles, int K_, int nN_, int G_, int c_) { A = (const char*)A_; B = (const char*)B_; tile_e = te; rowtok = rt; K = K_; lda = K_; ldb = K_; nN = nN_; NperE = nN_ * BM; nwg = ntiles * nN_; G = G_; c = c_; }
    DI bool next(int i, Unit& u) const {
        int L = i * G + c; if (L >= nwg) return false;
        if (G == 256 && (i + 1) * G <= nwg) { const int x = c & 7, sl = c >> 3, mt = G / nN / 8;
            L = i * G + (x * mt + sl / nN) * nN + (sl % nN); }
        u.pm = L / nN; u.pn = L % nN; u.aux = __builtin_amdgcn_readfirstlane(__hip_atomic_load(tile_e + u.pm, __ATOMIC_RELAXED, __HIP_MEMORY_SCOPE_AGENT)); return true;
    }
    DI const char* a_ptr(const Unit& u) const { return GATH ? A : A + (size_t)u.pm * BM * lda * 2; }
    DI unsigned a_rowoff(const Unit& u, int row) const { return (unsigned)__hip_atomic_load(rowtok + u.pm * BM + row, __ATOMIC_RELAXED, __HIP_MEMORY_SCOPE_AGENT) * (unsigned)(lda * 2); }
    DI const char* b_ptr(const Unit& u) const { return B + ((size_t)u.aux * NperE + (size_t)u.pn * BM) * ldb * 2; }
};

typedef f32x4 AccT[2][2][4][2];
struct EpiWin {
    static constexpr bool PERM = true;
    bf16_t* us5; bf16_t* prw; bf16_t* gates;
    DI static u32x4 pack8(const f32x4& v0, const f32x4& v1) { u32x4 w; w.x = cvt_pk_bf16(v0[0], v0[1]); w.y = cvt_pk_bf16(v0[2], v0[3]); w.z = cvt_pk_bf16(v1[0], v1[1]); w.w = cvt_pk_bf16(v1[2], v1[3]); return w; }
    DI void operator()(const AccT& acc, const Unit& u, int wr, int wc, int fr, int fq) const {
        if (u.pn < 2) {
#pragma unroll
            for (int ai = 0; ai < 2; ++ai)
#pragma unroll
                for (int m = 0; m < 4; ++m) { const int r = u.pm * BM + ai * HALF + wr * 64 + m * 16 + fr, b = r >> 12, sq = r & 4095, ch = sq / S5L, j = sq % S5L;
#pragma unroll
                    for (int bj = 0; bj < 2; ++bj) { const int c0 = u.pn * BM + bj * HALF + wc * 32 + 8 * fq, g = c0 >> 4, ci = c0 & 15;
                        *(u32x4*)(us5 + ((size_t)(g * S5ROWS + b * S5NC + ch) * LDU + j * 16 + ci)) = pack8(acc[ai][bj][m][0], acc[ai][bj][m][1]); } }
        } else if (u.pn < 9) {
#pragma unroll
            for (int ai = 0; ai < 2; ++ai)
#pragma unroll
                for (int m = 0; m < 4; ++m) { const int r = u.pm * BM + ai * HALF + wr * 64 + m * 16 + fr;
#pragma unroll
                    for (int bj = 0; bj < 2; ++bj) { const int c0 = u.pn * BM + bj * HALF + wc * 32 + 8 * fq - 512;
                        bf16_t* dst = (u.pn < 8) ? prw + hm_off(r, c0) : prw + PRW_XS + (size_t)r * 256 + (c0 - 1536);
                        *(u32x4*)dst = pack8(acc[ai][bj][m][0], acc[ai][bj][m][1]); } }
        } else {
#pragma unroll
            for (int ai = 0; ai < 2; ++ai)
#pragma unroll
                for (int m = 0; m < 4; ++m) { const int r = u.pm * BM + ai * HALF + wr * 64 + m * 16 + fr;
#pragma unroll
                    for (int bj = 0; bj < 2; ++bj) { const int c0 = u.pn * BM + bj * HALF + wc * 32 + 8 * fq;
                        const f32x4& v0 = acc[ai][bj][m][0]; const f32x4& v1 = acc[ai][bj][m][1];
                        const f32x2 a_ = pk_sigmoid(lo2(v0)), b_ = pk_sigmoid(hi2(v0)), c_ = pk_sigmoid(lo2(v1)), d_ = pk_sigmoid(hi2(v1));
                        u32x4 w; w.x = cvt_pk_bf16(a_.x, a_.y); w.y = cvt_pk_bf16(b_.x, b_.y); w.z = cvt_pk_bf16(c_.x, c_.y); w.w = cvt_pk_bf16(d_.x, d_.y);
                        *(u32x4*)(gates + (size_t)r * 2048 + (c0 - 2304)) = w; } }
        }
    }
};
struct EpiWinG8 {
    static constexpr bool PERM = true;
    bf16_t* us5; bf16_t* prw; bf16_t* gates;
    DI void operator()(const AccT& acc, const Unit& u, int wr, int wc, int fr, int fq) const {
        constexpr float sc = 1.0f / (F8_SX * F8_SW);
        if (u.pn < 2) {
#pragma unroll
            for (int ai = 0; ai < 2; ++ai)
#pragma unroll
                for (int m = 0; m < 4; ++m) { const int r = u.pm * BM + ai * HALF + wr * 64 + m * 16 + fr, b = r >> 12, sq = r & 4095, ch = sq / S5L, j = sq % S5L;
#pragma unroll
                    for (int bj = 0; bj < 2; ++bj) { const int c0 = u.pn * BM + bj * HALF + wc * 32 + 8 * fq, g = c0 >> 4, ci = c0 & 15;
                        *(u32x4*)(us5 + ((size_t)(g * S5ROWS + b * S5NC + ch) * LDU + j * 16 + ci)) = EpiWin::pack8(acc[ai][bj][m][0] * sc, acc[ai][bj][m][1] * sc); } }
        } else if (u.pn < 5) {
#pragma unroll
            for (int ai = 0; ai < 2; ++ai)
#pragma unroll
                for (int m = 0; m < 4; ++m) { const int r = u.pm * BM + ai * HALF + wr * 64 + m * 16 + fr;
#pragma unroll
                    for (int bj = 0; bj < 2; ++bj) { const int c0 = 1024 + (u.pn - 2) * BM + bj * HALF + wc * 32 + 8 * fq;
                        bf16_t* dst = (u.pn < 4) ? prw + hm_off(r, c0) : prw + PRW_XS + (size_t)r * 256 + (c0 - 1536);
                        *(u32x4*)dst = EpiWin::pack8(acc[ai][bj][m][0] * sc, acc[ai][bj][m][1] * sc); } }
        } else {
#pragma unroll
            for (int ai = 0; ai < 2; ++ai)
#pragma unroll
                for (int m = 0; m < 4; ++m) { const int r = u.pm * BM + ai * HALF + wr * 64 + m * 16 + fr;
#pragma unroll
                    for (int bj = 0; bj < 2; ++bj) { const int c0 = (u.pn - 5) * BM + bj * HALF + wc * 32 + 8 * fq;
                        const f32x4& v0 = acc[ai][bj][m][0]; const f32x4& v1 = acc[ai][bj][m][1];
                        const f32x2 a_ = pk_sigmoid(lo2(v0) * sc), b_ = pk_sigmoid(hi2(v0) * sc), c_ = pk_sigmoid(lo2(v1) * sc), d_ = pk_sigmoid(hi2(v1) * sc);
                        u32x4 w; w.x = cvt_pk_bf16(a_.x, a_.y); w.y = cvt_pk_bf16(b_.x, b_.y); w.z = cvt_pk_bf16(c_.x, c_.y); w.w = cvt_pk_bf16(d_.x, d_.y);
                        *(u32x4*)(gates + (size_t)r * 2048 + c0) = w; } }
        }
    }
};
struct EpiS5State {
    static constexpr bool PERM = false;
    float* sloc;
    DI void operator()(const AccT& acc, const Unit& u, int wr, int wc, int fr, int fq) const {
#pragma unroll
        for (int ai = 0; ai < 2; ++ai)
#pragma unroll
            for (int m = 0; m < 4; ++m) {
                const int r = u.pm * BM + ai * HALF + wr * 64 + m * 16 + fr;
#pragma unroll
                for (int n = 0; n < 2; ++n) *(f32x4*)(sloc + (size_t)r * 128 + wc * 32 + 16 * n + 4 * fq) = acc[ai][0][m][n];
            }
    }
};
struct EpiS5Out {
    static constexpr bool PERM = true;
    unsigned char* ys;
    DI void operator()(const AccT& acc, const Unit& u, int wr, int wc, int fr, int fq) const {
        const int g = u.aux;
#pragma unroll
        for (int ai = 0; ai < 2; ++ai)
#pragma unroll
            for (int m = 0; m < 4; ++m) {
                const int r = u.pm * BM + ai * HALF + wr * 64 + m * 16 + fr;
                const int rc = r - g * S5ROWS;
#pragma unroll
                for (int bj = 0; bj < 2; ++bj) {
                    const int c0 = u.pn * BM + bj * HALF + wc * 32 + 8 * fq;
                    const int t = c0 >> 4, co = c0 & 15;
                    const size_t tok = (size_t)rc * S5L + t;
                    f32x4 v0 = acc[ai][bj][m][0], v1 = acc[ai][bj][m][1];
                    { const f32x2 a_ = pk_gelu_tanh(lo2(v0)), b_ = pk_gelu_tanh(hi2(v0)), c_ = pk_gelu_tanh(lo2(v1)), d_ = pk_gelu_tanh(hi2(v1));
                      v0 = (f32x4){a_.x, a_.y, b_.x, b_.y}; v1 = (f32x4){c_.x, c_.y, d_.x, d_.y}; }
                    u32x2 w; w.x = pk4_fp8(v0[0] * F8_SM, v0[1] * F8_SM, v0[2] * F8_SM, v0[3] * F8_SM); w.y = pk4_fp8(v1[0] * F8_SM, v1[1] * F8_SM, v1[2] * F8_SM, v1[3] * F8_SM);
                    *(u32x2*)(ys + tok * 512 + g * 16 + co) = w;
                }
            }
    }
};
struct EpiLora {
    static constexpr bool PERM = true;
    bf16_t* lwag; const float* w0; const float* a0;
    DI void operator()(const AccT& acc, const Unit& u, int wr, int wc, int fr, int fq) const {
        f32x4 bl0[2], bl1[2];
#pragma unroll
        for (int bj = 0; bj < 2; ++bj) { const int c0 = u.pn * BM + bj * HALF + wc * 32 + 8 * fq; bl0[bj] = (f32x4){0.f, 0.f, 0.f, 0.f}; bl1[bj] = bl0[bj];
            if (c0 < 512) { bl0[bj] = *(const f32x4*)(w0 + c0); bl1[bj] = *(const f32x4*)(w0 + c0 + 4); } else if (c0 < 1024) { bl0[bj] = *(const f32x4*)(a0 + c0 - 512); bl1[bj] = *(const f32x4*)(a0 + c0 - 508); } }
#pragma unroll
        for (int bj = 0; bj < 2; ++bj) {
            const int c0 = u.pn * BM + bj * HALF + wc * 32 + 8 * fq;
            const f32x4 b0 = bl0[bj], b1 = bl1[bj];
            const f32x2 bias[4] = {lo2(b0), hi2(b0), lo2(b1), hi2(b1)};
            const float osc = (c0 < 512) ? -0.6065306597f : 1.0f;
            if (c0 < 1024) {
#pragma unroll
                for (int ai = 0; ai < 2; ++ai)
#pragma unroll
                    for (int m = 0; m < 4; ++m) { const int r = u.pm * BM + ai * HALF + wr * 64 + m * 16 + fr; u32x4 w;
#pragma unroll
                        for (int jp = 0; jp < 4; ++jp) { const f32x4& a = acc[ai][bj][m][jp >> 1]; const f32x2 v = pk_sigmoid(((jp & 1) ? hi2(a) : lo2(a)) + bias[jp]) * osc; w[jp] = cvt_pk_bf16(v.x, v.y); }
                        *(u32x4*)(lwag + hm_off(r, c0)) = w; }
            } else {
#pragma unroll
                for (int ai = 0; ai < 2; ++ai)
#pragma unroll
                    for (int m = 0; m < 4; ++m) { const int r = u.pm * BM + ai * HALF + wr * 64 + m * 16 + fr; u32x4 w;
#pragma unroll
                        for (int jp = 0; jp < 4; ++jp) { const f32x4& a = acc[ai][bj][m][jp >> 1]; const f32x2 v = (jp & 1) ? hi2(a) : lo2(a); w[jp] = cvt_pk_bf16(v.x, v.y); }
                        *(u32x4*)(lwag + hm_off(r, c0)) = w; }
            }
        }
    }
};
struct EpiGlu {
    static constexpr bool PERM = true;
    bf16_t* mixed; const bf16_t* gates; const float* bglu;
    DI void operator()(const AccT& acc, const Unit& u, int wr, int wc, int fr, int fq) const {
        const int cw = wc * 32 + 8 * fq, j0 = u.pn * 128 + cw;
        const float* bp = bglu + u.pn * 256 + cw;
        const f32x4 ba0 = *(const f32x4*)bp, ba1 = *(const f32x4*)(bp + 4), bb0 = *(const f32x4*)(bp + 128), bb1 = *(const f32x4*)(bp + 132);
        const f32x2 ba[4] = {lo2(ba0), hi2(ba0), lo2(ba1), hi2(ba1)}, bb[4] = {lo2(bb0), hi2(bb0), lo2(bb1), hi2(bb1)};
        u32x4 gw[2][4];
#pragma unroll
        for (int ai = 0; ai < 2; ++ai)
#pragma unroll
            for (int m = 0; m < 4; ++m) gw[ai][m] = *(const u32x4*)(gates + (size_t)(u.pm * BM + ai * HALF + wr * 64 + m * 16 + fr) * 2048 + j0);
#pragma unroll
        for (int ai = 0; ai < 2; ++ai)
#pragma unroll
            for (int m = 0; m < 4; ++m) {
                const int r = u.pm * BM + ai * HALF + wr * 64 + m * 16 + fr;
                u32x4 w;
#pragma unroll
                for (int jp = 0; jp < 4; ++jp) {
                    const f32x4& aa = acc[ai][0][m][jp >> 1]; const f32x4& ab = acc[ai][1][m][jp >> 1];
                    const f32x2 za = ((jp & 1) ? hi2(aa) : lo2(aa)) * (1.0f / (F8_SM * F8_SW)) + ba[jp], zb = ((jp & 1) ? hi2(ab) : lo2(ab)) * (1.0f / (F8_SM * F8_SW)) + bb[jp];
                    const unsigned gwd = gw[ai][m][jp]; const f32x2 gt = {bf_lo(gwd), bf_hi(gwd)};
                    const f32x2 o = (gt * za) * pk_sigmoid(zb);
                    w[jp] = cvt_pk_bf16(o.x, o.y);
                }
                *(u32x4*)(mixed + (size_t)r * 1024 + j0) = w;
            }
    }
};
struct EpiWo {
    static constexpr bool PERM = true;
    bf16_t* mixed; const bf16_t* gates; unsigned char* mixed8;
    DI void ld(u32x4 (&gw)[2][2], u32x4 (&mw)[2][2], const Unit& u, int k, int wr, int wc, int fr, int fq) const {
        const int ai = k >> 1;
#pragma unroll
        for (int mm = 0; mm < 2; ++mm)
#pragma unroll
            for (int bj = 0; bj < 2; ++bj) { const size_t r = (size_t)(u.pm * BM + ai * HALF + wr * 64 + (2 * (k & 1) + mm) * 16 + fr); const int c0 = u.pn * BM + bj * HALF + wc * 32 + 8 * fq;
                gw[mm][bj] = *(const u32x4*)(gates + r * 2048 + 1024 + c0); mw[mm][bj] = *(const u32x4*)(mixed + r * 1024 + c0); }
    }
    DI void operator()(const AccT& acc, const Unit& u, int wr, int wc, int fr, int fq) const {
        u32x4 gw[4][2][2], mw[4][2][2];
        ld(gw[0], mw[0], u, 0, wr, wc, fr, fq); ld(gw[1], mw[1], u, 1, wr, wc, fr, fq);
#pragma unroll
        for (int k = 0; k < 4; ++k) { const int ai = k >> 1;
            u32x2 w[2][2];
#pragma unroll
            for (int mm = 0; mm < 2; ++mm) { const int m = 2 * (k & 1) + mm;
#pragma unroll
                for (int bj = 0; bj < 2; ++bj)
                    { f32x2 o[4];
#pragma unroll
                    for (int jp = 0; jp < 4; ++jp) { const unsigned gwd = gw[k][mm][bj][jp], mwd = mw[k][mm][bj][jp]; const f32x4& a = acc[ai][bj][m][jp >> 1];
                        o[jp] = ((f32x2){bf_lo(mwd), bf_hi(mwd)} + (f32x2){bf_lo(gwd), bf_hi(gwd)} * ((jp & 1) ? hi2(a) : lo2(a))) * F8_SM; }
                    w[mm][bj].x = pk4_fp8(o[0].x, o[0].y, o[1].x, o[1].y); w[mm][bj].y = pk4_fp8(o[2].x, o[2].y, o[3].x, o[3].y); } }
            if (k < 2) ld(gw[k + 2], mw[k + 2], u, k + 2, wr, wc, fr, fq);
#pragma unroll
            for (int mm = 0; mm < 2; ++mm)
#pragma unroll
                for (int bj = 0; bj < 2; ++bj) { const size_t r = (size_t)(u.pm * BM + ai * HALF + wr * 64 + (2 * (k & 1) + mm) * 16 + fr); const int c0 = u.pn * BM + bj * HALF + wc * 32 + 8 * fq;
                    *(u32x2*)(mixed8 + r * 1024 + c0) = w[mm][bj]; }
        }
    }
};
struct EpiOut {
    static constexpr bool PERM = true;
    bf16_t* hb; const float* x;
    DI void ld(f32x4 (&xv)[2][2][2], const Unit& u, int k, int wr, int wc, int fr, int fq) const {
        const int ai = k >> 1;
#pragma unroll
        for (int mm = 0; mm < 2; ++mm) { const size_t r = (size_t)(u.pm * BM + ai * HALF + wr * 64 + (2 * (k & 1) + mm) * 16 + fr);
#pragma unroll
            for (int bj = 0; bj < 2; ++bj) { const float* xp = x + r * 1024 + u.pn * BM + bj * HALF + wc * 32 + 8 * fq; xv[mm][bj][0] = *(const f32x4*)xp; xv[mm][bj][1] = *(const f32x4*)(xp + 4); } }
    }
    DI void operator()(const AccT& acc, const Unit& u, int wr, int wc, int fr, int fq) const {
        f32x4 xv[4][2][2][2];
        ld(xv[0], u, 0, wr, wc, fr, fq); ld(xv[1], u, 1, wr, wc, fr, fq); ld(xv[2], u, 2, wr, wc, fr, fq);
#pragma unroll
        for (int k = 0; k < 4; ++k) { const int ai = k >> 1;
            u32x4 w[2][2];
#pragma unroll
            for (int mm = 0; mm < 2; ++mm) { const int m = 2 * (k & 1) + mm;
#pragma unroll
                for (int bj = 0; bj < 2; ++bj) { const f32x4 v0 = xv[k][mm][bj][0] + acc[ai][bj][m][0] * (1.0f / (F8_SM * F8_SW)), v1 = xv[k][mm][bj][1] + acc[ai][bj][m][1] * (1.0f / (F8_SM * F8_SW));
                    w[mm][bj].x = cvt_pk_bf16(v0[0], v0[1]); w[mm][bj].y = cvt_pk_bf16(v0[2], v0[3]); w[mm][bj].z = cvt_pk_bf16(v1[0], v1[1]); w[mm][bj].w = cvt_pk_bf16(v1[2], v1[3]); } }
            if (k == 0) ld(xv[3], u, 3, wr, wc, fr, fq);
#pragma unroll
            for (int mm = 0; mm < 2; ++mm) { const size_t r = (size_t)(u.pm * BM + ai * HALF + wr * 64 + (2 * (k & 1) + mm) * 16 + fr);
#pragma unroll
                for (int bj = 0; bj < 2; ++bj) *(u32x4*)(hb + r * 1024 + u.pn * BM + bj * HALF + wc * 32 + 8 * fq) = w[mm][bj]; }
        }
    }
};
struct EpiRouter {
    static constexpr bool PERM = false;
    float* logits;
    DI void operator()(const AccT& acc, const Unit& u, int wr, int wc, int fr, int fq) const {
        if (wc != 0) return;
#pragma unroll
        for (int n = 0; n < 2; ++n) {
            const int c = 16 * n + 4 * fq;
#pragma unroll
            for (int ai = 0; ai < 2; ++ai)
#pragma unroll
                for (int m = 0; m < 4; ++m) {
                    const size_t r = (size_t)(u.pm * BM + ai * HALF + wr * 64 + m * 16 + fr);
                    *(f32x4*)(logits + r * 32 + c) = acc[ai][0][m][n];
                }
        }
    }
};
struct EpiMoe1 {
    static constexpr bool PERM = true;
    unsigned char* act; const float* b1p;
    DI void operator()(const AccT& acc, const Unit& u, int wr, int wc, int fr, int fq) const {
        const int cw = wc * 32 + 8 * fq, j0 = u.pn * 128 + cw;
        const float* bp = b1p + (size_t)u.aux * 2048 + u.pn * 256 + cw;
        const f32x4 ba0 = *(const f32x4*)bp, ba1 = *(const f32x4*)(bp + 4), bb0 = *(const f32x4*)(bp + 128), bb1 = *(const f32x4*)(bp + 132);
        const f32x2 ba[4] = {lo2(ba0), hi2(ba0), lo2(ba1), hi2(ba1)}, bb[4] = {lo2(bb0), hi2(bb0), lo2(bb1), hi2(bb1)};
        constexpr float sc = 1.0f / (F8_SX * F8_SW);
#pragma unroll
        for (int ai = 0; ai < 2; ++ai)
#pragma unroll
            for (int m = 0; m < 4; ++m) {
                const size_t r = (size_t)(u.pm * BM + ai * HALF + wr * 64 + m * 16 + fr);
                f32x2 o[4];
#pragma unroll
                for (int jp = 0; jp < 4; ++jp) {
                    const f32x4& ag = acc[ai][0][m][jp >> 1]; const f32x4& al_ = acc[ai][1][m][jp >> 1];
                    const f32x2 g = ((jp & 1) ? hi2(ag) : lo2(ag)) * sc + ba[jp], l = ((jp & 1) ? hi2(al_) : lo2(al_)) * sc + bb[jp];
                    const f32x2 xg = __builtin_elementwise_min(g, (f32x2){7.0f, 7.0f});
                    const f32x2 xl = __builtin_elementwise_min(__builtin_elementwise_max(l, (f32x2){-7.0f, -7.0f}), (f32x2){7.0f, 7.0f});
                    o[jp] = (xg * pk_sigmoid_scaled(xg, -1.702f * 1.44269504f)) * (xl * F8_SA + F8_SA);
                }
                u32x2 w; w.x = pk4_fp8_nc(o[0], o[1]); w.y = pk4_fp8_nc(o[2], o[3]);
                *(u32x2*)(act + r * 1024 + j0) = w;
            }
    }
};
struct EpiMoe2 {
    static constexpr bool PERM = true;
    unsigned char* y2; const float* b2; const float* rowg;
    DI void operator()(const AccT& acc, const Unit& u, int wr, int wc, int fr, int fq) const {
        float gt[2][4];
#pragma unroll
        for (int ai = 0; ai < 2; ++ai)
#pragma unroll
            for (int m = 0; m < 4; ++m) gt[ai][m] = rowg[(size_t)(u.pm * BM + ai * HALF + wr * 64 + m * 16 + fr)] * F8_SY;
#pragma unroll
        for (int bj = 0; bj < 2; ++bj) {
            const int c0 = u.pn * BM + bj * HALF + wc * 32 + 8 * fq;
            const f32x4 bva = *(const f32x4*)(b2 + (size_t)u.aux * 1024 + c0), bvb = *(const f32x4*)(b2 + (size_t)u.aux * 1024 + c0 + 4);
            const f32x2 bv[4] = {lo2(bva), hi2(bva), lo2(bvb), hi2(bvb)};
#pragma unroll
            for (int ai = 0; ai < 2; ++ai)
#pragma unroll
                for (int m = 0; m < 4; ++m) {
                    const size_t r = (size_t)(u.pm * BM + ai * HALF + wr * 64 + m * 16 + fr);
                    const float g = gt[ai][m];
                    f32x2 o[4];
#pragma unroll
                    for (int jp = 0; jp < 4; ++jp) { const f32x4& a = acc[ai][bj][m][jp >> 1];
                        o[jp] = (((jp & 1) ? hi2(a) : lo2(a)) * (1.0f / (F8_SA * F8_SW)) + bv[jp]) * g;
                        o[jp] = __builtin_elementwise_min(__builtin_elementwise_max(o[jp], (f32x2){-448.f, -448.f}), (f32x2){448.f, 448.f}); }
                    u32x2 w; w.x = pk4_fp8_nc(o[0], o[1]); w.y = pk4_fp8_nc(o[2], o[3]);
                    *(u32x2*)(y2 + r * 1024 + c0) = w;
                }
        }
    }
};
struct KArgs { const float* in[34]; float* out; unsigned char* ws; int ph_lo, ph_hi; };
struct Frame {
    LAS unsigned char* lds; int tid, lane, wave, G, bid;
    const float* const* in; float* out; unsigned char* ws;
};

template <class MP>
DI void conv_T(const Frame& F, const float* src, size_t src_bstride, int ld, bf16_t* dst, int N, int K, int nbatch, MP mp, int t0 = 0, int t1 = 0x7fffffff) {
    LAS unsigned* tile = (LAS unsigned*)F.lds;
    const int ntk = K / 64, ntn = N / 256, per = ntk * ntn;
    const int tend = (per * nbatch) < t1 ? (per * nbatch) : t1;
    for (int t = t0 + F.bid; t < tend; t += F.G) {
        const int bt = t / per, tt = t % per, tk = tt % ntk, pn = tt / ntk;
        const float* s = src + (size_t)bt * src_bstride + (size_t)(tk * 64) * ld + mp.src(pn, F.lane);
        f32x4 va[4], vb[4];
#pragma unroll
        for (int i = 0; i < 4; ++i) { const int kp = F.wave + 8 * i; va[i] = *(const f32x4*)(s + (size_t)(2 * kp) * ld); vb[i] = *(const f32x4*)(s + (size_t)(2 * kp + 1) * ld); }
#pragma unroll
        for (int i = 0; i < 4; ++i) { const int kp = F.wave + 8 * i;
#pragma unroll
            for (int j = 0; j < 4; ++j) tile[mp.dst(F.lane, j) * 33 + kp] = cvt_pk_bf16(va[i][j], vb[i][j]); }
        __syncthreads();
        unsigned* d = (unsigned*)(dst + (size_t)bt * N * K + (size_t)(pn * 256) * K + tk * 64);
#pragma unroll
        for (int i = 0; i < 4; ++i) { const int pc = F.tid + NTHR * i, nn = pc >> 3, seg = pc & 7;
            u32x4 w; w.x = tile[nn * 33 + seg * 4]; w.y = tile[nn * 33 + seg * 4 + 1]; w.z = tile[nn * 33 + seg * 4 + 2]; w.w = tile[nn * 33 + seg * 4 + 3];
            *(u32x4*)(d + ((size_t)nn * K) / 2 + seg * 4) = w; }
        __syncthreads();
    }
}
template <class MP>
DI void conv_T8(const Frame& F, const float* src, size_t src_bstride, int ld, unsigned char* dst, int N, int K, int nbatch, MP mp, float scale, int t0 = 0, int t1 = 0x7fffffff) {
    LAS unsigned* tile = (LAS unsigned*)F.lds;
    const int ntk = K / 64, ntn = N / 256, per = ntk * ntn;
    const int tend = (per * nbatch) < t1 ? (per * nbatch) : t1;
    for (int t = t0 + F.bid; t < tend; t += F.G) {
        const int bt = t / per, tt = t % per, tk = tt % ntk, pn = tt / ntk;
        const float* s = src + (size_t)bt * src_bstride + (size_t)(tk * 64) * ld + mp.src(pn, F.lane);
        f32x4 v[2][4];
#pragma unroll
        for (int i = 0; i < 2; ++i) { const int kq = F.wave + 8 * i;
#pragma unroll
            for (int e = 0; e < 4; ++e) v[i][e] = *(const f32x4*)(s + (size_t)(4 * kq + e) * ld); }
#pragma unroll
        for (int i = 0; i < 2; ++i) { const int kq = F.wave + 8 * i;
#pragma unroll
            for (int j = 0; j < 4; ++j) tile[mp.dst(F.lane, j) * 17 + kq] = pk4_fp8(v[i][0][j] * scale, v[i][1][j] * scale, v[i][2][j] * scale, v[i][3][j] * scale); }
        __syncthreads();
        unsigned char* d = dst + ((size_t)bt * N + (size_t)pn * 256) * K + tk * 64;
#pragma unroll
        for (int i = 0; i < 2; ++i) { const int pc = F.tid + NTHR * i, nn = pc >> 2, seg = pc & 3;
            u32x4 w; w.x = tile[nn * 17 + seg * 4]; w.y = tile[nn * 17 + seg * 4 + 1]; w.z = tile[nn * 17 + seg * 4 + 2]; w.w = tile[nn * 17 + seg * 4 + 3];
            *(u32x4*)(d + (size_t)nn * K + seg * 16) = w; }
        __syncthreads();
    }
}
struct MpId  { DI int src(int pn, int f) const { return pn * 256 + 4 * f; } DI int dst(int f, int j) const { return 4 * f + j; } };
struct MpSwi { DI int src(int pn, int f) const { return pn * 256 + 4 * f; } DI int dst(int f, int j) const { const int n = 4 * f + j; return (n >> 1) + 128 * (n & 1); } };
struct MpGlu { DI int src(int pn, int f) const { const int w = 4 * f; return pn * 128 + (w & 127) + 1024 * (w >> 7); } DI int dst(int f, int j) const { return 4 * f + j; } };
struct CmGlu { DI int operator()(int n) const { const int pn = n >> 8, w = n & 255; return pn * 128 + (w & 127) + 1024 * (w >> 7); } };
struct CmSwi { DI int operator()(int n) const { const int pn = n >> 8, w = n & 255; return 2 * (pn * 128 + (w & 127)) + (w >> 7); } };

DI void rmsnorm_rows(const Frame& F, const float* x, const float* g, bf16_t* out, int row0, int nrows, unsigned char* out8 = nullptr) {
    const int stride = F.G * NWAVES;
    for (int row = row0 + F.bid * NWAVES + F.wave; row < row0 + nrows; row += 2 * stride) {
        const int row2 = (row + stride < row0 + nrows) ? row + stride : row;
        const f32x4* xr = (const f32x4*)(x + (size_t)row * D); const f32x4* xr2 = (const f32x4*)(x + (size_t)row2 * D);
        f32x4 v[4], u[4]; float ss = 0.f, su = 0.f;
#pragma unroll
        for (int i = 0; i < 4; ++i) { v[i] = xr[i * 64 + F.lane]; u[i] = xr2[i * 64 + F.lane]; }
#pragma unroll
        for (int i = 0; i < 4; ++i) { ss += v[i][0] * v[i][0] + v[i][1] * v[i][1] + v[i][2] * v[i][2] + v[i][3] * v[i][3]; su += u[i][0] * u[i][0] + u[i][1] * u[i][1] + u[i][2] * u[i][2] + u[i][3] * u[i][3]; }
        ss = wave_sum(ss); su = wave_sum(su);
        const float rs = rsqrtf(ss * (1.0f / D) + 1e-5f), ru = rsqrtf(su * (1.0f / D) + 1e-5f);
#pragma unroll
        for (int i = 0; i < 4; ++i) { const f32x4 gv = ((const f32x4*)g)[i * 64 + F.lane];
            u32x2 w; w.x = cvt_pk_bf16(v[i][0] * rs * gv[0], v[i][1] * rs * gv[1]); w.y = cvt_pk_bf16(v[i][2] * rs * gv[2], v[i][3] * rs * gv[3]);
            *(u32x2*)(out + (size_t)row * D + (i * 64 + F.lane) * 4) = w;
            u32x2 w2; w2.x = cvt_pk_bf16(u[i][0] * ru * gv[0], u[i][1] * ru * gv[1]); w2.y = cvt_pk_bf16(u[i][2] * ru * gv[2], u[i][3] * ru * gv[3]);
            *(u32x2*)(out + (size_t)row2 * D + (i * 64 + F.lane) * 4) = w2;
            if (out8) { *(unsigned*)(out8 + (size_t)row * D + (i * 64 + F.lane) * 4) = pk4_fp8(v[i][0] * rs * gv[0] * F8_SX, v[i][1] * rs * gv[1] * F8_SX, v[i][2] * rs * gv[2] * F8_SX, v[i][3] * rs * gv[3] * F8_SX);
                *(unsigned*)(out8 + (size_t)row2 * D + (i * 64 + F.lane) * 4) = pk4_fp8(u[i][0] * ru * gv[0] * F8_SX, u[i][1] * ru * gv[1] * F8_SX, u[i][2] * ru * gv[2] * F8_SX, u[i][3] * ru * gv[3] * F8_SX); } }
    }
}

DI void p0_prologue(const Frame& F) {
    unsigned char* ws = F.ws;
    conv_T(F, F.in[2], 0, INC, (bf16_t*)(ws + WS_WIN), 2304, D, 1, MpId());
    conv_T8(F, F.in[2], 0, INC, (unsigned char*)(ws + WS_WIN8), 512, 1024, 1, MpId(), F8_SW);
    conv_T8(F, F.in[2] + 1536, 0, INC, (unsigned char*)(ws + WS_WIN8) + (size_t)512 * 1024, 2816, 1024, 1, MpId(), F8_SW);
    conv_T8(F, F.in[11], 0, 2048, (unsigned char*)(ws + WS_WGLU8), 2048, 512, 1, MpGlu(), F8_SW);
    conv_T(F, F.in[24], 0, 1024, (bf16_t*)(ws + WS_WO), 1024, 512, 1, MpId());
    conv_T8(F, F.in[25], 0, 1024, (unsigned char*)(ws + WS_WOUT8), 1024, 1024, 1, MpId(), F8_SW);
    {
        bf16_t* wl = (bf16_t*)(ws + WS_WLORA); const float* w2 = F.in[15]; const float* a2 = F.in[17]; const float* g2 = F.in[18];
        for (int idx = F.bid * NTHR + F.tid; idx < 1536 * 128; idx += F.G * NTHR) { const int n = idx >> 7, k = idx & 127; float v = 0.f;
            if (n < 512) { if (k < 64) v = w2[k * 512 + n]; } else if (n < 1024) { if (k >= 64) v = a2[(k - 64) * 512 + (n - 512)]; } else { v = g2[k * 512 + (n - 1024)]; }
            wl[idx] = f2bf(v); }
        bf16_t* wrt = (bf16_t*)(ws + WS_WR); const float* rw = F.in[27];
        for (int idx = F.bid * NTHR + F.tid; idx < 256 * 1024; idx += F.G * NTHR) { const int n = idx >> 10, k = idx & 1023; wrt[idx] = f2bf(n < 32 ? rw[k * 32 + n] * F.in[26][k] : 0.f); }
        float* bg = (float*)(ws + WS_BGLU); const float* bsrc = F.in[12]; CmGlu cm;
        for (int idx = F.bid * NTHR + F.tid; idx < 2048; idx += F.G * NTHR) bg[idx] = bsrc[cm(idx)];
    }
    if (F.bid & 1) rmsnorm_rows(F, F.in[0], F.in[1], (bf16_t*)(ws + WS_XN), 0, T, ws + WS_XN8);
    {
        LAS float* L = (LAS float*)F.lds;
        LAS float* pwr = L, *pwi = L + 64, *p1r = L + 128, *p1i = L + 192, *ffr = L + 256, *ffi = L + 320;
        LAS float* bbr = L + 384, *bbi = bbr + 1024, *ccr = bbi + 1024, *cci = ccr + 1024, *kj = cci + 1024;
        const float* lam_re = F.in[3]; const float* lam_im = F.in[4]; const float* log_dt = F.in[5];
        const float* b_re = F.in[6]; const float* b_im = F.in[7]; const float* c_re = F.in[8]; const float* c_im = F.in[9]; const float* dsk = F.in[10];
        unsigned* toep = (unsigned*)(ws + WS_TOEP); unsigned* wst = (unsigned*)(ws + WS_WST);
        for (int it = F.bid; it < 32 * S5L; it += F.G) {
            const int g = it / S5L, j = it % S5L;
            if (F.tid < 64) { const int p = F.tid; const float lr = lam_re[g * 64 + p], li = lam_im[g * 64 + p], dt = __expf(log_dt[g]);
                float sn, cs; { const float mg = expf((float)j * lr * dt); sincosf((float)j * (li * dt), &sn, &cs); pwr[p] = mg * cs; pwi[p] = mg * sn; }
                { const float mg = expf((float)(j + 1) * lr * dt); sincosf((float)(j + 1) * (li * dt), &sn, &cs); p1r[p] = mg * cs; p1i[p] = mg * sn; }
                { const float mg = expf(lr * dt); sincosf(li * dt, &sn, &cs); const float nr = mg * cs - 1.0f, ni = mg * sn, den = lr * lr + li * li;
                  ffr[p] = (nr * lr + ni * li) / den; ffi[p] = (ni * lr - nr * li) / den; } }
            __syncthreads();
            for (int idx = F.tid; idx < 1024; idx += NTHR) { const int p = idx >> 4; const float br = b_re[g * 1024 + idx], bi = b_im[g * 1024 + idx];
                bbr[idx] = ffr[p] * br - ffi[p] * bi; bbi[idx] = ffr[p] * bi + ffi[p] * br;
                ccr[idx] = c_re[g * 1024 + idx]; cci[idx] = c_im[g * 1024 + idx]; }
            __syncthreads();
            if (F.tid < 256) { const int co = F.tid >> 4, ci = F.tid & 15; float s = 0.f;
                for (int p = 0; p < 64; ++p) { const float zr = pwr[p] * bbr[p * 16 + ci] - pwi[p] * bbi[p * 16 + ci], zi = pwr[p] * bbi[p * 16 + ci] + pwi[p] * bbr[p * 16 + ci];
                    s += ccr[co * 64 + p] * zr - cci[co * 64 + p] * zi; }
                if (j == 0 && co == ci) s += dsk[g * 16 + co];
                kj[F.tid] = s; }
            __syncthreads();
            for (int idx = F.tid; idx < (S5L - j) * 128; idx += NTHR) { const int t = j + idx / 128, rem = idx % 128, co = rem >> 3, ci = (rem & 7) * 2;
                toep[((size_t)(g * 512 + t * 16 + co) * LDU + (t - j) * 16 + ci) / 2] = cvt_pk_bf16(kj[co * 16 + ci], kj[co * 16 + ci + 1]);
                if (j > 0) toep[((size_t)(g * 512 + (t - j) * 16 + co) * LDU + t * 16 + ci) / 2] = 0u; }
            for (int idx = F.tid; idx < 16 * 64; idx += NTHR) { const int co = idx >> 6, q = (idx & 63) * 2; float o[2];
#pragma unroll
                for (int e = 0; e < 2; ++e) { const int qq = q + e, p = qq & 63; const float cr = ccr[co * 64 + p], cim = cci[co * 64 + p];
                    o[e] = (qq < 64) ? (cr * p1r[p] - cim * p1i[p]) : -(cr * p1i[p] + cim * p1r[p]); }
                toep[((size_t)(g * 512 + j * 16 + co) * LDU + 512 + q) / 2] = cvt_pk_bf16(o[0], o[1]); }
            { const int s = S5L - 1 - j;
              for (int idx = F.tid; idx < 256 * 8; idx += NTHR) { const int q = idx >> 3, ci = (idx & 7) * 2; float o[2] = {0.f, 0.f};
                if (q < 128) { const int p = q & 63;
#pragma unroll
                    for (int e = 0; e < 2; ++e) { const float br = bbr[p * 16 + ci + e], bi = bbi[p * 16 + ci + e];
                        o[e] = (q < 64) ? (pwr[p] * br - pwi[p] * bi) : (pwr[p] * bi + pwi[p] * br); } }
                wst[((size_t)(g * 256 + q) * 512 + s * 16 + ci) / 2] = cvt_pk_bf16(o[0], o[1]); } }
            __syncthreads();
        }
    }
    if (!(F.bid & 1)) rmsnorm_rows(F, F.in[0], F.in[1], (bf16_t*)(ws + WS_XN), 0, T, ws + WS_XN8);
}

DI void p_rw_prep(const Frame& F) {
    const bf16_t* prw = (const bf16_t*)(F.ws + WS_PRW); bf16_t* al_ = (bf16_t*)(F.ws + WS_ALORA); const float* mu = F.in[13];
    for (int idx = F.bid * NTHR + F.tid; idx < T * 32; idx += F.G * NTHR) {
        const int t = idx >> 5, c8 = (idx & 31) * 8;
        const u32x4 cur = *(const u32x4*)(prw + PRW_XS + (size_t)t * 256 + c8);
        u32x4 prv = (u32x4){0u, 0u, 0u, 0u};
        if ((t & (SEQ - 1)) != 0) prv = *(const u32x4*)(prw + PRW_XS + (size_t)(t - 1) * 256 + c8);
        float o[8];
#pragma unroll
        for (int j = 0; j < 8; ++j) { const float c = (j & 1) ? bf_hi(cur[j >> 1]) : bf_lo(cur[j >> 1]), p = (j & 1) ? bf_hi(prv[j >> 1]) : bf_lo(prv[j >> 1]);
            const float xs = c + mu[1536 + c8 + j] * (p - c);
            o[j] = (c8 < 64) ? ftanh(xs) : ((c8 < 128) ? xs : fsigmoid(xs)); }
        u32x4 w; w.x = cvt_pk_bf16(o[0], o[1]); w.y = cvt_pk_bf16(o[2], o[3]); w.z = cvt_pk_bf16(o[4], o[5]); w.w = cvt_pk_bf16(o[6], o[7]);
        *(u32x4*)(al_ + (size_t)t * 256 + c8) = w;
    }
}

DI void p_s5_carry(const Frame& F) {
    static_assert(S5NC == 128, "four 32-chunk quarters per sequence");
    const float* lam_re = F.in[3]; const float* lam_im = F.in[4]; const float* log_dt = F.in[5];
    const float* sloc = (const float*)(F.ws + WS_SLOC); bf16_t* us5 = (bf16_t*)(F.ws + WS_US5);
    LAS float* xch = (LAS float*)F.lds;
    const int p = F.lane, seg = F.wave & 3, pr = F.wave >> 2;
    for (int it = F.bid; it < NB * 32 / 2; it += F.G) {
        const int bg = 2 * it + pr, g = bg & 31, b = bg >> 5;
        const float lr = lam_re[g * 64 + p], li = lam_im[g * 64 + p], dt = __expf(log_dt[g]);
        float sn, cs; const float mg = expf((float)S5L * lr * dt); sincosf((float)S5L * (li * dt), &sn, &cs);
        const float ar = mg * cs, ai = mg * sn;
        const size_t row0 = (size_t)g * S5ROWS + (size_t)b * S5NC + seg * 32;
        float sr[32], si[32];
#pragma unroll
        for (int j = 0; j < 32; ++j) { sr[j] = sloc[(row0 + j) * 128 + p]; si[j] = sloc[(row0 + j) * 128 + 64 + p]; }
        float xr = 0.f, xi = 0.f;
#pragma unroll
        for (int j = 0; j < 32; ++j) { const float nr = ar * xr - ai * xi + sr[j], ni = ar * xi + ai * xr + si[j]; xr = nr; xi = ni; }
        xch[((pr * 4 + seg) * 2 + 0) * 64 + p] = xr; xch[((pr * 4 + seg) * 2 + 1) * 64 + p] = xi;
        __syncthreads();
        float qr = ar, qi = ai;
#pragma unroll
        for (int k = 0; k < 5; ++k) { const float t = qr * qr - qi * qi; qi = 2.0f * qr * qi; qr = t; }
        xr = 0.f; xi = 0.f;
#pragma unroll
        for (int k = 0; k < 3; ++k) if (k < seg) { const float er = xch[((pr * 4 + k) * 2 + 0) * 64 + p], ei = xch[((pr * 4 + k) * 2 + 1) * 64 + p];
            const float nr = qr * xr - qi * xi + er, ni = qr * xi + qi * xr + ei; xr = nr; xi = ni; }
        __syncthreads();
#pragma unroll
        for (int j = 0; j < 32; ++j) { const size_t row = row0 + j;
            us5[row * LDU + 512 + p] = f2bf(xr); us5[row * LDU + 576 + p] = f2bf(xi);
            const float nr = ar * xr - ai * xi + sr[j], ni = ar * xi + ai * xr + si[j];
            xr = nr; xi = ni; }
    }
}

constexpr int PT = 72, SLOTB = 64 * PT * 2;
DI LAS bf16_t* rslot(LAS unsigned char* lds, int i) { return (LAS bf16_t*)(lds + i * SLOTB); }
DI void mm_acc(f32x4 (&acc)[2], const LAS bf16_t* A, const LAS bf16_t* Bt, int ti, int tj0, int r, int q) {
#pragma unroll
    for (int s2 = 0; s2 < 2; ++s2) {
        const bf16x8 a = *(const LAS bf16x8*)(A + (16 * ti + r) * PT + 32 * s2 + 8 * q);
#pragma unroll
        for (int e = 0; e < 2; ++e) { const bf16x8 b = *(const LAS bf16x8*)(Bt + (16 * (tj0 + e) + r) * PT + 32 * s2 + 8 * q);
            acc[e] = __builtin_amdgcn_mfma_f32_16x16x32_bf16(a, b, acc[e], 0, 0, 0); }
    }
}
DI void mm_acc_bnat(f32x4 (&acc)[2], const LAS bf16_t* A, const LAS bf16_t* Bn, int ti, int tj0, int r, int q) {
#pragma unroll
    for (int s2 = 0; s2 < 2; ++s2) {
        const bf16x8 a = *(const LAS bf16x8*)(A + (16 * ti + r) * PT + 32 * s2 + 8 * q);
#pragma unroll
        for (int e = 0; e < 2; ++e) { bf16x8 b;
#pragma unroll
            for (int jj = 0; jj < 8; ++jj) b[jj] = (short)Bn[(32 * s2 + 8 * q + jj) * PT + 16 * (tj0 + e) + r];
            acc[e] = __builtin_amdgcn_mfma_f32_16x16x32_bf16(a, b, acc[e], 0, 0, 0); }
    }
}
DI void st_rm(LAS bf16_t* Dm, const f32x4& v, int i0, int j) {
#pragma unroll
    for (int g = 0; g < 4; ++g) Dm[(i0 + g) * PT + j] = f2bf(v[g]);
}
DI void st_tr(LAS bf16_t* Dm, const f32x4& v, int i0, int j) { u32x2 w; w.x = cvt_pk_bf16(v[0], v[1]); w.y = cvt_pk_bf16(v[2], v[3]); *(LAS u32x2*)(Dm + j * PT + i0) = w; }
DI f32x4 ld_rm(const LAS bf16_t* Sm, int i0, int j) { f32x4 v;
#pragma unroll
    for (int g = 0; g < 4; ++g) v[g] = bf2f(Sm[(i0 + g) * PT + j]);
    return v; }
DI void ld_frag(bf16x8 (&f)[2], const LAS bf16_t* M, int row, int q) { f[0] = *(const LAS bf16x8*)(M + row * PT + 8 * q); f[1] = *(const LAS bf16x8*)(M + row * PT + 32 + 8 * q); }
DI f32x4 mm2(const bf16x8 (&x)[2], const bf16x8 (&y)[2], f32x4 c) { c = __builtin_amdgcn_mfma_f32_16x16x32_bf16(x[0], y[0], c, 0, 0, 0); return __builtin_amdgcn_mfma_f32_16x16x32_bf16(x[1], y[1], c, 0, 0, 0); }
typedef short v4i16_t __attribute__((ext_vector_type(4)));
DI void ld_frag_tr(bf16x8 (&f)[2], const LAS bf16_t* XT, int T0, int r, int q) {
#pragma unroll
    for (int s2 = 0; s2 < 2; ++s2) { const LAS bf16_t* p = XT + (32 * s2 + 8 * q + (r >> 2)) * PT + T0 + 4 * (r & 3);
        const v4i16_t lo = __builtin_amdgcn_ds_read_tr16_b64_v4i16((LAS v4i16_t*)p), hi = __builtin_amdgcn_ds_read_tr16_b64_v4i16((LAS v4i16_t*)(p + 4 * PT));
        f[s2] = __builtin_shufflevector(lo, hi, 0, 1, 2, 3, 4, 5, 6, 7); }
}
DI void st_sw(LAS bf16_t* Dm, const f32x4& v, int i, int j0) { u32x2 w; w.x = cvt_pk_bf16(v[0], v[1]); w.y = cvt_pk_bf16(v[2], v[3]); *(LAS u32x2*)(Dm + i * PT + j0) = w; }
DI f32x4 ld_sw(const LAS bf16_t* Sm, int i, int j0) { const u32x2 w = *(const LAS u32x2*)(Sm + i * PT + j0); return (f32x4){bf_lo(w.x), bf_hi(w.x), bf_lo(w.y), bf_hi(w.y)}; }
#define ZACC(a) do { a[0] = (f32x4){0.f, 0.f, 0.f, 0.f}; a[1] = (f32x4){0.f, 0.f, 0.f, 0.f}; } while (0)

DI float wave_sum2(float v) { return xrow_sum(row_sum16(v)); }
#define LSYNC() do { asm volatile("s_waitcnt lgkmcnt(0)" ::: "memory"); __builtin_amdgcn_s_barrier(); asm volatile("" ::: "memory"); } while (0)

struct RaRaw { bf16_t r[9], k[9], v[9], lw[8], a[8]; float c[6]; };
DI void ra_load(RaRaw& x, const bf16_t* prw, const bf16_t* lwag, const float* mu, const float* k_k, const float* k_a, const float* r_k, int ci, int w, int lane) {
    const int bh = ci >> 6, c = ci & 63, b = bh >> 3, h = bh & 7;
    const size_t tok0 = (size_t)b * SEQ + c * 64 + 8 * w;
    const bool has_prev = !(c == 0 && w == 0);
    const size_t e0 = ((size_t)h * T + tok0) * 64, st = (size_t)8 * T * 64;
    const bf16_t* pr_ = prw + e0 + lane; const bf16_t* pk_ = pr_ + st; const bf16_t* pv_ = pk_ + st;
    const bf16_t* pl_ = lwag + e0 + lane; const bf16_t* pa_ = pl_ + st;
    const int po = has_prev ? -64 : 0;
    x.r[0] = pr_[po]; x.k[0] = pk_[po]; x.v[0] = pv_[po];
#pragma unroll
    for (int i = 0; i < 8; ++i) {
        x.r[i + 1] = pr_[i * 64]; x.k[i + 1] = pk_[i * 64]; x.v[i + 1] = pv_[i * 64];
        x.lw[i] = pl_[i * 64]; x.a[i] = pa_[i * 64]; }
    const int ch = h * 64 + lane;
    x.c[0] = mu[ch]; x.c[1] = mu[512 + ch]; x.c[2] = mu[1024 + ch]; x.c[3] = k_k[ch]; x.c[4] = k_a[ch]; x.c[5] = r_k[ch];
}
DI void p_rw_chunk(const Frame& F) {
    const bf16_t* prw = (const bf16_t*)(F.ws + WS_PRW); const bf16_t* lwag = (const bf16_t*)(F.ws + WS_LWAG);
    const float* mu = F.in[13]; const float* k_k = F.in[19]; const float* k_a = F.in[20]; const float* r_k = F.in[21];
    float* bonus = (float*)(F.ws + WS_BONUS);
    bf16_t* gM = (bf16_t*)(F.ws + WS_CHK_M); bf16_t* gN0T = (bf16_t*)(F.ws + WS_CHK_N0T); bf16_t* gQ = (bf16_t*)(F.ws + WS_CHK_Q); bf16_t* gY0 = (bf16_t*)(F.ws + WS_CHK_Y0T);
    LAS unsigned char* lds = F.lds;
    LAS float* segtot = (LAS float*)(lds + 14 * SLOTB);
    LAS float* PLs = segtot + 512;
    LAS float* DB = PLs + 64;
    constexpr int PD = 20;
    constexpr int TP = 24;
    LAS bf16_t* TDT = (LAS bf16_t*)(DB + 64 * PD);
    const int w = F.wave, lane = F.lane, r = lane & 15, q = lane >> 4, ti = w >> 1, tj0 = 2 * (w & 1), i0 = 16 * ti + 4 * q;
    LAS bf16_t* S0 = rslot(lds, 0); LAS bf16_t* S1 = rslot(lds, 1); LAS bf16_t* S2 = rslot(lds, 2); LAS bf16_t* S3 = rslot(lds, 3);
    LAS bf16_t* S4 = rslot(lds, 4); LAS bf16_t* S5 = rslot(lds, 5); LAS bf16_t* S6 = rslot(lds, 6); LAS bf16_t* S7 = rslot(lds, 7);
    LAS bf16_t* S8 = rslot(lds, 8); LAS bf16_t* S9 = rslot(lds, 9); LAS bf16_t* S10 = rslot(lds, 10); LAS bf16_t* S11 = rslot(lds, 11);
    LAS bf16_t* S12 = rslot(lds, 12); LAS bf16_t* S13 = rslot(lds, 13);
    bf16x8 idf[2][2];
#pragma unroll
    for (int e = 0; e < 2; ++e)
#pragma unroll
        for (int s2 = 0; s2 < 2; ++s2)
#pragma unroll
            for (int jj = 0; jj < 8; ++jj) idf[e][s2][jj] = (32 * s2 + 8 * q + jj == 16 * (tj0 + e) + r) ? (short)0x3F80 : (short)0;
    RaRaw raw;
    if (F.bid < RW_NCH) ra_load(raw, prw, lwag, mu, k_k, k_a, r_k, F.bid, w, lane);
    __builtin_amdgcn_s_waitcnt(0x0F70);
    for (int ci = F.bid; ci < RW_NCH; ci += F.G) {
        const int bh = ci >> 6, c = ci & 63, b = bh >> 3, h = bh & 7, ch = h * 64 + lane;
        {
            const size_t tok0 = (size_t)b * SEQ + c * 64 + 8 * w;
            const float mur = raw.c[0], muk = raw.c[1], muv = raw.c[2], kkw = raw.c[3], ka = raw.c[4], rk = raw.c[5];
            const bool has_prev = !(c == 0 && w == 0);
            float xr[9], xk[9], xv[9];
            xr[0] = has_prev ? bf2f(raw.r[0]) : 0.f; xk[0] = has_prev ? bf2f(raw.k[0]) : 0.f; xv[0] = has_prev ? bf2f(raw.v[0]) : 0.f;
#pragma unroll
            for (int i = 1; i < 9; ++i) { xr[i] = bf2f(raw.r[i]); xk[i] = bf2f(raw.k[i]); xv[i] = bf2f(raw.v[i]); }
            f32x2 rr2[4], vv2[4], aa2[4], km2[4], kn2[4], sq2[4], bq2[4]; float cl[8];
            float run = 0.f;
#pragma unroll
            for (int p2 = 0; p2 < 4; ++p2) {
                const f32x2 cr = {xr[2 * p2 + 1], xr[2 * p2 + 2]}, pr = {xr[2 * p2], xr[2 * p2 + 1]};
                const f32x2 ck = {xk[2 * p2 + 1], xk[2 * p2 + 2]}, pk = {xk[2 * p2], xk[2 * p2 + 1]};
                const f32x2 cv = {xv[2 * p2 + 1], xv[2 * p2 + 2]}, pv = {xv[2 * p2], xv[2 * p2 + 1]};
                const f32x2 r_ = cr + (pr - cr) * mur, k_ = ck + (pk - ck) * muk, v_ = cv + (pv - cv) * muv;
                const f32x2 a_ = {bf2f(raw.a[2 * p2]), bf2f(raw.a[2 * p2 + 1])};
                const f32x2 kx = k_ * kkw; sq2[p2] = kx * kx;
                const f32x2 kmod = k_ * (a_ * ka + (1.0f - ka));
                bq2[p2] = (r_ * kmod) * rk;
                rr2[p2] = r_; vv2[p2] = v_; aa2[p2] = a_; km2[p2] = kmod; kn2[p2] = kx;
                run += bf2f(raw.lw[2 * p2]); cl[2 * p2] = run; run += bf2f(raw.lw[2 * p2 + 1]); cl[2 * p2 + 1] = run;
            }
            {
                float A8[8], B4[4], C2[2];
#pragma unroll
                for (int k = 0; k < 4; ++k) { A8[k] = comb32(sq2[k].x, sq2[k].y); A8[4 + k] = comb32(bq2[k].x, bq2[k].y); }
#pragma unroll
                for (int j = 0; j < 4; ++j) B4[j] = comb16(A8[2 * j], A8[2 * j + 1]);
#pragma unroll
                for (int i = 0; i < 2; ++i) { const float t1 = DPP_ADD(B4[2 * i], 0x128), t2 = DPP_ADD(B4[2 * i + 1], 0x128); C2[i] = (lane & 8) ? t2 : t1; }
                const float u1 = DPP_ADD(C2[0], 0x141), u2 = DPP_ADD(C2[1], 0x141);
                float dsum = (lane & 4) ? u2 : u1;
                dsum = DPP_ADD(dsum, 0xB1); dsum = DPP_ADD(dsum, 0x4E);
                if ((lane & 7) == 4) bonus[(tok0 + 4 * ((lane >> 3) & 1) + 2 * ((lane >> 4) & 1) + (lane >> 5)) * 8 + h] = dsum;
                const float rsv = fminf(__builtin_amdgcn_rsqf(dsum), 1e12f);
                const int rsi = __builtin_bit_cast(int, rsv);
                float rs[8];
#pragma unroll
                for (int tt = 0; tt < 8; ++tt) rs[tt] = __builtin_bit_cast(float, __builtin_amdgcn_readlane(rsi, 8 * (tt >> 2) + 16 * ((tt >> 1) & 1) + 32 * (tt & 1)));
#pragma unroll
                for (int p2 = 0; p2 < 4; ++p2) kn2[p2] = kn2[p2] * (f32x2){rs[2 * p2], rs[2 * p2 + 1]};
            }
            segtot[w * 64 + lane] = run;
            LSYNC();
            float pre = 0.f;
#pragma unroll
            for (int w2 = 0; w2 < 7; ++w2) { const float sv = segtot[w2 * 64 + lane]; pre += (w2 < w) ? sv : 0.f; }
            if (w == 7) PLs[lane] = __expf(pre + run);
            float ep = __expf(pre);
            unsigned xa[4], xb[4], xkk[4], xrr[4], xvv[4];
#pragma unroll
            for (int p2 = 0; p2 < 4; ++p2) {
                const f32x2 tt = ((f32x2){cl[2 * p2], cl[2 * p2 + 1]} + pre) * 1.44269504f;
                const f32x2 e = {__builtin_amdgcn_exp2f(tt.x), __builtin_amdgcn_exp2f(tt.y)}, en = {__builtin_amdgcn_rcpf(e.x), __builtin_amdgcn_rcpf(e.y)}, epv = {ep, e.x};
                ep = e.y;
                const f32x2 at = -(kn2[p2] * epv), bt = (kn2[p2] * aa2[p2]) * en, kt = km2[p2] * en, rt = rr2[p2] * e;
                xa[p2] = cvt_pk_bf16(at.x, at.y); xb[p2] = cvt_pk_bf16(bt.x, bt.y); xkk[p2] = cvt_pk_bf16(kt.x, kt.y); xrr[p2] = cvt_pk_bf16(rt.x, rt.y); xvv[p2] = cvt_pk_bf16(vv2[p2].x, vv2[p2].y);
            }
            *(LAS u32x4*)(S1 + lane * PT + 8 * w) = (u32x4){xa[0], xa[1], xa[2], xa[3]};
            *(LAS u32x4*)(S3 + lane * PT + 8 * w) = (u32x4){xb[0], xb[1], xb[2], xb[3]};
            *(LAS u32x4*)(S5 + lane * PT + 8 * w) = (u32x4){xkk[0], xkk[1], xkk[2], xkk[3]};
            *(LAS u32x4*)(S7 + lane * PT + 8 * w) = (u32x4){xvv[0], xvv[1], xvv[2], xvv[3]};
            *(LAS u32x4*)(S6 + lane * PT + 8 * w) = (u32x4){xrr[0], xrr[1], xrr[2], xrr[3]};
        }
        LSYNC();
        if (ci + F.G < RW_NCH) ra_load(raw, prw, lwag, mu, k_k, k_a, r_k, ci + F.G, w, lane);
        f32x4 acc[2];
        const f32x4 Z4 = (f32x4){0.f, 0.f, 0.f, 0.f};
        const int ia = 16 * ti + r, jb0 = 16 * tj0 + r;
        bf16x8 a6[2];
        { bf16x8 a0[2], b2[2][2], b4[2][2];
          ld_frag_tr(a0, S1, 16 * ti, r, q); ld_frag_tr(a6, S6, 16 * ti, r, q);
#pragma unroll
          for (int e = 0; e < 2; ++e) { ld_frag_tr(b2[e], S3, 16 * (tj0 + e), r, q); ld_frag_tr(b4[e], S5, 16 * (tj0 + e), r, q); }
#pragma unroll
          for (int e = 0; e < 2; ++e) { const int tj = tj0 + e, j = 16 * tj + r, js = 16 * tj + 4 * q;
            const f32x4 c = mm2(a0, b2[e], Z4);
            if (tj == ti) {
#pragma unroll
                for (int g = 0; g < 4; ++g) DB[(ti * 16 + 4 * q + g) * PD + r] = (4 * q + g > r) ? c[g] : 0.f;
            }
            st_tr(S8, (ti > tj) ? c : Z4, i0, j);
            f32x4 v = mm2(b4[e], a0, Z4);
#pragma unroll
            for (int g = 0; g < 4; ++g) v[g] = (ia > js + g) ? v[g] : 0.f;
            st_sw(S9, v, ia, js);
            v = mm2(b2[e], a6, Z4);
#pragma unroll
            for (int g = 0; g < 4; ++g) v[g] = (ia >= js + g) ? v[g] : 0.f;
            st_sw(S10, v, ia, js);
            v = mm2(b4[e], a6, Z4);
#pragma unroll
            for (int g = 0; g < 4; ++g) v[g] = (ia >= js + g) ? v[g] : 0.f;
            st_sw(S11, v, ia, js); } }
        LSYNC();
        ZACC(acc); mm_acc(acc, S9, S7, ti, tj0, r, q);
#pragma unroll
        for (int e = 0; e < 2; ++e) st_tr(S2, acc[e], i0, 16 * (tj0 + e) + r);
        if (w < 4) {
            const int i = lane >> 2, p = lane & 3;
            int io = i; asm volatile("" : "+v"(io));
            const LAS float* Dp = DB + (w * 16 + p) * PD;
            f32x4 Dm[4][4];
#pragma unroll
            for (int m = 0; m < 4; ++m)
#pragma unroll
                for (int c4 = 0; c4 < 4; ++c4) Dm[m][c4] = *(const LAS f32x4*)(Dp + 4 * m * PD + 4 * c4);
            float mine[4] = {0.f, 0.f, 0.f, 0.f}, tr[16];
#pragma unroll
            for (int j = 15; j >= 0; --j) { float part = 0.f;
#pragma unroll
                for (int m = 3; m >= 0; --m) if (4 * m + 3 > j) part = __builtin_fmaf(mine[m], Dm[m][j >> 2][j & 3], part);
                float tot = part + __builtin_bit_cast(float, __builtin_amdgcn_update_dpp(0, __builtin_bit_cast(int, part), 0xB1, 0xf, 0xf, false));
                tot = tot + __builtin_bit_cast(float, __builtin_amdgcn_update_dpp(0, __builtin_bit_cast(int, tot), 0x4E, 0xf, 0xf, false));
                const float trj = (j == io) ? 1.0f : tot;
                tr[j] = trj; mine[j >> 2] = (p == (j & 3)) ? trj : mine[j >> 2]; }
            u32x4 z = (u32x4){0u, 0u, 0u, 0u}, x0, x1;
            x0.x = cvt_pk_bf16(tr[0], tr[1]); x0.y = cvt_pk_bf16(tr[2], tr[3]); x0.z = cvt_pk_bf16(tr[4], tr[5]); x0.w = cvt_pk_bf16(tr[6], tr[7]);
            x1.x = cvt_pk_bf16(tr[8], tr[9]); x1.y = cvt_pk_bf16(tr[10], tr[11]); x1.z = cvt_pk_bf16(tr[12], tr[13]); x1.w = cvt_pk_bf16(tr[14], tr[15]);
            LAS bf16_t* dst = S0 + (16 * w + i) * PT + 16 * p;
            *(LAS u32x4*)dst = (p == w) ? x0 : z; *(LAS u32x4*)(dst + 8) = (p == w) ? x1 : z;
#pragma unroll
            for (int m = 0; m < 4; ++m) TDT[(16 * w + 4 * m + p) * TP + i] = f2bf(mine[m]);
        }
        LSYNC();
        { bf16x8 a[2], b[2][2]; ld_frag(a, S0, ia, q);
#pragma unroll
          for (int e = 0; e < 2; ++e) ld_frag(b[e], S8, jb0 + 16 * e, q);
#pragma unroll
          for (int e = 0; e < 2; ++e) { st_tr(S12, mm2(a, b[e], Z4), i0, 16 * (tj0 + e) + r); st_sw(S4, mm2(b[e], a, Z4), ia, 16 * (tj0 + e) + 4 * q); } }
        LSYNC();
        { bf16x8 a[2], b[2][2]; ld_frag(a, S4, ia, q);
#pragma unroll
          for (int e = 0; e < 2; ++e) ld_frag(b[e], S12, jb0 + 16 * e, q);
          const bf16x8 as = (w & 1) ? a[1] : a[0];
#pragma unroll
          for (int e = 0; e < 2; ++e) { const int tj = tj0 + e, j = 16 * tj + r, js = 16 * tj + 4 * q;
            st_sw(S13, mm2(b[e], a, Z4), ia, js);
            bf16x8 bt = *(const LAS bf16x8*)(TDT + j * TP + 8 * (q & 1));
            if ((q >> 1) != e) bt = (bf16x8){0, 0, 0, 0, 0, 0, 0, 0};
            f32x4 c = Z4;
            if (ti == tj) { const u32x2 wv = *(const LAS u32x2*)(TDT + j * TP + 4 * q); c = (f32x4){bf_lo(wv.x), bf_hi(wv.x), bf_lo(wv.y), bf_hi(wv.y)}; }
            st_tr(S9, __builtin_amdgcn_mfma_f32_16x16x32_bf16(as, bt, c, 0, 0, 0), i0, j);
            st_sw(S8, __builtin_amdgcn_mfma_f32_16x16x32_bf16(bt, as, ld_sw(S0, ia, js), 0, 0, 0), ia, js); } }
        LSYNC();
        { bf16x8 a[2], b[2][2]; ld_frag(a, S13, ia, q);
#pragma unroll
          for (int e = 0; e < 2; ++e) ld_frag(b[e], S9, jb0 + 16 * e, q);
#pragma unroll
          for (int e = 0; e < 2; ++e) { const int js = 16 * (tj0 + e) + 4 * q; st_sw(S12, mm2(b[e], a, ld_sw(S8, ia, js)), ia, js); } }
        LSYNC();
        { bf16x8 a[2], b1[2][2], bx[2][2]; ld_frag(a, S12, ia, q);
#pragma unroll
          for (int e = 0; e < 2; ++e) { ld_frag(b1[e], S1, jb0 + 16 * e, q); ld_frag(bx[e], S2, jb0 + 16 * e, q); }
#pragma unroll
          for (int e = 0; e < 2; ++e) { const int j = 16 * (tj0 + e) + r; st_tr(S0, mm2(a, b1[e], Z4), i0, j); st_tr(S4, mm2(a, bx[e], Z4), i0, j); } }
        LSYNC();
        { bf16x8 a10[2], a11[2], a3[2], a5[2], b0[2][2], b4[2][2], b7[2][2];
          ld_frag(a10, S10, ia, q); ld_frag(a11, S11, ia, q); ld_frag(a3, S3, ia, q); ld_frag(a5, S5, ia, q);
#pragma unroll
          for (int e = 0; e < 2; ++e) { ld_frag(b0[e], S0, jb0 + 16 * e, q); ld_frag(b4[e], S4, jb0 + 16 * e, q); ld_frag(b7[e], S7, jb0 + 16 * e, q); }
          const float pli = PLs[ia];
          f32x4 plg;
#pragma unroll
          for (int g = 0; g < 4; ++g) plg[g] = PLs[i0 + g];
#pragma unroll
          for (int e = 0; e < 2; ++e) { const int j = 16 * (tj0 + e) + r, js = 16 * (tj0 + e) + 4 * q;
            const f32x4 vq = mm2(b0[e], a10, mm2(idf[e], a6, Z4));
            const f32x4 vy = mm2(b7[e], a11, mm2(b4[e], a10, Z4));
            f32x4 vm = mm2(b0[e], a3, Z4);
#pragma unroll
            for (int g = 0; g < 4; ++g) vm[g] = pli * (vm[g] + ((ia == js + g) ? 1.0f : 0.f));
            const f32x4 vn = mm2(a5, b7[e], mm2(a3, b4[e], Z4)) * plg;
            st_sw(S1, vq, ia, js); st_sw(S2, vy, ia, js); st_sw(S8, vm, ia, js); st_tr(S9, vn, i0, j); } }
        LSYNC();
        { const int row = F.tid >> 3, seg = (F.tid & 7) * 8; const size_t go = (size_t)ci * 4096 + row * 64 + seg;
          *(u32x4*)(gQ + go) = *(const LAS u32x4*)(S1 + row * PT + seg); *(u32x4*)(gY0 + go) = *(const LAS u32x4*)(S2 + row * PT + seg);
          *(u32x4*)(gM + go) = *(const LAS u32x4*)(S8 + row * PT + seg); *(u32x4*)(gN0T + go) = *(const LAS u32x4*)(S9 + row * PT + seg); }
        LSYNC();
        __builtin_amdgcn_s_waitcnt(0x0F74);
    }
    asm volatile("s_waitcnt vmcnt(0)" ::: "memory");
}

struct ScanOps { u32x2 m[4][2][2]; u32x2 n0[4]; };
DI void scan_load(ScanOps& o, const bf16_t* gM, const bf16_t* gN0T, size_t ci, int col, int q, int v) {
#pragma unroll
    for (int m = 0; m < 4; ++m) {
#pragma unroll
        for (int s2 = 0; s2 < 2; ++s2) { const bf16_t* p = gM + ci * 4096 + (16 * m + col) * 64 + 32 * s2 + 4 * q; o.m[m][s2][0] = *(const u32x2*)p; o.m[m][s2][1] = *(const u32x2*)(p + 16); }
        o.n0[m] = *(const u32x2*)(gN0T + ci * 4096 + v * 64 + 16 * m + 4 * q); }
}
DI void scan_step(const ScanOps& o, f32x4 (&H)[4], bf16_t* gHT, size_t ci, int q, int v) {
    u32x4 bfr[2];
#pragma unroll
    for (int s2 = 0; s2 < 2; ++s2) { bfr[s2].x = cvt_pk_bf16(H[2 * s2][0], H[2 * s2][1]); bfr[s2].y = cvt_pk_bf16(H[2 * s2][2], H[2 * s2][3]);
        bfr[s2].z = cvt_pk_bf16(H[2 * s2 + 1][0], H[2 * s2 + 1][1]); bfr[s2].w = cvt_pk_bf16(H[2 * s2 + 1][2], H[2 * s2 + 1][3]);
        bf16_t* hp = gHT + ci * 4096 + v * 64 + 32 * s2 + 4 * q;
        *(u32x2*)hp = (u32x2){bfr[s2].x, bfr[s2].y}; *(u32x2*)(hp + 16) = (u32x2){bfr[s2].z, bfr[s2].w}; }
#pragma unroll
    for (int m = 0; m < 4; ++m) {
        f32x4 a2 = (f32x4){bf_lo(o.n0[m].x), bf_hi(o.n0[m].x), bf_lo(o.n0[m].y), bf_hi(o.n0[m].y)};
#pragma unroll
        for (int s2 = 0; s2 < 2; ++s2) { const u32x4 af = (u32x4){o.m[m][s2][0].x, o.m[m][s2][0].y, o.m[m][s2][1].x, o.m[m][s2][1].y};
            a2 = __builtin_amdgcn_mfma_f32_16x16x32_bf16(__builtin_bit_cast(bf16x8, af), __builtin_bit_cast(bf16x8, bfr[s2]), a2, 0, 0, 0); }
        H[m] = a2; }
}
constexpr int SC_DEPTH = 10, SC_SLOT = 12288;
DI void scan_dma(unsigned lds_dst, unsigned voff, const char* base) { asm volatile("s_mov_b32 m0, %0\n\ts_nop 0\n\tglobal_load_lds_dwordx4 %1, %2" :: "s"(lds_dst), "v"(voff), "s"(base) : "memory"); }
DI void scan_lds_load(ScanOps& o, const LAS unsigned char* slot, int lbM, int lbN, const int (&xo)[2][2], int c7) {
#pragma unroll
    for (int m = 0; m < 4; ++m) {
#pragma unroll
        for (int s2 = 0; s2 < 2; ++s2) { o.m[m][s2][0] = *(const LAS u32x2*)(slot + lbM + m * 2048 + xo[s2][0]); o.m[m][s2][1] = *(const LAS u32x2*)(slot + lbM + m * 2048 + xo[s2][1]); }
        o.n0[m] = *(const LAS u32x2*)(slot + 8192 + lbN + (((2 * m) << 4) ^ c7)); }
}
DI void p_rw_scan(const Frame& F) {
    const bf16_t* gM = (const bf16_t*)(F.ws + WS_CHK_M); const bf16_t* gN0T = (const bf16_t*)(F.ws + WS_CHK_N0T); bf16_t* gHT = (bf16_t*)(F.ws + WS_CHK_HT);
    const unsigned ldsbase = (unsigned)(size_t)F.lds;
    const int w = F.wave, col = F.lane & 15, q = F.lane >> 4;
    const int lw = w - 2, lt = F.tid - 128;
    const int P1 = (384 + lt) & 511;
    const unsigned voff0 = (unsigned)((lt >> 3) * 128 + (((lt & 7) ^ ((lt >> 3) & 7)) << 4));
    const unsigned voff1 = (unsigned)((P1 >> 3) * 128 + (((P1 & 7) ^ ((P1 >> 3) & 7)) << 4));
    const int c7 = (col & 7) << 4, qh = (q >> 1) << 4;
    const int lbM = col * 128 + 8 * (q & 1), lbN = (16 * (w & 1) + col) * 128 + 8 * (q & 1);
    int xo[2][2];
#pragma unroll
    for (int s2 = 0; s2 < 2; ++s2)
#pragma unroll
        for (int h = 0; h < 2; ++h) xo[s2][h] = (((4 * s2 + 2 * h) << 4) + qh) ^ c7;
    const int c7n = c7 ^ qh;
    for (int p = F.bid; p < 256; p += F.G) {
        const int bh = p >> 1, half = p & 1, v = 32 * half + 16 * (w & 1) + col;
        const size_t c0 = (size_t)bh * 64;
        const char* baseM = (const char*)(gM + c0 * 4096);
        const char* baseN = (const char*)(gN0T + c0 * 4096 + half * 2048);
        const char* base1 = (lw < 2) ? baseM : baseN;
#define SC_ISSUE(c, slot) do { if (w >= 2) { const unsigned _d = ldsbase + (unsigned)(slot) * SC_SLOT + (unsigned)lw * 1024u; \
            scan_dma(_d, voff0 + (unsigned)(c) * 8192u, baseM); scan_dma(_d + 6144u, voff1 + (unsigned)(c) * 8192u, base1); } } while (0)
#pragma unroll 1
        for (int c = 0; c < SC_DEPTH; ++c) SC_ISSUE(c, c);
        asm volatile("s_waitcnt vmcnt(0)" ::: "memory"); __builtin_amdgcn_s_barrier();
        static_assert(2 * (SC_DEPTH - 2) == 16, "vmcnt literal below");
        if (w < 2) {
            f32x4 H[4];
#pragma unroll
            for (int m = 0; m < 4; ++m) H[m] = (f32x4){0.f, 0.f, 0.f, 0.f};
            ScanOps A, B;
            scan_lds_load(A, F.lds, lbM, lbN, xo, c7n);
            int slot = 0;
#define SC_STEP(X, Y, c) do { \
                __builtin_amdgcn_s_waitcnt(0xC07F);     \
                __builtin_amdgcn_s_barrier(); \
                slot = (slot + 1 == SC_DEPTH) ? 0 : slot + 1; \
                scan_lds_load(Y, F.lds + slot * SC_SLOT, lbM, lbN, xo, c7n); \
                scan_step(X, H, gHT, c0 + (c), q, v); } while (0)
#pragma unroll 1
            for (int c = 0; c < 64; c += 2) { SC_STEP(A, B, c); SC_STEP(B, A, c + 1); }
        } else {
            int slot = 0;
#pragma unroll 1
            for (int c = 0; c < 64; ++c) {
                asm volatile("s_waitcnt vmcnt(16)" ::: "memory");
                __builtin_amdgcn_s_barrier();
                { const int _cn = (c + SC_DEPTH < 64) ? c + SC_DEPTH : 63; SC_ISSUE(_cn, slot); }
                slot = (slot + 1 == SC_DEPTH) ? 0 : slot + 1;
            }
        }
#undef SC_STEP
#undef SC_ISSUE
        asm volatile("s_waitcnt vmcnt(0)" ::: "memory"); __builtin_amdgcn_s_barrier();
    }
}

struct RcIn { bf16x8 qf[2], hb[4][2]; u32x2 y0[4], cv[4], pv[4], gw[4]; float bn; };
DI void rc_load(RcIn& x, const bf16_t* gQ, const bf16_t* gY0, const bf16_t* gHT, const bf16_t* prw, const bf16_t* lwag, const float* bonus, int item, int r, int q) {
    const int ci = item >> 2, ti = item & 3, bh = ci >> 6, c = ci & 63, b = bh >> 3, h = bh & 7;
    const size_t cb = (size_t)ci * 4096; const size_t tok = (size_t)b * SEQ + c * 64 + 16 * ti + r;
    const bool first = (tok & (SEQ - 1)) == 0; const size_t tp = first ? tok : tok - 1;
#pragma unroll
    for (int s2 = 0; s2 < 2; ++s2) x.qf[s2] = *(const bf16x8*)(gQ + cb + (16 * ti + r) * 64 + 32 * s2 + 8 * q);
#pragma unroll
    for (int n = 0; n < 4; ++n) { const int cch = h * 64 + 16 * n + 4 * q;
        x.y0[n] = *(const u32x2*)(gY0 + cb + (16 * ti + r) * 64 + 16 * n + 4 * q);
#pragma unroll
        for (int s2 = 0; s2 < 2; ++s2) x.hb[n][s2] = *(const bf16x8*)(gHT + cb + (16 * n + r) * 64 + 32 * s2 + 8 * q);
        x.cv[n] = *(const u32x2*)(prw + hm_off((int)tok, 1024 + cch)); x.pv[n] = *(const u32x2*)(prw + hm_off((int)tp, 1024 + cch));
        x.gw[n] = *(const u32x2*)(lwag + hm_off((int)tok, 1024 + cch)); }
    x.bn = bonus[tok * 8 + h];
}
DI void rc_compute(const RcIn& x, bf16_t* yrw, const float* mu, const float* ln_g, const float* ln_b, int item, int r, int q) {
    const int ci = item >> 2, ti = item & 3, bh = ci >> 6, c = ci & 63, b = bh >> 3, h = bh & 7;
    const size_t tok = (size_t)b * SEQ + c * 64 + 16 * ti + r; const bool first = (tok & (SEQ - 1)) == 0;
    f32x4 y[4];
#pragma unroll
    for (int n = 0; n < 4; ++n) { y[n] = (f32x4){bf_lo(x.y0[n].x), bf_hi(x.y0[n].x), bf_lo(x.y0[n].y), bf_hi(x.y0[n].y)};
#pragma unroll
        for (int s2 = 0; s2 < 2; ++s2) y[n] = __builtin_amdgcn_mfma_f32_16x16x32_bf16(x.hb[n][s2], x.qf[s2], y[n], 0, 0, 0); }
    float s1 = 0.f;
#pragma unroll
    for (int n = 0; n < 4; ++n) s1 += (y[n][0] + y[n][1]) + (y[n][2] + y[n][3]);
    s1 = xrow_sum(s1);
    const float mean = s1 * (1.0f / 64.0f);
    float s2 = 0.f;
#pragma unroll
    for (int n = 0; n < 4; ++n) { y[n] = y[n] - mean; s2 += (y[n][0] * y[n][0] + y[n][1] * y[n][1]) + (y[n][2] * y[n][2] + y[n][3] * y[n][3]); }
    s2 = xrow_sum(s2);
    const float rstd = rsqrtf(s2 * (1.0f / 64.0f) + 64e-5f);
#pragma unroll
    for (int n = 0; n < 4; ++n) { const int cch = h * 64 + 16 * n + 4 * q;
        const f32x4 muv = *(const f32x4*)(mu + 1024 + cch), lg = *(const f32x4*)(ln_g + cch), lb = *(const f32x4*)(ln_b + cch);
        const float cv[4] = {bf_lo(x.cv[n].x), bf_hi(x.cv[n].x), bf_lo(x.cv[n].y), bf_hi(x.cv[n].y)};
        const float pv[4] = {first ? 0.f : bf_lo(x.pv[n].x), first ? 0.f : bf_hi(x.pv[n].x), first ? 0.f : bf_lo(x.pv[n].y), first ? 0.f : bf_hi(x.pv[n].y)};
        const float gg[4] = {bf_lo(x.gw[n].x), bf_hi(x.gw[n].x), bf_lo(x.gw[n].y), bf_hi(x.gw[n].y)};
        float o[4];
#pragma unroll
        for (int g = 0; g < 4; ++g) { const float vsh = cv[g] + muv[g] * (pv[g] - cv[g]); o[g] = (y[n][g] * rstd * lg[g] + lb[g] + x.bn * vsh) * gg[g]; }
        u32x2 ow; ow.x = cvt_pk_bf16(o[0], o[1]); ow.y = cvt_pk_bf16(o[2], o[3]);
        *(u32x2*)(yrw + tok * 512 + cch) = ow; }
}
constexpr int RC_NSLOT = 3, RC_SLOT = 5 * 8192;
DI void p_rw_out(const Frame& F) {
    const bf16_t* gQ = (const bf16_t*)(F.ws + WS_CHK_Q); const bf16_t* gY0 = (const bf16_t*)(F.ws + WS_CHK_Y0T); const bf16_t* gHT = (const bf16_t*)(F.ws + WS_CHK_HT);
    const bf16_t* prw = (const bf16_t*)(F.ws + WS_PRW); const bf16_t* lwag = (const bf16_t*)(F.ws + WS_LWAG); const float* bonus = (const float*)(F.ws + WS_BONUS);
    bf16_t* yrw = (bf16_t*)(F.ws + WS_YRW);
    const float* mu = F.in[13]; const float* ln_g = F.in[22]; const float* ln_b = F.in[23];
    const unsigned ldsbase = (unsigned)(size_t)F.lds;
    const int w = F.wave, r = F.lane & 15, q = F.lane >> 4;
    const int nch = (RW_NCH - F.bid + F.G - 1) / F.G;
    if (w >= 4) {
        const int lw = w - 4, lt = F.tid - 256;
        const unsigned voff0 = (unsigned)((lt >> 3) * 128 + (((lt & 7) ^ ((lt >> 3) & 7)) << 4));
#define RC_ISSUE(k, slot) do { const int _k = ((k) < nch) ? (k) : nch - 1; const int _ci = F.bid + _k * F.G, _bh = _ci >> 6, _c = _ci & 63, _b = _bh >> 3, _h = _bh & 7; \
            const size_t _cb = (size_t)_ci * 4096, _hv = ((size_t)(16 + _h) * T + (size_t)_b * SEQ + _c * 64) * 64; \
            const unsigned _d = ldsbase + (unsigned)(slot) * RC_SLOT + (unsigned)lw * 1024u; \
            const char* _p0 = (const char*)(gQ + _cb); const char* _p1 = (const char*)(gY0 + _cb); const char* _p2 = (const char*)(gHT + _cb); const char* _p3 = (const char*)(prw + _hv); const char* _p4 = (const char*)(lwag + _hv); \
            scan_dma(_d, voff0, _p0); scan_dma(_d + 4096u, voff0 + 4096u, _p0); scan_dma(_d + 8192u, voff0, _p1); scan_dma(_d + 12288u, voff0 + 4096u, _p1); \
            scan_dma(_d + 16384u, voff0, _p2); scan_dma(_d + 20480u, voff0 + 4096u, _p2); scan_dma(_d + 24576u, voff0, _p3); scan_dma(_d + 28672u, voff0 + 4096u, _p3); \
            scan_dma(_d + 32768u, voff0, _p4); scan_dma(_d + 36864u, voff0 + 4096u, _p4); } while (0)
        static_assert(RC_NSLOT == 3, "vmcnt literal below = 10 x (RC_NSLOT - 2)");
        RC_ISSUE(0, 0); RC_ISSUE(1, 1);
        int slot = 2;
#pragma unroll 1
        for (int k = 0; k < nch; ++k) {
            asm volatile("s_waitcnt vmcnt(10)" ::: "memory");
            __builtin_amdgcn_s_barrier();
            RC_ISSUE(k + 2, slot);
            slot = (slot == 2) ? 0 : slot + 1;
        }
        asm volatile("s_waitcnt vmcnt(0)" ::: "memory");
#undef RC_ISSUE
    } else {
        const int trow = 16 * w + r, prow = trow > 0 ? trow - 1 : 0;
        const int sw = (trow & 7) << 4, swp = (prow & 7) << 4, swr = (r & 7) << 4;
        float bn_n = 0.f; u32x2 pvg_n[4];
#define RC_PRE(k) do { const int _ci = F.bid + (k) * F.G, _bh = _ci >> 6, _c = _ci & 63, _b = _bh >> 3, _h = _bh & 7; const size_t _t0 = (size_t)_b * SEQ + _c * 64; \
            bn_n = bonus[(_t0 + trow) * 8 + _h]; \
            _Pragma("unroll") for (int n = 0; n < 4; ++n) pvg_n[n] = *(const u32x2*)(prw + hm_off((int)(_t0 > 0 ? _t0 - 1 : 0), 1024 + _h * 64 + 16 * n + 4 * q)); } while (0)
        RC_PRE(0);
        int slot = 0;
#pragma unroll 1
        for (int k = 0; k < nch; ++k) {
            const int ci = F.bid + k * F.G;
            RcIn x; x.bn = bn_n;
#pragma unroll
            for (int n = 0; n < 4; ++n) x.pv[n] = pvg_n[n];
            __builtin_amdgcn_s_barrier();
            if (k + 1 < nch) RC_PRE(k + 1);
            const LAS unsigned char* sl = F.lds + slot * RC_SLOT;
#pragma unroll
            for (int s2 = 0; s2 < 2; ++s2) x.qf[s2] = *(const LAS bf16x8*)(sl + trow * 128 + (((4 * s2 + q) << 4) ^ sw));
#pragma unroll
            for (int n = 0; n < 4; ++n) { const int o8 = trow * 128 + (((2 * n + (q >> 1)) << 4) ^ sw) + 8 * (q & 1);
                x.y0[n] = *(const LAS u32x2*)(sl + 8192 + o8); x.cv[n] = *(const LAS u32x2*)(sl + 24576 + o8); x.gw[n] = *(const LAS u32x2*)(sl + 32768 + o8);
                const u32x2 pl = *(const LAS u32x2*)(sl + 24576 + prow * 128 + (((2 * n + (q >> 1)) << 4) ^ swp) + 8 * (q & 1));
                if (trow > 0) x.pv[n] = pl;
#pragma unroll
                for (int s2 = 0; s2 < 2; ++s2) x.hb[n][s2] = *(const LAS bf16x8*)(sl + 16384 + (16 * n + r) * 128 + (((4 * s2 + q) << 4) ^ swr)); }
            rc_compute(x, yrw, mu, ln_g, ln_b, ci * 4 + w, r, q);
            slot = (slot == 2) ? 0 : slot + 1;
        }
#undef RC_PRE
    }
}

DI void p_moe_prep_rows(const Frame& F, int row0) {
    const bf16_t* hb = (const bf16_t*)(F.ws + WS_HB); float* rsv = (float*)(F.ws + WS_RS); unsigned char* out8 = (unsigned char*)(F.ws + WS_XN2F8); const float* g = F.in[26];
    for (int row = row0 + F.wave; row < row0 + BM; row += 2 * NWAVES) {
        const int row2 = row + NWAVES;
        u32x4 a[2], b[2];
        a[0] = *(const u32x4*)(hb + (size_t)row * D + F.lane * 16); a[1] = *(const u32x4*)(hb + (size_t)row * D + F.lane * 16 + 8);
        b[0] = *(const u32x4*)(hb + (size_t)row2 * D + F.lane * 16); b[1] = *(const u32x4*)(hb + (size_t)row2 * D + F.lane * 16 + 8);
        float v[16], u[16]; float ss = 0.f, su = 0.f;
#pragma unroll
        for (int j = 0; j < 8; ++j) { v[2 * j] = bf_lo(a[j >> 2][j & 3]); v[2 * j + 1] = bf_hi(a[j >> 2][j & 3]); u[2 * j] = bf_lo(b[j >> 2][j & 3]); u[2 * j + 1] = bf_hi(b[j >> 2][j & 3]); }
#pragma unroll
        for (int j = 0; j < 16; ++j) { ss += v[j] * v[j]; su += u[j] * u[j]; }
        ss = wave_sum(ss); su = wave_sum(su);
        const float rs = rsqrtf(ss * (1.0f / D) + 1e-5f), ru = rsqrtf(su * (1.0f / D) + 1e-5f);
        float gv[16];
#pragma unroll
        for (int q = 0; q < 4; ++q) { const f32x4 t = *(const f32x4*)(g + F.lane * 16 + q * 4); gv[4 * q] = t[0]; gv[4 * q + 1] = t[1]; gv[4 * q + 2] = t[2]; gv[4 * q + 3] = t[3]; }
#pragma unroll
        for (int j = 0; j < 16; ++j) { v[j] *= rs * gv[j]; u[j] *= ru * gv[j]; }
        u32x4 q0, q1;
        if (F.lane == 0) { rsv[row] = rs; rsv[row2] = ru; }
        q0.x = pk4_fp8(v[0] * F8_SX, v[1] * F8_SX, v[2] * F8_SX, v[3] * F8_SX); q0.y = pk4_fp8(v[4] * F8_SX, v[5] * F8_SX, v[6] * F8_SX, v[7] * F8_SX);
        q0.z = pk4_fp8(v[8] * F8_SX, v[9] * F8_SX, v[10] * F8_SX, v[11] * F8_SX); q0.w = pk4_fp8(v[12] * F8_SX, v[13] * F8_SX, v[14] * F8_SX, v[15] * F8_SX);
        q1.x = pk4_fp8(u[0] * F8_SX, u[1] * F8_SX, u[2] * F8_SX, u[3] * F8_SX); q1.y = pk4_fp8(u[4] * F8_SX, u[5] * F8_SX, u[6] * F8_SX, u[7] * F8_SX);
        q1.z = pk4_fp8(u[8] * F8_SX, u[9] * F8_SX, u[10] * F8_SX, u[11] * F8_SX); q1.w = pk4_fp8(u[12] * F8_SX, u[13] * F8_SX, u[14] * F8_SX, u[15] * F8_SX);
        *(u32x4*)(out8 + (size_t)row * D + F.lane * 16) = q0; *(u32x4*)(out8 + (size_t)row2 * D + F.lane * 16) = q1;
    }
}
DI void p_moe_b1p(const Frame& F) {
    float* b1p = (float*)(F.ws + WS_B1P); const float* b1 = F.in[30]; CmSwi cm;
    for (int idx = F.bid * NTHR + F.tid; idx < 32 * 2048; idx += F.G * NTHR) { const int e = idx >> 11, n = idx & 2047; b1p[idx] = b1[e * 2048 + cm(n)]; }
}
DI void p_conv_part(const Frame& F, int part) {
    if (part == 0) conv_T8(F, F.in[29], (size_t)1024 * 2048, 2048, (unsigned char*)(F.ws + WS_W1), 2048, 1024, 32, MpSwi(), F8_SW, 0, 2048);
    else if (part == 1) conv_T8(F, F.in[29], (size_t)1024 * 2048, 2048, (unsigned char*)(F.ws + WS_W1), 2048, 1024, 32, MpSwi(), F8_SW, 2048, 4096);
    else conv_T8(F, F.in[31], (size_t)1024 * 1024, 1024, (unsigned char*)(F.ws + WS_W2), 1024, 1024, 32, MpId(), F8_SW);
}

DI void router_rows(const Frame& F, int row0) {
    const bf16_t* hb = (const bf16_t*)(F.ws + WS_HB); const bf16_t* wr = (const bf16_t*)(F.ws + WS_WR); float* logits = (float*)(F.ws + WS_LOG);
    constexpr int WP = 1040;
    LAS bf16_t* wl = (LAS bf16_t*)(F.lds + 4096);
    for (int p = F.tid; p < 4096; p += NTHR) { const int n = p >> 7, c = (p & 127) * 8; *(LAS u32x4*)(wl + n * WP + c) = *(const u32x4*)(wr + n * 1024 + c); }
    __syncthreads();
    const int r = F.lane & 15, q = F.lane >> 4;
    for (int tl = F.wave; tl < 16; tl += NWAVES) {
        const bf16_t* ap = hb + (size_t)(row0 + 16 * tl + r) * D + 8 * q;
        f32x4 acc[2] = {(f32x4){0.f, 0.f, 0.f, 0.f}, (f32x4){0.f, 0.f, 0.f, 0.f}};
#pragma unroll 1
        for (int sb = 0; sb < 32; sb += 8) {
            bf16x8 a[8];
#pragma unroll
            for (int j = 0; j < 8; ++j) a[j] = *(const bf16x8*)(ap + 32 * (sb + j));
#pragma unroll
            for (int j = 0; j < 8; ++j)
#pragma unroll
                for (int n = 0; n < 2; ++n) { const bf16x8 b = *(const LAS bf16x8*)(wl + (16 * n + r) * WP + 32 * (sb + j) + 8 * q);
                    acc[n] = __builtin_amdgcn_mfma_f32_16x16x32_bf16(b, a[j], acc[n], 0, 0, 0); }
        }
#pragma unroll
        for (int n = 0; n < 2; ++n) *(f32x4*)(logits + (size_t)(row0 + 16 * tl + r) * 32 + 16 * n + 4 * q) = acc[n];
    }
    asm volatile("s_waitcnt vmcnt(0)" ::: "memory");
    __syncthreads();
}

DI void topk_rows(const Frame& F, int row0) {
    LAS unsigned* cnt = (LAS unsigned*)F.lds; LAS unsigned* base = cnt + 32;
    const float* logits = (const float*)(F.ws + WS_LOG); unsigned* epos = (unsigned*)(F.ws + WS_EPOS); float* gatev = (float*)(F.ws + WS_GATEV);
    const int pass = row0 / TPP;
    unsigned* gcnt = (unsigned*)(F.ws + WS_CTL) + CW_GCNT + pass * 32;
    if (F.tid < 32) cnt[F.tid] = 0u;
    __syncthreads();
    int e4[4] = {0, 0, 0, 0}; unsigned p4[4] = {0u, 0u, 0u, 0u}; float g4[4] = {0.f, 0.f, 0.f, 0.f};
    const int token = row0 + F.tid;
    if (F.tid < 256) {
        float l[32]; const float rsc = ((const float*)(F.ws + WS_RS))[token];
#pragma unroll
        for (int q = 0; q < 8; ++q) { const f32x4 v = *(const f32x4*)(logits + (size_t)token * 32 + q * 4), bq = *(const f32x4*)(F.in[28] + q * 4); l[q * 4] = v[0] * rsc + bq[0]; l[q * 4 + 1] = v[1] * rsc + bq[1]; l[q * 4 + 2] = v[2] * rsc + bq[2]; l[q * 4 + 3] = v[3] * rsc + bq[3]; }
        unsigned used = 0u; float tv[4];
#pragma unroll
        for (int k = 0; k < 4; ++k) { float best = -3.0e38f; int bi = 0;
#pragma unroll
            for (int e = 0; e < 32; ++e) { const bool ok = !((used >> e) & 1u) && (l[e] > best); best = ok ? l[e] : best; bi = ok ? e : bi; }
            used |= 1u << bi; e4[k] = bi; tv[k] = best; }
        const float m = tv[0]; float ex[4], sum = 0.f;
#pragma unroll
        for (int k = 0; k < 4; ++k) { ex[k] = __expf(tv[k] - m); sum += ex[k]; }
#pragma unroll
        for (int k = 0; k < 4; ++k) { g4[k] = ex[k] / sum; p4[k] = atomicAdd((unsigned*)&cnt[e4[k]], 1u); }
    }
    __syncthreads();
    if (F.tid < 32) base[F.tid] = __hip_atomic_fetch_add(&gcnt[F.tid], cnt[F.tid], __ATOMIC_RELAXED, __HIP_MEMORY_SCOPE_AGENT);
    __syncthreads();
    if (F.tid < 256) {
#pragma unroll
        for (int k = 0; k < 4; ++k) { epos[(size_t)token * 4 + k] = ((unsigned)e4[k] << 24) | (base[e4[k]] + p4[k]); gatev[(size_t)token * 4 + k] = g4[k]; }
    }
    __syncthreads();
}
DI void p_gather(const Frame& F, int pass) {
    LAS int* poff = (LAS int*)F.lds;
    LAS int* pcnt = poff + 40;
    unsigned* gcnt = (unsigned*)(F.ws + WS_CTL) + CW_GCNT + pass * 32;
    int* tile_e = (int*)(F.ws + WS_TILEE) + pass * TE_STRIDE;
    __syncthreads();
    if (F.tid == 0) { int acc = 0; for (int e = 0; e < 32; ++e) { poff[e] = acc; const int c = (int)__hip_atomic_load(&gcnt[e], __ATOMIC_RELAXED, __HIP_MEMORY_SCOPE_AGENT); pcnt[e] = c; acc += ((c + 255) >> 8) << 8; } poff[32] = acc; }
    __syncthreads();
    if (F.bid == 0) {
        const int nt = poff[32] >> 8;
        for (int t = F.tid; t < nt; t += NTHR) { int e = 0; for (int q = 1; q < 32; ++q) if (poff[q] <= t * 256) e = q; tile_e[1 + t] = e; }
        if (F.tid == 0) tile_e[0] = nt;
    }
    const unsigned* epos = (const unsigned*)(F.ws + WS_EPOS); const float* gatev = (const float*)(F.ws + WS_GATEV);
    int* slot = (int*)(F.ws + WS_SLOT); float* rowg = (float*)(F.ws + WS_ROWG) + (size_t)pass * MAXTILES * 256;
    int* rowtok = (int*)(F.ws + WS_ROWTOK) + (size_t)pass * MAXTILES * 256;
    for (int i = F.bid * NTHR + F.tid; i < 32 * 256; i += F.G * NTHR) { const int e = i >> 8, sl = poff[e] + pcnt[e] + (i & 255); if (sl < poff[e + 1]) rowtok[sl] = 0; }
    for (int i = F.bid * NTHR + F.tid; i < TPP * 4; i += F.G * NTHR) {
        const int token = pass * TPP + (i >> 2);
        const unsigned ep = epos[(size_t)pass * TPP * 4 + i]; const int sl = poff[ep >> 24] + (int)(ep & 0xffffffu);
        slot[(size_t)pass * TPP * 4 + i] = sl; rowg[sl] = gatev[(size_t)pass * TPP * 4 + i]; rowtok[sl] = token;
    }
    __syncthreads();
}
typedef int i32x4_t __attribute__((ext_vector_type(4)));
constexpr int CB_NSLOT = 5, CB_TOK = 6144, CB_SLOT = 4 * CB_TOK;
DI void p_combine(const Frame& F, int pass) {
    int tz_ = threadIdx.x; asm volatile("" : "+v"(tz_)); const int lane_ = tz_ & 63;
    const i32x4_t* slot = (const i32x4_t*)(F.ws + WS_SLOT); const unsigned char* y2 = (const unsigned char*)(F.ws + WS_XS) + (size_t)pass * PASS_BUF; const float* gf = F.in[33];
    const bf16_t* hbb = (const bf16_t*)(F.ws + WS_HB);
    const unsigned ldsbase = (unsigned)(size_t)F.lds;
    const int w = F.wave, stride = F.G * 4, nst = (TPP + stride - 1) / stride, tb0 = pass * TPP;
    if (w >= 4) {
        const int lw = w - 4; const unsigned vo = (unsigned)lane_ * 16u;
#define CB_ISSUE(k, sl) do { int _t = F.bid * 4 + lw + (((k) < nst) ? (k) : nst - 1) * stride; _t = _t < TPP ? _t : TPP - 1; const int _tok = tb0 + _t; \
            i32x4_t _s; asm volatile("s_load_dwordx4 %0, %1, 0x0\n\ts_waitcnt lgkmcnt(0)" : "=s"(_s) : "s"(slot + _tok) : "memory"); \
            const unsigned _d = ldsbase + (unsigned)(sl) * CB_SLOT + (unsigned)lw * CB_TOK; const char* _h = (const char*)(hbb + (size_t)_tok * D); \
            scan_dma(_d, vo, _h); scan_dma(_d + 1024u, vo + 1024u, _h); \
            scan_dma(_d + 2048u, vo, (const char*)(y2 + (size_t)_s[0] * D)); scan_dma(_d + 3072u, vo, (const char*)(y2 + (size_t)_s[1] * D)); \
            scan_dma(_d + 4096u, vo, (const char*)(y2 + (size_t)_s[2] * D)); scan_dma(_d + 5120u, vo, (const char*)(y2 + (size_t)_s[3] * D)); } while (0)
        static_assert(CB_NSLOT == 5, "vmcnt literal below = 6 x (CB_NSLOT - 2)");
        CB_ISSUE(0, 0); CB_ISSUE(1, 1); CB_ISSUE(2, 2); CB_ISSUE(3, 3);
        int sl = 4;
#pragma unroll 1
        for (int k = 0; k < nst; ++k) {
            asm volatile("s_waitcnt vmcnt(18)" ::: "memory");
            __builtin_amdgcn_s_barrier();
            CB_ISSUE(k + 4, sl);
            sl = (sl == CB_NSLOT - 1) ? 0 : sl + 1;
        }
        asm volatile("s_waitcnt vmcnt(0)" ::: "memory");
#undef CB_ISSUE
    } else {
        f32x4 gv[4];
#pragma unroll
        for (int q = 0; q < 4; ++q) gv[q] = *(const f32x4*)(gf + lane_ * 16 + q * 4);
        int sl = 0;
#pragma unroll 1
        for (int k = 0; k < nst; ++k) {
            const int t = F.bid * 4 + w + k * stride;
            __builtin_amdgcn_s_barrier();
            const LAS unsigned char* p = F.lds + sl * CB_SLOT + w * CB_TOK;
            const u32x4 h0 = *(const LAS u32x4*)(p + lane_ * 32), h1 = *(const LAS u32x4*)(p + lane_ * 32 + 16);
            u32x4 yw[4];
#pragma unroll
            for (int k2 = 0; k2 < 4; ++k2) yw[k2] = *(const LAS u32x4*)(p + 2048 + 1024 * k2 + lane_ * 16);
            float v[16];
#pragma unroll
            for (int j = 0; j < 4; ++j) { v[2 * j] = bf_lo(h0[j]); v[2 * j + 1] = bf_hi(h0[j]); v[8 + 2 * j] = bf_lo(h1[j]); v[8 + 2 * j + 1] = bf_hi(h1[j]); }
#pragma unroll
            for (int k2 = 0; k2 < 4; ++k2)
#pragma unroll
                for (int j = 0; j < 4; ++j) { const f32x2 lo = __builtin_amdgcn_cvt_pk_f32_fp8((int)yw[k2][j], false), hi = __builtin_amdgcn_cvt_pk_f32_fp8((int)yw[k2][j], true);
                    v[4 * j] += lo[0] * (1.0f / F8_SY); v[4 * j + 1] += lo[1] * (1.0f / F8_SY); v[4 * j + 2] += hi[0] * (1.0f / F8_SY); v[4 * j + 3] += hi[1] * (1.0f / F8_SY); }
            float ss = 0.f;
#pragma unroll
            for (int j = 0; j < 16; ++j) ss += v[j] * v[j];
            ss = wave_sum(ss);
            const float rs = rsqrtf(ss * (1.0f / D) + 1e-5f);
            if (t < TPP) { f32x4* orow = (f32x4*)(F.out + (size_t)(tb0 + t) * D + lane_ * 16);
#pragma unroll
                for (int q = 0; q < 4; ++q) orow[q] = (f32x4){v[q * 4] * rs * gv[q][0], v[q * 4 + 1] * rs * gv[q][1], v[q * 4 + 2] * rs * gv[q][2], v[q * 4 + 3] * rs * gv[q][3]}; }
            sl = (sl == CB_NSLOT - 1) ? 0 : sl + 1;
        }
    }
    __syncthreads();
}

constexpr int N_PHASES = 17;
__global__ void __launch_bounds__(NTHR, 2) fwd_kernel(KArgs args) {
    extern __shared__ __attribute__((aligned(16))) unsigned char lds_raw[];
    Frame F; F.lds = (LAS unsigned char*)lds_raw; F.tid = threadIdx.x; F.lane = F.tid & 63; F.wave = __builtin_amdgcn_readfirstlane(F.tid >> 6);
    F.G = gridDim.x; F.bid = blockIdx.x; F.in = args.in; F.out = args.out; F.ws = args.ws;
    unsigned char* ws = args.ws;
    volatile LAS unsigned* MISC = (volatile LAS unsigned*)(F.lds + MISC_OFF);
    if (F.tid < 4) MISC[F.tid] = 0u;
    __syncthreads();
    XcdBarrier bar; bar.bar = (unsigned*)(ws + WS_CTL) + CW_BAR; bar.x = 0; bar.st = MISC;
    if (N_LAUNCH_MODE == 1) bar = xcd_barrier_post((unsigned*)(ws + WS_CTL) + CW_BAR, MISC);
    const int lo = args.ph_lo, hi = args.ph_hi;
#define IN(k) (lo <= (k) && (k) < hi)
#define REP(k) for (int _r = 0; _r < 1 + (int)((PROBE_MASK >> (k)) & 1u); ++_r)
#define SEAM(k) do { if (N_LAUNCH_MODE == 1 && IN(k) && IN((k) + 1)) xcd_barrier(bar); } while (0)
    bf16_t* gates = (bf16_t*)args.out;

    if (IN(0)) { REP(0) p0_prologue(F); SEAM(0); }
    if (IN(1)) {
        { PlainSched S; S.init(ws + WS_XN, ws + WS_WIN, T, 1024, D, D, D, F.G, F.bid); S.pn_base = 2;
          EpiWin E{(bf16_t*)(ws + WS_US5), (bf16_t*)(ws + WS_PRW), gates};
          gemm_phase(F.lds, S, E); }
        { PlainSchedT<true> S; S.init(ws + WS_XN8, ws + WS_WIN8, T, 3328, 512, 512, 512, F.G, F.bid);
          EpiWinG8 E{(bf16_t*)(ws + WS_US5), (bf16_t*)(ws + WS_PRW), gates};
          gemm_phase(F.lds, S, E); }
        SEAM(1);
    }
    if (IN(2)) {
        GroupSched S; S.init(ws + WS_US5, ws + WS_WST, 512, LDU, 512, S5ROWS / BM, 1, F.G, F.bid);
        EpiS5State E{(float*)(ws + WS_SLOC)};
        REP(2) { gemm_phase(F.lds, S, E); p_rw_prep(F); } SEAM(2);
    }
    if (IN(3)) {
        REP(3) p_s5_carry(F);
        PlainSched S; S.init(ws + WS_ALORA, ws + WS_WLORA, T, 1536, 128, 256, 128, F.G, F.bid); S.akoff_pn = 4; S.akoff_bytes = 256;
        EpiLora E{(bf16_t*)(ws + WS_LWAG), F.in[14], F.in[16]};
        REP(3) gemm_phase(F.lds, S, E); SEAM(3);
    }
    if (IN(4)) {
        GroupSched S; S.init(ws + WS_US5, ws + WS_TOEP, LDU, LDU, LDU, S5ROWS / BM, 2, F.G, F.bid);
        EpiS5Out E{(unsigned char*)(ws + WS_YS8)};
        REP(4) gemm_phase(F.lds, S, E); SEAM(4);
    }
    if (IN(5)) { REP(5) p_rw_chunk(F); SEAM(5); }
    if (IN(6)) { REP(6) p_rw_scan(F); SEAM(6); }
    if (IN(7)) { REP(7) p_rw_out(F); SEAM(7); }
    if (IN(8)) {
        PlainSchedT<true> S; S.init(ws + WS_YS8, ws + WS_WGLU8, T, 2048, 256, 256, 256, F.G, F.bid);
        EpiGlu E{(bf16_t*)(ws + WS_XN), gates, (const float*)(ws + WS_BGLU)};
        if (F.bid & 1) p_conv_part(F, 0);
        gemm_phase(F.lds, S, E);
        if (!(F.bid & 1)) p_conv_part(F, 0);
        SEAM(8);
    }
    if (IN(9)) {
        PlainSched S; S.init(ws + WS_YRW, ws + WS_WO, T, 1024, 512, 512, 512, F.G, F.bid);
        EpiWo E{(bf16_t*)(ws + WS_XN), gates, (unsigned char*)(ws + WS_MIXED8)};
        if (F.bid & 1) p_conv_part(F, 1);
        gemm_phase(F.lds, S, E);
        if (!(F.bid & 1)) p_conv_part(F, 1);
        SEAM(9);
    }
    if (IN(10)) {
        PlainSchedT<true> S; S.init(ws + WS_MIXED8, ws + WS_WOUT8, T, 1024, 512, 512, 512, F.G, F.bid); S.rowown = 1;
        EpiOut E{(bf16_t*)(ws + WS_HB), F.in[0]};
        if (F.bid & 1) p_conv_part(F, 2);
        gemm_phase(F.lds, S, E);
        if (!(F.bid & 1)) p_conv_part(F, 2);
        if (N_LAUNCH_MODE == 1 && IN(10) && IN(11)) { asm volatile("s_waitcnt vmcnt(0)" ::: "memory"); __syncthreads(); __builtin_amdgcn_fence(__ATOMIC_ACQUIRE, "agent"); }
    }
    if (IN(11)) {
        PlainSched S; S.init(ws + WS_HB, ws + WS_WR, T, 256, 1024, 1024, 1024, F.G, F.bid); S.rowown = 1;
        { Unit u; for (int i = 0; S.next(i, u); ++i) p_moe_prep_rows(F, u.pm * BM); }
        p_moe_b1p(F);
        asm volatile("s_waitcnt vmcnt(0)" ::: "memory"); __syncthreads();
        { Unit u; for (int i = 0; S.next(i, u); ++i) router_rows(F, u.pm * BM); }
        { Unit u; for (int i = 0; S.next(i, u); ++i) topk_rows(F, u.pm * BM); }
        SEAM(11);
    }
    if (IN(12)) { p_gather(F, 0); p_gather(F, 1); SEAM(12); }
#define MOE_G1(PASS, CIDX) \
            const int* te = (const int*)(ws + WS_TILEE) + (PASS) * TE_STRIDE; const int ntl = __builtin_amdgcn_readfirstlane(__hip_atomic_load(te, __ATOMIC_RELAXED, __HIP_MEMORY_SCOPE_AGENT)); \
            MoeSched<true> S; S.init(ws + WS_XN2F8, ws + WS_W1, te + 1, (const int*)(ws + WS_ROWTOK) + (size_t)(PASS) * MAXTILES * 256, ntl, 512, 8, F.G, (CIDX)); \
            EpiMoe1 E{(unsigned char*)(ws + WS_ACT) + (size_t)(PASS) * PASS_BUF, (const float*)(ws + WS_B1P)};
#define MOE_G2(PASS) \
            const int* te = (const int*)(ws + WS_TILEE) + (PASS) * TE_STRIDE; const int ntl = __builtin_amdgcn_readfirstlane(__hip_atomic_load(te, __ATOMIC_RELAXED, __HIP_MEMORY_SCOPE_AGENT)); \
            MoeSched<false> S; S.init(ws + WS_ACT + (size_t)(PASS) * PASS_BUF, ws + WS_W2, te + 1, nullptr, ntl, 512, 4, F.G, F.bid); \
            EpiMoe2 E{(unsigned char*)(ws + WS_XS) + (size_t)(PASS) * PASS_BUF, F.in[32], (const float*)(ws + WS_ROWG) + (size_t)(PASS) * MAXTILES * 256};
    if (IN(13)) { MOE_G1(0, F.bid) gemm_phase(F.lds, S, E); SEAM(13); }
    if (IN(14)) {
        { MOE_G2(0) gemm_phase(F.lds, S, E); }
        { MOE_G1(1, F.G - 1 - F.bid) gemm_phase(F.lds, S, E); }
        SEAM(14);
    }
    if (IN(15)) {
        if (F.bid & 1) p_combine(F, 0);
        { MOE_G2(1) gemm_phase(F.lds, S, E); }
        if (!(F.bid & 1)) p_combine(F, 0);
        SEAM(15);
    }
    if (IN(16)) { p_combine(F, 1); }
#undef MOE_G1
#undef MOE_G2
#undef IN
#undef SEAM
#undef REP
}

extern "C" void kernel_launch(void* const* d_in, const int* in_sizes, int n_in, void* d_out, int out_size, void* d_ws, size_t ws_size, hipStream_t stream) {
    static int grid = 0;
    if (grid == 0) {
        if (n_in != 34 || in_sizes[0] != T * D || out_size != T * D || ws_size < WS_END) { fprintf(stderr, "kernel_launch: unexpected shapes (n_in %d, in0 %d, out %d, ws %zu < %zu)\n", n_in, n_in > 0 ? in_sizes[0] : -1, out_size, ws_size, (size_t)WS_END); grid = -1; return; }
        int dev = 0, cus = 0, per_cu = 0;
        if (hipGetDevice(&dev) != hipSuccess || hipDeviceGetAttribute(&cus, hipDeviceAttributeMultiprocessorCount, dev) != hipSuccess) { grid = -1; return; }
        if (hipFuncSetAttribute((const void*)fwd_kernel, hipFuncAttributeMaxDynamicSharedMemorySize, LDS_BYTES) != hipSuccess) { fprintf(stderr, "kernel_launch: hipFuncSetAttribute failed\n"); grid = -1; return; }
        if (hipOccupancyMaxActiveBlocksPerMultiprocessor(&per_cu, (const void*)fwd_kernel, NTHR, LDS_BYTES) != hipSuccess || per_cu < 1) { fprintf(stderr, "kernel_launch: occupancy query says %d\n", per_cu); }
        (void)hipGetLastError();
        grid = cus;
    }
    if (grid < 0) return;
    (void)hipMemsetAsync((char*)d_ws + WS_CTL, 0, CTL_BYTES, stream);
    KArgs a{};
    for (int i = 0; i < 34; ++i) a.in[i] = (const float*)d_in[i];
    a.out = (float*)d_out; a.ws = (unsigned char*)d_ws;
    if (N_LAUNCH_MODE == 1) {
        a.ph_lo = 0; a.ph_hi = N_PHASES;
        hipLaunchKernelGGL(fwd_kernel, dim3(grid), dim3(NTHR), LDS_BYTES, stream, a);
    } else {
        for (int p = 0; p < N_PHASES; ++p) { a.ph_lo = p; a.ph_hi = p + 1; hipLaunchKernelGGL(fwd_kernel, dim3(grid), dim3(NTHR), LDS_BYTES, stream, a); }
    }
}
```
